# Optimizing an MI355X kernel written in HIP

```python
import math
import jax, jax.numpy as jnp
from jax import lax
import numpy as np

D_MODEL = 1024
BATCH = 4
SEQ = 8192
DEPTH = 4

HEAD_DIM = 64
MIX_WIDTH = D_MODEL
SWA_HEADS = 4
SWA_KV_HEADS = 2
SWA_WINDOW = 128
SWA_BLOCK = 128
NSA_HEADS = 4
NSA_CMP_BLOCK = 32
NSA_CMP_STRIDE = 16
NSA_CMP_HIDDEN = 128
NSA_SEL_BLOCK = 64
NSA_TOP_N = 16
NSA_WINDOW = 512
NSA_Q_BLOCK = 128
NSA_KV_STREAMS = 6
NSA_BRANCHES = 3
SWA_WIDTH = SWA_HEADS * HEAD_DIM
SWA_KV_WIDTH = SWA_KV_HEADS * HEAD_DIM
NSA_WIDTH = NSA_HEADS * HEAD_DIM
SSM_WIDTH = MIX_WIDTH - SWA_WIDTH - NSA_WIDTH
SSM_GROUP_CH = 16
SSM_GROUPS = SSM_WIDTH // SSM_GROUP_CH
SSM_STATE = 64
DT_MIN = 1e-3
DT_MAX = 1e-1
NUM_BUCKETS = 32
BUCKET_EXACT = NUM_BUCKETS // 2
BUCKET_MAX_DIST = 1024
N_BIAS_HEADS = SWA_HEADS + NSA_HEADS
D_FF = 4 * D_MODEL
EPS = 1e-6
NEG_INF = -1e30
SEL_FORCE = 1e4
OFF_QA = 0
OFF_KA = OFF_QA + SWA_WIDTH
OFF_VA = OFF_KA + SWA_KV_WIDTH
OFF_U = OFF_VA + SWA_KV_WIDTH
OFF_QC = OFF_U + SSM_WIDTH
OFF_KVC = OFF_QC + NSA_WIDTH
OFF_GC = OFF_KVC + NSA_KV_STREAMS * HEAD_DIM
IN_WIDTH = OFF_GC + NSA_BRANCHES * NSA_HEADS

kernel_name = "hybrid_swa_s5_nsa_trunk"


def rms_norm(x, g):
    xf = x.astype(jnp.float32)
    y = xf * lax.rsqrt(jnp.mean(xf * xf, axis=-1, keepdims=True) + EPS)
    return (y * g.astype(jnp.float32)).astype(x.dtype)


def rel_bucket(dist):
    n = jnp.maximum(dist, 0)
    nf = jnp.maximum(n, 1).astype(jnp.float32)
    large = BUCKET_EXACT + (jnp.log(nf / BUCKET_EXACT) / math.log(BUCKET_MAX_DIST / BUCKET_EXACT)
                            * (NUM_BUCKETS - BUCKET_EXACT)).astype(jnp.int32)
    return jnp.where(n < BUCKET_EXACT, n, jnp.minimum(large, NUM_BUCKETS - 1))


def masked_softmax(logits, valid):
    p = jax.nn.softmax(jnp.where(valid, logits, NEG_INF), axis=-1)
    return jnp.where(valid, p, 0.0)


def swa_sink_mixer(q, k, v, sinks, bias_tbl):
    Bsz, L, H, d = q.shape
    KV = k.shape[2]
    G = H // KV
    nb = L // SWA_BLOCK
    pad = ((0, 0), (SWA_BLOCK, 0), (0, 0), (0, 0))
    kp = jnp.pad(k, pad).reshape(Bsz, nb + 1, SWA_BLOCK, KV, d)
    vp = jnp.pad(v, pad).reshape(Bsz, nb + 1, SWA_BLOCK, KV, d)
    kb = jnp.concatenate([kp[:, :-1], kp[:, 1:]], axis=2)
    vb = jnp.concatenate([vp[:, :-1], vp[:, 1:]], axis=2)
    qb = q.reshape(Bsz, nb, SWA_BLOCK, KV, G, d)
    lg = jnp.einsum('bnqkgd,bnskd->bnkgqs', qb, kb, preferred_element_type=jnp.float32) * (d ** -0.5)
    i = jnp.arange(SWA_BLOCK)[:, None]
    j = jnp.arange(2 * SWA_BLOCK)[None, :]
    dist = i - j + SWA_BLOCK
    bias = bias_tbl.astype(jnp.float32)[rel_bucket(dist)]
    bias = bias.transpose(2, 0, 1).reshape(KV, G, SWA_BLOCK, 2 * SWA_BLOCK)
    s_pos = jnp.arange(nb)[:, None] * SWA_BLOCK - SWA_BLOCK + j
    valid = ((dist >= 0) & (dist < SWA_WINDOW))[None] & (s_pos >= 0)[:, None, :]
    valid = valid[None, :, None, None]
    lg = jnp.where(valid, lg + bias, NEG_INF)
    sink = sinks.astype(jnp.float32).reshape(KV, G, 1, 1)
    m = jnp.maximum(jnp.max(lg, axis=-1, keepdims=True), sink)
    p = jnp.exp(lg - m)
    denom = jnp.sum(p, axis=-1, keepdims=True) + jnp.exp(sink - m)
    o = jnp.einsum('bnkgqs,bnskd->bnqkgd', p / denom, vb.astype(jnp.float32))
    return o.reshape(Bsz, L, H * d).astype(q.dtype)


def _scan_combine(left, right):
    a_l, b_l = left
    a_r, b_r = right
    return a_r * a_l, a_r * b_l + b_r


def s5_mixer(u, a_re, a_im, log_dt, b_re, b_im, c_re, c_im, d_skip, glu_w, glu_b):
    Bsz, L, W = u.shape
    f32 = jnp.float32
    uf = u.astype(f32).reshape(Bsz, L, SSM_GROUPS, SSM_GROUP_CH)
    A = lax.complex(a_re.astype(f32), a_im.astype(f32))
    dt = jnp.exp(log_dt.astype(f32))[:, None]
    A_bar = jnp.exp(A * dt)
    Bm = lax.complex(b_re.astype(f32), b_im.astype(f32))
    B_bar = ((A_bar - 1.0) / A)[..., None] * Bm
    Bu = jnp.einsum('blgp,gnp->blgn', uf.astype(jnp.complex64), B_bar)
    a_seq = jnp.broadcast_to(A_bar, (1, L) + A_bar.shape)
    _, states = lax.associative_scan(_scan_combine, (a_seq, Bu), axis=1)
    Cm = lax.complex(c_re.astype(f32), c_im.astype(f32))
    y = jnp.einsum('blgn,gpn->blgp', states, Cm).real
    y = y + d_skip.astype(f32).reshape(SSM_GROUPS, SSM_GROUP_CH) * uf
    z = jax.nn.gelu(y.reshape(Bsz, L, W))
    ab = z @ glu_w.astype(f32) + glu_b.astype(f32)
    out = ab[..., :W] * jax.nn.sigmoid(ab[..., W:])
    return out.astype(u.dtype)


def nsa_compress(tok, pos, w1, w2):
    Bsz, L, d = tok.shape
    ch = tok.reshape(Bsz, L // NSA_CMP_STRIDE, NSA_CMP_STRIDE, d)
    blocks = jnp.concatenate([ch[:, :-1], ch[:, 1:]], axis=2)
    M = blocks.shape[1]
    blocks = (blocks + pos).reshape(Bsz, M, NSA_CMP_BLOCK * d)
    return jax.nn.gelu(blocks @ w1) @ w2


def nsa_mixer(q, kv, gates, cmp_pos, cmp_w1, cmp_w2, g_kc, g_ks, g_kw, bias_tbl):
    Bsz, L, HC, d = q.shape
    f32 = jnp.float32
    k_cmp = rms_norm(nsa_compress(kv[:, :, 0], cmp_pos[0], cmp_w1[0], cmp_w2[0]), g_kc)
    v_cmp = nsa_compress(kv[:, :, 1], cmp_pos[1], cmp_w1[1], cmp_w2[1]).astype(f32)
    NS = L // NSA_SEL_BLOCK
    n_top = min(NSA_TOP_N, NS)
    k_sel = rms_norm(kv[:, :, 2], g_ks).reshape(Bsz, NS, NSA_SEL_BLOCK, d)
    v_sel = kv[:, :, 3].reshape(Bsz, NS, NSA_SEL_BLOCK, d)
    wpad = ((0, 0), (NSA_WINDOW, 0), (0, 0))
    k_win = jnp.pad(rms_norm(kv[:, :, 4], g_kw), wpad)
    v_win = jnp.pad(kv[:, :, 5], wpad)
    M = k_cmp.shape[1]
    cmp_start = jnp.arange(M) * NSA_CMP_STRIDE
    cmp_end = cmp_start + NSA_CMP_BLOCK - 1
    sel_start = jnp.arange(NS) * NSA_SEL_BLOCK
    overlap = ((cmp_start[:, None] < sel_start[None, :] + NSA_SEL_BLOCK)
               & (cmp_start[:, None] + NSA_CMP_BLOCK > sel_start[None, :])).astype(f32)
    bias_c = bias_tbl.astype(f32)
    bidx = jnp.arange(Bsz)[:, None, None]
    scale = d ** -0.5
    QB = NSA_Q_BLOCK

    def block(bi):
        t = bi * QB + jnp.arange(QB)
        qb = lax.dynamic_slice_in_dim(q, bi * QB, QB, axis=1)
        gb = lax.dynamic_slice_in_dim(gates, bi * QB, QB, axis=1).astype(f32)
        dist_c = t[:, None] - cmp_end[None, :]
        lg_c = jnp.einsum('bqhd,bmd->bhqm', qb, k_cmp, preferred_element_type=f32) * scale
        lg_c = lg_c + bias_c[rel_bucket(dist_c)].transpose(2, 0, 1)
        p_cmp = masked_softmax(lg_c, dist_c >= 0)
        o_cmp = jnp.einsum('bhqm,bmd->bqhd', p_cmp, v_cmp)
        imp = jnp.einsum('bhqm,mj->bqj', p_cmp, overlap)
        cur = t // NSA_SEL_BLOCK
        blk = jnp.arange(NS)[None, :]
        forced = (blk == 0) | (blk == cur[:, None]) | (blk == cur[:, None] - 1)
        future = sel_start[None, :] > t[:, None]
        score = jnp.where(forced, SEL_FORCE, jnp.where(future, -SEL_FORCE, imp))
        _, idx = lax.top_k(score, n_top)
        ks = k_sel[bidx, idx]
        vs = v_sel[bidx, idx].astype(f32)
        s_pos = idx[..., None] * NSA_SEL_BLOCK + jnp.arange(NSA_SEL_BLOCK)
        dist_s = t[None, :, None, None] - s_pos
        lg_s = jnp.einsum('bqhd,bqnsd->bqhns', qb, ks, preferred_element_type=f32) * scale
        lg_s = lg_s + jnp.moveaxis(bias_c[rel_bucket(dist_s)], -1, 2)
        shp = lg_s.shape
        valid_s = (dist_s >= 0).reshape(Bsz, QB, 1, -1)
        p_s = masked_softmax(lg_s.reshape(shp[:3] + (-1,)), valid_s).reshape(shp)
        o_sel = jnp.einsum('bqhns,bqnsd->bqhd', p_s, vs)
        kw = lax.dynamic_slice_in_dim(k_win, bi * QB, QB + NSA_WINDOW, axis=1)
        vw = lax.dynamic_slice_in_dim(v_win, bi * QB, QB + NSA_WINDOW, axis=1).astype(f32)
        w_pos = bi * QB - NSA_WINDOW + jnp.arange(QB + NSA_WINDOW)
        dist_w = t[:, None] - w_pos[None, :]
        valid_w = (dist_w >= 0) & (dist_w < NSA_WINDOW) & (w_pos[None, :] >= 0)
        lg_w = jnp.einsum('bqhd,bsd->bhqs', qb, kw, preferred_element_type=f32) * scale
        lg_w = lg_w + bias_c[rel_bucket(dist_w)].transpose(2, 0, 1)
        p_w = masked_softmax(lg_w, valid_w)
        o_win = jnp.einsum('bhqs,bsd->bqhd', p_w, vw)
        o = gb[..., 0:1] * o_cmp + gb[..., 1:2] * o_sel + gb[..., 2:3] * o_win
        return o.reshape(Bsz, QB, HC * d).astype(q.dtype)

    out = lax.map(block, jnp.arange(L // QB))
    return out.transpose(1, 0, 2, 3).reshape(Bsz, L, HC * d)


def setup_inputs(seed: int = 0) -> dict:
    key = jax.random.key(seed)
    ks = jax.random.split(key, 32)
    f32 = jnp.float32

    def nrm(k, shape, scale):
        return jax.random.normal(k, shape, f32) * scale

    G, N, P = SSM_GROUPS, SSM_STATE, SSM_GROUP_CH
    return {
        'x': nrm(ks[0], (BATCH, SEQ, D_MODEL), 1.0),
        'norm1_g': 1.0 + nrm(ks[1], (DEPTH, D_MODEL), 0.02),
        'w_in': nrm(ks[2], (DEPTH, D_MODEL, IN_WIDTH), D_MODEL ** -0.5),
        'qk_g': 1.0 + nrm(ks[3], (DEPTH, 6, HEAD_DIM), 0.02),
        'sinks': nrm(ks[4], (DEPTH, SWA_HEADS), 0.5),
        'rel_bias': nrm(ks[5], (NUM_BUCKETS, N_BIAS_HEADS), 0.2),
        'ssm_a_re': -0.5 * jnp.exp(nrm(ks[6], (DEPTH, G, N), 0.05)),
        'ssm_a_im': math.pi * jnp.arange(N, dtype=f32)[None, None, :] + nrm(ks[7], (DEPTH, G, N), 0.01),
        'ssm_log_dt': jax.random.uniform(ks[8], (DEPTH, G), f32, math.log(DT_MIN), math.log(DT_MAX)),
        'ssm_b_re': nrm(ks[9], (DEPTH, G, N, P), (2 * P) ** -0.5),
        'ssm_b_im': nrm(ks[10], (DEPTH, G, N, P), (2 * P) ** -0.5),
        'ssm_c_re': nrm(ks[11], (DEPTH, G, P, N), N ** -0.5),
        'ssm_c_im': nrm(ks[12], (DEPTH, G, P, N), N ** -0.5),
        'ssm_d': nrm(ks[13], (DEPTH, SSM_WIDTH), 0.5),
        'glu_w': nrm(ks[14], (DEPTH, SSM_WIDTH, 2 * SSM_WIDTH), SSM_WIDTH ** -0.5),
        'glu_b': nrm(ks[15], (DEPTH, 2 * SSM_WIDTH), 0.02),
        'cmp_pos': nrm(ks[16], (DEPTH, 2, NSA_CMP_BLOCK, HEAD_DIM), 0.1),
        'cmp_w1': nrm(ks[17], (DEPTH, 2, NSA_CMP_BLOCK * HEAD_DIM, NSA_CMP_HIDDEN), (NSA_CMP_BLOCK * HEAD_DIM) ** -0.5),
        'cmp_w2': nrm(ks[18], (DEPTH, 2, NSA_CMP_HIDDEN, HEAD_DIM), NSA_CMP_HIDDEN ** -0.5),
        'out_norm_g': 1.0 + nrm(ks[19], (DEPTH, MIX_WIDTH), 0.02),
        'w_out': nrm(ks[20], (DEPTH, MIX_WIDTH, D_MODEL), 0.5 * MIX_WIDTH ** -0.5),
        'norm2_g': 1.0 + nrm(ks[21], (DEPTH, D_MODEL), 0.02),
        'w_up': nrm(ks[22], (DEPTH, D_MODEL, D_FF), D_MODEL ** -0.5),
        'w_down': nrm(ks[23], (DEPTH, D_FF, D_MODEL), 0.5 * D_FF ** -0.5),
    }


def reference(x, norm1_g, w_in, qk_g, sinks, rel_bias, ssm_a_re, ssm_a_im, ssm_log_dt,
              ssm_b_re, ssm_b_im, ssm_c_re, ssm_c_im, ssm_d, glu_w, glu_b,
              cmp_pos, cmp_w1, cmp_w2, out_norm_g, w_out, norm2_g, w_up, w_down):
    Bsz, L, _ = x.shape
    for l in range(DEPTH):
        h = rms_norm(x, norm1_g[l])
        proj = jnp.einsum('bld,de->ble', h, w_in[l])
        qa = rms_norm(proj[..., OFF_QA:OFF_KA].reshape(Bsz, L, SWA_HEADS, HEAD_DIM), qk_g[l, 0])
        ka = rms_norm(proj[..., OFF_KA:OFF_VA].reshape(Bsz, L, SWA_KV_HEADS, HEAD_DIM), qk_g[l, 1])
        va = proj[..., OFF_VA:OFF_U].reshape(Bsz, L, SWA_KV_HEADS, HEAD_DIM)
        o_a = swa_sink_mixer(qa, ka, va, sinks[l], rel_bias[:, :SWA_HEADS])
        o_b = s5_mixer(proj[..., OFF_U:OFF_QC], ssm_a_re[l], ssm_a_im[l], ssm_log_dt[l],
                       ssm_b_re[l], ssm_b_im[l], ssm_c_re[l], ssm_c_im[l], ssm_d[l], glu_w[l], glu_b[l])
        qc = rms_norm(proj[..., OFF_QC:OFF_KVC].reshape(Bsz, L, NSA_HEADS, HEAD_DIM), qk_g[l, 2])
        kvc = proj[..., OFF_KVC:OFF_GC].reshape(Bsz, L, NSA_KV_STREAMS, HEAD_DIM)
        gc = jax.nn.sigmoid(proj[..., OFF_GC:IN_WIDTH].reshape(Bsz, L, NSA_HEADS, NSA_BRANCHES))
        o_c = nsa_mixer(qc, kvc, gc, cmp_pos[l], cmp_w1[l], cmp_w2[l],
                        qk_g[l, 3], qk_g[l, 4], qk_g[l, 5], rel_bias[:, SWA_HEADS:])
        g_out = out_norm_g[l]
        mixed = jnp.concatenate([
            rms_norm(o_a, g_out[:SWA_WIDTH]),
            rms_norm(o_b, g_out[SWA_WIDTH:SWA_WIDTH + SSM_WIDTH]),
            rms_norm(o_c, g_out[SWA_WIDTH + SSM_WIDTH:]),
        ], axis=-1)
        x = x + jnp.einsum('ble,ed->bld', mixed, w_out[l])
        h2 = rms_norm(x, norm2_g[l])
        hid = jax.nn.relu(jnp.einsum('bld,df->blf', h2, w_up[l]))
        x = x + jnp.einsum('blf,fd->bld', hid * hid, w_down[l])
    return x
```

```cpp
#include <hip/hip_runtime.h>
#include <hip/hip_cooperative_groups.h>
#include <cstdio>
namespace cg = cooperative_groups;

typedef _Float16 h16;
typedef __attribute__((ext_vector_type(8))) _Float16 h16x8;
typedef __attribute__((ext_vector_type(4))) float f32x4;

constexpr int NT = 256;
constexpr int NW = NT / 64;
constexpr int BATCH = 4, SEQ = 8192, NTOK = BATCH * SEQ, DM = 1024, DEPTH = 4, IW = 1676, IWP = 1792, DFF = 4096;
constexpr int OFF_U = 512, OFF_QC = 1024, OFF_KVC = 1280, OFF_GC = 1664;
constexpr int NCMP = 511;
constexpr float EPS = 1e-6f;

constexpr size_t SZ_WIN = (size_t)IWP * DM * 2, SZ_WGLU = (size_t)1024 * 512 * 2, SZ_WOUT = (size_t)DM * DM * 2,
                 SZ_WUP = (size_t)DFF * DM * 2, SZ_WDN = (size_t)DM * DFF * 2;
constexpr size_t O_WIN = 0;
constexpr size_t O_WGLU = O_WIN + DEPTH * SZ_WIN;
constexpr size_t O_WOUT = O_WGLU + DEPTH * SZ_WGLU;
constexpr size_t O_WUP = O_WOUT + DEPTH * SZ_WOUT;
constexpr size_t O_WDN = O_WUP + DEPTH * SZ_WUP;
constexpr size_t O_XB = O_WDN + DEPTH * SZ_WDN;
constexpr size_t O_SSQ = O_XB + (size_t)NTOK * DM * 2;
constexpr size_t O_SSQB = O_SSQ + (size_t)NTOK * 16 * 4;
constexpr size_t O_KCMP = O_SSQB + (size_t)NTOK * 16 * 4;
constexpr size_t O_VCMP = O_KCMP + (size_t)BATCH * 512 * 64 * 4;
constexpr size_t O_ABAR = O_VCMP + (size_t)BATCH * 512 * 64 * 4;
constexpr size_t O_BBAR = O_ABAR + (size_t)DEPTH * 32 * 64 * 8;
constexpr size_t O_BIAS1 = O_BBAR + (size_t)DEPTH * 32 * 64 * 16 * 8;
constexpr size_t O_LUT = O_BIAS1 + (size_t)DEPTH * 2 * 128 * 4;
constexpr size_t O_BIG = (O_LUT + 8192 * 4 + 255) / 256 * 256;
constexpr size_t O_P = O_BIG;
constexpr size_t O_Z = O_P + (size_t)NTOK * IWP * 2;
constexpr size_t O_OB = O_Z + (size_t)NTOK * 512 * 2;
constexpr size_t O_OAC = O_OB + (size_t)NTOK * 512 * 2;
constexpr size_t O_HID = O_BIG;
constexpr size_t WS_NEED = O_BIG + (size_t)NTOK * DFF * 2;

struct Params {
  const float* in[24];
  float* out;
  char* ws;
};

__device__ __forceinline__ float wave_sum(float v) {
  for (int o = 32; o; o >>= 1) v += __shfl_xor(v, o);
  return v;
}
__device__ __forceinline__ float wave_max(float v) {
  for (int o = 32; o; o >>= 1) v = fmaxf(v, __shfl_xor(v, o));
  return v;
}
__device__ __forceinline__ float gelu_tanh(float x) {
  float u = 0.7978845608028654f * (x + 0.044715f * x * x * x);
  return 0.5f * x * (1.f + tanhf(u));
}
__device__ __forceinline__ float sigmoidf(float x) { return 1.f / (1.f + __expf(-x)); }
__device__ __forceinline__ float rdlane(float v, int l) {
  return __int_as_float(__builtin_amdgcn_readlane(__float_as_int(v), l));
}

__device__ __forceinline__ void gemm_kloop(const h16* __restrict__ A, int lda, const h16* __restrict__ Bt, int ldb, int K,
                                           int brow, int bcol, h16* SA, h16* SB, f32x4 (&acc)[4][4]) {
  const int tid = threadIdx.x, lane = tid & 63, wid = tid >> 6, wr = wid >> 1, wc = wid & 1, fr = lane & 15, fq = lane >> 4;
  for (int kt = 0; kt < K / 32; ++kt) {
    for (int i = 0; i < 2; ++i) {
      int b = tid * 16 + i * 4096, r = b / 64, c = (b % 64) / 2;
      __builtin_amdgcn_global_load_lds((const unsigned*)(A + (long)(brow + r) * lda + kt * 32 + c),
                                       (unsigned*)((char*)SA + b), 16, 0, 0);
      __builtin_amdgcn_global_load_lds((const unsigned*)(Bt + (long)(bcol + r) * ldb + kt * 32 + c),
                                       (unsigned*)((char*)SB + b), 16, 0, 0);
    }
    asm volatile("s_waitcnt vmcnt(0)" ::: "memory");
    __syncthreads();
    h16x8 At[4], Bl[4];
#pragma unroll
    for (int m = 0; m < 4; ++m) At[m] = *(const h16x8*)((const char*)SA + (wr * 64 + m * 16 + fr) * 64 + fq * 16);
#pragma unroll
    for (int n = 0; n < 4; ++n) Bl[n] = *(const h16x8*)((const char*)SB + (wc * 64 + n * 16 + fr) * 64 + fq * 16);
#pragma unroll
    for (int m = 0; m < 4; ++m)
#pragma unroll
      for (int n = 0; n < 4; ++n) acc[m][n] = __builtin_amdgcn_mfma_f32_16x16x32_f16(At[m], Bl[n], acc[m][n], 0, 0, 0);
    __syncthreads();
  }
}

__device__ __forceinline__ void zero_acc(f32x4 (&acc)[4][4]) {
#pragma unroll
  for (int m = 0; m < 4; ++m)
#pragma unroll
    for (int n = 0; n < 4; ++n) acc[m][n] = f32x4{0.f, 0.f, 0.f, 0.f};
}

__device__ __forceinline__ void load_rowscale(const float* ssq, int brow, float inv_n, float* rsl) {
  int tid = threadIdx.x;
  if (tid < 128) {
    const float4* s4 = (const float4*)(ssq + (long)(brow + tid) * 16);
    float s = 0.f;
    for (int i = 0; i < 4; ++i) { float4 v = s4[i]; s += v.x + v.y + v.z + v.w; }
    rsl[tid] = rsqrtf(s * inv_n + EPS);
  }
  __syncthreads();
}

template <class SrcF>
__device__ __forceinline__ void conv_tile(SrcF src, h16* dst, int ldo, int n0, int k0, float* tile) {
  int tid = threadIdx.x;
  for (int idx = tid; idx < 4096; idx += NT) {
    int kk = idx >> 6, nn = idx & 63;
    tile[kk * 65 + nn] = src(k0 + kk, n0 + nn);
  }
  __syncthreads();
  for (int idx = tid; idx < 4096; idx += NT) {
    int nn = idx >> 6, kk = idx & 63;
    dst[(long)(n0 + nn) * ldo + k0 + kk] = (h16)tile[kk * 65 + nn];
  }
  __syncthreads();
}

__device__ void phase0(const Params& p, float* lds) {
  const int tid = threadIdx.x;
  constexpr int T_IN = (IWP / 64) * (DM / 64);
  constexpr int T_GLU = 16 * 8;
  constexpr int T_OUT = 16 * 16;
  constexpr int T_UP = 64 * 16;
  constexpr int T_DN = 16 * 64;
  constexpr int T_L = T_IN + T_GLU + T_OUT + T_UP + T_DN;
  for (int ti = blockIdx.x; ti < DEPTH * T_L; ti += gridDim.x) {
    int l = ti / T_L, r = ti % T_L;
    if (r < T_IN) {
      int nt = r / 16, kt = r % 16;
      const float* w = p.in[2] + (size_t)l * DM * IW;
      const float* g = p.in[1] + l * DM;
      conv_tile([&](int k, int n) { return n < IW ? w[(long)k * IW + n] * g[k] : 0.f; },
                (h16*)(p.ws + O_WIN + l * SZ_WIN), DM, nt * 64, kt * 64, lds);
    } else if ((r -= T_IN) < T_GLU) {
      int nt = r / 8, kt = r % 8;
      const float* w = p.in[14] + (size_t)l * 512 * 1024;
      conv_tile([&](int k, int n2) {
        int q = n2 >> 5, rr = n2 & 31;
        int n = rr < 16 ? 16 * q + rr : 512 + 16 * q + (rr - 16);
        return w[(long)k * 1024 + n]; },
                (h16*)(p.ws + O_WGLU + l * SZ_WGLU), 512, nt * 64, kt * 64, lds);
    } else if ((r -= T_GLU) < T_OUT) {
      int nt = r / 16, kt = r % 16;
      const float* w = p.in[20] + (size_t)l * DM * DM;
      const float* g = p.in[19] + l * DM;
      conv_tile([&](int k2, int n) {
        int k = k2 < 512 ? 256 + k2 : (k2 < 768 ? k2 - 512 : k2);
        return w[(long)k * DM + n] * g[k]; },
                (h16*)(p.ws + O_WOUT + l * SZ_WOUT), DM, nt * 64, kt * 64, lds);
    } else if ((r -= T_OUT) < T_UP) {
      int nt = r / 16, kt = r % 16;
      const float* w = p.in[22] + (size_t)l * DM * DFF;
      const float* g = p.in[21] + l * DM;
      conv_tile([&](int k, int n) { return w[(long)k * DFF + n] * g[k]; },
                (h16*)(p.ws + O_WUP + l * SZ_WUP), DM, nt * 64, kt * 64, lds);
    } else {
      r -= T_UP;
      int nt = r / 64, kt = r % 64;
      const float* w = p.in[23] + (size_t)l * DFF * DM;
      conv_tile([&](int k, int n) { return w[(long)k * DM + n]; },
                (h16*)(p.ws + O_WDN + l * SZ_WDN), DFF, nt * 64, kt * 64, lds);
    }
  }
  {
    const int lane = tid & 63;
    const int gw = blockIdx.x * NW + (tid >> 6), nw = gridDim.x * NW;
    const float* x = p.in[0];
    h16* xb = (h16*)(p.ws + O_XB);
    float* ssq = (float*)(p.ws + O_SSQ);
    for (int row = gw; row < NTOK; row += nw) {
      const float4* xr = (const float4*)(x + (long)row * DM + lane * 16);
      float s = 0.f;
      h16 hv[16];
      for (int i = 0; i < 4; ++i) {
        float4 v = xr[i];
        s += v.x * v.x + v.y * v.y + v.z * v.z + v.w * v.w;
        hv[i * 4 + 0] = (h16)v.x; hv[i * 4 + 1] = (h16)v.y; hv[i * 4 + 2] = (h16)v.z; hv[i * 4 + 3] = (h16)v.w;
      }
      h16x8* xo = (h16x8*)(xb + (long)row * DM + lane * 16);
      h16x8 o0, o1;
      for (int i = 0; i < 8; ++i) { o0[i] = hv[i]; o1[i] = hv[8 + i]; }
      xo[0] = o0; xo[1] = o1;
      s += __shfl_xor(s, 1);
      s += __shfl_xor(s, 2);
      if ((lane & 3) == 0) ssq[(long)row * 16 + (lane >> 2)] = s;
    }
  }
  const int gt = blockIdx.x * NT + tid, ngt = gridDim.x * NT;
  for (int i = gt; i < DEPTH * 32 * 64; i += ngt) {
    int l = i / 2048, g = (i / 64) % 32;
    double are = p.in[6][i], aim = p.in[7][i];
    double dt = exp((double)p.in[8][l * 32 + g]);
    double er = exp(are * dt), abr = er * cos(aim * dt), abi = er * sin(aim * dt);
    ((float2*)(p.ws + O_ABAR))[i] = make_float2((float)abr, (float)abi);
    double nr = abr - 1.0, ni = abi, den = are * are + aim * aim;
    double fr = (nr * are + ni * aim) / den, fi = (ni * are - nr * aim) / den;
    float2* bb = (float2*)(p.ws + O_BBAR) + (size_t)i * 16;
    for (int q = 0; q < 16; ++q) {
      double br = p.in[9][(size_t)i * 16 + q], bi = p.in[10][(size_t)i * 16 + q];
      bb[q] = make_float2((float)(fr * br - fi * bi), (float)(fr * bi + fi * br));
    }
  }
  for (int i = gt; i < DEPTH * 2 * 128; i += ngt) {
    int ls = i / 128, j = i % 128;
    const float* pos = p.in[16] + (size_t)ls * 2048;
    const float* w1 = p.in[17] + (size_t)ls * 2048 * 128;
    float a = 0.f;
    for (int k = 0; k < 2048; ++k) a += pos[k] * w1[(long)k * 128 + j];
    ((float*)(p.ws + O_BIAS1))[i] = a;
  }
  for (int d = gt; d < 8192; d += ngt) {
    int bk;
    if (d < 16) bk = d;
    else {
      float nf = (float)d;
      int large = 16 + (int)(logf(nf / 16.0f) / 4.1588830833596715f * 16.0f);
      bk = large < 31 ? large : 31;
    }
    ((int*)(p.ws + O_LUT))[d] = bk;
  }
}

__device__ void phase_gemm1(const Params& p, int l, char* lds) {
  h16* SA = (h16*)lds; h16* SB = (h16*)(lds + 8192); float* rsl = (float*)(lds + 16384);
  const h16* A = (const h16*)(p.ws + O_XB);
  const h16* Bt = (const h16*)(p.ws + O_WIN + l * SZ_WIN);
  h16* P = (h16*)(p.ws + O_P);
  const float* ssq = (const float*)(p.ws + O_SSQ);
  const float* qkg = p.in[3] + l * 6 * 64;
  const int tid = threadIdx.x, lane = tid & 63, wid = tid >> 6, wr = wid >> 1, wc = wid & 1, fr = lane & 15, fq = lane >> 4;
  constexpr int NN = IWP / 128;
  for (int t = blockIdx.x; t < (NTOK / 128) * NN; t += gridDim.x) {
    int brow = (t / NN) * 128, bcol = (t % NN) * 128;
    f32x4 acc[4][4];
    zero_acc(acc);
    gemm_kloop(A, DM, Bt, DM, DM, brow, bcol, SA, SB, acc);
    load_rowscale(ssq, brow, 1.f / DM, rsl);
    int hs = (bcol + wc * 64) >> 6;
    int gi = -1;
    if (hs < 4) gi = 0; else if (hs < 6) gi = 1; else if (hs >= 16 && hs < 20) gi = 2; else if (hs == 22) gi = 4; else if (hs == 24) gi = 5;
    bool gate = (hs == 26);
    float gv[4] = {1.f, 1.f, 1.f, 1.f};
    if (gi >= 0) for (int n = 0; n < 4; ++n) gv[n] = qkg[gi * 64 + n * 16 + fr];
#pragma unroll
    for (int m = 0; m < 4; ++m)
#pragma unroll
      for (int j = 0; j < 4; ++j) {
        int rl = wr * 64 + m * 16 + fq * 4 + j;
        float r = rsl[rl];
        float v[4];
        for (int n = 0; n < 4; ++n) v[n] = acc[m][n][j] * r;
        if (gi >= 0) {
          float ss = v[0] * v[0] + v[1] * v[1] + v[2] * v[2] + v[3] * v[3];
          ss += __shfl_xor(ss, 1); ss += __shfl_xor(ss, 2); ss += __shfl_xor(ss, 4); ss += __shfl_xor(ss, 8);
          float sc = rsqrtf(ss * (1.f / 64.f) + EPS);
          for (int n = 0; n < 4; ++n) v[n] *= sc * gv[n];
        } else if (gate) {
          for (int n = 0; n < 4; ++n) v[n] = (n * 16 + fr) < 12 ? sigmoidf(v[n]) : 0.f;
        }
        for (int n = 0; n < 4; ++n) P[(long)(brow + rl) * IWP + bcol + wc * 64 + n * 16 + fr] = (h16)v[n];
      }
    __syncthreads();
  }
}

__device__ void phase_glu(const Params& p, int l, char* lds) {
  h16* SA = (h16*)lds; h16* SB = (h16*)(lds + 8192);
  const h16* A = (const h16*)(p.ws + O_Z);
  const h16* Bt = (const h16*)(p.ws + O_WGLU + l * SZ_WGLU);
  h16* OB = (h16*)(p.ws + O_OB);
  float* ssqb = (float*)(p.ws + O_SSQB);
  const float* gb = p.in[15] + l * 1024;
  const int tid = threadIdx.x, lane = tid & 63, wid = tid >> 6, wr = wid >> 1, wc = wid & 1, fr = lane & 15, fq = lane >> 4;
  constexpr int NN = 8;
  for (int t = blockIdx.x; t < (NTOK / 128) * NN; t += gridDim.x) {
    int brow = (t / NN) * 128, bcol = (t % NN) * 128;
    f32x4 acc[4][4];
    zero_acc(acc);
    gemm_kloop(A, 512, Bt, 512, 512, brow, bcol, SA, SB, acc);
    int ocb = (bcol + wc * 64) / 2;
    float ba[2], bb[2];
    for (int np = 0; np < 2; ++np) { ba[np] = gb[ocb + np * 16 + fr]; bb[np] = gb[512 + ocb + np * 16 + fr]; }
#pragma unroll
    for (int m = 0; m < 4; ++m)
#pragma unroll
      for (int j = 0; j < 4; ++j) {
        int row = brow + wr * 64 + m * 16 + fq * 4 + j;
        float ss = 0.f;
        for (int np = 0; np < 2; ++np) {
          float a = acc[m][2 * np][j] + ba[np], b = acc[m][2 * np + 1][j] + bb[np];
          float o = a * sigmoidf(b);
          OB[(long)row * 512 + ocb + np * 16 + fr] = (h16)o;
          ss += o * o;
        }
        ss += __shfl_xor(ss, 1); ss += __shfl_xor(ss, 2); ss += __shfl_xor(ss, 4); ss += __shfl_xor(ss, 8);
        if (fr == 0) ssqb[(long)row * 16 + ((bcol + wc * 64) >> 6)] = ss;
      }
  }
}

__device__ void phase_wout(const Params& p, int l, char* lds) {
  h16* SA = (h16*)lds; h16* SB = (h16*)(lds + 8192); float* rsl = (float*)(lds + 16384);
  const h16* A1 = (const h16*)(p.ws + O_OB);
  const h16* A2 = (const h16*)(p.ws + O_OAC);
  const h16* Bt = (const h16*)(p.ws + O_WOUT + l * SZ_WOUT);
  const float* ssqb = (const float*)(p.ws + O_SSQB);
  const float* xsrc = (l == 0) ? p.in[0] : p.out;
  float* xo = p.out;
  h16* xb = (h16*)(p.ws + O_XB);
  float* ssq = (float*)(p.ws + O_SSQ);
  const int tid = threadIdx.x, lane = tid & 63, wid = tid >> 6, wr = wid >> 1, wc = wid & 1, fr = lane & 15, fq = lane >> 4;
  constexpr int NN = 8;
  for (int t = blockIdx.x; t < (NTOK / 128) * NN; t += gridDim.x) {
    int brow = (t / NN) * 128, bcol = (t % NN) * 128;
    f32x4 acc[4][4];
    zero_acc(acc);
    load_rowscale(ssqb, brow, 1.f / 512.f, rsl);
    gemm_kloop(A1, 512, Bt, DM, 512, brow, bcol, SA, SB, acc);
#pragma unroll
    for (int m = 0; m < 4; ++m)
#pragma unroll
      for (int j = 0; j < 4; ++j) {
        float r = rsl[wr * 64 + m * 16 + fq * 4 + j];
        for (int n = 0; n < 4; ++n) acc[m][n][j] *= r;
      }
    gemm_kloop(A2, 512, Bt + 512, DM, 512, brow, bcol, SA, SB, acc);
#pragma unroll
    for (int m = 0; m < 4; ++m)
#pragma unroll
      for (int j = 0; j < 4; ++j) {
        int row = brow + wr * 64 + m * 16 + fq * 4 + j;
        float ss = 0.f;
        for (int n = 0; n < 4; ++n) {
          long idx = (long)row * DM + bcol + wc * 64 + n * 16 + fr;
          float xn = xsrc[idx] + acc[m][n][j];
          xo[idx] = xn;
          xb[idx] = (h16)xn;
          ss += xn * xn;
        }
        ss += __shfl_xor(ss, 1); ss += __shfl_xor(ss, 2); ss += __shfl_xor(ss, 4); ss += __shfl_xor(ss, 8);
        if (fr == 0) ssq[(long)row * 16 + ((bcol + wc * 64) >> 6)] = ss;
      }
    __syncthreads();
  }
}

__device__ void phase_up(const Params& p, int l, char* lds) {
  h16* SA = (h16*)lds; h16* SB = (h16*)(lds + 8192); float* rsl = (float*)(lds + 16384);
  const h16* A = (const h16*)(p.ws + O_XB);
  const h16* Bt = (const h16*)(p.ws + O_WUP + l * SZ_WUP);
  h16* hid = (h16*)(p.ws + O_HID);
  const float* ssq = (const float*)(p.ws + O_SSQ);
  const int tid = threadIdx.x, lane = tid & 63, wid = tid >> 6, wr = wid >> 1, wc = wid & 1, fr = lane & 15, fq = lane >> 4;
  constexpr int NN = DFF / 128;
  for (int t = blockIdx.x; t < (NTOK / 128) * NN; t += gridDim.x) {
    int brow = (t / NN) * 128, bcol = (t % NN) * 128;
    f32x4 acc[4][4];
    zero_acc(acc);
    gemm_kloop(A, DM, Bt, DM, DM, brow, bcol, SA, SB, acc);
    load_rowscale(ssq, brow, 1.f / DM, rsl);
#pragma unroll
    for (int m = 0; m < 4; ++m)
#pragma unroll
      for (int j = 0; j < 4; ++j) {
        int rl = wr * 64 + m * 16 + fq * 4 + j;
        float r = rsl[rl];
        for (int n = 0; n < 4; ++n) {
          float v = fmaxf(acc[m][n][j] * r, 0.f);
          hid[(long)(brow + rl) * DFF + bcol + wc * 64 + n * 16 + fr] = (h16)(v * v);
        }
      }
    __syncthreads();
  }
}

__device__ void phase_down(const Params& p, int l, char* lds) {
  h16* SA = (h16*)lds; h16* SB = (h16*)(lds + 8192);
  const h16* A = (const h16*)(p.ws + O_HID);
  const h16* Bt = (const h16*)(p.ws + O_WDN + l * SZ_WDN);
  float* xo = p.out;
  h16* xb = (h16*)(p.ws + O_XB);
  float* ssq = (float*)(p.ws + O_SSQ);
  const int tid = threadIdx.x, lane = tid & 63, wid = tid >> 6, wr = wid >> 1, wc = wid & 1, fr = lane & 15, fq = lane >> 4;
  constexpr int NN = 8;
  for (int t = blockIdx.x; t < (NTOK / 128) * NN; t += gridDim.x) {
    int brow = (t / NN) * 128, bcol = (t % NN) * 128;
    f32x4 acc[4][4];
    zero_acc(acc);
    gemm_kloop(A, DFF, Bt, DFF, DFF, brow, bcol, SA, SB, acc);
#pragma unroll
    for (int m = 0; m < 4; ++m)
#pragma unroll
      for (int j = 0; j < 4; ++j) {
        int row = brow + wr * 64 + m * 16 + fq * 4 + j;
        float ss = 0.f;
        for (int n = 0; n < 4; ++n) {
          long idx = (long)row * DM + bcol + wc * 64 + n * 16 + fr;
          float xn = xo[idx] + acc[m][n][j];
          xo[idx] = xn;
          xb[idx] = (h16)xn;
          ss += xn * xn;
        }
        ss += __shfl_xor(ss, 1); ss += __shfl_xor(ss, 2); ss += __shfl_xor(ss, 4); ss += __shfl_xor(ss, 8);
        if (fr == 0) ssq[(long)row * 16 + ((bcol + wc * 64) >> 6)] = ss;
      }
  }
}

template <int NH>
struct AttnState {
  float m[NH], l[NH], o[NH];
  __device__ __forceinline__ void init() {
    for (int h = 0; h < NH; ++h) { m[h] = -1e30f; l[h] = 0.f; o[h] = 0.f; }
  }
};

template <int NH>
__device__ __forceinline__ void attend64(AttnState<NH>& st, const float* qs, const h16* Kb, const h16* Vb, int ld, long s,
                                         bool valid, int dist, const float* bias_tbl, int hoff, const int* lut) {
  const int lane = threadIdx.x & 63;
  float kf[64];
  {
    const h16x8* kp = (const h16x8*)(Kb + s * ld);
#pragma unroll
    for (int i = 0; i < 8; ++i) {
      h16x8 kv = kp[i];
#pragma unroll
      for (int e = 0; e < 8; ++e) kf[i * 8 + e] = (float)kv[e];
    }
  }
  int bk = lut[valid ? dist : 0];
  float pr[NH];
#pragma unroll
  for (int h = 0; h < NH; ++h) {
    float d = 0.f;
    const float4* q4 = (const float4*)(qs + h * 64);
#pragma unroll
    for (int i = 0; i < 16; ++i) {
      float4 q = q4[i];
      d += q.x * kf[i * 4] + q.y * kf[i * 4 + 1] + q.z * kf[i * 4 + 2] + q.w * kf[i * 4 + 3];
    }
    float lg = valid ? d + bias_tbl[bk * 8 + hoff + h] : -1e30f;
    float mx = wave_max(lg);
    float mn = fmaxf(st.m[h], mx);
    float pp = valid ? __expf(lg - mn) : 0.f;
    float corr = __expf(st.m[h] - mn);
    st.l[h] = st.l[h] * corr + wave_sum(pp);
    st.o[h] *= corr;
    st.m[h] = mn;
    pr[h] = pp;
  }
  for (int key = 0; key < 64; ++key) {
    long sk = ((long)__builtin_amdgcn_readlane((int)s, key));
    float v = (float)Vb[sk * ld + lane];
#pragma unroll
    for (int h = 0; h < NH; ++h) st.o[h] += rdlane(pr[h], key) * v;
  }
}

__device__ void phase2(const Params& p, int l, char* lds) {
  const int tid = threadIdx.x, lane = tid & 63, w = tid >> 6;
  const int gw = blockIdx.x * NW + w, nw = gridDim.x * NW;
  const h16* P = (const h16*)(p.ws + O_P);
  const int* lut = (const int*)(p.ws + O_LUT);
  float* bias_tbl = (float*)lds;
  float* qs = (float*)(lds + 1024) + w * 256;
  float2* sbuf = (float2*)(lds + 1024 + NW * 1024) + w * 64;
  for (int i = tid; i < 256; i += NT) bias_tbl[i] = p.in[5][i];
  __syncthreads();

  if (gw < BATCH * 32) {
    int b = gw / 32, g = gw % 32;
    const float2 ab = ((const float2*)(p.ws + O_ABAR))[(l * 32 + g) * 64 + lane];
    const float2* bbp = (const float2*)(p.ws + O_BBAR) + (size_t)((l * 32 + g) * 64 + lane) * 16;
    float bre[16], bim[16];
    for (int q = 0; q < 16; ++q) { float2 v = bbp[q]; bre[q] = v.x; bim[q] = v.y; }
    const int pp = lane & 15, qt = lane >> 4;
    float cre[16], cim[16];
    for (int i = 0; i < 16; ++i) {
      cre[i] = p.in[11][((size_t)(l * 32 + g) * 16 + pp) * 64 + qt * 16 + i];
      cim[i] = p.in[12][((size_t)(l * 32 + g) * 16 + pp) * 64 + qt * 16 + i];
    }
    const float dsk = p.in[13][l * 512 + g * 16 + pp];
    h16* Z = (h16*)(p.ws + O_Z);
    float sr = 0.f, si = 0.f;
    const h16* up = P + (size_t)b * SEQ * IWP + OFF_U + g * 16;
#pragma unroll 4
    for (int t = 0; t < SEQ; ++t) {
      const h16x8* u8 = (const h16x8*)(up + (size_t)t * IWP);
      h16x8 u0 = u8[0], u1 = u8[1];
      float uf[16];
      for (int e = 0; e < 8; ++e) { uf[e] = (float)u0[e]; uf[8 + e] = (float)u1[e]; }
      float br = 0.f, bi = 0.f;
      for (int q = 0; q < 16; ++q) { br += bre[q] * uf[q]; bi += bim[q] * uf[q]; }
      float nr = ab.x * sr - ab.y * si + br;
      float ni = ab.x * si + ab.y * sr + bi;
      sr = nr; si = ni;
      sbuf[lane] = make_float2(sr, si);
      float a = 0.f;
      for (int i = 0; i < 16; ++i) { float2 sv = sbuf[qt * 16 + i]; a += cre[i] * sv.x - cim[i] * sv.y; }
      a += __shfl_xor(a, 16);
      a += __shfl_xor(a, 32);
      float upp = 0.f;
      for (int q = 0; q < 16; ++q) upp = (pp == q) ? uf[q] : upp;
      if (lane < 16) Z[((size_t)b * SEQ + t) * 512 + g * 16 + pp] = (h16)gelu_tanh(a + dsk * upp);
    }
  }

  {
    const float* KC = (const float*)(p.ws + O_KCMP);
    (void)KC;
    for (int item = gw; item < BATCH * 128 * 2; item += nw) {
      int s = item & 1, mg = (item >> 1) & 127, b = item >> 8;
      const float* w1 = p.in[17] + (size_t)(l * 2 + s) * 2048 * 128;
      const float* w2 = p.in[18] + (size_t)(l * 2 + s) * 128 * 64;
      const float* b1 = (const float*)(p.ws + O_BIAS1) + (l * 2 + s) * 128;
      float a0[4], a1[4];
      for (int mi = 0; mi < 4; ++mi) { a0[mi] = b1[lane]; a1[mi] = b1[64 + lane]; }
      for (int tt = 0; tt < 32; ++tt) {
        float xv[4];
        for (int mi = 0; mi < 4; ++mi) {
          int m = mg * 4 + mi;
          int tok = 16 * m + tt;
          if (tok > SEQ - 1) tok = SEQ - 1;
          xv[mi] = (float)P[((size_t)b * SEQ + tok) * IWP + OFF_KVC + s * 64 + lane];
        }
        const float* wr = w1 + (size_t)tt * 64 * 128;
        for (int d = 0; d < 64; ++d) {
          float wa = wr[d * 128 + lane], wb = wr[d * 128 + 64 + lane];
          for (int mi = 0; mi < 4; ++mi) {
            float x = rdlane(xv[mi], d);
            a0[mi] += x * wa; a1[mi] += x * wb;
          }
        }
      }
      for (int mi = 0; mi < 4; ++mi) { a0[mi] = gelu_tanh(a0[mi]); a1[mi] = gelu_tanh(a1[mi]); }
      float o[4] = {0.f, 0.f, 0.f, 0.f};
      for (int j = 0; j < 64; ++j) {
        float wa = w2[j * 64 + lane], wb = w2[(64 + j) * 64 + lane];
        for (int mi = 0; mi < 4; ++mi) o[mi] += rdlane(a0[mi], j) * wa + rdlane(a1[mi], j) * wb;
      }
      for (int mi = 0; mi < 4; ++mi) {
        int m = mg * 4 + mi;
        if (m >= NCMP) continue;
        if (s == 0) {
          float ss = wave_sum(o[mi] * o[mi]);
          float v = o[mi] * rsqrtf(ss * (1.f / 64.f) + EPS) * p.in[3][(l * 6 + 3) * 64 + lane];
          ((float*)(p.ws + O_KCMP))[((size_t)b * 512 + m) * 64 + lane] = v;
        } else {
          ((float*)(p.ws + O_VCMP))[((size_t)b * 512 + m) * 64 + lane] = o[mi];
        }
      }
    }
  }

  {
    h16* OAC = (h16*)(p.ws + O_OAC);
    for (int tok = gw; tok < NTOK; tok += nw) {
      int b = tok / SEQ, t = tok % SEQ;
      float oh[4];
      float ssum = 0.f;
      for (int h = 0; h < 4; ++h) {
        qs[lane] = (float)P[(size_t)tok * IWP + h * 64 + lane] * 0.125f;
        AttnState<1> st;
        st.init();
        const h16* Kb = P + (size_t)b * SEQ * IWP + 256 + (h >> 1) * 64;
        const h16* Vb = P + (size_t)b * SEQ * IWP + 384 + (h >> 1) * 64;
        for (int c = 0; c < 2; ++c) {
          int s = t - 127 + c * 64 + lane;
          bool valid = s >= 0;
          attend64<1>(st, qs, Kb, Vb, IWP, valid ? s : 0, valid, t - s, bias_tbl, h, lut);
        }
        float sink = p.in[4][l * 4 + h];
        float mn = fmaxf(st.m[0], sink);
        float corr = __expf(st.m[0] - mn);
        float den = st.l[0] * corr + __expf(sink - mn);
        oh[h] = st.o[0] * corr / den;
        ssum += oh[h] * oh[h];
      }
      ssum = wave_sum(ssum);
      float sc = rsqrtf(ssum * (1.f / 256.f) + EPS);
      for (int h = 0; h < 4; ++h) OAC[(size_t)tok * 512 + h * 64 + lane] = (h16)(oh[h] * sc);
    }
  }
}

__device__ void phase_nsa(const Params& p, int l, char* lds) {
  const int tid = threadIdx.x, lane = tid & 63, w = tid >> 6;
  const int gw = blockIdx.x * NW + w, nw = gridDim.x * NW;
  const h16* P = (const h16*)(p.ws + O_P);
  const int* lut = (const int*)(p.ws + O_LUT);
  float* bias_tbl = (float*)lds;
  float* qs = (float*)(lds + 1024) + w * 256;
  float* pl = (float*)(lds + 1024 + NW * 1024) + w * 2048;
  float* imp = (float*)(lds + 1024 + NW * 1024 + NW * 8192) + w * 128;
  __syncthreads();
  for (int i = tid; i < 256; i += NT) bias_tbl[i] = p.in[5][i];
  __syncthreads();
  const float* KC = (const float*)(p.ws + O_KCMP);
  const float* VC = (const float*)(p.ws + O_VCMP);
  h16* OAC = (h16*)(p.ws + O_OAC);
  for (int it = gw; it < NTOK; it += nw) {
    int tok = it;
    int b = tok / SEQ, t = tok % SEQ;
    for (int h = 0; h < 4; ++h) qs[h * 64 + lane] = (float)P[(size_t)tok * IWP + OFF_QC + h * 64 + lane] * 0.125f;
    int Mv = t >= 31 ? (t - 31) / 16 + 1 : 0;
    if (Mv > NCMP) Mv = NCMP;
    float ocmp[4] = {0.f, 0.f, 0.f, 0.f};
    {
      float mx[4] = {-1e30f, -1e30f, -1e30f, -1e30f};
      int nch = (Mv + 63) / 64;
      for (int c = 0; c < nch; ++c) {
        int m = c * 64 + lane;
        bool valid = m < Mv;
        const float4* kp = (const float4*)(KC + ((size_t)b * 512 + (valid ? m : 0)) * 64);
        float kf[64];
        for (int i = 0; i < 16; ++i) { float4 v = kp[i]; kf[4 * i] = v.x; kf[4 * i + 1] = v.y; kf[4 * i + 2] = v.z; kf[4 * i + 3] = v.w; }
        int dist = t - (16 * m + 31);
        int bk = lut[valid ? dist : 0];
        for (int h = 0; h < 4; ++h) {
          float d = 0.f;
          const float4* q4 = (const float4*)(qs + h * 64);
          for (int i = 0; i < 16; ++i) { float4 q = q4[i]; d += q.x * kf[4 * i] + q.y * kf[4 * i + 1] + q.z * kf[4 * i + 2] + q.w * kf[4 * i + 3]; }
          float lg = valid ? d + bias_tbl[bk * 8 + 4 + h] : -1e30f;
          pl[h * 512 + m] = lg;
          mx[h] = fmaxf(mx[h], lg);
        }
      }
      float inv[4];
      for (int h = 0; h < 4; ++h) {
        mx[h] = wave_max(mx[h]);
        float s = 0.f;
        for (int c = 0; c < nch; ++c) {
          int m = c * 64 + lane;
          float e = (m < Mv) ? __expf(pl[h * 512 + m] - mx[h]) : 0.f;
          pl[h * 512 + m] = e;
          s += e;
        }
        s = wave_sum(s);
        inv[h] = s > 0.f ? 1.f / s : 0.f;
      }
      for (int h = 0; h < 4; ++h)
        for (int c = 0; c < nch; ++c) pl[h * 512 + c * 64 + lane] *= inv[h];
      for (int jj = 0; jj < 2; ++jj) {
        int j = jj * 64 + lane;
        float a = 0.f;
        for (int m = 4 * j - 1; m <= 4 * j + 3; ++m)
          if (m >= 0 && m < Mv) a += pl[m] + pl[512 + m] + pl[1024 + m] + pl[1536 + m];
        imp[j] = a;
      }
      for (int m = 0; m < Mv; ++m) {
        float v = VC[((size_t)b * 512 + m) * 64 + lane];
        for (int h = 0; h < 4; ++h) ocmp[h] += pl[h * 512 + m] * v;
      }
    }
    const int cur = t >> 6;
    unsigned long long mlo, mhi;
    {
      int nforced = cur >= 2 ? 3 : cur + 1;
      int npick = 16 - nforced;
      int j0 = lane, j1 = lane + 64;
      float v0 = imp[j0], v1 = imp[j1];
      int r0 = 0, r1 = 0;
      for (int jp = 1; jp <= cur - 2; ++jp) {
        float vp = imp[jp];
        r0 += (vp > v0 || (vp == v0 && jp < j0)) ? 1 : 0;
        r1 += (vp > v1 || (vp == v1 && jp < j1)) ? 1 : 0;
      }
      bool c0 = j0 >= 1 && j0 <= cur - 2, c1 = j1 <= cur - 2;
      bool f0 = j0 == 0 || j0 == cur || j0 == cur - 1, f1 = j1 == cur || j1 == cur - 1;
      bool s0 = f0 || (c0 && r0 < npick), s1 = f1 || (c1 && r1 < npick);
      mlo = __ballot(s0);
      mhi = __ballot(s1);
    }
    AttnState<4> ss;
    ss.init();
    {
      const h16* Kb = P + (size_t)b * SEQ * IWP + OFF_KVC + 2 * 64;
      const h16* Vb = P + (size_t)b * SEQ * IWP + OFF_KVC + 3 * 64;
      for (int half = 0; half < 2; ++half) {
        unsigned long long mk = half ? mhi : mlo;
        while (mk) {
          int j = __builtin_ctzll(mk) + half * 64;
          mk &= mk - 1;
          int s = j * 64 + lane;
          bool valid = s <= t;
          attend64<4>(ss, qs, Kb, Vb, IWP, valid ? s : 0, valid, t - s, bias_tbl, 4, lut);
        }
      }
    }
    AttnState<4> sw;
    sw.init();
    {
      const h16* Kb = P + (size_t)b * SEQ * IWP + OFF_KVC + 4 * 64;
      const h16* Vb = P + (size_t)b * SEQ * IWP + OFF_KVC + 5 * 64;
      for (int c = 0; c < 8; ++c) {
        int s = t - 511 + c * 64 + lane;
        bool valid = s >= 0;
        if (t - 511 + c * 64 + 63 < 0) continue;
        attend64<4>(sw, qs, Kb, Vb, IWP, valid ? s : 0, valid, t - s, bias_tbl, 4, lut);
      }
    }
    float oc[4];
    float ssum = 0.f;
    for (int h = 0; h < 4; ++h) {
      float g0 = (float)P[(size_t)tok * IWP + OFF_GC + h * 3 + 0];
      float g1 = (float)P[(size_t)tok * IWP + OFF_GC + h * 3 + 1];
      float g2 = (float)P[(size_t)tok * IWP + OFF_GC + h * 3 + 2];
      float os = ss.l[h] > 0.f ? ss.o[h] / ss.l[h] : 0.f;
      float ow = sw.l[h] > 0.f ? sw.o[h] / sw.l[h] : 0.f;
      oc[h] = g0 * ocmp[h] + g1 * os + g2 * ow;
      ssum += oc[h] * oc[h];
    }
    ssum = wave_sum(ssum);
    float sc = rsqrtf(ssum * (1.f / 256.f) + EPS);
    for (int h = 0; h < 4; ++h) OAC[(size_t)tok * 512 + 256 + h * 64 + lane] = (h16)(oc[h] * sc);
  }
}

constexpr int LDS_BYTES = 1024 + NW * 1024 + NW * 8192 + NW * 512 + 1024;

__global__ void __launch_bounds__(NT) fwd_megakernel(Params p) {
  cg::grid_group grid = cg::this_grid();
  __shared__ __attribute__((aligned(16))) char lds[LDS_BYTES];
  phase0(p, (float*)lds);
  grid.sync();
  for (int l = 0; l < DEPTH; ++l) {
    phase_gemm1(p, l, lds);
    grid.sync();
    phase2(p, l, lds);
    grid.sync();
    phase_glu(p, l, lds);
    phase_nsa(p, l, lds);
    grid.sync();
    phase_wout(p, l, lds);
    grid.sync();
    phase_up(p, l, lds);
    grid.sync();
    phase_down(p, l, lds);
    grid.sync();
  }
}

extern "C" void kernel_launch(void* const* d_in, const int* in_sizes, int n_in, void* d_out, int out_size, void* d_ws,
                              size_t ws_size, hipStream_t stream) {
  static int grid_blocks = 0;
  if (!grid_blocks) {
    int dev = 0, cus = 0, per_cu = 0;
    hipGetDevice(&dev);
    hipDeviceGetAttribute(&cus, hipDeviceAttributeMultiprocessorCount, dev);
    hipOccupancyMaxActiveBlocksPerMultiprocessor(&per_cu, fwd_megakernel, NT, 0);
    if (per_cu > 2) per_cu = 2;
    grid_blocks = cus * per_cu;
  }
  if (ws_size < WS_NEED) {
    fprintf(stderr, "workspace too small: %zu < %zu\n", ws_size, WS_NEED);
    return;
  }
  Params p{};
  for (int i = 0; i < 24; ++i) p.in[i] = (const float*)d_in[i];
  p.out = (float*)d_out;
  p.ws = (char*)d_ws;
  void* args[] = {&p};
  hipError_t e = hipLaunchCooperativeKernel((void*)fwd_megakernel, dim3(grid_blocks), dim3(NT), args, 0, stream);
  if (e != hipSuccess) fprintf(stderr, "cooperative launch failed: %s (grid %d)\n", hipGetErrorString(e), grid_blocks);
}
```

```cpp
#include <hip/hip_runtime.h>
#include <hip/hip_cooperative_groups.h>
#include <cstdio>
namespace cg = cooperative_groups;

typedef _Float16 h16;
typedef __attribute__((ext_vector_type(8))) _Float16 h16x8;
typedef __attribute__((ext_vector_type(4))) float f32x4;

constexpr int NT = 256;
constexpr int NW = NT / 64;
constexpr int BATCH = 4, SEQ = 8192, NTOK = BATCH * SEQ, DM = 1024, DEPTH = 4, IW = 1676, IWP = 1792, DFF = 4096;
constexpr int OFF_U = 512, OFF_QC = 1024, OFF_KVC = 1280, OFF_GC = 1664;
constexpr int NCMP = 511;
constexpr float EPS = 1e-6f;

constexpr size_t SZ_WIN = (size_t)IWP * DM * 2, SZ_WGLU = (size_t)1024 * 512 * 2, SZ_WOUT = (size_t)DM * DM * 2,
                 SZ_WUP = (size_t)DFF * DM * 2, SZ_WDN = (size_t)DM * DFF * 2;
constexpr size_t O_WIN = 0;
constexpr size_t O_WGLU = O_WIN + DEPTH * SZ_WIN;
constexpr size_t O_WOUT = O_WGLU + DEPTH * SZ_WGLU;
constexpr size_t O_WUP = O_WOUT + DEPTH * SZ_WOUT;
constexpr size_t O_WDN = O_WUP + DEPTH * SZ_WUP;
constexpr size_t O_XB = O_WDN + DEPTH * SZ_WDN;
constexpr size_t O_SSQ = O_XB + (size_t)NTOK * DM * 2;
constexpr size_t O_SSQB = O_SSQ + (size_t)NTOK * 16 * 4;
constexpr size_t O_KCMP = O_SSQB + (size_t)NTOK * 16 * 4;
constexpr size_t O_VCMP = O_KCMP + (size_t)BATCH * 512 * 64 * 4;
constexpr size_t O_ABAR = O_VCMP + (size_t)BATCH * 512 * 64 * 4;
constexpr size_t O_BBAR = O_ABAR + (size_t)DEPTH * 32 * 64 * 8;
constexpr size_t O_BIAS1 = O_BBAR + (size_t)DEPTH * 32 * 64 * 16 * 8;
constexpr size_t O_LUT = O_BIAS1 + (size_t)DEPTH * 2 * 128 * 4;
constexpr size_t O_AT = O_LUT + 8192 * 4;
constexpr size_t O_KTAB = O_AT + (size_t)128 * 64 * 8;
constexpr size_t SZ_KTAB = (size_t)65 * 256 * 2;
constexpr size_t O_W1 = O_KTAB + 128 * SZ_KTAB;
constexpr size_t SZ_W13 = (size_t)128 * 1024 * 2;
constexpr size_t O_W3 = O_W1 + 128 * SZ_W13;
constexpr size_t O_BIG = (O_W3 + 128 * SZ_W13 + 255) / 256 * 256;
constexpr size_t O_APOW = O_BIG;
constexpr size_t O_P = O_BIG;
constexpr size_t O_Z = O_P + (size_t)NTOK * IWP * 2;
constexpr size_t O_OB = O_Z + (size_t)NTOK * 512 * 2;
constexpr size_t O_OAC = O_OB + (size_t)NTOK * 512 * 2;
constexpr size_t O_E = O_OAC + (size_t)NTOK * 512 * 2;
constexpr size_t O_HID = O_BIG;
constexpr size_t WS_NEED = O_BIG + (size_t)NTOK * DFF * 2;

struct Params {
  const float* in[24];
  float* out;
  char* ws;
};

__device__ __forceinline__ float wave_sum(float v) {
  for (int o = 32; o; o >>= 1) v += __shfl_xor(v, o);
  return v;
}
__device__ __forceinline__ float wave_max(float v) {
  for (int o = 32; o; o >>= 1) v = fmaxf(v, __shfl_xor(v, o));
  return v;
}
__device__ __forceinline__ float gelu_tanh(float x) {
  float u = 0.7978845608028654f * (x + 0.044715f * x * x * x);
  return 0.5f * x * (1.f + tanhf(u));
}
__device__ __forceinline__ float sigmoidf(float x) { return 1.f / (1.f + __expf(-x)); }
__device__ __forceinline__ float rdlane(float v, int l) {
  return __int_as_float(__builtin_amdgcn_readlane(__float_as_int(v), l));
}

__device__ __forceinline__ void gemm_kloop(const h16* __restrict__ A, int lda, const h16* __restrict__ Bt, int ldb, int K,
                                           int brow, int bcol, h16* SA, h16* SB, f32x4 (&acc)[4][4]) {
  const int tid = threadIdx.x, lane = tid & 63, wid = tid >> 6, wr = wid >> 1, wc = wid & 1, fr = lane & 15, fq = lane >> 4;
  for (int kt = 0; kt < K / 32; ++kt) {
    for (int i = 0; i < 2; ++i) {
      int b = tid * 16 + i * 4096, r = b / 64, c = (b % 64) / 2;
      __builtin_amdgcn_global_load_lds((const unsigned*)(A + (long)(brow + r) * lda + kt * 32 + c),
                                       (unsigned*)((char*)SA + b), 16, 0, 0);
      __builtin_amdgcn_global_load_lds((const unsigned*)(Bt + (long)(bcol + r) * ldb + kt * 32 + c),
                                       (unsigned*)((char*)SB + b), 16, 0, 0);
    }
    asm volatile("s_waitcnt vmcnt(0)" ::: "memory");
    __syncthreads();
    h16x8 At[4], Bl[4];
#pragma unroll
    for (int m = 0; m < 4; ++m) At[m] = *(const h16x8*)((const char*)SA + (wr * 64 + m * 16 + fr) * 64 + fq * 16);
#pragma unroll
    for (int n = 0; n < 4; ++n) Bl[n] = *(const h16x8*)((const char*)SB + (wc * 64 + n * 16 + fr) * 64 + fq * 16);
#pragma unroll
    for (int m = 0; m < 4; ++m)
#pragma unroll
      for (int n = 0; n < 4; ++n) acc[m][n] = __builtin_amdgcn_mfma_f32_16x16x32_f16(At[m], Bl[n], acc[m][n], 0, 0, 0);
    __syncthreads();
  }
}

__device__ __forceinline__ void zero_acc(f32x4 (&acc)[4][4]) {
#pragma unroll
  for (int m = 0; m < 4; ++m)
#pragma unroll
    for (int n = 0; n < 4; ++n) acc[m][n] = f32x4{0.f, 0.f, 0.f, 0.f};
}

__device__ __forceinline__ void load_rowscale(const float* ssq, int brow, float inv_n, float* rsl) {
  int tid = threadIdx.x;
  if (tid < 128) {
    const float4* s4 = (const float4*)(ssq + (long)(brow + tid) * 16);
    float s = 0.f;
    for (int i = 0; i < 4; ++i) { float4 v = s4[i]; s += v.x + v.y + v.z + v.w; }
    rsl[tid] = rsqrtf(s * inv_n + EPS);
  }
  __syncthreads();
}

template <class SrcF>
__device__ __forceinline__ void conv_tile(SrcF src, h16* dst, int ldo, int n0, int k0, float* tile) {
  int tid = threadIdx.x;
  for (int idx = tid; idx < 4096; idx += NT) {
    int kk = idx >> 6, nn = idx & 63;
    tile[kk * 65 + nn] = src(k0 + kk, n0 + nn);
  }
  __syncthreads();
  for (int idx = tid; idx < 4096; idx += NT) {
    int nn = idx >> 6, kk = idx & 63;
    dst[(long)(n0 + nn) * ldo + k0 + kk] = (h16)tile[kk * 65 + nn];
  }
  __syncthreads();
}

__device__ void phase0(const Params& p, float* lds) {
  const int tid = threadIdx.x;
  constexpr int T_IN = (IWP / 64) * (DM / 64);
  constexpr int T_GLU = 16 * 8;
  constexpr int T_OUT = 16 * 16;
  constexpr int T_UP = 64 * 16;
  constexpr int T_DN = 16 * 64;
  constexpr int T_L = T_IN + T_GLU + T_OUT + T_UP + T_DN;
  for (int ti = blockIdx.x; ti < DEPTH * T_L; ti += gridDim.x) {
    int l = ti / T_L, r = ti % T_L;
    if (r < T_IN) {
      int nt = r / 16, kt = r % 16;
      const float* w = p.in[2] + (size_t)l * DM * IW;
      const float* g = p.in[1] + l * DM;
      conv_tile([&](int k, int n) { return n < IW ? w[(long)k * IW + n] * g[k] : 0.f; },
                (h16*)(p.ws + O_WIN + l * SZ_WIN), DM, nt * 64, kt * 64, lds);
    } else if ((r -= T_IN) < T_GLU) {
      int nt = r / 8, kt = r % 8;
      const float* w = p.in[14] + (size_t)l * 512 * 1024;
      conv_tile([&](int k, int n2) {
        int q = n2 >> 5, rr = n2 & 31;
        int n = rr < 16 ? 16 * q + rr : 512 + 16 * q + (rr - 16);
        return w[(long)k * 1024 + n]; },
                (h16*)(p.ws + O_WGLU + l * SZ_WGLU), 512, nt * 64, kt * 64, lds);
    } else if ((r -= T_GLU) < T_OUT) {
      int nt = r / 16, kt = r % 16;
      const float* w = p.in[20] + (size_t)l * DM * DM;
      const float* g = p.in[19] + l * DM;
      conv_tile([&](int k2, int n) {
        int k = k2 < 512 ? 256 + k2 : (k2 < 768 ? k2 - 512 : k2);
        return w[(long)k * DM + n] * g[k]; },
                (h16*)(p.ws + O_WOUT + l * SZ_WOUT), DM, nt * 64, kt * 64, lds);
    } else if ((r -= T_OUT) < T_UP) {
      int nt = r / 16, kt = r % 16;
      const float* w = p.in[22] + (size_t)l * DM * DFF;
      const float* g = p.in[21] + l * DM;
      conv_tile([&](int k, int n) { return w[(long)k * DFF + n] * g[k]; },
                (h16*)(p.ws + O_WUP + l * SZ_WUP), DM, nt * 64, kt * 64, lds);
    } else {
      r -= T_UP;
      int nt = r / 64, kt = r % 64;
      const float* w = p.in[23] + (size_t)l * DFF * DM;
      conv_tile([&](int k, int n) { return w[(long)k * DM + n]; },
                (h16*)(p.ws + O_WDN + l * SZ_WDN), DFF, nt * 64, kt * 64, lds);
    }
  }
  {
    const int lane = tid & 63;
    const int gw = blockIdx.x * NW + (tid >> 6), nw = gridDim.x * NW;
    const float* x = p.in[0];
    h16* xb = (h16*)(p.ws + O_XB);
    float* ssq = (float*)(p.ws + O_SSQ);
    for (int row = gw; row < NTOK; row += nw) {
      const float4* xr = (const float4*)(x + (long)row * DM + lane * 16);
      float s = 0.f;
      h16 hv[16];
      for (int i = 0; i < 4; ++i) {
        float4 v = xr[i];
        s += v.x * v.x + v.y * v.y + v.z * v.z + v.w * v.w;
        hv[i * 4 + 0] = (h16)v.x; hv[i * 4 + 1] = (h16)v.y; hv[i * 4 + 2] = (h16)v.z; hv[i * 4 + 3] = (h16)v.w;
      }
      h16x8* xo = (h16x8*)(xb + (long)row * DM + lane * 16);
      h16x8 o0, o1;
      for (int i = 0; i < 8; ++i) { o0[i] = hv[i]; o1[i] = hv[8 + i]; }
      xo[0] = o0; xo[1] = o1;
      s += __shfl_xor(s, 1);
      s += __shfl_xor(s, 2);
      if ((lane & 3) == 0) ssq[(long)row * 16 + (lane >> 2)] = s;
    }
  }
  const int gt = blockIdx.x * NT + tid, ngt = gridDim.x * NT;
  for (int i = gt; i < DEPTH * 32 * 64; i += ngt) {
    int l = i / 2048, g = (i / 64) % 32;
    double are = p.in[6][i], aim = p.in[7][i];
    double dt = exp((double)p.in[8][l * 32 + g]);
    double er = exp(are * dt), abr = er * cos(aim * dt), abi = er * sin(aim * dt);
    ((float2*)(p.ws + O_ABAR))[i] = make_float2((float)abr, (float)abi);
    double nr = abr - 1.0, ni = abi, den = are * are + aim * aim;
    double fr = (nr * are + ni * aim) / den, fi = (ni * are - nr * aim) / den;
    float2* bb = (float2*)(p.ws + O_BBAR) + (size_t)i * 16;
    for (int q = 0; q < 16; ++q) {
      double br = p.in[9][(size_t)i * 16 + q], bi = p.in[10][(size_t)i * 16 + q];
      bb[q] = make_float2((float)((fr * br - fi * bi) / dt), (float)((fr * bi + fi * br) / dt));
    }
  }
  for (int i = gt; i < 128 * 65 * 64; i += ngt) {
    int n = i & 63, j = (i >> 6) % 65, lg = i / (65 * 64);
    double are = p.in[6][lg * 64 + n], aim = p.in[7][lg * 64 + n];
    double dt = exp((double)p.in[8][lg]);
    double er = exp(are * dt * j), ang = aim * dt * j;
    ((double2*)(p.ws + O_APOW))[i] = make_double2(er * cos(ang), er * sin(ang));
  }
  for (int i = gt; i < DEPTH * 2 * 128; i += ngt) {
    int ls = i / 128, j = i % 128;
    const float* pos = p.in[16] + (size_t)ls * 2048;
    const float* w1 = p.in[17] + (size_t)ls * 2048 * 128;
    float a = 0.f;
    for (int k = 0; k < 2048; ++k) a += pos[k] * w1[(long)k * 128 + j];
    ((float*)(p.ws + O_BIAS1))[i] = a;
  }
  for (int d = gt; d < 8192; d += ngt) {
    int bk;
    if (d < 16) bk = d;
    else {
      float nf = (float)d;
      int large = 16 + (int)(logf(nf / 16.0f) / 4.1588830833596715f * 16.0f);
      bk = large < 31 ? large : 31;
    }
    ((int*)(p.ws + O_LUT))[d] = bk;
  }
}

__device__ void phase0b(const Params& p) {
  const int gt = blockIdx.x * NT + threadIdx.x, ngt = gridDim.x * NT;
  const double2* apow = (const double2*)(p.ws + O_APOW);
  const float2* bbs = (const float2*)(p.ws + O_BBAR);
  for (int i = gt; i < 128 * 64 * 64; i += ngt) {
    int tau = i & 63, n = (i >> 6) & 63, lg = i >> 12;
    double2 ap = apow[(lg * 65 + (63 - tau)) * 64 + n];
    const float2* bb = bbs + (size_t)(lg * 64 + n) * 16;
    h16x8 re0, re1, im0, im1;
#pragma unroll
    for (int q = 0; q < 8; ++q) {
      float2 b0 = bb[q], b1 = bb[8 + q];
      re0[q] = (h16)(float)(ap.x * b0.x - ap.y * b0.y);
      im0[q] = (h16)(float)(ap.x * b0.y + ap.y * b0.x);
      re1[q] = (h16)(float)(ap.x * b1.x - ap.y * b1.y);
      im1[q] = (h16)(float)(ap.x * b1.y + ap.y * b1.x);
    }
    h16* W1 = (h16*)(p.ws + O_W1 + (size_t)lg * SZ_W13);
    *(h16x8*)(W1 + ((size_t)(2 * tau) * 128 + 2 * n) * 8) = re0;
    *(h16x8*)(W1 + ((size_t)(2 * tau) * 128 + 2 * n + 1) * 8) = im0;
    *(h16x8*)(W1 + ((size_t)(2 * tau + 1) * 128 + 2 * n) * 8) = re1;
    *(h16x8*)(W1 + ((size_t)(2 * tau + 1) * 128 + 2 * n + 1) * 8) = im1;
  }
  for (int i = gt; i < 128 * 64 * 16 * 16; i += ngt) {
    int pp = i & 15, kc = (i >> 4) & 15, tau = (i >> 8) & 63, lg = i >> 14;
    h16x8 v;
#pragma unroll
    for (int e = 0; e < 4; ++e) {
      int n = 4 * kc + e;
      double2 ap = apow[(lg * 65 + tau + 1) * 64 + n];
      double cr = p.in[11][((size_t)lg * 16 + pp) * 64 + n], ci = p.in[12][((size_t)lg * 16 + pp) * 64 + n];
      v[2 * e] = (h16)(float)(cr * ap.x - ci * ap.y);
      v[2 * e + 1] = (h16)(float)(-(cr * ap.y + ci * ap.x));
    }
    h16* W3 = (h16*)(p.ws + O_W3 + (size_t)lg * SZ_W13);
    *(h16x8*)(W3 + ((size_t)((tau * 16 + kc) * 16) + pp) * 8) = v;
  }
  for (int i = gt; i < 128 * 65 * 16; i += ngt) {
    int pp = i & 15, slot = (i >> 4) % 65, lg = i / (65 * 16);
    float acc[16];
#pragma unroll
    for (int q = 0; q < 16; ++q) acc[q] = 0.f;
    if (slot > 0) {
      for (int n = 0; n < 64; ++n) {
        double2 ap = apow[(lg * 65 + slot - 1) * 64 + n];
        double cr = p.in[11][((size_t)lg * 16 + pp) * 64 + n], ci = p.in[12][((size_t)lg * 16 + pp) * 64 + n];
        float xr = (float)(cr * ap.x - ci * ap.y), xi = (float)(cr * ap.y + ci * ap.x);
        const float2* bb = bbs + (size_t)(lg * 64 + n) * 16;
#pragma unroll
        for (int q = 0; q < 16; ++q) { float2 b = bb[q]; acc[q] += xr * b.x - xi * b.y; }
      }
    }
    h16x8 v0, v1;
#pragma unroll
    for (int q = 0; q < 8; ++q) { v0[q] = (h16)acc[q]; v1[q] = (h16)acc[8 + q]; }
    h16* kt = (h16*)(p.ws + O_KTAB + (size_t)lg * SZ_KTAB) + slot * 256 + pp * 16;
    *(h16x8*)kt = v0;
    *(h16x8*)(kt + 8) = v1;
  }
  for (int i = gt; i < 128 * 64; i += ngt) {
    double2 ap = apow[((i >> 6) * 65 + 64) * 64 + (i & 63)];
    ((float2*)(p.ws + O_AT))[i] = make_float2((float)ap.x, (float)ap.y);
  }
}

__device__ void ssm_endstates(const Params& p, int l) {
  const int tid = threadIdx.x, lane = tid & 63, w = tid >> 6;
  const int gw = blockIdx.x * NW + w, nw = gridDim.x * NW;
  const h16* P = (const h16*)(p.ws + O_P);
  float* E = (float*)(p.ws + O_E);
  for (int unit = gw; unit < 32 * 32; unit += nw) {
    int g = unit >> 5, ctile = unit & 31;
    const h16* W1 = (const h16*)(p.ws + O_W1 + (size_t)(l * 32 + g) * SZ_W13);
    int gch = ctile * 16 + (lane & 15);
    const h16* ub = P + (size_t)gch * 64 * IWP + OFF_U + g * 16 + ((lane >> 4) & 1) * 8 + (size_t)(lane >> 5) * IWP;
    f32x4 acc[8];
#pragma unroll
    for (int mt = 0; mt < 8; ++mt) acc[mt] = f32x4{0.f, 0.f, 0.f, 0.f};
#pragma unroll 2
    for (int ks = 0; ks < 32; ++ks) {
      h16x8 B = *(const h16x8*)(ub + (size_t)(ks * 2) * IWP);
#pragma unroll
      for (int mt = 0; mt < 8; ++mt) {
        h16x8 A = *(const h16x8*)(W1 + ((size_t)(ks * 4 + (lane >> 4)) * 128 + mt * 16 + (lane & 15)) * 8);
        acc[mt] = __builtin_amdgcn_mfma_f32_16x16x32_f16(A, B, acc[mt], 0, 0, 0);
      }
    }
#pragma unroll
    for (int mt = 0; mt < 8; ++mt)
      *(f32x4*)(E + ((size_t)gch * 32 + g) * 128 + mt * 16 + (lane >> 4) * 4) = acc[mt];
  }
}

constexpr int BU_PITCH = 1032, BS_PITCH = 136;
constexpr int SSMY_LDS = 65 * 512 + 16 * BU_PITCH * 2 + 16 * BS_PITCH * 2;
__device__ void ssm_outputs(const Params& p, int l, char* lds) {
  const int tid = threadIdx.x, lane = tid & 63, w = tid >> 6;
  h16* Kt = (h16*)lds;
  h16* Bu = (h16*)(lds + 65 * 512);
  h16* Bs = (h16*)(lds + 65 * 512 + 16 * BU_PITCH * 2);
  const h16* P = (const h16*)(p.ws + O_P);
  const float* E = (const float*)(p.ws + O_E);
  h16* Z = (h16*)(p.ws + O_Z);
  for (int unit = blockIdx.x; unit < 1024; unit += gridDim.x) {
    const int g = unit & 31, bc = unit >> 5, b = bc >> 3, ct = bc & 7;
    const int lg = l * 32 + g;
    __syncthreads();
    if (w == 0) {
      float2 at = ((const float2*)(p.ws + O_AT))[lg * 64 + lane];
      const float2* Eb = (const float2*)E + ((size_t)(b * 128) * 32 + g) * 64 + lane;
      float sr = 0.f, si = 0.f;
      const int c0 = ct * 16;
#pragma unroll 8
      for (int c = 0; c < c0; ++c) {
        float2 e = Eb[(size_t)c * 2048];
        float nr = at.x * sr - at.y * si + e.x, ni = at.x * si + at.y * sr + e.y;
        sr = nr; si = ni;
      }
#pragma unroll
      for (int i = 0; i < 16; ++i) {
        Bs[i * BS_PITCH + 2 * lane] = (h16)sr;
        Bs[i * BS_PITCH + 2 * lane + 1] = (h16)si;
        float2 e = Eb[(size_t)(c0 + i) * 2048];
        float nr = at.x * sr - at.y * si + e.x, ni = at.x * si + at.y * sr + e.y;
        sr = nr; si = ni;
      }
    } else {
      const int t2 = tid - 64, n2 = NT - 64;
      const h16x8* ks = (const h16x8*)(p.ws + O_KTAB + (size_t)lg * SZ_KTAB);
      for (int i = t2; i < 65 * 32; i += n2) ((h16x8*)Kt)[i] = ks[i];
      for (int i = t2; i < 2048; i += n2) {
        int tk = i >> 1, hf = i & 1;
        h16x8 v = *(const h16x8*)(P + ((size_t)b * SEQ + ct * 1024 + tk) * IWP + OFF_U + g * 16 + hf * 8);
        *(h16x8*)(Bu + (tk >> 6) * BU_PITCH + (tk & 63) * 16 + hf * 8) = v;
      }
    }
    __syncthreads();
    const float dt = expf(p.in[8][lg]);
    const int col = lane & 15, hi = lane >> 5, qh = (lane >> 4) & 1, p0 = (lane >> 4) * 4;
    const h16* W3 = (const h16*)(p.ws + O_W3 + (size_t)lg * SZ_W13);
    float dsk[4];
    for (int j = 0; j < 4; ++j) dsk[j] = p.in[13][l * 512 + g * 16 + p0 + j];
    for (int r = 0; r < 64 / NW; ++r) {
      const int base = (r >> 1) * 2 * NW;
      const int tau = (r & 1) ? base + 2 * NW - 1 - w : base + w;
      f32x4 acc = {0.f, 0.f, 0.f, 0.f};
      const int nks = tau / 2 + 1;
      for (int i = 0; i < nks; ++i) {
        int j = tau - (2 * i + hi);
        h16x8 A = *(const h16x8*)(Kt + (j + 1) * 256 + (lane & 15) * 16 + qh * 8);
        h16x8 B = *(const h16x8*)(Bu + col * BU_PITCH + (2 * i + hi) * 16 + qh * 8);
        acc = __builtin_amdgcn_mfma_f32_16x16x32_f16(A, B, acc, 0, 0, 0);
      }
#pragma unroll
      for (int ks = 0; ks < 4; ++ks) {
        h16x8 A = *(const h16x8*)(W3 + ((size_t)((tau * 16 + ks * 4 + (lane >> 4)) * 16) + (lane & 15)) * 8);
        h16x8 B = *(const h16x8*)(Bs + col * BS_PITCH + ks * 32 + (lane >> 4) * 8);
        acc = __builtin_amdgcn_mfma_f32_16x16x32_f16(A, B, acc, 0, 0, 0);
      }
      const h16* up = Bu + col * BU_PITCH + tau * 16 + p0;
      size_t tok = ((size_t)b * 128 + ct * 16 + col) * 64 + tau;
      h16 zz[4];
      for (int j = 0; j < 4; ++j) zz[j] = (h16)gelu_tanh(dt * acc[j] + dsk[j] * (float)up[j]);
      typedef __attribute__((ext_vector_type(4))) _Float16 h16x4;
      h16x4 zv = {zz[0], zz[1], zz[2], zz[3]};
      *(h16x4*)(Z + tok * 512 + g * 16 + p0) = zv;
    }
  }
}

__device__ void phase_gemm1(const Params& p, int l, char* lds) {
  h16* SA = (h16*)lds; h16* SB = (h16*)(lds + 8192); float* rsl = (float*)(lds + 16384);
  const h16* A = (const h16*)(p.ws + O_XB);
  const h16* Bt = (const h16*)(p.ws + O_WIN + l * SZ_WIN);
  h16* P = (h16*)(p.ws + O_P);
  const float* ssq = (const float*)(p.ws + O_SSQ);
  const float* qkg = p.in[3] + l * 6 * 64;
  const int tid = threadIdx.x, lane = tid & 63, wid = tid >> 6, wr = wid >> 1, wc = wid & 1, fr = lane & 15, fq = lane >> 4;
  constexpr int NN = IWP / 128;
  for (int t = blockIdx.x; t < (NTOK / 128) * NN; t += gridDim.x) {
    int brow = (t / NN) * 128, bcol = (t % NN) * 128;
    f32x4 acc[4][4];
    zero_acc(acc);
    gemm_kloop(A, DM, Bt, DM, DM, brow, bcol, SA, SB, acc);
    load_rowscale(ssq, brow, 1.f / DM, rsl);
    int hs = (bcol + wc * 64) >> 6;
    int gi = -1;
    if (hs < 4) gi = 0; else if (hs < 6) gi = 1; else if (hs >= 16 && hs < 20) gi = 2; else if (hs == 22) gi = 4; else if (hs == 24) gi = 5;
    bool gate = (hs == 26);
    float gv[4] = {1.f, 1.f, 1.f, 1.f};
    if (gi >= 0) for (int n = 0; n < 4; ++n) gv[n] = qkg[gi * 64 + n * 16 + fr];
#pragma unroll
    for (int m = 0; m < 4; ++m)
#pragma unroll
      for (int j = 0; j < 4; ++j) {
        int rl = wr * 64 + m * 16 + fq * 4 + j;
        float r = rsl[rl];
        float v[4];
        for (int n = 0; n < 4; ++n) v[n] = acc[m][n][j] * r;
        if (gi >= 0) {
          float ss = v[0] * v[0] + v[1] * v[1] + v[2] * v[2] + v[3] * v[3];
          ss += __shfl_xor(ss, 1); ss += __shfl_xor(ss, 2); ss += __shfl_xor(ss, 4); ss += __shfl_xor(ss, 8);
          float sc = rsqrtf(ss * (1.f / 64.f) + EPS);
          for (int n = 0; n < 4; ++n) v[n] *= sc * gv[n];
        } else if (gate) {
          for (int n = 0; n < 4; ++n) v[n] = (n * 16 + fr) < 12 ? sigmoidf(v[n]) : 0.f;
        }
        for (int n = 0; n < 4; ++n) P[(long)(brow + rl) * IWP + bcol + wc * 64 + n * 16 + fr] = (h16)v[n];
      }
    __syncthreads();
  }
}

__device__ void phase_glu(const Params& p, int l, char* lds) {
  h16* SA = (h16*)lds; h16* SB = (h16*)(lds + 8192);
  const h16* A = (const h16*)(p.ws + O_Z);
  const h16* Bt = (const h16*)(p.ws + O_WGLU + l * SZ_WGLU);
  h16* OB = (h16*)(p.ws + O_OB);
  float* ssqb = (float*)(p.ws + O_SSQB);
  const float* gb = p.in[15] + l * 1024;
  const int tid = threadIdx.x, lane = tid & 63, wid = tid >> 6, wr = wid >> 1, wc = wid & 1, fr = lane & 15, fq = lane >> 4;
  constexpr int NN = 8;
  for (int t = blockIdx.x; t < (NTOK / 128) * NN; t += gridDim.x) {
    int brow = (t / NN) * 128, bcol = (t % NN) * 128;
    f32x4 acc[4][4];
    zero_acc(acc);
    gemm_kloop(A, 512, Bt, 512, 512, brow, bcol, SA, SB, acc);
    int ocb = (bcol + wc * 64) / 2;
    float ba[2], bb[2];
    for (int np = 0; np < 2; ++np) { ba[np] = gb[ocb + np * 16 + fr]; bb[np] = gb[512 + ocb + np * 16 + fr]; }
#pragma unroll
    for (int m = 0; m < 4; ++m)
#pragma unroll
      for (int j = 0; j < 4; ++j) {
        int row = brow + wr * 64 + m * 16 + fq * 4 + j;
        float ss = 0.f;
        for (int np = 0; np < 2; ++np) {
          float a = acc[m][2 * np][j] + ba[np], b = acc[m][2 * np + 1][j] + bb[np];
          float o = a * sigmoidf(b);
          OB[(long)row * 512 + ocb + np * 16 + fr] = (h16)o;
          ss += o * o;
        }
        ss += __shfl_xor(ss, 1); ss += __shfl_xor(ss, 2); ss += __shfl_xor(ss, 4); ss += __shfl_xor(ss, 8);
        if (fr == 0) ssqb[(long)row * 16 + ((bcol + wc * 64) >> 6)] = ss;
      }
  }
}

__device__ void phase_wout(const Params& p, int l, char* lds) {
  h16* SA = (h16*)lds; h16* SB = (h16*)(lds + 8192); float* rsl = (float*)(lds + 16384);
  const h16* A1 = (const h16*)(p.ws + O_OB);
  const h16* A2 = (const h16*)(p.ws + O_OAC);
  const h16* Bt = (const h16*)(p.ws + O_WOUT + l * SZ_WOUT);
  const float* ssqb = (const float*)(p.ws + O_SSQB);
  const float* xsrc = (l == 0) ? p.in[0] : p.out;
  float* xo = p.out;
  h16* xb = (h16*)(p.ws + O_XB);
  float* ssq = (float*)(p.ws + O_SSQ);
  const int tid = threadIdx.x, lane = tid & 63, wid = tid >> 6, wr = wid >> 1, wc = wid & 1, fr = lane & 15, fq = lane >> 4;
  constexpr int NN = 8;
  for (int t = blockIdx.x; t < (NTOK / 128) * NN; t += gridDim.x) {
    int brow = (t / NN) * 128, bcol = (t % NN) * 128;
    f32x4 acc[4][4];
    zero_acc(acc);
    load_rowscale(ssqb, brow, 1.f / 512.f, rsl);
    gemm_kloop(A1, 512, Bt, DM, 512, brow, bcol, SA, SB, acc);
#pragma unroll
    for (int m = 0; m < 4; ++m)
#pragma unroll
      for (int j = 0; j < 4; ++j) {
        float r = rsl[wr * 64 + m * 16 + fq * 4 + j];
        for (int n = 0; n < 4; ++n) acc[m][n][j] *= r;
      }
    gemm_kloop(A2, 512, Bt + 512, DM, 512, brow, bcol, SA, SB, acc);
#pragma unroll
    for (int m = 0; m < 4; ++m)
#pragma unroll
      for (int j = 0; j < 4; ++j) {
        int row = brow + wr * 64 + m * 16 + fq * 4 + j;
        float ss = 0.f;
        for (int n = 0; n < 4; ++n) {
          long idx = (long)row * DM + bcol + wc * 64 + n * 16 + fr;
          float xn = xsrc[idx] + acc[m][n][j];
          xo[idx] = xn;
          xb[idx] = (h16)xn;
          ss += xn * xn;
        }
        ss += __shfl_xor(ss, 1); ss += __shfl_xor(ss, 2); ss += __shfl_xor(ss, 4); ss += __shfl_xor(ss, 8);
        if (fr == 0) ssq[(long)row * 16 + ((bcol + wc * 64) >> 6)] = ss;
      }
    __syncthreads();
  }
}

__device__ void phase_up(const Params& p, int l, char* lds) {
  h16* SA = (h16*)lds; h16* SB = (h16*)(lds + 8192); float* rsl = (float*)(lds + 16384);
  const h16* A = (const h16*)(p.ws + O_XB);
  const h16* Bt = (const h16*)(p.ws + O_WUP + l * SZ_WUP);
  h16* hid = (h16*)(p.ws + O_HID);
  const float* ssq = (const float*)(p.ws + O_SSQ);
  const int tid = threadIdx.x, lane = tid & 63, wid = tid >> 6, wr = wid >> 1, wc = wid & 1, fr = lane & 15, fq = lane >> 4;
  constexpr int NN = DFF / 128;
  for (int t = blockIdx.x; t < (NTOK / 128) * NN; t += gridDim.x) {
    int brow = (t / NN) * 128, bcol = (t % NN) * 128;
    f32x4 acc[4][4];
    zero_acc(acc);
    gemm_kloop(A, DM, Bt, DM, DM, brow, bcol, SA, SB, acc);
    load_rowscale(ssq, brow, 1.f / DM, rsl);
#pragma unroll
    for (int m = 0; m < 4; ++m)
#pragma unroll
      for (int j = 0; j < 4; ++j) {
        int rl = wr * 64 + m * 16 + fq * 4 + j;
        float r = rsl[rl];
        for (int n = 0; n < 4; ++n) {
          float v = fmaxf(acc[m][n][j] * r, 0.f);
          hid[(long)(brow + rl) * DFF + bcol + wc * 64 + n * 16 + fr] = (h16)(v * v);
        }
      }
    __syncthreads();
  }
}

__device__ void phase_down(const Params& p, int l, char* lds) {
  h16* SA = (h16*)lds; h16* SB = (h16*)(lds + 8192);
  const h16* A = (const h16*)(p.ws + O_HID);
  const h16* Bt = (const h16*)(p.ws + O_WDN + l * SZ_WDN);
  float* xo = p.out;
  h16* xb = (h16*)(p.ws + O_XB);
  float* ssq = (float*)(p.ws + O_SSQ);
  const int tid = threadIdx.x, lane = tid & 63, wid = tid >> 6, wr = wid >> 1, wc = wid & 1, fr = lane & 15, fq = lane >> 4;
  constexpr int NN = 8;
  for (int t = blockIdx.x; t < (NTOK / 128) * NN; t += gridDim.x) {
    int brow = (t / NN) * 128, bcol = (t % NN) * 128;
    f32x4 acc[4][4];
    zero_acc(acc);
    gemm_kloop(A, DFF, Bt, DFF, DFF, brow, bcol, SA, SB, acc);
#pragma unroll
    for (int m = 0; m < 4; ++m)
#pragma unroll
      for (int j = 0; j < 4; ++j) {
        int row = brow + wr * 64 + m * 16 + fq * 4 + j;
        float ss = 0.f;
        for (int n = 0; n < 4; ++n) {
          long idx = (long)row * DM + bcol + wc * 64 + n * 16 + fr;
          float xn = xo[idx] + acc[m][n][j];
          xo[idx] = xn;
          xb[idx] = (h16)xn;
          ss += xn * xn;
        }
        ss += __shfl_xor(ss, 1); ss += __shfl_xor(ss, 2); ss += __shfl_xor(ss, 4); ss += __shfl_xor(ss, 8);
        if (fr == 0) ssq[(long)row * 16 + ((bcol + wc * 64) >> 6)] = ss;
      }
  }
}

template <int NH>
struct AttnState {
  float m[NH], l[NH], o[NH];
  __device__ __forceinline__ void init() {
    for (int h = 0; h < NH; ++h) { m[h] = -1e30f; l[h] = 0.f; o[h] = 0.f; }
  }
};

template <int NH>
__device__ __forceinline__ void attend64(AttnState<NH>& st, const float* qs, const h16* Kb, const h16* Vb, int ld, long s,
                                         bool valid, int dist, const float* bias_tbl, int hoff, const int* lut) {
  const int lane = threadIdx.x & 63;
  float kf[64];
  {
    const h16x8* kp = (const h16x8*)(Kb + s * ld);
#pragma unroll
    for (int i = 0; i < 8; ++i) {
      h16x8 kv = kp[i];
#pragma unroll
      for (int e = 0; e < 8; ++e) kf[i * 8 + e] = (float)kv[e];
    }
  }
  int bk = lut[valid ? dist : 0];
  float pr[NH];
#pragma unroll
  for (int h = 0; h < NH; ++h) {
    float d = 0.f;
    const float4* q4 = (const float4*)(qs + h * 64);
#pragma unroll
    for (int i = 0; i < 16; ++i) {
      float4 q = q4[i];
      d += q.x * kf[i * 4] + q.y * kf[i * 4 + 1] + q.z * kf[i * 4 + 2] + q.w * kf[i * 4 + 3];
    }
    float lg = valid ? d + bias_tbl[bk * 8 + hoff + h] : -1e30f;
    float mx = wave_max(lg);
    float mn = fmaxf(st.m[h], mx);
    float pp = valid ? __expf(lg - mn) : 0.f;
    float corr = __expf(st.m[h] - mn);
    st.l[h] = st.l[h] * corr + wave_sum(pp);
    st.o[h] *= corr;
    st.m[h] = mn;
    pr[h] = pp;
  }
  for (int key = 0; key < 64; ++key) {
    long sk = ((long)__builtin_amdgcn_readlane((int)s, key));
    float v = (float)Vb[sk * ld + lane];
#pragma unroll
    for (int h = 0; h < NH; ++h) st.o[h] += rdlane(pr[h], key) * v;
  }
}

__device__ void phase2(const Params& p, int l, char* lds) {
  const int tid = threadIdx.x, lane = tid & 63, w = tid >> 6;
  const int gw = blockIdx.x * NW + w, nw = gridDim.x * NW;
  const h16* P = (const h16*)(p.ws + O_P);
  const int* lut = (const int*)(p.ws + O_LUT);
  float* bias_tbl = (float*)lds;
  float* qs = (float*)(lds + 1024) + w * 256;
  float2* sbuf = (float2*)(lds + 1024 + NW * 1024) + w * 64;
  for (int i = tid; i < 256; i += NT) bias_tbl[i] = p.in[5][i];
  __syncthreads();

  {
    const float* KC = (const float*)(p.ws + O_KCMP);
    (void)KC;
    for (int item = gw; item < BATCH * 128 * 2; item += nw) {
      int s = item & 1, mg = (item >> 1) & 127, b = item >> 8;
      const float* w1 = p.in[17] + (size_t)(l * 2 + s) * 2048 * 128;
      const float* w2 = p.in[18] + (size_t)(l * 2 + s) * 128 * 64;
      const float* b1 = (const float*)(p.ws + O_BIAS1) + (l * 2 + s) * 128;
      float a0[4], a1[4];
      for (int mi = 0; mi < 4; ++mi) { a0[mi] = b1[lane]; a1[mi] = b1[64 + lane]; }
      for (int tt = 0; tt < 32; ++tt) {
        float xv[4];
        for (int mi = 0; mi < 4; ++mi) {
          int m = mg * 4 + mi;
          int tok = 16 * m + tt;
          if (tok > SEQ - 1) tok = SEQ - 1;
          xv[mi] = (float)P[((size_t)b * SEQ + tok) * IWP + OFF_KVC + s * 64 + lane];
        }
        const float* wr = w1 + (size_t)tt * 64 * 128;
        for (int d = 0; d < 64; ++d) {
          float wa = wr[d * 128 + lane], wb = wr[d * 128 + 64 + lane];
          for (int mi = 0; mi < 4; ++mi) {
            float x = rdlane(xv[mi], d);
            a0[mi] += x * wa; a1[mi] += x * wb;
          }
        }
      }
      for (int mi = 0; mi < 4; ++mi) { a0[mi] = gelu_tanh(a0[mi]); a1[mi] = gelu_tanh(a1[mi]); }
      float o[4] = {0.f, 0.f, 0.f, 0.f};
      for (int j = 0; j < 64; ++j) {
        float wa = w2[j * 64 + lane], wb = w2[(64 + j) * 64 + lane];
        for (int mi = 0; mi < 4; ++mi) o[mi] += rdlane(a0[mi], j) * wa + rdlane(a1[mi], j) * wb;
      }
      for (int mi = 0; mi < 4; ++mi) {
        int m = mg * 4 + mi;
        if (m >= NCMP) continue;
        if (s == 0) {
          float ss = wave_sum(o[mi] * o[mi]);
          float v = o[mi] * rsqrtf(ss * (1.f / 64.f) + EPS) * p.in[3][(l * 6 + 3) * 64 + lane];
          ((float*)(p.ws + O_KCMP))[((size_t)b * 512 + m) * 64 + lane] = v;
        } else {
          ((float*)(p.ws + O_VCMP))[((size_t)b * 512 + m) * 64 + lane] = o[mi];
        }
      }
    }
  }

  {
    h16* OAC = (h16*)(p.ws + O_OAC);
    for (int tok = gw; tok < NTOK; tok += nw) {
      int b = tok / SEQ, t = tok % SEQ;
      float oh[4];
      float ssum = 0.f;
      for (int h = 0; h < 4; ++h) {
        qs[lane] = (float)P[(size_t)tok * IWP + h * 64 + lane] * 0.125f;
        AttnState<1> st;
        st.init();
        const h16* Kb = P + (size_t)b * SEQ * IWP + 256 + (h >> 1) * 64;
        const h16* Vb = P + (size_t)b * SEQ * IWP + 384 + (h >> 1) * 64;
        for (int c = 0; c < 2; ++c) {
          int s = t - 127 + c * 64 + lane;
          bool valid = s >= 0;
          attend64<1>(st, qs, Kb, Vb, IWP, valid ? s : 0, valid, t - s, bias_tbl, h, lut);
        }
        float sink = p.in[4][l * 4 + h];
        float mn = fmaxf(st.m[0], sink);
        float corr = __expf(st.m[0] - mn);
        float den = st.l[0] * corr + __expf(sink - mn);
        oh[h] = st.o[0] * corr / den;
        ssum += oh[h] * oh[h];
      }
      ssum = wave_sum(ssum);
      float sc = rsqrtf(ssum * (1.f / 256.f) + EPS);
      for (int h = 0; h < 4; ++h) OAC[(size_t)tok * 512 + h * 64 + lane] = (h16)(oh[h] * sc);
    }
  }
}

__device__ void phase_nsa(const Params& p, int l, char* lds) {
  const int tid = threadIdx.x, lane = tid & 63, w = tid >> 6;
  const int gw = blockIdx.x * NW + w, nw = gridDim.x * NW;
  const h16* P = (const h16*)(p.ws + O_P);
  const int* lut = (const int*)(p.ws + O_LUT);
  float* bias_tbl = (float*)lds;
  float* qs = (float*)(lds + 1024) + w * 256;
  float* pl = (float*)(lds + 1024 + NW * 1024) + w * 2048;
  float* imp = (float*)(lds + 1024 + NW * 1024 + NW * 8192) + w * 128;
  __syncthreads();
  for (int i = tid; i < 256; i += NT) bias_tbl[i] = p.in[5][i];
  __syncthreads();
  const float* KC = (const float*)(p.ws + O_KCMP);
  const float* VC = (const float*)(p.ws + O_VCMP);
  h16* OAC = (h16*)(p.ws + O_OAC);
  for (int it = gw; it < NTOK; it += nw) {
    int tok = it;
    int b = tok / SEQ, t = tok % SEQ;
    for (int h = 0; h < 4; ++h) qs[h * 64 + lane] = (float)P[(size_t)tok * IWP + OFF_QC + h * 64 + lane] * 0.125f;
    int Mv = t >= 31 ? (t - 31) / 16 + 1 : 0;
    if (Mv > NCMP) Mv = NCMP;
    float ocmp[4] = {0.f, 0.f, 0.f, 0.f};
    {
      float mx[4] = {-1e30f, -1e30f, -1e30f, -1e30f};
      int nch = (Mv + 63) / 64;
      for (int c = 0; c < nch; ++c) {
        int m = c * 64 + lane;
        bool valid = m < Mv;
        const float4* kp = (const float4*)(KC + ((size_t)b * 512 + (valid ? m : 0)) * 64);
        float kf[64];
        for (int i = 0; i < 16; ++i) { float4 v = kp[i]; kf[4 * i] = v.x; kf[4 * i + 1] = v.y; kf[4 * i + 2] = v.z; kf[4 * i + 3] = v.w; }
        int dist = t - (16 * m + 31);
        int bk = lut[valid ? dist : 0];
        for (int h = 0; h < 4; ++h) {
          float d = 0.f;
          const float4* q4 = (const float4*)(qs + h * 64);
          for (int i = 0; i < 16; ++i) { float4 q = q4[i]; d += q.x * kf[4 * i] + q.y * kf[4 * i + 1] + q.z * kf[4 * i + 2] + q.w * kf[4 * i + 3]; }
          float lg = valid ? d + bias_tbl[bk * 8 + 4 + h] : -1e30f;
          pl[h * 512 + m] = lg;
          mx[h] = fmaxf(mx[h], lg);
        }
      }
      float inv[4];
      for (int h = 0; h < 4; ++h) {
        mx[h] = wave_max(mx[h]);
        float s = 0.f;
        for (int c = 0; c < nch; ++c) {
          int m = c * 64 + lane;
          float e = (m < Mv) ? __expf(pl[h * 512 + m] - mx[h]) : 0.f;
          pl[h * 512 + m] = e;
          s += e;
        }
        s = wave_sum(s);
        inv[h] = s > 0.f ? 1.f / s : 0.f;
      }
      for (int h = 0; h < 4; ++h)
        for (int c = 0; c < nch; ++c) pl[h * 512 + c * 64 + lane] *= inv[h];
      for (int jj = 0; jj < 2; ++jj) {
        int j = jj * 64 + lane;
        float a = 0.f;
        for (int m = 4 * j - 1; m <= 4 * j + 3; ++m)
          if (m >= 0 && m < Mv) a += pl[m] + pl[512 + m] + pl[1024 + m] + pl[1536 + m];
        imp[j] = a;
      }
      for (int m = 0; m < Mv; ++m) {
        float v = VC[((size_t)b * 512 + m) * 64 + lane];
        for (int h = 0; h < 4; ++h) ocmp[h] += pl[h * 512 + m] * v;
      }
    }
    const int cur = t >> 6;
    unsigned long long mlo, mhi;
    {
      int nforced = cur >= 2 ? 3 : cur + 1;
      int npick = 16 - nforced;
      int j0 = lane, j1 = lane + 64;
      float v0 = imp[j0], v1 = imp[j1];
      int r0 = 0, r1 = 0;
      for (int jp = 1; jp <= cur - 2; ++jp) {
        float vp = imp[jp];
        r0 += (vp > v0 || (vp == v0 && jp < j0)) ? 1 : 0;
        r1 += (vp > v1 || (vp == v1 && jp < j1)) ? 1 : 0;
      }
      bool c0 = j0 >= 1 && j0 <= cur - 2, c1 = j1 <= cur - 2;
      bool f0 = j0 == 0 || j0 == cur || j0 == cur - 1, f1 = j1 == cur || j1 == cur - 1;
      bool s0 = f0 || (c0 && r0 < npick), s1 = f1 || (c1 && r1 < npick);
      mlo = __ballot(s0);
      mhi = __ballot(s1);
    }
    AttnState<4> ss;
    ss.init();
    {
      const h16* Kb = P + (size_t)b * SEQ * IWP + OFF_KVC + 2 * 64;
      const h16* Vb = P + (size_t)b * SEQ * IWP + OFF_KVC + 3 * 64;
      for (int half = 0; half < 2; ++half) {
        unsigned long long mk = half ? mhi : mlo;
        while (mk) {
          int j = __builtin_ctzll(mk) + half * 64;
          mk &= mk - 1;
          int s = j * 64 + lane;
          bool valid = s <= t;
          attend64<4>(ss, qs, Kb, Vb, IWP, valid ? s : 0, valid, t - s, bias_tbl, 4, lut);
        }
      }
    }
    AttnState<4> sw;
    sw.init();
    {
      const h16* Kb = P + (size_t)b * SEQ * IWP + OFF_KVC + 4 * 64;
      const h16* Vb = P + (size_t)b * SEQ * IWP + OFF_KVC + 5 * 64;
      for (int c = 0; c < 8; ++c) {
        int s = t - 511 + c * 64 + lane;
        bool valid = s >= 0;
        if (t - 511 + c * 64 + 63 < 0) continue;
        attend64<4>(sw, qs, Kb, Vb, IWP, valid ? s : 0, valid, t - s, bias_tbl, 4, lut);
      }
    }
    float oc[4];
    float ssum = 0.f;
    for (int h = 0; h < 4; ++h) {
      float g0 = (float)P[(size_t)tok * IWP + OFF_GC + h * 3 + 0];
      float g1 = (float)P[(size_t)tok * IWP + OFF_GC + h * 3 + 1];
      float g2 = (float)P[(size_t)tok * IWP + OFF_GC + h * 3 + 2];
      float os = ss.l[h] > 0.f ? ss.o[h] / ss.l[h] : 0.f;
      float ow = sw.l[h] > 0.f ? sw.o[h] / sw.l[h] : 0.f;
      oc[h] = g0 * ocmp[h] + g1 * os + g2 * ow;
      ssum += oc[h] * oc[h];
    }
    ssum = wave_sum(ssum);
    float sc = rsqrtf(ssum * (1.f / 256.f) + EPS);
    for (int h = 0; h < 4; ++h) OAC[(size_t)tok * 512 + 256 + h * 64 + lane] = (h16)(oc[h] * sc);
  }
}

constexpr int LDS_NSA = 1024 + NW * 1024 + NW * 8192 + NW * 512 + 1024;
constexpr int LDS_BYTES = LDS_NSA > SSMY_LDS ? LDS_NSA : SSMY_LDS;

__global__ void __launch_bounds__(NT) fwd_megakernel(Params p) {
  cg::grid_group grid = cg::this_grid();
  __shared__ __attribute__((aligned(16))) char lds[LDS_BYTES];
  phase0(p, (float*)lds);
  grid.sync();
  phase0b(p);
  grid.sync();
  for (int l = 0; l < DEPTH; ++l) {
    phase_gemm1(p, l, lds);
    grid.sync();
    ssm_endstates(p, l);
    phase2(p, l, lds);
    grid.sync();
    ssm_outputs(p, l, lds);
    phase_nsa(p, l, lds);
    grid.sync();
    phase_glu(p, l, lds);
    grid.sync();
    phase_wout(p, l, lds);
    grid.sync();
    phase_up(p, l, lds);
    grid.sync();
    phase_down(p, l, lds);
    grid.sync();
  }
}

extern "C" void kernel_launch(void* const* d_in, const int* in_sizes, int n_in, void* d_out, int out_size, void* d_ws,
                              size_t ws_size, hipStream_t stream) {
  static int grid_blocks = 0;
  if (!grid_blocks) {
    int dev = 0, cus = 0, per_cu = 0;
    hipGetDevice(&dev);
    hipDeviceGetAttribute(&cus, hipDeviceAttributeMultiprocessorCount, dev);
    hipOccupancyMaxActiveBlocksPerMultiprocessor(&per_cu, fwd_megakernel, NT, 0);
    if (per_cu > 2) per_cu = 2;
    grid_blocks = cus * per_cu;
  }
  if (ws_size < WS_NEED) {
    fprintf(stderr, "workspace too small: %zu < %zu\n", ws_size, WS_NEED);
    return;
  }
  Params p{};
  for (int i = 0; i < 24; ++i) p.in[i] = (const float*)d_in[i];
  p.out = (float*)d_out;
  p.ws = (char*)d_ws;
  void* args[] = {&p};
  hipError_t e = hipLaunchCooperativeKernel((void*)fwd_megakernel, dim3(grid_blocks), dim3(NT), args, 0, stream);
  if (e != hipSuccess) fprintf(stderr, "cooperative launch failed: %s (grid %d)\n", hipGetErrorString(e), grid_blocks);
}
```

```cpp
#include <hip/hip_runtime.h>
#include <hip/hip_cooperative_groups.h>
#include <cstdio>
namespace cg = cooperative_groups;

typedef _Float16 h16;
typedef __attribute__((ext_vector_type(8))) _Float16 h16x8;
typedef __attribute__((ext_vector_type(4))) float f32x4;

constexpr int NT = 512;
constexpr int NW = NT / 64;
constexpr int BATCH = 4, SEQ = 8192, NTOK = BATCH * SEQ, DM = 1024, DEPTH = 4, IW = 1676, IWP = 1792, DFF = 4096;
constexpr int OFF_U = 512, OFF_QC = 1024, OFF_KVC = 1280, OFF_GC = 1664;
constexpr int NCMP = 511;
constexpr float EPS = 1e-6f;

constexpr size_t SZ_WIN = (size_t)IWP * DM * 2, SZ_WGLU = (size_t)1024 * 512 * 2, SZ_WOUT = (size_t)DM * DM * 2,
                 SZ_WUP = (size_t)DFF * DM * 2, SZ_WDN = (size_t)DM * DFF * 2;
constexpr size_t O_WIN = 0;
constexpr size_t O_WGLU = O_WIN + DEPTH * SZ_WIN;
constexpr size_t O_WOUT = O_WGLU + DEPTH * SZ_WGLU;
constexpr size_t O_WUP = O_WOUT + DEPTH * SZ_WOUT;
constexpr size_t O_WDN = O_WUP + DEPTH * SZ_WUP;
constexpr size_t O_XB = O_WDN + DEPTH * SZ_WDN;
constexpr size_t O_SSQ = O_XB + (size_t)NTOK * DM * 2;
constexpr size_t O_SSQB = O_SSQ + (size_t)NTOK * 16 * 4;
constexpr size_t O_KCMP = O_SSQB + (size_t)NTOK * 16 * 4;
constexpr size_t O_VCMP = O_KCMP + (size_t)BATCH * 512 * 64 * 4;
constexpr size_t O_ABAR = O_VCMP + (size_t)BATCH * 512 * 64 * 4;
constexpr size_t O_BBAR = O_ABAR + (size_t)DEPTH * 32 * 64 * 8;
constexpr size_t O_BIAS1 = O_BBAR + (size_t)DEPTH * 32 * 64 * 16 * 8;
constexpr size_t O_LUT = O_BIAS1 + (size_t)DEPTH * 2 * 128 * 4;
constexpr size_t O_AT = O_LUT + 8192 * 4;
constexpr size_t O_KTAB = O_AT + (size_t)128 * 64 * 8;
constexpr size_t SZ_KTAB = (size_t)65 * 256 * 2;
constexpr size_t O_W1 = O_KTAB + 128 * SZ_KTAB;
constexpr size_t SZ_W13 = (size_t)128 * 1024 * 2;
constexpr size_t O_W3 = O_W1 + 128 * SZ_W13;
constexpr size_t O_BIG = (O_W3 + 128 * SZ_W13 + 255) / 256 * 256;
constexpr size_t O_APOW = O_BIG;
constexpr size_t O_P = O_BIG;
constexpr size_t O_Z = O_P + (size_t)NTOK * IWP * 2;
constexpr size_t O_OB = O_Z + (size_t)NTOK * 512 * 2;
constexpr size_t O_OAC = O_OB + (size_t)NTOK * 512 * 2;
constexpr size_t O_E = O_OAC + (size_t)NTOK * 512 * 2;
constexpr size_t O_HID = O_BIG;
constexpr size_t WS_NEED = O_BIG + (size_t)NTOK * DFF * 2;

struct Params {
  const float* in[24];
  float* out;
  char* ws;
};

__device__ __forceinline__ int opaque_tid() {
  int t = threadIdx.x;
  asm volatile("" : "+v"(t));
  return t;
}
__device__ __forceinline__ float wave_sum(float v) {
  for (int o = 32; o; o >>= 1) v += __shfl_xor(v, o);
  return v;
}
__device__ __forceinline__ float wave_max(float v) {
  for (int o = 32; o; o >>= 1) v = fmaxf(v, __shfl_xor(v, o));
  return v;
}
__device__ __forceinline__ float gelu_tanh(float x) {
  float u = 0.7978845608028654f * (x + 0.044715f * x * x * x);
  return 0.5f * x * (1.f + tanhf(u));
}
__device__ __forceinline__ float sigmoidf(float x) { return 1.f / (1.f + __expf(-x)); }
__device__ __forceinline__ float rdlane(float v, int l) {
  return __int_as_float(__builtin_amdgcn_readlane(__float_as_int(v), l));
}

__device__ __forceinline__ void gemm_kloop(const h16* __restrict__ A, int lda, const h16* __restrict__ Bt, int ldb, int K,
                                           int brow, int bcol, h16* SA, h16* SB, f32x4 (&acc)[4][4]) {
  const int tid = opaque_tid(), lane = tid & 63, wid = tid >> 6, wr = wid >> 2, wc = wid & 3, fr = lane & 15, fq = lane >> 4;
  for (int kt = 0; kt < K / 32; ++kt) {
    {
      int b = tid * 16, r = b / 64, c = (b % 64) / 2;
      __builtin_amdgcn_global_load_lds((const unsigned*)(A + (long)(brow + r) * lda + kt * 32 + c),
                                       (unsigned*)((char*)SA + b), 16, 0, 0);
    }
    for (int i = 0; i < 2; ++i) {
      int b = tid * 16 + i * 8192, r = b / 64, c = (b % 64) / 2;
      __builtin_amdgcn_global_load_lds((const unsigned*)(Bt + (long)(bcol + r) * ldb + kt * 32 + c),
                                       (unsigned*)((char*)SB + b), 16, 0, 0);
    }
    asm volatile("s_waitcnt vmcnt(0)" ::: "memory");
    __syncthreads();
    h16x8 At[4], Bl[4];
#pragma unroll
    for (int m = 0; m < 4; ++m) At[m] = *(const h16x8*)((const char*)SA + (wr * 64 + m * 16 + fr) * 64 + fq * 16);
#pragma unroll
    for (int n = 0; n < 4; ++n) Bl[n] = *(const h16x8*)((const char*)SB + (wc * 64 + n * 16 + fr) * 64 + fq * 16);
#pragma unroll
    for (int m = 0; m < 4; ++m)
#pragma unroll
      for (int n = 0; n < 4; ++n) acc[m][n] = __builtin_amdgcn_mfma_f32_16x16x32_f16(At[m], Bl[n], acc[m][n], 0, 0, 0);
    __syncthreads();
  }
}

__device__ __forceinline__ void zero_acc(f32x4 (&acc)[4][4]) {
#pragma unroll
  for (int m = 0; m < 4; ++m)
#pragma unroll
    for (int n = 0; n < 4; ++n) acc[m][n] = f32x4{0.f, 0.f, 0.f, 0.f};
}

__device__ __forceinline__ void load_rowscale(const float* ssq, int brow, float inv_n, float* rsl) {
  int tid = opaque_tid();
  if (tid < 128) {
    const float4* s4 = (const float4*)(ssq + (long)(brow + tid) * 16);
    float s = 0.f;
    for (int i = 0; i < 4; ++i) { float4 v = s4[i]; s += v.x + v.y + v.z + v.w; }
    rsl[tid] = rsqrtf(s * inv_n + EPS);
  }
  __syncthreads();
}

template <class SrcF>
__device__ __forceinline__ void conv_tile(SrcF src, h16* dst, int ldo, int n0, int k0, float* tile) {
  int tid = opaque_tid();
  for (int idx = tid; idx < 4096; idx += NT) {
    int kk = idx >> 6, nn = idx & 63;
    tile[kk * 65 + nn] = src(k0 + kk, n0 + nn);
  }
  __syncthreads();
  for (int idx = tid; idx < 4096; idx += NT) {
    int nn = idx >> 6, kk = idx & 63;
    dst[(long)(n0 + nn) * ldo + k0 + kk] = (h16)tile[kk * 65 + nn];
  }
  __syncthreads();
}

__device__ void phase0(const Params& p, float* lds) {
  const int tid = opaque_tid();
  constexpr int T_IN = (IWP / 64) * (DM / 64);
  constexpr int T_GLU = 16 * 8;
  constexpr int T_OUT = 16 * 16;
  constexpr int T_UP = 64 * 16;
  constexpr int T_DN = 16 * 64;
  constexpr int T_L = T_IN + T_GLU + T_OUT + T_UP + T_DN;
  for (int ti = blockIdx.x; ti < DEPTH * T_L; ti += gridDim.x) {
    int l = ti / T_L, r = ti % T_L;
    if (r < T_IN) {
      int nt = r / 16, kt = r % 16;
      const float* w = p.in[2] + (size_t)l * DM * IW;
      const float* g = p.in[1] + l * DM;
      conv_tile([&](int k, int n) { return n < IW ? w[(long)k * IW + n] * g[k] : 0.f; },
                (h16*)(p.ws + O_WIN + l * SZ_WIN), DM, nt * 64, kt * 64, lds);
    } else if ((r -= T_IN) < T_GLU) {
      int nt = r / 8, kt = r % 8;
      const float* w = p.in[14] + (size_t)l * 512 * 1024;
      conv_tile([&](int k, int n2) {
        int q = n2 >> 5, rr = n2 & 31;
        int n = rr < 16 ? 16 * q + rr : 512 + 16 * q + (rr - 16);
        return w[(long)k * 1024 + n]; },
                (h16*)(p.ws + O_WGLU + l * SZ_WGLU), 512, nt * 64, kt * 64, lds);
    } else if ((r -= T_GLU) < T_OUT) {
      int nt = r / 16, kt = r % 16;
      const float* w = p.in[20] + (size_t)l * DM * DM;
      const float* g = p.in[19] + l * DM;
      conv_tile([&](int k2, int n) {
        int k = k2 < 512 ? 256 + k2 : (k2 < 768 ? k2 - 512 : k2);
        return w[(long)k * DM + n] * g[k]; },
                (h16*)(p.ws + O_WOUT + l * SZ_WOUT), DM, nt * 64, kt * 64, lds);
    } else if ((r -= T_OUT) < T_UP) {
      int nt = r / 16, kt = r % 16;
      const float* w = p.in[22] + (size_t)l * DM * DFF;
      const float* g = p.in[21] + l * DM;
      conv_tile([&](int k, int n) { return w[(long)k * DFF + n] * g[k]; },
                (h16*)(p.ws + O_WUP + l * SZ_WUP), DM, nt * 64, kt * 64, lds);
    } else {
      r -= T_UP;
      int nt = r / 64, kt = r % 64;
      const float* w = p.in[23] + (size_t)l * DFF * DM;
      conv_tile([&](int k, int n) { return w[(long)k * DM + n]; },
                (h16*)(p.ws + O_WDN + l * SZ_WDN), DFF, nt * 64, kt * 64, lds);
    }
  }
  {
    const int lane = tid & 63;
    const int gw = blockIdx.x * NW + (tid >> 6), nw = gridDim.x * NW;
    const float* x = p.in[0];
    h16* xb = (h16*)(p.ws + O_XB);
    float* ssq = (float*)(p.ws + O_SSQ);
    for (int row = gw; row < NTOK; row += nw) {
      const float4* xr = (const float4*)(x + (long)row * DM + lane * 16);
      float s = 0.f;
      h16 hv[16];
      for (int i = 0; i < 4; ++i) {
        float4 v = xr[i];
        s += v.x * v.x + v.y * v.y + v.z * v.z + v.w * v.w;
        hv[i * 4 + 0] = (h16)v.x; hv[i * 4 + 1] = (h16)v.y; hv[i * 4 + 2] = (h16)v.z; hv[i * 4 + 3] = (h16)v.w;
      }
      h16x8* xo = (h16x8*)(xb + (long)row * DM + lane * 16);
      h16x8 o0, o1;
      for (int i = 0; i < 8; ++i) { o0[i] = hv[i]; o1[i] = hv[8 + i]; }
      xo[0] = o0; xo[1] = o1;
      s += __shfl_xor(s, 1);
      s += __shfl_xor(s, 2);
      if ((lane & 3) == 0) ssq[(long)row * 16 + (lane >> 2)] = s;
    }
  }
  const int gt = blockIdx.x * NT + tid, ngt = gridDim.x * NT;
  for (int i = gt; i < DEPTH * 32 * 64; i += ngt) {
    int l = i / 2048, g = (i / 64) % 32;
    double are = p.in[6][i], aim = p.in[7][i];
    double dt = exp((double)p.in[8][l * 32 + g]);
    double er = exp(are * dt), abr = er * cos(aim * dt), abi = er * sin(aim * dt);
    ((float2*)(p.ws + O_ABAR))[i] = make_float2((float)abr, (float)abi);
    double nr = abr - 1.0, ni = abi, den = are * are + aim * aim;
    double fr = (nr * are + ni * aim) / den, fi = (ni * are - nr * aim) / den;
    float2* bb = (float2*)(p.ws + O_BBAR) + (size_t)i * 16;
    for (int q = 0; q < 16; ++q) {
      double br = p.in[9][(size_t)i * 16 + q], bi = p.in[10][(size_t)i * 16 + q];
      bb[q] = make_float2((float)((fr * br - fi * bi) / dt), (float)((fr * bi + fi * br) / dt));
    }
  }
  for (int i = gt; i < 128 * 65 * 64; i += ngt) {
    int n = i & 63, j = (i >> 6) % 65, lg = i / (65 * 64);
    double are = p.in[6][lg * 64 + n], aim = p.in[7][lg * 64 + n];
    double dt = exp((double)p.in[8][lg]);
    double er = exp(are * dt * j), ang = aim * dt * j;
    ((double2*)(p.ws + O_APOW))[i] = make_double2(er * cos(ang), er * sin(ang));
  }
  for (int i = gt; i < DEPTH * 2 * 128; i += ngt) {
    int ls = i / 128, j = i % 128;
    const float* pos = p.in[16] + (size_t)ls * 2048;
    const float* w1 = p.in[17] + (size_t)ls * 2048 * 128;
    float a = 0.f;
    for (int k = 0; k < 2048; ++k) a += pos[k] * w1[(long)k * 128 + j];
    ((float*)(p.ws + O_BIAS1))[i] = a;
  }
  for (int d = gt; d < 8192; d += ngt) {
    int bk;
    if (d < 16) bk = d;
    else {
      float nf = (float)d;
      int large = 16 + (int)(logf(nf / 16.0f) / 4.1588830833596715f * 16.0f);
      bk = large < 31 ? large : 31;
    }
    ((int*)(p.ws + O_LUT))[d] = bk;
  }
}

__device__ void phase0b(const Params& p) {
  const int gt = blockIdx.x * NT + threadIdx.x, ngt = gridDim.x * NT;
  const double2* apow = (const double2*)(p.ws + O_APOW);
  const float2* bbs = (const float2*)(p.ws + O_BBAR);
  for (int i = gt; i < 128 * 64 * 64; i += ngt) {
    int tau = i & 63, n = (i >> 6) & 63, lg = i >> 12;
    double2 ap = apow[(lg * 65 + (63 - tau)) * 64 + n];
    const float2* bb = bbs + (size_t)(lg * 64 + n) * 16;
    h16x8 re0, re1, im0, im1;
#pragma unroll
    for (int q = 0; q < 8; ++q) {
      float2 b0 = bb[q], b1 = bb[8 + q];
      re0[q] = (h16)(float)(ap.x * b0.x - ap.y * b0.y);
      im0[q] = (h16)(float)(ap.x * b0.y + ap.y * b0.x);
      re1[q] = (h16)(float)(ap.x * b1.x - ap.y * b1.y);
      im1[q] = (h16)(float)(ap.x * b1.y + ap.y * b1.x);
    }
    h16* W1 = (h16*)(p.ws + O_W1 + (size_t)lg * SZ_W13);
    *(h16x8*)(W1 + ((size_t)(2 * tau) * 128 + 2 * n) * 8) = re0;
    *(h16x8*)(W1 + ((size_t)(2 * tau) * 128 + 2 * n + 1) * 8) = im0;
    *(h16x8*)(W1 + ((size_t)(2 * tau + 1) * 128 + 2 * n) * 8) = re1;
    *(h16x8*)(W1 + ((size_t)(2 * tau + 1) * 128 + 2 * n + 1) * 8) = im1;
  }
  for (int i = gt; i < 128 * 64 * 16 * 16; i += ngt) {
    int pp = i & 15, kc = (i >> 4) & 15, tau = (i >> 8) & 63, lg = i >> 14;
    h16x8 v;
#pragma unroll
    for (int e = 0; e < 4; ++e) {
      int n = 4 * kc + e;
      double2 ap = apow[(lg * 65 + tau + 1) * 64 + n];
      double cr = p.in[11][((size_t)lg * 16 + pp) * 64 + n], ci = p.in[12][((size_t)lg * 16 + pp) * 64 + n];
      v[2 * e] = (h16)(float)(cr * ap.x - ci * ap.y);
      v[2 * e + 1] = (h16)(float)(-(cr * ap.y + ci * ap.x));
    }
    h16* W3 = (h16*)(p.ws + O_W3 + (size_t)lg * SZ_W13);
    *(h16x8*)(W3 + ((size_t)((tau * 16 + kc) * 16) + pp) * 8) = v;
  }
  for (int i = gt; i < 128 * 65 * 16; i += ngt) {
    int pp = i & 15, slot = (i >> 4) % 65, lg = i / (65 * 16);
    float acc[16];
#pragma unroll
    for (int q = 0; q < 16; ++q) acc[q] = 0.f;
    if (slot > 0) {
      for (int n = 0; n < 64; ++n) {
        double2 ap = apow[(lg * 65 + slot - 1) * 64 + n];
        double cr = p.in[11][((size_t)lg * 16 + pp) * 64 + n], ci = p.in[12][((size_t)lg * 16 + pp) * 64 + n];
        float xr = (float)(cr * ap.x - ci * ap.y), xi = (float)(cr * ap.y + ci * ap.x);
        const float2* bb = bbs + (size_t)(lg * 64 + n) * 16;
#pragma unroll
        for (int q = 0; q < 16; ++q) { float2 b = bb[q]; acc[q] += xr * b.x - xi * b.y; }
      }
    }
    h16x8 v0, v1;
#pragma unroll
    for (int q = 0; q < 8; ++q) { v0[q] = (h16)acc[q]; v1[q] = (h16)acc[8 + q]; }
    h16* kt = (h16*)(p.ws + O_KTAB + (size_t)lg * SZ_KTAB) + slot * 256 + pp * 16;
    *(h16x8*)kt = v0;
    *(h16x8*)(kt + 8) = v1;
  }
  for (int i = gt; i < 128 * 64; i += ngt) {
    double2 ap = apow[((i >> 6) * 65 + 64) * 64 + (i & 63)];
    ((float2*)(p.ws + O_AT))[i] = make_float2((float)ap.x, (float)ap.y);
  }
}

__device__ void ssm_endstates(const Params& p, int l) {
  const int tid = opaque_tid(), lane = tid & 63, w = tid >> 6;
  const int gw = blockIdx.x * NW + w, nw = gridDim.x * NW;
  const h16* P = (const h16*)(p.ws + O_P);
  float* E = (float*)(p.ws + O_E);
  for (int unit = gw; unit < 32 * 32; unit += nw) {
    int g = unit >> 5, ctile = unit & 31;
    const h16* W1 = (const h16*)(p.ws + O_W1 + (size_t)(l * 32 + g) * SZ_W13);
    int gch = ctile * 16 + (lane & 15);
    const h16* ub = P + (size_t)gch * 64 * IWP + OFF_U + g * 16 + ((lane >> 4) & 1) * 8 + (size_t)(lane >> 5) * IWP;
    f32x4 acc[8];
#pragma unroll
    for (int mt = 0; mt < 8; ++mt) acc[mt] = f32x4{0.f, 0.f, 0.f, 0.f};
#pragma unroll 2
    for (int ks = 0; ks < 32; ++ks) {
      h16x8 B = *(const h16x8*)(ub + (size_t)(ks * 2) * IWP);
#pragma unroll
      for (int mt = 0; mt < 8; ++mt) {
        h16x8 A = *(const h16x8*)(W1 + ((size_t)(ks * 4 + (lane >> 4)) * 128 + mt * 16 + (lane & 15)) * 8);
        acc[mt] = __builtin_amdgcn_mfma_f32_16x16x32_f16(A, B, acc[mt], 0, 0, 0);
      }
    }
#pragma unroll
    for (int mt = 0; mt < 8; ++mt)
      *(f32x4*)(E + ((size_t)gch * 32 + g) * 128 + mt * 16 + (lane >> 4) * 4) = acc[mt];
  }
}

constexpr int BU_PITCH = 1032, BS_PITCH = 136;
constexpr int SSMY_LDS = 65 * 512 + 16 * BU_PITCH * 2 + 16 * BS_PITCH * 2;
__device__ void ssm_outputs(const Params& p, int l, char* lds) {
  const int tid = opaque_tid(), lane = tid & 63, w = tid >> 6;
  h16* Kt = (h16*)lds;
  h16* Bu = (h16*)(lds + 65 * 512);
  h16* Bs = (h16*)(lds + 65 * 512 + 16 * BU_PITCH * 2);
  const h16* P = (const h16*)(p.ws + O_P);
  const float* E = (const float*)(p.ws + O_E);
  h16* Z = (h16*)(p.ws + O_Z);
  for (int unit = blockIdx.x; unit < 1024; unit += gridDim.x) {
    const int g = unit & 31, bc = unit >> 5, b = bc >> 3, ct = bc & 7;
    const int lg = l * 32 + g;
    __syncthreads();
    if (w == 0) {
      float2 at = ((const float2*)(p.ws + O_AT))[lg * 64 + lane];
      const float2* Eb = (const float2*)E + ((size_t)(b * 128) * 32 + g) * 64 + lane;
      float sr = 0.f, si = 0.f;
      const int c0 = ct * 16;
#pragma unroll 8
      for (int c = 0; c < c0; ++c) {
        float2 e = Eb[(size_t)c * 2048];
        float nr = at.x * sr - at.y * si + e.x, ni = at.x * si + at.y * sr + e.y;
        sr = nr; si = ni;
      }
#pragma unroll
      for (int i = 0; i < 16; ++i) {
        Bs[i * BS_PITCH + 2 * lane] = (h16)sr;
        Bs[i * BS_PITCH + 2 * lane + 1] = (h16)si;
        float2 e = Eb[(size_t)(c0 + i) * 2048];
        float nr = at.x * sr - at.y * si + e.x, ni = at.x * si + at.y * sr + e.y;
        sr = nr; si = ni;
      }
    } else {
      const int t2 = tid - 64, n2 = NT - 64;
      const h16x8* ks = (const h16x8*)(p.ws + O_KTAB + (size_t)lg * SZ_KTAB);
      for (int i = t2; i < 65 * 32; i += n2) ((h16x8*)Kt)[i] = ks[i];
      for (int i = t2; i < 2048; i += n2) {
        int tk = i >> 1, hf = i & 1;
        h16x8 v = *(const h16x8*)(P + ((size_t)b * SEQ + ct * 1024 + tk) * IWP + OFF_U + g * 16 + hf * 8);
        *(h16x8*)(Bu + (tk >> 6) * BU_PITCH + (tk & 63) * 16 + hf * 8) = v;
      }
    }
    __syncthreads();
    const float dt = expf(p.in[8][lg]);
    const int col = lane & 15, hi = lane >> 5, qh = (lane >> 4) & 1, p0 = (lane >> 4) * 4;
    const h16* W3 = (const h16*)(p.ws + O_W3 + (size_t)lg * SZ_W13);
    float dsk[4];
    for (int j = 0; j < 4; ++j) dsk[j] = p.in[13][l * 512 + g * 16 + p0 + j];
    for (int r = 0; r < 64 / NW; ++r) {
      const int base = (r >> 1) * 2 * NW;
      const int tau = (r & 1) ? base + 2 * NW - 1 - w : base + w;
      f32x4 acc = {0.f, 0.f, 0.f, 0.f};
      const int nks = tau / 2 + 1;
      for (int i = 0; i < nks; ++i) {
        int j = tau - (2 * i + hi);
        h16x8 A = *(const h16x8*)(Kt + (j + 1) * 256 + (lane & 15) * 16 + qh * 8);
        h16x8 B = *(const h16x8*)(Bu + col * BU_PITCH + (2 * i + hi) * 16 + qh * 8);
        acc = __builtin_amdgcn_mfma_f32_16x16x32_f16(A, B, acc, 0, 0, 0);
      }
#pragma unroll
      for (int ks = 0; ks < 4; ++ks) {
        h16x8 A = *(const h16x8*)(W3 + ((size_t)((tau * 16 + ks * 4 + (lane >> 4)) * 16) + (lane & 15)) * 8);
        h16x8 B = *(const h16x8*)(Bs + col * BS_PITCH + ks * 32 + (lane >> 4) * 8);
        acc = __builtin_amdgcn_mfma_f32_16x16x32_f16(A, B, acc, 0, 0, 0);
      }
      const h16* up = Bu + col * BU_PITCH + tau * 16 + p0;
      size_t tok = ((size_t)b * 128 + ct * 16 + col) * 64 + tau;
      h16 zz[4];
      for (int j = 0; j < 4; ++j) zz[j] = (h16)gelu_tanh(dt * acc[j] + dsk[j] * (float)up[j]);
      typedef __attribute__((ext_vector_type(4))) _Float16 h16x4;
      h16x4 zv = {zz[0], zz[1], zz[2], zz[3]};
      *(h16x4*)(Z + tok * 512 + g * 16 + p0) = zv;
    }
  }
}

__device__ void phase_gemm1(const Params& p, int l, char* lds) {
  h16* SA = (h16*)lds; h16* SB = (h16*)(lds + 8192); float* rsl = (float*)(lds + 24576);
  const h16* A = (const h16*)(p.ws + O_XB);
  const h16* Bt = (const h16*)(p.ws + O_WIN + l * SZ_WIN);
  h16* P = (h16*)(p.ws + O_P);
  const float* ssq = (const float*)(p.ws + O_SSQ);
  const float* qkg = p.in[3] + l * 6 * 64;
  const int tid = opaque_tid(), lane = tid & 63, wid = tid >> 6, wr = wid >> 2, wc = wid & 3, fr = lane & 15, fq = lane >> 4;
  constexpr int NN = IWP / 256;
  for (int t = blockIdx.x; t < (NTOK / 128) * NN; t += gridDim.x) {
    int brow = (t / NN) * 128, bcol = (t % NN) * 256;
    f32x4 acc[4][4];
    zero_acc(acc);
    gemm_kloop(A, DM, Bt, DM, DM, brow, bcol, SA, SB, acc);
    load_rowscale(ssq, brow, 1.f / DM, rsl);
    int hs = (bcol + wc * 64) >> 6;
    int gi = -1;
    if (hs < 4) gi = 0; else if (hs < 6) gi = 1; else if (hs >= 16 && hs < 20) gi = 2; else if (hs == 22) gi = 4; else if (hs == 24) gi = 5;
    bool gate = (hs == 26);
    float gv[4] = {1.f, 1.f, 1.f, 1.f};
    if (gi >= 0) for (int n = 0; n < 4; ++n) gv[n] = qkg[gi * 64 + n * 16 + fr];
#pragma unroll
    for (int m = 0; m < 4; ++m)
#pragma unroll
      for (int j = 0; j < 4; ++j) {
        int rl = wr * 64 + m * 16 + fq * 4 + j;
        float r = rsl[rl];
        float v[4];
        for (int n = 0; n < 4; ++n) v[n] = acc[m][n][j] * r;
        if (gi >= 0) {
          float ss = v[0] * v[0] + v[1] * v[1] + v[2] * v[2] + v[3] * v[3];
          ss += __shfl_xor(ss, 1); ss += __shfl_xor(ss, 2); ss += __shfl_xor(ss, 4); ss += __shfl_xor(ss, 8);
          float sc = rsqrtf(ss * (1.f / 64.f) + EPS);
          for (int n = 0; n < 4; ++n) v[n] *= sc * gv[n];
        } else if (gate) {
          for (int n = 0; n < 4; ++n) v[n] = (n * 16 + fr) < 12 ? sigmoidf(v[n]) : 0.f;
        }
        for (int n = 0; n < 4; ++n) P[(long)(brow + rl) * IWP + bcol + wc * 64 + n * 16 + fr] = (h16)v[n];
      }
    __syncthreads();
  }
}

__device__ void phase_glu(const Params& p, int l, char* lds) {
  h16* SA = (h16*)lds; h16* SB = (h16*)(lds + 8192);
  const h16* A = (const h16*)(p.ws + O_Z);
  const h16* Bt = (const h16*)(p.ws + O_WGLU + l * SZ_WGLU);
  h16* OB = (h16*)(p.ws + O_OB);
  float* ssqb = (float*)(p.ws + O_SSQB);
  const float* gb = p.in[15] + l * 1024;
  const int tid = opaque_tid(), lane = tid & 63, wid = tid >> 6, wr = wid >> 2, wc = wid & 3, fr = lane & 15, fq = lane >> 4;
  constexpr int NN = 4;
  for (int t = blockIdx.x; t < (NTOK / 128) * NN; t += gridDim.x) {
    int brow = (t / NN) * 128, bcol = (t % NN) * 256;
    f32x4 acc[4][4];
    zero_acc(acc);
    gemm_kloop(A, 512, Bt, 512, 512, brow, bcol, SA, SB, acc);
    int ocb = (bcol + wc * 64) / 2;
    float ba[2], bb[2];
    for (int np = 0; np < 2; ++np) { ba[np] = gb[ocb + np * 16 + fr]; bb[np] = gb[512 + ocb + np * 16 + fr]; }
#pragma unroll
    for (int m = 0; m < 4; ++m)
#pragma unroll
      for (int j = 0; j < 4; ++j) {
        int row = brow + wr * 64 + m * 16 + fq * 4 + j;
        float ss = 0.f;
        for (int np = 0; np < 2; ++np) {
          float a = acc[m][2 * np][j] + ba[np], b = acc[m][2 * np + 1][j] + bb[np];
          float o = a * sigmoidf(b);
          OB[(long)row * 512 + ocb + np * 16 + fr] = (h16)o;
          ss += o * o;
        }
        ss += __shfl_xor(ss, 1); ss += __shfl_xor(ss, 2); ss += __shfl_xor(ss, 4); ss += __shfl_xor(ss, 8);
        if (fr == 0) ssqb[(long)row * 16 + ((bcol + wc * 64) >> 6)] = ss;
      }
  }
}

__device__ void phase_wout(const Params& p, int l, char* lds) {
  h16* SA = (h16*)lds; h16* SB = (h16*)(lds + 8192); float* rsl = (float*)(lds + 24576);
  const h16* A1 = (const h16*)(p.ws + O_OB);
  const h16* A2 = (const h16*)(p.ws + O_OAC);
  const h16* Bt = (const h16*)(p.ws + O_WOUT + l * SZ_WOUT);
  const float* ssqb = (const float*)(p.ws + O_SSQB);
  const float* xsrc = (l == 0) ? p.in[0] : p.out;
  float* xo = p.out;
  h16* xb = (h16*)(p.ws + O_XB);
  float* ssq = (float*)(p.ws + O_SSQ);
  const int tid = opaque_tid(), lane = tid & 63, wid = tid >> 6, wr = wid >> 2, wc = wid & 3, fr = lane & 15, fq = lane >> 4;
  constexpr int NN = 4;
  for (int t = blockIdx.x; t < (NTOK / 128) * NN; t += gridDim.x) {
    int brow = (t / NN) * 128, bcol = (t % NN) * 256;
    f32x4 acc[4][4];
    zero_acc(acc);
    load_rowscale(ssqb, brow, 1.f / 512.f, rsl);
    gemm_kloop(A1, 512, Bt, DM, 512, brow, bcol, SA, SB, acc);
#pragma unroll
    for (int m = 0; m < 4; ++m)
#pragma unroll
      for (int j = 0; j < 4; ++j) {
        float r = rsl[wr * 64 + m * 16 + fq * 4 + j];
        for (int n = 0; n < 4; ++n) acc[m][n][j] *= r;
      }
    gemm_kloop(A2, 512, Bt + 512, DM, 512, brow, bcol, SA, SB, acc);
#pragma unroll
    for (int m = 0; m < 4; ++m)
#pragma unroll
      for (int j = 0; j < 4; ++j) {
        int row = brow + wr * 64 + m * 16 + fq * 4 + j;
        float ss = 0.f;
        for (int n = 0; n < 4; ++n) {
          long idx = (long)row * DM + bcol + wc * 64 + n * 16 + fr;
          float xn = xsrc[idx] + acc[m][n][j];
          xo[idx] = xn;
          xb[idx] = (h16)xn;
          ss += xn * xn;
        }
        ss += __shfl_xor(ss, 1); ss += __shfl_xor(ss, 2); ss += __shfl_xor(ss, 4); ss += __shfl_xor(ss, 8);
        if (fr == 0) ssq[(long)row * 16 + ((bcol + wc * 64) >> 6)] = ss;
      }
    __syncthreads();
  }
}

__device__ void phase_up(const Params& p, int l, char* lds) {
  h16* SA = (h16*)lds; h16* SB = (h16*)(lds + 8192); float* rsl = (float*)(lds + 24576);
  const h16* A = (const h16*)(p.ws + O_XB);
  const h16* Bt = (const h16*)(p.ws + O_WUP + l * SZ_WUP);
  h16* hid = (h16*)(p.ws + O_HID);
  const float* ssq = (const float*)(p.ws + O_SSQ);
  const int tid = opaque_tid(), lane = tid & 63, wid = tid >> 6, wr = wid >> 2, wc = wid & 3, fr = lane & 15, fq = lane >> 4;
  constexpr int NN = DFF / 256;
  for (int t = blockIdx.x; t < (NTOK / 128) * NN; t += gridDim.x) {
    int brow = (t / NN) * 128, bcol = (t % NN) * 256;
    f32x4 acc[4][4];
    zero_acc(acc);
    gemm_kloop(A, DM, Bt, DM, DM, brow, bcol, SA, SB, acc);
    load_rowscale(ssq, brow, 1.f / DM, rsl);
#pragma unroll
    for (int m = 0; m < 4; ++m)
#pragma unroll
      for (int j = 0; j < 4; ++j) {
        int rl = wr * 64 + m * 16 + fq * 4 + j;
        float r = rsl[rl];
        for (int n = 0; n < 4; ++n) {
          float v = fmaxf(acc[m][n][j] * r, 0.f);
          hid[(long)(brow + rl) * DFF + bcol + wc * 64 + n * 16 + fr] = (h16)(v * v);
        }
      }
    __syncthreads();
  }
}

__device__ void phase_down(const Params& p, int l, char* lds) {
  h16* SA = (h16*)lds; h16* SB = (h16*)(lds + 8192);
  const h16* A = (const h16*)(p.ws + O_HID);
  const h16* Bt = (const h16*)(p.ws + O_WDN + l * SZ_WDN);
  float* xo = p.out;
  h16* xb = (h16*)(p.ws + O_XB);
  float* ssq = (float*)(p.ws + O_SSQ);
  const int tid = opaque_tid(), lane = tid & 63, wid = tid >> 6, wr = wid >> 2, wc = wid & 3, fr = lane & 15, fq = lane >> 4;
  constexpr int NN = 4;
  for (int t = blockIdx.x; t < (NTOK / 128) * NN; t += gridDim.x) {
    int brow = (t / NN) * 128, bcol = (t % NN) * 256;
    f32x4 acc[4][4];
    zero_acc(acc);
    gemm_kloop(A, DFF, Bt, DFF, DFF, brow, bcol, SA, SB, acc);
#pragma unroll
    for (int m = 0; m < 4; ++m)
#pragma unroll
      for (int j = 0; j < 4; ++j) {
        int row = brow + wr * 64 + m * 16 + fq * 4 + j;
        float ss = 0.f;
        for (int n = 0; n < 4; ++n) {
          long idx = (long)row * DM + bcol + wc * 64 + n * 16 + fr;
          float xn = xo[idx] + acc[m][n][j];
          xo[idx] = xn;
          xb[idx] = (h16)xn;
          ss += xn * xn;
        }
        ss += __shfl_xor(ss, 1); ss += __shfl_xor(ss, 2); ss += __shfl_xor(ss, 4); ss += __shfl_xor(ss, 8);
        if (fr == 0) ssq[(long)row * 16 + ((bcol + wc * 64) >> 6)] = ss;
      }
  }
}

constexpr int KP = 72;
enum { M_SWA = 0, M_WIN = 1, M_SEL = 2, M_CMPA = 3, M_CMPB = 4 };
struct RowState { float m[4], l[4]; };

__device__ __forceinline__ h16x8 ld_row8(const h16* base, int ld, int row, int nrows, int c8) {
  h16x8 z = {0, 0, 0, 0, 0, 0, 0, 0};
  return (row >= 0 && row < nrows) ? *(const h16x8*)(base + (size_t)row * ld + c8 * 8) : z;
}
__device__ __forceinline__ void st_k(h16* Ks, int row, int c8, h16x8 v) { *(h16x8*)(Ks + row * KP + c8 * 8) = v; }
__device__ __forceinline__ void st_vt(h16* Vt, int row, int c8, h16x8 v) {
#pragma unroll
  for (int e = 0; e < 8; ++e) Vt[(c8 * 8 + e) * KP + row] = v[e];
}

template <int MODE, int RGM>
__device__ __forceinline__ void attn_tile(const h16x8 (&Q)[2][2], f32x4 (&O)[2][4], RowState (&st)[2], const h16* Ks,
                                          const h16* Vt, h16* Pb, const float* biasT, const int (&tq)[2], int head,
                                          int kbase, const bool (&selbit)[2], float (&hp)[2][4]) {
  const int lane = threadIdx.x & 63, col = lane & 15, q4 = lane >> 4;
  f32x4 S[2][4];
#pragma unroll
  for (int kt = 0; kt < 4; ++kt) {
#pragma unroll
    for (int rg = 0; rg < 2; ++rg) S[rg][kt] = f32x4{0.f, 0.f, 0.f, 0.f};
#pragma unroll
    for (int ks = 0; ks < 2; ++ks) {
      h16x8 B = *(const h16x8*)(Ks + (kt * 16 + col) * KP + ks * 32 + q4 * 8);
#pragma unroll
      for (int rg = 0; rg < 2; ++rg)
        if (RGM & (1 << rg)) S[rg][kt] = __builtin_amdgcn_mfma_f32_16x16x32_f16(Q[rg][ks], B, S[rg][kt], 0, 0, 0);
    }
  }
#pragma unroll
  for (int rg = 0; rg < 2; ++rg) {
    if (!(RGM & (1 << rg))) continue;
#pragma unroll
    for (int kt = 0; kt < 4; ++kt) {
      const int kx = kbase + kt * 16 + col;
      if (MODE == M_SWA) {
#pragma unroll
        for (int j = 0; j < 4; ++j) {
          int dist = tq[rg] + j - kx;
          bool valid = dist >= 0 && dist < 128 && kx >= 0;
          int dc = dist < 0 ? 0 : (dist > 799 ? 799 : dist);
          S[rg][kt][j] = valid ? S[rg][kt][j] * 0.125f + biasT[dc * 4 + head] : -1e30f;
        }
      } else {
        int dist;
        bool valid;
        if (MODE == M_WIN) { dist = tq[rg] - kx; valid = dist >= 0 && dist < 512 && kx >= 0; }
        else if (MODE == M_SEL) { dist = tq[rg] - kx; valid = selbit[rg] && dist >= 0; }
        else { dist = tq[rg] - (16 * kx + 31); valid = dist >= 0 && kx < NCMP; }
        int dc = dist < 0 ? 0 : (dist > 799 ? 799 : dist);
        float4 bv = *(const float4*)(biasT + dc * 4);
        S[rg][kt][0] = valid ? S[rg][kt][0] * 0.125f + bv.x : -1e30f;
        S[rg][kt][1] = valid ? S[rg][kt][1] * 0.125f + bv.y : -1e30f;
        S[rg][kt][2] = valid ? S[rg][kt][2] * 0.125f + bv.z : -1e30f;
        S[rg][kt][3] = valid ? S[rg][kt][3] * 0.125f + bv.w : -1e30f;
      }
    }
    if (MODE == M_CMPB) {
#pragma unroll
      for (int kt = 0; kt < 4; ++kt) {
        float h = 0.f;
#pragma unroll
        for (int j = 0; j < 4; ++j) {
          float pv = __expf(S[rg][kt][j] - st[rg].m[j]) * st[rg].l[j];
          S[rg][kt][j] = pv;
          h += pv;
        }
        hp[rg][kt] = h;
      }
    } else {
#pragma unroll
      for (int j = 0; j < 4; ++j) {
        float mx = fmaxf(fmaxf(S[rg][0][j], S[rg][1][j]), fmaxf(S[rg][2][j], S[rg][3][j]));
        mx = fmaxf(mx, __shfl_xor(mx, 1));
        mx = fmaxf(mx, __shfl_xor(mx, 2));
        mx = fmaxf(mx, __shfl_xor(mx, 4));
        mx = fmaxf(mx, __shfl_xor(mx, 8));
        float mn = fmaxf(st[rg].m[j], mx);
        float corr = __expf(st[rg].m[j] - mn);
        st[rg].m[j] = mn;
        float mm = fmaxf(mn, -1e20f);
        float ls = 0.f;
#pragma unroll
        for (int kt = 0; kt < 4; ++kt) {
          float pv = __expf(S[rg][kt][j] - mm);
          S[rg][kt][j] = pv;
          ls += pv;
        }
        st[rg].l[j] = st[rg].l[j] * corr + ls;
        if (MODE != M_CMPA) {
#pragma unroll
          for (int nt = 0; nt < 4; ++nt) O[rg][nt][j] *= corr;
        }
      }
    }
    if (MODE != M_CMPA) {
#pragma unroll
      for (int kt = 0; kt < 4; ++kt)
#pragma unroll
        for (int j = 0; j < 4; ++j) Pb[rg * 16 * KP + (q4 * 4 + j) * KP + kt * 16 + col] = (h16)S[rg][kt][j];
    }
  }
  if (MODE == M_CMPA) return;
  asm volatile("" ::: "memory");
#pragma unroll
  for (int ks = 0; ks < 2; ++ks) {
    h16x8 A[2];
#pragma unroll
    for (int rg = 0; rg < 2; ++rg)
      if (RGM & (1 << rg)) A[rg] = *(const h16x8*)(Pb + rg * 16 * KP + col * KP + ks * 32 + q4 * 8);
#pragma unroll
    for (int nt = 0; nt < 4; ++nt) {
      h16x8 B = *(const h16x8*)(Vt + (nt * 16 + col) * KP + ks * 32 + q4 * 8);
#pragma unroll
      for (int rg = 0; rg < 2; ++rg)
        if (RGM & (1 << rg)) O[rg][nt] = __builtin_amdgcn_mfma_f32_16x16x32_f16(A[rg], B, O[rg][nt], 0, 0, 0);
    }
  }
  asm volatile("" ::: "memory");
}

__device__ __forceinline__ float red16(float v) {
  v += __shfl_xor(v, 1); v += __shfl_xor(v, 2); v += __shfl_xor(v, 4); v += __shfl_xor(v, 8);
  return v;
}

__device__ void phase_compress(const Params& p, int l) {
  const int tid = opaque_tid(), lane = tid & 63, w = tid >> 6;
  const int gw = blockIdx.x * NW + w, nw = gridDim.x * NW;
  const h16* P = (const h16*)(p.ws + O_P);
  for (int item = gw; item < BATCH * 128 * 2; item += nw) {
    int s = item & 1, mg = (item >> 1) & 127, b = item >> 8;
    const float* w1 = p.in[17] + (size_t)(l * 2 + s) * 2048 * 128;
    const float* w2 = p.in[18] + (size_t)(l * 2 + s) * 128 * 64;
    const float* b1 = (const float*)(p.ws + O_BIAS1) + (l * 2 + s) * 128;
    float a0[4], a1[4];
    for (int mi = 0; mi < 4; ++mi) { a0[mi] = b1[lane]; a1[mi] = b1[64 + lane]; }
    for (int tt = 0; tt < 32; ++tt) {
      float xv[4];
      for (int mi = 0; mi < 4; ++mi) {
        int tok = 16 * (mg * 4 + mi) + tt;
        if (tok > SEQ - 1) tok = SEQ - 1;
        xv[mi] = (float)P[((size_t)b * SEQ + tok) * IWP + OFF_KVC + s * 64 + lane];
      }
      const float* wr = w1 + (size_t)tt * 64 * 128;
#pragma unroll 4
      for (int d = 0; d < 64; ++d) {
        float wa = wr[d * 128 + lane], wb = wr[d * 128 + 64 + lane];
        for (int mi = 0; mi < 4; ++mi) {
          float x = rdlane(xv[mi], d);
          a0[mi] += x * wa; a1[mi] += x * wb;
        }
      }
    }
    for (int mi = 0; mi < 4; ++mi) { a0[mi] = gelu_tanh(a0[mi]); a1[mi] = gelu_tanh(a1[mi]); }
    float o[4] = {0.f, 0.f, 0.f, 0.f};
    for (int j = 0; j < 64; ++j) {
      float wa = w2[j * 64 + lane], wb = w2[(64 + j) * 64 + lane];
      for (int mi = 0; mi < 4; ++mi) o[mi] += rdlane(a0[mi], j) * wa + rdlane(a1[mi], j) * wb;
    }
    for (int mi = 0; mi < 4; ++mi) {
      int m = mg * 4 + mi;
      float v = o[mi];
      if (s == 0) {
        float ss = wave_sum(v * v);
        v = v * rsqrtf(ss * (1.f / 64.f) + EPS) * p.in[3][(l * 6 + 3) * 64 + lane];
      }
      if (m >= NCMP) v = 0.f;
      ((h16*)(p.ws + (s == 0 ? O_KCMP : O_VCMP)))[((size_t)b * 512 + m) * 64 + lane] = (h16)v;
    }
  }
}

constexpr int LDS_BIAS = 800 * 16;
constexpr int LDS_PB = NW * 32 * KP * 2;
__device__ void phase_swa(const Params& p, int l, char* lds) {
  const int tid = opaque_tid(), lane = tid & 63, w = tid >> 6, col = lane & 15, q4 = lane >> 4;
  float* biasT = (float*)lds;
  h16* Pb = (h16*)(lds + LDS_BIAS) + w * 32 * KP;
  h16* KV = (h16*)(lds + LDS_BIAS + LDS_PB);
  float* nrm = (float*)(lds + LDS_BIAS + LDS_PB + 4 * 64 * KP * 2);
  const h16* P = (const h16*)(p.ws + O_P);
  const int* lut = (const int*)(p.ws + O_LUT);
  h16* OAC = (h16*)(p.ws + O_OAC);
  __syncthreads();
  for (int i = tid; i < 3200; i += NT) biasT[i] = p.in[5][lut[i >> 2] * 8 + (i & 3)];
  __syncthreads();
  const int head = w >> 1, kvh = w >> 2;
  const float sink = p.in[4][l * 4 + head];
  const int srow = tid >> 3, c8 = tid & 7;
  float hpd[2][4];
  const bool nosel[2] = {false, false};
  for (int u = blockIdx.x; u < BATCH * 128; u += gridDim.x) {
    const int b = u >> 7, t0 = (u & 127) * 64;
    const h16* Pbat = P + (size_t)b * SEQ * IWP;
    h16x8 Q[2][2];
    int tq[2];
#pragma unroll
    for (int rg = 0; rg < 2; ++rg) {
      const int qb = (w & 1) * 32 + rg * 16;
      const h16* qp = Pbat + (size_t)(t0 + qb + col) * IWP + head * 64 + q4 * 8;
      Q[rg][0] = *(const h16x8*)qp;
      Q[rg][1] = *(const h16x8*)(qp + 32);
      tq[rg] = t0 + qb + q4 * 4;
    }
    f32x4 O[2][4];
    RowState st[2];
#pragma unroll
    for (int rg = 0; rg < 2; ++rg) {
#pragma unroll
      for (int nt = 0; nt < 4; ++nt) O[rg][nt] = f32x4{0.f, 0.f, 0.f, 0.f};
#pragma unroll
      for (int j = 0; j < 4; ++j) { st[rg].m[j] = -1e30f; st[rg].l[j] = 0.f; }
    }
    const int i0 = t0 >= 128 ? 0 : (t0 >= 64 ? 1 : 2);
    h16x8 rk[2], rv[2];
    {
      int sb = t0 - 128 + i0 * 64;
      for (int h2 = 0; h2 < 2; ++h2) {
        rk[h2] = ld_row8(Pbat + 256 + h2 * 64, IWP, sb + srow, SEQ, c8);
        rv[h2] = ld_row8(Pbat + 384 + h2 * 64, IWP, sb + srow, SEQ, c8);
      }
    }
    for (int i = i0; i < 3; ++i) {
      __syncthreads();
      for (int h2 = 0; h2 < 2; ++h2) {
        st_k(KV + h2 * 64 * KP, srow, c8, rk[h2]);
        st_vt(KV + (2 + h2) * 64 * KP, srow, c8, rv[h2]);
      }
      __syncthreads();
      if (i + 1 < 3) {
        int sb = t0 - 128 + (i + 1) * 64;
        for (int h2 = 0; h2 < 2; ++h2) {
          rk[h2] = ld_row8(Pbat + 256 + h2 * 64, IWP, sb + srow, SEQ, c8);
          rv[h2] = ld_row8(Pbat + 384 + h2 * 64, IWP, sb + srow, SEQ, c8);
        }
      }
      const int kb = t0 - 128 + i * 64;
      attn_tile<M_SWA, 3>(Q, O, st, KV + kvh * 64 * KP, KV + (2 + kvh) * 64 * KP, Pb, biasT, tq, head, kb, nosel, hpd);
    }
    __syncthreads();
#pragma unroll
    for (int rg = 0; rg < 2; ++rg) {
      const int qb = (w & 1) * 32 + rg * 16;
#pragma unroll
      for (int j = 0; j < 4; ++j) {
        float lsum = red16(st[rg].l[j]);
        float mn = fmaxf(st[rg].m[j], sink);
        float corr = __expf(st[rg].m[j] - mn);
        float inv = corr / (lsum * corr + __expf(sink - mn));
        float ss = 0.f;
#pragma unroll
        for (int nt = 0; nt < 4; ++nt) { O[rg][nt][j] *= inv; ss += O[rg][nt][j] * O[rg][nt][j]; }
        ss = red16(ss);
        if (col == 0) nrm[head * 64 + qb + q4 * 4 + j] = ss;
      }
    }
    __syncthreads();
#pragma unroll
    for (int rg = 0; rg < 2; ++rg) {
      const int qb = (w & 1) * 32 + rg * 16;
#pragma unroll
      for (int j = 0; j < 4; ++j) {
        const int qi = qb + q4 * 4 + j;
        float tot = nrm[qi] + nrm[64 + qi] + nrm[128 + qi] + nrm[192 + qi];
        float sc = rsqrtf(tot * (1.f / 256.f) + EPS);
#pragma unroll
        for (int nt = 0; nt < 4; ++nt)
          OAC[((size_t)b * SEQ + t0 + qi) * 512 + head * 64 + nt * 16 + col] = (h16)(O[rg][nt][j] * sc);
      }
    }
  }
}

constexpr int LDS_NSA = LDS_BIAS + LDS_PB + 2 * 64 * KP * 2 + NW * 4 * 128 * 4 + 32 * 16;
__device__ void phase_nsa(const Params& p, int l, char* lds) {
  const int tid = opaque_tid(), lane = tid & 63, w = tid >> 6, col = lane & 15, q4 = lane >> 4;
  float* biasT = (float*)lds;
  h16* Pb = (h16*)(lds + LDS_BIAS) + w * 32 * KP;
  h16* Ks = (h16*)(lds + LDS_BIAS + LDS_PB);
  h16* Vt = Ks + 64 * KP;
  float* impw = (float*)(lds + LDS_BIAS + LDS_PB + 2 * 64 * KP * 2) + w * 4 * 128;
  unsigned long long* selm = (unsigned long long*)(lds + LDS_BIAS + LDS_PB + 2 * 64 * KP * 2 + NW * 4 * 128 * 4);
  const h16* P = (const h16*)(p.ws + O_P);
  const int* lut = (const int*)(p.ws + O_LUT);
  h16* OAC = (h16*)(p.ws + O_OAC);
  __syncthreads();
  for (int i = tid; i < 3200; i += NT) biasT[i] = p.in[5][lut[i >> 2] * 8 + 4 + (i & 3)];
  __syncthreads();
  const int srow = tid >> 3, c8 = tid & 7;
  float hpd[2][4];
  const bool nosel[2] = {false, false};
  for (int u = blockIdx.x; u < 1024; u += gridDim.x) {
    const int rnd = u >> 8, b = (u & 255) >> 6, ti = u & 63;
    const int tile = rnd == 0 ? 255 - ti : (rnd == 1 ? 128 + ti : (rnd == 2 ? 127 - ti : ti));
    const int t0 = tile * 32, cur = t0 >> 6;
    const h16* Pbat = P + (size_t)b * SEQ * IWP;
    const h16* KC = (const h16*)(p.ws + O_KCMP) + (size_t)b * 512 * 64;
    const h16* VC = (const h16*)(p.ws + O_VCMP) + (size_t)b * 512 * 64;
    h16x8 Q[2][2];
    int tq[2] = {0, 0};
    {
      const int qi = w * 4 + (col >> 2), hd = col & 3;
      const h16* qp = Pbat + (size_t)(t0 + qi) * IWP + OFF_QC + hd * 64 + q4 * 8;
      Q[0][0] = *(const h16x8*)qp;
      Q[0][1] = *(const h16x8*)(qp + 32);
      tq[0] = t0 + w * 4 + q4;
    }
    for (int i = lane; i < 512; i += 64) impw[i] = 0.f;
    f32x4 O[2][4], Oc[2][4];
    RowState st[2];
    h16x8 rk, rv;
    int mvmax = t0 / 16 + 1;
    if (mvmax > NCMP) mvmax = NCMP;
    const int ntc = (mvmax + 63) >> 6;
#pragma unroll
    for (int rg = 0; rg < 1; ++rg)
#pragma unroll
      for (int j = 0; j < 4; ++j) { st[rg].m[j] = -1e30f; st[rg].l[j] = 0.f; }
    rk = ld_row8(KC, 64, srow, 512, c8);
    for (int i = 0; i < ntc; ++i) {
      __syncthreads();
      st_k(Ks, srow, c8, rk);
      __syncthreads();
      if (i + 1 < ntc) rk = ld_row8(KC, 64, (i + 1) * 64 + srow, 512, c8);
      attn_tile<M_CMPA, 1>(Q, O, st, Ks, Vt, Pb, biasT, tq, 0, i * 64, nosel, hpd);
    }
#pragma unroll
    for (int rg = 0; rg < 1; ++rg)
#pragma unroll
      for (int j = 0; j < 4; ++j) {
        float ls = red16(st[rg].l[j]);
        st[rg].l[j] = ls > 0.f ? 1.f / ls : 0.f;
      }
#pragma unroll
    for (int rg = 0; rg < 1; ++rg)
#pragma unroll
      for (int nt = 0; nt < 4; ++nt) O[rg][nt] = f32x4{0.f, 0.f, 0.f, 0.f};
    float carry[1] = {0.f};
    rk = ld_row8(KC, 64, srow, 512, c8);
    rv = ld_row8(VC, 64, srow, 512, c8);
    for (int i = 0; i < ntc; ++i) {
      __syncthreads();
      st_k(Ks, srow, c8, rk);
      st_vt(Vt, srow, c8, rv);
      __syncthreads();
      if (i + 1 < ntc) {
        rk = ld_row8(KC, 64, (i + 1) * 64 + srow, 512, c8);
        rv = ld_row8(VC, 64, (i + 1) * 64 + srow, 512, c8);
      }
      float hp2[2][4];
      attn_tile<M_CMPB, 1>(Q, O, st, Ks, Vt, Pb, biasT, tq, 0, i * 64, nosel, hp2);
#pragma unroll
      for (int rg = 0; rg < 1; ++rg) {
        float hp[4] = {hp2[rg][0], hp2[rg][1], hp2[rg][2], hp2[rg][3]};
#pragma unroll
        for (int kt = 0; kt < 4; ++kt) {
          float h = hp[kt];
          float qs = h + __shfl_xor(h, 1);
          qs += __shfl_xor(qs, 2);
          float prev = __shfl_up(h, 1);
          float cin = (kt == 0) ? carry[rg] : __shfl(hp[kt > 0 ? kt - 1 : 0], (lane & 48) | 15);
          float pk = (col == 0) ? cin : prev;
          if ((col & 3) == 0) impw[(rg * 4 + q4) * 128 + ((i * 64 + kt * 16 + col) >> 2)] = qs + pk;
        }
        carry[rg] = __shfl(hp[3], (lane & 48) | 15);
      }
    }
#pragma unroll
    for (int rg = 0; rg < 1; ++rg) {
      const h16* gp = Pbat + (size_t)tq[rg] * IWP + OFF_GC;
#pragma unroll
      for (int j = 0; j < 4; ++j) {
        float g0 = (float)gp[j * 3 + 0];
#pragma unroll
        for (int nt = 0; nt < 4; ++nt) Oc[rg][nt][j] = g0 * O[rg][nt][j];
      }
    }
    {
      const int nforced = cur >= 2 ? 3 : cur + 1;
      const int npick = 16 - nforced;
      for (int qi = 0; qi < 4; ++qi) {
        const float* im = impw + qi * 128;
        const int j0 = lane, j1 = lane + 64;
        const float v0 = im[j0], v1 = im[j1];
        int r0 = 0, r1 = 0;
        for (int jp = 1; jp <= cur - 2; ++jp) {
          float vp = im[jp];
          r0 += (vp > v0 || (vp == v0 && jp < j0)) ? 1 : 0;
          r1 += (vp > v1 || (vp == v1 && jp < j1)) ? 1 : 0;
        }
        bool c0 = j0 >= 1 && j0 <= cur - 2, c1 = j1 <= cur - 2;
        bool f0 = j0 == 0 || j0 == cur || j0 == cur - 1, f1 = j1 == cur || j1 == cur - 1;
        unsigned long long mlo = __ballot(f0 || (c0 && r0 < npick));
        unsigned long long mhi = __ballot(f1 || (c1 && r1 < npick));
        if (lane == 0) { selm[(w * 4 + qi) * 2] = mlo; selm[(w * 4 + qi) * 2 + 1] = mhi; }
      }
    }
    asm volatile("" ::: "memory");
    unsigned long long slo[2], shi[2];
#pragma unroll
    for (int rg = 0; rg < 1; ++rg) {
      slo[rg] = selm[(w * 4 + q4) * 2];
      shi[rg] = selm[(w * 4 + q4) * 2 + 1];
    }
#pragma unroll
    for (int rg = 0; rg < 1; ++rg) {
#pragma unroll
      for (int nt = 0; nt < 4; ++nt) O[rg][nt] = f32x4{0.f, 0.f, 0.f, 0.f};
#pragma unroll
      for (int j = 0; j < 4; ++j) { st[rg].m[j] = -1e30f; st[rg].l[j] = 0.f; }
    }
    rk = ld_row8(Pbat + OFF_KVC + 128, IWP, srow, SEQ, c8);
    rv = ld_row8(Pbat + OFF_KVC + 192, IWP, srow, SEQ, c8);
    for (int jb = 0; jb <= cur; ++jb) {
      __syncthreads();
      st_k(Ks, srow, c8, rk);
      st_vt(Vt, srow, c8, rv);
      __syncthreads();
      if (jb + 1 <= cur) {
        rk = ld_row8(Pbat + OFF_KVC + 128, IWP, (jb + 1) * 64 + srow, SEQ, c8);
        rv = ld_row8(Pbat + OFF_KVC + 192, IWP, (jb + 1) * 64 + srow, SEQ, c8);
      }
      bool sb[2] = {false, false};
      sb[0] = ((jb < 64 ? (slo[0] >> jb) : (shi[0] >> (jb - 64))) & 1ull) != 0;
      if (__any(sb[0])) attn_tile<M_SEL, 1>(Q, O, st, Ks, Vt, Pb, biasT, tq, 0, jb * 64, sb, hpd);
    }
#pragma unroll
    for (int rg = 0; rg < 1; ++rg) {
      const h16* gp = Pbat + (size_t)tq[rg] * IWP + OFF_GC;
#pragma unroll
      for (int j = 0; j < 4; ++j) {
        float ls = red16(st[rg].l[j]);
        float f = ls > 0.f ? (float)gp[j * 3 + 1] / ls : 0.f;
#pragma unroll
        for (int nt = 0; nt < 4; ++nt) Oc[rg][nt][j] += f * O[rg][nt][j];
      }
    }
#pragma unroll
    for (int rg = 0; rg < 1; ++rg) {
#pragma unroll
      for (int nt = 0; nt < 4; ++nt) O[rg][nt] = f32x4{0.f, 0.f, 0.f, 0.f};
#pragma unroll
      for (int j = 0; j < 4; ++j) { st[rg].m[j] = -1e30f; st[rg].l[j] = 0.f; }
    }
    const int w0 = cur >= 8 ? cur - 8 : 0;
    rk = ld_row8(Pbat + OFF_KVC + 256, IWP, w0 * 64 + srow, SEQ, c8);
    rv = ld_row8(Pbat + OFF_KVC + 320, IWP, w0 * 64 + srow, SEQ, c8);
    for (int wi = w0; wi <= cur; ++wi) {
      __syncthreads();
      st_k(Ks, srow, c8, rk);
      st_vt(Vt, srow, c8, rv);
      __syncthreads();
      if (wi + 1 <= cur) {
        rk = ld_row8(Pbat + OFF_KVC + 256, IWP, (wi + 1) * 64 + srow, SEQ, c8);
        rv = ld_row8(Pbat + OFF_KVC + 320, IWP, (wi + 1) * 64 + srow, SEQ, c8);
      }
      attn_tile<M_WIN, 1>(Q, O, st, Ks, Vt, Pb, biasT, tq, 0, wi * 64, nosel, hpd);
    }
#pragma unroll
    for (int rg = 0; rg < 1; ++rg) {
      const h16* gp = Pbat + (size_t)tq[rg] * IWP + OFF_GC;
      float ss = 0.f;
#pragma unroll
      for (int j = 0; j < 4; ++j) {
        float ls = red16(st[rg].l[j]);
        float f = ls > 0.f ? (float)gp[j * 3 + 2] / ls : 0.f;
#pragma unroll
        for (int nt = 0; nt < 4; ++nt) {
          float v = Oc[rg][nt][j] + f * O[rg][nt][j];
          Oc[rg][nt][j] = v;
          ss += v * v;
        }
      }
      ss = red16(ss);
      float sc = rsqrtf(ss * (1.f / 256.f) + EPS);
#pragma unroll
      for (int j = 0; j < 4; ++j)
#pragma unroll
        for (int nt = 0; nt < 4; ++nt)
          OAC[((size_t)b * SEQ + tq[rg]) * 512 + 256 + j * 64 + nt * 16 + col] = (h16)(Oc[rg][nt][j] * sc);
    }
  }
}

constexpr int LDS_SWA = LDS_BIAS + LDS_PB + 4 * 64 * KP * 2 + 1024;
constexpr int LDS_GEMM = 8192 + 16384 + 512;
constexpr int lds_max(int a, int b) { return a > b ? a : b; }
constexpr int LDS_BYTES = lds_max(lds_max(LDS_NSA, SSMY_LDS), lds_max(LDS_SWA, lds_max(LDS_GEMM, 64 * 65 * 4)));

__global__ void __launch_bounds__(NT) fwd_megakernel(Params p) {
  cg::grid_group grid = cg::this_grid();
  __shared__ __attribute__((aligned(16))) char lds[LDS_BYTES];
  phase0(p, (float*)lds);
  grid.sync();
  phase0b(p);
  grid.sync();
  for (int l = 0; l < DEPTH; ++l) {
    phase_gemm1(p, l, lds);
    grid.sync();
    ssm_endstates(p, l);
    phase_compress(p, l);
    phase_swa(p, l, lds);
    grid.sync();
    phase_nsa(p, l, lds);
    ssm_outputs(p, l, lds);
    grid.sync();
    phase_glu(p, l, lds);
    grid.sync();
    phase_wout(p, l, lds);
    grid.sync();
    phase_up(p, l, lds);
    grid.sync();
    phase_down(p, l, lds);
    grid.sync();
  }
}

extern "C" void kernel_launch(void* const* d_in, const int* in_sizes, int n_in, void* d_out, int out_size, void* d_ws,
                              size_t ws_size, hipStream_t stream) {
  static int grid_blocks = 0;
  if (!grid_blocks) {
    int dev = 0, cus = 0, per_cu = 0;
    (void)hipGetDevice(&dev);
    (void)hipDeviceGetAttribute(&cus, hipDeviceAttributeMultiprocessorCount, dev);
    (void)hipOccupancyMaxActiveBlocksPerMultiprocessor(&per_cu, fwd_megakernel, NT, 0);
    if (per_cu > 1) per_cu = 1;
    grid_blocks = cus * per_cu;
  }
  if (ws_size < WS_NEED) {
    fprintf(stderr, "workspace too small: %zu < %zu\n", ws_size, WS_NEED);
    return;
  }
  Params p{};
  for (int i = 0; i < 24; ++i) p.in[i] = (const float*)d_in[i];
  p.out = (float*)d_out;
  p.ws = (char*)d_ws;
  void* args[] = {&p};
  hipError_t e = hipLaunchCooperativeKernel((void*)fwd_megakernel, dim3(grid_blocks), dim3(NT), args, 0, stream);
  if (e != hipSuccess) fprintf(stderr, "cooperative launch failed: %s (grid %d)\n", hipGetErrorString(e), grid_blocks);
}
```

```cpp
#include <hip/hip_runtime.h>
#include <hip/hip_cooperative_groups.h>
#include <cstdio>
namespace cg = cooperative_groups;

typedef _Float16 h16;
typedef __attribute__((ext_vector_type(8))) _Float16 h16x8;
typedef __attribute__((ext_vector_type(4))) float f32x4;

constexpr int NT = 512;
constexpr int NW = NT / 64;
constexpr int BATCH = 4, SEQ = 8192, NTOK = BATCH * SEQ, DM = 1024, DEPTH = 4, IW = 1676, IWP = 1792, DFF = 4096;
constexpr int OFF_U = 512, OFF_QC = 1024, OFF_KVC = 1280, OFF_GC = 1664;
constexpr int NCMP = 511;
constexpr float EPS = 1e-6f;

constexpr size_t SZ_WIN = (size_t)IWP * DM * 2, SZ_WGLU = (size_t)1024 * 512 * 2, SZ_WOUT = (size_t)DM * DM * 2,
                 SZ_WUP = (size_t)DFF * DM * 2, SZ_WDN = (size_t)DM * DFF * 2;
constexpr size_t O_WIN = 0;
constexpr size_t O_WGLU = O_WIN + DEPTH * SZ_WIN;
constexpr size_t O_WOUT = O_WGLU + DEPTH * SZ_WGLU;
constexpr size_t O_WUP = O_WOUT + DEPTH * SZ_WOUT;
constexpr size_t O_WDN = O_WUP + DEPTH * SZ_WUP;
constexpr size_t O_XB = O_WDN + DEPTH * SZ_WDN;
constexpr size_t O_SSQ = O_XB + (size_t)NTOK * DM * 2;
constexpr size_t O_SSQB = O_SSQ + (size_t)NTOK * 16 * 4;
constexpr size_t O_KCMP = O_SSQB + (size_t)NTOK * 16 * 4;
constexpr size_t O_VCMP = O_KCMP + (size_t)BATCH * 512 * 64 * 4;
constexpr size_t O_ABAR = O_VCMP + (size_t)BATCH * 512 * 64 * 4;
constexpr size_t O_BBAR = O_ABAR + (size_t)DEPTH * 32 * 64 * 8;
constexpr size_t O_BIAS1 = O_BBAR + (size_t)DEPTH * 32 * 64 * 16 * 8;
constexpr size_t O_LUT = O_BIAS1 + (size_t)DEPTH * 2 * 128 * 4;
constexpr size_t O_AT = O_LUT + 8192 * 4;
constexpr size_t O_KTAB = O_AT + (size_t)128 * 64 * 8;
constexpr size_t SZ_KTAB = (size_t)65 * 256 * 2;
constexpr size_t O_W1 = O_KTAB + 128 * SZ_KTAB;
constexpr size_t SZ_W13 = (size_t)128 * 1024 * 2;
constexpr size_t O_W3 = O_W1 + 128 * SZ_W13;
constexpr size_t O_BIG = (O_W3 + 128 * SZ_W13 + 255) / 256 * 256;
constexpr size_t O_APOW = O_BIG;
constexpr size_t O_P = O_BIG;
constexpr size_t O_Z = O_P + (size_t)NTOK * IWP * 2;
constexpr size_t O_OB = O_Z + (size_t)NTOK * 512 * 2;
constexpr size_t O_OAC = O_OB + (size_t)NTOK * 512 * 2;
constexpr size_t O_E = O_OAC + (size_t)NTOK * 512 * 2;
constexpr size_t O_HID = O_BIG;
constexpr size_t WS_NEED = O_BIG + (size_t)NTOK * DFF * 2;

struct Params {
  const float* in[24];
  float* out;
  char* ws;
};

__device__ __forceinline__ int opaque_tid() {
  int t = threadIdx.x;
  asm volatile("" : "+v"(t));
  return t;
}
template <int CTRL>
__device__ __forceinline__ float dppf(float v) {
  return __int_as_float(__builtin_amdgcn_update_dpp(0, __float_as_int(v), CTRL, 0xF, 0xF, true));
}
__device__ __forceinline__ float sum16(float v) {
  v += dppf<0xB1>(v); v += dppf<0x4E>(v); v += dppf<0x141>(v); v += dppf<0x140>(v);
  return v;
}
__device__ __forceinline__ float max16(float v) {
  v = fmaxf(v, dppf<0xB1>(v)); v = fmaxf(v, dppf<0x4E>(v)); v = fmaxf(v, dppf<0x141>(v)); v = fmaxf(v, dppf<0x140>(v));
  return v;
}
__device__ __forceinline__ float xor16(float v) { return __int_as_float(__builtin_amdgcn_ds_swizzle(__float_as_int(v), 0x401F)); }
__device__ __forceinline__ float rdlane_c(float v, int l) { return __int_as_float(__builtin_amdgcn_readlane(__float_as_int(v), l)); }
__device__ __forceinline__ float wave_sum(float v) {
  v = sum16(v); v += xor16(v);
  return rdlane_c(v, 0) + rdlane_c(v, 32);
}
__device__ __forceinline__ float gelu_tanh(float x) {
  float u = 0.7978845608028654f * (x + 0.044715f * x * x * x);
  return 0.5f * x * (1.f + tanhf(u));
}
__device__ __forceinline__ float sigmoidf(float x) { return 1.f / (1.f + __expf(-x)); }
__device__ __forceinline__ float rdlane(float v, int l) {
  return __int_as_float(__builtin_amdgcn_readlane(__float_as_int(v), l));
}

template <class SrcF>
__device__ __forceinline__ void conv_tile(SrcF src, h16* dst, int ldo, int n0, int k0, float* tile) {
  int tid = opaque_tid();
  for (int idx = tid; idx < 4096; idx += NT) {
    int kk = idx >> 6, nn = idx & 63;
    tile[kk * 65 + nn] = src(k0 + kk, n0 + nn);
  }
  __syncthreads();
  for (int idx = tid; idx < 4096; idx += NT) {
    int nn = idx >> 6, kk = idx & 63;
    dst[(long)(n0 + nn) * ldo + k0 + kk] = (h16)tile[kk * 65 + nn];
  }
  __syncthreads();
}

__device__ void phase0(const Params& p, float* lds) {
  const int tid = opaque_tid();
  constexpr int T_IN = (IWP / 64) * (DM / 64);
  constexpr int T_GLU = 16 * 8;
  constexpr int T_OUT = 16 * 16;
  constexpr int T_UP = 64 * 16;
  constexpr int T_DN = 16 * 64;
  constexpr int T_L = T_IN + T_GLU + T_OUT + T_UP + T_DN;
  for (int ti = blockIdx.x; ti < DEPTH * T_L; ti += gridDim.x) {
    int l = ti / T_L, r = ti % T_L;
    if (r < T_IN) {
      int nt = r / 16, kt = r % 16;
      const float* w = p.in[2] + (size_t)l * DM * IW;
      const float* g = p.in[1] + l * DM;
      conv_tile([&](int k, int sl) {
        int n = (sl & ~255) + 64 * ((sl >> 5) & 3) + 32 * ((sl >> 7) & 1) + (sl & 31);
        return n < IW ? w[(long)k * IW + n] * g[k] : 0.f; },
                (h16*)(p.ws + O_WIN + l * SZ_WIN), DM, nt * 64, kt * 64, lds);
    } else if ((r -= T_IN) < T_GLU) {
      int nt = r / 8, kt = r % 8;
      const float* w = p.in[14] + (size_t)l * 512 * 1024;
      conv_tile([&](int k, int n2) {
        int pn = n2 >> 8, bj = (n2 >> 7) & 1, wc = (n2 >> 5) & 3, nn = (n2 >> 4) & 1, r = n2 & 15;
        int n = (nn ? 512 : 0) + 128 * pn + 64 * bj + 16 * wc + r;
        return w[(long)k * 1024 + n]; },
                (h16*)(p.ws + O_WGLU + l * SZ_WGLU), 512, nt * 64, kt * 64, lds);
    } else if ((r -= T_GLU) < T_OUT) {
      int seg = r / 128, nt = (r % 128) / 8, kt = r % 8;
      const float* w = p.in[20] + (size_t)l * DM * DM;
      const float* g = p.in[19] + l * DM;
      conv_tile([&](int k2, int n) {
        int k = seg == 0 ? 256 + k2 : (k2 < 256 ? k2 : 512 + k2);
        return w[(long)k * DM + n] * g[k]; },
                (h16*)(p.ws + O_WOUT + l * SZ_WOUT + (size_t)seg * DM * 512 * 2), 512, nt * 64, kt * 64, lds);
    } else if ((r -= T_OUT) < T_UP) {
      int nt = r / 16, kt = r % 16;
      const float* w = p.in[22] + (size_t)l * DM * DFF;
      const float* g = p.in[21] + l * DM;
      conv_tile([&](int k, int n) { return w[(long)k * DFF + n] * g[k]; },
                (h16*)(p.ws + O_WUP + l * SZ_WUP), DM, nt * 64, kt * 64, lds);
    } else {
      r -= T_UP;
      int nt = r / 64, kt = r % 64;
      const float* w = p.in[23] + (size_t)l * DFF * DM;
      conv_tile([&](int k, int n) { return w[(long)k * DM + n]; },
                (h16*)(p.ws + O_WDN + l * SZ_WDN), DFF, nt * 64, kt * 64, lds);
    }
  }
  {
    const int lane = tid & 63;
    const int gw = blockIdx.x * NW + (tid >> 6), nw = gridDim.x * NW;
    const float* x = p.in[0];
    h16* xb = (h16*)(p.ws + O_XB);
    float* ssq = (float*)(p.ws + O_SSQ);
    for (int row = gw; row < NTOK; row += nw) {
      const float4* xr = (const float4*)(x + (long)row * DM + lane * 16);
      float s = 0.f;
      h16 hv[16];
      for (int i = 0; i < 4; ++i) {
        float4 v = xr[i];
        s += v.x * v.x + v.y * v.y + v.z * v.z + v.w * v.w;
        hv[i * 4 + 0] = (h16)v.x; hv[i * 4 + 1] = (h16)v.y; hv[i * 4 + 2] = (h16)v.z; hv[i * 4 + 3] = (h16)v.w;
      }
      h16x8* xo = (h16x8*)(xb + (long)row * DM + lane * 16);
      h16x8 o0, o1;
      for (int i = 0; i < 8; ++i) { o0[i] = hv[i]; o1[i] = hv[8 + i]; }
      xo[0] = o0; xo[1] = o1;
      s += dppf<0xB1>(s);
      s += dppf<0x4E>(s);
      if ((lane & 3) == 0) ssq[(long)row * 16 + (lane >> 2)] = s;
    }
  }
  const int gt = blockIdx.x * NT + tid, ngt = gridDim.x * NT;
  for (int i = gt; i < DEPTH * 32 * 64; i += ngt) {
    int l = i / 2048, g = (i / 64) % 32;
    double are = p.in[6][i], aim = p.in[7][i];
    double dt = exp((double)p.in[8][l * 32 + g]);
    double er = exp(are * dt), abr = er * cos(aim * dt), abi = er * sin(aim * dt);
    ((float2*)(p.ws + O_ABAR))[i] = make_float2((float)abr, (float)abi);
    double nr = abr - 1.0, ni = abi, den = are * are + aim * aim;
    double fr = (nr * are + ni * aim) / den, fi = (ni * are - nr * aim) / den;
    float2* bb = (float2*)(p.ws + O_BBAR) + (size_t)i * 16;
    for (int q = 0; q < 16; ++q) {
      double br = p.in[9][(size_t)i * 16 + q], bi = p.in[10][(size_t)i * 16 + q];
      bb[q] = make_float2((float)((fr * br - fi * bi) / dt), (float)((fr * bi + fi * br) / dt));
    }
  }
  for (int i = gt; i < 128 * 65 * 64; i += ngt) {
    int n = i & 63, j = (i >> 6) % 65, lg = i / (65 * 64);
    double are = p.in[6][lg * 64 + n], aim = p.in[7][lg * 64 + n];
    double dt = exp((double)p.in[8][lg]);
    double er = exp(are * dt * j), ang = aim * dt * j;
    ((double2*)(p.ws + O_APOW))[i] = make_double2(er * cos(ang), er * sin(ang));
  }
  for (int i = gt; i < DEPTH * 2 * 128; i += ngt) {
    int ls = i / 128, j = i % 128;
    const float* pos = p.in[16] + (size_t)ls * 2048;
    const float* w1 = p.in[17] + (size_t)ls * 2048 * 128;
    float a = 0.f;
    for (int k = 0; k < 2048; ++k) a += pos[k] * w1[(long)k * 128 + j];
    ((float*)(p.ws + O_BIAS1))[i] = a;
  }
  for (int d = gt; d < 8192; d += ngt) {
    int bk;
    if (d < 16) bk = d;
    else {
      float nf = (float)d;
      int large = 16 + (int)(logf(nf / 16.0f) / 4.1588830833596715f * 16.0f);
      bk = large < 31 ? large : 31;
    }
    ((int*)(p.ws + O_LUT))[d] = bk;
  }
}

__device__ void phase0b(const Params& p) {
  const int gt = blockIdx.x * NT + threadIdx.x, ngt = gridDim.x * NT;
  const double2* apow = (const double2*)(p.ws + O_APOW);
  const float2* bbs = (const float2*)(p.ws + O_BBAR);
  for (int i = gt; i < 128 * 64 * 64; i += ngt) {
    int tau = i & 63, n = (i >> 6) & 63, lg = i >> 12;
    double2 ap = apow[(lg * 65 + (63 - tau)) * 64 + n];
    const float2* bb = bbs + (size_t)(lg * 64 + n) * 16;
    h16x8 re0, re1, im0, im1;
#pragma unroll
    for (int q = 0; q < 8; ++q) {
      float2 b0 = bb[q], b1 = bb[8 + q];
      re0[q] = (h16)(float)(ap.x * b0.x - ap.y * b0.y);
      im0[q] = (h16)(float)(ap.x * b0.y + ap.y * b0.x);
      re1[q] = (h16)(float)(ap.x * b1.x - ap.y * b1.y);
      im1[q] = (h16)(float)(ap.x * b1.y + ap.y * b1.x);
    }
    h16* W1 = (h16*)(p.ws + O_W1 + (size_t)lg * SZ_W13);
    *(h16x8*)(W1 + ((size_t)(2 * tau) * 128 + 2 * n) * 8) = re0;
    *(h16x8*)(W1 + ((size_t)(2 * tau) * 128 + 2 * n + 1) * 8) = im0;
    *(h16x8*)(W1 + ((size_t)(2 * tau + 1) * 128 + 2 * n) * 8) = re1;
    *(h16x8*)(W1 + ((size_t)(2 * tau + 1) * 128 + 2 * n + 1) * 8) = im1;
  }
  for (int i = gt; i < 128 * 64 * 16 * 16; i += ngt) {
    int pp = i & 15, kc = (i >> 4) & 15, tau = (i >> 8) & 63, lg = i >> 14;
    h16x8 v;
#pragma unroll
    for (int e = 0; e < 4; ++e) {
      int n = 4 * kc + e;
      double2 ap = apow[(lg * 65 + tau + 1) * 64 + n];
      double cr = p.in[11][((size_t)lg * 16 + pp) * 64 + n], ci = p.in[12][((size_t)lg * 16 + pp) * 64 + n];
      v[2 * e] = (h16)(float)(cr * ap.x - ci * ap.y);
      v[2 * e + 1] = (h16)(float)(-(cr * ap.y + ci * ap.x));
    }
    h16* W3 = (h16*)(p.ws + O_W3 + (size_t)lg * SZ_W13);
    *(h16x8*)(W3 + ((size_t)((tau * 16 + kc) * 16) + pp) * 8) = v;
  }
  for (int i = gt; i < 128 * 65 * 16; i += ngt) {
    int pp = i & 15, slot = (i >> 4) % 65, lg = i / (65 * 16);
    float acc[16];
#pragma unroll
    for (int q = 0; q < 16; ++q) acc[q] = 0.f;
    if (slot > 0) {
      for (int n = 0; n < 64; ++n) {
        double2 ap = apow[(lg * 65 + slot - 1) * 64 + n];
        double cr = p.in[11][((size_t)lg * 16 + pp) * 64 + n], ci = p.in[12][((size_t)lg * 16 + pp) * 64 + n];
        float xr = (float)(cr * ap.x - ci * ap.y), xi = (float)(cr * ap.y + ci * ap.x);
        const float2* bb = bbs + (size_t)(lg * 64 + n) * 16;
#pragma unroll
        for (int q = 0; q < 16; ++q) { float2 b = bb[q]; acc[q] += xr * b.x - xi * b.y; }
      }
    }
    h16x8 v0, v1;
#pragma unroll
    for (int q = 0; q < 8; ++q) { v0[q] = (h16)acc[q]; v1[q] = (h16)acc[8 + q]; }
    h16* kt = (h16*)(p.ws + O_KTAB + (size_t)lg * SZ_KTAB) + slot * 256 + pp * 16;
    *(h16x8*)kt = v0;
    *(h16x8*)(kt + 8) = v1;
  }
  for (int i = gt; i < 128 * 64; i += ngt) {
    double2 ap = apow[((i >> 6) * 65 + 64) * 64 + (i & 63)];
    ((float2*)(p.ws + O_AT))[i] = make_float2((float)ap.x, (float)ap.y);
  }
}

__device__ void ssm_endstates(const Params& p, int l) {
  const int tid = opaque_tid(), lane = tid & 63, w = tid >> 6;
  const int gw = blockIdx.x * NW + w, nw = gridDim.x * NW;
  const h16* P = (const h16*)(p.ws + O_P);
  float* E = (float*)(p.ws + O_E);
  for (int unit = gw; unit < 32 * 32; unit += nw) {
    int g = unit >> 5, ctile = unit & 31;
    const h16* W1 = (const h16*)(p.ws + O_W1 + (size_t)(l * 32 + g) * SZ_W13);
    int gch = ctile * 16 + (lane & 15);
    const h16* ub = P + (size_t)gch * 64 * IWP + OFF_U + g * 16 + ((lane >> 4) & 1) * 8 + (size_t)(lane >> 5) * IWP;
    f32x4 acc[8];
#pragma unroll
    for (int mt = 0; mt < 8; ++mt) acc[mt] = f32x4{0.f, 0.f, 0.f, 0.f};
#pragma unroll 2
    for (int ks = 0; ks < 32; ++ks) {
      h16x8 B = *(const h16x8*)(ub + (size_t)(ks * 2) * IWP);
#pragma unroll
      for (int mt = 0; mt < 8; ++mt) {
        h16x8 A = *(const h16x8*)(W1 + ((size_t)(ks * 4 + (lane >> 4)) * 128 + mt * 16 + (lane & 15)) * 8);
        acc[mt] = __builtin_amdgcn_mfma_f32_16x16x32_f16(A, B, acc[mt], 0, 0, 0);
      }
    }
#pragma unroll
    for (int mt = 0; mt < 8; ++mt)
      *(f32x4*)(E + ((size_t)gch * 32 + g) * 128 + mt * 16 + (lane >> 4) * 4) = acc[mt];
  }
}

constexpr int BU_PITCH = 1032, BS_PITCH = 136;
constexpr int SSMY_LDS = 65 * 512 + 16 * BU_PITCH * 2 + 16 * BS_PITCH * 2;
__device__ void ssm_outputs(const Params& p, int l, char* lds) {
  const int tid = opaque_tid(), lane = tid & 63, w = tid >> 6;
  h16* Kt = (h16*)lds;
  h16* Bu = (h16*)(lds + 65 * 512);
  h16* Bs = (h16*)(lds + 65 * 512 + 16 * BU_PITCH * 2);
  const h16* P = (const h16*)(p.ws + O_P);
  const float* E = (const float*)(p.ws + O_E);
  h16* Z = (h16*)(p.ws + O_Z);
  for (int unit = blockIdx.x; unit < 1024; unit += gridDim.x) {
    const int g = unit & 31, bc = unit >> 5, b = bc >> 3, ct = bc & 7;
    const int lg = l * 32 + g;
    __syncthreads();
    if (w == 0) {
      float2 at = ((const float2*)(p.ws + O_AT))[lg * 64 + lane];
      const float2* Eb = (const float2*)E + ((size_t)(b * 128) * 32 + g) * 64 + lane;
      float sr = 0.f, si = 0.f;
      const int c0 = ct * 16;
#pragma unroll 8
      for (int c = 0; c < c0; ++c) {
        float2 e = Eb[(size_t)c * 2048];
        float nr = at.x * sr - at.y * si + e.x, ni = at.x * si + at.y * sr + e.y;
        sr = nr; si = ni;
      }
#pragma unroll
      for (int i = 0; i < 16; ++i) {
        Bs[i * BS_PITCH + 2 * lane] = (h16)sr;
        Bs[i * BS_PITCH + 2 * lane + 1] = (h16)si;
        float2 e = Eb[(size_t)(c0 + i) * 2048];
        float nr = at.x * sr - at.y * si + e.x, ni = at.x * si + at.y * sr + e.y;
        sr = nr; si = ni;
      }
    } else {
      const int t2 = tid - 64, n2 = NT - 64;
      const h16x8* ks = (const h16x8*)(p.ws + O_KTAB + (size_t)lg * SZ_KTAB);
      for (int i = t2; i < 65 * 32; i += n2) ((h16x8*)Kt)[i] = ks[i];
      for (int i = t2; i < 2048; i += n2) {
        int tk = i >> 1, hf = i & 1;
        h16x8 v = *(const h16x8*)(P + ((size_t)b * SEQ + ct * 1024 + tk) * IWP + OFF_U + g * 16 + hf * 8);
        *(h16x8*)(Bu + (tk >> 6) * BU_PITCH + (tk & 63) * 16 + hf * 8) = v;
      }
    }
    __syncthreads();
    const float dt = expf(p.in[8][lg]);
    const int col = lane & 15, hi = lane >> 5, qh = (lane >> 4) & 1, p0 = (lane >> 4) * 4;
    const h16* W3 = (const h16*)(p.ws + O_W3 + (size_t)lg * SZ_W13);
    float dsk[4];
    for (int j = 0; j < 4; ++j) dsk[j] = p.in[13][l * 512 + g * 16 + p0 + j];
    for (int r = 0; r < 64 / NW; ++r) {
      const int base = (r >> 1) * 2 * NW;
      const int tau = (r & 1) ? base + 2 * NW - 1 - w : base + w;
      f32x4 acc = {0.f, 0.f, 0.f, 0.f};
      const int nks = tau / 2 + 1;
      for (int i = 0; i < nks; ++i) {
        int j = tau - (2 * i + hi);
        h16x8 A = *(const h16x8*)(Kt + (j + 1) * 256 + (lane & 15) * 16 + qh * 8);
        h16x8 B = *(const h16x8*)(Bu + col * BU_PITCH + (2 * i + hi) * 16 + qh * 8);
        acc = __builtin_amdgcn_mfma_f32_16x16x32_f16(A, B, acc, 0, 0, 0);
      }
#pragma unroll
      for (int ks = 0; ks < 4; ++ks) {
        h16x8 A = *(const h16x8*)(W3 + ((size_t)((tau * 16 + ks * 4 + (lane >> 4)) * 16) + (lane & 15)) * 8);
        h16x8 B = *(const h16x8*)(Bs + col * BS_PITCH + ks * 32 + (lane >> 4) * 8);
        acc = __builtin_amdgcn_mfma_f32_16x16x32_f16(A, B, acc, 0, 0, 0);
      }
      const h16* up = Bu + col * BU_PITCH + tau * 16 + p0;
      size_t tok = ((size_t)b * 128 + ct * 16 + col) * 64 + tau;
      h16 zz[4];
      for (int j = 0; j < 4; ++j) zz[j] = (h16)gelu_tanh(dt * acc[j] + dsk[j] * (float)up[j]);
      typedef __attribute__((ext_vector_type(4))) _Float16 h16x4;
      h16x4 zv = {zz[0], zz[1], zz[2], zz[3]};
      *(h16x4*)(Z + tok * 512 + g * 16 + p0) = zv;
    }
  }
}

#define LAS __attribute__((address_space(3)))
typedef _Float16 h16x4 __attribute__((ext_vector_type(4)));
namespace g8 {
constexpr int BM = 256, BK = 64, HALF = 128, HTB = HALF * BK * 2, STAGE_BYTES = 8 * HTB, NXCD = 8, WGM = 8;
__device__ __forceinline__ int lds_byte(int r, int c) {
  const int st = (r >> 4) * 2 + (c >> 5), rr = r & 15, cc = c & 31, ob = rr * 64 + cc * 2;
  return st * 1024 + (ob ^ (((ob >> 9) & 1) << 5));
}
__device__ __forceinline__ void stage_rc(int b, int& R, int& C) {
  const int st = b / 1024, sb = b % 1024, swz = sb ^ (((sb >> 9) & 1) << 5);
  R = (st >> 1) * 16 + swz / 64;
  C = (st & 1) * 32 + (swz % 64) / 2;
}
struct Unit { int pm, pn; };
struct Order {
  int nM, nN, nwg, G, c;
  __device__ void init(int M, int N, int G_, int c_) { nM = M / BM; nN = N / BM; nwg = nM * nN; G = G_; c = c_; }
  __device__ bool next(int i, Unit& u) const {
    const long L = (long)i * G + c;
    if (L >= nwg) return false;
    int wgid = (int)L;
    { const int q = nwg / NXCD, r = nwg % NXCD, xcd = wgid % NXCD, off = wgid / NXCD; wgid = (xcd < r ? xcd * (q + 1) : r * (q + 1) + (xcd - r) * q) + off; }
    const int nig = WGM * nN, gid = wgid / nig, fm = gid * WGM, gsz = (nM - fm) < WGM ? (nM - fm) : WGM;
    u.pm = fm + ((wgid % nig) % gsz);
    u.pn = (wgid % nig) / gsz;
    return true;
  }
};
template <class Epi>
__device__ __forceinline__ void gemm_phase(LAS unsigned char* lds, const h16* A, const h16* Bt, int K, const Order& S, const Epi& E) {
  const int tid = opaque_tid(), wid = __builtin_amdgcn_readfirstlane(tid >> 6), lane = tid & 63, wr = wid >> 2, wc = wid & 3, fr = lane & 15, fq = lane >> 4;
  const int nt = K / BK;
  unsigned voffA[2];
#pragma unroll
  for (int i = 0; i < 2; ++i) { int R, C; stage_rc(tid * 16 + i * 8192, R, C); voffA[i] = (unsigned)(R * K + C) * 2u; }
  const size_t kstep = (size_t)(BK * 2);
  const size_t hstep = (size_t)HALF * K * 2;
  const size_t tstep = 2 * hstep;
  const unsigned ldsw = (unsigned)wid * 1024u;
  const int aoff = lds_byte(wr * 64 + fr, fq * 8), boff = lds_byte(wc * 32 + fr, fq * 8);
#define G8_SA(b, h) (((b) * 2 + (h)) * HTB)
#define G8_SB(b, h) ((4 + (b) * 2 + (h)) * HTB)
#define G8_STAGE(bufoff, gbase) do { _Pragma("unroll") for (int _i = 0; _i < 2; ++_i) \
    __builtin_amdgcn_global_load_lds((const unsigned*)((const char*)(gbase) + voffA[_i]), (LAS unsigned*)(lds + (bufoff) + ldsw + _i * 8192), 16, 0, 0); } while (0)
#define G8_LDA(dst, b, h) do { _Pragma("unroll") for (int m = 0; m < 4; ++m) _Pragma("unroll") for (int k = 0; k < 2; ++k) dst[m][k] = *(const LAS h16x8*)(lds + G8_SA(b, h) + aoff + m * 2048 + k * 1024); } while (0)
#define G8_LDB(dst, b, h) do { _Pragma("unroll") for (int n = 0; n < 2; ++n) _Pragma("unroll") for (int k = 0; k < 2; ++k) dst[n][k] = *(const LAS h16x8*)(lds + G8_SB(b, h) + boff + n * 2048 + k * 1024); } while (0)
#define G8_MMA(ai, bj, At, Bt_) do { __builtin_amdgcn_s_setprio(1); _Pragma("unroll") for (int m = 0; m < 4; ++m) _Pragma("unroll") for (int n = 0; n < 2; ++n) _Pragma("unroll") for (int k = 0; k < 2; ++k) \
    acc[ai][bj][m][n] = __builtin_amdgcn_mfma_f32_16x16x32_f16(Bt_[n][k], At[m][k], acc[ai][bj][m][n], 0, 0, 0); __builtin_amdgcn_s_setprio(0); } while (0)
#define G8_WAIT_V(n) asm volatile("s_waitcnt vmcnt(" #n ")" ::: "memory")
#define G8_WAIT_L(n) asm volatile("s_waitcnt lgkmcnt(" #n ")" ::: "memory")
#define G8_BAR __builtin_amdgcn_s_barrier()
#define G8_SCHED __builtin_amdgcn_sched_barrier(0)
  Unit cur, nxt;
  int ui = 0;
  if (!S.next(0, cur)) return;
  f32x4 acc[2][2][4][2];
#pragma unroll
  for (int a = 0; a < 2; ++a)
#pragma unroll
    for (int b = 0; b < 2; ++b)
#pragma unroll
      for (int m = 0; m < 4; ++m)
#pragma unroll
        for (int n = 0; n < 2; ++n) acc[a][b][m][n] = (f32x4){0.f, 0.f, 0.f, 0.f};
  h16x8 At[4][2], B0[2][2], B1[2][2];
  const char* cA = (const char*)A + (size_t)cur.pm * tstep;
  const char* cB = (const char*)Bt + (size_t)cur.pn * tstep;
  G8_STAGE(G8_SB(0, 0), cB); G8_STAGE(G8_SA(0, 0), cA); G8_STAGE(G8_SB(0, 1), cB + hstep); G8_STAGE(G8_SA(0, 1), cA + hstep);
  if (wr == 1) G8_BAR;
  G8_WAIT_V(4); G8_BAR;
  G8_STAGE(G8_SB(1, 0), cB + kstep); G8_STAGE(G8_SA(1, 0), cA + kstep); G8_STAGE(G8_SB(1, 1), cB + hstep + kstep);
  G8_WAIT_V(6); G8_BAR;
  for (;;) {
    const bool has_next = S.next(ui + 1, nxt);
    const char* nA = has_next ? (const char*)A + (size_t)nxt.pm * tstep : cA;
    const char* nB = has_next ? (const char*)Bt + (size_t)nxt.pn * tstep : cB;
    for (int t = 0; t < nt; t += 2) {
      const bool last = (t == nt - 2);
      const char* a1 = cA + (size_t)(t + 1) * kstep;
      const char* a2 = last ? nA : cA + (size_t)(t + 2) * kstep;
      const char* b2 = last ? nB : cB + (size_t)(t + 2) * kstep;
      const char* a3 = a2 + kstep;
      const char* b3 = b2 + kstep;
      G8_LDB(B0, 0, 0); G8_SCHED; G8_LDA(At, 0, 0); G8_STAGE(G8_SA(1, 1), a1 + hstep);
      G8_WAIT_L(8); G8_BAR; G8_WAIT_L(0); G8_MMA(0, 0, At, B0); G8_BAR; G8_SCHED;
      G8_LDB(B1, 0, 1); G8_STAGE(G8_SB(0, 0), b2);
      G8_BAR; G8_WAIT_L(0); G8_MMA(0, 1, At, B1); G8_BAR;
      G8_LDA(At, 0, 1); G8_STAGE(G8_SA(0, 0), a2);
      G8_BAR; G8_WAIT_L(0); G8_MMA(1, 0, At, B0); G8_BAR; G8_SCHED;
      G8_STAGE(G8_SB(0, 1), b2 + hstep);
      G8_WAIT_V(6); G8_BAR; G8_MMA(1, 1, At, B1); G8_BAR;
      G8_LDB(B0, 1, 0); G8_SCHED; G8_LDA(At, 1, 0); G8_STAGE(G8_SA(0, 1), a2 + hstep);
      G8_WAIT_L(8); G8_BAR; G8_WAIT_L(0); G8_MMA(0, 0, At, B0); G8_BAR; G8_SCHED;
      G8_LDB(B1, 1, 1); G8_STAGE(G8_SB(1, 0), b3);
      G8_BAR; G8_WAIT_L(0); G8_MMA(0, 1, At, B1); G8_BAR;
      G8_LDA(At, 1, 1); G8_STAGE(G8_SA(1, 0), a3);
      G8_BAR; G8_WAIT_L(0); G8_MMA(1, 0, At, B0); G8_BAR; G8_SCHED;
      G8_STAGE(G8_SB(1, 1), b3 + hstep);
      G8_WAIT_V(6); G8_BAR; G8_MMA(1, 1, At, B1); G8_BAR;
    }
    E(acc, cur, ui, wr, wc, fr, fq);
    if (!has_next) break;
#pragma unroll
    for (int a = 0; a < 2; ++a)
#pragma unroll
      for (int b = 0; b < 2; ++b)
#pragma unroll
        for (int m = 0; m < 4; ++m)
#pragma unroll
          for (int n = 0; n < 2; ++n) acc[a][b][m][n] = (f32x4){0.f, 0.f, 0.f, 0.f};
    cur = nxt; cA = nA; cB = nB; ++ui;
  }
  G8_WAIT_V(0);
  if (wr == 0) G8_BAR;
  G8_BAR;
#undef G8_SA
#undef G8_SB
#undef G8_STAGE
#undef G8_LDA
#undef G8_LDB
#undef G8_MMA
#undef G8_WAIT_V
#undef G8_WAIT_L
#undef G8_BAR
#undef G8_SCHED
}
}

constexpr int RSL_OFF = g8::STAGE_BYTES;
constexpr int LDS_GEMM = g8::STAGE_BYTES + 8 * 256 * 4;

__device__ __forceinline__ void fill_rowscales(float* rsl, const float* ssq, float inv_n, const g8::Order& S) {
  const int tid = opaque_tid();
  g8::Unit u;
  __syncthreads();
  for (int i = 0; S.next(i, u); ++i) {
    if (tid < 256) {
      const float4* s4 = (const float4*)(ssq + (size_t)(u.pm * 256 + tid) * 16);
      float s = 0.f;
      for (int k = 0; k < 4; ++k) { float4 v = s4[k]; s += v.x + v.y + v.z + v.w; }
      rsl[i * 256 + tid] = rsqrtf(s * inv_n + EPS);
    }
  }
  __syncthreads();
}

__device__ __forceinline__ h16x4 pack4(float a, float b, float c, float d) { h16x4 v = {(h16)a, (h16)b, (h16)c, (h16)d}; return v; }

struct EpiIn {
  h16* P; const float* rsl; const float* qkg;
  __device__ __forceinline__ void operator()(const f32x4 (&acc)[2][2][4][2], const g8::Unit& u, int ui, int wr, int wc, int fr, int fq) const {
    const int hs = u.pn * 4 + wc;
    int gi = -1;
    if (hs < 4) gi = 0; else if (hs < 6) gi = 1; else if (hs >= 16 && hs < 20) gi = 2; else if (hs == 22) gi = 4; else if (hs == 24) gi = 5;
    const bool gate = (hs == 26);
#pragma unroll
    for (int ai = 0; ai < 2; ++ai)
#pragma unroll
      for (int m = 0; m < 4; ++m) {
        const int rl = 128 * ai + 64 * wr + 16 * m + fr;
        const float r = rsl[ui * 256 + rl];
        f32x4 v[2][2];
#pragma unroll
        for (int bj = 0; bj < 2; ++bj)
#pragma unroll
          for (int n = 0; n < 2; ++n) v[bj][n] = acc[ai][bj][m][n] * r;
        if (gi >= 0) {
          float ss = 0.f;
#pragma unroll
          for (int bj = 0; bj < 2; ++bj)
#pragma unroll
            for (int n = 0; n < 2; ++n)
#pragma unroll
              for (int j = 0; j < 4; ++j) ss += v[bj][n][j] * v[bj][n][j];
          ss += xor16(ss);
          ss += __shfl_xor(ss, 32);
          const float sc = rsqrtf(ss * (1.f / 64.f) + EPS);
#pragma unroll
          for (int bj = 0; bj < 2; ++bj)
#pragma unroll
            for (int n = 0; n < 2; ++n) {
              const float4 g4 = *(const float4*)(qkg + gi * 64 + 32 * bj + 16 * n + 4 * fq);
              v[bj][n][0] *= sc * g4.x; v[bj][n][1] *= sc * g4.y; v[bj][n][2] *= sc * g4.z; v[bj][n][3] *= sc * g4.w;
            }
        } else if (gate) {
#pragma unroll
          for (int bj = 0; bj < 2; ++bj)
#pragma unroll
            for (int n = 0; n < 2; ++n)
#pragma unroll
              for (int j = 0; j < 4; ++j) v[bj][n][j] = (32 * bj + 16 * n + 4 * fq + j) < 12 ? sigmoidf(v[bj][n][j]) : 0.f;
        }
        h16* rowp = P + (size_t)(u.pm * 256 + rl) * IWP + 64 * hs + 4 * fq;
#pragma unroll
        for (int bj = 0; bj < 2; ++bj)
#pragma unroll
          for (int n = 0; n < 2; ++n) *(h16x4*)(rowp + 32 * bj + 16 * n) = pack4(v[bj][n][0], v[bj][n][1], v[bj][n][2], v[bj][n][3]);
      }
  }
};

struct EpiGlu {
  h16* OB; float* ssqb; const float* gb;
  __device__ __forceinline__ void operator()(const f32x4 (&acc)[2][2][4][2], const g8::Unit& u, int ui, int wr, int wc, int fr, int fq) const {
    const int ocb = 128 * u.pn + 16 * wc + 4 * fq;
    float4 ba[2], bb[2];
#pragma unroll
    for (int bj = 0; bj < 2; ++bj) { ba[bj] = *(const float4*)(gb + ocb + 64 * bj); bb[bj] = *(const float4*)(gb + 512 + ocb + 64 * bj); }
#pragma unroll
    for (int ai = 0; ai < 2; ++ai)
#pragma unroll
      for (int m = 0; m < 4; ++m) {
        const size_t row = (size_t)u.pm * 256 + 128 * ai + 64 * wr + 16 * m + fr;
        float ss = 0.f;
#pragma unroll
        for (int bj = 0; bj < 2; ++bj) {
          const f32x4 a = acc[ai][bj][m][0], b = acc[ai][bj][m][1];
          float o0 = (a[0] + ba[bj].x) * sigmoidf(b[0] + bb[bj].x);
          float o1 = (a[1] + ba[bj].y) * sigmoidf(b[1] + bb[bj].y);
          float o2 = (a[2] + ba[bj].z) * sigmoidf(b[2] + bb[bj].z);
          float o3 = (a[3] + ba[bj].w) * sigmoidf(b[3] + bb[bj].w);
          *(h16x4*)(OB + row * 512 + ocb + 64 * bj) = pack4(o0, o1, o2, o3);
          ss += o0 * o0 + o1 * o1 + o2 * o2 + o3 * o3;
        }
        ss += xor16(ss);
        ss += __shfl_xor(ss, 32);
        if (fq == 0) ssqb[row * 16 + u.pn * 4 + wc] = ss;
      }
  }
};

struct EpiOutB {
  float* xo; const float* xsrc; const float* rsl;
  __device__ __forceinline__ void operator()(const f32x4 (&acc)[2][2][4][2], const g8::Unit& u, int ui, int wr, int wc, int fr, int fq) const {
#pragma unroll
    for (int ai = 0; ai < 2; ++ai)
#pragma unroll
      for (int m = 0; m < 4; ++m) {
        const int rl = 128 * ai + 64 * wr + 16 * m + fr;
        const float r = rsl[ui * 256 + rl];
        const size_t base = (size_t)(u.pm * 256 + rl) * DM + 256 * u.pn + 32 * wc + 4 * fq;
#pragma unroll
        for (int bj = 0; bj < 2; ++bj)
#pragma unroll
          for (int n = 0; n < 2; ++n) {
            const size_t idx = base + 128 * bj + 16 * n;
            const float4 xv = *(const float4*)(xsrc + idx);
            const f32x4 a = acc[ai][bj][m][n];
            *(float4*)(xo + idx) = make_float4(xv.x + r * a[0], xv.y + r * a[1], xv.z + r * a[2], xv.w + r * a[3]);
          }
      }
  }
};

struct EpiRes {
  float* xo; h16* xb; float* ssq;
  __device__ __forceinline__ void operator()(const f32x4 (&acc)[2][2][4][2], const g8::Unit& u, int ui, int wr, int wc, int fr, int fq) const {
#pragma unroll
    for (int ai = 0; ai < 2; ++ai)
#pragma unroll
      for (int m = 0; m < 4; ++m) {
        const size_t row = (size_t)u.pm * 256 + 128 * ai + 64 * wr + 16 * m + fr;
        const size_t base = row * DM + 256 * u.pn + 32 * wc + 4 * fq;
        float ss = 0.f;
#pragma unroll
        for (int bj = 0; bj < 2; ++bj)
#pragma unroll
          for (int n = 0; n < 2; ++n) {
            const size_t idx = base + 128 * bj + 16 * n;
            const float4 xv = *(const float4*)(xo + idx);
            const f32x4 a = acc[ai][bj][m][n];
            const float x0 = xv.x + a[0], x1 = xv.y + a[1], x2 = xv.z + a[2], x3 = xv.w + a[3];
            *(float4*)(xo + idx) = make_float4(x0, x1, x2, x3);
            *(h16x4*)(xb + idx) = pack4(x0, x1, x2, x3);
            ss += x0 * x0 + x1 * x1 + x2 * x2 + x3 * x3;
          }
        ss += xor16(ss);
        ss += __shfl_xor(ss, 32);
        if (fq == 0) ssq[row * 16 + u.pn * 4 + wc] = ss;
      }
  }
};

struct EpiUp {
  h16* hid; const float* rsl;
  __device__ __forceinline__ void operator()(const f32x4 (&acc)[2][2][4][2], const g8::Unit& u, int ui, int wr, int wc, int fr, int fq) const {
#pragma unroll
    for (int ai = 0; ai < 2; ++ai)
#pragma unroll
      for (int m = 0; m < 4; ++m) {
        const int rl = 128 * ai + 64 * wr + 16 * m + fr;
        const float r = rsl[ui * 256 + rl];
        h16* rowp = hid + (size_t)(u.pm * 256 + rl) * DFF + 256 * u.pn + 32 * wc + 4 * fq;
#pragma unroll
        for (int bj = 0; bj < 2; ++bj)
#pragma unroll
          for (int n = 0; n < 2; ++n) {
            const f32x4 a = acc[ai][bj][m][n];
            float v0 = fmaxf(a[0] * r, 0.f), v1 = fmaxf(a[1] * r, 0.f), v2 = fmaxf(a[2] * r, 0.f), v3 = fmaxf(a[3] * r, 0.f);
            *(h16x4*)(rowp + 128 * bj + 16 * n) = pack4(v0 * v0, v1 * v1, v2 * v2, v3 * v3);
          }
      }
  }
};

__device__ void phase_gemm1(const Params& p, int l, char* lds) {
  g8::Order S; S.init(NTOK, IWP, gridDim.x, blockIdx.x);
  float* rsl = (float*)(lds + RSL_OFF);
  fill_rowscales(rsl, (const float*)(p.ws + O_SSQ), 1.f / DM, S);
  EpiIn E{(h16*)(p.ws + O_P), rsl, p.in[3] + l * 6 * 64};
  g8::gemm_phase((LAS unsigned char*)lds, (const h16*)(p.ws + O_XB), (const h16*)(p.ws + O_WIN + l * SZ_WIN), DM, S, E);
}
__device__ void phase_glu(const Params& p, int l, char* lds) {
  g8::Order S; S.init(NTOK, 1024, gridDim.x, blockIdx.x);
  __syncthreads();
  EpiGlu E{(h16*)(p.ws + O_OB), (float*)(p.ws + O_SSQB), p.in[15] + l * 1024};
  g8::gemm_phase((LAS unsigned char*)lds, (const h16*)(p.ws + O_Z), (const h16*)(p.ws + O_WGLU + l * SZ_WGLU), 512, S, E);
}
__device__ void phase_wout(const Params& p, int l, char* lds) {
  g8::Order S; S.init(NTOK, DM, gridDim.x, blockIdx.x);
  float* rsl = (float*)(lds + RSL_OFF);
  fill_rowscales(rsl, (const float*)(p.ws + O_SSQB), 1.f / 512.f, S);
  EpiOutB E1{p.out, (l == 0) ? p.in[0] : p.out, rsl};
  g8::gemm_phase((LAS unsigned char*)lds, (const h16*)(p.ws + O_OB), (const h16*)(p.ws + O_WOUT + l * SZ_WOUT), 512, S, E1);
  __syncthreads();
  EpiRes E2{p.out, (h16*)(p.ws + O_XB), (float*)(p.ws + O_SSQ)};
  g8::gemm_phase((LAS unsigned char*)lds, (const h16*)(p.ws + O_OAC), (const h16*)(p.ws + O_WOUT + l * SZ_WOUT + (size_t)DM * 512 * 2), 512, S, E2);
}
__device__ void phase_up(const Params& p, int l, char* lds) {
  g8::Order S; S.init(NTOK, DFF, gridDim.x, blockIdx.x);
  float* rsl = (float*)(lds + RSL_OFF);
  fill_rowscales(rsl, (const float*)(p.ws + O_SSQ), 1.f / DM, S);
  EpiUp E{(h16*)(p.ws + O_HID), rsl};
  g8::gemm_phase((LAS unsigned char*)lds, (const h16*)(p.ws + O_XB), (const h16*)(p.ws + O_WUP + l * SZ_WUP), DM, S, E);
}
__device__ void phase_down(const Params& p, int l, char* lds) {
  g8::Order S; S.init(NTOK, DM, gridDim.x, blockIdx.x);
  __syncthreads();
  EpiRes E{p.out, (h16*)(p.ws + O_XB), (float*)(p.ws + O_SSQ)};
  g8::gemm_phase((LAS unsigned char*)lds, (const h16*)(p.ws + O_HID), (const h16*)(p.ws + O_WDN + l * SZ_WDN), DFF, S, E);
}

constexpr int KP = 72;
enum { M_SWA = 0, M_WIN = 1, M_SEL = 2, M_CMPA = 3, M_CMPB = 4 };
struct RowState { float m[4], l[4]; };

__device__ __forceinline__ h16x8 ld_row8(const h16* base, int ld, int row, int nrows, int c8) {
  h16x8 z = {0, 0, 0, 0, 0, 0, 0, 0};
  return (row >= 0 && row < nrows) ? *(const h16x8*)(base + (size_t)row * ld + c8 * 8) : z;
}
__device__ __forceinline__ void st_k(h16* Ks, int row, int c8, h16x8 v) { *(h16x8*)(Ks + row * KP + c8 * 8) = v; }
__device__ __forceinline__ void st_vt(h16* Vt, int row, int c8, h16x8 v) {
#pragma unroll
  for (int e = 0; e < 8; ++e) Vt[(c8 * 8 + e) * KP + row] = v[e];
}

template <int MODE, int RGM>
__device__ __forceinline__ void attn_tile(const h16x8 (&Q)[2][2], f32x4 (&O)[2][4], RowState (&st)[2], const h16* Ks,
                                          const h16* Vt, h16* Pb, const float* biasT, const int (&tq)[2], int head,
                                          int kbase, const bool (&selbit)[2], float (&hp)[2][4], const int lane) {
  const int col = lane & 15, q4 = lane >> 4;
  f32x4 S[2][4];
#pragma unroll
  for (int kt = 0; kt < 4; ++kt) {
#pragma unroll
    for (int rg = 0; rg < 2; ++rg) S[rg][kt] = f32x4{0.f, 0.f, 0.f, 0.f};
#pragma unroll
    for (int ks = 0; ks < 2; ++ks) {
      h16x8 B = *(const h16x8*)(Ks + (kt * 16 + col) * KP + ks * 32 + q4 * 8);
#pragma unroll
      for (int rg = 0; rg < 2; ++rg)
        if (RGM & (1 << rg)) S[rg][kt] = __builtin_amdgcn_mfma_f32_16x16x32_f16(Q[rg][ks], B, S[rg][kt], 0, 0, 0);
    }
  }
#pragma unroll
  for (int rg = 0; rg < 2; ++rg) {
    if (!(RGM & (1 << rg))) continue;
#pragma unroll
    for (int kt = 0; kt < 4; ++kt) {
      const int kx = kbase + kt * 16 + col;
      if (MODE == M_SWA) {
#pragma unroll
        for (int j = 0; j < 4; ++j) {
          int dist = tq[rg] + j - kx;
          bool valid = dist >= 0 && dist < 128 && kx >= 0;
          int dc = dist < 0 ? 0 : (dist > 799 ? 799 : dist);
          S[rg][kt][j] = valid ? S[rg][kt][j] * 0.125f + biasT[dc * 4 + head] : -1e30f;
        }
      } else {
        int dist;
        bool valid;
        if (MODE == M_WIN) { dist = tq[rg] - kx; valid = dist >= 0 && dist < 512 && kx >= 0; }
        else if (MODE == M_SEL) { dist = tq[rg] - kx; valid = selbit[rg] && dist >= 0; }
        else { dist = tq[rg] - (16 * kx + 31); valid = dist >= 0 && kx < NCMP; }
        int dc = dist < 0 ? 0 : (dist > 799 ? 799 : dist);
        float4 bv = *(const float4*)(biasT + dc * 4);
        S[rg][kt][0] = valid ? S[rg][kt][0] * 0.125f + bv.x : -1e30f;
        S[rg][kt][1] = valid ? S[rg][kt][1] * 0.125f + bv.y : -1e30f;
        S[rg][kt][2] = valid ? S[rg][kt][2] * 0.125f + bv.z : -1e30f;
        S[rg][kt][3] = valid ? S[rg][kt][3] * 0.125f + bv.w : -1e30f;
      }
    }
    if (MODE == M_CMPB) {
#pragma unroll
      for (int kt = 0; kt < 4; ++kt) {
        float h = 0.f;
#pragma unroll
        for (int j = 0; j < 4; ++j) {
          float pv = __expf(S[rg][kt][j] - st[rg].m[j]) * st[rg].l[j];
          S[rg][kt][j] = pv;
          h += pv;
        }
        hp[rg][kt] = h;
      }
    } else {
#pragma unroll
      for (int j = 0; j < 4; ++j) {
        float mx = fmaxf(fmaxf(S[rg][0][j], S[rg][1][j]), fmaxf(S[rg][2][j], S[rg][3][j]));
        mx = max16(mx);
        float mn = fmaxf(st[rg].m[j], mx);
        float corr = __expf(st[rg].m[j] - mn);
        st[rg].m[j] = mn;
        float mm = fmaxf(mn, -1e20f);
        float ls = 0.f;
#pragma unroll
        for (int kt = 0; kt < 4; ++kt) {
          float pv = __expf(S[rg][kt][j] - mm);
          S[rg][kt][j] = pv;
          ls += pv;
        }
        st[rg].l[j] = st[rg].l[j] * corr + ls;
        if (MODE != M_CMPA) {
#pragma unroll
          for (int nt = 0; nt < 4; ++nt) O[rg][nt][j] *= corr;
        }
      }
    }
    if (MODE != M_CMPA) {
#pragma unroll
      for (int kt = 0; kt < 4; ++kt)
#pragma unroll
        for (int j = 0; j < 4; ++j) Pb[rg * 16 * KP + (q4 * 4 + j) * KP + kt * 16 + col] = (h16)S[rg][kt][j];
    }
  }
  if (MODE == M_CMPA) return;
  asm volatile("" ::: "memory");
#pragma unroll
  for (int ks = 0; ks < 2; ++ks) {
    h16x8 A[2];
#pragma unroll
    for (int rg = 0; rg < 2; ++rg)
      if (RGM & (1 << rg)) A[rg] = *(const h16x8*)(Pb + rg * 16 * KP + col * KP + ks * 32 + q4 * 8);
#pragma unroll
    for (int nt = 0; nt < 4; ++nt) {
      h16x8 B = *(const h16x8*)(Vt + (nt * 16 + col) * KP + ks * 32 + q4 * 8);
#pragma unroll
      for (int rg = 0; rg < 2; ++rg)
        if (RGM & (1 << rg)) O[rg][nt] = __builtin_amdgcn_mfma_f32_16x16x32_f16(A[rg], B, O[rg][nt], 0, 0, 0);
    }
  }
  asm volatile("" ::: "memory");
}

__device__ __forceinline__ float red16(float v) { return sum16(v); }

__device__ void phase_compress(const Params& p, int l) {
  const int tid = opaque_tid(), lane = tid & 63, w = tid >> 6;
  const int gw = blockIdx.x * NW + w, nw = gridDim.x * NW;
  const h16* P = (const h16*)(p.ws + O_P);
  for (int item = gw; item < BATCH * 128 * 2; item += nw) {
    int s = item & 1, mg = (item >> 1) & 127, b = item >> 8;
    const float* w1 = p.in[17] + (size_t)(l * 2 + s) * 2048 * 128;
    const float* w2 = p.in[18] + (size_t)(l * 2 + s) * 128 * 64;
    const float* b1 = (const float*)(p.ws + O_BIAS1) + (l * 2 + s) * 128;
    float a0[4], a1[4];
    for (int mi = 0; mi < 4; ++mi) { a0[mi] = b1[lane]; a1[mi] = b1[64 + lane]; }
    for (int tt = 0; tt < 32; ++tt) {
      float xv[4];
      for (int mi = 0; mi < 4; ++mi) {
        int tok = 16 * (mg * 4 + mi) + tt;
        if (tok > SEQ - 1) tok = SEQ - 1;
        xv[mi] = (float)P[((size_t)b * SEQ + tok) * IWP + OFF_KVC + s * 64 + lane];
      }
      const float* wr = w1 + (size_t)tt * 64 * 128;
#pragma unroll 4
      for (int d = 0; d < 64; ++d) {
        float wa = wr[d * 128 + lane], wb = wr[d * 128 + 64 + lane];
        for (int mi = 0; mi < 4; ++mi) {
          float x = rdlane(xv[mi], d);
          a0[mi] += x * wa; a1[mi] += x * wb;
        }
      }
    }
    for (int mi = 0; mi < 4; ++mi) { a0[mi] = gelu_tanh(a0[mi]); a1[mi] = gelu_tanh(a1[mi]); }
    float o[4] = {0.f, 0.f, 0.f, 0.f};
    for (int j = 0; j < 64; ++j) {
      float wa = w2[j * 64 + lane], wb = w2[(64 + j) * 64 + lane];
      for (int mi = 0; mi < 4; ++mi) o[mi] += rdlane(a0[mi], j) * wa + rdlane(a1[mi], j) * wb;
    }
    for (int mi = 0; mi < 4; ++mi) {
      int m = mg * 4 + mi;
      float v = o[mi];
      if (s == 0) {
        float ss = wave_sum(v * v);
        v = v * rsqrtf(ss * (1.f / 64.f) + EPS) * p.in[3][(l * 6 + 3) * 64 + lane];
      }
      if (m >= NCMP) v = 0.f;
      ((h16*)(p.ws + (s == 0 ? O_KCMP : O_VCMP)))[((size_t)b * 512 + m) * 64 + lane] = (h16)v;
    }
  }
}

constexpr int LDS_BIAS = 800 * 16;
constexpr int LDS_PB = NW * 32 * KP * 2;
__device__ void phase_swa(const Params& p, int l, char* lds) {
  const int tid = opaque_tid(), lane = tid & 63, w = tid >> 6, col = lane & 15, q4 = lane >> 4;
  float* biasT = (float*)lds;
  h16* Pb = (h16*)(lds + LDS_BIAS) + w * 32 * KP;
  h16* KV = (h16*)(lds + LDS_BIAS + LDS_PB);
  float* nrm = (float*)(lds + LDS_BIAS + LDS_PB + 4 * 64 * KP * 2);
  const h16* P = (const h16*)(p.ws + O_P);
  const int* lut = (const int*)(p.ws + O_LUT);
  h16* OAC = (h16*)(p.ws + O_OAC);
  __syncthreads();
  for (int i = tid; i < 3200; i += NT) biasT[i] = p.in[5][lut[i >> 2] * 8 + (i & 3)];
  __syncthreads();
  const int head = w >> 1, kvh = w >> 2;
  const float sink = p.in[4][l * 4 + head];
  const int srow = tid >> 3, c8 = tid & 7;
  float hpd[2][4];
  const bool nosel[2] = {false, false};
  for (int u = blockIdx.x; u < BATCH * 128; u += gridDim.x) {
    const int b = u >> 7, t0 = (u & 127) * 64;
    const h16* Pbat = P + (size_t)b * SEQ * IWP;
    h16x8 Q[2][2];
    int tq[2];
#pragma unroll
    for (int rg = 0; rg < 2; ++rg) {
      const int qb = (w & 1) * 32 + rg * 16;
      const h16* qp = Pbat + (size_t)(t0 + qb + col) * IWP + head * 64 + q4 * 8;
      Q[rg][0] = *(const h16x8*)qp;
      Q[rg][1] = *(const h16x8*)(qp + 32);
      tq[rg] = t0 + qb + q4 * 4;
    }
    f32x4 O[2][4];
    RowState st[2];
#pragma unroll
    for (int rg = 0; rg < 2; ++rg) {
#pragma unroll
      for (int nt = 0; nt < 4; ++nt) O[rg][nt] = f32x4{0.f, 0.f, 0.f, 0.f};
#pragma unroll
      for (int j = 0; j < 4; ++j) { st[rg].m[j] = -1e30f; st[rg].l[j] = 0.f; }
    }
    const int i0 = t0 >= 128 ? 0 : (t0 >= 64 ? 1 : 2);
    h16x8 rk[2], rv[2];
    {
      int sb = t0 - 128 + i0 * 64;
      for (int h2 = 0; h2 < 2; ++h2) {
        rk[h2] = ld_row8(Pbat + 256 + h2 * 64, IWP, sb + srow, SEQ, c8);
        rv[h2] = ld_row8(Pbat + 384 + h2 * 64, IWP, sb + srow, SEQ, c8);
      }
    }
    for (int i = i0; i < 3; ++i) {
      __syncthreads();
      for (int h2 = 0; h2 < 2; ++h2) {
        st_k(KV + h2 * 64 * KP, srow, c8, rk[h2]);
        st_vt(KV + (2 + h2) * 64 * KP, srow, c8, rv[h2]);
      }
      __syncthreads();
      if (i + 1 < 3) {
        int sb = t0 - 128 + (i + 1) * 64;
        for (int h2 = 0; h2 < 2; ++h2) {
          rk[h2] = ld_row8(Pbat + 256 + h2 * 64, IWP, sb + srow, SEQ, c8);
          rv[h2] = ld_row8(Pbat + 384 + h2 * 64, IWP, sb + srow, SEQ, c8);
        }
      }
      const int kb = t0 - 128 + i * 64;
      attn_tile<M_SWA, 3>(Q, O, st, KV + kvh * 64 * KP, KV + (2 + kvh) * 64 * KP, Pb, biasT, tq, head, kb, nosel, hpd, lane);
    }
    __syncthreads();
#pragma unroll
    for (int rg = 0; rg < 2; ++rg) {
      const int qb = (w & 1) * 32 + rg * 16;
#pragma unroll
      for (int j = 0; j < 4; ++j) {
        float lsum = red16(st[rg].l[j]);
        float mn = fmaxf(st[rg].m[j], sink);
        float corr = __expf(st[rg].m[j] - mn);
        float inv = corr / (lsum * corr + __expf(sink - mn));
        float ss = 0.f;
#pragma unroll
        for (int nt = 0; nt < 4; ++nt) { O[rg][nt][j] *= inv; ss += O[rg][nt][j] * O[rg][nt][j]; }
        ss = red16(ss);
        if (col == 0) nrm[head * 64 + qb + q4 * 4 + j] = ss;
      }
    }
    __syncthreads();
#pragma unroll
    for (int rg = 0; rg < 2; ++rg) {
      const int qb = (w & 1) * 32 + rg * 16;
#pragma unroll
      for (int j = 0; j < 4; ++j) {
        const int qi = qb + q4 * 4 + j;
        float tot = nrm[qi] + nrm[64 + qi] + nrm[128 + qi] + nrm[192 + qi];
        float sc = rsqrtf(tot * (1.f / 256.f) + EPS);
#pragma unroll
        for (int nt = 0; nt < 4; ++nt)
          OAC[((size_t)b * SEQ + t0 + qi) * 512 + head * 64 + nt * 16 + col] = (h16)(O[rg][nt][j] * sc);
      }
    }
  }
}

constexpr int LDS_NSA = LDS_BIAS + LDS_PB + 2 * 64 * KP * 2 + NW * 4 * 128 * 4 + 32 * 16;
__device__ void phase_nsa(const Params& p, int l, char* lds) {
  const int tid = opaque_tid(), lane = tid & 63, w = tid >> 6, col = lane & 15, q4 = lane >> 4;
  float* biasT = (float*)lds;
  h16* Pb = (h16*)(lds + LDS_BIAS) + w * 32 * KP;
  h16* Ks = (h16*)(lds + LDS_BIAS + LDS_PB);
  h16* Vt = Ks + 64 * KP;
  float* impw = (float*)(lds + LDS_BIAS + LDS_PB + 2 * 64 * KP * 2) + w * 4 * 128;
  unsigned long long* selm = (unsigned long long*)(lds + LDS_BIAS + LDS_PB + 2 * 64 * KP * 2 + NW * 4 * 128 * 4);
  const h16* P = (const h16*)(p.ws + O_P);
  const int* lut = (const int*)(p.ws + O_LUT);
  h16* OAC = (h16*)(p.ws + O_OAC);
  __syncthreads();
  for (int i = tid; i < 3200; i += NT) biasT[i] = p.in[5][lut[i >> 2] * 8 + 4 + (i & 3)];
  __syncthreads();
  const int srow = tid >> 3, c8 = tid & 7;
  float hpd[2][4];
  const bool nosel[2] = {false, false};
  for (int u = blockIdx.x; u < 1024; u += gridDim.x) {
    const int rnd = u >> 8, b = (u & 255) >> 6, ti = u & 63;
    const int tile = rnd == 0 ? 255 - ti : (rnd == 1 ? 128 + ti : (rnd == 2 ? 127 - ti : ti));
    const int t0 = tile * 32, cur = t0 >> 6;
    const h16* Pbat = P + (size_t)b * SEQ * IWP;
    const h16* KC = (const h16*)(p.ws + O_KCMP) + (size_t)b * 512 * 64;
    const h16* VC = (const h16*)(p.ws + O_VCMP) + (size_t)b * 512 * 64;
    h16x8 Q[2][2];
    int tq[2] = {0, 0};
    {
      const int qi = w * 4 + (col >> 2), hd = col & 3;
      const h16* qp = Pbat + (size_t)(t0 + qi) * IWP + OFF_QC + hd * 64 + q4 * 8;
      Q[0][0] = *(const h16x8*)qp;
      Q[0][1] = *(const h16x8*)(qp + 32);
      tq[0] = t0 + w * 4 + q4;
    }
    for (int i = lane; i < 512; i += 64) impw[i] = 0.f;
    f32x4 O[2][4], Oc[2][4];
    RowState st[2];
    h16x8 rk, rv;
    int mvmax = t0 / 16 + 1;
    if (mvmax > NCMP) mvmax = NCMP;
    const int ntc = (mvmax + 63) >> 6;
#pragma unroll
    for (int rg = 0; rg < 1; ++rg)
#pragma unroll
      for (int j = 0; j < 4; ++j) { st[rg].m[j] = -1e30f; st[rg].l[j] = 0.f; }
    rk = ld_row8(KC, 64, srow, 512, c8);
    for (int i = 0; i < ntc; ++i) {
      __syncthreads();
      st_k(Ks, srow, c8, rk);
      __syncthreads();
      if (i + 1 < ntc) rk = ld_row8(KC, 64, (i + 1) * 64 + srow, 512, c8);
      attn_tile<M_CMPA, 1>(Q, O, st, Ks, Vt, Pb, biasT, tq, 0, i * 64, nosel, hpd, lane);
    }
#pragma unroll
    for (int rg = 0; rg < 1; ++rg)
#pragma unroll
      for (int j = 0; j < 4; ++j) {
        float ls = red16(st[rg].l[j]);
        st[rg].l[j] = ls > 0.f ? 1.f / ls : 0.f;
      }
#pragma unroll
    for (int rg = 0; rg < 1; ++rg)
#pragma unroll
      for (int nt = 0; nt < 4; ++nt) O[rg][nt] = f32x4{0.f, 0.f, 0.f, 0.f};
    float carry[1] = {0.f};
    rk = ld_row8(KC, 64, srow, 512, c8);
    rv = ld_row8(VC, 64, srow, 512, c8);
    for (int i = 0; i < ntc; ++i) {
      __syncthreads();
      st_k(Ks, srow, c8, rk);
      st_vt(Vt, srow, c8, rv);
      __syncthreads();
      if (i + 1 < ntc) {
        rk = ld_row8(KC, 64, (i + 1) * 64 + srow, 512, c8);
        rv = ld_row8(VC, 64, (i + 1) * 64 + srow, 512, c8);
      }
      float hp2[2][4];
      attn_tile<M_CMPB, 1>(Q, O, st, Ks, Vt, Pb, biasT, tq, 0, i * 64, nosel, hp2, lane);
#pragma unroll
      for (int rg = 0; rg < 1; ++rg) {
        float hp[4] = {hp2[rg][0], hp2[rg][1], hp2[rg][2], hp2[rg][3]};
#pragma unroll
        for (int kt = 0; kt < 4; ++kt) {
          float h = hp[kt];
          float qs = h + dppf<0xB1>(h);
          qs += dppf<0x4E>(qs);
          float prev = dppf<0x121>(h);
          float cin = (kt == 0) ? carry[rg] : dppf<0x121>(hp[kt > 0 ? kt - 1 : 0]);
          float pk = (col == 0) ? cin : prev;
          if ((col & 3) == 0) impw[(rg * 4 + q4) * 128 + ((i * 64 + kt * 16 + col) >> 2)] = qs + pk;
        }
        carry[rg] = dppf<0x121>(hp[3]);
      }
    }
#pragma unroll
    for (int rg = 0; rg < 1; ++rg) {
      const h16* gp = Pbat + (size_t)tq[rg] * IWP + OFF_GC;
#pragma unroll
      for (int j = 0; j < 4; ++j) {
        float g0 = (float)gp[j * 3 + 0];
#pragma unroll
        for (int nt = 0; nt < 4; ++nt) Oc[rg][nt][j] = g0 * O[rg][nt][j];
      }
    }
    {
      const int nforced = cur >= 2 ? 3 : cur + 1;
      const int npick = 16 - nforced;
      for (int qi = 0; qi < 4; ++qi) {
        const float* im = impw + qi * 128;
        const int j0 = lane, j1 = lane + 64;
        const float v0 = im[j0], v1 = im[j1];
        int r0 = 0, r1 = 0;
        for (int jp = 1; jp <= cur - 2; ++jp) {
          float vp = im[jp];
          r0 += (vp > v0 || (vp == v0 && jp < j0)) ? 1 : 0;
          r1 += (vp > v1 || (vp == v1 && jp < j1)) ? 1 : 0;
        }
        bool c0 = j0 >= 1 && j0 <= cur - 2, c1 = j1 <= cur - 2;
        bool f0 = j0 == 0 || j0 == cur || j0 == cur - 1, f1 = j1 == cur || j1 == cur - 1;
        unsigned long long mlo = __ballot(f0 || (c0 && r0 < npick));
        unsigned long long mhi = __ballot(f1 || (c1 && r1 < npick));
        if (lane == 0) { selm[(w * 4 + qi) * 2] = mlo; selm[(w * 4 + qi) * 2 + 1] = mhi; }
      }
    }
    asm volatile("" ::: "memory");
    unsigned long long slo[2], shi[2];
#pragma unroll
    for (int rg = 0; rg < 1; ++rg) {
      slo[rg] = selm[(w * 4 + q4) * 2];
      shi[rg] = selm[(w * 4 + q4) * 2 + 1];
    }
#pragma unroll
    for (int rg = 0; rg < 1; ++rg) {
#pragma unroll
      for (int nt = 0; nt < 4; ++nt) O[rg][nt] = f32x4{0.f, 0.f, 0.f, 0.f};
#pragma unroll
      for (int j = 0; j < 4; ++j) { st[rg].m[j] = -1e30f; st[rg].l[j] = 0.f; }
    }
    rk = ld_row8(Pbat + OFF_KVC + 128, IWP, srow, SEQ, c8);
    rv = ld_row8(Pbat + OFF_KVC + 192, IWP, srow, SEQ, c8);
    for (int jb = 0; jb <= cur; ++jb) {
      __syncthreads();
      st_k(Ks, srow, c8, rk);
      st_vt(Vt, srow, c8, rv);
      __syncthreads();
      if (jb + 1 <= cur) {
        rk = ld_row8(Pbat + OFF_KVC + 128, IWP, (jb + 1) * 64 + srow, SEQ, c8);
        rv = ld_row8(Pbat + OFF_KVC + 192, IWP, (jb + 1) * 64 + srow, SEQ, c8);
      }
      bool sb[2] = {false, false};
      sb[0] = ((jb < 64 ? (slo[0] >> jb) : (shi[0] >> (jb - 64))) & 1ull) != 0;
      if (__any(sb[0])) attn_tile<M_SEL, 1>(Q, O, st, Ks, Vt, Pb, biasT, tq, 0, jb * 64, sb, hpd, lane);
    }
#pragma unroll
    for (int rg = 0; rg < 1; ++rg) {
      const h16* gp = Pbat + (size_t)tq[rg] * IWP + OFF_GC;
#pragma unroll
      for (int j = 0; j < 4; ++j) {
        float ls = red16(st[rg].l[j]);
        float f = ls > 0.f ? (float)gp[j * 3 + 1] / ls : 0.f;
#pragma unroll
        for (int nt = 0; nt < 4; ++nt) Oc[rg][nt][j] += f * O[rg][nt][j];
      }
    }
#pragma unroll
    for (int rg = 0; rg < 1; ++rg) {
#pragma unroll
      for (int nt = 0; nt < 4; ++nt) O[rg][nt] = f32x4{0.f, 0.f, 0.f, 0.f};
#pragma unroll
      for (int j = 0; j < 4; ++j) { st[rg].m[j] = -1e30f; st[rg].l[j] = 0.f; }
    }
    const int w0 = cur >= 8 ? cur - 8 : 0;
    rk = ld_row8(Pbat + OFF_KVC + 256, IWP, w0 * 64 + srow, SEQ, c8);
    rv = ld_row8(Pbat + OFF_KVC + 320, IWP, w0 * 64 + srow, SEQ, c8);
    for (int wi = w0; wi <= cur; ++wi) {
      __syncthreads();
      st_k(Ks, srow, c8, rk);
      st_vt(Vt, srow, c8, rv);
      __syncthreads();
      if (wi + 1 <= cur) {
        rk = ld_row8(Pbat + OFF_KVC + 256, IWP, (wi + 1) * 64 + srow, SEQ, c8);
        rv = ld_row8(Pbat + OFF_KVC + 320, IWP, (wi + 1) * 64 + srow, SEQ, c8);
      }
      attn_tile<M_WIN, 1>(Q, O, st, Ks, Vt, Pb, biasT, tq, 0, wi * 64, nosel, hpd, lane);
    }
#pragma unroll
    for (int rg = 0; rg < 1; ++rg) {
      const h16* gp = Pbat + (size_t)tq[rg] * IWP + OFF_GC;
      float ss = 0.f;
#pragma unroll
      for (int j = 0; j < 4; ++j) {
        float ls = red16(st[rg].l[j]);
        float f = ls > 0.f ? (float)gp[j * 3 + 2] / ls : 0.f;
#pragma unroll
        for (int nt = 0; nt < 4; ++nt) {
          float v = Oc[rg][nt][j] + f * O[rg][nt][j];
          Oc[rg][nt][j] = v;
          ss += v * v;
        }
      }
      ss = red16(ss);
      float sc = rsqrtf(ss * (1.f / 256.f) + EPS);
#pragma unroll
      for (int j = 0; j < 4; ++j)
#pragma unroll
        for (int nt = 0; nt < 4; ++nt)
          OAC[((size_t)b * SEQ + tq[rg]) * 512 + 256 + j * 64 + nt * 16 + col] = (h16)(Oc[rg][nt][j] * sc);
    }
  }
}

constexpr int LDS_SWA = LDS_BIAS + LDS_PB + 4 * 64 * KP * 2 + 1024;
constexpr int lds_max(int a, int b) { return a > b ? a : b; }
constexpr int LDS_BYTES = lds_max(lds_max(LDS_NSA, SSMY_LDS), lds_max(LDS_SWA, lds_max(LDS_GEMM, 64 * 65 * 4)));

__global__ void __launch_bounds__(NT) fwd_megakernel(Params p) {
  cg::grid_group grid = cg::this_grid();
  __shared__ __attribute__((aligned(16))) char lds[LDS_BYTES];
  phase0(p, (float*)lds);
  grid.sync();
  phase0b(p);
  grid.sync();
  for (int l = 0; l < DEPTH; ++l) {
    phase_gemm1(p, l, lds);
    grid.sync();
    ssm_endstates(p, l);
    phase_compress(p, l);
    phase_swa(p, l, lds);
    grid.sync();
    phase_nsa(p, l, lds);
    ssm_outputs(p, l, lds);
    grid.sync();
    phase_glu(p, l, lds);
    grid.sync();
    phase_wout(p, l, lds);
    grid.sync();
    phase_up(p, l, lds);
    grid.sync();
    phase_down(p, l, lds);
    grid.sync();
  }
}

extern "C" void kernel_launch(void* const* d_in, const int* in_sizes, int n_in, void* d_out, int out_size, void* d_ws,
                              size_t ws_size, hipStream_t stream) {
  static int grid_blocks = 0;
  if (!grid_blocks) {
    int dev = 0, cus = 0, per_cu = 0;
    (void)hipGetDevice(&dev);
    (void)hipDeviceGetAttribute(&cus, hipDeviceAttributeMultiprocessorCount, dev);
    (void)hipOccupancyMaxActiveBlocksPerMultiprocessor(&per_cu, fwd_megakernel, NT, 0);
    if (per_cu > 1) per_cu = 1;
    grid_blocks = cus * per_cu;
  }
  if (ws_size < WS_NEED) {
    fprintf(stderr, "workspace too small: %zu < %zu\n", ws_size, WS_NEED);
    return;
  }
  Params p{};
  for (int i = 0; i < 24; ++i) p.in[i] = (const float*)d_in[i];
  p.out = (float*)d_out;
  p.ws = (char*)d_ws;
  void* args[] = {&p};
  hipError_t e = hipLaunchCooperativeKernel((void*)fwd_megakernel, dim3(grid_blocks), dim3(NT), args, 0, stream);
  if (e != hipSuccess) fprintf(stderr, "cooperative launch failed: %s (grid %d)\n", hipGetErrorString(e), grid_blocks);
}
```

```cpp
#include <hip/hip_runtime.h>
#include <hip/hip_cooperative_groups.h>
#include <cstdio>
namespace cg = cooperative_groups;

typedef _Float16 h16;
typedef __attribute__((ext_vector_type(8))) _Float16 h16x8;
typedef __attribute__((ext_vector_type(4))) float f32x4;

constexpr int NT = 512;
constexpr int NW = NT / 64;
constexpr int BATCH = 4, SEQ = 8192, NTOK = BATCH * SEQ, DM = 1024, DEPTH = 4, IW = 1676, IWP = 1792, DFF = 4096;
constexpr int OFF_U = 512, OFF_QC = 1024, OFF_KVC = 1280, OFF_GC = 1664;
constexpr int NCMP = 511;
constexpr float EPS = 1e-6f;

constexpr size_t SZ_WIN = (size_t)IWP * DM * 2, SZ_WGLU = (size_t)1024 * 512 * 2, SZ_WOUT = (size_t)DM * DM * 2,
                 SZ_WUP = (size_t)DFF * DM * 2, SZ_WDN = (size_t)DM * DFF * 2;
constexpr size_t O_WIN = 0;
constexpr size_t O_WGLU = O_WIN + DEPTH * SZ_WIN;
constexpr size_t O_WOUT = O_WGLU + DEPTH * SZ_WGLU;
constexpr size_t O_WUP = O_WOUT + DEPTH * SZ_WOUT;
constexpr size_t O_WDN = O_WUP + DEPTH * SZ_WUP;
constexpr size_t O_XB = O_WDN + DEPTH * SZ_WDN;
constexpr size_t O_SSQ = O_XB + (size_t)NTOK * DM * 2;
constexpr size_t O_SSQB = O_SSQ + (size_t)NTOK * 16 * 4;
constexpr size_t O_KCMP = O_SSQB + (size_t)NTOK * 16 * 4;
constexpr size_t O_VCMP = O_KCMP + (size_t)BATCH * 512 * 64 * 4;
constexpr size_t O_ABAR = O_VCMP + (size_t)BATCH * 512 * 64 * 4;
constexpr size_t O_BBAR = O_ABAR + (size_t)DEPTH * 32 * 64 * 8;
constexpr size_t O_BIAS1 = O_BBAR + (size_t)DEPTH * 32 * 64 * 16 * 8;
constexpr size_t O_LUT = O_BIAS1 + (size_t)DEPTH * 2 * 128 * 4;
constexpr size_t O_AT = O_LUT + 8192 * 4;
constexpr size_t O_KTAB = O_AT + (size_t)128 * 64 * 8;
constexpr size_t SZ_KTAB = (size_t)65 * 256 * 2;
constexpr size_t O_W1 = O_KTAB + 128 * SZ_KTAB;
constexpr size_t SZ_W13 = (size_t)128 * 1024 * 2;
constexpr size_t O_W3 = O_W1 + 128 * SZ_W13;
constexpr size_t O_W1T = O_W3 + 128 * SZ_W13;
constexpr size_t O_W2T = O_W1T + (size_t)8 * 128 * 2048 * 2;
constexpr size_t O_BIG = (O_W2T + (size_t)8 * 64 * 128 * 2 + 255) / 256 * 256;
constexpr size_t O_APOW = O_BIG;
constexpr size_t O_P = O_BIG;
constexpr size_t O_Z = O_P + (size_t)NTOK * IWP * 2;
constexpr size_t O_OB = O_Z + (size_t)NTOK * 512 * 2;
constexpr size_t O_OAC = O_OB + (size_t)NTOK * 512 * 2;
constexpr size_t O_E = O_OAC + (size_t)NTOK * 512 * 2;
constexpr size_t O_HID = O_BIG;
constexpr size_t WS_NEED = O_BIG + (size_t)NTOK * DFF * 2;

struct Params {
  const float* in[24];
  float* out;
  char* ws;
};

__device__ __forceinline__ int opaque_tid() {
  int t = threadIdx.x;
  asm volatile("" : "+v"(t));
  return t;
}
template <int CTRL>
__device__ __forceinline__ float dppf(float v) {
  return __int_as_float(__builtin_amdgcn_update_dpp(0, __float_as_int(v), CTRL, 0xF, 0xF, true));
}
__device__ __forceinline__ float sum16(float v) {
  v += dppf<0xB1>(v); v += dppf<0x4E>(v); v += dppf<0x141>(v); v += dppf<0x140>(v);
  return v;
}
__device__ __forceinline__ float max16(float v) {
  v = fmaxf(v, dppf<0xB1>(v)); v = fmaxf(v, dppf<0x4E>(v)); v = fmaxf(v, dppf<0x141>(v)); v = fmaxf(v, dppf<0x140>(v));
  return v;
}
__device__ __forceinline__ float xor16(float v) { return __int_as_float(__builtin_amdgcn_ds_swizzle(__float_as_int(v), 0x401F)); }
__device__ __forceinline__ float rdlane_c(float v, int l) { return __int_as_float(__builtin_amdgcn_readlane(__float_as_int(v), l)); }
__device__ __forceinline__ float wave_sum(float v) {
  v = sum16(v); v += xor16(v);
  return rdlane_c(v, 0) + rdlane_c(v, 32);
}
__device__ __forceinline__ float gelu_tanh(float x) {
  float u = 0.7978845608028654f * (x + 0.044715f * x * x * x);
  return 0.5f * x * (1.f + tanhf(u));
}
__device__ __forceinline__ float sigmoidf(float x) { return 1.f / (1.f + __expf(-x)); }
__device__ __forceinline__ float rdlane(float v, int l) {
  return __int_as_float(__builtin_amdgcn_readlane(__float_as_int(v), l));
}

template <class SrcF>
__device__ __forceinline__ void conv_tile(SrcF src, h16* dst, int ldo, int n0, int k0, float* tile) {
  int tid = opaque_tid();
  for (int idx = tid; idx < 4096; idx += NT) {
    int kk = idx >> 6, nn = idx & 63;
    tile[kk * 65 + nn] = src(k0 + kk, n0 + nn);
  }
  __syncthreads();
  for (int idx = tid; idx < 4096; idx += NT) {
    int nn = idx >> 6, kk = idx & 63;
    dst[(long)(n0 + nn) * ldo + k0 + kk] = (h16)tile[kk * 65 + nn];
  }
  __syncthreads();
}

__device__ void phase0(const Params& p, float* lds) {
  const int tid = opaque_tid();
  constexpr int T_IN = (IWP / 64) * (DM / 64);
  constexpr int T_GLU = 16 * 8;
  constexpr int T_OUT = 16 * 16;
  constexpr int T_UP = 64 * 16;
  constexpr int T_DN = 16 * 64;
  constexpr int T_L = T_IN + T_GLU + T_OUT + T_UP + T_DN;
  for (int ti = blockIdx.x; ti < DEPTH * T_L; ti += gridDim.x) {
    int l = ti / T_L, r = ti % T_L;
    if (r < T_IN) {
      int nt = r / 16, kt = r % 16;
      const float* w = p.in[2] + (size_t)l * DM * IW;
      const float* g = p.in[1] + l * DM;
      conv_tile([&](int k, int sl) {
        int n = (sl & ~255) + 64 * ((sl >> 5) & 3) + 32 * ((sl >> 7) & 1) + (sl & 31);
        return n < IW ? w[(long)k * IW + n] * g[k] : 0.f; },
                (h16*)(p.ws + O_WIN + l * SZ_WIN), DM, nt * 64, kt * 64, lds);
    } else if ((r -= T_IN) < T_GLU) {
      int nt = r / 8, kt = r % 8;
      const float* w = p.in[14] + (size_t)l * 512 * 1024;
      conv_tile([&](int k, int n2) {
        int pn = n2 >> 8, bj = (n2 >> 7) & 1, wc = (n2 >> 5) & 3, nn = (n2 >> 4) & 1, r = n2 & 15;
        int n = (nn ? 512 : 0) + 128 * pn + 64 * bj + 16 * wc + r;
        return w[(long)k * 1024 + n]; },
                (h16*)(p.ws + O_WGLU + l * SZ_WGLU), 512, nt * 64, kt * 64, lds);
    } else if ((r -= T_GLU) < T_OUT) {
      int seg = r / 128, nt = (r % 128) / 8, kt = r % 8;
      const float* w = p.in[20] + (size_t)l * DM * DM;
      const float* g = p.in[19] + l * DM;
      conv_tile([&](int k2, int n) {
        int k = seg == 0 ? 256 + k2 : (k2 < 256 ? k2 : 512 + k2);
        return w[(long)k * DM + n] * g[k]; },
                (h16*)(p.ws + O_WOUT + l * SZ_WOUT + (size_t)seg * DM * 512 * 2), 512, nt * 64, kt * 64, lds);
    } else if ((r -= T_OUT) < T_UP) {
      int nt = r / 16, kt = r % 16;
      const float* w = p.in[22] + (size_t)l * DM * DFF;
      const float* g = p.in[21] + l * DM;
      conv_tile([&](int k, int n) { return w[(long)k * DFF + n] * g[k]; },
                (h16*)(p.ws + O_WUP + l * SZ_WUP), DM, nt * 64, kt * 64, lds);
    } else {
      r -= T_UP;
      int nt = r / 64, kt = r % 64;
      const float* w = p.in[23] + (size_t)l * DFF * DM;
      conv_tile([&](int k, int n) { return w[(long)k * DM + n]; },
                (h16*)(p.ws + O_WDN + l * SZ_WDN), DFF, nt * 64, kt * 64, lds);
    }
  }
  for (int ti = blockIdx.x; ti < 8 * 66; ti += gridDim.x) {
    int ls = ti / 66, r = ti % 66;
    if (r < 64) {
      int nt = r >> 5, kt = r & 31;
      const float* w = p.in[17] + (size_t)ls * 2048 * 128;
      conv_tile([&](int k, int n) { return w[(long)k * 128 + n]; }, (h16*)(p.ws + O_W1T) + (size_t)ls * 128 * 2048, 2048, nt * 64, kt * 64, lds);
    } else {
      int kt = r - 64;
      const float* w = p.in[18] + (size_t)ls * 128 * 64;
      conv_tile([&](int k, int n) { return w[(long)k * 64 + n]; }, (h16*)(p.ws + O_W2T) + (size_t)ls * 64 * 128, 128, 0, kt * 64, lds);
    }
  }
  {
    const int lane = tid & 63;
    const int gw = blockIdx.x * NW + (tid >> 6), nw = gridDim.x * NW;
    const float* x = p.in[0];
    h16* xb = (h16*)(p.ws + O_XB);
    float* ssq = (float*)(p.ws + O_SSQ);
    for (int row = gw; row < NTOK; row += nw) {
      const float4* xr = (const float4*)(x + (long)row * DM + lane * 16);
      float s = 0.f;
      h16 hv[16];
      for (int i = 0; i < 4; ++i) {
        float4 v = xr[i];
        s += v.x * v.x + v.y * v.y + v.z * v.z + v.w * v.w;
        hv[i * 4 + 0] = (h16)v.x; hv[i * 4 + 1] = (h16)v.y; hv[i * 4 + 2] = (h16)v.z; hv[i * 4 + 3] = (h16)v.w;
      }
      h16x8* xo = (h16x8*)(xb + (long)row * DM + lane * 16);
      h16x8 o0, o1;
      for (int i = 0; i < 8; ++i) { o0[i] = hv[i]; o1[i] = hv[8 + i]; }
      xo[0] = o0; xo[1] = o1;
      s += dppf<0xB1>(s);
      s += dppf<0x4E>(s);
      if ((lane & 3) == 0) ssq[(long)row * 16 + (lane >> 2)] = s;
    }
  }
  const int gt = blockIdx.x * NT + tid, ngt = gridDim.x * NT;
  for (int i = gt; i < DEPTH * 32 * 64; i += ngt) {
    int l = i / 2048, g = (i / 64) % 32;
    double are = p.in[6][i], aim = p.in[7][i];
    double dt = exp((double)p.in[8][l * 32 + g]);
    double er = exp(are * dt), abr = er * cos(aim * dt), abi = er * sin(aim * dt);
    ((float2*)(p.ws + O_ABAR))[i] = make_float2((float)abr, (float)abi);
    double nr = abr - 1.0, ni = abi, den = are * are + aim * aim;
    double fr = (nr * are + ni * aim) / den, fi = (ni * are - nr * aim) / den;
    float2* bb = (float2*)(p.ws + O_BBAR) + (size_t)i * 16;
    for (int q = 0; q < 16; ++q) {
      double br = p.in[9][(size_t)i * 16 + q], bi = p.in[10][(size_t)i * 16 + q];
      bb[q] = make_float2((float)((fr * br - fi * bi) / dt), (float)((fr * bi + fi * br) / dt));
    }
  }
  for (int i = gt; i < 128 * 65 * 64; i += ngt) {
    int n = i & 63, j = (i >> 6) % 65, lg = i / (65 * 64);
    double are = p.in[6][lg * 64 + n], aim = p.in[7][lg * 64 + n];
    double dt = exp((double)p.in[8][lg]);
    double er = exp(are * dt * j), ang = aim * dt * j;
    ((double2*)(p.ws + O_APOW))[i] = make_double2(er * cos(ang), er * sin(ang));
  }
  for (int i = gt; i < DEPTH * 2 * 128; i += ngt) {
    int ls = i / 128, j = i % 128;
    const float* pos = p.in[16] + (size_t)ls * 2048;
    const float* w1 = p.in[17] + (size_t)ls * 2048 * 128;
    float a = 0.f;
    for (int k = 0; k < 2048; ++k) a += pos[k] * w1[(long)k * 128 + j];
    ((float*)(p.ws + O_BIAS1))[i] = a;
  }
  for (int d = gt; d < 8192; d += ngt) {
    int bk;
    if (d < 16) bk = d;
    else {
      float nf = (float)d;
      int large = 16 + (int)(logf(nf / 16.0f) / 4.1588830833596715f * 16.0f);
      bk = large < 31 ? large : 31;
    }
    ((int*)(p.ws + O_LUT))[d] = bk;
  }
}

__device__ void phase0b(const Params& p) {
  const int gt = blockIdx.x * NT + threadIdx.x, ngt = gridDim.x * NT;
  const double2* apow = (const double2*)(p.ws + O_APOW);
  const float2* bbs = (const float2*)(p.ws + O_BBAR);
  for (int i = gt; i < 128 * 64 * 64; i += ngt) {
    int tau = i & 63, n = (i >> 6) & 63, lg = i >> 12;
    double2 ap = apow[(lg * 65 + (63 - tau)) * 64 + n];
    const float2* bb = bbs + (size_t)(lg * 64 + n) * 16;
    h16x8 re0, re1, im0, im1;
#pragma unroll
    for (int q = 0; q < 8; ++q) {
      float2 b0 = bb[q], b1 = bb[8 + q];
      re0[q] = (h16)(float)(ap.x * b0.x - ap.y * b0.y);
      im0[q] = (h16)(float)(ap.x * b0.y + ap.y * b0.x);
      re1[q] = (h16)(float)(ap.x * b1.x - ap.y * b1.y);
      im1[q] = (h16)(float)(ap.x * b1.y + ap.y * b1.x);
    }
    h16* W1 = (h16*)(p.ws + O_W1 + (size_t)lg * SZ_W13);
    *(h16x8*)(W1 + ((size_t)(2 * tau) * 128 + 2 * n) * 8) = re0;
    *(h16x8*)(W1 + ((size_t)(2 * tau) * 128 + 2 * n + 1) * 8) = im0;
    *(h16x8*)(W1 + ((size_t)(2 * tau + 1) * 128 + 2 * n) * 8) = re1;
    *(h16x8*)(W1 + ((size_t)(2 * tau + 1) * 128 + 2 * n + 1) * 8) = im1;
  }
  for (int i = gt; i < 128 * 64 * 16 * 16; i += ngt) {
    int pp = i & 15, kc = (i >> 4) & 15, tau = (i >> 8) & 63, lg = i >> 14;
    h16x8 v;
#pragma unroll
    for (int e = 0; e < 4; ++e) {
      int n = 4 * kc + e;
      double2 ap = apow[(lg * 65 + tau + 1) * 64 + n];
      double cr = p.in[11][((size_t)lg * 16 + pp) * 64 + n], ci = p.in[12][((size_t)lg * 16 + pp) * 64 + n];
      v[2 * e] = (h16)(float)(cr * ap.x - ci * ap.y);
      v[2 * e + 1] = (h16)(float)(-(cr * ap.y + ci * ap.x));
    }
    h16* W3 = (h16*)(p.ws + O_W3 + (size_t)lg * SZ_W13);
    *(h16x8*)(W3 + ((size_t)((tau * 16 + kc) * 16) + pp) * 8) = v;
  }
  for (int i = gt; i < 128 * 65 * 16; i += ngt) {
    int pp = i & 15, slot = (i >> 4) % 65, lg = i / (65 * 16);
    float acc[16];
#pragma unroll
    for (int q = 0; q < 16; ++q) acc[q] = 0.f;
    if (slot > 0) {
      for (int n = 0; n < 64; ++n) {
        double2 ap = apow[(lg * 65 + slot - 1) * 64 + n];
        double cr = p.in[11][((size_t)lg * 16 + pp) * 64 + n], ci = p.in[12][((size_t)lg * 16 + pp) * 64 + n];
        float xr = (float)(cr * ap.x - ci * ap.y), xi = (float)(cr * ap.y + ci * ap.x);
        const float2* bb = bbs + (size_t)(lg * 64 + n) * 16;
#pragma unroll
        for (int q = 0; q < 16; ++q) { float2 b = bb[q]; acc[q] += xr * b.x - xi * b.y; }
      }
    }
    h16x8 v0, v1;
#pragma unroll
    for (int q = 0; q < 8; ++q) { v0[q] = (h16)acc[q]; v1[q] = (h16)acc[8 + q]; }
    h16* kt = (h16*)(p.ws + O_KTAB + (size_t)lg * SZ_KTAB) + slot * 256 + pp * 16;
    *(h16x8*)kt = v0;
    *(h16x8*)(kt + 8) = v1;
  }
  for (int i = gt; i < 128 * 64; i += ngt) {
    double2 ap = apow[((i >> 6) * 65 + 64) * 64 + (i & 63)];
    ((float2*)(p.ws + O_AT))[i] = make_float2((float)ap.x, (float)ap.y);
  }
}

__device__ void ssm_endstates(const Params& p, int l) {
  const int tid = opaque_tid(), lane = tid & 63, w = tid >> 6;
  const int gw = blockIdx.x * NW + w, nw = gridDim.x * NW;
  const h16* P = (const h16*)(p.ws + O_P);
  float* E = (float*)(p.ws + O_E);
  for (int unit = gw; unit < 32 * 32; unit += nw) {
    int g = unit >> 5, ctile = unit & 31;
    const h16* W1 = (const h16*)(p.ws + O_W1 + (size_t)(l * 32 + g) * SZ_W13);
    int gch = ctile * 16 + (lane & 15);
    const h16* ub = P + (size_t)gch * 64 * IWP + OFF_U + g * 16 + ((lane >> 4) & 1) * 8 + (size_t)(lane >> 5) * IWP;
    f32x4 acc[8];
#pragma unroll
    for (int mt = 0; mt < 8; ++mt) acc[mt] = f32x4{0.f, 0.f, 0.f, 0.f};
#pragma unroll 2
    for (int ks = 0; ks < 32; ++ks) {
      h16x8 B = *(const h16x8*)(ub + (size_t)(ks * 2) * IWP);
#pragma unroll
      for (int mt = 0; mt < 8; ++mt) {
        h16x8 A = *(const h16x8*)(W1 + ((size_t)(ks * 4 + (lane >> 4)) * 128 + mt * 16 + (lane & 15)) * 8);
        acc[mt] = __builtin_amdgcn_mfma_f32_16x16x32_f16(A, B, acc[mt], 0, 0, 0);
      }
    }
#pragma unroll
    for (int mt = 0; mt < 8; ++mt)
      *(f32x4*)(E + ((size_t)gch * 32 + g) * 128 + mt * 16 + (lane >> 4) * 4) = acc[mt];
  }
}

constexpr int BU_PITCH = 1032, BS_PITCH = 136;
constexpr int SSMY_LDS = 65 * 512 + 16 * BU_PITCH * 2 + 16 * BS_PITCH * 2;
__device__ void ssm_outputs(const Params& p, int l, char* lds) {
  const int tid = opaque_tid(), lane = tid & 63, w = tid >> 6;
  h16* Kt = (h16*)lds;
  h16* Bu = (h16*)(lds + 65 * 512);
  h16* Bs = (h16*)(lds + 65 * 512 + 16 * BU_PITCH * 2);
  const h16* P = (const h16*)(p.ws + O_P);
  const float* E = (const float*)(p.ws + O_E);
  h16* Z = (h16*)(p.ws + O_Z);
  for (int unit = blockIdx.x; unit < 1024; unit += gridDim.x) {
    const int g = unit & 31, bc = unit >> 5, b = bc >> 3, ct = bc & 7;
    const int lg = l * 32 + g;
    __syncthreads();
    if (w == 0) {
      float2 at = ((const float2*)(p.ws + O_AT))[lg * 64 + lane];
      const float2* Eb = (const float2*)E + ((size_t)(b * 128) * 32 + g) * 64 + lane;
      float sr = 0.f, si = 0.f;
      const int c0 = ct * 16;
#pragma unroll 8
      for (int c = 0; c < c0; ++c) {
        float2 e = Eb[(size_t)c * 2048];
        float nr = at.x * sr - at.y * si + e.x, ni = at.x * si + at.y * sr + e.y;
        sr = nr; si = ni;
      }
#pragma unroll
      for (int i = 0; i < 16; ++i) {
        Bs[i * BS_PITCH + 2 * lane] = (h16)sr;
        Bs[i * BS_PITCH + 2 * lane + 1] = (h16)si;
        float2 e = Eb[(size_t)(c0 + i) * 2048];
        float nr = at.x * sr - at.y * si + e.x, ni = at.x * si + at.y * sr + e.y;
        sr = nr; si = ni;
      }
    } else {
      const int t2 = tid - 64, n2 = NT - 64;
      const h16x8* ks = (const h16x8*)(p.ws + O_KTAB + (size_t)lg * SZ_KTAB);
      for (int i = t2; i < 65 * 32; i += n2) ((h16x8*)Kt)[i] = ks[i];
      for (int i = t2; i < 2048; i += n2) {
        int tk = i >> 1, hf = i & 1;
        h16x8 v = *(const h16x8*)(P + ((size_t)b * SEQ + ct * 1024 + tk) * IWP + OFF_U + g * 16 + hf * 8);
        *(h16x8*)(Bu + (tk >> 6) * BU_PITCH + (tk & 63) * 16 + hf * 8) = v;
      }
    }
    __syncthreads();
    const float dt = expf(p.in[8][lg]);
    const int col = lane & 15, hi = lane >> 5, qh = (lane >> 4) & 1, p0 = (lane >> 4) * 4;
    const h16* W3 = (const h16*)(p.ws + O_W3 + (size_t)lg * SZ_W13);
    float dsk[4];
    for (int j = 0; j < 4; ++j) dsk[j] = p.in[13][l * 512 + g * 16 + p0 + j];
    for (int r = 0; r < 64 / NW; ++r) {
      const int base = (r >> 1) * 2 * NW;
      const int tau = (r & 1) ? base + 2 * NW - 1 - w : base + w;
      f32x4 acc = {0.f, 0.f, 0.f, 0.f};
      const int nks = tau / 2 + 1;
      for (int i = 0; i < nks; ++i) {
        int j = tau - (2 * i + hi);
        h16x8 A = *(const h16x8*)(Kt + (j + 1) * 256 + (lane & 15) * 16 + qh * 8);
        h16x8 B = *(const h16x8*)(Bu + col * BU_PITCH + (2 * i + hi) * 16 + qh * 8);
        acc = __builtin_amdgcn_mfma_f32_16x16x32_f16(A, B, acc, 0, 0, 0);
      }
#pragma unroll
      for (int ks = 0; ks < 4; ++ks) {
        h16x8 A = *(const h16x8*)(W3 + ((size_t)((tau * 16 + ks * 4 + (lane >> 4)) * 16) + (lane & 15)) * 8);
        h16x8 B = *(const h16x8*)(Bs + col * BS_PITCH + ks * 32 + (lane >> 4) * 8);
        acc = __builtin_amdgcn_mfma_f32_16x16x32_f16(A, B, acc, 0, 0, 0);
      }
      const h16* up = Bu + col * BU_PITCH + tau * 16 + p0;
      size_t tok = ((size_t)b * 128 + ct * 16 + col) * 64 + tau;
      h16 zz[4];
      for (int j = 0; j < 4; ++j) zz[j] = (h16)gelu_tanh(dt * acc[j] + dsk[j] * (float)up[j]);
      typedef __attribute__((ext_vector_type(4))) _Float16 h16x4;
      h16x4 zv = {zz[0], zz[1], zz[2], zz[3]};
      *(h16x4*)(Z + tok * 512 + g * 16 + p0) = zv;
    }
  }
}

#define LAS __attribute__((address_space(3)))
typedef _Float16 h16x4 __attribute__((ext_vector_type(4)));
namespace g8 {
constexpr int BM = 256, BK = 64, HALF = 128, HTB = HALF * BK * 2, STAGE_BYTES = 8 * HTB, NXCD = 8, WGM = 8;
__device__ __forceinline__ int lds_byte(int r, int c) {
  const int st = (r >> 4) * 2 + (c >> 5), rr = r & 15, cc = c & 31, ob = rr * 64 + cc * 2;
  return st * 1024 + (ob ^ (((ob >> 9) & 1) << 5));
}
__device__ __forceinline__ void stage_rc(int b, int& R, int& C) {
  const int st = b / 1024, sb = b % 1024, swz = sb ^ (((sb >> 9) & 1) << 5);
  R = (st >> 1) * 16 + swz / 64;
  C = (st & 1) * 32 + (swz % 64) / 2;
}
struct Unit { int pm, pn; };
struct Order {
  int nM, nN, nwg, G, c;
  __device__ void init(int M, int N, int G_, int c_) { nM = M / BM; nN = N / BM; nwg = nM * nN; G = G_; c = c_; }
  __device__ bool next(int i, Unit& u) const {
    const long L = (long)i * G + c;
    if (L >= nwg) return false;
    int wgid = (int)L;
    { const int q = nwg / NXCD, r = nwg % NXCD, xcd = wgid % NXCD, off = wgid / NXCD; wgid = (xcd < r ? xcd * (q + 1) : r * (q + 1) + (xcd - r) * q) + off; }
    const int nig = WGM * nN, gid = wgid / nig, fm = gid * WGM, gsz = (nM - fm) < WGM ? (nM - fm) : WGM;
    u.pm = fm + ((wgid % nig) % gsz);
    u.pn = (wgid % nig) / gsz;
    return true;
  }
};
template <class Epi>
__device__ __forceinline__ void gemm_phase(LAS unsigned char* lds, const h16* A, const h16* Bt, int K, const Order& S, const Epi& E) {
  const int tid = opaque_tid(), wid = __builtin_amdgcn_readfirstlane(tid >> 6), lane = tid & 63, wr = wid >> 2, wc = wid & 3, fr = lane & 15, fq = lane >> 4;
  const int nt = K / BK;
  unsigned voffA[2];
#pragma unroll
  for (int i = 0; i < 2; ++i) { int R, C; stage_rc(tid * 16 + i * 8192, R, C); voffA[i] = (unsigned)(R * K + C) * 2u; }
  const size_t kstep = (size_t)(BK * 2);
  const size_t hstep = (size_t)HALF * K * 2;
  const size_t tstep = 2 * hstep;
  const unsigned ldsw = (unsigned)wid * 1024u;
  const int aoff = lds_byte(wr * 64 + fr, fq * 8), boff = lds_byte(wc * 32 + fr, fq * 8);
#define G8_SA(b, h) (((b) * 2 + (h)) * HTB)
#define G8_SB(b, h) ((4 + (b) * 2 + (h)) * HTB)
#define G8_STAGE(bufoff, gbase) do { _Pragma("unroll") for (int _i = 0; _i < 2; ++_i) \
    __builtin_amdgcn_global_load_lds((const unsigned*)((const char*)(gbase) + voffA[_i]), (LAS unsigned*)(lds + (bufoff) + ldsw + _i * 8192), 16, 0, 0); } while (0)
#define G8_LDA(dst, b, h) do { _Pragma("unroll") for (int m = 0; m < 4; ++m) _Pragma("unroll") for (int k = 0; k < 2; ++k) dst[m][k] = *(const LAS h16x8*)(lds + G8_SA(b, h) + aoff + m * 2048 + k * 1024); } while (0)
#define G8_LDB(dst, b, h) do { _Pragma("unroll") for (int n = 0; n < 2; ++n) _Pragma("unroll") for (int k = 0; k < 2; ++k) dst[n][k] = *(const LAS h16x8*)(lds + G8_SB(b, h) + boff + n * 2048 + k * 1024); } while (0)
#define G8_MMA(ai, bj, At, Bt_) do { __builtin_amdgcn_s_setprio(1); _Pragma("unroll") for (int m = 0; m < 4; ++m) _Pragma("unroll") for (int n = 0; n < 2; ++n) _Pragma("unroll") for (int k = 0; k < 2; ++k) \
    acc[ai][bj][m][n] = __builtin_amdgcn_mfma_f32_16x16x32_f16(Bt_[n][k], At[m][k], acc[ai][bj][m][n], 0, 0, 0); __builtin_amdgcn_s_setprio(0); } while (0)
#define G8_WAIT_V(n) asm volatile("s_waitcnt vmcnt(" #n ")" ::: "memory")
#define G8_WAIT_L(n) asm volatile("s_waitcnt lgkmcnt(" #n ")" ::: "memory")
#define G8_BAR __builtin_amdgcn_s_barrier()
#define G8_SCHED __builtin_amdgcn_sched_barrier(0)
  Unit cur, nxt;
  int ui = 0;
  if (!S.next(0, cur)) return;
  f32x4 acc[2][2][4][2];
#pragma unroll
  for (int a = 0; a < 2; ++a)
#pragma unroll
    for (int b = 0; b < 2; ++b)
#pragma unroll
      for (int m = 0; m < 4; ++m)
#pragma unroll
        for (int n = 0; n < 2; ++n) acc[a][b][m][n] = (f32x4){0.f, 0.f, 0.f, 0.f};
  h16x8 At[4][2], B0[2][2], B1[2][2];
  const char* cA = (const char*)A + (size_t)cur.pm * tstep;
  const char* cB = (const char*)Bt + (size_t)cur.pn * tstep;
  G8_STAGE(G8_SB(0, 0), cB); G8_STAGE(G8_SA(0, 0), cA); G8_STAGE(G8_SB(0, 1), cB + hstep); G8_STAGE(G8_SA(0, 1), cA + hstep);
  if (wr == 1) G8_BAR;
  G8_WAIT_V(4); G8_BAR;
  G8_STAGE(G8_SB(1, 0), cB + kstep); G8_STAGE(G8_SA(1, 0), cA + kstep); G8_STAGE(G8_SB(1, 1), cB + hstep + kstep);
  G8_WAIT_V(6); G8_BAR;
  for (;;) {
    const bool has_next = S.next(ui + 1, nxt);
    const char* nA = has_next ? (const char*)A + (size_t)nxt.pm * tstep : cA;
    const char* nB = has_next ? (const char*)Bt + (size_t)nxt.pn * tstep : cB;
    for (int t = 0; t < nt; t += 2) {
      const bool last = (t == nt - 2);
      const char* a1 = cA + (size_t)(t + 1) * kstep;
      const char* a2 = last ? nA : cA + (size_t)(t + 2) * kstep;
      const char* b2 = last ? nB : cB + (size_t)(t + 2) * kstep;
      const char* a3 = a2 + kstep;
      const char* b3 = b2 + kstep;
      G8_LDB(B0, 0, 0); G8_SCHED; G8_LDA(At, 0, 0); G8_STAGE(G8_SA(1, 1), a1 + hstep);
      G8_WAIT_L(8); G8_BAR; G8_WAIT_L(0); G8_MMA(0, 0, At, B0); G8_BAR; G8_SCHED;
      G8_LDB(B1, 0, 1); G8_STAGE(G8_SB(0, 0), b2);
      G8_BAR; G8_WAIT_L(0); G8_MMA(0, 1, At, B1); G8_BAR;
      G8_LDA(At, 0, 1); G8_STAGE(G8_SA(0, 0), a2);
      G8_BAR; G8_WAIT_L(0); G8_MMA(1, 0, At, B0); G8_BAR; G8_SCHED;
      G8_STAGE(G8_SB(0, 1), b2 + hstep);
      G8_WAIT_V(6); G8_BAR; G8_MMA(1, 1, At, B1); G8_BAR;
      G8_LDB(B0, 1, 0); G8_SCHED; G8_LDA(At, 1, 0); G8_STAGE(G8_SA(0, 1), a2 + hstep);
      G8_WAIT_L(8); G8_BAR; G8_WAIT_L(0); G8_MMA(0, 0, At, B0); G8_BAR; G8_SCHED;
      G8_LDB(B1, 1, 1); G8_STAGE(G8_SB(1, 0), b3);
      G8_BAR; G8_WAIT_L(0); G8_MMA(0, 1, At, B1); G8_BAR;
      G8_LDA(At, 1, 1); G8_STAGE(G8_SA(1, 0), a3);
      G8_BAR; G8_WAIT_L(0); G8_MMA(1, 0, At, B0); G8_BAR; G8_SCHED;
      G8_STAGE(G8_SB(1, 1), b3 + hstep);
      G8_WAIT_V(6); G8_BAR; G8_MMA(1, 1, At, B1); G8_BAR;
    }
    E(acc, cur, ui, wr, wc, fr, fq);
    if (!has_next) break;
#pragma unroll
    for (int a = 0; a < 2; ++a)
#pragma unroll
      for (int b = 0; b < 2; ++b)
#pragma unroll
        for (int m = 0; m < 4; ++m)
#pragma unroll
          for (int n = 0; n < 2; ++n) acc[a][b][m][n] = (f32x4){0.f, 0.f, 0.f, 0.f};
    cur = nxt; cA = nA; cB = nB; ++ui;
  }
  G8_WAIT_V(0);
  if (wr == 0) G8_BAR;
  G8_BAR;
#undef G8_SA
#undef G8_SB
#undef G8_STAGE
#undef G8_LDA
#undef G8_LDB
#undef G8_MMA
#undef G8_WAIT_V
#undef G8_WAIT_L
#undef G8_BAR
#undef G8_SCHED
}
}

constexpr int RSL_OFF = g8::STAGE_BYTES;
constexpr int LDS_GEMM = g8::STAGE_BYTES + 8 * 256 * 4;

__device__ __forceinline__ void fill_rowscales(float* rsl, const float* ssq, float inv_n, const g8::Order& S) {
  const int tid = opaque_tid();
  g8::Unit u;
  __syncthreads();
  for (int i = 0; S.next(i, u); ++i) {
    if (tid < 256) {
      const float4* s4 = (const float4*)(ssq + (size_t)(u.pm * 256 + tid) * 16);
      float s = 0.f;
      for (int k = 0; k < 4; ++k) { float4 v = s4[k]; s += v.x + v.y + v.z + v.w; }
      rsl[i * 256 + tid] = rsqrtf(s * inv_n + EPS);
    }
  }
  __syncthreads();
}

__device__ __forceinline__ h16x4 pack4(float a, float b, float c, float d) { h16x4 v = {(h16)a, (h16)b, (h16)c, (h16)d}; return v; }

struct EpiIn {
  h16* P; const float* rsl; const float* qkg;
  __device__ __forceinline__ void operator()(const f32x4 (&acc)[2][2][4][2], const g8::Unit& u, int ui, int wr, int wc, int fr, int fq) const {
    const int hs = u.pn * 4 + wc;
    int gi = -1;
    if (hs < 4) gi = 0; else if (hs < 6) gi = 1; else if (hs >= 16 && hs < 20) gi = 2; else if (hs == 22) gi = 4; else if (hs == 24) gi = 5;
    const bool gate = (hs == 26);
#pragma unroll
    for (int ai = 0; ai < 2; ++ai)
#pragma unroll
      for (int m = 0; m < 4; ++m) {
        const int rl = 128 * ai + 64 * wr + 16 * m + fr;
        const float r = rsl[ui * 256 + rl];
        f32x4 v[2][2];
#pragma unroll
        for (int bj = 0; bj < 2; ++bj)
#pragma unroll
          for (int n = 0; n < 2; ++n) v[bj][n] = acc[ai][bj][m][n] * r;
        if (gi >= 0) {
          float ss = 0.f;
#pragma unroll
          for (int bj = 0; bj < 2; ++bj)
#pragma unroll
            for (int n = 0; n < 2; ++n)
#pragma unroll
              for (int j = 0; j < 4; ++j) ss += v[bj][n][j] * v[bj][n][j];
          ss += xor16(ss);
          ss += __shfl_xor(ss, 32);
          const float sc = rsqrtf(ss * (1.f / 64.f) + EPS);
#pragma unroll
          for (int bj = 0; bj < 2; ++bj)
#pragma unroll
            for (int n = 0; n < 2; ++n) {
              const float4 g4 = *(const float4*)(qkg + gi * 64 + 32 * bj + 16 * n + 4 * fq);
              v[bj][n][0] *= sc * g4.x; v[bj][n][1] *= sc * g4.y; v[bj][n][2] *= sc * g4.z; v[bj][n][3] *= sc * g4.w;
            }
        } else if (gate) {
#pragma unroll
          for (int bj = 0; bj < 2; ++bj)
#pragma unroll
            for (int n = 0; n < 2; ++n)
#pragma unroll
              for (int j = 0; j < 4; ++j) v[bj][n][j] = (32 * bj + 16 * n + 4 * fq + j) < 12 ? sigmoidf(v[bj][n][j]) : 0.f;
        }
        h16* rowp = P + (size_t)(u.pm * 256 + rl) * IWP + 64 * hs + 4 * fq;
#pragma unroll
        for (int bj = 0; bj < 2; ++bj)
#pragma unroll
          for (int n = 0; n < 2; ++n) *(h16x4*)(rowp + 32 * bj + 16 * n) = pack4(v[bj][n][0], v[bj][n][1], v[bj][n][2], v[bj][n][3]);
      }
  }
};

struct EpiGlu {
  h16* OB; float* ssqb; const float* gb;
  __device__ __forceinline__ void operator()(const f32x4 (&acc)[2][2][4][2], const g8::Unit& u, int ui, int wr, int wc, int fr, int fq) const {
    const int ocb = 128 * u.pn + 16 * wc + 4 * fq;
    float4 ba[2], bb[2];
#pragma unroll
    for (int bj = 0; bj < 2; ++bj) { ba[bj] = *(const float4*)(gb + ocb + 64 * bj); bb[bj] = *(const float4*)(gb + 512 + ocb + 64 * bj); }
#pragma unroll
    for (int ai = 0; ai < 2; ++ai)
#pragma unroll
      for (int m = 0; m < 4; ++m) {
        const size_t row = (size_t)u.pm * 256 + 128 * ai + 64 * wr + 16 * m + fr;
        float ss = 0.f;
#pragma unroll
        for (int bj = 0; bj < 2; ++bj) {
          const f32x4 a = acc[ai][bj][m][0], b = acc[ai][bj][m][1];
          float o0 = (a[0] + ba[bj].x) * sigmoidf(b[0] + bb[bj].x);
          float o1 = (a[1] + ba[bj].y) * sigmoidf(b[1] + bb[bj].y);
          float o2 = (a[2] + ba[bj].z) * sigmoidf(b[2] + bb[bj].z);
          float o3 = (a[3] + ba[bj].w) * sigmoidf(b[3] + bb[bj].w);
          *(h16x4*)(OB + row * 512 + ocb + 64 * bj) = pack4(o0, o1, o2, o3);
          ss += o0 * o0 + o1 * o1 + o2 * o2 + o3 * o3;
        }
        ss += xor16(ss);
        ss += __shfl_xor(ss, 32);
        if (fq == 0) ssqb[row * 16 + u.pn * 4 + wc] = ss;
      }
  }
};

struct EpiOutB {
  float* xo; const float* xsrc; const float* rsl;
  __device__ __forceinline__ void operator()(const f32x4 (&acc)[2][2][4][2], const g8::Unit& u, int ui, int wr, int wc, int fr, int fq) const {
#pragma unroll
    for (int ai = 0; ai < 2; ++ai)
#pragma unroll
      for (int m = 0; m < 4; ++m) {
        const int rl = 128 * ai + 64 * wr + 16 * m + fr;
        const float r = rsl[ui * 256 + rl];
        const size_t base = (size_t)(u.pm * 256 + rl) * DM + 256 * u.pn + 32 * wc + 4 * fq;
#pragma unroll
        for (int bj = 0; bj < 2; ++bj)
#pragma unroll
          for (int n = 0; n < 2; ++n) {
            const size_t idx = base + 128 * bj + 16 * n;
            const float4 xv = *(const float4*)(xsrc + idx);
            const f32x4 a = acc[ai][bj][m][n];
            *(float4*)(xo + idx) = make_float4(xv.x + r * a[0], xv.y + r * a[1], xv.z + r * a[2], xv.w + r * a[3]);
          }
      }
  }
};

struct EpiRes {
  float* xo; h16* xb; float* ssq;
  __device__ __forceinline__ void operator()(const f32x4 (&acc)[2][2][4][2], const g8::Unit& u, int ui, int wr, int wc, int fr, int fq) const {
#pragma unroll
    for (int ai = 0; ai < 2; ++ai)
#pragma unroll
      for (int m = 0; m < 4; ++m) {
        const size_t row = (size_t)u.pm * 256 + 128 * ai + 64 * wr + 16 * m + fr;
        const size_t base = row * DM + 256 * u.pn + 32 * wc + 4 * fq;
        float ss = 0.f;
#pragma unroll
        for (int bj = 0; bj < 2; ++bj)
#pragma unroll
          for (int n = 0; n < 2; ++n) {
            const size_t idx = base + 128 * bj + 16 * n;
            const float4 xv = *(const float4*)(xo + idx);
            const f32x4 a = acc[ai][bj][m][n];
            const float x0 = xv.x + a[0], x1 = xv.y + a[1], x2 = xv.z + a[2], x3 = xv.w + a[3];
            *(float4*)(xo + idx) = make_float4(x0, x1, x2, x3);
            *(h16x4*)(xb + idx) = pack4(x0, x1, x2, x3);
            ss += x0 * x0 + x1 * x1 + x2 * x2 + x3 * x3;
          }
        ss += xor16(ss);
        ss += __shfl_xor(ss, 32);
        if (fq == 0) ssq[row * 16 + u.pn * 4 + wc] = ss;
      }
  }
};

struct EpiUp {
  h16* hid; const float* rsl;
  __device__ __forceinline__ void operator()(const f32x4 (&acc)[2][2][4][2], const g8::Unit& u, int ui, int wr, int wc, int fr, int fq) const {
#pragma unroll
    for (int ai = 0; ai < 2; ++ai)
#pragma unroll
      for (int m = 0; m < 4; ++m) {
        const int rl = 128 * ai + 64 * wr + 16 * m + fr;
        const float r = rsl[ui * 256 + rl];
        h16* rowp = hid + (size_t)(u.pm * 256 + rl) * DFF + 256 * u.pn + 32 * wc + 4 * fq;
#pragma unroll
        for (int bj = 0; bj < 2; ++bj)
#pragma unroll
          for (int n = 0; n < 2; ++n) {
            const f32x4 a = acc[ai][bj][m][n];
            float v0 = fmaxf(a[0] * r, 0.f), v1 = fmaxf(a[1] * r, 0.f), v2 = fmaxf(a[2] * r, 0.f), v3 = fmaxf(a[3] * r, 0.f);
            *(h16x4*)(rowp + 128 * bj + 16 * n) = pack4(v0 * v0, v1 * v1, v2 * v2, v3 * v3);
          }
      }
  }
};

__device__ void phase_gemm1(const Params& p, int l, char* lds) {
  g8::Order S; S.init(NTOK, IWP, gridDim.x, blockIdx.x);
  float* rsl = (float*)(lds + RSL_OFF);
  fill_rowscales(rsl, (const float*)(p.ws + O_SSQ), 1.f / DM, S);
  EpiIn E{(h16*)(p.ws + O_P), rsl, p.in[3] + l * 6 * 64};
  g8::gemm_phase((LAS unsigned char*)lds, (const h16*)(p.ws + O_XB), (const h16*)(p.ws + O_WIN + l * SZ_WIN), DM, S, E);
}
__device__ void phase_glu(const Params& p, int l, char* lds) {
  g8::Order S; S.init(NTOK, 1024, gridDim.x, blockIdx.x);
  __syncthreads();
  EpiGlu E{(h16*)(p.ws + O_OB), (float*)(p.ws + O_SSQB), p.in[15] + l * 1024};
  g8::gemm_phase((LAS unsigned char*)lds, (const h16*)(p.ws + O_Z), (const h16*)(p.ws + O_WGLU + l * SZ_WGLU), 512, S, E);
}
__device__ void phase_wout(const Params& p, int l, char* lds) {
  g8::Order S; S.init(NTOK, DM, gridDim.x, blockIdx.x);
  float* rsl = (float*)(lds + RSL_OFF);
  fill_rowscales(rsl, (const float*)(p.ws + O_SSQB), 1.f / 512.f, S);
  EpiOutB E1{p.out, (l == 0) ? p.in[0] : p.out, rsl};
  g8::gemm_phase((LAS unsigned char*)lds, (const h16*)(p.ws + O_OB), (const h16*)(p.ws + O_WOUT + l * SZ_WOUT), 512, S, E1);
  __syncthreads();
  EpiRes E2{p.out, (h16*)(p.ws + O_XB), (float*)(p.ws + O_SSQ)};
  g8::gemm_phase((LAS unsigned char*)lds, (const h16*)(p.ws + O_OAC), (const h16*)(p.ws + O_WOUT + l * SZ_WOUT + (size_t)DM * 512 * 2), 512, S, E2);
}
__device__ void phase_up(const Params& p, int l, char* lds) {
  g8::Order S; S.init(NTOK, DFF, gridDim.x, blockIdx.x);
  float* rsl = (float*)(lds + RSL_OFF);
  fill_rowscales(rsl, (const float*)(p.ws + O_SSQ), 1.f / DM, S);
  EpiUp E{(h16*)(p.ws + O_HID), rsl};
  g8::gemm_phase((LAS unsigned char*)lds, (const h16*)(p.ws + O_XB), (const h16*)(p.ws + O_WUP + l * SZ_WUP), DM, S, E);
}
__device__ void phase_down(const Params& p, int l, char* lds) {
  g8::Order S; S.init(NTOK, DM, gridDim.x, blockIdx.x);
  __syncthreads();
  EpiRes E{p.out, (h16*)(p.ws + O_XB), (float*)(p.ws + O_SSQ)};
  g8::gemm_phase((LAS unsigned char*)lds, (const h16*)(p.ws + O_HID), (const h16*)(p.ws + O_WDN + l * SZ_WDN), DFF, S, E);
}

constexpr int KP = 72;
enum { M_SWA = 0, M_WIN = 1, M_SEL = 2, M_CMPA = 3, M_CMPB = 4 };
struct RowState { float m[4], l[4]; };

__device__ __forceinline__ h16x8 ld_row8(const h16* base, int ld, int row, int nrows, int c8) {
  h16x8 z = {0, 0, 0, 0, 0, 0, 0, 0};
  return (row >= 0 && row < nrows) ? *(const h16x8*)(base + (size_t)row * ld + c8 * 8) : z;
}
__device__ __forceinline__ void st_k(h16* Ks, int row, int c8, h16x8 v) { *(h16x8*)(Ks + row * KP + c8 * 8) = v; }
__device__ __forceinline__ void st_vt(h16* Vt, int row, int c8, h16x8 v) {
#pragma unroll
  for (int e = 0; e < 8; ++e) Vt[(c8 * 8 + e) * KP + row] = v[e];
}

template <int MODE, int RGM>
__device__ __forceinline__ void attn_tile(const h16x8 (&Q)[2][2], f32x4 (&O)[2][4], RowState (&st)[2], const h16* Ks,
                                          const h16* Vt, h16* Pb, const float* biasT, const int (&tq)[2], int head,
                                          int kbase, const bool (&selbit)[2], float (&hp)[2][4], const int lane) {
  const int col = lane & 15, q4 = lane >> 4;
  f32x4 S[2][4];
#pragma unroll
  for (int kt = 0; kt < 4; ++kt) {
#pragma unroll
    for (int rg = 0; rg < 2; ++rg) S[rg][kt] = f32x4{0.f, 0.f, 0.f, 0.f};
#pragma unroll
    for (int ks = 0; ks < 2; ++ks) {
      h16x8 B = *(const h16x8*)(Ks + (kt * 16 + col) * KP + ks * 32 + q4 * 8);
#pragma unroll
      for (int rg = 0; rg < 2; ++rg)
        if (RGM & (1 << rg)) S[rg][kt] = __builtin_amdgcn_mfma_f32_16x16x32_f16(Q[rg][ks], B, S[rg][kt], 0, 0, 0);
    }
  }
#pragma unroll
  for (int rg = 0; rg < 2; ++rg) {
    if (!(RGM & (1 << rg))) continue;
#pragma unroll
    for (int kt = 0; kt < 4; ++kt) {
      const int kx = kbase + kt * 16 + col;
      if (MODE == M_SWA) {
#pragma unroll
        for (int j = 0; j < 4; ++j) {
          int dist = tq[rg] + j - kx;
          bool valid = dist >= 0 && dist < 128 && kx >= 0;
          int dc = dist < 0 ? 0 : (dist > 799 ? 799 : dist);
          S[rg][kt][j] = valid ? S[rg][kt][j] * 0.125f + biasT[dc * 4 + head] : -1e30f;
        }
      } else {
        int dist;
        bool valid;
        if (MODE == M_WIN) { dist = tq[rg] - kx; valid = dist >= 0 && dist < 512 && kx >= 0; }
        else if (MODE == M_SEL) { dist = tq[rg] - kx; valid = selbit[rg] && dist >= 0; }
        else { dist = tq[rg] - (16 * kx + 31); valid = dist >= 0 && kx < NCMP; }
        int dc = dist < 0 ? 0 : (dist > 799 ? 799 : dist);
        float4 bv = *(const float4*)(biasT + dc * 4);
        S[rg][kt][0] = valid ? S[rg][kt][0] * 0.125f + bv.x : -1e30f;
        S[rg][kt][1] = valid ? S[rg][kt][1] * 0.125f + bv.y : -1e30f;
        S[rg][kt][2] = valid ? S[rg][kt][2] * 0.125f + bv.z : -1e30f;
        S[rg][kt][3] = valid ? S[rg][kt][3] * 0.125f + bv.w : -1e30f;
      }
    }
    if (MODE == M_CMPB) {
#pragma unroll
      for (int kt = 0; kt < 4; ++kt) {
        float h = 0.f;
#pragma unroll
        for (int j = 0; j < 4; ++j) {
          float pv = __expf(S[rg][kt][j] - st[rg].m[j]) * st[rg].l[j];
          S[rg][kt][j] = pv;
          h += pv;
        }
        hp[rg][kt] = h;
      }
    } else {
#pragma unroll
      for (int j = 0; j < 4; ++j) {
        float mx = fmaxf(fmaxf(S[rg][0][j], S[rg][1][j]), fmaxf(S[rg][2][j], S[rg][3][j]));
        mx = max16(mx);
        float mn = fmaxf(st[rg].m[j], mx);
        float corr = __expf(st[rg].m[j] - mn);
        st[rg].m[j] = mn;
        float mm = fmaxf(mn, -1e20f);
        float ls = 0.f;
#pragma unroll
        for (int kt = 0; kt < 4; ++kt) {
          float pv = __expf(S[rg][kt][j] - mm);
          S[rg][kt][j] = pv;
          ls += pv;
        }
        st[rg].l[j] = st[rg].l[j] * corr + ls;
        if (MODE != M_CMPA) {
#pragma unroll
          for (int nt = 0; nt < 4; ++nt) O[rg][nt][j] *= corr;
        }
      }
    }
    if (MODE != M_CMPA) {
#pragma unroll
      for (int kt = 0; kt < 4; ++kt)
#pragma unroll
        for (int j = 0; j < 4; ++j) Pb[rg * 16 * KP + (q4 * 4 + j) * KP + kt * 16 + col] = (h16)S[rg][kt][j];
    }
  }
  if (MODE == M_CMPA) return;
  asm volatile("" ::: "memory");
#pragma unroll
  for (int ks = 0; ks < 2; ++ks) {
    h16x8 A[2];
#pragma unroll
    for (int rg = 0; rg < 2; ++rg)
      if (RGM & (1 << rg)) A[rg] = *(const h16x8*)(Pb + rg * 16 * KP + col * KP + ks * 32 + q4 * 8);
#pragma unroll
    for (int nt = 0; nt < 4; ++nt) {
      h16x8 B = *(const h16x8*)(Vt + (nt * 16 + col) * KP + ks * 32 + q4 * 8);
#pragma unroll
      for (int rg = 0; rg < 2; ++rg)
        if (RGM & (1 << rg)) O[rg][nt] = __builtin_amdgcn_mfma_f32_16x16x32_f16(A[rg], B, O[rg][nt], 0, 0, 0);
    }
  }
  asm volatile("" ::: "memory");
}

__device__ __forceinline__ float red16(float v) { return sum16(v); }

constexpr int LDS_CMP = 8 * 16 * 128 * 4 + 16 * 136 * 2 + 4 * 16 * 4;
__device__ void phase_compress(const Params& p, int l, char* lds) {
  const int tid = opaque_tid(), lane = tid & 63, w = tid >> 6, col = lane & 15, q4 = lane >> 4;
  float* red = (float*)lds;
  h16* hid = (h16*)(lds + 8 * 16 * 128 * 4);
  float* nrm2 = (float*)(lds + 8 * 16 * 128 * 4 + 16 * 136 * 2);
  const h16* P = (const h16*)(p.ws + O_P);
  for (int u = blockIdx.x; u < BATCH * 2 * 32; u += gridDim.x) {
    const int mt = u & 31, st = (u >> 5) & 1, b = u >> 6;
    const h16* W1t = (const h16*)(p.ws + O_W1T) + (size_t)(l * 2 + st) * 128 * 2048;
    const h16* W2t = (const h16*)(p.ws + O_W2T) + (size_t)(l * 2 + st) * 64 * 128;
    const float* b1 = (const float*)(p.ws + O_BIAS1) + (l * 2 + st) * 128;
    __syncthreads();
    {
      f32x4 acc[8];
#pragma unroll
      for (int nt = 0; nt < 8; ++nt) acc[nt] = f32x4{0.f, 0.f, 0.f, 0.f};
      const int m = 16 * mt + col;
#pragma unroll 2
      for (int kk = 0; kk < 8; ++kk) {
        const int ks = 8 * w + kk, tt = ks >> 1, d0 = (ks & 1) * 32 + q4 * 8;
        int tok = 16 * m + tt;
        if (tok > SEQ - 1) tok = SEQ - 1;
        const h16x8 A = *(const h16x8*)(P + ((size_t)b * SEQ + tok) * IWP + OFF_KVC + st * 64 + d0);
#pragma unroll
        for (int nt = 0; nt < 8; ++nt) {
          const h16x8 B = *(const h16x8*)(W1t + (size_t)(nt * 16 + col) * 2048 + ks * 32 + q4 * 8);
          acc[nt] = __builtin_amdgcn_mfma_f32_16x16x32_f16(A, B, acc[nt], 0, 0, 0);
        }
      }
#pragma unroll
      for (int nt = 0; nt < 8; ++nt)
#pragma unroll
        for (int j = 0; j < 4; ++j) red[(w * 16 + q4 * 4 + j) * 128 + nt * 16 + col] = acc[nt][j];
    }
    __syncthreads();
    {
      const int row = tid >> 5, c4 = (tid & 31) * 4;
      float4 sum = *(const float4*)(b1 + c4);
#pragma unroll
      for (int ww = 0; ww < 8; ++ww) {
        const float4 v = *(const float4*)(red + (ww * 16 + row) * 128 + c4);
        sum.x += v.x; sum.y += v.y; sum.z += v.z; sum.w += v.w;
      }
      *(h16x4*)(hid + row * 136 + c4) = pack4(gelu_tanh(sum.x), gelu_tanh(sum.y), gelu_tanh(sum.z), gelu_tanh(sum.w));
    }
    __syncthreads();
    f32x4 o2 = {0.f, 0.f, 0.f, 0.f};
    if (w < 4) {
#pragma unroll
      for (int ks = 0; ks < 4; ++ks) {
        const h16x8 A = *(const h16x8*)(hid + col * 136 + ks * 32 + q4 * 8);
        const h16x8 B = *(const h16x8*)(W2t + (size_t)(w * 16 + col) * 128 + ks * 32 + q4 * 8);
        o2 = __builtin_amdgcn_mfma_f32_16x16x32_f16(A, B, o2, 0, 0, 0);
      }
      if (st == 0) {
#pragma unroll
        for (int j = 0; j < 4; ++j) {
          float ss = sum16(o2[j] * o2[j]);
          if (col == 0) nrm2[w * 16 + q4 * 4 + j] = ss;
        }
      }
    }
    __syncthreads();
    if (w < 4) {
      const float g = p.in[3][(l * 6 + 3) * 64 + w * 16 + col];
      h16* dst = (h16*)(p.ws + (st == 0 ? O_KCMP : O_VCMP));
#pragma unroll
      for (int j = 0; j < 4; ++j) {
        const int row = q4 * 4 + j, m = 16 * mt + row;
        float v = o2[j];
        if (st == 0) {
          float tot = nrm2[row] + nrm2[16 + row] + nrm2[32 + row] + nrm2[48 + row];
          v = v * rsqrtf(tot * (1.f / 64.f) + EPS) * g;
        }
        if (m >= NCMP) v = 0.f;
        dst[((size_t)b * 512 + m) * 64 + w * 16 + col] = (h16)v;
      }
    }
  }
}

constexpr int LDS_BIAS = 800 * 16;
constexpr int LDS_PB = NW * 32 * KP * 2;
__device__ void phase_swa(const Params& p, int l, char* lds) {
  const int tid = opaque_tid(), lane = tid & 63, w = tid >> 6, col = lane & 15, q4 = lane >> 4;
  float* biasT = (float*)lds;
  h16* Pb = (h16*)(lds + LDS_BIAS) + w * 32 * KP;
  h16* KV = (h16*)(lds + LDS_BIAS + LDS_PB);
  float* nrm = (float*)(lds + LDS_BIAS + LDS_PB + 4 * 64 * KP * 2);
  const h16* P = (const h16*)(p.ws + O_P);
  const int* lut = (const int*)(p.ws + O_LUT);
  h16* OAC = (h16*)(p.ws + O_OAC);
  __syncthreads();
  for (int i = tid; i < 3200; i += NT) biasT[i] = p.in[5][lut[i >> 2] * 8 + (i & 3)];
  __syncthreads();
  const int head = w >> 1, kvh = w >> 2;
  const float sink = p.in[4][l * 4 + head];
  const int srow = tid >> 3, c8 = tid & 7;
  float hpd[2][4];
  const bool nosel[2] = {false, false};
  for (int u = blockIdx.x; u < BATCH * 128; u += gridDim.x) {
    const int b = u >> 7, t0 = (u & 127) * 64;
    const h16* Pbat = P + (size_t)b * SEQ * IWP;
    h16x8 Q[2][2];
    int tq[2];
#pragma unroll
    for (int rg = 0; rg < 2; ++rg) {
      const int qb = (w & 1) * 32 + rg * 16;
      const h16* qp = Pbat + (size_t)(t0 + qb + col) * IWP + head * 64 + q4 * 8;
      Q[rg][0] = *(const h16x8*)qp;
      Q[rg][1] = *(const h16x8*)(qp + 32);
      tq[rg] = t0 + qb + q4 * 4;
    }
    f32x4 O[2][4];
    RowState st[2];
#pragma unroll
    for (int rg = 0; rg < 2; ++rg) {
#pragma unroll
      for (int nt = 0; nt < 4; ++nt) O[rg][nt] = f32x4{0.f, 0.f, 0.f, 0.f};
#pragma unroll
      for (int j = 0; j < 4; ++j) { st[rg].m[j] = -1e30f; st[rg].l[j] = 0.f; }
    }
    const int i0 = t0 >= 128 ? 0 : (t0 >= 64 ? 1 : 2);
    h16x8 rk[2], rv[2];
    {
      int sb = t0 - 128 + i0 * 64;
      for (int h2 = 0; h2 < 2; ++h2) {
        rk[h2] = ld_row8(Pbat + 256 + h2 * 64, IWP, sb + srow, SEQ, c8);
        rv[h2] = ld_row8(Pbat + 384 + h2 * 64, IWP, sb + srow, SEQ, c8);
      }
    }
    for (int i = i0; i < 3; ++i) {
      __syncthreads();
      for (int h2 = 0; h2 < 2; ++h2) {
        st_k(KV + h2 * 64 * KP, srow, c8, rk[h2]);
        st_vt(KV + (2 + h2) * 64 * KP, srow, c8, rv[h2]);
      }
      __syncthreads();
      if (i + 1 < 3) {
        int sb = t0 - 128 + (i + 1) * 64;
        for (int h2 = 0; h2 < 2; ++h2) {
          rk[h2] = ld_row8(Pbat + 256 + h2 * 64, IWP, sb + srow, SEQ, c8);
          rv[h2] = ld_row8(Pbat + 384 + h2 * 64, IWP, sb + srow, SEQ, c8);
        }
      }
      const int kb = t0 - 128 + i * 64;
      attn_tile<M_SWA, 3>(Q, O, st, KV + kvh * 64 * KP, KV + (2 + kvh) * 64 * KP, Pb, biasT, tq, head, kb, nosel, hpd, lane);
    }
    __syncthreads();
#pragma unroll
    for (int rg = 0; rg < 2; ++rg) {
      const int qb = (w & 1) * 32 + rg * 16;
#pragma unroll
      for (int j = 0; j < 4; ++j) {
        float lsum = red16(st[rg].l[j]);
        float mn = fmaxf(st[rg].m[j], sink);
        float corr = __expf(st[rg].m[j] - mn);
        float inv = corr / (lsum * corr + __expf(sink - mn));
        float ss = 0.f;
#pragma unroll
        for (int nt = 0; nt < 4; ++nt) { O[rg][nt][j] *= inv; ss += O[rg][nt][j] * O[rg][nt][j]; }
        ss = red16(ss);
        if (col == 0) nrm[head * 64 + qb + q4 * 4 + j] = ss;
      }
    }
    __syncthreads();
#pragma unroll
    for (int rg = 0; rg < 2; ++rg) {
      const int qb = (w & 1) * 32 + rg * 16;
#pragma unroll
      for (int j = 0; j < 4; ++j) {
        const int qi = qb + q4 * 4 + j;
        float tot = nrm[qi] + nrm[64 + qi] + nrm[128 + qi] + nrm[192 + qi];
        float sc = rsqrtf(tot * (1.f / 256.f) + EPS);
#pragma unroll
        for (int nt = 0; nt < 4; ++nt)
          OAC[((size_t)b * SEQ + t0 + qi) * 512 + head * 64 + nt * 16 + col] = (h16)(O[rg][nt][j] * sc);
      }
    }
  }
}

constexpr int LDS_NSA = LDS_BIAS + LDS_PB + 2 * 64 * KP * 2 + NW * 4 * 128 * 4 + 32 * 16;
__device__ void phase_nsa(const Params& p, int l, char* lds) {
  const int tid = opaque_tid(), lane = tid & 63, w = tid >> 6, col = lane & 15, q4 = lane >> 4;
  float* biasT = (float*)lds;
  h16* Pb = (h16*)(lds + LDS_BIAS) + w * 32 * KP;
  h16* Ks = (h16*)(lds + LDS_BIAS + LDS_PB);
  h16* Vt = Ks + 64 * KP;
  float* impw = (float*)(lds + LDS_BIAS + LDS_PB + 2 * 64 * KP * 2) + w * 4 * 128;
  unsigned long long* selm = (unsigned long long*)(lds + LDS_BIAS + LDS_PB + 2 * 64 * KP * 2 + NW * 4 * 128 * 4);
  const h16* P = (const h16*)(p.ws + O_P);
  const int* lut = (const int*)(p.ws + O_LUT);
  h16* OAC = (h16*)(p.ws + O_OAC);
  __syncthreads();
  for (int i = tid; i < 3200; i += NT) biasT[i] = p.in[5][lut[i >> 2] * 8 + 4 + (i & 3)];
  __syncthreads();
  const int srow = tid >> 3, c8 = tid & 7;
  float hpd[2][4];
  const bool nosel[2] = {false, false};
  for (int u = blockIdx.x; u < 1024; u += gridDim.x) {
    const int rnd = u >> 8, b = (u & 255) >> 6, ti = u & 63;
    const int tile = rnd == 0 ? 255 - ti : (rnd == 1 ? 128 + ti : (rnd == 2 ? 127 - ti : ti));
    const int t0 = tile * 32, cur = t0 >> 6;
    const h16* Pbat = P + (size_t)b * SEQ * IWP;
    const h16* KC = (const h16*)(p.ws + O_KCMP) + (size_t)b * 512 * 64;
    const h16* VC = (const h16*)(p.ws + O_VCMP) + (size_t)b * 512 * 64;
    h16x8 Q[2][2];
    int tq[2] = {0, 0};
    {
      const int qi = w * 4 + (col >> 2), hd = col & 3;
      const h16* qp = Pbat + (size_t)(t0 + qi) * IWP + OFF_QC + hd * 64 + q4 * 8;
      Q[0][0] = *(const h16x8*)qp;
      Q[0][1] = *(const h16x8*)(qp + 32);
      tq[0] = t0 + w * 4 + q4;
    }
    for (int i = lane; i < 512; i += 64) impw[i] = 0.f;
    f32x4 O[2][4], Oc[2][4];
    RowState st[2];
    h16x8 rk, rv;
    int mvmax = t0 / 16 + 1;
    if (mvmax > NCMP) mvmax = NCMP;
    const int ntc = (mvmax + 63) >> 6;
#pragma unroll
    for (int rg = 0; rg < 1; ++rg)
#pragma unroll
      for (int j = 0; j < 4; ++j) { st[rg].m[j] = -1e30f; st[rg].l[j] = 0.f; }
    rk = ld_row8(KC, 64, srow, 512, c8);
    for (int i = 0; i < ntc; ++i) {
      __syncthreads();
      st_k(Ks, srow, c8, rk);
      __syncthreads();
      if (i + 1 < ntc) rk = ld_row8(KC, 64, (i + 1) * 64 + srow, 512, c8);
      attn_tile<M_CMPA, 1>(Q, O, st, Ks, Vt, Pb, biasT, tq, 0, i * 64, nosel, hpd, lane);
    }
#pragma unroll
    for (int rg = 0; rg < 1; ++rg)
#pragma unroll
      for (int j = 0; j < 4; ++j) {
        float ls = red16(st[rg].l[j]);
        st[rg].l[j] = ls > 0.f ? 1.f / ls : 0.f;
      }
#pragma unroll
    for (int rg = 0; rg < 1; ++rg)
#pragma unroll
      for (int nt = 0; nt < 4; ++nt) O[rg][nt] = f32x4{0.f, 0.f, 0.f, 0.f};
    float carry[1] = {0.f};
    rk = ld_row8(KC, 64, srow, 512, c8);
    rv = ld_row8(VC, 64, srow, 512, c8);
    for (int i = 0; i < ntc; ++i) {
      __syncthreads();
      st_k(Ks, srow, c8, rk);
      st_vt(Vt, srow, c8, rv);
      __syncthreads();
      if (i + 1 < ntc) {
        rk = ld_row8(KC, 64, (i + 1) * 64 + srow, 512, c8);
        rv = ld_row8(VC, 64, (i + 1) * 64 + srow, 512, c8);
      }
      float hp2[2][4];
      attn_tile<M_CMPB, 1>(Q, O, st, Ks, Vt, Pb, biasT, tq, 0, i * 64, nosel, hp2, lane);
#pragma unroll
      for (int rg = 0; rg < 1; ++rg) {
        float hp[4] = {hp2[rg][0], hp2[rg][1], hp2[rg][2], hp2[rg][3]};
#pragma unroll
        for (int kt = 0; kt < 4; ++kt) {
          float h = hp[kt];
          float qs = h + dppf<0xB1>(h);
          qs += dppf<0x4E>(qs);
          float prev = dppf<0x121>(h);
          float cin = (kt == 0) ? carry[rg] : dppf<0x121>(hp[kt > 0 ? kt - 1 : 0]);
          float pk = (col == 0) ? cin : prev;
          if ((col & 3) == 0) impw[(rg * 4 + q4) * 128 + ((i * 64 + kt * 16 + col) >> 2)] = qs + pk;
        }
        carry[rg] = dppf<0x121>(hp[3]);
      }
    }
#pragma unroll
    for (int rg = 0; rg < 1; ++rg) {
      const h16* gp = Pbat + (size_t)tq[rg] * IWP + OFF_GC;
#pragma unroll
      for (int j = 0; j < 4; ++j) {
        float g0 = (float)gp[j * 3 + 0];
#pragma unroll
        for (int nt = 0; nt < 4; ++nt) Oc[rg][nt][j] = g0 * O[rg][nt][j];
      }
    }
    {
      const int nforced = cur >= 2 ? 3 : cur + 1;
      const int npick = 16 - nforced;
      for (int qi = 0; qi < 4; ++qi) {
        const float* im = impw + qi * 128;
        const int j0 = lane, j1 = lane + 64;
        const float v0 = im[j0], v1 = im[j1];
        int r0 = 0, r1 = 0;
        for (int jp = 1; jp <= cur - 2; ++jp) {
          float vp = im[jp];
          r0 += (vp > v0 || (vp == v0 && jp < j0)) ? 1 : 0;
          r1 += (vp > v1 || (vp == v1 && jp < j1)) ? 1 : 0;
        }
        bool c0 = j0 >= 1 && j0 <= cur - 2, c1 = j1 <= cur - 2;
        bool f0 = j0 == 0 || j0 == cur || j0 == cur - 1, f1 = j1 == cur || j1 == cur - 1;
        unsigned long long mlo = __ballot(f0 || (c0 && r0 < npick));
        unsigned long long mhi = __ballot(f1 || (c1 && r1 < npick));
        if (lane == 0) { selm[(w * 4 + qi) * 2] = mlo; selm[(w * 4 + qi) * 2 + 1] = mhi; }
      }
    }
    asm volatile("" ::: "memory");
    unsigned long long slo[2], shi[2];
#pragma unroll
    for (int rg = 0; rg < 1; ++rg) {
      slo[rg] = selm[(w * 4 + q4) * 2];
      shi[rg] = selm[(w * 4 + q4) * 2 + 1];
    }
#pragma unroll
    for (int rg = 0; rg < 1; ++rg) {
#pragma unroll
      for (int nt = 0; nt < 4; ++nt) O[rg][nt] = f32x4{0.f, 0.f, 0.f, 0.f};
#pragma unroll
      for (int j = 0; j < 4; ++j) { st[rg].m[j] = -1e30f; st[rg].l[j] = 0.f; }
    }
    rk = ld_row8(Pbat + OFF_KVC + 128, IWP, srow, SEQ, c8);
    rv = ld_row8(Pbat + OFF_KVC + 192, IWP, srow, SEQ, c8);
    for (int jb = 0; jb <= cur; ++jb) {
      __syncthreads();
      st_k(Ks, srow, c8, rk);
      st_vt(Vt, srow, c8, rv);
      __syncthreads();
      if (jb + 1 <= cur) {
        rk = ld_row8(Pbat + OFF_KVC + 128, IWP, (jb + 1) * 64 + srow, SEQ, c8);
        rv = ld_row8(Pbat + OFF_KVC + 192, IWP, (jb + 1) * 64 + srow, SEQ, c8);
      }
      bool sb[2] = {false, false};
      sb[0] = ((jb < 64 ? (slo[0] >> jb) : (shi[0] >> (jb - 64))) & 1ull) != 0;
      if (__any(sb[0])) attn_tile<M_SEL, 1>(Q, O, st, Ks, Vt, Pb, biasT, tq, 0, jb * 64, sb, hpd, lane);
    }
#pragma unroll
    for (int rg = 0; rg < 1; ++rg) {
      const h16* gp = Pbat + (size_t)tq[rg] * IWP + OFF_GC;
#pragma unroll
      for (int j = 0; j < 4; ++j) {
        float ls = red16(st[rg].l[j]);
        float f = ls > 0.f ? (float)gp[j * 3 + 1] / ls : 0.f;
#pragma unroll
        for (int nt = 0; nt < 4; ++nt) Oc[rg][nt][j] += f * O[rg][nt][j];
      }
    }
#pragma unroll
    for (int rg = 0; rg < 1; ++rg) {
#pragma unroll
      for (int nt = 0; nt < 4; ++nt) O[rg][nt] = f32x4{0.f, 0.f, 0.f, 0.f};
#pragma unroll
      for (int j = 0; j < 4; ++j) { st[rg].m[j] = -1e30f; st[rg].l[j] = 0.f; }
    }
    const int w0 = cur >= 8 ? cur - 8 : 0;
    rk = ld_row8(Pbat + OFF_KVC + 256, IWP, w0 * 64 + srow, SEQ, c8);
    rv = ld_row8(Pbat + OFF_KVC + 320, IWP, w0 * 64 + srow, SEQ, c8);
    for (int wi = w0; wi <= cur; ++wi) {
      __syncthreads();
      st_k(Ks, srow, c8, rk);
      st_vt(Vt, srow, c8, rv);
      __syncthreads();
      if (wi + 1 <= cur) {
        rk = ld_row8(Pbat + OFF_KVC + 256, IWP, (wi + 1) * 64 + srow, SEQ, c8);
        rv = ld_row8(Pbat + OFF_KVC + 320, IWP, (wi + 1) * 64 + srow, SEQ, c8);
      }
      attn_tile<M_WIN, 1>(Q, O, st, Ks, Vt, Pb, biasT, tq, 0, wi * 64, nosel, hpd, lane);
    }
#pragma unroll
    for (int rg = 0; rg < 1; ++rg) {
      const h16* gp = Pbat + (size_t)tq[rg] * IWP + OFF_GC;
      float ss = 0.f;
#pragma unroll
      for (int j = 0; j < 4; ++j) {
        float ls = red16(st[rg].l[j]);
        float f = ls > 0.f ? (float)gp[j * 3 + 2] / ls : 0.f;
#pragma unroll
        for (int nt = 0; nt < 4; ++nt) {
          float v = Oc[rg][nt][j] + f * O[rg][nt][j];
          Oc[rg][nt][j] = v;
          ss += v * v;
        }
      }
      ss = red16(ss);
      float sc = rsqrtf(ss * (1.f / 256.f) + EPS);
#pragma unroll
      for (int j = 0; j < 4; ++j)
#pragma unroll
        for (int nt = 0; nt < 4; ++nt)
          OAC[((size_t)b * SEQ + tq[rg]) * 512 + 256 + j * 64 + nt * 16 + col] = (h16)(Oc[rg][nt][j] * sc);
    }
  }
}

constexpr int LDS_SWA = LDS_BIAS + LDS_PB + 4 * 64 * KP * 2 + 1024;
constexpr int lds_max(int a, int b) { return a > b ? a : b; }
constexpr int LDS_BYTES = lds_max(lds_max(LDS_NSA, SSMY_LDS), lds_max(LDS_SWA, lds_max(LDS_GEMM, lds_max(LDS_CMP, 64 * 65 * 4))));

__global__ void __launch_bounds__(NT) fwd_megakernel(Params p) {
  cg::grid_group grid = cg::this_grid();
  __shared__ __attribute__((aligned(16))) char lds[LDS_BYTES];
  phase0(p, (float*)lds);
  grid.sync();
  phase0b(p);
  grid.sync();
  for (int l = 0; l < DEPTH; ++l) {
    phase_gemm1(p, l, lds);
    grid.sync();
    ssm_endstates(p, l);
    phase_compress(p, l, lds);
    phase_swa(p, l, lds);
    grid.sync();
    phase_nsa(p, l, lds);
    ssm_outputs(p, l, lds);
    grid.sync();
    phase_glu(p, l, lds);
    grid.sync();
    phase_wout(p, l, lds);
    grid.sync();
    phase_up(p, l, lds);
    grid.sync();
    phase_down(p, l, lds);
    grid.sync();
  }
}

extern "C" void kernel_launch(void* const* d_in, const int* in_sizes, int n_in, void* d_out, int out_size, void* d_ws,
                              size_t ws_size, hipStream_t stream) {
  static int grid_blocks = 0;
  if (!grid_blocks) {
    int dev = 0, cus = 0, per_cu = 0;
    (void)hipGetDevice(&dev);
    (void)hipDeviceGetAttribute(&cus, hipDeviceAttributeMultiprocessorCount, dev);
    (void)hipOccupancyMaxActiveBlocksPerMultiprocessor(&per_cu, fwd_megakernel, NT, 0);
    if (per_cu > 1) per_cu = 1;
    grid_blocks = cus * per_cu;
  }
  if (ws_size < WS_NEED) {
    fprintf(stderr, "workspace too small: %zu < %zu\n", ws_size, WS_NEED);
    return;
  }
  Params p{};
  for (int i = 0; i < 24; ++i) p.in[i] = (const float*)d_in[i];
  p.out = (float*)d_out;
  p.ws = (char*)d_ws;
  void* args[] = {&p};
  hipError_t e = hipLaunchCooperativeKernel((void*)fwd_megakernel, dim3(grid_blocks), dim3(NT), args, 0, stream);
  if (e != hipSuccess) fprintf(stderr, "cooperative launch failed: %s (grid %d)\n", hipGetErrorString(e), grid_blocks);
}
```

```cpp
#include <hip/hip_runtime.h>
#include <hip/hip_cooperative_groups.h>
#include <cstdio>
namespace cg = cooperative_groups;

typedef _Float16 h16;
typedef __attribute__((ext_vector_type(8))) _Float16 h16x8;
typedef __attribute__((ext_vector_type(4))) float f32x4;

constexpr int NT = 512;
constexpr int NW = NT / 64;
constexpr int BATCH = 4, SEQ = 8192, NTOK = BATCH * SEQ, DM = 1024, DEPTH = 4, IW = 1676, IWP = 1792, DFF = 4096;
constexpr int OFF_U = 512, OFF_QC = 1024, OFF_KVC = 1280, OFF_GC = 1664;
constexpr int NCMP = 511;
constexpr float EPS = 1e-6f;

constexpr size_t SZ_WIN = (size_t)IWP * DM * 2, SZ_WGLU = (size_t)1024 * 512 * 2, SZ_WOUT = (size_t)DM * DM * 2,
                 SZ_WUP = (size_t)DFF * DM * 2, SZ_WDN = (size_t)DM * DFF * 2;
constexpr size_t O_WIN = 0;
constexpr size_t O_WGLU = O_WIN + DEPTH * SZ_WIN;
constexpr size_t O_WOUT = O_WGLU + DEPTH * SZ_WGLU;
constexpr size_t O_WUP = O_WOUT + DEPTH * SZ_WOUT;
constexpr size_t O_WDN = O_WUP + DEPTH * SZ_WUP;
constexpr size_t O_XB = O_WDN + DEPTH * SZ_WDN;
constexpr size_t O_SSQ = O_XB + (size_t)NTOK * DM * 2;
constexpr size_t O_SSQB = O_SSQ + (size_t)NTOK * 16 * 4;
constexpr size_t O_KCMP = O_SSQB + (size_t)NTOK * 16 * 4;
constexpr size_t O_VCMP = O_KCMP + (size_t)BATCH * 512 * 64 * 4;
constexpr size_t O_ABAR = O_VCMP + (size_t)BATCH * 512 * 64 * 4;
constexpr size_t O_BBAR = O_ABAR + (size_t)DEPTH * 32 * 64 * 8;
constexpr size_t O_BIAS1 = O_BBAR + (size_t)DEPTH * 32 * 64 * 16 * 8;
constexpr size_t O_LUT = O_BIAS1 + (size_t)DEPTH * 2 * 128 * 4;
constexpr size_t O_AT = O_LUT + 8192 * 4;
constexpr size_t O_KTAB = O_AT + (size_t)128 * 64 * 8;
constexpr size_t SZ_KTAB = (size_t)65 * 256 * 2;
constexpr size_t O_W1 = O_KTAB + 128 * SZ_KTAB;
constexpr size_t SZ_W13 = (size_t)128 * 1024 * 2;
constexpr size_t O_W3 = O_W1 + 128 * SZ_W13;
constexpr size_t O_W1T = O_W3 + 128 * SZ_W13;
constexpr size_t O_W2T = O_W1T + (size_t)8 * 128 * 2048 * 2;
constexpr size_t O_BIG = (O_W2T + (size_t)8 * 64 * 128 * 2 + 255) / 256 * 256;
constexpr size_t O_APOW = O_BIG;
constexpr size_t O_P = O_BIG;
constexpr size_t O_Z = O_P + (size_t)NTOK * IWP * 2;
constexpr size_t O_OB = O_Z + (size_t)NTOK * 512 * 2;
constexpr size_t O_OAC = O_OB + (size_t)512 * 2;
constexpr size_t O_E = O_OB + (size_t)NTOK * 1024 * 2;
constexpr size_t O_HID = O_BIG;
constexpr size_t WS_NEED = O_BIG + (size_t)NTOK * DFF * 2;

struct Params {
  const float* in[24];
  float* out;
  char* ws;
};

__device__ __forceinline__ int opaque_tid() {
  int t = threadIdx.x;
  asm volatile("" : "+v"(t));
  return t;
}
template <int CTRL>
__device__ __forceinline__ float dppf(float v) {
  return __int_as_float(__builtin_amdgcn_update_dpp(0, __float_as_int(v), CTRL, 0xF, 0xF, true));
}
__device__ __forceinline__ float sum16(float v) {
  v += dppf<0xB1>(v); v += dppf<0x4E>(v); v += dppf<0x141>(v); v += dppf<0x140>(v);
  return v;
}
__device__ __forceinline__ float max16(float v) {
  v = fmaxf(v, dppf<0xB1>(v)); v = fmaxf(v, dppf<0x4E>(v)); v = fmaxf(v, dppf<0x141>(v)); v = fmaxf(v, dppf<0x140>(v));
  return v;
}
__device__ __forceinline__ float xor16(float v) { return __int_as_float(__builtin_amdgcn_ds_swizzle(__float_as_int(v), 0x401F)); }
__device__ __forceinline__ float rdlane_c(float v, int l) { return __int_as_float(__builtin_amdgcn_readlane(__float_as_int(v), l)); }
__device__ __forceinline__ float wave_sum(float v) {
  v = sum16(v); v += xor16(v);
  return rdlane_c(v, 0) + rdlane_c(v, 32);
}
__device__ __forceinline__ float gelu_tanh(float x) {
  float u = 0.7978845608028654f * (x + 0.044715f * x * x * x);
  return 0.5f * x * (1.f + tanhf(u));
}
__device__ __forceinline__ float sigmoidf(float x) { return 1.f / (1.f + __expf(-x)); }
__device__ __forceinline__ float rdlane(float v, int l) {
  return __int_as_float(__builtin_amdgcn_readlane(__float_as_int(v), l));
}

template <class SrcF>
__device__ __forceinline__ void conv_tile(SrcF src, h16* dst, int ldo, int n0, int k0, float* tile) {
  int tid = opaque_tid();
  for (int idx = tid; idx < 4096; idx += NT) {
    int kk = idx >> 6, nn = idx & 63;
    tile[kk * 65 + nn] = src(k0 + kk, n0 + nn);
  }
  __syncthreads();
  for (int idx = tid; idx < 4096; idx += NT) {
    int nn = idx >> 6, kk = idx & 63;
    dst[(long)(n0 + nn) * ldo + k0 + kk] = (h16)tile[kk * 65 + nn];
  }
  __syncthreads();
}

__device__ void phase0(const Params& p, float* lds) {
  const int tid = opaque_tid();
  constexpr int T_IN = (IWP / 64) * (DM / 64);
  constexpr int T_GLU = 16 * 8;
  constexpr int T_OUT = 16 * 16;
  constexpr int T_UP = 64 * 16;
  constexpr int T_DN = 16 * 64;
  constexpr int T_L = T_IN + T_GLU + T_OUT + T_UP + T_DN;
  for (int ti = blockIdx.x; ti < DEPTH * T_L; ti += gridDim.x) {
    int l = ti / T_L, r = ti % T_L;
    if (r < T_IN) {
      int nt = r / 16, kt = r % 16;
      const float* w = p.in[2] + (size_t)l * DM * IW;
      const float* g = p.in[1] + l * DM;
      conv_tile([&](int k, int sl) {
        int n = (sl & ~255) + 64 * ((sl >> 5) & 3) + 32 * ((sl >> 7) & 1) + (sl & 31);
        return n < IW ? w[(long)k * IW + n] * g[k] : 0.f; },
                (h16*)(p.ws + O_WIN + l * SZ_WIN), DM, nt * 64, kt * 64, lds);
    } else if ((r -= T_IN) < T_GLU) {
      int nt = r / 8, kt = r % 8;
      const float* w = p.in[14] + (size_t)l * 512 * 1024;
      conv_tile([&](int k, int n2) {
        int pn = n2 >> 8, bj = (n2 >> 7) & 1, wc = (n2 >> 5) & 3, nn = (n2 >> 4) & 1, r = n2 & 15;
        int n = (nn ? 512 : 0) + 128 * pn + 64 * bj + 16 * wc + r;
        return w[(long)k * 1024 + n]; },
                (h16*)(p.ws + O_WGLU + l * SZ_WGLU), 512, nt * 64, kt * 64, lds);
    } else if ((r -= T_GLU) < T_OUT) {
      int nt = r / 16, kt = r % 16;
      const float* w = p.in[20] + (size_t)l * DM * DM;
      const float* g = p.in[19] + l * DM;
      conv_tile([&](int k2, int n) {
        int k = k2 < 512 ? 256 + k2 : (k2 < 768 ? k2 - 512 : k2);
        return w[(long)k * DM + n] * g[k]; },
                (h16*)(p.ws + O_WOUT + l * SZ_WOUT), DM, nt * 64, kt * 64, lds);
    } else if ((r -= T_OUT) < T_UP) {
      int nt = r / 16, kt = r % 16;
      const float* w = p.in[22] + (size_t)l * DM * DFF;
      const float* g = p.in[21] + l * DM;
      conv_tile([&](int k, int n) { return w[(long)k * DFF + n] * g[k]; },
                (h16*)(p.ws + O_WUP + l * SZ_WUP), DM, nt * 64, kt * 64, lds);
    } else {
      r -= T_UP;
      int nt = r / 64, kt = r % 64;
      const float* w = p.in[23] + (size_t)l * DFF * DM;
      conv_tile([&](int k, int n) { return w[(long)k * DM + n]; },
                (h16*)(p.ws + O_WDN + l * SZ_WDN), DFF, nt * 64, kt * 64, lds);
    }
  }
  for (int ti = blockIdx.x; ti < 8 * 66; ti += gridDim.x) {
    int ls = ti / 66, r = ti % 66;
    if (r < 64) {
      int nt = r >> 5, kt = r & 31;
      const float* w = p.in[17] + (size_t)ls * 2048 * 128;
      conv_tile([&](int k, int n) { return w[(long)k * 128 + n]; }, (h16*)(p.ws + O_W1T) + (size_t)ls * 128 * 2048, 2048, nt * 64, kt * 64, lds);
    } else {
      int kt = r - 64;
      const float* w = p.in[18] + (size_t)ls * 128 * 64;
      conv_tile([&](int k, int n) { return w[(long)k * 64 + n]; }, (h16*)(p.ws + O_W2T) + (size_t)ls * 64 * 128, 128, 0, kt * 64, lds);
    }
  }
  {
    const int lane = tid & 63;
    const int gw = blockIdx.x * NW + (tid >> 6), nw = gridDim.x * NW;
    const float* x = p.in[0];
    h16* xb = (h16*)(p.ws + O_XB);
    float* ssq = (float*)(p.ws + O_SSQ);
    for (int row = gw; row < NTOK; row += nw) {
      const float4* xr = (const float4*)(x + (long)row * DM + lane * 16);
      float s = 0.f;
      h16 hv[16];
      for (int i = 0; i < 4; ++i) {
        float4 v = xr[i];
        s += v.x * v.x + v.y * v.y + v.z * v.z + v.w * v.w;
        hv[i * 4 + 0] = (h16)v.x; hv[i * 4 + 1] = (h16)v.y; hv[i * 4 + 2] = (h16)v.z; hv[i * 4 + 3] = (h16)v.w;
      }
      h16x8* xo = (h16x8*)(xb + (long)row * DM + lane * 16);
      h16x8 o0, o1;
      for (int i = 0; i < 8; ++i) { o0[i] = hv[i]; o1[i] = hv[8 + i]; }
      xo[0] = o0; xo[1] = o1;
      s += dppf<0xB1>(s);
      s += dppf<0x4E>(s);
      if ((lane & 3) == 0) ssq[(long)row * 16 + (lane >> 2)] = s;
    }
  }
  const int gt = blockIdx.x * NT + tid, ngt = gridDim.x * NT;
  for (int i = gt; i < DEPTH * 32 * 64; i += ngt) {
    int l = i / 2048, g = (i / 64) % 32;
    double are = p.in[6][i], aim = p.in[7][i];
    double dt = exp((double)p.in[8][l * 32 + g]);
    double er = exp(are * dt), abr = er * cos(aim * dt), abi = er * sin(aim * dt);
    ((float2*)(p.ws + O_ABAR))[i] = make_float2((float)abr, (float)abi);
    double nr = abr - 1.0, ni = abi, den = are * are + aim * aim;
    double fr = (nr * are + ni * aim) / den, fi = (ni * are - nr * aim) / den;
    float2* bb = (float2*)(p.ws + O_BBAR) + (size_t)i * 16;
    for (int q = 0; q < 16; ++q) {
      double br = p.in[9][(size_t)i * 16 + q], bi = p.in[10][(size_t)i * 16 + q];
      bb[q] = make_float2((float)((fr * br - fi * bi) / dt), (float)((fr * bi + fi * br) / dt));
    }
  }
  for (int i = gt; i < 128 * 65 * 64; i += ngt) {
    int n = i & 63, j = (i >> 6) % 65, lg = i / (65 * 64);
    double are = p.in[6][lg * 64 + n], aim = p.in[7][lg * 64 + n];
    double dt = exp((double)p.in[8][lg]);
    double er = exp(are * dt * j), ang = aim * dt * j;
    ((double2*)(p.ws + O_APOW))[i] = make_double2(er * cos(ang), er * sin(ang));
  }
  for (int i = gt; i < DEPTH * 2 * 128; i += ngt) {
    int ls = i / 128, j = i % 128;
    const float* pos = p.in[16] + (size_t)ls * 2048;
    const float* w1 = p.in[17] + (size_t)ls * 2048 * 128;
    float a = 0.f;
    for (int k = 0; k < 2048; ++k) a += pos[k] * w1[(long)k * 128 + j];
    ((float*)(p.ws + O_BIAS1))[i] = a;
  }
  for (int d = gt; d < 8192; d += ngt) {
    int bk;
    if (d < 16) bk = d;
    else {
      float nf = (float)d;
      int large = 16 + (int)(logf(nf / 16.0f) / 4.1588830833596715f * 16.0f);
      bk = large < 31 ? large : 31;
    }
    ((int*)(p.ws + O_LUT))[d] = bk;
  }
}

__device__ void phase0b(const Params& p) {
  const int gt = blockIdx.x * NT + threadIdx.x, ngt = gridDim.x * NT;
  const double2* apow = (const double2*)(p.ws + O_APOW);
  const float2* bbs = (const float2*)(p.ws + O_BBAR);
  for (int i = gt; i < 128 * 64 * 64; i += ngt) {
    int tau = i & 63, n = (i >> 6) & 63, lg = i >> 12;
    double2 ap = apow[(lg * 65 + (63 - tau)) * 64 + n];
    const float2* bb = bbs + (size_t)(lg * 64 + n) * 16;
    h16x8 re0, re1, im0, im1;
#pragma unroll
    for (int q = 0; q < 8; ++q) {
      float2 b0 = bb[q], b1 = bb[8 + q];
      re0[q] = (h16)(float)(ap.x * b0.x - ap.y * b0.y);
      im0[q] = (h16)(float)(ap.x * b0.y + ap.y * b0.x);
      re1[q] = (h16)(float)(ap.x * b1.x - ap.y * b1.y);
      im1[q] = (h16)(float)(ap.x * b1.y + ap.y * b1.x);
    }
    h16* W1 = (h16*)(p.ws + O_W1 + (size_t)lg * SZ_W13);
    *(h16x8*)(W1 + ((size_t)(2 * tau) * 128 + 2 * n) * 8) = re0;
    *(h16x8*)(W1 + ((size_t)(2 * tau) * 128 + 2 * n + 1) * 8) = im0;
    *(h16x8*)(W1 + ((size_t)(2 * tau + 1) * 128 + 2 * n) * 8) = re1;
    *(h16x8*)(W1 + ((size_t)(2 * tau + 1) * 128 + 2 * n + 1) * 8) = im1;
  }
  for (int i = gt; i < 128 * 64 * 16 * 16; i += ngt) {
    int pp = i & 15, kc = (i >> 4) & 15, tau = (i >> 8) & 63, lg = i >> 14;
    h16x8 v;
#pragma unroll
    for (int e = 0; e < 4; ++e) {
      int n = 4 * kc + e;
      double2 ap = apow[(lg * 65 + tau + 1) * 64 + n];
      double cr = p.in[11][((size_t)lg * 16 + pp) * 64 + n], ci = p.in[12][((size_t)lg * 16 + pp) * 64 + n];
      v[2 * e] = (h16)(float)(cr * ap.x - ci * ap.y);
      v[2 * e + 1] = (h16)(float)(-(cr * ap.y + ci * ap.x));
    }
    h16* W3 = (h16*)(p.ws + O_W3 + (size_t)lg * SZ_W13);
    *(h16x8*)(W3 + ((size_t)((tau * 16 + kc) * 16) + pp) * 8) = v;
  }
  for (int i = gt; i < 128 * 65 * 16; i += ngt) {
    int pp = i & 15, slot = (i >> 4) % 65, lg = i / (65 * 16);
    float acc[16];
#pragma unroll
    for (int q = 0; q < 16; ++q) acc[q] = 0.f;
    if (slot > 0) {
      for (int n = 0; n < 64; ++n) {
        double2 ap = apow[(lg * 65 + slot - 1) * 64 + n];
        double cr = p.in[11][((size_t)lg * 16 + pp) * 64 + n], ci = p.in[12][((size_t)lg * 16 + pp) * 64 + n];
        float xr = (float)(cr * ap.x - ci * ap.y), xi = (float)(cr * ap.y + ci * ap.x);
        const float2* bb = bbs + (size_t)(lg * 64 + n) * 16;
#pragma unroll
        for (int q = 0; q < 16; ++q) { float2 b = bb[q]; acc[q] += xr * b.x - xi * b.y; }
      }
    }
    h16x8 v0, v1;
#pragma unroll
    for (int q = 0; q < 8; ++q) { v0[q] = (h16)acc[q]; v1[q] = (h16)acc[8 + q]; }
    h16* kt = (h16*)(p.ws + O_KTAB + (size_t)lg * SZ_KTAB) + slot * 256 + pp * 16;
    *(h16x8*)kt = v0;
    *(h16x8*)(kt + 8) = v1;
  }
  for (int i = gt; i < 128 * 64; i += ngt) {
    double2 ap = apow[((i >> 6) * 65 + 64) * 64 + (i & 63)];
    ((float2*)(p.ws + O_AT))[i] = make_float2((float)ap.x, (float)ap.y);
  }
}

__device__ void ssm_endstates(const Params& p, int l) {
  const int tid = opaque_tid(), lane = tid & 63, w = tid >> 6;
  const int gw = blockIdx.x * NW + w, nw = gridDim.x * NW;
  const h16* P = (const h16*)(p.ws + O_P);
  float* E = (float*)(p.ws + O_E);
  for (int unit = gw; unit < 32 * 32; unit += nw) {
    int g = unit >> 5, ctile = unit & 31;
    const h16* W1 = (const h16*)(p.ws + O_W1 + (size_t)(l * 32 + g) * SZ_W13);
    int gch = ctile * 16 + (lane & 15);
    const h16* ub = P + (size_t)gch * 64 * IWP + OFF_U + g * 16 + ((lane >> 4) & 1) * 8 + (size_t)(lane >> 5) * IWP;
    f32x4 acc[8];
#pragma unroll
    for (int mt = 0; mt < 8; ++mt) acc[mt] = f32x4{0.f, 0.f, 0.f, 0.f};
#pragma unroll 2
    for (int ks = 0; ks < 32; ++ks) {
      h16x8 B = *(const h16x8*)(ub + (size_t)(ks * 2) * IWP);
#pragma unroll
      for (int mt = 0; mt < 8; ++mt) {
        h16x8 A = *(const h16x8*)(W1 + ((size_t)(ks * 4 + (lane >> 4)) * 128 + mt * 16 + (lane & 15)) * 8);
        acc[mt] = __builtin_amdgcn_mfma_f32_16x16x32_f16(A, B, acc[mt], 0, 0, 0);
      }
    }
#pragma unroll
    for (int mt = 0; mt < 8; ++mt)
      *(f32x4*)(E + ((size_t)gch * 32 + g) * 128 + mt * 16 + (lane >> 4) * 4) = acc[mt];
  }
}

constexpr int BU_PITCH = 1032, BS_PITCH = 136;
constexpr int SSMY_LDS = 65 * 512 + 16 * BU_PITCH * 2 + 16 * BS_PITCH * 2;
__device__ void ssm_outputs(const Params& p, int l, char* lds) {
  const int tid = opaque_tid(), lane = tid & 63, w = tid >> 6;
  h16* Kt = (h16*)lds;
  h16* Bu = (h16*)(lds + 65 * 512);
  h16* Bs = (h16*)(lds + 65 * 512 + 16 * BU_PITCH * 2);
  const h16* P = (const h16*)(p.ws + O_P);
  const float* E = (const float*)(p.ws + O_E);
  h16* Z = (h16*)(p.ws + O_Z);
  for (int unit = blockIdx.x; unit < 1024; unit += gridDim.x) {
    const int g = unit & 31, bc = unit >> 5, b = bc >> 3, ct = bc & 7;
    const int lg = l * 32 + g;
    __syncthreads();
    if (w == 0) {
      float2 at = ((const float2*)(p.ws + O_AT))[lg * 64 + lane];
      const float2* Eb = (const float2*)E + ((size_t)(b * 128) * 32 + g) * 64 + lane;
      float sr = 0.f, si = 0.f;
      const int c0 = ct * 16;
#pragma unroll 8
      for (int c = 0; c < c0; ++c) {
        float2 e = Eb[(size_t)c * 2048];
        float nr = at.x * sr - at.y * si + e.x, ni = at.x * si + at.y * sr + e.y;
        sr = nr; si = ni;
      }
#pragma unroll
      for (int i = 0; i < 16; ++i) {
        Bs[i * BS_PITCH + 2 * lane] = (h16)sr;
        Bs[i * BS_PITCH + 2 * lane + 1] = (h16)si;
        float2 e = Eb[(size_t)(c0 + i) * 2048];
        float nr = at.x * sr - at.y * si + e.x, ni = at.x * si + at.y * sr + e.y;
        sr = nr; si = ni;
      }
    } else {
      const int t2 = tid - 64, n2 = NT - 64;
      const h16x8* ks = (const h16x8*)(p.ws + O_KTAB + (size_t)lg * SZ_KTAB);
      for (int i = t2; i < 65 * 32; i += n2) ((h16x8*)Kt)[i] = ks[i];
      for (int i = t2; i < 2048; i += n2) {
        int tk = i >> 1, hf = i & 1;
        h16x8 v = *(const h16x8*)(P + ((size_t)b * SEQ + ct * 1024 + tk) * IWP + OFF_U + g * 16 + hf * 8);
        *(h16x8*)(Bu + (tk >> 6) * BU_PITCH + (tk & 63) * 16 + hf * 8) = v;
      }
    }
    __syncthreads();
    const float dt = expf(p.in[8][lg]);
    const int col = lane & 15, hi = lane >> 5, qh = (lane >> 4) & 1, p0 = (lane >> 4) * 4;
    const h16* W3 = (const h16*)(p.ws + O_W3 + (size_t)lg * SZ_W13);
    float dsk[4];
    for (int j = 0; j < 4; ++j) dsk[j] = p.in[13][l * 512 + g * 16 + p0 + j];
    for (int r = 0; r < 64 / NW; ++r) {
      const int base = (r >> 1) * 2 * NW;
      const int tau = (r & 1) ? base + 2 * NW - 1 - w : base + w;
      f32x4 acc = {0.f, 0.f, 0.f, 0.f};
      const int nks = tau / 2 + 1;
      for (int i = 0; i < nks; ++i) {
        int j = tau - (2 * i + hi);
        h16x8 A = *(const h16x8*)(Kt + (j + 1) * 256 + (lane & 15) * 16 + qh * 8);
        h16x8 B = *(const h16x8*)(Bu + col * BU_PITCH + (2 * i + hi) * 16 + qh * 8);
        acc = __builtin_amdgcn_mfma_f32_16x16x32_f16(A, B, acc, 0, 0, 0);
      }
#pragma unroll
      for (int ks = 0; ks < 4; ++ks) {
        h16x8 A = *(const h16x8*)(W3 + ((size_t)((tau * 16 + ks * 4 + (lane >> 4)) * 16) + (lane & 15)) * 8);
        h16x8 B = *(const h16x8*)(Bs + col * BS_PITCH + ks * 32 + (lane >> 4) * 8);
        acc = __builtin_amdgcn_mfma_f32_16x16x32_f16(A, B, acc, 0, 0, 0);
      }
      const h16* up = Bu + col * BU_PITCH + tau * 16 + p0;
      size_t tok = ((size_t)b * 128 + ct * 16 + col) * 64 + tau;
      h16 zz[4];
      for (int j = 0; j < 4; ++j) zz[j] = (h16)gelu_tanh(dt * acc[j] + dsk[j] * (float)up[j]);
      typedef __attribute__((ext_vector_type(4))) _Float16 h16x4;
      h16x4 zv = {zz[0], zz[1], zz[2], zz[3]};
      *(h16x4*)(Z + tok * 512 + g * 16 + p0) = zv;
    }
  }
}

#define LAS __attribute__((address_space(3)))
typedef _Float16 h16x4 __attribute__((ext_vector_type(4)));
namespace g8 {
constexpr int BM = 256, BK = 64, HALF = 128, HTB = HALF * BK * 2, STAGE_BYTES = 8 * HTB, NXCD = 8, WGM = 8;
__device__ __forceinline__ int lds_byte(int r, int c) {
  const int st = (r >> 4) * 2 + (c >> 5), rr = r & 15, cc = c & 31, ob = rr * 64 + cc * 2;
  return st * 1024 + (ob ^ (((ob >> 9) & 1) << 5));
}
__device__ __forceinline__ void stage_rc(int b, int& R, int& C) {
  const int st = b / 1024, sb = b % 1024, swz = sb ^ (((sb >> 9) & 1) << 5);
  R = (st >> 1) * 16 + swz / 64;
  C = (st & 1) * 32 + (swz % 64) / 2;
}
struct Unit { int pm, pn; };
struct Order {
  int nM, nN, nwg, G, c;
  __device__ void init(int M, int N, int G_, int c_) { nM = M / BM; nN = N / BM; nwg = nM * nN; G = G_; c = c_; }
  __device__ bool next(int i, Unit& u) const {
    const long L = (long)i * G + c;
    if (L >= nwg) return false;
    int wgid = (int)L;
    { const int q = nwg / NXCD, r = nwg % NXCD, xcd = wgid % NXCD, off = wgid / NXCD; wgid = (xcd < r ? xcd * (q + 1) : r * (q + 1) + (xcd - r) * q) + off; }
    const int nig = WGM * nN, gid = wgid / nig, fm = gid * WGM, gsz = (nM - fm) < WGM ? (nM - fm) : WGM;
    u.pm = fm + ((wgid % nig) % gsz);
    u.pn = (wgid % nig) / gsz;
    return true;
  }
};
template <class Epi>
__device__ __forceinline__ void gemm_phase(LAS unsigned char* lds, const h16* A, const h16* Bt, int K, const Order& S, const Epi& E) {
  const int tid = opaque_tid(), wid = __builtin_amdgcn_readfirstlane(tid >> 6), lane = tid & 63, wr = wid >> 2, wc = wid & 3, fr = lane & 15, fq = lane >> 4;
  const int nt = K / BK;
  unsigned voffA[2];
#pragma unroll
  for (int i = 0; i < 2; ++i) { int R, C; stage_rc(tid * 16 + i * 8192, R, C); voffA[i] = (unsigned)(R * K + C) * 2u; }
  const size_t kstep = (size_t)(BK * 2);
  const size_t hstep = (size_t)HALF * K * 2;
  const size_t tstep = 2 * hstep;
  const unsigned ldsw = (unsigned)wid * 1024u;
  const int aoff = lds_byte(wr * 64 + fr, fq * 8), boff = lds_byte(wc * 32 + fr, fq * 8);
#define G8_SA(b, h) (((b) * 2 + (h)) * HTB)
#define G8_SB(b, h) ((4 + (b) * 2 + (h)) * HTB)
#define G8_STAGE(bufoff, gbase) do { _Pragma("unroll") for (int _i = 0; _i < 2; ++_i) \
    __builtin_amdgcn_global_load_lds((const unsigned*)((const char*)(gbase) + voffA[_i]), (LAS unsigned*)(lds + (bufoff) + ldsw + _i * 8192), 16, 0, 0); } while (0)
#define G8_LDA(dst, b, h) do { _Pragma("unroll") for (int m = 0; m < 4; ++m) _Pragma("unroll") for (int k = 0; k < 2; ++k) dst[m][k] = *(const LAS h16x8*)(lds + G8_SA(b, h) + aoff + m * 2048 + k * 1024); } while (0)
#define G8_LDB(dst, b, h) do { _Pragma("unroll") for (int n = 0; n < 2; ++n) _Pragma("unroll") for (int k = 0; k < 2; ++k) dst[n][k] = *(const LAS h16x8*)(lds + G8_SB(b, h) + boff + n * 2048 + k * 1024); } while (0)
#define G8_MMA(ai, bj, At, Bt_) do { __builtin_amdgcn_s_setprio(1); _Pragma("unroll") for (int m = 0; m < 4; ++m) _Pragma("unroll") for (int n = 0; n < 2; ++n) _Pragma("unroll") for (int k = 0; k < 2; ++k) \
    acc[ai][bj][m][n] = __builtin_amdgcn_mfma_f32_16x16x32_f16(Bt_[n][k], At[m][k], acc[ai][bj][m][n], 0, 0, 0); __builtin_amdgcn_s_setprio(0); } while (0)
#define G8_WAIT_V(n) asm volatile("s_waitcnt vmcnt(" #n ")" ::: "memory")
#define G8_WAIT_L(n) asm volatile("s_waitcnt lgkmcnt(" #n ")" ::: "memory")
#define G8_BAR __builtin_amdgcn_s_barrier()
#define G8_SCHED __builtin_amdgcn_sched_barrier(0)
  Unit cur, nxt;
  int ui = 0;
  if (!S.next(0, cur)) return;
  f32x4 acc[2][2][4][2];
#pragma unroll
  for (int a = 0; a < 2; ++a)
#pragma unroll
    for (int b = 0; b < 2; ++b)
#pragma unroll
      for (int m = 0; m < 4; ++m)
#pragma unroll
        for (int n = 0; n < 2; ++n) acc[a][b][m][n] = (f32x4){0.f, 0.f, 0.f, 0.f};
  h16x8 At[4][2], B0[2][2], B1[2][2];
  const char* cA = (const char*)A + (size_t)cur.pm * tstep;
  const char* cB = (const char*)Bt + (size_t)cur.pn * tstep;
  G8_STAGE(G8_SB(0, 0), cB); G8_STAGE(G8_SA(0, 0), cA); G8_STAGE(G8_SB(0, 1), cB + hstep); G8_STAGE(G8_SA(0, 1), cA + hstep);
  if (wr == 1) G8_BAR;
  G8_WAIT_V(4); G8_BAR;
  G8_STAGE(G8_SB(1, 0), cB + kstep); G8_STAGE(G8_SA(1, 0), cA + kstep); G8_STAGE(G8_SB(1, 1), cB + hstep + kstep);
  G8_WAIT_V(6); G8_BAR;
  for (;;) {
    const bool has_next = S.next(ui + 1, nxt);
    const char* nA = has_next ? (const char*)A + (size_t)nxt.pm * tstep : cA;
    const char* nB = has_next ? (const char*)Bt + (size_t)nxt.pn * tstep : cB;
    for (int t = 0; t < nt; t += 2) {
      const bool last = (t == nt - 2);
      const char* a1 = cA + (size_t)(t + 1) * kstep;
      const char* a2 = last ? nA : cA + (size_t)(t + 2) * kstep;
      const char* b2 = last ? nB : cB + (size_t)(t + 2) * kstep;
      const char* a3 = a2 + kstep;
      const char* b3 = b2 + kstep;
      if (Epi::MID_T >= 0 && t == Epi::MID_T) E.mid(acc, ui, wr, fr);
      G8_LDB(B0, 0, 0); G8_SCHED; G8_LDA(At, 0, 0); G8_STAGE(G8_SA(1, 1), a1 + hstep);
      G8_WAIT_L(8); G8_BAR; G8_WAIT_L(0); G8_MMA(0, 0, At, B0); G8_BAR; G8_SCHED;
      G8_LDB(B1, 0, 1); G8_STAGE(G8_SB(0, 0), b2);
      G8_BAR; G8_WAIT_L(0); G8_MMA(0, 1, At, B1); G8_BAR;
      G8_LDA(At, 0, 1); G8_STAGE(G8_SA(0, 0), a2);
      G8_BAR; G8_WAIT_L(0); G8_MMA(1, 0, At, B0); G8_BAR; G8_SCHED;
      G8_STAGE(G8_SB(0, 1), b2 + hstep);
      G8_WAIT_V(6); G8_BAR; G8_MMA(1, 1, At, B1); G8_BAR;
      G8_LDB(B0, 1, 0); G8_SCHED; G8_LDA(At, 1, 0); G8_STAGE(G8_SA(0, 1), a2 + hstep);
      G8_WAIT_L(8); G8_BAR; G8_WAIT_L(0); G8_MMA(0, 0, At, B0); G8_BAR; G8_SCHED;
      G8_LDB(B1, 1, 1); G8_STAGE(G8_SB(1, 0), b3);
      G8_BAR; G8_WAIT_L(0); G8_MMA(0, 1, At, B1); G8_BAR;
      G8_LDA(At, 1, 1); G8_STAGE(G8_SA(1, 0), a3);
      G8_BAR; G8_WAIT_L(0); G8_MMA(1, 0, At, B0); G8_BAR; G8_SCHED;
      G8_STAGE(G8_SB(1, 1), b3 + hstep);
      G8_WAIT_V(6); G8_BAR; G8_MMA(1, 1, At, B1); G8_BAR;
    }
    E(acc, cur, ui, wr, wc, fr, fq);
    if (!has_next) break;
#pragma unroll
    for (int a = 0; a < 2; ++a)
#pragma unroll
      for (int b = 0; b < 2; ++b)
#pragma unroll
        for (int m = 0; m < 4; ++m)
#pragma unroll
          for (int n = 0; n < 2; ++n) acc[a][b][m][n] = (f32x4){0.f, 0.f, 0.f, 0.f};
    cur = nxt; cA = nA; cB = nB; ++ui;
  }
  G8_WAIT_V(0);
  if (wr == 0) G8_BAR;
  G8_BAR;
#undef G8_SA
#undef G8_SB
#undef G8_STAGE
#undef G8_LDA
#undef G8_LDB
#undef G8_MMA
#undef G8_WAIT_V
#undef G8_WAIT_L
#undef G8_BAR
#undef G8_SCHED
}
}

constexpr int RSL_OFF = g8::STAGE_BYTES;
constexpr int LDS_GEMM = g8::STAGE_BYTES + 8 * 256 * 4;

__device__ __forceinline__ void fill_rowscales(float* rsl, const float* ssq, float inv_n, const g8::Order& S) {
  const int tid = opaque_tid();
  g8::Unit u;
  __syncthreads();
  for (int i = 0; S.next(i, u); ++i) {
    if (tid < 256) {
      const float4* s4 = (const float4*)(ssq + (size_t)(u.pm * 256 + tid) * 16);
      float s = 0.f;
      for (int k = 0; k < 4; ++k) { float4 v = s4[k]; s += v.x + v.y + v.z + v.w; }
      rsl[i * 256 + tid] = rsqrtf(s * inv_n + EPS);
    }
  }
  __syncthreads();
}

__device__ __forceinline__ h16x4 pack4(float a, float b, float c, float d) { h16x4 v = {(h16)a, (h16)b, (h16)c, (h16)d}; return v; }

struct EpiIn {
  static constexpr int MID_T = -1;
  __device__ __forceinline__ void mid(f32x4 (&)[2][2][4][2], int, int, int) const {}
  h16* P; const float* rsl; const float* qkg;
  __device__ __forceinline__ void operator()(const f32x4 (&acc)[2][2][4][2], const g8::Unit& u, int ui, int wr, int wc, int fr, int fq) const {
    const int hs = u.pn * 4 + wc;
    int gi = -1;
    if (hs < 4) gi = 0; else if (hs < 6) gi = 1; else if (hs >= 16 && hs < 20) gi = 2; else if (hs == 22) gi = 4; else if (hs == 24) gi = 5;
    const bool gate = (hs == 26);
#pragma unroll
    for (int ai = 0; ai < 2; ++ai)
#pragma unroll
      for (int m = 0; m < 4; ++m) {
        const int rl = 128 * ai + 64 * wr + 16 * m + fr;
        const float r = rsl[ui * 256 + rl];
        f32x4 v[2][2];
#pragma unroll
        for (int bj = 0; bj < 2; ++bj)
#pragma unroll
          for (int n = 0; n < 2; ++n) v[bj][n] = acc[ai][bj][m][n] * r;
        if (gi >= 0) {
          float ss = 0.f;
#pragma unroll
          for (int bj = 0; bj < 2; ++bj)
#pragma unroll
            for (int n = 0; n < 2; ++n)
#pragma unroll
              for (int j = 0; j < 4; ++j) ss += v[bj][n][j] * v[bj][n][j];
          ss += xor16(ss);
          ss += __shfl_xor(ss, 32);
          const float sc = rsqrtf(ss * (1.f / 64.f) + EPS);
#pragma unroll
          for (int bj = 0; bj < 2; ++bj)
#pragma unroll
            for (int n = 0; n < 2; ++n) {
              const float4 g4 = *(const float4*)(qkg + gi * 64 + 32 * bj + 16 * n + 4 * fq);
              v[bj][n][0] *= sc * g4.x; v[bj][n][1] *= sc * g4.y; v[bj][n][2] *= sc * g4.z; v[bj][n][3] *= sc * g4.w;
            }
        } else if (gate) {
#pragma unroll
          for (int bj = 0; bj < 2; ++bj)
#pragma unroll
            for (int n = 0; n < 2; ++n)
#pragma unroll
              for (int j = 0; j < 4; ++j) v[bj][n][j] = (32 * bj + 16 * n + 4 * fq + j) < 12 ? sigmoidf(v[bj][n][j]) : 0.f;
        }
        h16* rowp = P + (size_t)(u.pm * 256 + rl) * IWP + 64 * hs + 4 * fq;
#pragma unroll
        for (int bj = 0; bj < 2; ++bj)
#pragma unroll
          for (int n = 0; n < 2; ++n) *(h16x4*)(rowp + 32 * bj + 16 * n) = pack4(v[bj][n][0], v[bj][n][1], v[bj][n][2], v[bj][n][3]);
      }
  }
};

struct EpiGlu {
  static constexpr int MID_T = -1;
  __device__ __forceinline__ void mid(f32x4 (&)[2][2][4][2], int, int, int) const {}
  h16* OB; float* ssqb; const float* gb;
  __device__ __forceinline__ void operator()(const f32x4 (&acc)[2][2][4][2], const g8::Unit& u, int ui, int wr, int wc, int fr, int fq) const {
    const int ocb = 128 * u.pn + 16 * wc + 4 * fq;
    float4 ba[2], bb[2];
#pragma unroll
    for (int bj = 0; bj < 2; ++bj) { ba[bj] = *(const float4*)(gb + ocb + 64 * bj); bb[bj] = *(const float4*)(gb + 512 + ocb + 64 * bj); }
#pragma unroll
    for (int ai = 0; ai < 2; ++ai)
#pragma unroll
      for (int m = 0; m < 4; ++m) {
        const size_t row = (size_t)u.pm * 256 + 128 * ai + 64 * wr + 16 * m + fr;
        float ss = 0.f;
#pragma unroll
        for (int bj = 0; bj < 2; ++bj) {
          const f32x4 a = acc[ai][bj][m][0], b = acc[ai][bj][m][1];
          float o0 = (a[0] + ba[bj].x) * sigmoidf(b[0] + bb[bj].x);
          float o1 = (a[1] + ba[bj].y) * sigmoidf(b[1] + bb[bj].y);
          float o2 = (a[2] + ba[bj].z) * sigmoidf(b[2] + bb[bj].z);
          float o3 = (a[3] + ba[bj].w) * sigmoidf(b[3] + bb[bj].w);
          *(h16x4*)(OB + row * 1024 + ocb + 64 * bj) = pack4(o0, o1, o2, o3);
          ss += o0 * o0 + o1 * o1 + o2 * o2 + o3 * o3;
        }
        ss += xor16(ss);
        ss += __shfl_xor(ss, 32);
        if (fq == 0) ssqb[row * 16 + u.pn * 4 + wc] = ss;
      }
  }
};

struct EpiRes {
  static constexpr int MID_T = -1;
  __device__ __forceinline__ void mid(f32x4 (&)[2][2][4][2], int, int, int) const {}
  float* xo; const float* xsrc; h16* xb; float* ssq;
  __device__ __forceinline__ void operator()(const f32x4 (&acc)[2][2][4][2], const g8::Unit& u, int ui, int wr, int wc, int fr, int fq) const {
#pragma unroll
    for (int ai = 0; ai < 2; ++ai)
#pragma unroll
      for (int m = 0; m < 4; ++m) {
        const size_t row = (size_t)u.pm * 256 + 128 * ai + 64 * wr + 16 * m + fr;
        const size_t base = row * DM + 256 * u.pn + 32 * wc + 4 * fq;
        float ss = 0.f;
#pragma unroll
        for (int bj = 0; bj < 2; ++bj)
#pragma unroll
          for (int n = 0; n < 2; ++n) {
            const size_t idx = base + 128 * bj + 16 * n;
            const float4 xv = *(const float4*)(xsrc + idx);
            const f32x4 a = acc[ai][bj][m][n];
            const float x0 = xv.x + a[0], x1 = xv.y + a[1], x2 = xv.z + a[2], x3 = xv.w + a[3];
            *(float4*)(xo + idx) = make_float4(x0, x1, x2, x3);
            *(h16x4*)(xb + idx) = pack4(x0, x1, x2, x3);
            ss += x0 * x0 + x1 * x1 + x2 * x2 + x3 * x3;
          }
        ss += xor16(ss);
        ss += __shfl_xor(ss, 32);
        if (fq == 0) ssq[row * 16 + u.pn * 4 + wc] = ss;
      }
  }
};

struct EpiOut : EpiRes {
  static constexpr int MID_T = 8;
  const float* rsl;
  __device__ __forceinline__ void mid(f32x4 (&acc)[2][2][4][2], int ui, int wr, int fr) const {
#pragma unroll
    for (int ai = 0; ai < 2; ++ai)
#pragma unroll
      for (int m = 0; m < 4; ++m) {
        const float r = rsl[ui * 256 + 128 * ai + 64 * wr + 16 * m + fr];
#pragma unroll
        for (int bj = 0; bj < 2; ++bj)
#pragma unroll
          for (int n = 0; n < 2; ++n) acc[ai][bj][m][n] *= r;
      }
  }
};

struct EpiUp {
  static constexpr int MID_T = -1;
  __device__ __forceinline__ void mid(f32x4 (&)[2][2][4][2], int, int, int) const {}
  h16* hid; const float* rsl;
  __device__ __forceinline__ void operator()(const f32x4 (&acc)[2][2][4][2], const g8::Unit& u, int ui, int wr, int wc, int fr, int fq) const {
#pragma unroll
    for (int ai = 0; ai < 2; ++ai)
#pragma unroll
      for (int m = 0; m < 4; ++m) {
        const int rl = 128 * ai + 64 * wr + 16 * m + fr;
        const float r = rsl[ui * 256 + rl];
        h16* rowp = hid + (size_t)(u.pm * 256 + rl) * DFF + 256 * u.pn + 32 * wc + 4 * fq;
#pragma unroll
        for (int bj = 0; bj < 2; ++bj)
#pragma unroll
          for (int n = 0; n < 2; ++n) {
            const f32x4 a = acc[ai][bj][m][n];
            float v0 = fmaxf(a[0] * r, 0.f), v1 = fmaxf(a[1] * r, 0.f), v2 = fmaxf(a[2] * r, 0.f), v3 = fmaxf(a[3] * r, 0.f);
            *(h16x4*)(rowp + 128 * bj + 16 * n) = pack4(v0 * v0, v1 * v1, v2 * v2, v3 * v3);
          }
      }
  }
};

__device__ void phase_gemm1(const Params& p, int l, char* lds) {
  g8::Order S; S.init(NTOK, IWP, gridDim.x, blockIdx.x);
  float* rsl = (float*)(lds + RSL_OFF);
  fill_rowscales(rsl, (const float*)(p.ws + O_SSQ), 1.f / DM, S);
  EpiIn E{(h16*)(p.ws + O_P), rsl, p.in[3] + l * 6 * 64};
  g8::gemm_phase((LAS unsigned char*)lds, (const h16*)(p.ws + O_XB), (const h16*)(p.ws + O_WIN + l * SZ_WIN), DM, S, E);
}
__device__ void phase_glu(const Params& p, int l, char* lds) {
  g8::Order S; S.init(NTOK, 1024, gridDim.x, blockIdx.x);
  __syncthreads();
  EpiGlu E{(h16*)(p.ws + O_OB), (float*)(p.ws + O_SSQB), p.in[15] + l * 1024};
  g8::gemm_phase((LAS unsigned char*)lds, (const h16*)(p.ws + O_Z), (const h16*)(p.ws + O_WGLU + l * SZ_WGLU), 512, S, E);
}
__device__ void phase_wout(const Params& p, int l, char* lds) {
  g8::Order S; S.init(NTOK, DM, gridDim.x, blockIdx.x);
  float* rsl = (float*)(lds + RSL_OFF);
  fill_rowscales(rsl, (const float*)(p.ws + O_SSQB), 1.f / 512.f, S);
  EpiOut E;
  E.xo = p.out; E.xsrc = (l == 0) ? p.in[0] : p.out; E.xb = (h16*)(p.ws + O_XB); E.ssq = (float*)(p.ws + O_SSQ); E.rsl = rsl;
  g8::gemm_phase((LAS unsigned char*)lds, (const h16*)(p.ws + O_OB), (const h16*)(p.ws + O_WOUT + l * SZ_WOUT), DM, S, E);
}
__device__ void phase_up(const Params& p, int l, char* lds) {
  g8::Order S; S.init(NTOK, DFF, gridDim.x, blockIdx.x);
  float* rsl = (float*)(lds + RSL_OFF);
  fill_rowscales(rsl, (const float*)(p.ws + O_SSQ), 1.f / DM, S);
  EpiUp E{(h16*)(p.ws + O_HID), rsl};
  g8::gemm_phase((LAS unsigned char*)lds, (const h16*)(p.ws + O_XB), (const h16*)(p.ws + O_WUP + l * SZ_WUP), DM, S, E);
}
__device__ void phase_down(const Params& p, int l, char* lds) {
  g8::Order S; S.init(NTOK, DM, gridDim.x, blockIdx.x);
  __syncthreads();
  EpiRes E{p.out, p.out, (h16*)(p.ws + O_XB), (float*)(p.ws + O_SSQ)};
  g8::gemm_phase((LAS unsigned char*)lds, (const h16*)(p.ws + O_HID), (const h16*)(p.ws + O_WDN + l * SZ_WDN), DFF, S, E);
}

constexpr int KP = 72;
enum { M_SWA = 0, M_WIN = 1, M_SEL = 2, M_CMPA = 3, M_CMPB = 4 };
constexpr float LOG2E = 1.4426950408889634f, SCL2 = 0.125f * LOG2E;
struct RowState { float m[4], l[4]; };

__device__ __forceinline__ h16x8 ld_row8(const h16* base, int ld, int row, int nrows, int c8) {
  h16x8 z = {0, 0, 0, 0, 0, 0, 0, 0};
  return (row >= 0 && row < nrows) ? *(const h16x8*)(base + (size_t)row * ld + c8 * 8) : z;
}
__device__ __forceinline__ void st_k(h16* Ks, int row, int c8, h16x8 v) { *(h16x8*)(Ks + row * KP + c8 * 8) = v; }
__device__ __forceinline__ void st_vt(h16* Vt, int row, int c8, h16x8 v) {
#pragma unroll
  for (int e = 0; e < 8; ++e) Vt[(c8 * 8 + e) * KP + row] = v[e];
}

template <int MODE, int RGM>
__device__ __forceinline__ void attn_tile(const h16x8 (&Q)[2][2], f32x4 (&O)[2][4], RowState (&st)[2], const h16* Ks,
                                          const h16* Vt, h16* Pb, const float* biasT, const int (&tq)[2], int head,
                                          int kbase, const bool (&selbit)[2], float (&hp)[2][4], const int lane) {
  const int col = lane & 15, q4 = lane >> 4;
  f32x4 S[2][4];
#pragma unroll
  for (int kt = 0; kt < 4; ++kt) {
#pragma unroll
    for (int rg = 0; rg < 2; ++rg) S[rg][kt] = f32x4{0.f, 0.f, 0.f, 0.f};
#pragma unroll
    for (int ks = 0; ks < 2; ++ks) {
      h16x8 B = *(const h16x8*)(Ks + (kt * 16 + col) * KP + ks * 32 + q4 * 8);
#pragma unroll
      for (int rg = 0; rg < 2; ++rg)
        if (RGM & (1 << rg)) S[rg][kt] = __builtin_amdgcn_mfma_f32_16x16x32_f16(Q[rg][ks], B, S[rg][kt], 0, 0, 0);
    }
  }
#pragma unroll
  for (int rg = 0; rg < 2; ++rg) {
    if (!(RGM & (1 << rg))) continue;
#pragma unroll
    for (int kt = 0; kt < 4; ++kt) {
      const int kx = kbase + kt * 16 + col;
      if (MODE == M_SWA) {
#pragma unroll
        for (int j = 0; j < 4; ++j) {
          int dist = tq[rg] + j - kx;
          bool valid = dist >= 0 && dist < 128 && kx >= 0;
          int dc = dist < 0 ? 0 : (dist > 799 ? 799 : dist);
          S[rg][kt][j] = valid ? S[rg][kt][j] * SCL2 + biasT[dc * 4 + head] : -1e30f;
        }
      } else {
        int dist;
        bool valid;
        if (MODE == M_WIN) { dist = tq[rg] - kx; valid = dist >= 0 && dist < 512 && kx >= 0; }
        else if (MODE == M_SEL) { dist = tq[rg] - kx; valid = selbit[rg] && dist >= 0; }
        else { dist = tq[rg] - (16 * kx + 31); valid = dist >= 0 && kx < NCMP; }
        int dc = dist < 0 ? 0 : (dist > 799 ? 799 : dist);
        float4 bv = *(const float4*)(biasT + dc * 4);
        S[rg][kt][0] = valid ? S[rg][kt][0] * SCL2 + bv.x : -1e30f;
        S[rg][kt][1] = valid ? S[rg][kt][1] * SCL2 + bv.y : -1e30f;
        S[rg][kt][2] = valid ? S[rg][kt][2] * SCL2 + bv.z : -1e30f;
        S[rg][kt][3] = valid ? S[rg][kt][3] * SCL2 + bv.w : -1e30f;
      }
    }
    if (MODE == M_CMPB) {
#pragma unroll
      for (int kt = 0; kt < 4; ++kt) {
        float h = 0.f;
#pragma unroll
        for (int j = 0; j < 4; ++j) {
          float pv = __builtin_amdgcn_exp2f(S[rg][kt][j] - st[rg].m[j]) * st[rg].l[j];
          S[rg][kt][j] = pv;
          h += pv;
        }
        hp[rg][kt] = h;
      }
    } else {
#pragma unroll
      for (int j = 0; j < 4; ++j) {
        float mx = fmaxf(fmaxf(S[rg][0][j], S[rg][1][j]), fmaxf(S[rg][2][j], S[rg][3][j]));
        mx = max16(mx);
        float mn = fmaxf(st[rg].m[j], mx);
        float corr = __builtin_amdgcn_exp2f(st[rg].m[j] - mn);
        st[rg].m[j] = mn;
        float mm = fmaxf(mn, -1e20f);
        float ls = 0.f;
#pragma unroll
        for (int kt = 0; kt < 4; ++kt) {
          float pv = __builtin_amdgcn_exp2f(S[rg][kt][j] - mm);
          S[rg][kt][j] = pv;
          ls += pv;
        }
        st[rg].l[j] = st[rg].l[j] * corr + ls;
        if (MODE != M_CMPA) {
#pragma unroll
          for (int nt = 0; nt < 4; ++nt) O[rg][nt][j] *= corr;
        }
      }
    }
    if (MODE != M_CMPA) {
#pragma unroll
      for (int kt = 0; kt < 4; ++kt)
#pragma unroll
        for (int j = 0; j < 4; ++j) Pb[rg * 16 * KP + (q4 * 4 + j) * KP + kt * 16 + col] = (h16)S[rg][kt][j];
    }
  }
  if (MODE == M_CMPA) return;
  asm volatile("" ::: "memory");
#pragma unroll
  for (int ks = 0; ks < 2; ++ks) {
    h16x8 A[2];
#pragma unroll
    for (int rg = 0; rg < 2; ++rg)
      if (RGM & (1 << rg)) A[rg] = *(const h16x8*)(Pb + rg * 16 * KP + col * KP + ks * 32 + q4 * 8);
#pragma unroll
    for (int nt = 0; nt < 4; ++nt) {
      h16x8 B = *(const h16x8*)(Vt + (nt * 16 + col) * KP + ks * 32 + q4 * 8);
#pragma unroll
      for (int rg = 0; rg < 2; ++rg)
        if (RGM & (1 << rg)) O[rg][nt] = __builtin_amdgcn_mfma_f32_16x16x32_f16(A[rg], B, O[rg][nt], 0, 0, 0);
    }
  }
  asm volatile("" ::: "memory");
}

__device__ __forceinline__ float red16(float v) { return sum16(v); }

constexpr int LDS_CMP = 8 * 16 * 128 * 4 + 16 * 136 * 2 + 4 * 16 * 4;
__device__ void phase_compress(const Params& p, int l, char* lds) {
  const int tid = opaque_tid(), lane = tid & 63, w = tid >> 6, col = lane & 15, q4 = lane >> 4;
  float* red = (float*)lds;
  h16* hid = (h16*)(lds + 8 * 16 * 128 * 4);
  float* nrm2 = (float*)(lds + 8 * 16 * 128 * 4 + 16 * 136 * 2);
  const h16* P = (const h16*)(p.ws + O_P);
  for (int u = blockIdx.x; u < BATCH * 2 * 32; u += gridDim.x) {
    const int mt = u & 31, st = (u >> 5) & 1, b = u >> 6;
    const h16* W1t = (const h16*)(p.ws + O_W1T) + (size_t)(l * 2 + st) * 128 * 2048;
    const h16* W2t = (const h16*)(p.ws + O_W2T) + (size_t)(l * 2 + st) * 64 * 128;
    const float* b1 = (const float*)(p.ws + O_BIAS1) + (l * 2 + st) * 128;
    __syncthreads();
    {
      f32x4 acc[8];
#pragma unroll
      for (int nt = 0; nt < 8; ++nt) acc[nt] = f32x4{0.f, 0.f, 0.f, 0.f};
      const int m = 16 * mt + col;
#pragma unroll 2
      for (int kk = 0; kk < 8; ++kk) {
        const int ks = 8 * w + kk, tt = ks >> 1, d0 = (ks & 1) * 32 + q4 * 8;
        int tok = 16 * m + tt;
        if (tok > SEQ - 1) tok = SEQ - 1;
        const h16x8 A = *(const h16x8*)(P + ((size_t)b * SEQ + tok) * IWP + OFF_KVC + st * 64 + d0);
#pragma unroll
        for (int nt = 0; nt < 8; ++nt) {
          const h16x8 B = *(const h16x8*)(W1t + (size_t)(nt * 16 + col) * 2048 + ks * 32 + q4 * 8);
          acc[nt] = __builtin_amdgcn_mfma_f32_16x16x32_f16(A, B, acc[nt], 0, 0, 0);
        }
      }
#pragma unroll
      for (int nt = 0; nt < 8; ++nt)
#pragma unroll
        for (int j = 0; j < 4; ++j) red[(w * 16 + q4 * 4 + j) * 128 + nt * 16 + col] = acc[nt][j];
    }
    __syncthreads();
    {
      const int row = tid >> 5, c4 = (tid & 31) * 4;
      float4 sum = *(const float4*)(b1 + c4);
#pragma unroll
      for (int ww = 0; ww < 8; ++ww) {
        const float4 v = *(const float4*)(red + (ww * 16 + row) * 128 + c4);
        sum.x += v.x; sum.y += v.y; sum.z += v.z; sum.w += v.w;
      }
      *(h16x4*)(hid + row * 136 + c4) = pack4(gelu_tanh(sum.x), gelu_tanh(sum.y), gelu_tanh(sum.z), gelu_tanh(sum.w));
    }
    __syncthreads();
    f32x4 o2 = {0.f, 0.f, 0.f, 0.f};
    if (w < 4) {
#pragma unroll
      for (int ks = 0; ks < 4; ++ks) {
        const h16x8 A = *(const h16x8*)(hid + col * 136 + ks * 32 + q4 * 8);
        const h16x8 B = *(const h16x8*)(W2t + (size_t)(w * 16 + col) * 128 + ks * 32 + q4 * 8);
        o2 = __builtin_amdgcn_mfma_f32_16x16x32_f16(A, B, o2, 0, 0, 0);
      }
      if (st == 0) {
#pragma unroll
        for (int j = 0; j < 4; ++j) {
          float ss = sum16(o2[j] * o2[j]);
          if (col == 0) nrm2[w * 16 + q4 * 4 + j] = ss;
        }
      }
    }
    __syncthreads();
    if (w < 4) {
      const float g = p.in[3][(l * 6 + 3) * 64 + w * 16 + col];
      h16* dst = (h16*)(p.ws + (st == 0 ? O_KCMP : O_VCMP));
#pragma unroll
      for (int j = 0; j < 4; ++j) {
        const int row = q4 * 4 + j, m = 16 * mt + row;
        float v = o2[j];
        if (st == 0) {
          float tot = nrm2[row] + nrm2[16 + row] + nrm2[32 + row] + nrm2[48 + row];
          v = v * rsqrtf(tot * (1.f / 64.f) + EPS) * g;
        }
        if (m >= NCMP) v = 0.f;
        dst[((size_t)b * 512 + m) * 64 + w * 16 + col] = (h16)v;
      }
    }
  }
}

constexpr int LDS_BIAS = 800 * 16;
constexpr int LDS_PB = NW * 32 * KP * 2;
__device__ void phase_swa(const Params& p, int l, char* lds) {
  const int tid = opaque_tid(), lane = tid & 63, w = tid >> 6, col = lane & 15, q4 = lane >> 4;
  float* biasT = (float*)lds;
  h16* Pb = (h16*)(lds + LDS_BIAS) + w * 32 * KP;
  h16* KV = (h16*)(lds + LDS_BIAS + LDS_PB);
  float* nrm = (float*)(lds + LDS_BIAS + LDS_PB + 4 * 64 * KP * 2);
  const h16* P = (const h16*)(p.ws + O_P);
  const int* lut = (const int*)(p.ws + O_LUT);
  h16* OAC = (h16*)(p.ws + O_OAC);
  __syncthreads();
  for (int i = tid; i < 3200; i += NT) biasT[i] = p.in[5][lut[i >> 2] * 8 + (i & 3)] * LOG2E;
  __syncthreads();
  const int head = w >> 1, kvh = w >> 2;
  const float sink = p.in[4][l * 4 + head] * LOG2E;
  const int srow = tid >> 3, c8 = tid & 7;
  float hpd[2][4];
  const bool nosel[2] = {false, false};
  for (int u = blockIdx.x; u < BATCH * 128; u += gridDim.x) {
    const int b = u >> 7, t0 = (u & 127) * 64;
    const h16* Pbat = P + (size_t)b * SEQ * IWP;
    h16x8 Q[2][2];
    int tq[2];
#pragma unroll
    for (int rg = 0; rg < 2; ++rg) {
      const int qb = (w & 1) * 32 + rg * 16;
      const h16* qp = Pbat + (size_t)(t0 + qb + col) * IWP + head * 64 + q4 * 8;
      Q[rg][0] = *(const h16x8*)qp;
      Q[rg][1] = *(const h16x8*)(qp + 32);
      tq[rg] = t0 + qb + q4 * 4;
    }
    f32x4 O[2][4];
    RowState st[2];
#pragma unroll
    for (int rg = 0; rg < 2; ++rg) {
#pragma unroll
      for (int nt = 0; nt < 4; ++nt) O[rg][nt] = f32x4{0.f, 0.f, 0.f, 0.f};
#pragma unroll
      for (int j = 0; j < 4; ++j) { st[rg].m[j] = -1e30f; st[rg].l[j] = 0.f; }
    }
    const int i0 = t0 >= 128 ? 0 : (t0 >= 64 ? 1 : 2);
    h16x8 rk[2], rv[2];
    {
      int sb = t0 - 128 + i0 * 64;
      for (int h2 = 0; h2 < 2; ++h2) {
        rk[h2] = ld_row8(Pbat + 256 + h2 * 64, IWP, sb + srow, SEQ, c8);
        rv[h2] = ld_row8(Pbat + 384 + h2 * 64, IWP, sb + srow, SEQ, c8);
      }
    }
    for (int i = i0; i < 3; ++i) {
      __syncthreads();
      for (int h2 = 0; h2 < 2; ++h2) {
        st_k(KV + h2 * 64 * KP, srow, c8, rk[h2]);
        st_vt(KV + (2 + h2) * 64 * KP, srow, c8, rv[h2]);
      }
      __syncthreads();
      if (i + 1 < 3) {
        int sb = t0 - 128 + (i + 1) * 64;
        for (int h2 = 0; h2 < 2; ++h2) {
          rk[h2] = ld_row8(Pbat + 256 + h2 * 64, IWP, sb + srow, SEQ, c8);
          rv[h2] = ld_row8(Pbat + 384 + h2 * 64, IWP, sb + srow, SEQ, c8);
        }
      }
      const int kb = t0 - 128 + i * 64;
      attn_tile<M_SWA, 3>(Q, O, st, KV + kvh * 64 * KP, KV + (2 + kvh) * 64 * KP, Pb, biasT, tq, head, kb, nosel, hpd, lane);
    }
    __syncthreads();
#pragma unroll
    for (int rg = 0; rg < 2; ++rg) {
      const int qb = (w & 1) * 32 + rg * 16;
#pragma unroll
      for (int j = 0; j < 4; ++j) {
        float lsum = red16(st[rg].l[j]);
        float mn = fmaxf(st[rg].m[j], sink);
        float corr = __builtin_amdgcn_exp2f(st[rg].m[j] - mn);
        float inv = corr / (lsum * corr + __builtin_amdgcn_exp2f(sink - mn));
        float ss = 0.f;
#pragma unroll
        for (int nt = 0; nt < 4; ++nt) { O[rg][nt][j] *= inv; ss += O[rg][nt][j] * O[rg][nt][j]; }
        ss = red16(ss);
        if (col == 0) nrm[head * 64 + qb + q4 * 4 + j] = ss;
      }
    }
    __syncthreads();
#pragma unroll
    for (int rg = 0; rg < 2; ++rg) {
      const int qb = (w & 1) * 32 + rg * 16;
#pragma unroll
      for (int j = 0; j < 4; ++j) {
        const int qi = qb + q4 * 4 + j;
        float tot = nrm[qi] + nrm[64 + qi] + nrm[128 + qi] + nrm[192 + qi];
        float sc = rsqrtf(tot * (1.f / 256.f) + EPS);
#pragma unroll
        for (int nt = 0; nt < 4; ++nt)
          OAC[((size_t)b * SEQ + t0 + qi) * 1024 + head * 64 + nt * 16 + col] = (h16)(O[rg][nt][j] * sc);
      }
    }
  }
}

constexpr int LDS_NSA = LDS_BIAS + LDS_PB + 4 * 64 * KP * 2 + NW * 4 * 128 * 4 + 32 * 16;
__device__ void phase_nsa(const Params& p, int l, char* lds) {
  const int tid = opaque_tid(), lane = tid & 63, w = tid >> 6, col = lane & 15, q4 = lane >> 4;
  float* biasT = (float*)lds;
  h16* Pb = (h16*)(lds + LDS_BIAS) + w * 32 * KP;
  h16* KV0 = (h16*)(lds + LDS_BIAS + LDS_PB);
  float* impw = (float*)(lds + LDS_BIAS + LDS_PB + 4 * 64 * KP * 2) + w * 4 * 128;
  unsigned long long* selm = (unsigned long long*)(lds + LDS_BIAS + LDS_PB + 4 * 64 * KP * 2 + NW * 4 * 128 * 4);
#define KSB(i) (KV0 + ((i) & 1) * 2 * 64 * KP)
#define VTB(i) (KV0 + ((i) & 1) * 2 * 64 * KP + 64 * KP)
  const h16* P = (const h16*)(p.ws + O_P);
  const int* lut = (const int*)(p.ws + O_LUT);
  h16* OAC = (h16*)(p.ws + O_OAC);
  __syncthreads();
  for (int i = tid; i < 3200; i += NT) biasT[i] = p.in[5][lut[i >> 2] * 8 + 4 + (i & 3)] * LOG2E;
  __syncthreads();
  const int srow = tid >> 3, c8 = tid & 7;
  float hpd[2][4];
  const bool nosel[2] = {false, false};
  for (int u = blockIdx.x; u < 1024; u += gridDim.x) {
    const int rnd = u >> 8, b = (u & 255) >> 6, ti = u & 63;
    const int tile = rnd == 0 ? 255 - ti : (rnd == 1 ? 128 + ti : (rnd == 2 ? 127 - ti : ti));
    const int t0 = tile * 32, cur = t0 >> 6;
    const h16* Pbat = P + (size_t)b * SEQ * IWP;
    const h16* KC = (const h16*)(p.ws + O_KCMP) + (size_t)b * 512 * 64;
    const h16* VC = (const h16*)(p.ws + O_VCMP) + (size_t)b * 512 * 64;
    h16x8 Q[2][2];
    int tq[2] = {0, 0};
    {
      const int qi = w * 4 + (col >> 2), hd = col & 3;
      const h16* qp = Pbat + (size_t)(t0 + qi) * IWP + OFF_QC + hd * 64 + q4 * 8;
      Q[0][0] = *(const h16x8*)qp;
      Q[0][1] = *(const h16x8*)(qp + 32);
      tq[0] = t0 + w * 4 + q4;
    }
    for (int i = lane; i < 512; i += 64) impw[i] = 0.f;
    f32x4 O[2][4], Oc[2][4];
    RowState st[2];
    h16x8 rk, rv;
    int mvmax = t0 / 16 + 1;
    if (mvmax > NCMP) mvmax = NCMP;
    const int ntc = (mvmax + 63) >> 6;
#pragma unroll
    for (int rg = 0; rg < 1; ++rg)
#pragma unroll
      for (int j = 0; j < 4; ++j) { st[rg].m[j] = -1e30f; st[rg].l[j] = 0.f; }
    rk = ld_row8(KC, 64, srow, 512, c8);
    st_k(KSB(0), srow, c8, rk);
    if (1 < ntc) rk = ld_row8(KC, 64, 64 + srow, 512, c8);
    __syncthreads();
    for (int i = 0; i < ntc; ++i) {
      if (i + 1 < ntc) st_k(KSB(i + 1), srow, c8, rk);
      if (i + 2 < ntc) rk = ld_row8(KC, 64, (i + 2) * 64 + srow, 512, c8);
      attn_tile<M_CMPA, 1>(Q, O, st, KSB(i), VTB(i), Pb, biasT, tq, 0, i * 64, nosel, hpd, lane);
      __syncthreads();
    }
#pragma unroll
    for (int rg = 0; rg < 1; ++rg)
#pragma unroll
      for (int j = 0; j < 4; ++j) {
        float ls = red16(st[rg].l[j]);
        st[rg].l[j] = ls > 0.f ? 1.f / ls : 0.f;
      }
#pragma unroll
    for (int rg = 0; rg < 1; ++rg)
#pragma unroll
      for (int nt = 0; nt < 4; ++nt) O[rg][nt] = f32x4{0.f, 0.f, 0.f, 0.f};
    float carry[1] = {0.f};
    rk = ld_row8(KC, 64, srow, 512, c8);
    rv = ld_row8(VC, 64, srow, 512, c8);
    st_k(KSB(0), srow, c8, rk);
    st_vt(VTB(0), srow, c8, rv);
    if (1 < ntc) {
      rk = ld_row8(KC, 64, 64 + srow, 512, c8);
      rv = ld_row8(VC, 64, 64 + srow, 512, c8);
    }
    __syncthreads();
    for (int i = 0; i < ntc; ++i) {
      if (i + 1 < ntc) { st_k(KSB(i + 1), srow, c8, rk); st_vt(VTB(i + 1), srow, c8, rv); }
      if (i + 2 < ntc) {
        rk = ld_row8(KC, 64, (i + 2) * 64 + srow, 512, c8);
        rv = ld_row8(VC, 64, (i + 2) * 64 + srow, 512, c8);
      }
      float hp2[2][4];
      attn_tile<M_CMPB, 1>(Q, O, st, KSB(i), VTB(i), Pb, biasT, tq, 0, i * 64, nosel, hp2, lane);
#pragma unroll
      for (int rg = 0; rg < 1; ++rg) {
        float hp[4] = {hp2[rg][0], hp2[rg][1], hp2[rg][2], hp2[rg][3]};
#pragma unroll
        for (int kt = 0; kt < 4; ++kt) {
          float h = hp[kt];
          float qs = h + dppf<0xB1>(h);
          qs += dppf<0x4E>(qs);
          float prev = dppf<0x121>(h);
          float cin = (kt == 0) ? carry[rg] : dppf<0x121>(hp[kt > 0 ? kt - 1 : 0]);
          float pk = (col == 0) ? cin : prev;
          if ((col & 3) == 0) impw[(rg * 4 + q4) * 128 + ((i * 64 + kt * 16 + col) >> 2)] = qs + pk;
        }
        carry[rg] = dppf<0x121>(hp[3]);
      }
      __syncthreads();
    }
#pragma unroll
    for (int rg = 0; rg < 1; ++rg) {
      const h16* gp = Pbat + (size_t)tq[rg] * IWP + OFF_GC;
#pragma unroll
      for (int j = 0; j < 4; ++j) {
        float g0 = (float)gp[j * 3 + 0];
#pragma unroll
        for (int nt = 0; nt < 4; ++nt) Oc[rg][nt][j] = g0 * O[rg][nt][j];
      }
    }
    {
      const int nforced = cur >= 2 ? 3 : cur + 1;
      const int npick = 16 - nforced;
      for (int qi = 0; qi < 4; ++qi) {
        const float* im = impw + qi * 128;
        const int j0 = lane, j1 = lane + 64;
        const float v0 = im[j0], v1 = im[j1];
        int r0 = 0, r1 = 0;
        for (int jp = 1; jp <= cur - 2; ++jp) {
          float vp = im[jp];
          r0 += (vp > v0 || (vp == v0 && jp < j0)) ? 1 : 0;
          r1 += (vp > v1 || (vp == v1 && jp < j1)) ? 1 : 0;
        }
        bool c0 = j0 >= 1 && j0 <= cur - 2, c1 = j1 <= cur - 2;
        bool f0 = j0 == 0 || j0 == cur || j0 == cur - 1, f1 = j1 == cur || j1 == cur - 1;
        unsigned long long mlo = __ballot(f0 || (c0 && r0 < npick));
        unsigned long long mhi = __ballot(f1 || (c1 && r1 < npick));
        if (lane == 0) { selm[(w * 4 + qi) * 2] = mlo; selm[(w * 4 + qi) * 2 + 1] = mhi; }
      }
    }
    asm volatile("" ::: "memory");
    unsigned long long slo[2], shi[2];
#pragma unroll
    for (int rg = 0; rg < 1; ++rg) {
      slo[rg] = selm[(w * 4 + q4) * 2];
      shi[rg] = selm[(w * 4 + q4) * 2 + 1];
    }
#pragma unroll
    for (int rg = 0; rg < 1; ++rg) {
#pragma unroll
      for (int nt = 0; nt < 4; ++nt) O[rg][nt] = f32x4{0.f, 0.f, 0.f, 0.f};
#pragma unroll
      for (int j = 0; j < 4; ++j) { st[rg].m[j] = -1e30f; st[rg].l[j] = 0.f; }
    }
    rk = ld_row8(Pbat + OFF_KVC + 128, IWP, srow, SEQ, c8);
    rv = ld_row8(Pbat + OFF_KVC + 192, IWP, srow, SEQ, c8);
    st_k(KSB(0), srow, c8, rk);
    st_vt(VTB(0), srow, c8, rv);
    if (1 <= cur) {
      rk = ld_row8(Pbat + OFF_KVC + 128, IWP, 64 + srow, SEQ, c8);
      rv = ld_row8(Pbat + OFF_KVC + 192, IWP, 64 + srow, SEQ, c8);
    }
    __syncthreads();
    for (int jb = 0; jb <= cur; ++jb) {
      if (jb + 1 <= cur) { st_k(KSB(jb + 1), srow, c8, rk); st_vt(VTB(jb + 1), srow, c8, rv); }
      if (jb + 2 <= cur) {
        rk = ld_row8(Pbat + OFF_KVC + 128, IWP, (jb + 2) * 64 + srow, SEQ, c8);
        rv = ld_row8(Pbat + OFF_KVC + 192, IWP, (jb + 2) * 64 + srow, SEQ, c8);
      }
      bool sb[2] = {false, false};
      sb[0] = ((jb < 64 ? (slo[0] >> jb) : (shi[0] >> (jb - 64))) & 1ull) != 0;
      if (__any(sb[0])) attn_tile<M_SEL, 1>(Q, O, st, KSB(jb), VTB(jb), Pb, biasT, tq, 0, jb * 64, sb, hpd, lane);
      __syncthreads();
    }
#pragma unroll
    for (int rg = 0; rg < 1; ++rg) {
      const h16* gp = Pbat + (size_t)tq[rg] * IWP + OFF_GC;
#pragma unroll
      for (int j = 0; j < 4; ++j) {
        float ls = red16(st[rg].l[j]);
        float f = ls > 0.f ? (float)gp[j * 3 + 1] / ls : 0.f;
#pragma unroll
        for (int nt = 0; nt < 4; ++nt) Oc[rg][nt][j] += f * O[rg][nt][j];
      }
    }
#pragma unroll
    for (int rg = 0; rg < 1; ++rg) {
#pragma unroll
      for (int nt = 0; nt < 4; ++nt) O[rg][nt] = f32x4{0.f, 0.f, 0.f, 0.f};
#pragma unroll
      for (int j = 0; j < 4; ++j) { st[rg].m[j] = -1e30f; st[rg].l[j] = 0.f; }
    }
    const int w0 = cur >= 8 ? cur - 8 : 0;
    rk = ld_row8(Pbat + OFF_KVC + 256, IWP, w0 * 64 + srow, SEQ, c8);
    rv = ld_row8(Pbat + OFF_KVC + 320, IWP, w0 * 64 + srow, SEQ, c8);
    st_k(KSB(w0), srow, c8, rk);
    st_vt(VTB(w0), srow, c8, rv);
    if (w0 + 1 <= cur) {
      rk = ld_row8(Pbat + OFF_KVC + 256, IWP, (w0 + 1) * 64 + srow, SEQ, c8);
      rv = ld_row8(Pbat + OFF_KVC + 320, IWP, (w0 + 1) * 64 + srow, SEQ, c8);
    }
    __syncthreads();
    for (int wi = w0; wi <= cur; ++wi) {
      if (wi + 1 <= cur) { st_k(KSB(wi + 1), srow, c8, rk); st_vt(VTB(wi + 1), srow, c8, rv); }
      if (wi + 2 <= cur) {
        rk = ld_row8(Pbat + OFF_KVC + 256, IWP, (wi + 2) * 64 + srow, SEQ, c8);
        rv = ld_row8(Pbat + OFF_KVC + 320, IWP, (wi + 2) * 64 + srow, SEQ, c8);
      }
      attn_tile<M_WIN, 1>(Q, O, st, KSB(wi), VTB(wi), Pb, biasT, tq, 0, wi * 64, nosel, hpd, lane);
      __syncthreads();
    }
#pragma unroll
    for (int rg = 0; rg < 1; ++rg) {
      const h16* gp = Pbat + (size_t)tq[rg] * IWP + OFF_GC;
      float ss = 0.f;
#pragma unroll
      for (int j = 0; j < 4; ++j) {
        float ls = red16(st[rg].l[j]);
        float f = ls > 0.f ? (float)gp[j * 3 + 2] / ls : 0.f;
#pragma unroll
        for (int nt = 0; nt < 4; ++nt) {
          float v = Oc[rg][nt][j] + f * O[rg][nt][j];
          Oc[rg][nt][j] = v;
          ss += v * v;
        }
      }
      ss = red16(ss);
      float sc = rsqrtf(ss * (1.f / 256.f) + EPS);
#pragma unroll
      for (int j = 0; j < 4; ++j)
#pragma unroll
        for (int nt = 0; nt < 4; ++nt)
          OAC[((size_t)b * SEQ + tq[rg]) * 1024 + 256 + j * 64 + nt * 16 + col] = (h16)(Oc[rg][nt][j] * sc);
    }
  }
}

constexpr int LDS_SWA = LDS_BIAS + LDS_PB + 4 * 64 * KP * 2 + 1024;
constexpr int lds_max(int a, int b) { return a > b ? a : b; }
constexpr int LDS_BYTES = lds_max(lds_max(LDS_NSA, SSMY_LDS), lds_max(LDS_SWA, lds_max(LDS_GEMM, lds_max(LDS_CMP, 64 * 65 * 4))));

__global__ void __launch_bounds__(NT) fwd_megakernel(Params p) {
  cg::grid_group grid = cg::this_grid();
  __shared__ __attribute__((aligned(16))) char lds[LDS_BYTES];
  phase0(p, (float*)lds);
  grid.sync();
  phase0b(p);
  grid.sync();
  for (int l = 0; l < DEPTH; ++l) {
    phase_gemm1(p, l, lds);
    grid.sync();
    ssm_endstates(p, l);
    phase_compress(p, l, lds);
    phase_swa(p, l, lds);
    grid.sync();
    phase_nsa(p, l, lds);
    ssm_outputs(p, l, lds);
    grid.sync();
    phase_glu(p, l, lds);
    grid.sync();
    phase_wout(p, l, lds);
    grid.sync();
    phase_up(p, l, lds);
    grid.sync();
    phase_down(p, l, lds);
    grid.sync();
  }
}

extern "C" void kernel_launch(void* const* d_in, const int* in_sizes, int n_in, void* d_out, int out_size, void* d_ws,
                              size_t ws_size, hipStream_t stream) {
  static int grid_blocks = 0;
  if (!grid_blocks) {
    int dev = 0, cus = 0, per_cu = 0;
    (void)hipGetDevice(&dev);
    (void)hipDeviceGetAttribute(&cus, hipDeviceAttributeMultiprocessorCount, dev);
    (void)hipOccupancyMaxActiveBlocksPerMultiprocessor(&per_cu, fwd_megakernel, NT, 0);
    if (per_cu > 1) per_cu = 1;
    grid_blocks = cus * per_cu;
  }
  if (ws_size < WS_NEED) {
    fprintf(stderr, "workspace too small: %zu < %zu\n", ws_size, WS_NEED);
    return;
  }
  Params p{};
  for (int i = 0; i < 24; ++i) p.in[i] = (const float*)d_in[i];
  p.out = (float*)d_out;
  p.ws = (char*)d_ws;
  void* args[] = {&p};
  hipError_t e = hipLaunchCooperativeKernel((void*)fwd_megakernel, dim3(grid_blocks), dim3(NT), args, 0, stream);
  if (e != hipSuccess) fprintf(stderr, "cooperative launch failed: %s (grid %d)\n", hipGetErrorString(e), grid_blocks);
}
```

```cpp
#include <hip/hip_runtime.h>
#include <hip/hip_cooperative_groups.h>
#include <cstdio>
namespace cg = cooperative_groups;

typedef _Float16 h16;
typedef __attribute__((ext_vector_type(8))) _Float16 h16x8;
typedef __attribute__((ext_vector_type(4))) float f32x4;

constexpr int NT = 512;
constexpr int NW = NT / 64;
constexpr int BATCH = 4, SEQ = 8192, NTOK = BATCH * SEQ, DM = 1024, DEPTH = 4, IW = 1676, IWP = 1792, DFF = 4096;
constexpr int OFF_U = 512, OFF_QC = 1024, OFF_KVC = 1280, OFF_GC = 1664;
constexpr int NCMP = 511;
constexpr float EPS = 1e-6f;

constexpr size_t SZ_WIN = (size_t)IWP * DM * 2, SZ_WGLU = (size_t)1024 * 512 * 2, SZ_WOUT = (size_t)DM * DM * 2,
                 SZ_WUP = (size_t)DFF * DM * 2, SZ_WDN = (size_t)DM * DFF * 2;
constexpr size_t O_WIN = 0;
constexpr size_t O_WGLU = O_WIN + DEPTH * SZ_WIN;
constexpr size_t O_WOUT = O_WGLU + DEPTH * SZ_WGLU;
constexpr size_t O_WUP = O_WOUT + DEPTH * SZ_WOUT;
constexpr size_t O_WDN = O_WUP + DEPTH * SZ_WUP;
constexpr size_t O_XB = O_WDN + DEPTH * SZ_WDN;
constexpr size_t O_SSQ = O_XB + (size_t)NTOK * DM * 2;
constexpr size_t O_SSQB = O_SSQ + (size_t)NTOK * 16 * 4;
constexpr size_t O_KCMP = O_SSQB + (size_t)NTOK * 16 * 4;
constexpr size_t O_VCMP = O_KCMP + (size_t)BATCH * 512 * 64 * 4;
constexpr size_t O_ABAR = O_VCMP + (size_t)BATCH * 512 * 64 * 4;
constexpr size_t O_BBAR = O_ABAR + (size_t)DEPTH * 32 * 64 * 8;
constexpr size_t O_BIAS1 = O_BBAR + (size_t)DEPTH * 32 * 64 * 16 * 8;
constexpr size_t O_LUT = O_BIAS1 + (size_t)DEPTH * 2 * 128 * 4;
constexpr size_t O_AT = O_LUT + 8192 * 4;
constexpr size_t O_KTAB = O_AT + (size_t)128 * 64 * 8;
constexpr size_t SZ_KTAB = (size_t)65 * 256 * 2;
constexpr size_t O_W1 = O_KTAB + 128 * SZ_KTAB;
constexpr size_t SZ_W13 = (size_t)128 * 1024 * 2;
constexpr size_t O_W3 = O_W1 + 128 * SZ_W13;
constexpr size_t O_W1T = O_W3 + 128 * SZ_W13;
constexpr size_t O_W2T = O_W1T + (size_t)8 * 128 * 2048 * 2;
constexpr size_t O_B1P = O_W2T + (size_t)8 * 64 * 128 * 2;
constexpr size_t O_BAR = (O_B1P + (size_t)8 * 32 * 128 * 4 + 255) / 256 * 256;
constexpr size_t SZ_BAR = 3456 * 4;
constexpr size_t O_BIG = (O_BAR + SZ_BAR + 255) / 256 * 256;
constexpr size_t O_APOW = O_BIG;
constexpr size_t O_P = O_BIG;
constexpr size_t O_Z = O_P + (size_t)NTOK * IWP * 2;
constexpr size_t O_OB = O_Z + (size_t)NTOK * 512 * 2;
constexpr size_t O_OAC = O_OB + (size_t)512 * 2;
constexpr size_t O_E = O_OB + (size_t)NTOK * 1024 * 2;
constexpr size_t O_HID = O_BIG;
constexpr size_t WS_NEED = O_BIG + (size_t)NTOK * DFF * 2;

struct Params {
  const float* in[24];
  float* out;
  char* ws;
};

__device__ __forceinline__ int opaque_tid() {
  int t = threadIdx.x;
  asm volatile("" : "+v"(t));
  return t;
}
template <int CTRL>
__device__ __forceinline__ float dppf(float v) {
  return __int_as_float(__builtin_amdgcn_update_dpp(0, __float_as_int(v), CTRL, 0xF, 0xF, true));
}
__device__ __forceinline__ float sum16(float v) {
  v += dppf<0xB1>(v); v += dppf<0x4E>(v); v += dppf<0x141>(v); v += dppf<0x140>(v);
  return v;
}
__device__ __forceinline__ float max16(float v) {
  v = fmaxf(v, dppf<0xB1>(v)); v = fmaxf(v, dppf<0x4E>(v)); v = fmaxf(v, dppf<0x141>(v)); v = fmaxf(v, dppf<0x140>(v));
  return v;
}
__device__ __forceinline__ float xor16(float v) { return __int_as_float(__builtin_amdgcn_ds_swizzle(__float_as_int(v), 0x401F)); }
__device__ __forceinline__ float rdlane_c(float v, int l) { return __int_as_float(__builtin_amdgcn_readlane(__float_as_int(v), l)); }
__device__ __forceinline__ float wave_sum(float v) {
  v = sum16(v); v += xor16(v);
  return rdlane_c(v, 0) + rdlane_c(v, 32);
}
__device__ __forceinline__ float gelu_tanh(float x) {
  float u = 0.7978845608028654f * (x + 0.044715f * x * x * x);
  return 0.5f * x * (1.f + tanhf(u));
}
__device__ __forceinline__ float sigmoidf(float x) { return 1.f / (1.f + __expf(-x)); }
__device__ __forceinline__ float rdlane(float v, int l) {
  return __int_as_float(__builtin_amdgcn_readlane(__float_as_int(v), l));
}

template <class SrcF>
__device__ __forceinline__ void conv_tile(SrcF src, h16* dst, int ldo, int n0, int k0, float* tile) {
  int tid = opaque_tid();
  for (int idx = tid; idx < 4096; idx += NT) {
    int kk = idx >> 6, nn = idx & 63;
    tile[kk * 65 + nn] = src(k0 + kk, n0 + nn);
  }
  __syncthreads();
  for (int idx = tid; idx < 4096; idx += NT) {
    int nn = idx >> 6, kk = idx & 63;
    dst[(long)(n0 + nn) * ldo + k0 + kk] = (h16)tile[kk * 65 + nn];
  }
  __syncthreads();
}

__device__ void phase0(const Params& p, float* lds) {
  const int tid = opaque_tid();
  constexpr int T_IN = (IWP / 64) * (DM / 64);
  constexpr int T_GLU = 16 * 8;
  constexpr int T_OUT = 16 * 16;
  constexpr int T_UP = 64 * 16;
  constexpr int T_DN = 16 * 64;
  constexpr int T_L = T_IN + T_GLU + T_OUT + T_UP + T_DN;
  for (int ti = blockIdx.x; ti < DEPTH * T_L; ti += gridDim.x) {
    int l = ti / T_L, r = ti % T_L;
    if (r < T_IN) {
      int nt = r / 16, kt = r % 16;
      const float* w = p.in[2] + (size_t)l * DM * IW;
      const float* g = p.in[1] + l * DM;
      conv_tile([&](int k, int sl) {
        int n = (sl & ~255) + 64 * ((sl >> 5) & 3) + 32 * ((sl >> 7) & 1) + (sl & 31);
        return n < IW ? w[(long)k * IW + n] * g[k] : 0.f; },
                (h16*)(p.ws + O_WIN + l * SZ_WIN), DM, nt * 64, kt * 64, lds);
    } else if ((r -= T_IN) < T_GLU) {
      int nt = r / 8, kt = r % 8;
      const float* w = p.in[14] + (size_t)l * 512 * 1024;
      conv_tile([&](int k, int n2) {
        int pn = n2 >> 8, bj = (n2 >> 7) & 1, wc = (n2 >> 5) & 3, nn = (n2 >> 4) & 1, r = n2 & 15;
        int n = (nn ? 512 : 0) + 128 * pn + 64 * bj + 16 * wc + r;
        return w[(long)k * 1024 + n]; },
                (h16*)(p.ws + O_WGLU + l * SZ_WGLU), 512, nt * 64, kt * 64, lds);
    } else if ((r -= T_GLU) < T_OUT) {
      int nt = r / 16, kt = r % 16;
      const float* w = p.in[20] + (size_t)l * DM * DM;
      const float* g = p.in[19] + l * DM;
      conv_tile([&](int k2, int n) {
        int k = k2 < 512 ? 256 + k2 : (k2 < 768 ? k2 - 512 : k2);
        return w[(long)k * DM + n] * g[k]; },
                (h16*)(p.ws + O_WOUT + l * SZ_WOUT), DM, nt * 64, kt * 64, lds);
    } else if ((r -= T_OUT) < T_UP) {
      int nt = r / 16, kt = r % 16;
      const float* w = p.in[22] + (size_t)l * DM * DFF;
      const float* g = p.in[21] + l * DM;
      conv_tile([&](int k, int n) { return w[(long)k * DFF + n] * g[k]; },
                (h16*)(p.ws + O_WUP + l * SZ_WUP), DM, nt * 64, kt * 64, lds);
    } else {
      r -= T_UP;
      int nt = r / 64, kt = r % 64;
      const float* w = p.in[23] + (size_t)l * DFF * DM;
      conv_tile([&](int k, int n) { return w[(long)k * DM + n]; },
                (h16*)(p.ws + O_WDN + l * SZ_WDN), DFF, nt * 64, kt * 64, lds);
    }
  }
  for (int ti = blockIdx.x; ti < 8 * 66; ti += gridDim.x) {
    int ls = ti / 66, r = ti % 66;
    if (r < 64) {
      int nt = r >> 5, kt = r & 31;
      const float* w = p.in[17] + (size_t)ls * 2048 * 128;
      conv_tile([&](int k, int n) { return w[(long)k * 128 + n]; }, (h16*)(p.ws + O_W1T) + (size_t)ls * 128 * 2048, 2048, nt * 64, kt * 64, lds);
    } else {
      int kt = r - 64;
      const float* w = p.in[18] + (size_t)ls * 128 * 64;
      conv_tile([&](int k, int n) { return w[(long)k * 64 + n]; }, (h16*)(p.ws + O_W2T) + (size_t)ls * 64 * 128, 128, 0, kt * 64, lds);
    }
  }
  {
    const int lane = tid & 63;
    const int gw = blockIdx.x * NW + (tid >> 6), nw = gridDim.x * NW;
    const float* x = p.in[0];
    h16* xb = (h16*)(p.ws + O_XB);
    float* ssq = (float*)(p.ws + O_SSQ);
    for (int row = gw; row < NTOK; row += nw) {
      const float4* xr = (const float4*)(x + (long)row * DM + lane * 16);
      float s = 0.f;
      h16 hv[16];
      for (int i = 0; i < 4; ++i) {
        float4 v = xr[i];
        s += v.x * v.x + v.y * v.y + v.z * v.z + v.w * v.w;
        hv[i * 4 + 0] = (h16)v.x; hv[i * 4 + 1] = (h16)v.y; hv[i * 4 + 2] = (h16)v.z; hv[i * 4 + 3] = (h16)v.w;
      }
      h16x8* xo = (h16x8*)(xb + (long)row * DM + lane * 16);
      h16x8 o0, o1;
      for (int i = 0; i < 8; ++i) { o0[i] = hv[i]; o1[i] = hv[8 + i]; }
      xo[0] = o0; xo[1] = o1;
      s += dppf<0xB1>(s);
      s += dppf<0x4E>(s);
      if ((lane & 3) == 0) ssq[(long)row * 16 + (lane >> 2)] = s;
    }
  }
  const int gt = blockIdx.x * NT + tid, ngt = gridDim.x * NT;
  for (int i = gt; i < DEPTH * 32 * 64; i += ngt) {
    int l = i / 2048, g = (i / 64) % 32;
    double are = p.in[6][i], aim = p.in[7][i];
    double dt = exp((double)p.in[8][l * 32 + g]);
    double er = exp(are * dt), abr = er * cos(aim * dt), abi = er * sin(aim * dt);
    ((float2*)(p.ws + O_ABAR))[i] = make_float2((float)abr, (float)abi);
    double nr = abr - 1.0, ni = abi, den = are * are + aim * aim;
    double fr = (nr * are + ni * aim) / den, fi = (ni * are - nr * aim) / den;
    float2* bb = (float2*)(p.ws + O_BBAR) + (size_t)i * 16;
    for (int q = 0; q < 16; ++q) {
      double br = p.in[9][(size_t)i * 16 + q], bi = p.in[10][(size_t)i * 16 + q];
      bb[q] = make_float2((float)((fr * br - fi * bi) / dt), (float)((fr * bi + fi * br) / dt));
    }
  }
  for (int i = gt; i < 128 * 65 * 64; i += ngt) {
    int n = i & 63, j = (i >> 6) % 65, lg = i / (65 * 64);
    double are = p.in[6][lg * 64 + n], aim = p.in[7][lg * 64 + n];
    double dt = exp((double)p.in[8][lg]);
    double er = exp(are * dt * j), ang = aim * dt * j;
    ((double2*)(p.ws + O_APOW))[i] = make_double2(er * cos(ang), er * sin(ang));
  }
  for (int i = gt; i < DEPTH * 2 * 128 * 32; i += ngt) {
    int j = i & 127, kc = (i >> 7) & 31, ls = i >> 12;
    const float* pos = p.in[16] + (size_t)ls * 2048 + kc * 64;
    const float* w1 = p.in[17] + ((size_t)ls * 2048 + kc * 64) * 128;
    float a = 0.f;
#pragma unroll 16
    for (int k = 0; k < 64; ++k) a += pos[k] * w1[(long)k * 128 + j];
    ((float*)(p.ws + O_B1P))[i] = a;
  }
  for (int d = gt; d < 8192; d += ngt) {
    int bk;
    if (d < 16) bk = d;
    else {
      float nf = (float)d;
      int large = 16 + (int)(logf(nf / 16.0f) / 4.1588830833596715f * 16.0f);
      bk = large < 31 ? large : 31;
    }
    ((int*)(p.ws + O_LUT))[d] = bk;
  }
}

__device__ void phase0b(const Params& p) {
  const int gt = blockIdx.x * NT + threadIdx.x, ngt = gridDim.x * NT;
  const double2* apow = (const double2*)(p.ws + O_APOW);
  const float2* bbs = (const float2*)(p.ws + O_BBAR);
  for (int i = gt; i < 128 * 64 * 64; i += ngt) {
    int tau = i & 63, n = (i >> 6) & 63, lg = i >> 12;
    double2 ap = apow[(lg * 65 + (63 - tau)) * 64 + n];
    const float2* bb = bbs + (size_t)(lg * 64 + n) * 16;
    h16x8 re0, re1, im0, im1;
#pragma unroll
    for (int q = 0; q < 8; ++q) {
      float2 b0 = bb[q], b1 = bb[8 + q];
      re0[q] = (h16)(float)(ap.x * b0.x - ap.y * b0.y);
      im0[q] = (h16)(float)(ap.x * b0.y + ap.y * b0.x);
      re1[q] = (h16)(float)(ap.x * b1.x - ap.y * b1.y);
      im1[q] = (h16)(float)(ap.x * b1.y + ap.y * b1.x);
    }
    h16* W1 = (h16*)(p.ws + O_W1 + (size_t)lg * SZ_W13);
    *(h16x8*)(W1 + ((size_t)(2 * tau) * 128 + 2 * n) * 8) = re0;
    *(h16x8*)(W1 + ((size_t)(2 * tau) * 128 + 2 * n + 1) * 8) = im0;
    *(h16x8*)(W1 + ((size_t)(2 * tau + 1) * 128 + 2 * n) * 8) = re1;
    *(h16x8*)(W1 + ((size_t)(2 * tau + 1) * 128 + 2 * n + 1) * 8) = im1;
  }
  for (int i = gt; i < 128 * 64 * 16 * 16; i += ngt) {
    int pp = i & 15, kc = (i >> 4) & 15, tau = (i >> 8) & 63, lg = i >> 14;
    h16x8 v;
#pragma unroll
    for (int e = 0; e < 4; ++e) {
      int n = 4 * kc + e;
      double2 ap = apow[(lg * 65 + tau + 1) * 64 + n];
      double cr = p.in[11][((size_t)lg * 16 + pp) * 64 + n], ci = p.in[12][((size_t)lg * 16 + pp) * 64 + n];
      v[2 * e] = (h16)(float)(cr * ap.x - ci * ap.y);
      v[2 * e + 1] = (h16)(float)(-(cr * ap.y + ci * ap.x));
    }
    h16* W3 = (h16*)(p.ws + O_W3 + (size_t)lg * SZ_W13);
    *(h16x8*)(W3 + ((size_t)((tau * 16 + kc) * 16) + pp) * 8) = v;
  }
  for (int i = gt; i < 128 * 65 * 16; i += ngt) {
    int pp = i & 15, slot = (i >> 4) % 65, lg = i / (65 * 16);
    float acc[16];
#pragma unroll
    for (int q = 0; q < 16; ++q) acc[q] = 0.f;
    if (slot > 0) {
      for (int n = 0; n < 64; ++n) {
        double2 ap = apow[(lg * 65 + slot - 1) * 64 + n];
        double cr = p.in[11][((size_t)lg * 16 + pp) * 64 + n], ci = p.in[12][((size_t)lg * 16 + pp) * 64 + n];
        float xr = (float)(cr * ap.x - ci * ap.y), xi = (float)(cr * ap.y + ci * ap.x);
        const float2* bb = bbs + (size_t)(lg * 64 + n) * 16;
#pragma unroll
        for (int q = 0; q < 16; ++q) { float2 b = bb[q]; acc[q] += xr * b.x - xi * b.y; }
      }
    }
    h16x8 v0, v1;
#pragma unroll
    for (int q = 0; q < 8; ++q) { v0[q] = (h16)acc[q]; v1[q] = (h16)acc[8 + q]; }
    h16* kt = (h16*)(p.ws + O_KTAB + (size_t)lg * SZ_KTAB) + slot * 256 + pp * 16;
    *(h16x8*)kt = v0;
    *(h16x8*)(kt + 8) = v1;
  }
  for (int i = gt; i < 128 * 64; i += ngt) {
    double2 ap = apow[((i >> 6) * 65 + 64) * 64 + (i & 63)];
    ((float2*)(p.ws + O_AT))[i] = make_float2((float)ap.x, (float)ap.y);
  }
  for (int i = gt; i < DEPTH * 2 * 128; i += ngt) {
    const float* pp = (const float*)(p.ws + O_B1P) + (size_t)(i >> 7) * 32 * 128 + (i & 127);
    float a = 0.f;
    for (int kc = 0; kc < 32; ++kc) a += pp[kc * 128];
    ((float*)(p.ws + O_BIAS1))[i] = a;
  }
}

__device__ void ssm_endstates(const Params& p, int l) {
  const int tid = opaque_tid(), lane = tid & 63, w = tid >> 6;
  const int gw = blockIdx.x * NW + w, nw = gridDim.x * NW;
  const h16* P = (const h16*)(p.ws + O_P);
  float* E = (float*)(p.ws + O_E);
  for (int unit = gw; unit < 32 * 32; unit += nw) {
    int g = unit >> 5, ctile = unit & 31;
    const h16* W1 = (const h16*)(p.ws + O_W1 + (size_t)(l * 32 + g) * SZ_W13);
    int gch = ctile * 16 + (lane & 15);
    const h16* ub = P + (size_t)gch * 64 * IWP + OFF_U + g * 16 + ((lane >> 4) & 1) * 8 + (size_t)(lane >> 5) * IWP;
    f32x4 acc[8];
#pragma unroll
    for (int mt = 0; mt < 8; ++mt) acc[mt] = f32x4{0.f, 0.f, 0.f, 0.f};
#pragma unroll 2
    for (int ks = 0; ks < 32; ++ks) {
      h16x8 B = *(const h16x8*)(ub + (size_t)(ks * 2) * IWP);
#pragma unroll
      for (int mt = 0; mt < 8; ++mt) {
        h16x8 A = *(const h16x8*)(W1 + ((size_t)(ks * 4 + (lane >> 4)) * 128 + mt * 16 + (lane & 15)) * 8);
        acc[mt] = __builtin_amdgcn_mfma_f32_16x16x32_f16(A, B, acc[mt], 0, 0, 0);
      }
    }
#pragma unroll
    for (int mt = 0; mt < 8; ++mt)
      *(f32x4*)(E + ((size_t)gch * 32 + g) * 128 + mt * 16 + (lane >> 4) * 4) = acc[mt];
  }
}

constexpr int BU_PITCH = 1032, BS_PITCH = 136;
constexpr int SSMY_LDS = 65 * 512 + 16 * BU_PITCH * 2 + 16 * BS_PITCH * 2;
__device__ void ssm_outputs(const Params& p, int l, char* lds) {
  const int tid = opaque_tid(), lane = tid & 63, w = tid >> 6;
  h16* Kt = (h16*)lds;
  h16* Bu = (h16*)(lds + 65 * 512);
  h16* Bs = (h16*)(lds + 65 * 512 + 16 * BU_PITCH * 2);
  const h16* P = (const h16*)(p.ws + O_P);
  const float* E = (const float*)(p.ws + O_E);
  h16* Z = (h16*)(p.ws + O_Z);
  for (int unit = blockIdx.x; unit < 1024; unit += gridDim.x) {
    const int g = unit & 31, bc = unit >> 5, b = bc >> 3, ct = bc & 7;
    const int lg = l * 32 + g;
    __syncthreads();
    if (w == 0) {
      float2 at = ((const float2*)(p.ws + O_AT))[lg * 64 + lane];
      const float2* Eb = (const float2*)E + ((size_t)(b * 128) * 32 + g) * 64 + lane;
      float sr = 0.f, si = 0.f;
      const int c0 = ct * 16;
#pragma unroll 8
      for (int c = 0; c < c0; ++c) {
        float2 e = Eb[(size_t)c * 2048];
        float nr = at.x * sr - at.y * si + e.x, ni = at.x * si + at.y * sr + e.y;
        sr = nr; si = ni;
      }
#pragma unroll
      for (int i = 0; i < 16; ++i) {
        Bs[i * BS_PITCH + 2 * lane] = (h16)sr;
        Bs[i * BS_PITCH + 2 * lane + 1] = (h16)si;
        float2 e = Eb[(size_t)(c0 + i) * 2048];
        float nr = at.x * sr - at.y * si + e.x, ni = at.x * si + at.y * sr + e.y;
        sr = nr; si = ni;
      }
    } else {
      const int t2 = tid - 64, n2 = NT - 64;
      const h16x8* ks = (const h16x8*)(p.ws + O_KTAB + (size_t)lg * SZ_KTAB);
      for (int i = t2; i < 65 * 32; i += n2) ((h16x8*)Kt)[i] = ks[i];
      for (int i = t2; i < 2048; i += n2) {
        int tk = i >> 1, hf = i & 1;
        h16x8 v = *(const h16x8*)(P + ((size_t)b * SEQ + ct * 1024 + tk) * IWP + OFF_U + g * 16 + hf * 8);
        *(h16x8*)(Bu + (tk >> 6) * BU_PITCH + (tk & 63) * 16 + hf * 8) = v;
      }
    }
    __syncthreads();
    const float dt = expf(p.in[8][lg]);
    const int col = lane & 15, hi = lane >> 5, qh = (lane >> 4) & 1, p0 = (lane >> 4) * 4;
    const h16* W3 = (const h16*)(p.ws + O_W3 + (size_t)lg * SZ_W13);
    float dsk[4];
    for (int j = 0; j < 4; ++j) dsk[j] = p.in[13][l * 512 + g * 16 + p0 + j];
    for (int r = 0; r < 64 / NW; ++r) {
      const int base = (r >> 1) * 2 * NW;
      const int tau = (r & 1) ? base + 2 * NW - 1 - w : base + w;
      f32x4 acc = {0.f, 0.f, 0.f, 0.f};
      const int nks = tau / 2 + 1;
      h16x8 A3[4];
#pragma unroll
      for (int ks = 0; ks < 4; ++ks)
        A3[ks] = *(const h16x8*)(W3 + ((size_t)((tau * 16 + ks * 4 + (lane >> 4)) * 16) + (lane & 15)) * 8);
      for (int i = 0; i < nks; ++i) {
        int j = tau - (2 * i + hi);
        h16x8 A = *(const h16x8*)(Kt + (j + 1) * 256 + (lane & 15) * 16 + qh * 8);
        h16x8 B = *(const h16x8*)(Bu + col * BU_PITCH + (2 * i + hi) * 16 + qh * 8);
        acc = __builtin_amdgcn_mfma_f32_16x16x32_f16(A, B, acc, 0, 0, 0);
      }
#pragma unroll
      for (int ks = 0; ks < 4; ++ks) {
        h16x8 B = *(const h16x8*)(Bs + col * BS_PITCH + ks * 32 + (lane >> 4) * 8);
        acc = __builtin_amdgcn_mfma_f32_16x16x32_f16(A3[ks], B, acc, 0, 0, 0);
      }
      const h16* up = Bu + col * BU_PITCH + tau * 16 + p0;
      size_t tok = ((size_t)b * 128 + ct * 16 + col) * 64 + tau;
      h16 zz[4];
      for (int j = 0; j < 4; ++j) zz[j] = (h16)gelu_tanh(dt * acc[j] + dsk[j] * (float)up[j]);
      typedef __attribute__((ext_vector_type(4))) _Float16 h16x4;
      h16x4 zv = {zz[0], zz[1], zz[2], zz[3]};
      *(h16x4*)(Z + tok * 512 + g * 16 + p0) = zv;
    }
  }
}

#define LAS __attribute__((address_space(3)))
typedef _Float16 h16x4 __attribute__((ext_vector_type(4)));
#define XB_TMO      128
#define XB_XCNT(j)  (256  + 64 * (j))
#define XB_XSUB(j)  (1280 + 64 * (j))
#define XB_XGEN(j)  (2304 + 64 * (j))
#define XB_TOP      3328
#define XB_TOPGEN   3392
#define XCD_BAR_WORDS 3456
#define XB_SPIN_CAP (1u << 18)

__device__ __forceinline__ unsigned xb_ld(unsigned* p)              { return __hip_atomic_load(p, __ATOMIC_RELAXED, __HIP_MEMORY_SCOPE_AGENT); }
__device__ __forceinline__ unsigned xb_add(unsigned* p, unsigned v) { return __hip_atomic_fetch_add(p, v, __ATOMIC_RELAXED, __HIP_MEMORY_SCOPE_AGENT); }
__device__ __forceinline__ unsigned xb_xcc_id() { return (unsigned)__builtin_amdgcn_s_getreg((3 << 11) | 20) & 0xFu; }
#define XB_SPIN(cond, bar) do { unsigned _sp = 0; while (cond) { __builtin_amdgcn_s_sleep(1); \
    if ((++_sp & 255u) == 0u) { if (xb_ld(&(bar)[XB_TMO])) break; if (_sp > XB_SPIN_CAP) { atomicAdd(&(bar)[XB_TMO], 1u); break; } } } } while (0)

struct XcdBarrier {
    unsigned* bar; unsigned x;
    volatile LAS unsigned* st;
};

__device__ __forceinline__ XcdBarrier xcd_barrier_post(unsigned* bar, volatile LAS unsigned* st) {
    XcdBarrier b; b.bar = bar; b.x = xb_xcc_id(); b.st = st;
    if (threadIdx.x == 0) (void)xb_add(&bar[XB_XCNT(b.x)], 1u);
    return b;
}
__device__ __forceinline__ void xcd_barrier_complete(unsigned* bar, unsigned x, unsigned& nloc, unsigned& nx) {
    const unsigned G = gridDim.x * gridDim.y * gridDim.z;
    unsigned sum, cnt, mine, sp = 0u;
    for (;;) {
        sum = 0u; cnt = 0u; mine = 0u;
#pragma unroll
        for (unsigned j = 0; j < 16; ++j) { const unsigned c = xb_ld(&bar[XB_XCNT(j)]); sum += c; cnt += (c > 0u) ? 1u : 0u; mine = (j == x) ? c : mine; }
        if (sum == G) break;
        __builtin_amdgcn_s_sleep(1);
        if ((++sp & 255u) == 0u) { if (xb_ld(&bar[XB_TMO])) break; if (sp > XB_SPIN_CAP) { atomicAdd(&bar[XB_TMO], 1u); break; } }
    }
    nloc = mine > 0u ? mine : 1u; nx = cnt > 0u ? cnt : 1u;
}

__device__ __forceinline__ void xcd_barrier(const XcdBarrier& b) {
    asm volatile("s_waitcnt vmcnt(0)" ::: "memory");
    __syncthreads();
    if (threadIdx.x == 0) {
        unsigned* bar = b.bar;
        __builtin_amdgcn_s_waitcnt(0);
        unsigned nloc = b.st[0], nx = b.st[1];
        if (nloc == 0u) { xcd_barrier_complete(bar, b.x, nloc, nx); b.st[0] = nloc; b.st[1] = nx; }
        const unsigned old = xb_add(&bar[XB_XSUB(b.x)], 1u);
        const unsigned gen = old / nloc;
        if (old + 1u == (gen + 1u) * nloc) {
            __builtin_amdgcn_fence(__ATOMIC_RELEASE, "agent");
            asm volatile("s_waitcnt vmcnt(0)" ::: "memory");
            const unsigned og = xb_add(&bar[XB_TOP], 1u);
            const unsigned tg = og / nx;
            if (og + 1u == (tg + 1u) * nx) xb_add(&bar[XB_TOPGEN], 1u);
            else XB_SPIN(xb_ld(&bar[XB_TOPGEN]) == tg, bar);
            __builtin_amdgcn_fence(__ATOMIC_ACQUIRE, "agent");
            xb_add(&bar[XB_XGEN(b.x)], 1u);
            asm volatile("s_waitcnt vmcnt(0)" ::: "memory");
        } else {
            XB_SPIN(xb_ld(&bar[XB_XGEN(b.x)]) == gen, bar);
            __builtin_amdgcn_fence(__ATOMIC_ACQUIRE, "agent");
            asm volatile("s_waitcnt vmcnt(0)" ::: "memory");
        }
    }
    __syncthreads();
}


namespace g8 {
constexpr int BM = 256, BK = 64, HALF = 128, HTB = HALF * BK * 2, STAGE_BYTES = 8 * HTB, NXCD = 8, WGM = 8;
__device__ __forceinline__ int lds_byte(int r, int c) {
  const int st = (r >> 4) * 2 + (c >> 5), rr = r & 15, cc = c & 31, ob = rr * 64 + cc * 2;
  return st * 1024 + (ob ^ (((ob >> 9) & 1) << 5));
}
__device__ __forceinline__ void stage_rc(int b, int& R, int& C) {
  const int st = b / 1024, sb = b % 1024, swz = sb ^ (((sb >> 9) & 1) << 5);
  R = (st >> 1) * 16 + swz / 64;
  C = (st & 1) * 32 + (swz % 64) / 2;
}
struct Unit { int pm, pn; };
struct Order {
  int nM, nN, nwg, G, c;
  __device__ void init(int M, int N, int G_, int c_) { nM = M / BM; nN = N / BM; nwg = nM * nN; G = G_; c = c_; }
  __device__ bool next(int i, Unit& u) const {
    const long L = (long)i * G + c;
    if (L >= nwg) return false;
    int wgid = (int)L;
    { const int q = nwg / NXCD, r = nwg % NXCD, xcd = wgid % NXCD, off = wgid / NXCD; wgid = (xcd < r ? xcd * (q + 1) : r * (q + 1) + (xcd - r) * q) + off; }
    const int nig = WGM * nN, gid = wgid / nig, fm = gid * WGM, gsz = (nM - fm) < WGM ? (nM - fm) : WGM;
    u.pm = fm + ((wgid % nig) % gsz);
    u.pn = (wgid % nig) / gsz;
    return true;
  }
};
template <class Epi>
__device__ __forceinline__ void gemm_phase(LAS unsigned char* lds, const h16* A, const h16* Bt, int K, const Order& S, const Epi& E) {
  const int tid = opaque_tid(), wid = __builtin_amdgcn_readfirstlane(tid >> 6), lane = tid & 63, wr = wid >> 2, wc = wid & 3, fr = lane & 15, fq = lane >> 4;
  const int nt = K / BK;
  unsigned voffA[2];
#pragma unroll
  for (int i = 0; i < 2; ++i) { int R, C; stage_rc(tid * 16 + i * 8192, R, C); voffA[i] = (unsigned)(R * K + C) * 2u; }
  const size_t kstep = (size_t)(BK * 2);
  const size_t hstep = (size_t)HALF * K * 2;
  const size_t tstep = 2 * hstep;
  const unsigned ldsw = (unsigned)wid * 1024u;
  const int aoff = lds_byte(wr * 64 + fr, fq * 8), boff = lds_byte(wc * 32 + fr, fq * 8);
#define G8_SA(b, h) (((b) * 2 + (h)) * HTB)
#define G8_SB(b, h) ((4 + (b) * 2 + (h)) * HTB)
#define G8_STAGE(bufoff, gbase) do { _Pragma("unroll") for (int _i = 0; _i < 2; ++_i) \
    __builtin_amdgcn_global_load_lds((const unsigned*)((const char*)(gbase) + voffA[_i]), (LAS unsigned*)(lds + (bufoff) + ldsw + _i * 8192), 16, 0, 0); } while (0)
#define G8_LDA(dst, b, h) do { _Pragma("unroll") for (int m = 0; m < 4; ++m) _Pragma("unroll") for (int k = 0; k < 2; ++k) dst[m][k] = *(const LAS h16x8*)(lds + G8_SA(b, h) + aoff + m * 2048 + k * 1024); } while (0)
#define G8_LDB(dst, b, h) do { _Pragma("unroll") for (int n = 0; n < 2; ++n) _Pragma("unroll") for (int k = 0; k < 2; ++k) dst[n][k] = *(const LAS h16x8*)(lds + G8_SB(b, h) + boff + n * 2048 + k * 1024); } while (0)
#define G8_MMA(ai, bj, At, Bt_) do { __builtin_amdgcn_s_setprio(1); _Pragma("unroll") for (int m = 0; m < 4; ++m) _Pragma("unroll") for (int n = 0; n < 2; ++n) _Pragma("unroll") for (int k = 0; k < 2; ++k) \
    acc[ai][bj][m][n] = __builtin_amdgcn_mfma_f32_16x16x32_f16(Bt_[n][k], At[m][k], acc[ai][bj][m][n], 0, 0, 0); __builtin_amdgcn_s_setprio(0); } while (0)
#define G8_WAIT_V(n) asm volatile("s_waitcnt vmcnt(" #n ")" ::: "memory")
#define G8_WAIT_L(n) asm volatile("s_waitcnt lgkmcnt(" #n ")" ::: "memory")
#define G8_BAR __builtin_amdgcn_s_barrier()
#define G8_SCHED __builtin_amdgcn_sched_barrier(0)
  Unit cur, nxt;
  int ui = 0;
  if (!S.next(0, cur)) return;
  f32x4 acc[2][2][4][2];
#pragma unroll
  for (int a = 0; a < 2; ++a)
#pragma unroll
    for (int b = 0; b < 2; ++b)
#pragma unroll
      for (int m = 0; m < 4; ++m)
#pragma unroll
        for (int n = 0; n < 2; ++n) acc[a][b][m][n] = (f32x4){0.f, 0.f, 0.f, 0.f};
  h16x8 At[4][2], B0[2][2], B1[2][2];
  const char* cA = (const char*)A + (size_t)cur.pm * tstep;
  const char* cB = (const char*)Bt + (size_t)cur.pn * tstep;
  G8_STAGE(G8_SB(0, 0), cB); G8_STAGE(G8_SA(0, 0), cA); G8_STAGE(G8_SB(0, 1), cB + hstep); G8_STAGE(G8_SA(0, 1), cA + hstep);
  if (wr == 1) G8_BAR;
  G8_WAIT_V(4); G8_BAR;
  G8_STAGE(G8_SB(1, 0), cB + kstep); G8_STAGE(G8_SA(1, 0), cA + kstep); G8_STAGE(G8_SB(1, 1), cB + hstep + kstep);
  G8_WAIT_V(6); G8_BAR;
  for (;;) {
    const bool has_next = S.next(ui + 1, nxt);
    const char* nA = has_next ? (const char*)A + (size_t)nxt.pm * tstep : cA;
    const char* nB = has_next ? (const char*)Bt + (size_t)nxt.pn * tstep : cB;
    for (int t = 0; t < nt; t += 2) {
      const bool last = (t == nt - 2);
      const char* a1 = cA + (size_t)(t + 1) * kstep;
      const char* a2 = last ? nA : cA + (size_t)(t + 2) * kstep;
      const char* b2 = last ? nB : cB + (size_t)(t + 2) * kstep;
      const char* a3 = a2 + kstep;
      const char* b3 = b2 + kstep;
      if (Epi::MID_T >= 0 && t == Epi::MID_T) E.mid(acc, ui, wr, fr);
      G8_LDB(B0, 0, 0); G8_SCHED; G8_LDA(At, 0, 0); G8_STAGE(G8_SA(1, 1), a1 + hstep);
      G8_WAIT_L(8); G8_BAR; G8_WAIT_L(0); G8_MMA(0, 0, At, B0); G8_BAR; G8_SCHED;
      G8_LDB(B1, 0, 1); G8_STAGE(G8_SB(0, 0), b2);
      G8_BAR; G8_WAIT_L(0); G8_MMA(0, 1, At, B1); G8_BAR;
      G8_LDA(At, 0, 1); G8_STAGE(G8_SA(0, 0), a2);
      G8_BAR; G8_WAIT_L(0); G8_MMA(1, 0, At, B0); G8_BAR; G8_SCHED;
      G8_STAGE(G8_SB(0, 1), b2 + hstep);
      G8_WAIT_V(6); G8_BAR; G8_MMA(1, 1, At, B1); G8_BAR;
      G8_LDB(B0, 1, 0); G8_SCHED; G8_LDA(At, 1, 0); G8_STAGE(G8_SA(0, 1), a2 + hstep);
      G8_WAIT_L(8); G8_BAR; G8_WAIT_L(0); G8_MMA(0, 0, At, B0); G8_BAR; G8_SCHED;
      G8_LDB(B1, 1, 1); G8_STAGE(G8_SB(1, 0), b3);
      G8_BAR; G8_WAIT_L(0); G8_MMA(0, 1, At, B1); G8_BAR;
      G8_LDA(At, 1, 1); G8_STAGE(G8_SA(1, 0), a3);
      G8_BAR; G8_WAIT_L(0); G8_MMA(1, 0, At, B0); G8_BAR; G8_SCHED;
      G8_STAGE(G8_SB(1, 1), b3 + hstep);
      G8_WAIT_V(6); G8_BAR; G8_MMA(1, 1, At, B1); G8_BAR;
    }
    E(acc, cur, ui, wr, wc, fr, fq);
    if (!has_next) break;
#pragma unroll
    for (int a = 0; a < 2; ++a)
#pragma unroll
      for (int b = 0; b < 2; ++b)
#pragma unroll
        for (int m = 0; m < 4; ++m)
#pragma unroll
          for (int n = 0; n < 2; ++n) acc[a][b][m][n] = (f32x4){0.f, 0.f, 0.f, 0.f};
    cur = nxt; cA = nA; cB = nB; ++ui;
  }
  G8_WAIT_V(0);
  if (wr == 0) G8_BAR;
  G8_BAR;
#undef G8_SA
#undef G8_SB
#undef G8_STAGE
#undef G8_LDA
#undef G8_LDB
#undef G8_MMA
#undef G8_WAIT_V
#undef G8_WAIT_L
#undef G8_BAR
#undef G8_SCHED
}
}

constexpr int RSL_OFF = g8::STAGE_BYTES;
constexpr int LDS_GEMM = g8::STAGE_BYTES + 8 * 256 * 4;

__device__ __forceinline__ void fill_rowscales(float* rsl, const float* ssq, float inv_n, const g8::Order& S) {
  const int tid = opaque_tid();
  g8::Unit u;
  __syncthreads();
  for (int i = 0; S.next(i, u); ++i) {
    if (tid < 256) {
      const float4* s4 = (const float4*)(ssq + (size_t)(u.pm * 256 + tid) * 16);
      float s = 0.f;
      for (int k = 0; k < 4; ++k) { float4 v = s4[k]; s += v.x + v.y + v.z + v.w; }
      rsl[i * 256 + tid] = rsqrtf(s * inv_n + EPS);
    }
  }
  __syncthreads();
}

__device__ __forceinline__ h16x4 pack4(float a, float b, float c, float d) { h16x4 v = {(h16)a, (h16)b, (h16)c, (h16)d}; return v; }

struct EpiIn {
  static constexpr int MID_T = -1;
  __device__ __forceinline__ void mid(f32x4 (&)[2][2][4][2], int, int, int) const {}
  h16* P; const float* rsl; const float* qkg;
  __device__ __forceinline__ void operator()(const f32x4 (&acc)[2][2][4][2], const g8::Unit& u, int ui, int wr, int wc, int fr, int fq) const {
    const int hs = u.pn * 4 + wc;
    int gi = -1;
    if (hs < 4) gi = 0; else if (hs < 6) gi = 1; else if (hs >= 16 && hs < 20) gi = 2; else if (hs == 22) gi = 4; else if (hs == 24) gi = 5;
    const bool gate = (hs == 26);
#pragma unroll
    for (int ai = 0; ai < 2; ++ai)
#pragma unroll
      for (int m = 0; m < 4; ++m) {
        const int rl = 128 * ai + 64 * wr + 16 * m + fr;
        float r = rsl[ui * 256 + rl];
        if (gi >= 0) {
          float ss = 0.f;
#pragma unroll
          for (int bj = 0; bj < 2; ++bj)
#pragma unroll
            for (int n = 0; n < 2; ++n)
#pragma unroll
              for (int j = 0; j < 4; ++j) ss += acc[ai][bj][m][n][j] * acc[ai][bj][m][n][j];
          ss += xor16(ss);
          ss += __shfl_xor(ss, 32);
          r *= rsqrtf(ss * r * r * (1.f / 64.f) + EPS);
        }
        h16* rowp = P + (size_t)(u.pm * 256 + rl) * IWP + 64 * hs + 4 * fq;
#pragma unroll
        for (int bj = 0; bj < 2; ++bj)
#pragma unroll
          for (int n = 0; n < 2; ++n) {
            f32x4 v = acc[ai][bj][m][n] * r;
            if (gi >= 0) {
              const float4 g4 = *(const float4*)(qkg + gi * 64 + 32 * bj + 16 * n + 4 * fq);
              v[0] *= g4.x; v[1] *= g4.y; v[2] *= g4.z; v[3] *= g4.w;
            } else if (gate) {
#pragma unroll
              for (int j = 0; j < 4; ++j) v[j] = (32 * bj + 16 * n + 4 * fq + j) < 12 ? sigmoidf(v[j]) : 0.f;
            }
            *(h16x4*)(rowp + 32 * bj + 16 * n) = pack4(v[0], v[1], v[2], v[3]);
          }
      }
  }
};

struct EpiGlu {
  static constexpr int MID_T = -1;
  __device__ __forceinline__ void mid(f32x4 (&)[2][2][4][2], int, int, int) const {}
  h16* OB; float* ssqb; const float* gb;
  __device__ __forceinline__ void operator()(const f32x4 (&acc)[2][2][4][2], const g8::Unit& u, int ui, int wr, int wc, int fr, int fq) const {
    const int ocb = 128 * u.pn + 16 * wc + 4 * fq;
    float4 ba[2], bb[2];
#pragma unroll
    for (int bj = 0; bj < 2; ++bj) { ba[bj] = *(const float4*)(gb + ocb + 64 * bj); bb[bj] = *(const float4*)(gb + 512 + ocb + 64 * bj); }
#pragma unroll
    for (int ai = 0; ai < 2; ++ai)
#pragma unroll
      for (int m = 0; m < 4; ++m) {
        const size_t row = (size_t)u.pm * 256 + 128 * ai + 64 * wr + 16 * m + fr;
        float ss = 0.f;
#pragma unroll
        for (int bj = 0; bj < 2; ++bj) {
          const f32x4 a = acc[ai][bj][m][0], b = acc[ai][bj][m][1];
          float o0 = (a[0] + ba[bj].x) * sigmoidf(b[0] + bb[bj].x);
          float o1 = (a[1] + ba[bj].y) * sigmoidf(b[1] + bb[bj].y);
          float o2 = (a[2] + ba[bj].z) * sigmoidf(b[2] + bb[bj].z);
          float o3 = (a[3] + ba[bj].w) * sigmoidf(b[3] + bb[bj].w);
          *(h16x4*)(OB + row * 1024 + ocb + 64 * bj) = pack4(o0, o1, o2, o3);
          ss += o0 * o0 + o1 * o1 + o2 * o2 + o3 * o3;
        }
        ss += xor16(ss);
        ss += __shfl_xor(ss, 32);
        if (fq == 0) ssqb[row * 16 + u.pn * 4 + wc] = ss;
      }
  }
};

struct EpiRes {
  static constexpr int MID_T = -1;
  __device__ __forceinline__ void mid(f32x4 (&)[2][2][4][2], int, int, int) const {}
  float* xo; const float* xsrc; h16* xb; float* ssq;
  __device__ __forceinline__ void operator()(const f32x4 (&acc)[2][2][4][2], const g8::Unit& u, int ui, int wr, int wc, int fr, int fq) const {
#pragma unroll
    for (int ai = 0; ai < 2; ++ai)
#pragma unroll
      for (int m = 0; m < 4; ++m) {
        const size_t row = (size_t)u.pm * 256 + 128 * ai + 64 * wr + 16 * m + fr;
        const size_t base = row * DM + 256 * u.pn + 32 * wc + 4 * fq;
        float ss = 0.f;
#pragma unroll
        for (int bj = 0; bj < 2; ++bj)
#pragma unroll
          for (int n = 0; n < 2; ++n) {
            const size_t idx = base + 128 * bj + 16 * n;
            const float4 xv = *(const float4*)(xsrc + idx);
            const f32x4 a = acc[ai][bj][m][n];
            const float x0 = xv.x + a[0], x1 = xv.y + a[1], x2 = xv.z + a[2], x3 = xv.w + a[3];
            *(float4*)(xo + idx) = make_float4(x0, x1, x2, x3);
            *(h16x4*)(xb + idx) = pack4(x0, x1, x2, x3);
            ss += x0 * x0 + x1 * x1 + x2 * x2 + x3 * x3;
          }
        ss += xor16(ss);
        ss += __shfl_xor(ss, 32);
        if (fq == 0) ssq[row * 16 + u.pn * 4 + wc] = ss;
      }
  }
};

struct EpiOut : EpiRes {
  static constexpr int MID_T = 8;
  const float* rsl;
  __device__ __forceinline__ void mid(f32x4 (&acc)[2][2][4][2], int ui, int wr, int fr) const {
#pragma unroll
    for (int ai = 0; ai < 2; ++ai)
#pragma unroll
      for (int m = 0; m < 4; ++m) {
        const float r = rsl[ui * 256 + 128 * ai + 64 * wr + 16 * m + fr];
#pragma unroll
        for (int bj = 0; bj < 2; ++bj)
#pragma unroll
          for (int n = 0; n < 2; ++n) acc[ai][bj][m][n] *= r;
      }
  }
};

struct EpiUp {
  static constexpr int MID_T = -1;
  __device__ __forceinline__ void mid(f32x4 (&)[2][2][4][2], int, int, int) const {}
  h16* hid; const float* rsl;
  __device__ __forceinline__ void operator()(const f32x4 (&acc)[2][2][4][2], const g8::Unit& u, int ui, int wr, int wc, int fr, int fq) const {
#pragma unroll
    for (int ai = 0; ai < 2; ++ai)
#pragma unroll
      for (int m = 0; m < 4; ++m) {
        const int rl = 128 * ai + 64 * wr + 16 * m + fr;
        const float r = rsl[ui * 256 + rl];
        h16* rowp = hid + (size_t)(u.pm * 256 + rl) * DFF + 256 * u.pn + 32 * wc + 4 * fq;
#pragma unroll
        for (int bj = 0; bj < 2; ++bj)
#pragma unroll
          for (int n = 0; n < 2; ++n) {
            const f32x4 a = acc[ai][bj][m][n];
            float v0 = fmaxf(a[0] * r, 0.f), v1 = fmaxf(a[1] * r, 0.f), v2 = fmaxf(a[2] * r, 0.f), v3 = fmaxf(a[3] * r, 0.f);
            *(h16x4*)(rowp + 128 * bj + 16 * n) = pack4(v0 * v0, v1 * v1, v2 * v2, v3 * v3);
          }
      }
  }
};

__device__ void phase_gemm1(const Params& p, int l, char* lds) {
  g8::Order S; S.init(NTOK, IWP, gridDim.x, blockIdx.x);
  float* rsl = (float*)(lds + RSL_OFF);
  fill_rowscales(rsl, (const float*)(p.ws + O_SSQ), 1.f / DM, S);
  EpiIn E{(h16*)(p.ws + O_P), rsl, p.in[3] + l * 6 * 64};
  g8::gemm_phase((LAS unsigned char*)lds, (const h16*)(p.ws + O_XB), (const h16*)(p.ws + O_WIN + l * SZ_WIN), DM, S, E);
}
__device__ void phase_glu(const Params& p, int l, char* lds) {
  g8::Order S; S.init(NTOK, 1024, gridDim.x, blockIdx.x);
  __syncthreads();
  EpiGlu E{(h16*)(p.ws + O_OB), (float*)(p.ws + O_SSQB), p.in[15] + l * 1024};
  g8::gemm_phase((LAS unsigned char*)lds, (const h16*)(p.ws + O_Z), (const h16*)(p.ws + O_WGLU + l * SZ_WGLU), 512, S, E);
}
__device__ void phase_wout(const Params& p, int l, char* lds) {
  g8::Order S; S.init(NTOK, DM, gridDim.x, blockIdx.x);
  float* rsl = (float*)(lds + RSL_OFF);
  fill_rowscales(rsl, (const float*)(p.ws + O_SSQB), 1.f / 512.f, S);
  EpiOut E;
  E.xo = p.out; E.xsrc = (l == 0) ? p.in[0] : p.out; E.xb = (h16*)(p.ws + O_XB); E.ssq = (float*)(p.ws + O_SSQ); E.rsl = rsl;
  g8::gemm_phase((LAS unsigned char*)lds, (const h16*)(p.ws + O_OB), (const h16*)(p.ws + O_WOUT + l * SZ_WOUT), DM, S, E);
}
__device__ void phase_up(const Params& p, int l, char* lds) {
  g8::Order S; S.init(NTOK, DFF, gridDim.x, blockIdx.x);
  float* rsl = (float*)(lds + RSL_OFF);
  fill_rowscales(rsl, (const float*)(p.ws + O_SSQ), 1.f / DM, S);
  EpiUp E{(h16*)(p.ws + O_HID), rsl};
  g8::gemm_phase((LAS unsigned char*)lds, (const h16*)(p.ws + O_XB), (const h16*)(p.ws + O_WUP + l * SZ_WUP), DM, S, E);
}
__device__ void phase_down(const Params& p, int l, char* lds) {
  g8::Order S; S.init(NTOK, DM, gridDim.x, blockIdx.x);
  __syncthreads();
  EpiRes E{p.out, p.out, (h16*)(p.ws + O_XB), (float*)(p.ws + O_SSQ)};
  g8::gemm_phase((LAS unsigned char*)lds, (const h16*)(p.ws + O_HID), (const h16*)(p.ws + O_WDN + l * SZ_WDN), DFF, S, E);
}

constexpr int KP = 72;
enum { M_SWA = 0, M_WIN = 1, M_SEL = 2, M_CMPA = 3, M_CMPB = 4 };
constexpr float LOG2E = 1.4426950408889634f, SCL2 = 0.125f * LOG2E;
struct RowState { float m[4], l[4]; };

__device__ __forceinline__ h16x8 ld_row8(const h16* base, int ld, int row, int nrows, int c8) {
  h16x8 z = {0, 0, 0, 0, 0, 0, 0, 0};
  return (row >= 0 && row < nrows) ? *(const h16x8*)(base + (size_t)row * ld + c8 * 8) : z;
}
__device__ __forceinline__ void st_k(h16* Ks, int row, int c8, h16x8 v) { *(h16x8*)(Ks + row * KP + c8 * 8) = v; }
__device__ __forceinline__ void st_vt(h16* Vt, int row, int c8, h16x8 v) {
#pragma unroll
  for (int e = 0; e < 8; ++e) Vt[(c8 * 8 + e) * KP + row] = v[e];
}

template <int MODE, int RGM>
__device__ __forceinline__ void attn_tile(const h16x8 (&Q)[2][2], f32x4 (&O)[2][4], RowState (&st)[2], const h16* Ks,
                                          const h16* Vt, h16* Pb, const float* biasT, const int (&tq)[2], int head,
                                          int kbase, const bool (&selbit)[2], float (&hp)[2][4], const int lane) {
  const int col = lane & 15, q4 = lane >> 4;
  f32x4 S[2][4];
#pragma unroll
  for (int kt = 0; kt < 4; ++kt) {
#pragma unroll
    for (int rg = 0; rg < 2; ++rg) S[rg][kt] = f32x4{0.f, 0.f, 0.f, 0.f};
#pragma unroll
    for (int ks = 0; ks < 2; ++ks) {
      h16x8 B = *(const h16x8*)(Ks + (kt * 16 + col) * KP + ks * 32 + q4 * 8);
#pragma unroll
      for (int rg = 0; rg < 2; ++rg)
        if (RGM & (1 << rg)) S[rg][kt] = __builtin_amdgcn_mfma_f32_16x16x32_f16(Q[rg][ks], B, S[rg][kt], 0, 0, 0);
    }
  }
#pragma unroll
  for (int rg = 0; rg < 2; ++rg) {
    if (!(RGM & (1 << rg))) continue;
#pragma unroll
    for (int kt = 0; kt < 4; ++kt) {
      const int kx = kbase + kt * 16 + col;
      if (MODE == M_SWA) {
#pragma unroll
        for (int j = 0; j < 4; ++j) {
          int dist = tq[rg] + j - kx;
          bool valid = dist >= 0 && dist < 128 && kx >= 0;
          int dc = dist < 0 ? 0 : (dist > 799 ? 799 : dist);
          S[rg][kt][j] = valid ? S[rg][kt][j] * SCL2 + biasT[dc * 4 + head] : -1e30f;
        }
      } else {
        int dist;
        bool valid;
        if (MODE == M_WIN) { dist = tq[rg] - kx; valid = dist >= 0 && dist < 512 && kx >= 0; }
        else if (MODE == M_SEL) { dist = tq[rg] - kx; valid = selbit[rg] && dist >= 0; }
        else { dist = tq[rg] - (16 * kx + 31); valid = dist >= 0 && kx < NCMP; }
        int dc = dist < 0 ? 0 : (dist > 799 ? 799 : dist);
        float4 bv = *(const float4*)(biasT + dc * 4);
        S[rg][kt][0] = valid ? S[rg][kt][0] * SCL2 + bv.x : -1e30f;
        S[rg][kt][1] = valid ? S[rg][kt][1] * SCL2 + bv.y : -1e30f;
        S[rg][kt][2] = valid ? S[rg][kt][2] * SCL2 + bv.z : -1e30f;
        S[rg][kt][3] = valid ? S[rg][kt][3] * SCL2 + bv.w : -1e30f;
      }
    }
    if (MODE == M_CMPB) {
#pragma unroll
      for (int kt = 0; kt < 4; ++kt) {
        float h = 0.f;
#pragma unroll
        for (int j = 0; j < 4; ++j) {
          float pv = __builtin_amdgcn_exp2f(S[rg][kt][j] - st[rg].m[j]) * st[rg].l[j];
          S[rg][kt][j] = pv;
          h += pv;
        }
        hp[rg][kt] = h;
      }
    } else {
#pragma unroll
      for (int j = 0; j < 4; ++j) {
        float mx = fmaxf(fmaxf(S[rg][0][j], S[rg][1][j]), fmaxf(S[rg][2][j], S[rg][3][j]));
        mx = max16(mx);
        float mn = fmaxf(st[rg].m[j], mx);
        float corr = __builtin_amdgcn_exp2f(st[rg].m[j] - mn);
        st[rg].m[j] = mn;
        float mm = fmaxf(mn, -1e20f);
        float ls = 0.f;
#pragma unroll
        for (int kt = 0; kt < 4; ++kt) {
          float pv = __builtin_amdgcn_exp2f(S[rg][kt][j] - mm);
          S[rg][kt][j] = pv;
          ls += pv;
        }
        st[rg].l[j] = st[rg].l[j] * corr + ls;
        if (MODE != M_CMPA) {
#pragma unroll
          for (int nt = 0; nt < 4; ++nt) O[rg][nt][j] *= corr;
        }
      }
    }
    if (MODE != M_CMPA) {
#pragma unroll
      for (int kt = 0; kt < 4; ++kt)
#pragma unroll
        for (int j = 0; j < 4; ++j) Pb[rg * 16 * KP + (q4 * 4 + j) * KP + kt * 16 + col] = (h16)S[rg][kt][j];
    }
  }
  if (MODE == M_CMPA) return;
  asm volatile("" ::: "memory");
#pragma unroll
  for (int ks = 0; ks < 2; ++ks) {
    h16x8 A[2];
#pragma unroll
    for (int rg = 0; rg < 2; ++rg)
      if (RGM & (1 << rg)) A[rg] = *(const h16x8*)(Pb + rg * 16 * KP + col * KP + ks * 32 + q4 * 8);
#pragma unroll
    for (int nt = 0; nt < 4; ++nt) {
      h16x8 B = *(const h16x8*)(Vt + (nt * 16 + col) * KP + ks * 32 + q4 * 8);
#pragma unroll
      for (int rg = 0; rg < 2; ++rg)
        if (RGM & (1 << rg)) O[rg][nt] = __builtin_amdgcn_mfma_f32_16x16x32_f16(A[rg], B, O[rg][nt], 0, 0, 0);
    }
  }
  asm volatile("" ::: "memory");
}

__device__ __forceinline__ float red16(float v) { return sum16(v); }

constexpr int LDS_CMP = 8 * 16 * 128 * 4 + 16 * 136 * 2 + 4 * 16 * 4;
__device__ void phase_compress(const Params& p, int l, char* lds) {
  const int tid = opaque_tid(), lane = tid & 63, w = tid >> 6, col = lane & 15, q4 = lane >> 4;
  float* red = (float*)lds;
  h16* hid = (h16*)(lds + 8 * 16 * 128 * 4);
  float* nrm2 = (float*)(lds + 8 * 16 * 128 * 4 + 16 * 136 * 2);
  const h16* P = (const h16*)(p.ws + O_P);
  for (int u = blockIdx.x; u < BATCH * 2 * 32; u += gridDim.x) {
    const int mt = u & 31, st = (u >> 5) & 1, b = u >> 6;
    const h16* W1t = (const h16*)(p.ws + O_W1T) + (size_t)(l * 2 + st) * 128 * 2048;
    const h16* W2t = (const h16*)(p.ws + O_W2T) + (size_t)(l * 2 + st) * 64 * 128;
    const float* b1 = (const float*)(p.ws + O_BIAS1) + (l * 2 + st) * 128;
    __syncthreads();
    {
      f32x4 acc[8];
#pragma unroll
      for (int nt = 0; nt < 8; ++nt) acc[nt] = f32x4{0.f, 0.f, 0.f, 0.f};
      const int m = 16 * mt + col;
#pragma unroll 2
      for (int kk = 0; kk < 8; ++kk) {
        const int ks = 8 * w + kk, tt = ks >> 1, d0 = (ks & 1) * 32 + q4 * 8;
        int tok = 16 * m + tt;
        if (tok > SEQ - 1) tok = SEQ - 1;
        const h16x8 A = *(const h16x8*)(P + ((size_t)b * SEQ + tok) * IWP + OFF_KVC + st * 64 + d0);
#pragma unroll
        for (int nt = 0; nt < 8; ++nt) {
          const h16x8 B = *(const h16x8*)(W1t + (size_t)(nt * 16 + col) * 2048 + ks * 32 + q4 * 8);
          acc[nt] = __builtin_amdgcn_mfma_f32_16x16x32_f16(A, B, acc[nt], 0, 0, 0);
        }
      }
#pragma unroll
      for (int nt = 0; nt < 8; ++nt)
#pragma unroll
        for (int j = 0; j < 4; ++j) red[(w * 16 + q4 * 4 + j) * 128 + nt * 16 + col] = acc[nt][j];
    }
    __syncthreads();
    {
      const int row = tid >> 5, c4 = (tid & 31) * 4;
      float4 sum = *(const float4*)(b1 + c4);
#pragma unroll
      for (int ww = 0; ww < 8; ++ww) {
        const float4 v = *(const float4*)(red + (ww * 16 + row) * 128 + c4);
        sum.x += v.x; sum.y += v.y; sum.z += v.z; sum.w += v.w;
      }
      *(h16x4*)(hid + row * 136 + c4) = pack4(gelu_tanh(sum.x), gelu_tanh(sum.y), gelu_tanh(sum.z), gelu_tanh(sum.w));
    }
    __syncthreads();
    f32x4 o2 = {0.f, 0.f, 0.f, 0.f};
    if (w < 4) {
#pragma unroll
      for (int ks = 0; ks < 4; ++ks) {
        const h16x8 A = *(const h16x8*)(hid + col * 136 + ks * 32 + q4 * 8);
        const h16x8 B = *(const h16x8*)(W2t + (size_t)(w * 16 + col) * 128 + ks * 32 + q4 * 8);
        o2 = __builtin_amdgcn_mfma_f32_16x16x32_f16(A, B, o2, 0, 0, 0);
      }
      if (st == 0) {
#pragma unroll
        for (int j = 0; j < 4; ++j) {
          float ss = sum16(o2[j] * o2[j]);
          if (col == 0) nrm2[w * 16 + q4 * 4 + j] = ss;
        }
      }
    }
    __syncthreads();
    if (w < 4) {
      const float g = p.in[3][(l * 6 + 3) * 64 + w * 16 + col];
      h16* dst = (h16*)(p.ws + (st == 0 ? O_KCMP : O_VCMP));
#pragma unroll
      for (int j = 0; j < 4; ++j) {
        const int row = q4 * 4 + j, m = 16 * mt + row;
        float v = o2[j];
        if (st == 0) {
          float tot = nrm2[row] + nrm2[16 + row] + nrm2[32 + row] + nrm2[48 + row];
          v = v * rsqrtf(tot * (1.f / 64.f) + EPS) * g;
        }
        if (m >= NCMP) v = 0.f;
        dst[((size_t)b * 512 + m) * 64 + w * 16 + col] = (h16)v;
      }
    }
  }
}

constexpr int LDS_BIAS = 800 * 16;
constexpr int LDS_PB = NW * 32 * KP * 2;
__device__ void phase_swa(const Params& p, int l, char* lds) {
  const int tid = opaque_tid(), lane = tid & 63, w = tid >> 6, col = lane & 15, q4 = lane >> 4;
  float* biasT = (float*)lds;
  h16* Pb = (h16*)(lds + LDS_BIAS) + w * 32 * KP;
  h16* KV = (h16*)(lds + LDS_BIAS + LDS_PB);
  float* nrm = (float*)(lds + LDS_BIAS + LDS_PB + 4 * 64 * KP * 2);
  const h16* P = (const h16*)(p.ws + O_P);
  const int* lut = (const int*)(p.ws + O_LUT);
  h16* OAC = (h16*)(p.ws + O_OAC);
  __syncthreads();
  for (int i = tid; i < 3200; i += NT) biasT[i] = p.in[5][lut[i >> 2] * 8 + (i & 3)] * LOG2E;
  __syncthreads();
  const int head = w >> 1, kvh = w >> 2;
  const float sink = p.in[4][l * 4 + head] * LOG2E;
  const int srow = tid >> 3, c8 = tid & 7;
  float hpd[2][4];
  const bool nosel[2] = {false, false};
  for (int u = blockIdx.x; u < BATCH * 128; u += gridDim.x) {
    const int b = u >> 7, t0 = (u & 127) * 64;
    const h16* Pbat = P + (size_t)b * SEQ * IWP;
    h16x8 Q[2][2];
    int tq[2];
#pragma unroll
    for (int rg = 0; rg < 2; ++rg) {
      const int qb = (w & 1) * 32 + rg * 16;
      const h16* qp = Pbat + (size_t)(t0 + qb + col) * IWP + head * 64 + q4 * 8;
      Q[rg][0] = *(const h16x8*)qp;
      Q[rg][1] = *(const h16x8*)(qp + 32);
      tq[rg] = t0 + qb + q4 * 4;
    }
    f32x4 O[2][4];
    RowState st[2];
#pragma unroll
    for (int rg = 0; rg < 2; ++rg) {
#pragma unroll
      for (int nt = 0; nt < 4; ++nt) O[rg][nt] = f32x4{0.f, 0.f, 0.f, 0.f};
#pragma unroll
      for (int j = 0; j < 4; ++j) { st[rg].m[j] = -1e30f; st[rg].l[j] = 0.f; }
    }
    const int i0 = t0 >= 128 ? 0 : (t0 >= 64 ? 1 : 2);
    h16x8 rk[2], rv[2];
    {
      int sb = t0 - 128 + i0 * 64;
      for (int h2 = 0; h2 < 2; ++h2) {
        rk[h2] = ld_row8(Pbat + 256 + h2 * 64, IWP, sb + srow, SEQ, c8);
        rv[h2] = ld_row8(Pbat + 384 + h2 * 64, IWP, sb + srow, SEQ, c8);
      }
    }
    for (int i = i0; i < 3; ++i) {
      __syncthreads();
      for (int h2 = 0; h2 < 2; ++h2) {
        st_k(KV + h2 * 64 * KP, srow, c8, rk[h2]);
        st_vt(KV + (2 + h2) * 64 * KP, srow, c8, rv[h2]);
      }
      __syncthreads();
      if (i + 1 < 3) {
        int sb = t0 - 128 + (i + 1) * 64;
        for (int h2 = 0; h2 < 2; ++h2) {
          rk[h2] = ld_row8(Pbat + 256 + h2 * 64, IWP, sb + srow, SEQ, c8);
          rv[h2] = ld_row8(Pbat + 384 + h2 * 64, IWP, sb + srow, SEQ, c8);
        }
      }
      const int kb = t0 - 128 + i * 64;
      attn_tile<M_SWA, 3>(Q, O, st, KV + kvh * 64 * KP, KV + (2 + kvh) * 64 * KP, Pb, biasT, tq, head, kb, nosel, hpd, lane);
    }
    __syncthreads();
#pragma unroll
    for (int rg = 0; rg < 2; ++rg) {
      const int qb = (w & 1) * 32 + rg * 16;
#pragma unroll
      for (int j = 0; j < 4; ++j) {
        float lsum = red16(st[rg].l[j]);
        float mn = fmaxf(st[rg].m[j], sink);
        float corr = __builtin_amdgcn_exp2f(st[rg].m[j] - mn);
        float inv = corr / (lsum * corr + __builtin_amdgcn_exp2f(sink - mn));
        float ss = 0.f;
#pragma unroll
        for (int nt = 0; nt < 4; ++nt) { O[rg][nt][j] *= inv; ss += O[rg][nt][j] * O[rg][nt][j]; }
        ss = red16(ss);
        if (col == 0) nrm[head * 64 + qb + q4 * 4 + j] = ss;
      }
    }
    __syncthreads();
#pragma unroll
    for (int rg = 0; rg < 2; ++rg) {
      const int qb = (w & 1) * 32 + rg * 16;
#pragma unroll
      for (int j = 0; j < 4; ++j) {
        const int qi = qb + q4 * 4 + j;
        float tot = nrm[qi] + nrm[64 + qi] + nrm[128 + qi] + nrm[192 + qi];
        float sc = rsqrtf(tot * (1.f / 256.f) + EPS);
#pragma unroll
        for (int nt = 0; nt < 4; ++nt)
          OAC[((size_t)b * SEQ + t0 + qi) * 1024 + head * 64 + nt * 16 + col] = (h16)(O[rg][nt][j] * sc);
      }
    }
  }
}

constexpr int LDS_NSA = LDS_BIAS + LDS_PB + 4 * 64 * KP * 2 + NW * 4 * 128 * 4 + 32 * 16;
__device__ void phase_nsa(const Params& p, int l, char* lds) {
  const int tid = opaque_tid(), lane = tid & 63, w = tid >> 6, col = lane & 15, q4 = lane >> 4;
  float* biasT = (float*)lds;
  h16* Pb = (h16*)(lds + LDS_BIAS) + w * 32 * KP;
  h16* KV0 = (h16*)(lds + LDS_BIAS + LDS_PB);
  float* impw = (float*)(lds + LDS_BIAS + LDS_PB + 4 * 64 * KP * 2) + w * 4 * 128;
  unsigned long long* selm = (unsigned long long*)(lds + LDS_BIAS + LDS_PB + 4 * 64 * KP * 2 + NW * 4 * 128 * 4);
#define KSB(i) (KV0 + ((i) & 1) * 2 * 64 * KP)
#define VTB(i) (KV0 + ((i) & 1) * 2 * 64 * KP + 64 * KP)
  const h16* P = (const h16*)(p.ws + O_P);
  const int* lut = (const int*)(p.ws + O_LUT);
  h16* OAC = (h16*)(p.ws + O_OAC);
  __syncthreads();
  for (int i = tid; i < 3200; i += NT) biasT[i] = p.in[5][lut[i >> 2] * 8 + 4 + (i & 3)] * LOG2E;
  __syncthreads();
  const int srow = tid >> 3, c8 = tid & 7;
  float hpd[2][4];
  const bool nosel[2] = {false, false};
  for (int u = blockIdx.x; u < 1024; u += gridDim.x) {
    const int rnd = u >> 8, b = (u & 255) >> 6, ti = u & 63;
    const int tile = rnd == 0 ? 255 - ti : (rnd == 1 ? 128 + ti : (rnd == 2 ? 127 - ti : ti));
    const int t0 = tile * 32, cur = t0 >> 6;
    const h16* Pbat = P + (size_t)b * SEQ * IWP;
    const h16* KC = (const h16*)(p.ws + O_KCMP) + (size_t)b * 512 * 64;
    const h16* VC = (const h16*)(p.ws + O_VCMP) + (size_t)b * 512 * 64;
    h16x8 Q[2][2];
    int tq[2] = {0, 0};
    {
      const int qi = w * 4 + (col >> 2), hd = col & 3;
      const h16* qp = Pbat + (size_t)(t0 + qi) * IWP + OFF_QC + hd * 64 + q4 * 8;
      Q[0][0] = *(const h16x8*)qp;
      Q[0][1] = *(const h16x8*)(qp + 32);
      tq[0] = t0 + w * 4 + q4;
    }
    for (int i = lane; i < 512; i += 64) impw[i] = 0.f;
    f32x4 O[2][4], Oc[2][4];
    RowState st[2];
    h16x8 rk, rv;
    int mvmax = t0 / 16 + 1;
    if (mvmax > NCMP) mvmax = NCMP;
    const int ntc = (mvmax + 63) >> 6;
#pragma unroll
    for (int rg = 0; rg < 1; ++rg)
#pragma unroll
      for (int j = 0; j < 4; ++j) { st[rg].m[j] = -1e30f; st[rg].l[j] = 0.f; }
    rk = ld_row8(KC, 64, srow, 512, c8);
    st_k(KSB(0), srow, c8, rk);
    if (1 < ntc) rk = ld_row8(KC, 64, 64 + srow, 512, c8);
    __syncthreads();
    for (int i = 0; i < ntc; ++i) {
      if (i + 1 < ntc) st_k(KSB(i + 1), srow, c8, rk);
      if (i + 2 < ntc) rk = ld_row8(KC, 64, (i + 2) * 64 + srow, 512, c8);
      attn_tile<M_CMPA, 1>(Q, O, st, KSB(i), VTB(i), Pb, biasT, tq, 0, i * 64, nosel, hpd, lane);
      __syncthreads();
    }
#pragma unroll
    for (int rg = 0; rg < 1; ++rg)
#pragma unroll
      for (int j = 0; j < 4; ++j) {
        float ls = red16(st[rg].l[j]);
        st[rg].l[j] = ls > 0.f ? 1.f / ls : 0.f;
      }
#pragma unroll
    for (int rg = 0; rg < 1; ++rg)
#pragma unroll
      for (int nt = 0; nt < 4; ++nt) O[rg][nt] = f32x4{0.f, 0.f, 0.f, 0.f};
    float carry[1] = {0.f};
    rk = ld_row8(KC, 64, srow, 512, c8);
    rv = ld_row8(VC, 64, srow, 512, c8);
    st_k(KSB(0), srow, c8, rk);
    st_vt(VTB(0), srow, c8, rv);
    if (1 < ntc) {
      rk = ld_row8(KC, 64, 64 + srow, 512, c8);
      rv = ld_row8(VC, 64, 64 + srow, 512, c8);
    }
    __syncthreads();
    for (int i = 0; i < ntc; ++i) {
      if (i + 1 < ntc) { st_k(KSB(i + 1), srow, c8, rk); st_vt(VTB(i + 1), srow, c8, rv); }
      if (i + 2 < ntc) {
        rk = ld_row8(KC, 64, (i + 2) * 64 + srow, 512, c8);
        rv = ld_row8(VC, 64, (i + 2) * 64 + srow, 512, c8);
      }
      float hp2[2][4];
      attn_tile<M_CMPB, 1>(Q, O, st, KSB(i), VTB(i), Pb, biasT, tq, 0, i * 64, nosel, hp2, lane);
#pragma unroll
      for (int rg = 0; rg < 1; ++rg) {
        float hp[4] = {hp2[rg][0], hp2[rg][1], hp2[rg][2], hp2[rg][3]};
#pragma unroll
        for (int kt = 0; kt < 4; ++kt) {
          float h = hp[kt];
          float qs = h + dppf<0xB1>(h);
          qs += dppf<0x4E>(qs);
          float prev = dppf<0x121>(h);
          float cin = (kt == 0) ? carry[rg] : dppf<0x121>(hp[kt > 0 ? kt - 1 : 0]);
          float pk = (col == 0) ? cin : prev;
          if ((col & 3) == 0) impw[(rg * 4 + q4) * 128 + ((i * 64 + kt * 16 + col) >> 2)] = qs + pk;
        }
        carry[rg] = dppf<0x121>(hp[3]);
      }
      __syncthreads();
    }
#pragma unroll
    for (int rg = 0; rg < 1; ++rg) {
      const h16* gp = Pbat + (size_t)tq[rg] * IWP + OFF_GC;
#pragma unroll
      for (int j = 0; j < 4; ++j) {
        float g0 = (float)gp[j * 3 + 0];
#pragma unroll
        for (int nt = 0; nt < 4; ++nt) Oc[rg][nt][j] = g0 * O[rg][nt][j];
      }
    }
    {
      const int nforced = cur >= 2 ? 3 : cur + 1;
      const int npick = 16 - nforced;
      for (int qi = 0; qi < 4; ++qi) {
        const float* im = impw + qi * 128;
        const int j0 = lane, j1 = lane + 64;
        const float v0 = im[j0], v1 = im[j1];
        int r0 = 0, r1 = 0;
        for (int jp = 1; jp <= cur - 2; ++jp) {
          float vp = im[jp];
          r0 += (vp > v0 || (vp == v0 && jp < j0)) ? 1 : 0;
          r1 += (vp > v1 || (vp == v1 && jp < j1)) ? 1 : 0;
        }
        bool c0 = j0 >= 1 && j0 <= cur - 2, c1 = j1 <= cur - 2;
        bool f0 = j0 == 0 || j0 == cur || j0 == cur - 1, f1 = j1 == cur || j1 == cur - 1;
        unsigned long long mlo = __ballot(f0 || (c0 && r0 < npick));
        unsigned long long mhi = __ballot(f1 || (c1 && r1 < npick));
        if (lane == 0) { selm[(w * 4 + qi) * 2] = mlo; selm[(w * 4 + qi) * 2 + 1] = mhi; }
      }
    }
    asm volatile("" ::: "memory");
    unsigned long long slo[2], shi[2];
#pragma unroll
    for (int rg = 0; rg < 1; ++rg) {
      slo[rg] = selm[(w * 4 + q4) * 2];
      shi[rg] = selm[(w * 4 + q4) * 2 + 1];
    }
#pragma unroll
    for (int rg = 0; rg < 1; ++rg) {
#pragma unroll
      for (int nt = 0; nt < 4; ++nt) O[rg][nt] = f32x4{0.f, 0.f, 0.f, 0.f};
#pragma unroll
      for (int j = 0; j < 4; ++j) { st[rg].m[j] = -1e30f; st[rg].l[j] = 0.f; }
    }
    rk = ld_row8(Pbat + OFF_KVC + 128, IWP, srow, SEQ, c8);
    rv = ld_row8(Pbat + OFF_KVC + 192, IWP, srow, SEQ, c8);
    st_k(KSB(0), srow, c8, rk);
    st_vt(VTB(0), srow, c8, rv);
    if (1 <= cur) {
      rk = ld_row8(Pbat + OFF_KVC + 128, IWP, 64 + srow, SEQ, c8);
      rv = ld_row8(Pbat + OFF_KVC + 192, IWP, 64 + srow, SEQ, c8);
    }
    __syncthreads();
    for (int jb = 0; jb <= cur; ++jb) {
      if (jb + 1 <= cur) { st_k(KSB(jb + 1), srow, c8, rk); st_vt(VTB(jb + 1), srow, c8, rv); }
      if (jb + 2 <= cur) {
        rk = ld_row8(Pbat + OFF_KVC + 128, IWP, (jb + 2) * 64 + srow, SEQ, c8);
        rv = ld_row8(Pbat + OFF_KVC + 192, IWP, (jb + 2) * 64 + srow, SEQ, c8);
      }
      bool sb[2] = {false, false};
      sb[0] = ((jb < 64 ? (slo[0] >> jb) : (shi[0] >> (jb - 64))) & 1ull) != 0;
      if (__any(sb[0])) attn_tile<M_SEL, 1>(Q, O, st, KSB(jb), VTB(jb), Pb, biasT, tq, 0, jb * 64, sb, hpd, lane);
      __syncthreads();
    }
#pragma unroll
    for (int rg = 0; rg < 1; ++rg) {
      const h16* gp = Pbat + (size_t)tq[rg] * IWP + OFF_GC;
#pragma unroll
      for (int j = 0; j < 4; ++j) {
        float ls = red16(st[rg].l[j]);
        float f = ls > 0.f ? (float)gp[j * 3 + 1] / ls : 0.f;
#pragma unroll
        for (int nt = 0; nt < 4; ++nt) Oc[rg][nt][j] += f * O[rg][nt][j];
      }
    }
#pragma unroll
    for (int rg = 0; rg < 1; ++rg) {
#pragma unroll
      for (int nt = 0; nt < 4; ++nt) O[rg][nt] = f32x4{0.f, 0.f, 0.f, 0.f};
#pragma unroll
      for (int j = 0; j < 4; ++j) { st[rg].m[j] = -1e30f; st[rg].l[j] = 0.f; }
    }
    const int w0 = cur >= 8 ? cur - 8 : 0;
    rk = ld_row8(Pbat + OFF_KVC + 256, IWP, w0 * 64 + srow, SEQ, c8);
    rv = ld_row8(Pbat + OFF_KVC + 320, IWP, w0 * 64 + srow, SEQ, c8);
    st_k(KSB(w0), srow, c8, rk);
    st_vt(VTB(w0), srow, c8, rv);
    if (w0 + 1 <= cur) {
      rk = ld_row8(Pbat + OFF_KVC + 256, IWP, (w0 + 1) * 64 + srow, SEQ, c8);
      rv = ld_row8(Pbat + OFF_KVC + 320, IWP, (w0 + 1) * 64 + srow, SEQ, c8);
    }
    __syncthreads();
    for (int wi = w0; wi <= cur; ++wi) {
      if (wi + 1 <= cur) { st_k(KSB(wi + 1), srow, c8, rk); st_vt(VTB(wi + 1), srow, c8, rv); }
      if (wi + 2 <= cur) {
        rk = ld_row8(Pbat + OFF_KVC + 256, IWP, (wi + 2) * 64 + srow, SEQ, c8);
        rv = ld_row8(Pbat + OFF_KVC + 320, IWP, (wi + 2) * 64 + srow, SEQ, c8);
      }
      attn_tile<M_WIN, 1>(Q, O, st, KSB(wi), VTB(wi), Pb, biasT, tq, 0, wi * 64, nosel, hpd, lane);
      __syncthreads();
    }
#pragma unroll
    for (int rg = 0; rg < 1; ++rg) {
      const h16* gp = Pbat + (size_t)tq[rg] * IWP + OFF_GC;
      float ss = 0.f;
#pragma unroll
      for (int j = 0; j < 4; ++j) {
        float ls = red16(st[rg].l[j]);
        float f = ls > 0.f ? (float)gp[j * 3 + 2] / ls : 0.f;
#pragma unroll
        for (int nt = 0; nt < 4; ++nt) {
          float v = Oc[rg][nt][j] + f * O[rg][nt][j];
          Oc[rg][nt][j] = v;
          ss += v * v;
        }
      }
      ss = red16(ss);
      float sc = rsqrtf(ss * (1.f / 256.f) + EPS);
#pragma unroll
      for (int j = 0; j < 4; ++j)
#pragma unroll
        for (int nt = 0; nt < 4; ++nt)
          OAC[((size_t)b * SEQ + tq[rg]) * 1024 + 256 + j * 64 + nt * 16 + col] = (h16)(Oc[rg][nt][j] * sc);
    }
  }
}

constexpr int LDS_SWA = LDS_BIAS + LDS_PB + 4 * 64 * KP * 2 + 1024;
constexpr int lds_max(int a, int b) { return a > b ? a : b; }
constexpr int LDS_BYTES = lds_max(lds_max(LDS_NSA, SSMY_LDS), lds_max(LDS_SWA, lds_max(LDS_GEMM, lds_max(LDS_CMP, 64 * 65 * 4))));

__global__ void __launch_bounds__(NT) fwd_megakernel(Params p) {
  cg::grid_group grid = cg::this_grid();
  __shared__ __attribute__((aligned(16))) char lds[LDS_BYTES];
  __shared__ uint4 xb_words;
  if (threadIdx.x == 0) xb_words = make_uint4(0u, 0u, 0u, 0u);
  __syncthreads();
  (void)xcd_barrier_post((unsigned*)(p.ws + O_BAR), (volatile LAS unsigned*)&xb_words);
#define GBAR() do { XcdBarrier _b; _b.bar = (unsigned*)(p.ws + O_BAR); _b.x = xb_xcc_id(); _b.st = (volatile LAS unsigned*)&xb_words; xcd_barrier(_b); } while (0)
  phase0(p, (float*)lds);
  grid.sync();
  phase0b(p);
  GBAR();
  for (int l = 0; l < DEPTH; ++l) {
    phase_gemm1(p, l, lds);
    GBAR();
    ssm_endstates(p, l);
    phase_compress(p, l, lds);
    GBAR();
    phase_nsa(p, l, lds);
    phase_swa(p, l, lds);
    ssm_outputs(p, l, lds);
    GBAR();
    phase_glu(p, l, lds);
    GBAR();
    phase_wout(p, l, lds);
    GBAR();
    phase_up(p, l, lds);
    GBAR();
    phase_down(p, l, lds);
    GBAR();
  }
}

extern "C" void kernel_launch(void* const* d_in, const int* in_sizes, int n_in, void* d_out, int out_size, void* d_ws,
                              size_t ws_size, hipStream_t stream) {
  static int grid_blocks = 0;
  if (!grid_blocks) {
    int dev = 0, cus = 0, per_cu = 0;
    (void)hipGetDevice(&dev);
    (void)hipDeviceGetAttribute(&cus, hipDeviceAttributeMultiprocessorCount, dev);
    (void)hipOccupancyMaxActiveBlocksPerMultiprocessor(&per_cu, fwd_megakernel, NT, 0);
    if (per_cu > 1) per_cu = 1;
    grid_blocks = cus * per_cu;
  }
  if (ws_size < WS_NEED) {
    fprintf(stderr, "workspace too small: %zu < %zu\n", ws_size, WS_NEED);
    return;
  }
  Params p{};
  for (int i = 0; i < 24; ++i) p.in[i] = (const float*)d_in[i];
  p.out = (float*)d_out;
  p.ws = (char*)d_ws;
  (void)hipMemsetAsync((char*)d_ws + O_BAR, 0, SZ_BAR, stream);
  void* args[] = {&p};
  hipError_t e = hipLaunchCooperativeKernel((void*)fwd_megakernel, dim3(grid_blocks), dim3(NT), args, 0, stream);
  if (e != hipSuccess) fprintf(stderr, "cooperative launch failed: %s (grid %d)\n", hipGetErrorString(e), grid_blocks);
}
```

```cpp
#include <hip/hip_runtime.h>
#include <hip/hip_cooperative_groups.h>
#include <cstdio>
namespace cg = cooperative_groups;

typedef _Float16 h16;
typedef __attribute__((ext_vector_type(8))) _Float16 h16x8;
typedef __attribute__((ext_vector_type(4))) float f32x4;

constexpr int NT = 512;
constexpr int NW = NT / 64;
constexpr int BATCH = 4, SEQ = 8192, NTOK = BATCH * SEQ, DM = 1024, DEPTH = 4, IW = 1676, IWP = 1792, DFF = 4096;
constexpr int OFF_U = 512, OFF_QC = 1024, OFF_KVC = 1280, OFF_GC = 1664;
constexpr int NCMP = 511;
constexpr float EPS = 1e-6f;

constexpr size_t SZ_WIN = (size_t)IWP * DM * 2, SZ_WGLU = (size_t)1024 * 512 * 2, SZ_WOUT = (size_t)DM * DM * 2,
                 SZ_WUP = (size_t)DFF * DM * 2, SZ_WDN = (size_t)DM * DFF * 2;
constexpr size_t O_WIN = 0;
constexpr size_t O_WGLU = O_WIN + DEPTH * SZ_WIN;
constexpr size_t O_WOUT = O_WGLU + DEPTH * SZ_WGLU;
constexpr size_t O_WUP = O_WOUT + DEPTH * SZ_WOUT;
constexpr size_t O_WDN = O_WUP + DEPTH * SZ_WUP;
constexpr size_t O_XB = O_WDN + DEPTH * SZ_WDN;
constexpr size_t O_SSQ = O_XB + (size_t)NTOK * DM * 2;
constexpr size_t O_SSQB = O_SSQ + (size_t)NTOK * 16 * 4;
constexpr size_t O_KCMP = O_SSQB + (size_t)NTOK * 16 * 4;
constexpr size_t O_VCMP = O_KCMP + (size_t)BATCH * 512 * 64 * 4;
constexpr size_t O_ABAR = O_VCMP + (size_t)BATCH * 512 * 64 * 4;
constexpr size_t O_BBAR = O_ABAR + (size_t)DEPTH * 32 * 64 * 8;
constexpr size_t O_BIAS1 = O_BBAR + (size_t)DEPTH * 32 * 64 * 16 * 8;
constexpr size_t O_LUT = O_BIAS1 + (size_t)DEPTH * 2 * 128 * 4;
constexpr size_t O_AT = O_LUT + 8192 * 4;
constexpr size_t O_KTAB = O_AT + (size_t)128 * 64 * 8;
constexpr size_t SZ_KTAB = (size_t)65 * 256 * 2;
constexpr size_t O_W1 = O_KTAB + 128 * SZ_KTAB;
constexpr size_t SZ_W13 = (size_t)128 * 1024 * 2;
constexpr size_t O_W3 = O_W1 + 128 * SZ_W13;
constexpr size_t O_W1T = O_W3 + 128 * SZ_W13;
constexpr size_t O_W2T = O_W1T + (size_t)8 * 128 * 2048 * 2;
constexpr size_t O_B1P = O_W2T + (size_t)8 * 64 * 128 * 2;
constexpr size_t O_BAR = (O_B1P + (size_t)8 * 32 * 128 * 4 + 255) / 256 * 256;
constexpr size_t SZ_BAR = 3456 * 4;
constexpr size_t O_BIG = (O_BAR + SZ_BAR + 255) / 256 * 256;
constexpr size_t O_APOW = O_BIG;
constexpr size_t O_P = O_BIG;
constexpr size_t O_Z = O_P + (size_t)NTOK * IWP * 2;
constexpr size_t O_OB = O_Z + (size_t)NTOK * 512 * 2;
constexpr size_t O_OAC = O_OB + (size_t)512 * 2;
constexpr size_t O_E = O_OB + (size_t)NTOK * 1024 * 2;
constexpr size_t O_HID = O_BIG;
constexpr size_t WS_NEED = O_BIG + (size_t)NTOK * DFF * 2;

struct Params {
  const float* in[24];
  float* out;
  char* ws;
};

__device__ __forceinline__ char* WS(const Params& p) {
  int z;
  asm volatile("s_mov_b32 %0, 0" : "=s"(z));
  return p.ws + z;
}
__device__ __forceinline__ int opaque_tid() {
  int t = threadIdx.x;
  asm volatile("" : "+v"(t));
  return t;
}
template <int CTRL>
__device__ __forceinline__ float dppf(float v) {
  return __int_as_float(__builtin_amdgcn_update_dpp(0, __float_as_int(v), CTRL, 0xF, 0xF, true));
}
__device__ __forceinline__ float sum16(float v) {
  v += dppf<0xB1>(v); v += dppf<0x4E>(v); v += dppf<0x141>(v); v += dppf<0x140>(v);
  return v;
}
__device__ __forceinline__ float max16(float v) {
  v = fmaxf(v, dppf<0xB1>(v)); v = fmaxf(v, dppf<0x4E>(v)); v = fmaxf(v, dppf<0x141>(v)); v = fmaxf(v, dppf<0x140>(v));
  return v;
}
__device__ __forceinline__ float xor16(float v) { return __int_as_float(__builtin_amdgcn_ds_swizzle(__float_as_int(v), 0x401F)); }
__device__ __forceinline__ float rdlane_c(float v, int l) { return __int_as_float(__builtin_amdgcn_readlane(__float_as_int(v), l)); }
__device__ __forceinline__ float wave_sum(float v) {
  v = sum16(v); v += xor16(v);
  return rdlane_c(v, 0) + rdlane_c(v, 32);
}
__device__ __forceinline__ float gelu_tanh(float x) {
  float u = 0.7978845608028654f * (x + 0.044715f * x * x * x);
  return 0.5f * x * (1.f + tanhf(u));
}
__device__ __forceinline__ float sigmoidf(float x) { return 1.f / (1.f + __expf(-x)); }
__device__ __forceinline__ float rdlane(float v, int l) {
  return __int_as_float(__builtin_amdgcn_readlane(__float_as_int(v), l));
}

template <class SrcF>
__device__ __forceinline__ void conv_tile(SrcF src, h16* dst, int ldo, int n0, int k0, float* tile) {
  int tid = opaque_tid();
  for (int idx = tid; idx < 4096; idx += NT) {
    int kk = idx >> 6, nn = idx & 63;
    tile[kk * 65 + nn] = src(k0 + kk, n0 + nn);
  }
  __syncthreads();
  for (int idx = tid; idx < 4096; idx += NT) {
    int nn = idx >> 6, kk = idx & 63;
    dst[(long)(n0 + nn) * ldo + k0 + kk] = (h16)tile[kk * 65 + nn];
  }
  __syncthreads();
}

__device__ __forceinline__ void phase0(const Params& p, float* lds) {
  const int tid = opaque_tid();
  constexpr int T_IN = (IWP / 64) * (DM / 64);
  constexpr int T_GLU = 16 * 8;
  constexpr int T_OUT = 16 * 16;
  constexpr int T_UP = 64 * 16;
  constexpr int T_DN = 16 * 64;
  constexpr int T_L = T_IN + T_GLU + T_OUT + T_UP + T_DN;
  for (int ti = blockIdx.x; ti < DEPTH * T_L; ti += gridDim.x) {
    int l = ti / T_L, r = ti % T_L;
    if (r < T_IN) {
      int nt = r / 16, kt = r % 16;
      const float* w = p.in[2] + (size_t)l * DM * IW;
      const float* g = p.in[1] + l * DM;
      conv_tile([&](int k, int sl) {
        int n = (sl & ~255) + 64 * ((sl >> 5) & 3) + 32 * ((sl >> 7) & 1) + (sl & 31);
        return n < IW ? w[(long)k * IW + n] * g[k] : 0.f; },
                (h16*)(WS(p) + O_WIN + l * SZ_WIN), DM, nt * 64, kt * 64, lds);
    } else if ((r -= T_IN) < T_GLU) {
      int nt = r / 8, kt = r % 8;
      const float* w = p.in[14] + (size_t)l * 512 * 1024;
      conv_tile([&](int k, int n2) {
        int pn = n2 >> 8, bj = (n2 >> 7) & 1, wc = (n2 >> 5) & 3, nn = (n2 >> 4) & 1, r = n2 & 15;
        int n = (nn ? 512 : 0) + 128 * pn + 64 * bj + 16 * wc + r;
        return w[(long)k * 1024 + n]; },
                (h16*)(WS(p) + O_WGLU + l * SZ_WGLU), 512, nt * 64, kt * 64, lds);
    } else if ((r -= T_GLU) < T_OUT) {
      int nt = r / 16, kt = r % 16;
      const float* w = p.in[20] + (size_t)l * DM * DM;
      const float* g = p.in[19] + l * DM;
      conv_tile([&](int k2, int n) {
        int k = k2 < 512 ? 256 + k2 : (k2 < 768 ? k2 - 512 : k2);
        return w[(long)k * DM + n] * g[k]; },
                (h16*)(WS(p) + O_WOUT + l * SZ_WOUT), DM, nt * 64, kt * 64, lds);
    } else if ((r -= T_OUT) < T_UP) {
      int nt = r / 16, kt = r % 16;
      const float* w = p.in[22] + (size_t)l * DM * DFF;
      const float* g = p.in[21] + l * DM;
      conv_tile([&](int k, int n) { return w[(long)k * DFF + n] * g[k]; },
                (h16*)(WS(p) + O_WUP + l * SZ_WUP), DM, nt * 64, kt * 64, lds);
    } else {
      r -= T_UP;
      int nt = r / 64, kt = r % 64;
      const float* w = p.in[23] + (size_t)l * DFF * DM;
      conv_tile([&](int k, int n) { return w[(long)k * DM + n]; },
                (h16*)(WS(p) + O_WDN + l * SZ_WDN), DFF, nt * 64, kt * 64, lds);
    }
  }
  for (int ti = blockIdx.x; ti < 8 * 66; ti += gridDim.x) {
    int ls = ti / 66, r = ti % 66;
    if (r < 64) {
      int nt = r >> 5, kt = r & 31;
      const float* w = p.in[17] + (size_t)ls * 2048 * 128;
      conv_tile([&](int k, int n) { return w[(long)k * 128 + n]; }, (h16*)(WS(p) + O_W1T) + (size_t)ls * 128 * 2048, 2048, nt * 64, kt * 64, lds);
    } else {
      int kt = r - 64;
      const float* w = p.in[18] + (size_t)ls * 128 * 64;
      conv_tile([&](int k, int n) { return w[(long)k * 64 + n]; }, (h16*)(WS(p) + O_W2T) + (size_t)ls * 64 * 128, 128, 0, kt * 64, lds);
    }
  }
  {
    const int lane = tid & 63;
    const int gw = blockIdx.x * NW + (tid >> 6), nw = gridDim.x * NW;
    const float* x = p.in[0];
    h16* xb = (h16*)(WS(p) + O_XB);
    float* ssq = (float*)(WS(p) + O_SSQ);
    for (int row = gw; row < NTOK; row += nw) {
      const float4* xr = (const float4*)(x + (long)row * DM + lane * 16);
      float s = 0.f;
      h16 hv[16];
      for (int i = 0; i < 4; ++i) {
        float4 v = xr[i];
        s += v.x * v.x + v.y * v.y + v.z * v.z + v.w * v.w;
        hv[i * 4 + 0] = (h16)v.x; hv[i * 4 + 1] = (h16)v.y; hv[i * 4 + 2] = (h16)v.z; hv[i * 4 + 3] = (h16)v.w;
      }
      h16x8* xo = (h16x8*)(xb + (long)row * DM + lane * 16);
      h16x8 o0, o1;
      for (int i = 0; i < 8; ++i) { o0[i] = hv[i]; o1[i] = hv[8 + i]; }
      xo[0] = o0; xo[1] = o1;
      s += dppf<0xB1>(s);
      s += dppf<0x4E>(s);
      if ((lane & 3) == 0) ssq[(long)row * 16 + (lane >> 2)] = s;
    }
  }
  const int gt = blockIdx.x * NT + tid, ngt = gridDim.x * NT;
  for (int i = gt; i < DEPTH * 32 * 64; i += ngt) {
    int l = i / 2048, g = (i / 64) % 32;
    double are = p.in[6][i], aim = p.in[7][i];
    double dt = exp((double)p.in[8][l * 32 + g]);
    double er = exp(are * dt), abr = er * cos(aim * dt), abi = er * sin(aim * dt);
    ((float2*)(WS(p) + O_ABAR))[i] = make_float2((float)abr, (float)abi);
    double nr = abr - 1.0, ni = abi, den = are * are + aim * aim;
    double fr = (nr * are + ni * aim) / den, fi = (ni * are - nr * aim) / den;
    float2* bb = (float2*)(WS(p) + O_BBAR) + (size_t)i * 16;
    for (int q = 0; q < 16; ++q) {
      double br = p.in[9][(size_t)i * 16 + q], bi = p.in[10][(size_t)i * 16 + q];
      bb[q] = make_float2((float)((fr * br - fi * bi) / dt), (float)((fr * bi + fi * br) / dt));
    }
  }
  for (int i = gt; i < 128 * 65 * 64; i += ngt) {
    int n = i & 63, j = (i >> 6) % 65, lg = i / (65 * 64);
    double are = p.in[6][lg * 64 + n], aim = p.in[7][lg * 64 + n];
    double dt = exp((double)p.in[8][lg]);
    double er = exp(are * dt * j), ang = aim * dt * j;
    ((double2*)(WS(p) + O_APOW))[i] = make_double2(er * cos(ang), er * sin(ang));
  }
  for (int i = gt; i < DEPTH * 2 * 128 * 32; i += ngt) {
    int j = i & 127, kc = (i >> 7) & 31, ls = i >> 12;
    const float* pos = p.in[16] + (size_t)ls * 2048 + kc * 64;
    const float* w1 = p.in[17] + ((size_t)ls * 2048 + kc * 64) * 128;
    float a = 0.f;
#pragma unroll 16
    for (int k = 0; k < 64; ++k) a += pos[k] * w1[(long)k * 128 + j];
    ((float*)(WS(p) + O_B1P))[i] = a;
  }
  for (int d = gt; d < 8192; d += ngt) {
    int bk;
    if (d < 16) bk = d;
    else {
      float nf = (float)d;
      int large = 16 + (int)(logf(nf / 16.0f) / 4.1588830833596715f * 16.0f);
      bk = large < 31 ? large : 31;
    }
    ((int*)(WS(p) + O_LUT))[d] = bk;
  }
}

__device__ __forceinline__ void phase0b(const Params& p) {
  const int gt = blockIdx.x * NT + threadIdx.x, ngt = gridDim.x * NT;
  const double2* apow = (const double2*)(WS(p) + O_APOW);
  const float2* bbs = (const float2*)(WS(p) + O_BBAR);
  for (int i = gt; i < 128 * 64 * 64; i += ngt) {
    int tau = i & 63, n = (i >> 6) & 63, lg = i >> 12;
    double2 ap = apow[(lg * 65 + (63 - tau)) * 64 + n];
    const float2* bb = bbs + (size_t)(lg * 64 + n) * 16;
    h16x8 re0, re1, im0, im1;
#pragma unroll
    for (int q = 0; q < 8; ++q) {
      float2 b0 = bb[q], b1 = bb[8 + q];
      re0[q] = (h16)(float)(ap.x * b0.x - ap.y * b0.y);
      im0[q] = (h16)(float)(ap.x * b0.y + ap.y * b0.x);
      re1[q] = (h16)(float)(ap.x * b1.x - ap.y * b1.y);
      im1[q] = (h16)(float)(ap.x * b1.y + ap.y * b1.x);
    }
    h16* W1 = (h16*)(WS(p) + O_W1 + (size_t)lg * SZ_W13);
    *(h16x8*)(W1 + ((size_t)(2 * tau) * 128 + 2 * n) * 8) = re0;
    *(h16x8*)(W1 + ((size_t)(2 * tau) * 128 + 2 * n + 1) * 8) = im0;
    *(h16x8*)(W1 + ((size_t)(2 * tau + 1) * 128 + 2 * n) * 8) = re1;
    *(h16x8*)(W1 + ((size_t)(2 * tau + 1) * 128 + 2 * n + 1) * 8) = im1;
  }
  for (int i = gt; i < 128 * 64 * 16 * 16; i += ngt) {
    int pp = i & 15, kc = (i >> 4) & 15, tau = (i >> 8) & 63, lg = i >> 14;
    h16x8 v;
#pragma unroll
    for (int e = 0; e < 4; ++e) {
      int n = 4 * kc + e;
      double2 ap = apow[(lg * 65 + tau + 1) * 64 + n];
      double cr = p.in[11][((size_t)lg * 16 + pp) * 64 + n], ci = p.in[12][((size_t)lg * 16 + pp) * 64 + n];
      v[2 * e] = (h16)(float)(cr * ap.x - ci * ap.y);
      v[2 * e + 1] = (h16)(float)(-(cr * ap.y + ci * ap.x));
    }
    h16* W3 = (h16*)(WS(p) + O_W3 + (size_t)lg * SZ_W13);
    *(h16x8*)(W3 + ((size_t)((tau * 16 + kc) * 16) + pp) * 8) = v;
  }
  for (int i = gt; i < 128 * 65 * 16; i += ngt) {
    int pp = i & 15, slot = (i >> 4) % 65, lg = i / (65 * 16);
    float acc[16];
#pragma unroll
    for (int q = 0; q < 16; ++q) acc[q] = 0.f;
    if (slot > 0) {
      for (int n = 0; n < 64; ++n) {
        double2 ap = apow[(lg * 65 + slot - 1) * 64 + n];
        double cr = p.in[11][((size_t)lg * 16 + pp) * 64 + n], ci = p.in[12][((size_t)lg * 16 + pp) * 64 + n];
        float xr = (float)(cr * ap.x - ci * ap.y), xi = (float)(cr * ap.y + ci * ap.x);
        const float2* bb = bbs + (size_t)(lg * 64 + n) * 16;
#pragma unroll
        for (int q = 0; q < 16; ++q) { float2 b = bb[q]; acc[q] += xr * b.x - xi * b.y; }
      }
    }
    h16x8 v0, v1;
#pragma unroll
    for (int q = 0; q < 8; ++q) { v0[q] = (h16)acc[q]; v1[q] = (h16)acc[8 + q]; }
    h16* kt = (h16*)(WS(p) + O_KTAB + (size_t)lg * SZ_KTAB) + slot * 256 + pp * 16;
    *(h16x8*)kt = v0;
    *(h16x8*)(kt + 8) = v1;
  }
  for (int i = gt; i < 128 * 64; i += ngt) {
    double2 ap = apow[((i >> 6) * 65 + 64) * 64 + (i & 63)];
    ((float2*)(WS(p) + O_AT))[i] = make_float2((float)ap.x, (float)ap.y);
  }
  for (int i = gt; i < DEPTH * 2 * 128; i += ngt) {
    const float* pp = (const float*)(WS(p) + O_B1P) + (size_t)(i >> 7) * 32 * 128 + (i & 127);
    float a = 0.f;
    for (int kc = 0; kc < 32; ++kc) a += pp[kc * 128];
    ((float*)(WS(p) + O_BIAS1))[i] = a;
  }
}

__device__ __forceinline__ void ssm_endstates(const Params& p, int l) {
  const int tid = opaque_tid(), lane = tid & 63, w = tid >> 6;
  const int gw = blockIdx.x * NW + w, nw = gridDim.x * NW;
  const h16* P = (const h16*)(WS(p) + O_P);
  float* E = (float*)(WS(p) + O_E);
  for (int unit = gw; unit < 32 * 32; unit += nw) {
    int g = unit >> 5, ctile = unit & 31;
    const h16* W1 = (const h16*)(WS(p) + O_W1 + (size_t)(l * 32 + g) * SZ_W13);
    int gch = ctile * 16 + (lane & 15);
    const h16* ub = P + (size_t)gch * 64 * IWP + OFF_U + g * 16 + ((lane >> 4) & 1) * 8 + (size_t)(lane >> 5) * IWP;
    f32x4 acc[8];
#pragma unroll
    for (int mt = 0; mt < 8; ++mt) acc[mt] = f32x4{0.f, 0.f, 0.f, 0.f};
#pragma unroll 2
    for (int ks = 0; ks < 32; ++ks) {
      h16x8 B = *(const h16x8*)(ub + (size_t)(ks * 2) * IWP);
#pragma unroll
      for (int mt = 0; mt < 8; ++mt) {
        h16x8 A = *(const h16x8*)(W1 + ((size_t)(ks * 4 + (lane >> 4)) * 128 + mt * 16 + (lane & 15)) * 8);
        acc[mt] = __builtin_amdgcn_mfma_f32_16x16x32_f16(A, B, acc[mt], 0, 0, 0);
      }
    }
#pragma unroll
    for (int mt = 0; mt < 8; ++mt)
      *(f32x4*)(E + ((size_t)gch * 32 + g) * 128 + mt * 16 + (lane >> 4) * 4) = acc[mt];
  }
}

constexpr int BU_PITCH = 1032, BS_PITCH = 136;
constexpr int SSMY_LDS = 65 * 512 + 16 * BU_PITCH * 2 + 16 * BS_PITCH * 2;
__device__ __forceinline__ void ssm_outputs(const Params& p, int l, char* lds) {
  const int tid = opaque_tid(), lane = tid & 63, w = tid >> 6;
  h16* Kt = (h16*)lds;
  h16* Bu = (h16*)(lds + 65 * 512);
  h16* Bs = (h16*)(lds + 65 * 512 + 16 * BU_PITCH * 2);
  const h16* P = (const h16*)(WS(p) + O_P);
  const float* E = (const float*)(WS(p) + O_E);
  h16* Z = (h16*)(WS(p) + O_Z);
  for (int unit = blockIdx.x; unit < 1024; unit += gridDim.x) {
    const int g = unit & 31, bc = unit >> 5, b = bc >> 3, ct = bc & 7;
    const int lg = l * 32 + g;
    __syncthreads();
    if (w == 0) {
      float2 at = ((const float2*)(WS(p) + O_AT))[lg * 64 + lane];
      const float2* Eb = (const float2*)E + ((size_t)(b * 128) * 32 + g) * 64 + lane;
      float sr = 0.f, si = 0.f;
      const int c0 = ct * 16;
#pragma unroll 8
      for (int c = 0; c < c0; ++c) {
        float2 e = Eb[(size_t)c * 2048];
        float nr = at.x * sr - at.y * si + e.x, ni = at.x * si + at.y * sr + e.y;
        sr = nr; si = ni;
      }
#pragma unroll
      for (int i = 0; i < 16; ++i) {
        Bs[i * BS_PITCH + 2 * lane] = (h16)sr;
        Bs[i * BS_PITCH + 2 * lane + 1] = (h16)si;
        float2 e = Eb[(size_t)(c0 + i) * 2048];
        float nr = at.x * sr - at.y * si + e.x, ni = at.x * si + at.y * sr + e.y;
        sr = nr; si = ni;
      }
    } else {
      const int t2 = tid - 64, n2 = NT - 64;
      const h16x8* ks = (const h16x8*)(WS(p) + O_KTAB + (size_t)lg * SZ_KTAB);
      for (int i = t2; i < 65 * 32; i += n2) ((h16x8*)Kt)[i] = ks[i];
      for (int i = t2; i < 2048; i += n2) {
        int tk = i >> 1, hf = i & 1;
        h16x8 v = *(const h16x8*)(P + ((size_t)b * SEQ + ct * 1024 + tk) * IWP + OFF_U + g * 16 + hf * 8);
        *(h16x8*)(Bu + (tk >> 6) * BU_PITCH + (tk & 63) * 16 + hf * 8) = v;
      }
    }
    __syncthreads();
    const float dt = expf(p.in[8][lg]);
    const int col = lane & 15, hi = lane >> 5, qh = (lane >> 4) & 1, p0 = (lane >> 4) * 4;
    const h16* W3 = (const h16*)(WS(p) + O_W3 + (size_t)lg * SZ_W13);
    float dsk[4];
    for (int j = 0; j < 4; ++j) dsk[j] = p.in[13][l * 512 + g * 16 + p0 + j];
    for (int r = 0; r < 64 / NW; ++r) {
      const int base = (r >> 1) * 2 * NW;
      const int tau = (r & 1) ? base + 2 * NW - 1 - w : base + w;
      f32x4 acc = {0.f, 0.f, 0.f, 0.f};
      const int nks = tau / 2 + 1;
      h16x8 A3[4];
#pragma unroll
      for (int ks = 0; ks < 4; ++ks)
        A3[ks] = *(const h16x8*)(W3 + ((size_t)((tau * 16 + ks * 4 + (lane >> 4)) * 16) + (lane & 15)) * 8);
      for (int i = 0; i < nks; ++i) {
        int j = tau - (2 * i + hi);
        h16x8 A = *(const h16x8*)(Kt + (j + 1) * 256 + (lane & 15) * 16 + qh * 8);
        h16x8 B = *(const h16x8*)(Bu + col * BU_PITCH + (2 * i + hi) * 16 + qh * 8);
        acc = __builtin_amdgcn_mfma_f32_16x16x32_f16(A, B, acc, 0, 0, 0);
      }
#pragma unroll
      for (int ks = 0; ks < 4; ++ks) {
        h16x8 B = *(const h16x8*)(Bs + col * BS_PITCH + ks * 32 + (lane >> 4) * 8);
        acc = __builtin_amdgcn_mfma_f32_16x16x32_f16(A3[ks], B, acc, 0, 0, 0);
      }
      const h16* up = Bu + col * BU_PITCH + tau * 16 + p0;
      size_t tok = ((size_t)b * 128 + ct * 16 + col) * 64 + tau;
      h16 zz[4];
      for (int j = 0; j < 4; ++j) zz[j] = (h16)gelu_tanh(dt * acc[j] + dsk[j] * (float)up[j]);
      typedef __attribute__((ext_vector_type(4))) _Float16 h16x4;
      h16x4 zv = {zz[0], zz[1], zz[2], zz[3]};
      *(h16x4*)(Z + tok * 512 + g * 16 + p0) = zv;
    }
  }
}

#define LAS __attribute__((address_space(3)))
typedef _Float16 h16x4 __attribute__((ext_vector_type(4)));
#define XB_TMO      128
#define XB_XCNT(j)  (256  + 64 * (j))
#define XB_XSUB(j)  (1280 + 64 * (j))
#define XB_XGEN(j)  (2304 + 64 * (j))
#define XB_TOP      3328
#define XB_TOPGEN   3392
#define XCD_BAR_WORDS 3456
#define XB_SPIN_CAP (1u << 18)

__device__ __forceinline__ unsigned xb_ld(unsigned* p)              { return __hip_atomic_load(p, __ATOMIC_RELAXED, __HIP_MEMORY_SCOPE_AGENT); }
__device__ __forceinline__ unsigned xb_add(unsigned* p, unsigned v) { return __hip_atomic_fetch_add(p, v, __ATOMIC_RELAXED, __HIP_MEMORY_SCOPE_AGENT); }
__device__ __forceinline__ unsigned xb_xcc_id() { return (unsigned)__builtin_amdgcn_s_getreg((3 << 11) | 20) & 0xFu; }
#define XB_SPIN(cond, bar) do { unsigned _sp = 0; while (cond) { __builtin_amdgcn_s_sleep(1); \
    if ((++_sp & 255u) == 0u) { if (xb_ld(&(bar)[XB_TMO])) break; if (_sp > XB_SPIN_CAP) { atomicAdd(&(bar)[XB_TMO], 1u); break; } } } } while (0)

struct XcdBarrier {
    unsigned* bar; unsigned x;
    volatile LAS unsigned* st;
};

__device__ __forceinline__ XcdBarrier xcd_barrier_post(unsigned* bar, volatile LAS unsigned* st) {
    XcdBarrier b; b.bar = bar; b.x = xb_xcc_id(); b.st = st;
    if (threadIdx.x == 0) (void)xb_add(&bar[XB_XCNT(b.x)], 1u);
    return b;
}
__device__ __forceinline__ void xcd_barrier_complete(unsigned* bar, unsigned x, unsigned& nloc, unsigned& nx) {
    const unsigned G = gridDim.x * gridDim.y * gridDim.z;
    unsigned sum, cnt, mine, sp = 0u;
    for (;;) {
        sum = 0u; cnt = 0u; mine = 0u;
#pragma unroll
        for (unsigned j = 0; j < 16; ++j) { const unsigned c = xb_ld(&bar[XB_XCNT(j)]); sum += c; cnt += (c > 0u) ? 1u : 0u; mine = (j == x) ? c : mine; }
        if (sum == G) break;
        __builtin_amdgcn_s_sleep(1);
        if ((++sp & 255u) == 0u) { if (xb_ld(&bar[XB_TMO])) break; if (sp > XB_SPIN_CAP) { atomicAdd(&bar[XB_TMO], 1u); break; } }
    }
    nloc = mine > 0u ? mine : 1u; nx = cnt > 0u ? cnt : 1u;
}

__device__ __forceinline__ void xcd_barrier(const XcdBarrier& b) {
    asm volatile("s_waitcnt vmcnt(0)" ::: "memory");
    __syncthreads();
    if (threadIdx.x == 0) {
        unsigned* bar = b.bar;
        __builtin_amdgcn_s_waitcnt(0);
        unsigned nloc = b.st[0], nx = b.st[1];
        if (nloc == 0u) { xcd_barrier_complete(bar, b.x, nloc, nx); b.st[0] = nloc; b.st[1] = nx; }
        const unsigned old = xb_add(&bar[XB_XSUB(b.x)], 1u);
        const unsigned gen = old / nloc;
        if (old + 1u == (gen + 1u) * nloc) {
            __builtin_amdgcn_fence(__ATOMIC_RELEASE, "agent");
            asm volatile("s_waitcnt vmcnt(0)" ::: "memory");
            const unsigned og = xb_add(&bar[XB_TOP], 1u);
            const unsigned tg = og / nx;
            if (og + 1u == (tg + 1u) * nx) xb_add(&bar[XB_TOPGEN], 1u);
            else XB_SPIN(xb_ld(&bar[XB_TOPGEN]) == tg, bar);
            __builtin_amdgcn_fence(__ATOMIC_ACQUIRE, "agent");
            xb_add(&bar[XB_XGEN(b.x)], 1u);
            asm volatile("s_waitcnt vmcnt(0)" ::: "memory");
        } else {
            XB_SPIN(xb_ld(&bar[XB_XGEN(b.x)]) == gen, bar);
            __builtin_amdgcn_fence(__ATOMIC_ACQUIRE, "agent");
            asm volatile("s_waitcnt vmcnt(0)" ::: "memory");
        }
    }
    __syncthreads();
}


namespace g8 {
constexpr int BM = 256, BK = 64, HALF = 128, HTB = HALF * BK * 2, STAGE_BYTES = 8 * HTB, NXCD = 8, WGM = 8;
__device__ __forceinline__ int lds_byte(int r, int c) {
  const int st = (r >> 4) * 2 + (c >> 5), rr = r & 15, cc = c & 31, ob = rr * 64 + cc * 2;
  return st * 1024 + (ob ^ (((ob >> 9) & 1) << 5));
}
__device__ __forceinline__ void stage_rc(int b, int& R, int& C) {
  const int st = b / 1024, sb = b % 1024, swz = sb ^ (((sb >> 9) & 1) << 5);
  R = (st >> 1) * 16 + swz / 64;
  C = (st & 1) * 32 + (swz % 64) / 2;
}
struct Unit { int pm, pn; };
struct Order {
  int nM, nN, nwg, G, c;
  __device__ void init(int M, int N, int G_, int c_) { nM = M / BM; nN = N / BM; nwg = nM * nN; G = G_; c = c_; }
  __device__ bool next(int i, Unit& u) const {
    const long L = (long)i * G + c;
    if (L >= nwg) return false;
    int wgid = (int)L;
    { const int q = nwg / NXCD, r = nwg % NXCD, xcd = wgid % NXCD, off = wgid / NXCD; wgid = (xcd < r ? xcd * (q + 1) : r * (q + 1) + (xcd - r) * q) + off; }
    const int nig = WGM * nN, gid = wgid / nig, fm = gid * WGM, gsz = (nM - fm) < WGM ? (nM - fm) : WGM;
    u.pm = fm + ((wgid % nig) % gsz);
    u.pn = (wgid % nig) / gsz;
    return true;
  }
};
template <class Epi>
__device__ __forceinline__ void gemm_phase(LAS unsigned char* lds, const h16* A, const h16* Bt, int K, const Order& S, const Epi& E) {
  const int tid = opaque_tid(), wid = __builtin_amdgcn_readfirstlane(tid >> 6), lane = tid & 63, wr = wid >> 2, wc = wid & 3, fr = lane & 15, fq = lane >> 4;
  const int nt = K / BK;
  unsigned voffA[2];
#pragma unroll
  for (int i = 0; i < 2; ++i) { int R, C; stage_rc(tid * 16 + i * 8192, R, C); voffA[i] = (unsigned)(R * K + C) * 2u; }
  const size_t kstep = (size_t)(BK * 2);
  const size_t hstep = (size_t)HALF * K * 2;
  const size_t tstep = 2 * hstep;
  const unsigned ldsw = (unsigned)wid * 1024u;
  const int aoff = lds_byte(wr * 64 + fr, fq * 8), boff = lds_byte(wc * 32 + fr, fq * 8);
#define G8_SA(b, h) (((b) * 2 + (h)) * HTB)
#define G8_SB(b, h) ((4 + (b) * 2 + (h)) * HTB)
#define G8_STAGE(bufoff, gbase) do { _Pragma("unroll") for (int _i = 0; _i < 2; ++_i) \
    __builtin_amdgcn_global_load_lds((const unsigned*)((const char*)(gbase) + voffA[_i]), (LAS unsigned*)(lds + (bufoff) + ldsw + _i * 8192), 16, 0, 0); } while (0)
#define G8_LDA(dst, b, h) do { _Pragma("unroll") for (int m = 0; m < 4; ++m) _Pragma("unroll") for (int k = 0; k < 2; ++k) dst[m][k] = *(const LAS h16x8*)(lds + G8_SA(b, h) + aoff + m * 2048 + k * 1024); } while (0)
#define G8_LDB(dst, b, h) do { _Pragma("unroll") for (int n = 0; n < 2; ++n) _Pragma("unroll") for (int k = 0; k < 2; ++k) dst[n][k] = *(const LAS h16x8*)(lds + G8_SB(b, h) + boff + n * 2048 + k * 1024); } while (0)
#define G8_MMA(ai, bj, At, Bt_) do { __builtin_amdgcn_s_setprio(1); _Pragma("unroll") for (int m = 0; m < 4; ++m) _Pragma("unroll") for (int n = 0; n < 2; ++n) _Pragma("unroll") for (int k = 0; k < 2; ++k) \
    acc[ai][bj][m][n] = __builtin_amdgcn_mfma_f32_16x16x32_f16(Bt_[n][k], At[m][k], acc[ai][bj][m][n], 0, 0, 0); __builtin_amdgcn_s_setprio(0); } while (0)
#define G8_WAIT_V(n) asm volatile("s_waitcnt vmcnt(" #n ")" ::: "memory")
#define G8_WAIT_L(n) asm volatile("s_waitcnt lgkmcnt(" #n ")" ::: "memory")
#define G8_BAR __builtin_amdgcn_s_barrier()
#define G8_SCHED __builtin_amdgcn_sched_barrier(0)
  Unit cur, nxt;
  int ui = 0;
  if (!S.next(0, cur)) return;
  f32x4 acc[2][2][4][2];
#pragma unroll
  for (int a = 0; a < 2; ++a)
#pragma unroll
    for (int b = 0; b < 2; ++b)
#pragma unroll
      for (int m = 0; m < 4; ++m)
#pragma unroll
        for (int n = 0; n < 2; ++n) acc[a][b][m][n] = (f32x4){0.f, 0.f, 0.f, 0.f};
  h16x8 At[4][2], B0[2][2], B1[2][2];
  const char* cA = (const char*)A + (size_t)cur.pm * tstep;
  const char* cB = (const char*)Bt + (size_t)cur.pn * tstep;
  G8_STAGE(G8_SB(0, 0), cB); G8_STAGE(G8_SA(0, 0), cA); G8_STAGE(G8_SB(0, 1), cB + hstep); G8_STAGE(G8_SA(0, 1), cA + hstep);
  if (wr == 1) G8_BAR;
  G8_WAIT_V(4); G8_BAR;
  G8_STAGE(G8_SB(1, 0), cB + kstep); G8_STAGE(G8_SA(1, 0), cA + kstep); G8_STAGE(G8_SB(1, 1), cB + hstep + kstep);
  G8_WAIT_V(6); G8_BAR;
  for (;;) {
    const bool has_next = S.next(ui + 1, nxt);
    const char* nA = has_next ? (const char*)A + (size_t)nxt.pm * tstep : cA;
    const char* nB = has_next ? (const char*)Bt + (size_t)nxt.pn * tstep : cB;
    for (int t = 0; t < nt; t += 2) {
      const bool last = (t == nt - 2);
      const char* a1 = cA + (size_t)(t + 1) * kstep;
      const char* a2 = last ? nA : cA + (size_t)(t + 2) * kstep;
      const char* b2 = last ? nB : cB + (size_t)(t + 2) * kstep;
      const char* a3 = a2 + kstep;
      const char* b3 = b2 + kstep;
      if (Epi::MID_T >= 0 && t == Epi::MID_T) E.mid(acc, ui, wr, fr);
      G8_LDB(B0, 0, 0); G8_SCHED; G8_LDA(At, 0, 0); G8_STAGE(G8_SA(1, 1), a1 + hstep);
      G8_WAIT_L(8); G8_BAR; G8_WAIT_L(0); G8_MMA(0, 0, At, B0); G8_BAR; G8_SCHED;
      G8_LDB(B1, 0, 1); G8_STAGE(G8_SB(0, 0), b2);
      G8_BAR; G8_WAIT_L(0); G8_MMA(0, 1, At, B1); G8_BAR;
      G8_LDA(At, 0, 1); G8_STAGE(G8_SA(0, 0), a2);
      G8_BAR; G8_WAIT_L(0); G8_MMA(1, 0, At, B0); G8_BAR; G8_SCHED;
      G8_STAGE(G8_SB(0, 1), b2 + hstep);
      G8_WAIT_V(6); G8_BAR; G8_MMA(1, 1, At, B1); G8_BAR;
      G8_LDB(B0, 1, 0); G8_SCHED; G8_LDA(At, 1, 0); G8_STAGE(G8_SA(0, 1), a2 + hstep);
      G8_WAIT_L(8); G8_BAR; G8_WAIT_L(0); G8_MMA(0, 0, At, B0); G8_BAR; G8_SCHED;
      G8_LDB(B1, 1, 1); G8_STAGE(G8_SB(1, 0), b3);
      G8_BAR; G8_WAIT_L(0); G8_MMA(0, 1, At, B1); G8_BAR;
      G8_LDA(At, 1, 1); G8_STAGE(G8_SA(1, 0), a3);
      G8_BAR; G8_WAIT_L(0); G8_MMA(1, 0, At, B0); G8_BAR; G8_SCHED;
      G8_STAGE(G8_SB(1, 1), b3 + hstep);
      G8_WAIT_V(6); G8_BAR; G8_MMA(1, 1, At, B1); G8_BAR;
    }
    E(acc, cur, ui, wr, wc, fr, fq);
    if (!has_next) break;
#pragma unroll
    for (int a = 0; a < 2; ++a)
#pragma unroll
      for (int b = 0; b < 2; ++b)
#pragma unroll
        for (int m = 0; m < 4; ++m)
#pragma unroll
          for (int n = 0; n < 2; ++n) acc[a][b][m][n] = (f32x4){0.f, 0.f, 0.f, 0.f};
    cur = nxt; cA = nA; cB = nB; ++ui;
  }
  G8_WAIT_V(0);
  if (wr == 0) G8_BAR;
  G8_BAR;
#undef G8_SA
#undef G8_SB
#undef G8_STAGE
#undef G8_LDA
#undef G8_LDB
#undef G8_MMA
#undef G8_WAIT_V
#undef G8_WAIT_L
#undef G8_BAR
#undef G8_SCHED
}
}

constexpr int RSL_OFF = g8::STAGE_BYTES;
constexpr int LDS_GEMM = g8::STAGE_BYTES + 8 * 256 * 4;

__device__ __forceinline__ void fill_rowscales(float* rsl, const float* ssq, float inv_n, const g8::Order& S) {
  const int tid = opaque_tid();
  g8::Unit u;
  __syncthreads();
  for (int i = 0; S.next(i, u); ++i) {
    if (tid < 256) {
      const float4* s4 = (const float4*)(ssq + (size_t)(u.pm * 256 + tid) * 16);
      float s = 0.f;
      for (int k = 0; k < 4; ++k) { float4 v = s4[k]; s += v.x + v.y + v.z + v.w; }
      rsl[i * 256 + tid] = rsqrtf(s * inv_n + EPS);
    }
  }
  __syncthreads();
}

__device__ __forceinline__ h16x4 pack4(float a, float b, float c, float d) { h16x4 v = {(h16)a, (h16)b, (h16)c, (h16)d}; return v; }

struct EpiIn {
  static constexpr int MID_T = -1;
  __device__ __forceinline__ void mid(f32x4 (&)[2][2][4][2], int, int, int) const {}
  h16* P; const float* rsl; const float* qkg;
  __device__ __forceinline__ void operator()(const f32x4 (&acc)[2][2][4][2], const g8::Unit& u, int ui, int wr, int wc, int fr, int fq) const {
    const int hs = u.pn * 4 + wc;
    int gi = -1;
    if (hs < 4) gi = 0; else if (hs < 6) gi = 1; else if (hs >= 16 && hs < 20) gi = 2; else if (hs == 22) gi = 4; else if (hs == 24) gi = 5;
    const bool gate = (hs == 26);
#pragma unroll
    for (int ai = 0; ai < 2; ++ai)
#pragma unroll
      for (int m = 0; m < 4; ++m) {
        const int rl = 128 * ai + 64 * wr + 16 * m + fr;
        float r = rsl[ui * 256 + rl];
        if (gi >= 0) {
          float ss = 0.f;
#pragma unroll
          for (int bj = 0; bj < 2; ++bj)
#pragma unroll
            for (int n = 0; n < 2; ++n)
#pragma unroll
              for (int j = 0; j < 4; ++j) ss += acc[ai][bj][m][n][j] * acc[ai][bj][m][n][j];
          ss += xor16(ss);
          ss += __shfl_xor(ss, 32);
          r *= rsqrtf(ss * r * r * (1.f / 64.f) + EPS);
        }
        h16* rowp = P + (size_t)(u.pm * 256 + rl) * IWP + 64 * hs + 4 * fq;
#pragma unroll
        for (int bj = 0; bj < 2; ++bj)
#pragma unroll
          for (int n = 0; n < 2; ++n) {
            f32x4 v = acc[ai][bj][m][n] * r;
            if (gi >= 0) {
              const float4 g4 = *(const float4*)(qkg + gi * 64 + 32 * bj + 16 * n + 4 * fq);
              v[0] *= g4.x; v[1] *= g4.y; v[2] *= g4.z; v[3] *= g4.w;
            } else if (gate) {
#pragma unroll
              for (int j = 0; j < 4; ++j) v[j] = (32 * bj + 16 * n + 4 * fq + j) < 12 ? sigmoidf(v[j]) : 0.f;
            }
            *(h16x4*)(rowp + 32 * bj + 16 * n) = pack4(v[0], v[1], v[2], v[3]);
          }
      }
  }
};

struct EpiGlu {
  static constexpr int MID_T = -1;
  __device__ __forceinline__ void mid(f32x4 (&)[2][2][4][2], int, int, int) const {}
  h16* OB; float* ssqb; const float* gb;
  __device__ __forceinline__ void operator()(const f32x4 (&acc)[2][2][4][2], const g8::Unit& u, int ui, int wr, int wc, int fr, int fq) const {
    const int ocb = 128 * u.pn + 16 * wc + 4 * fq;
    float4 ba[2], bb[2];
#pragma unroll
    for (int bj = 0; bj < 2; ++bj) { ba[bj] = *(const float4*)(gb + ocb + 64 * bj); bb[bj] = *(const float4*)(gb + 512 + ocb + 64 * bj); }
#pragma unroll
    for (int ai = 0; ai < 2; ++ai)
#pragma unroll
      for (int m = 0; m < 4; ++m) {
        const size_t row = (size_t)u.pm * 256 + 128 * ai + 64 * wr + 16 * m + fr;
        float ss = 0.f;
#pragma unroll
        for (int bj = 0; bj < 2; ++bj) {
          const f32x4 a = acc[ai][bj][m][0], b = acc[ai][bj][m][1];
          float o0 = (a[0] + ba[bj].x) * sigmoidf(b[0] + bb[bj].x);
          float o1 = (a[1] + ba[bj].y) * sigmoidf(b[1] + bb[bj].y);
          float o2 = (a[2] + ba[bj].z) * sigmoidf(b[2] + bb[bj].z);
          float o3 = (a[3] + ba[bj].w) * sigmoidf(b[3] + bb[bj].w);
          *(h16x4*)(OB + row * 1024 + ocb + 64 * bj) = pack4(o0, o1, o2, o3);
          ss += o0 * o0 + o1 * o1 + o2 * o2 + o3 * o3;
        }
        ss += xor16(ss);
        ss += __shfl_xor(ss, 32);
        if (fq == 0) ssqb[row * 16 + u.pn * 4 + wc] = ss;
      }
  }
};

struct EpiRes {
  static constexpr int MID_T = -1;
  __device__ __forceinline__ void mid(f32x4 (&)[2][2][4][2], int, int, int) const {}
  float* xo; const float* xsrc; h16* xb; float* ssq;
  __device__ __forceinline__ void operator()(const f32x4 (&acc)[2][2][4][2], const g8::Unit& u, int ui, int wr, int wc, int fr, int fq) const {
#pragma unroll
    for (int ai = 0; ai < 2; ++ai)
#pragma unroll
      for (int m = 0; m < 4; ++m) {
        const size_t row = (size_t)u.pm * 256 + 128 * ai + 64 * wr + 16 * m + fr;
        const size_t base = row * DM + 256 * u.pn + 32 * wc + 4 * fq;
        float ss = 0.f;
#pragma unroll
        for (int bj = 0; bj < 2; ++bj)
#pragma unroll
          for (int n = 0; n < 2; ++n) {
            const size_t idx = base + 128 * bj + 16 * n;
            const float4 xv = *(const float4*)(xsrc + idx);
            const f32x4 a = acc[ai][bj][m][n];
            const float x0 = xv.x + a[0], x1 = xv.y + a[1], x2 = xv.z + a[2], x3 = xv.w + a[3];
            *(float4*)(xo + idx) = make_float4(x0, x1, x2, x3);
            *(h16x4*)(xb + idx) = pack4(x0, x1, x2, x3);
            ss += x0 * x0 + x1 * x1 + x2 * x2 + x3 * x3;
          }
        ss += xor16(ss);
        ss += __shfl_xor(ss, 32);
        if (fq == 0) ssq[row * 16 + u.pn * 4 + wc] = ss;
      }
  }
};

struct EpiOut : EpiRes {
  static constexpr int MID_T = 8;
  const float* rsl;
  __device__ __forceinline__ void mid(f32x4 (&acc)[2][2][4][2], int ui, int wr, int fr) const {
#pragma unroll
    for (int ai = 0; ai < 2; ++ai)
#pragma unroll
      for (int m = 0; m < 4; ++m) {
        const float r = rsl[ui * 256 + 128 * ai + 64 * wr + 16 * m + fr];
#pragma unroll
        for (int bj = 0; bj < 2; ++bj)
#pragma unroll
          for (int n = 0; n < 2; ++n) acc[ai][bj][m][n] *= r;
      }
  }
};

struct EpiUp {
  static constexpr int MID_T = -1;
  __device__ __forceinline__ void mid(f32x4 (&)[2][2][4][2], int, int, int) const {}
  h16* hid; const float* rsl;
  __device__ __forceinline__ void operator()(const f32x4 (&acc)[2][2][4][2], const g8::Unit& u, int ui, int wr, int wc, int fr, int fq) const {
#pragma unroll
    for (int ai = 0; ai < 2; ++ai)
#pragma unroll
      for (int m = 0; m < 4; ++m) {
        const int rl = 128 * ai + 64 * wr + 16 * m + fr;
        const float r = rsl[ui * 256 + rl];
        h16* rowp = hid + (size_t)(u.pm * 256 + rl) * DFF + 256 * u.pn + 32 * wc + 4 * fq;
#pragma unroll
        for (int bj = 0; bj < 2; ++bj)
#pragma unroll
          for (int n = 0; n < 2; ++n) {
            const f32x4 a = acc[ai][bj][m][n];
            float v0 = fmaxf(a[0] * r, 0.f), v1 = fmaxf(a[1] * r, 0.f), v2 = fmaxf(a[2] * r, 0.f), v3 = fmaxf(a[3] * r, 0.f);
            *(h16x4*)(rowp + 128 * bj + 16 * n) = pack4(v0 * v0, v1 * v1, v2 * v2, v3 * v3);
          }
      }
  }
};

__device__ __forceinline__ void phase_gemm1(const Params& p, int l, char* lds) {
  g8::Order S; S.init(NTOK, IWP, gridDim.x, blockIdx.x);
  float* rsl = (float*)(lds + RSL_OFF);
  fill_rowscales(rsl, (const float*)(WS(p) + O_SSQ), 1.f / DM, S);
  EpiIn E{(h16*)(WS(p) + O_P), rsl, p.in[3] + l * 6 * 64};
  g8::gemm_phase((LAS unsigned char*)lds, (const h16*)(WS(p) + O_XB), (const h16*)(WS(p) + O_WIN + l * SZ_WIN), DM, S, E);
}
__device__ __forceinline__ void phase_glu(const Params& p, int l, char* lds) {
  g8::Order S; S.init(NTOK, 1024, gridDim.x, blockIdx.x);
  __syncthreads();
  EpiGlu E{(h16*)(WS(p) + O_OB), (float*)(WS(p) + O_SSQB), p.in[15] + l * 1024};
  g8::gemm_phase((LAS unsigned char*)lds, (const h16*)(WS(p) + O_Z), (const h16*)(WS(p) + O_WGLU + l * SZ_WGLU), 512, S, E);
}
__device__ __forceinline__ void phase_wout(const Params& p, int l, char* lds) {
  g8::Order S; S.init(NTOK, DM, gridDim.x, blockIdx.x);
  float* rsl = (float*)(lds + RSL_OFF);
  fill_rowscales(rsl, (const float*)(WS(p) + O_SSQB), 1.f / 512.f, S);
  EpiOut E;
  E.xo = p.out; E.xsrc = (l == 0) ? p.in[0] : p.out; E.xb = (h16*)(WS(p) + O_XB); E.ssq = (float*)(WS(p) + O_SSQ); E.rsl = rsl;
  g8::gemm_phase((LAS unsigned char*)lds, (const h16*)(WS(p) + O_OB), (const h16*)(WS(p) + O_WOUT + l * SZ_WOUT), DM, S, E);
}
__device__ __forceinline__ void phase_up(const Params& p, int l, char* lds) {
  g8::Order S; S.init(NTOK, DFF, gridDim.x, blockIdx.x);
  float* rsl = (float*)(lds + RSL_OFF);
  fill_rowscales(rsl, (const float*)(WS(p) + O_SSQ), 1.f / DM, S);
  EpiUp E{(h16*)(WS(p) + O_HID), rsl};
  g8::gemm_phase((LAS unsigned char*)lds, (const h16*)(WS(p) + O_XB), (const h16*)(WS(p) + O_WUP + l * SZ_WUP), DM, S, E);
}
__device__ __forceinline__ void phase_down(const Params& p, int l, char* lds) {
  g8::Order S; S.init(NTOK, DM, gridDim.x, blockIdx.x);
  __syncthreads();
  EpiRes E{p.out, p.out, (h16*)(WS(p) + O_XB), (float*)(WS(p) + O_SSQ)};
  g8::gemm_phase((LAS unsigned char*)lds, (const h16*)(WS(p) + O_HID), (const h16*)(WS(p) + O_WDN + l * SZ_WDN), DFF, S, E);
}

constexpr int KP = 72;
enum { M_SWA = 0, M_WIN = 1, M_SEL = 2, M_CMPA = 3, M_CMPB = 4 };
constexpr float LOG2E = 1.4426950408889634f, SCL2 = 0.125f * LOG2E;
struct ColState { float m, l; };
typedef short s16x4v __attribute__((__vector_size__(8)));

__device__ __forceinline__ h16x8 ld_row8(const h16* base, int ld, int row, int nrows, int c8) {
  h16x8 z = {0, 0, 0, 0, 0, 0, 0, 0};
  return (row >= 0 && row < nrows) ? *(const h16x8*)(base + (size_t)row * ld + c8 * 8) : z;
}
__device__ __forceinline__ void st_k(h16* Ks, int row, int c8, h16x8 v) { *(h16x8*)(Ks + row * KP + c8 * 8) = v; }
__device__ __forceinline__ void st_vt(h16* Vt, int row, int c8, h16x8 v) {
#pragma unroll
  for (int e = 0; e < 8; ++e) Vt[(c8 * 8 + e) * KP + row] = v[e];
}
__device__ __forceinline__ float max4q(float v) {
  v = fmaxf(v, xor16(v));
  auto r = __builtin_amdgcn_permlane32_swap(__float_as_int(v), __float_as_int(v), false, false);
  return fmaxf(__int_as_float(r[0]), __int_as_float(r[1]));
}
__device__ __forceinline__ float sum4q(float v) {
  v += xor16(v);
  auto r = __builtin_amdgcn_permlane32_swap(__float_as_int(v), __float_as_int(v), false, false);
  return __int_as_float(r[0]) + __int_as_float(r[1]);
}
__device__ __forceinline__ float quadsum(float v) { v += dppf<0xB1>(v); v += dppf<0x4E>(v); return v; }

template <int MODE, int RGM>
__device__ __forceinline__ void attn_tile(const h16x8 (&Q)[2][2], f32x4 (&O)[2][4], ColState (&st)[2], const h16* Ks,
                                          const h16* Vt, const float* biasT, const int (&tq)[2], int hd, int kbase, bool far,
                                          const bool (&selbit)[2], float (&hq)[2][4], float (&h3)[2][4], const int lane) {
  const int col = lane & 15, q4 = lane >> 4;
  constexpr int DK = (MODE == M_CMPA || MODE == M_CMPB) ? 16 : 1;
  f32x4 S[2][4];
#pragma unroll
  for (int kt = 0; kt < 4; ++kt) {
#pragma unroll
    for (int rg = 0; rg < 2; ++rg) S[rg][kt] = f32x4{0.f, 0.f, 0.f, 0.f};
#pragma unroll
    for (int ks = 0; ks < 2; ++ks) {
      h16x8 Kf = *(const h16x8*)(Ks + (kt * 16 + col) * KP + ks * 32 + q4 * 8);
#pragma unroll
      for (int rg = 0; rg < 2; ++rg)
        if (RGM & (1 << rg)) S[rg][kt] = __builtin_amdgcn_mfma_f32_16x16x32_f16(Kf, Q[rg][ks], S[rg][kt], 0, 0, 0);
    }
  }
  h16x8 Pf[2][2];
#pragma unroll
  for (int rg = 0; rg < 2; ++rg) {
    if (!(RGM & (1 << rg))) continue;
    const float* bt = biasT + hd * 800;
    if (far) {
      const float b31 = bt[799];
      const bool ok = (MODE == M_SEL) ? selbit[rg] : true;
#pragma unroll
      for (int kt = 0; kt < 4; ++kt)
#pragma unroll
        for (int j = 0; j < 4; ++j) S[rg][kt][j] = ok ? S[rg][kt][j] * SCL2 + b31 : -1e30f;
    } else {
      const int kx0 = kbase + q4 * 4;
      const int d0 = (DK == 16) ? tq[rg] - 31 - 16 * kx0 : tq[rg] - kx0;
#pragma unroll
      for (int kt = 0; kt < 4; ++kt)
#pragma unroll
        for (int j = 0; j < 4; ++j) {
          const int dist = d0 - DK * (kt * 16 + j);
          const int kx = kx0 + kt * 16 + j;
          bool valid = dist >= 0;
          if (MODE == M_SWA) valid = valid && dist < 128 && kx >= 0;
          if (MODE == M_WIN) valid = valid && dist < 512 && kx >= 0;
          if (MODE == M_SEL) valid = valid && selbit[rg];
          if (DK == 16) valid = valid && kx < NCMP;
          const int dc = dist < 0 ? 0 : (dist > 799 ? 799 : dist);
          S[rg][kt][j] = valid ? S[rg][kt][j] * SCL2 + bt[dc] : -1e30f;
        }
    }
    if (MODE == M_CMPB) {
#pragma unroll
      for (int kt = 0; kt < 4; ++kt) {
        float h = 0.f;
#pragma unroll
        for (int j = 0; j < 4; ++j) {
          float pv = __builtin_amdgcn_exp2f(S[rg][kt][j] - st[rg].m) * st[rg].l;
          S[rg][kt][j] = pv;
          h += pv;
        }
        hq[rg][kt] = h;
        h3[rg][kt] = S[rg][kt][3];
      }
    } else {
      float mx = -1e30f;
#pragma unroll
      for (int kt = 0; kt < 4; ++kt)
#pragma unroll
        for (int j = 0; j < 4; ++j) mx = fmaxf(mx, S[rg][kt][j]);
      mx = max4q(mx);
      const float mn = fmaxf(st[rg].m, mx);
      const float corr = __builtin_amdgcn_exp2f(st[rg].m - mn);
      st[rg].m = mn;
      const float mm = fmaxf(mn, -1e20f);
      float ls = 0.f;
#pragma unroll
      for (int kt = 0; kt < 4; ++kt)
#pragma unroll
        for (int j = 0; j < 4; ++j) {
          float pv = __builtin_amdgcn_exp2f(S[rg][kt][j] - mm);
          S[rg][kt][j] = pv;
          ls += pv;
        }
      st[rg].l = st[rg].l * corr + ls;
      if (MODE != M_CMPA) {
#pragma unroll
        for (int nt = 0; nt < 4; ++nt) O[rg][nt] *= corr;
      }
    }
    if (MODE != M_CMPA) {
#pragma unroll
      for (int ks = 0; ks < 2; ++ks)
#pragma unroll
        for (int i = 0; i < 4; ++i) {
          Pf[rg][ks][i] = (h16)S[rg][2 * ks][i];
          Pf[rg][ks][4 + i] = (h16)S[rg][2 * ks + 1][i];
        }
    }
  }
  if (MODE == M_CMPA) return;
#pragma unroll
  for (int ks = 0; ks < 2; ++ks)
#pragma unroll
    for (int nt = 0; nt < 4; ++nt) {
      const h16* vp = Vt + (ks * 32 + q4 * 4 + (col >> 2)) * KP + nt * 16 + 4 * (col & 3);
      const s16x4v r0 = __builtin_amdgcn_ds_read_tr16_b64_v4i16((LAS s16x4v*)vp);
      const s16x4v r1 = __builtin_amdgcn_ds_read_tr16_b64_v4i16((LAS s16x4v*)(vp + 16 * KP));
      const h16x4 v0 = __builtin_bit_cast(h16x4, r0), v1 = __builtin_bit_cast(h16x4, r1);
      const h16x8 Vf = {v0[0], v0[1], v0[2], v0[3], v1[0], v1[1], v1[2], v1[3]};
#pragma unroll
      for (int rg = 0; rg < 2; ++rg)
        if (RGM & (1 << rg)) O[rg][nt] = __builtin_amdgcn_mfma_f32_16x16x32_f16(Vf, Pf[rg][ks], O[rg][nt], 0, 0, 0);
    }
}

constexpr int LDS_CMP = 8 * 16 * 128 * 4 + 16 * 136 * 2 + 4 * 16 * 4;
__device__ __forceinline__ void phase_compress(const Params& p, int l, char* lds) {
  const int tid = opaque_tid(), lane = tid & 63, w = tid >> 6, col = lane & 15, q4 = lane >> 4;
  float* red = (float*)lds;
  h16* hid = (h16*)(lds + 8 * 16 * 128 * 4);
  float* nrm2 = (float*)(lds + 8 * 16 * 128 * 4 + 16 * 136 * 2);
  const h16* P = (const h16*)(WS(p) + O_P);
  for (int u = blockIdx.x; u < BATCH * 2 * 32; u += gridDim.x) {
    const int mt = u & 31, st = (u >> 5) & 1, b = u >> 6;
    const h16* W1t = (const h16*)(WS(p) + O_W1T) + (size_t)(l * 2 + st) * 128 * 2048;
    const h16* W2t = (const h16*)(WS(p) + O_W2T) + (size_t)(l * 2 + st) * 64 * 128;
    const float* b1 = (const float*)(WS(p) + O_BIAS1) + (l * 2 + st) * 128;
    __syncthreads();
    {
      f32x4 acc[8];
#pragma unroll
      for (int nt = 0; nt < 8; ++nt) acc[nt] = f32x4{0.f, 0.f, 0.f, 0.f};
      const int m = 16 * mt + col;
#pragma unroll 2
      for (int kk = 0; kk < 8; ++kk) {
        const int ks = 8 * w + kk, tt = ks >> 1, d0 = (ks & 1) * 32 + q4 * 8;
        int tok = 16 * m + tt;
        if (tok > SEQ - 1) tok = SEQ - 1;
        const h16x8 A = *(const h16x8*)(P + ((size_t)b * SEQ + tok) * IWP + OFF_KVC + st * 64 + d0);
#pragma unroll
        for (int nt = 0; nt < 8; ++nt) {
          const h16x8 B = *(const h16x8*)(W1t + (size_t)(nt * 16 + col) * 2048 + ks * 32 + q4 * 8);
          acc[nt] = __builtin_amdgcn_mfma_f32_16x16x32_f16(A, B, acc[nt], 0, 0, 0);
        }
      }
#pragma unroll
      for (int nt = 0; nt < 8; ++nt)
#pragma unroll
        for (int j = 0; j < 4; ++j) red[(w * 16 + q4 * 4 + j) * 128 + nt * 16 + col] = acc[nt][j];
    }
    __syncthreads();
    {
      const int row = tid >> 5, c4 = (tid & 31) * 4;
      float4 sum = *(const float4*)(b1 + c4);
#pragma unroll
      for (int ww = 0; ww < 8; ++ww) {
        const float4 v = *(const float4*)(red + (ww * 16 + row) * 128 + c4);
        sum.x += v.x; sum.y += v.y; sum.z += v.z; sum.w += v.w;
      }
      *(h16x4*)(hid + row * 136 + c4) = pack4(gelu_tanh(sum.x), gelu_tanh(sum.y), gelu_tanh(sum.z), gelu_tanh(sum.w));
    }
    __syncthreads();
    f32x4 o2 = {0.f, 0.f, 0.f, 0.f};
    if (w < 4) {
#pragma unroll
      for (int ks = 0; ks < 4; ++ks) {
        const h16x8 A = *(const h16x8*)(hid + col * 136 + ks * 32 + q4 * 8);
        const h16x8 B = *(const h16x8*)(W2t + (size_t)(w * 16 + col) * 128 + ks * 32 + q4 * 8);
        o2 = __builtin_amdgcn_mfma_f32_16x16x32_f16(A, B, o2, 0, 0, 0);
      }
      if (st == 0) {
#pragma unroll
        for (int j = 0; j < 4; ++j) {
          float ss = sum16(o2[j] * o2[j]);
          if (col == 0) nrm2[w * 16 + q4 * 4 + j] = ss;
        }
      }
    }
    __syncthreads();
    if (w < 4) {
      const float g = p.in[3][(l * 6 + 3) * 64 + w * 16 + col];
      h16* dst = (h16*)(WS(p) + (st == 0 ? O_KCMP : O_VCMP));
#pragma unroll
      for (int j = 0; j < 4; ++j) {
        const int row = q4 * 4 + j, m = 16 * mt + row;
        float v = o2[j];
        if (st == 0) {
          float tot = nrm2[row] + nrm2[16 + row] + nrm2[32 + row] + nrm2[48 + row];
          v = v * rsqrtf(tot * (1.f / 64.f) + EPS) * g;
        }
        if (m >= NCMP) v = 0.f;
        dst[((size_t)b * 512 + m) * 64 + w * 16 + col] = (h16)v;
      }
    }
  }
}

template <int D, class LoadF, class StoreF, class CompF>
__device__ __forceinline__ void tile_pipeline(int n, LoadF load, StoreF store, CompF comp) {
  h16x8 rk[D], rv[D];
#pragma unroll
  for (int d = 0; d < D; ++d)
    if (d < n) load(d, rk[d], rv[d]);
  store(0, rk[0], rv[0]);
  if (D < n) load(D, rk[0], rv[0]);
  __syncthreads();
  for (int i0 = 0; i0 < n; i0 += D) {
#pragma unroll
    for (int d = 0; d < D; ++d) {
      const int i = i0 + d;
      if (i < n) {
        if (i + 1 < n) store(i + 1, rk[(d + 1) % D], rv[(d + 1) % D]);
        if (i + 1 + D < n) load(i + 1 + D, rk[(d + 1) % D], rv[(d + 1) % D]);
        comp(i);
        __syncthreads();
      }
    }
  }
}

constexpr int LDS_BIAS = 800 * 16;
__device__ __forceinline__ void phase_swa(const Params& p, int l, char* lds) {
  const int tid = opaque_tid(), lane = tid & 63, w = tid >> 6, col = lane & 15, q4 = lane >> 4;
  float* biasT = (float*)lds;
  h16* KV = (h16*)(lds + LDS_BIAS);
  float* nrm = (float*)(lds + LDS_BIAS + 4 * 64 * KP * 2);
  const h16* P = (const h16*)(WS(p) + O_P);
  const int* lut = (const int*)(WS(p) + O_LUT);
  h16* OAC = (h16*)(WS(p) + O_OAC);
  __syncthreads();
  for (int i = tid; i < 3200; i += NT) biasT[i] = p.in[5][lut[i % 800] * 8 + (i / 800)] * LOG2E;
  __syncthreads();
  const int head = w >> 1, kvh = w >> 2;
  const float sink = p.in[4][l * 4 + head] * LOG2E;
  const int srow = tid >> 3, c8 = tid & 7;
  float hpd[2][4], hpe[2][4];
  const bool nosel[2] = {false, false};
  for (int u = blockIdx.x; u < BATCH * 128; u += gridDim.x) {
    const int b = u >> 7, t0 = (u & 127) * 64;
    const h16* Pbat = P + (size_t)b * SEQ * IWP;
    h16x8 Q[2][2];
    int tq[2];
#pragma unroll
    for (int rg = 0; rg < 2; ++rg) {
      const int qb = (w & 1) * 32 + rg * 16;
      const h16* qp = Pbat + (size_t)(t0 + qb + col) * IWP + head * 64 + q4 * 8;
      Q[rg][0] = *(const h16x8*)qp;
      Q[rg][1] = *(const h16x8*)(qp + 32);
      tq[rg] = t0 + qb + col;
    }
    f32x4 O[2][4];
    ColState st[2];
#pragma unroll
    for (int rg = 0; rg < 2; ++rg) {
#pragma unroll
      for (int nt = 0; nt < 4; ++nt) O[rg][nt] = f32x4{0.f, 0.f, 0.f, 0.f};
      st[rg].m = -1e30f; st[rg].l = 0.f;
    }
    const int i0 = t0 >= 128 ? 0 : (t0 >= 64 ? 1 : 2);
    h16x8 rk[2], rv[2];
    {
      int sb = t0 - 128 + i0 * 64;
      for (int h2 = 0; h2 < 2; ++h2) {
        rk[h2] = ld_row8(Pbat + 256 + h2 * 64, IWP, sb + srow, SEQ, c8);
        rv[h2] = ld_row8(Pbat + 384 + h2 * 64, IWP, sb + srow, SEQ, c8);
      }
    }
    for (int i = i0; i < 3; ++i) {
      __syncthreads();
      for (int h2 = 0; h2 < 2; ++h2) {
        st_k(KV + h2 * 64 * KP, srow, c8, rk[h2]);
        st_k(KV + (2 + h2) * 64 * KP, srow, c8, rv[h2]);
      }
      __syncthreads();
      if (i + 1 < 3) {
        int sb = t0 - 128 + (i + 1) * 64;
        for (int h2 = 0; h2 < 2; ++h2) {
          rk[h2] = ld_row8(Pbat + 256 + h2 * 64, IWP, sb + srow, SEQ, c8);
          rv[h2] = ld_row8(Pbat + 384 + h2 * 64, IWP, sb + srow, SEQ, c8);
        }
      }
      const int kb = t0 - 128 + i * 64;
      attn_tile<M_SWA, 3>(Q, O, st, KV + kvh * 64 * KP, KV + (2 + kvh) * 64 * KP, biasT, tq, head, kb, false, nosel, hpd, hpe, lane);
    }
    __syncthreads();
#pragma unroll
    for (int rg = 0; rg < 2; ++rg) {
      const int qb = (w & 1) * 32 + rg * 16;
      const float lsum = sum4q(st[rg].l);
      const float mn = fmaxf(st[rg].m, sink);
      const float corr = __builtin_amdgcn_exp2f(st[rg].m - mn);
      const float inv = corr / (lsum * corr + __builtin_amdgcn_exp2f(sink - mn));
      float ss = 0.f;
#pragma unroll
      for (int nt = 0; nt < 4; ++nt) {
        O[rg][nt] *= inv;
#pragma unroll
        for (int j = 0; j < 4; ++j) ss += O[rg][nt][j] * O[rg][nt][j];
      }
      ss = sum4q(ss);
      if (q4 == 0) nrm[head * 64 + qb + col] = ss;
    }
    __syncthreads();
#pragma unroll
    for (int rg = 0; rg < 2; ++rg) {
      const int qi = (w & 1) * 32 + rg * 16 + col;
      const float tot = nrm[qi] + nrm[64 + qi] + nrm[128 + qi] + nrm[192 + qi];
      const float sc = rsqrtf(tot * (1.f / 256.f) + EPS);
#pragma unroll
      for (int nt = 0; nt < 4; ++nt)
        *(h16x4*)(OAC + ((size_t)b * SEQ + t0 + qi) * 1024 + head * 64 + nt * 16 + q4 * 4) =
            pack4(O[rg][nt][0] * sc, O[rg][nt][1] * sc, O[rg][nt][2] * sc, O[rg][nt][3] * sc);
    }
  }
}

constexpr int LDS_NSA = LDS_BIAS + 4 * 64 * KP * 2 + NW * 4 * 128 * 4 + 32 * 16;
constexpr int PFD = 4;
__device__ __forceinline__ void phase_nsa(const Params& p, int l, char* lds, const int parts = 15) {
  const int tid = opaque_tid(), lane = tid & 63, w = tid >> 6, col = lane & 15, q4 = lane >> 4;
  float* biasT = (float*)lds;
  h16* KV0 = (h16*)(lds + LDS_BIAS);
  float* impw = (float*)(lds + LDS_BIAS + 4 * 64 * KP * 2) + w * 4 * 128;
  unsigned long long* selm = (unsigned long long*)(lds + LDS_BIAS + 4 * 64 * KP * 2 + NW * 4 * 128 * 4);
#define KSB(i) (KV0 + ((i) & 1) * 2 * 64 * KP)
#define VTB(i) (KV0 + ((i) & 1) * 2 * 64 * KP + 64 * KP)
  const h16* P = (const h16*)(WS(p) + O_P);
  const int* lut = (const int*)(WS(p) + O_LUT);
  h16* OAC = (h16*)(WS(p) + O_OAC);
  __syncthreads();
  for (int i = tid; i < 3200; i += NT) biasT[i] = p.in[5][lut[i % 800] * 8 + 4 + (i / 800)] * LOG2E;
  __syncthreads();
  const int srow = tid >> 3, c8 = tid & 7;
  const int hd = col & 3, qw = col >> 2;
  float hpd[2][4], hpe[2][4];
  const bool nosel[2] = {false, false};
  for (int u = blockIdx.x; u < 1024; u += gridDim.x) {
    const int rnd = u >> 8, b = (u & 255) >> 6, ti = u & 63;
    const int tile = rnd == 0 ? 255 - ti : (rnd == 1 ? 128 + ti : (rnd == 2 ? 127 - ti : ti));
    const int t0 = tile * 32, cur = t0 >> 6;
    const h16* Pbat = P + (size_t)b * SEQ * IWP;
    const h16* KC = (const h16*)(WS(p) + O_KCMP) + (size_t)b * 512 * 64;
    const h16* VC = (const h16*)(WS(p) + O_VCMP) + (size_t)b * 512 * 64;
    h16x8 Q[2][2];
    int tq[2] = {0, 0};
    {
      const h16* qp = Pbat + (size_t)(t0 + w * 4 + qw) * IWP + OFF_QC + hd * 64 + q4 * 8;
      Q[0][0] = *(const h16x8*)qp;
      Q[0][1] = *(const h16x8*)(qp + 32);
      tq[0] = t0 + w * 4 + qw;
    }
    const h16* gp = Pbat + (size_t)tq[0] * IWP + OFF_GC + hd * 3;
    for (int i = lane; i < 512; i += 64) impw[i] = 0.f;
    f32x4 O[2][4], Oc[4];
    ColState st[2];
    int mvmax = t0 / 16 + 1;
    if (mvmax > NCMP) mvmax = NCMP;
    const int ntc = (mvmax + 63) >> 6;
    st[0].m = -1e30f; st[0].l = 0.f;
    if (parts & 1) tile_pipeline<PFD>(ntc,
      [&](int i, h16x8& k, h16x8& v) { k = ld_row8(KC, 64, i * 64 + srow, 512, c8); },
      [&](int i, const h16x8& k, const h16x8& v) { st_k(KSB(i), srow, c8, k); },
      [&](int i) {
        const bool far = t0 - 31 - 16 * (i * 64 + 63) >= 799;
        attn_tile<M_CMPA, 1>(Q, O, st, KSB(i), VTB(i), biasT, tq, hd, i * 64, far, nosel, hpd, hpe, lane);
      });
    {
      const float ls = sum4q(st[0].l);
      st[0].l = ls > 0.f ? 1.f / ls : 0.f;
    }
#pragma unroll
    for (int nt = 0; nt < 4; ++nt) O[0][nt] = f32x4{0.f, 0.f, 0.f, 0.f};
    float carry = 0.f;
    if (parts & 1) tile_pipeline<PFD>(ntc,
      [&](int i, h16x8& k, h16x8& v) { k = ld_row8(KC, 64, i * 64 + srow, 512, c8); v = ld_row8(VC, 64, i * 64 + srow, 512, c8); },
      [&](int i, const h16x8& k, const h16x8& v) { st_k(KSB(i), srow, c8, k); st_k(VTB(i), srow, c8, v); },
      [&](int i) {
        float hq[2][4], h3[2][4];
        const bool far = t0 - 31 - 16 * (i * 64 + 63) >= 799;
        attn_tile<M_CMPB, 1>(Q, O, st, KSB(i), VTB(i), biasT, tq, hd, i * 64, far, nosel, hq, h3, lane);
        float t3p = carry;
#pragma unroll
        for (int kt = 0; kt < 4; ++kt) {
          const float qs = quadsum(hq[0][kt]);
          const float t3 = quadsum(h3[0][kt]);
          const float up = __shfl(t3, (lane + 48) & 63);
          const float wrp = __shfl(t3p, (lane + 48) & 63);
          const float pk = (q4 == 0) ? wrp : up;
          if (hd == 0) impw[qw * 128 + i * 16 + kt * 4 + q4] = qs + pk;
          t3p = t3;
        }
        carry = t3p;
      });
    {
      const float g0 = (float)gp[0];
#pragma unroll
      for (int nt = 0; nt < 4; ++nt) Oc[nt] = O[0][nt] * g0;
    }
    if (parts & 2) {
      const int nforced = cur >= 2 ? 3 : cur + 1;
      const int npick = 16 - nforced;
      for (int qi = 0; qi < 4; ++qi) {
        const float* im = impw + qi * 128;
        const int j0 = lane, j1 = lane + 64;
        const float v0 = im[j0], v1 = im[j1];
        int r0 = 0, r1 = 0;
        for (int jp = 1; jp <= cur - 2; ++jp) {
          float vp = im[jp];
          r0 += (vp > v0 || (vp == v0 && jp < j0)) ? 1 : 0;
          r1 += (vp > v1 || (vp == v1 && jp < j1)) ? 1 : 0;
        }
        bool c0 = j0 >= 1 && j0 <= cur - 2, c1 = j1 <= cur - 2;
        bool f0 = j0 == 0 || j0 == cur || j0 == cur - 1, f1 = j1 == cur || j1 == cur - 1;
        unsigned long long mlo = __ballot(f0 || (c0 && r0 < npick));
        unsigned long long mhi = __ballot(f1 || (c1 && r1 < npick));
        if (lane == 0) { selm[(w * 4 + qi) * 2] = mlo; selm[(w * 4 + qi) * 2 + 1] = mhi; }
      }
    }
    asm volatile("" ::: "memory");
    const unsigned long long slo = selm[(w * 4 + qw) * 2], shi = selm[(w * 4 + qw) * 2 + 1];
#pragma unroll
    for (int nt = 0; nt < 4; ++nt) O[0][nt] = f32x4{0.f, 0.f, 0.f, 0.f};
    st[0].m = -1e30f; st[0].l = 0.f;
    if (parts & 4) tile_pipeline<PFD>(cur + 1,
      [&](int jb, h16x8& k, h16x8& v) {
        k = ld_row8(Pbat + OFF_KVC + 128, IWP, jb * 64 + srow, SEQ, c8);
        v = ld_row8(Pbat + OFF_KVC + 192, IWP, jb * 64 + srow, SEQ, c8); },
      [&](int jb, const h16x8& k, const h16x8& v) { st_k(KSB(jb), srow, c8, k); st_k(VTB(jb), srow, c8, v); },
      [&](int jb) {
        bool sb[2] = {false, false};
        sb[0] = ((jb < 64 ? (slo >> jb) : (shi >> (jb - 64))) & 1ull) != 0;
        const bool far = t0 - (jb * 64 + 63) >= 799;
        if (__any(sb[0])) attn_tile<M_SEL, 1>(Q, O, st, KSB(jb), VTB(jb), biasT, tq, hd, jb * 64, far, sb, hpd, hpe, lane);
      });
    {
      const float ls = sum4q(st[0].l);
      const float f = ls > 0.f ? (float)gp[1] / ls : 0.f;
#pragma unroll
      for (int nt = 0; nt < 4; ++nt) Oc[nt] += O[0][nt] * f;
    }
#pragma unroll
    for (int nt = 0; nt < 4; ++nt) O[0][nt] = f32x4{0.f, 0.f, 0.f, 0.f};
    st[0].m = -1e30f; st[0].l = 0.f;
    const int w0 = cur >= 8 ? cur - 8 : 0;
    if (parts & 8) tile_pipeline<PFD>(cur - w0 + 1,
      [&](int i, h16x8& k, h16x8& v) {
        k = ld_row8(Pbat + OFF_KVC + 256, IWP, (w0 + i) * 64 + srow, SEQ, c8);
        v = ld_row8(Pbat + OFF_KVC + 320, IWP, (w0 + i) * 64 + srow, SEQ, c8); },
      [&](int i, const h16x8& k, const h16x8& v) { st_k(KSB(i), srow, c8, k); st_k(VTB(i), srow, c8, v); },
      [&](int i) { attn_tile<M_WIN, 1>(Q, O, st, KSB(i), VTB(i), biasT, tq, hd, (w0 + i) * 64, false, nosel, hpd, hpe, lane); });
    {
      const float ls = sum4q(st[0].l);
      const float f = ls > 0.f ? (float)gp[2] / ls : 0.f;
      float ss = 0.f;
#pragma unroll
      for (int nt = 0; nt < 4; ++nt) {
        Oc[nt] += O[0][nt] * f;
#pragma unroll
        for (int j = 0; j < 4; ++j) ss += Oc[nt][j] * Oc[nt][j];
      }
      ss = quadsum(sum4q(ss));
      const float sc = rsqrtf(ss * (1.f / 256.f) + EPS);
#pragma unroll
      for (int nt = 0; nt < 4; ++nt)
        *(h16x4*)(OAC + ((size_t)b * SEQ + tq[0]) * 1024 + 256 + hd * 64 + nt * 16 + q4 * 4) =
            pack4(Oc[nt][0] * sc, Oc[nt][1] * sc, Oc[nt][2] * sc, Oc[nt][3] * sc);
    }
  }
#undef KSB
#undef VTB
}

constexpr int LDS_SWA = LDS_BIAS + 4 * 64 * KP * 2 + 1024;
constexpr int lds_max(int a, int b) { return a > b ? a : b; }
constexpr int LDS_BYTES = lds_max(lds_max(LDS_NSA, SSMY_LDS), lds_max(LDS_SWA, lds_max(LDS_GEMM, lds_max(LDS_CMP, 64 * 65 * 4))));

__global__ void __launch_bounds__(NT) fwd_megakernel(Params p) {
  cg::grid_group grid = cg::this_grid();
  __shared__ __attribute__((aligned(16))) char lds[LDS_BYTES];
  __shared__ uint4 xb_words;
  if (threadIdx.x == 0) xb_words = make_uint4(0u, 0u, 0u, 0u);
  __syncthreads();
  (void)xcd_barrier_post((unsigned*)(WS(p) + O_BAR), (volatile LAS unsigned*)&xb_words);
#define GBAR() do { XcdBarrier _b; _b.bar = (unsigned*)(WS(p) + O_BAR); _b.x = xb_xcc_id(); _b.st = (volatile LAS unsigned*)&xb_words; xcd_barrier(_b); } while (0)
  phase0(p, (float*)lds);
  grid.sync();
  phase0b(p);
  GBAR();
  for (int l = 0; l < DEPTH; ++l) {
    phase_gemm1(p, l, lds);
    GBAR();
    ssm_endstates(p, l);
    phase_compress(p, l, lds);
    GBAR();
    phase_nsa(p, l, lds);
    phase_swa(p, l, lds);
    ssm_outputs(p, l, lds);
    GBAR();
    phase_glu(p, l, lds);
    GBAR();
    phase_wout(p, l, lds);
    GBAR();
    phase_up(p, l, lds);
    GBAR();
    phase_down(p, l, lds);
    GBAR();
  }
}

extern "C" void kernel_launch(void* const* d_in, const int* in_sizes, int n_in, void* d_out, int out_size, void* d_ws,
                              size_t ws_size, hipStream_t stream) {
  static int grid_blocks = 0;
  if (!grid_blocks) {
    int dev = 0, cus = 0, per_cu = 0;
    (void)hipGetDevice(&dev);
    (void)hipDeviceGetAttribute(&cus, hipDeviceAttributeMultiprocessorCount, dev);
    (void)hipOccupancyMaxActiveBlocksPerMultiprocessor(&per_cu, fwd_megakernel, NT, 0);
    if (per_cu > 1) per_cu = 1;
    grid_blocks = cus * per_cu;
  }
  if (ws_size < WS_NEED) {
    fprintf(stderr, "workspace too small: %zu < %zu\n", ws_size, WS_NEED);
    return;
  }
  Params p{};
  for (int i = 0; i < 24; ++i) p.in[i] = (const float*)d_in[i];
  p.out = (float*)d_out;
  p.ws = (char*)d_ws;
  (void)hipMemsetAsync((char*)d_ws + O_BAR, 0, SZ_BAR, stream);
  void* args[] = {&p};
  hipError_t e = hipLaunchCooperativeKernel((void*)fwd_megakernel, dim3(grid_blocks), dim3(NT), args, 0, stream);
  if (e != hipSuccess) fprintf(stderr, "cooperative launch failed: %s (grid %d)\n", hipGetErrorString(e), grid_blocks);
}
```

```cpp
#include <hip/hip_runtime.h>
#include <hip/hip_cooperative_groups.h>
#include <cstdio>
namespace cg = cooperative_groups;

typedef _Float16 h16;
typedef __attribute__((ext_vector_type(8))) _Float16 h16x8;
typedef __attribute__((ext_vector_type(4))) float f32x4;

constexpr int NT = 512;
constexpr int NW = NT / 64;
constexpr int BATCH = 4, SEQ = 8192, NTOK = BATCH * SEQ, DM = 1024, DEPTH = 4, IW = 1676, IWP = 1792, DFF = 4096;
constexpr int OFF_U = 512, OFF_QC = 1024, OFF_KVC = 1280, OFF_GC = 1664;
constexpr int NCMP = 511;
constexpr float EPS = 1e-6f;

constexpr size_t SZ_WIN = (size_t)IWP * DM * 2, SZ_WGLU = (size_t)1024 * 512 * 2, SZ_WOUT = (size_t)DM * DM * 2,
                 SZ_WUP = (size_t)DFF * DM * 2, SZ_WDN = (size_t)DM * DFF * 2;
constexpr size_t O_WIN = 0;
constexpr size_t O_WGLU = O_WIN + DEPTH * SZ_WIN;
constexpr size_t O_WOUT = O_WGLU + DEPTH * SZ_WGLU;
constexpr size_t O_WUP = O_WOUT + DEPTH * SZ_WOUT;
constexpr size_t O_WDN = O_WUP + DEPTH * SZ_WUP;
constexpr size_t O_XB = O_WDN + DEPTH * SZ_WDN;
constexpr size_t O_SSQ = O_XB + (size_t)NTOK * DM * 2;
constexpr size_t O_SSQB = O_SSQ + (size_t)NTOK * 16 * 4;
constexpr size_t O_KCMP = O_SSQB + (size_t)NTOK * 16 * 4;
constexpr size_t O_VCMP = O_KCMP + (size_t)BATCH * 512 * 64 * 4;
constexpr size_t O_ABAR = O_VCMP + (size_t)BATCH * 512 * 64 * 4;
constexpr size_t O_BBAR = O_ABAR + (size_t)DEPTH * 32 * 64 * 8;
constexpr size_t O_BIAS1 = O_BBAR + (size_t)DEPTH * 32 * 64 * 16 * 8;
constexpr size_t O_LUT = O_BIAS1 + (size_t)DEPTH * 2 * 128 * 4;
constexpr size_t O_AT = O_LUT + 8192 * 4;
constexpr size_t O_KTAB = O_AT + (size_t)128 * 64 * 8;
constexpr size_t SZ_KTAB = (size_t)65 * 256 * 2;
constexpr size_t O_W1 = O_KTAB + 128 * SZ_KTAB;
constexpr size_t SZ_W13 = (size_t)128 * 1024 * 2;
constexpr size_t O_W3 = O_W1 + 128 * SZ_W13;
constexpr size_t O_W1T = O_W3 + 128 * SZ_W13;
constexpr size_t O_W2T = O_W1T + (size_t)8 * 128 * 2048 * 2;
constexpr size_t O_B1P = O_W2T + (size_t)8 * 64 * 128 * 2;
constexpr size_t O_BAR = (O_B1P + (size_t)8 * 32 * 128 * 4 + 255) / 256 * 256;
constexpr size_t SZ_BAR = 3456 * 4;
constexpr size_t O_BIG = (O_BAR + SZ_BAR + 255) / 256 * 256;
constexpr size_t O_APOW = O_BIG;
constexpr size_t O_P = O_BIG;
constexpr size_t O_Z = O_P + (size_t)NTOK * IWP * 2;
constexpr size_t O_OB = O_Z + (size_t)NTOK * 512 * 2;
constexpr size_t O_OAC = O_OB + (size_t)512 * 2;
constexpr size_t O_E = O_OB + (size_t)NTOK * 1024 * 2;
constexpr size_t O_HID = O_BIG;
constexpr size_t WS_NEED = O_BIG + (size_t)NTOK * DFF * 2;

struct Params {
  const float* in[24];
  float* out;
  char* ws;
};

__device__ __forceinline__ char* WS(const Params& p) {
  int z;
  asm volatile("s_mov_b32 %0, 0" : "=s"(z));
  return p.ws + z;
}
__device__ __forceinline__ int opaque_tid() {
  int t = threadIdx.x;
  asm volatile("" : "+v"(t));
  return t;
}
template <int CTRL>
__device__ __forceinline__ float dppf(float v) {
  return __int_as_float(__builtin_amdgcn_update_dpp(0, __float_as_int(v), CTRL, 0xF, 0xF, true));
}
__device__ __forceinline__ float sum16(float v) {
  v += dppf<0xB1>(v); v += dppf<0x4E>(v); v += dppf<0x141>(v); v += dppf<0x140>(v);
  return v;
}
__device__ __forceinline__ float max16(float v) {
  v = fmaxf(v, dppf<0xB1>(v)); v = fmaxf(v, dppf<0x4E>(v)); v = fmaxf(v, dppf<0x141>(v)); v = fmaxf(v, dppf<0x140>(v));
  return v;
}
__device__ __forceinline__ float xor16(float v) { return __int_as_float(__builtin_amdgcn_ds_swizzle(__float_as_int(v), 0x401F)); }
__device__ __forceinline__ float rdlane_c(float v, int l) { return __int_as_float(__builtin_amdgcn_readlane(__float_as_int(v), l)); }
__device__ __forceinline__ float wave_sum(float v) {
  v = sum16(v); v += xor16(v);
  return rdlane_c(v, 0) + rdlane_c(v, 32);
}
__device__ __forceinline__ float gelu_tanh(float x) {
  float u = 0.7978845608028654f * (x + 0.044715f * x * x * x);
  return 0.5f * x * (1.f + tanhf(u));
}
__device__ __forceinline__ float sigmoidf(float x) { return 1.f / (1.f + __expf(-x)); }
__device__ __forceinline__ float rdlane(float v, int l) {
  return __int_as_float(__builtin_amdgcn_readlane(__float_as_int(v), l));
}

template <class SrcF>
__device__ __forceinline__ void conv_tile(SrcF src, h16* dst, int ldo, int n0, int k0, float* tile) {
  int tid = opaque_tid();
  for (int idx = tid; idx < 4096; idx += NT) {
    int kk = idx >> 6, nn = idx & 63;
    tile[kk * 65 + nn] = src(k0 + kk, n0 + nn);
  }
  __syncthreads();
  for (int idx = tid; idx < 4096; idx += NT) {
    int nn = idx >> 6, kk = idx & 63;
    dst[(long)(n0 + nn) * ldo + k0 + kk] = (h16)tile[kk * 65 + nn];
  }
  __syncthreads();
}

__device__ __forceinline__ void phase0(const Params& p, float* lds) {
  const int tid = opaque_tid();
  constexpr int T_IN = (IWP / 64) * (DM / 64);
  constexpr int T_GLU = 16 * 8;
  constexpr int T_OUT = 16 * 16;
  constexpr int T_UP = 64 * 16;
  constexpr int T_DN = 16 * 64;
  constexpr int T_L = T_IN + T_GLU + T_OUT + T_UP + T_DN;
  for (int ti = blockIdx.x; ti < DEPTH * T_L; ti += gridDim.x) {
    int l = ti / T_L, r = ti % T_L;
    if (r < T_IN) {
      int nt = r / 16, kt = r % 16;
      const float* w = p.in[2] + (size_t)l * DM * IW;
      const float* g = p.in[1] + l * DM;
      conv_tile([&](int k, int sl) {
        int n = (sl & ~255) + 64 * ((sl >> 5) & 3) + 32 * ((sl >> 7) & 1) + (sl & 31);
        return n < IW ? w[(long)k * IW + n] * g[k] : 0.f; },
                (h16*)(WS(p) + O_WIN + l * SZ_WIN), DM, nt * 64, kt * 64, lds);
    } else if ((r -= T_IN) < T_GLU) {
      int nt = r / 8, kt = r % 8;
      const float* w = p.in[14] + (size_t)l * 512 * 1024;
      conv_tile([&](int k, int n2) {
        int pn = n2 >> 8, bj = (n2 >> 7) & 1, wc = (n2 >> 5) & 3, nn = (n2 >> 4) & 1, r = n2 & 15;
        int n = (nn ? 512 : 0) + 128 * pn + 64 * bj + 16 * wc + r;
        return w[(long)k * 1024 + n]; },
                (h16*)(WS(p) + O_WGLU + l * SZ_WGLU), 512, nt * 64, kt * 64, lds);
    } else if ((r -= T_GLU) < T_OUT) {
      int nt = r / 16, kt = r % 16;
      const float* w = p.in[20] + (size_t)l * DM * DM;
      const float* g = p.in[19] + l * DM;
      conv_tile([&](int k2, int n) {
        int k = k2 < 512 ? 256 + k2 : (k2 < 768 ? k2 - 512 : k2);
        return w[(long)k * DM + n] * g[k]; },
                (h16*)(WS(p) + O_WOUT + l * SZ_WOUT), DM, nt * 64, kt * 64, lds);
    } else if ((r -= T_OUT) < T_UP) {
      int nt = r / 16, kt = r % 16;
      const float* w = p.in[22] + (size_t)l * DM * DFF;
      const float* g = p.in[21] + l * DM;
      conv_tile([&](int k, int n) { return w[(long)k * DFF + n] * g[k]; },
                (h16*)(WS(p) + O_WUP + l * SZ_WUP), DM, nt * 64, kt * 64, lds);
    } else {
      r -= T_UP;
      int nt = r / 64, kt = r % 64;
      const float* w = p.in[23] + (size_t)l * DFF * DM;
      conv_tile([&](int k, int n) { return w[(long)k * DM + n]; },
                (h16*)(WS(p) + O_WDN + l * SZ_WDN), DFF, nt * 64, kt * 64, lds);
    }
  }
  for (int ti = blockIdx.x; ti < 8 * 66; ti += gridDim.x) {
    int ls = ti / 66, r = ti % 66;
    if (r < 64) {
      int nt = r >> 5, kt = r & 31;
      const float* w = p.in[17] + (size_t)ls * 2048 * 128;
      conv_tile([&](int k, int n) { return w[(long)k * 128 + n]; }, (h16*)(WS(p) + O_W1T) + (size_t)ls * 128 * 2048, 2048, nt * 64, kt * 64, lds);
    } else {
      int kt = r - 64;
      const float* w = p.in[18] + (size_t)ls * 128 * 64;
      conv_tile([&](int k, int n) { return w[(long)k * 64 + n]; }, (h16*)(WS(p) + O_W2T) + (size_t)ls * 64 * 128, 128, 0, kt * 64, lds);
    }
  }
  {
    const int lane = tid & 63;
    const int gw = blockIdx.x * NW + (tid >> 6), nw = gridDim.x * NW;
    const float* x = p.in[0];
    h16* xb = (h16*)(WS(p) + O_XB);
    float* ssq = (float*)(WS(p) + O_SSQ);
    for (int row = gw; row < NTOK; row += nw) {
      const float4* xr = (const float4*)(x + (long)row * DM + lane * 16);
      float s = 0.f;
      h16 hv[16];
      for (int i = 0; i < 4; ++i) {
        float4 v = xr[i];
        s += v.x * v.x + v.y * v.y + v.z * v.z + v.w * v.w;
        hv[i * 4 + 0] = (h16)v.x; hv[i * 4 + 1] = (h16)v.y; hv[i * 4 + 2] = (h16)v.z; hv[i * 4 + 3] = (h16)v.w;
      }
      h16x8* xo = (h16x8*)(xb + (long)row * DM + lane * 16);
      h16x8 o0, o1;
      for (int i = 0; i < 8; ++i) { o0[i] = hv[i]; o1[i] = hv[8 + i]; }
      xo[0] = o0; xo[1] = o1;
      s += dppf<0xB1>(s);
      s += dppf<0x4E>(s);
      if ((lane & 3) == 0) ssq[(long)row * 16 + (lane >> 2)] = s;
    }
  }
  const int gt = blockIdx.x * NT + tid, ngt = gridDim.x * NT;
  for (int i = gt; i < DEPTH * 32 * 64; i += ngt) {
    int l = i / 2048, g = (i / 64) % 32;
    double are = p.in[6][i], aim = p.in[7][i];
    double dt = exp((double)p.in[8][l * 32 + g]);
    double er = exp(are * dt), abr = er * cos(aim * dt), abi = er * sin(aim * dt);
    ((float2*)(WS(p) + O_ABAR))[i] = make_float2((float)abr, (float)abi);
    double nr = abr - 1.0, ni = abi, den = are * are + aim * aim;
    double fr = (nr * are + ni * aim) / den, fi = (ni * are - nr * aim) / den;
    float2* bb = (float2*)(WS(p) + O_BBAR) + (size_t)i * 16;
    for (int q = 0; q < 16; ++q) {
      double br = p.in[9][(size_t)i * 16 + q], bi = p.in[10][(size_t)i * 16 + q];
      bb[q] = make_float2((float)((fr * br - fi * bi) / dt), (float)((fr * bi + fi * br) / dt));
    }
  }
  for (int i = gt; i < 128 * 65 * 64; i += ngt) {
    int n = i & 63, j = (i >> 6) % 65, lg = i / (65 * 64);
    double are = p.in[6][lg * 64 + n], aim = p.in[7][lg * 64 + n];
    double dt = exp((double)p.in[8][lg]);
    double er = exp(are * dt * j), ang = aim * dt * j;
    ((double2*)(WS(p) + O_APOW))[i] = make_double2(er * cos(ang), er * sin(ang));
  }
  for (int i = gt; i < DEPTH * 2 * 128 * 32; i += ngt) {
    int j = i & 127, kc = (i >> 7) & 31, ls = i >> 12;
    const float* pos = p.in[16] + (size_t)ls * 2048 + kc * 64;
    const float* w1 = p.in[17] + ((size_t)ls * 2048 + kc * 64) * 128;
    float a = 0.f;
#pragma unroll 16
    for (int k = 0; k < 64; ++k) a += pos[k] * w1[(long)k * 128 + j];
    ((float*)(WS(p) + O_B1P))[i] = a;
  }
  for (int d = gt; d < 8192; d += ngt) {
    int bk;
    if (d < 16) bk = d;
    else {
      float nf = (float)d;
      int large = 16 + (int)(logf(nf / 16.0f) / 4.1588830833596715f * 16.0f);
      bk = large < 31 ? large : 31;
    }
    ((int*)(WS(p) + O_LUT))[d] = bk;
  }
}

__device__ __forceinline__ void phase0b(const Params& p) {
  const int gt = blockIdx.x * NT + threadIdx.x, ngt = gridDim.x * NT;
  const double2* apow = (const double2*)(WS(p) + O_APOW);
  const float2* bbs = (const float2*)(WS(p) + O_BBAR);
  for (int i = gt; i < 128 * 64 * 64; i += ngt) {
    int tau = i & 63, n = (i >> 6) & 63, lg = i >> 12;
    double2 ap = apow[(lg * 65 + (63 - tau)) * 64 + n];
    const float2* bb = bbs + (size_t)(lg * 64 + n) * 16;
    h16x8 re0, re1, im0, im1;
#pragma unroll
    for (int q = 0; q < 8; ++q) {
      float2 b0 = bb[q], b1 = bb[8 + q];
      re0[q] = (h16)(float)(ap.x * b0.x - ap.y * b0.y);
      im0[q] = (h16)(float)(ap.x * b0.y + ap.y * b0.x);
      re1[q] = (h16)(float)(ap.x * b1.x - ap.y * b1.y);
      im1[q] = (h16)(float)(ap.x * b1.y + ap.y * b1.x);
    }
    h16* W1 = (h16*)(WS(p) + O_W1 + (size_t)lg * SZ_W13);
    *(h16x8*)(W1 + ((size_t)(2 * tau) * 128 + 2 * n) * 8) = re0;
    *(h16x8*)(W1 + ((size_t)(2 * tau) * 128 + 2 * n + 1) * 8) = im0;
    *(h16x8*)(W1 + ((size_t)(2 * tau + 1) * 128 + 2 * n) * 8) = re1;
    *(h16x8*)(W1 + ((size_t)(2 * tau + 1) * 128 + 2 * n + 1) * 8) = im1;
  }
  for (int i = gt; i < 128 * 64 * 16 * 16; i += ngt) {
    int pp = i & 15, kc = (i >> 4) & 15, tau = (i >> 8) & 63, lg = i >> 14;
    h16x8 v;
#pragma unroll
    for (int e = 0; e < 4; ++e) {
      int n = 4 * kc + e;
      double2 ap = apow[(lg * 65 + tau + 1) * 64 + n];
      double cr = p.in[11][((size_t)lg * 16 + pp) * 64 + n], ci = p.in[12][((size_t)lg * 16 + pp) * 64 + n];
      v[2 * e] = (h16)(float)(cr * ap.x - ci * ap.y);
      v[2 * e + 1] = (h16)(float)(-(cr * ap.y + ci * ap.x));
    }
    h16* W3 = (h16*)(WS(p) + O_W3 + (size_t)lg * SZ_W13);
    *(h16x8*)(W3 + ((size_t)((tau * 16 + kc) * 16) + pp) * 8) = v;
  }
  for (int i = gt; i < 128 * 65 * 16; i += ngt) {
    int pp = i & 15, slot = (i >> 4) % 65, lg = i / (65 * 16);
    float acc[16];
#pragma unroll
    for (int q = 0; q < 16; ++q) acc[q] = 0.f;
    if (slot > 0) {
      for (int n = 0; n < 64; ++n) {
        double2 ap = apow[(lg * 65 + slot - 1) * 64 + n];
        double cr = p.in[11][((size_t)lg * 16 + pp) * 64 + n], ci = p.in[12][((size_t)lg * 16 + pp) * 64 + n];
        float xr = (float)(cr * ap.x - ci * ap.y), xi = (float)(cr * ap.y + ci * ap.x);
        const float2* bb = bbs + (size_t)(lg * 64 + n) * 16;
#pragma unroll
        for (int q = 0; q < 16; ++q) { float2 b = bb[q]; acc[q] += xr * b.x - xi * b.y; }
      }
    }
    h16x8 v0, v1;
#pragma unroll
    for (int q = 0; q < 8; ++q) { v0[q] = (h16)acc[q]; v1[q] = (h16)acc[8 + q]; }
    h16* kt = (h16*)(WS(p) + O_KTAB + (size_t)lg * SZ_KTAB) + slot * 256 + pp * 16;
    *(h16x8*)kt = v0;
    *(h16x8*)(kt + 8) = v1;
  }
  for (int i = gt; i < 128 * 64; i += ngt) {
    double2 ap = apow[((i >> 6) * 65 + 64) * 64 + (i & 63)];
    ((float2*)(WS(p) + O_AT))[i] = make_float2((float)ap.x, (float)ap.y);
  }
  for (int i = gt; i < DEPTH * 2 * 128; i += ngt) {
    const float* pp = (const float*)(WS(p) + O_B1P) + (size_t)(i >> 7) * 32 * 128 + (i & 127);
    float a = 0.f;
    for (int kc = 0; kc < 32; ++kc) a += pp[kc * 128];
    ((float*)(WS(p) + O_BIAS1))[i] = a;
  }
}

__device__ __forceinline__ void ssm_endstates(const Params& p, int l) {
  const int tid = opaque_tid(), lane = tid & 63, w = tid >> 6;
  const int gw = blockIdx.x * NW + w, nw = gridDim.x * NW;
  const h16* P = (const h16*)(WS(p) + O_P);
  float* E = (float*)(WS(p) + O_E);
  for (int unit = gw; unit < 32 * 32; unit += nw) {
    int g = unit >> 5, ctile = unit & 31;
    const h16* W1 = (const h16*)(WS(p) + O_W1 + (size_t)(l * 32 + g) * SZ_W13);
    int gch = ctile * 16 + (lane & 15);
    const h16* ub = P + (size_t)gch * 64 * IWP + OFF_U + g * 16 + ((lane >> 4) & 1) * 8 + (size_t)(lane >> 5) * IWP;
    f32x4 acc[8];
#pragma unroll
    for (int mt = 0; mt < 8; ++mt) acc[mt] = f32x4{0.f, 0.f, 0.f, 0.f};
#pragma unroll 2
    for (int ks = 0; ks < 32; ++ks) {
      h16x8 B = *(const h16x8*)(ub + (size_t)(ks * 2) * IWP);
#pragma unroll
      for (int mt = 0; mt < 8; ++mt) {
        h16x8 A = *(const h16x8*)(W1 + ((size_t)(ks * 4 + (lane >> 4)) * 128 + mt * 16 + (lane & 15)) * 8);
        acc[mt] = __builtin_amdgcn_mfma_f32_16x16x32_f16(A, B, acc[mt], 0, 0, 0);
      }
    }
#pragma unroll
    for (int mt = 0; mt < 8; ++mt)
      *(f32x4*)(E + ((size_t)gch * 32 + g) * 128 + mt * 16 + (lane >> 4) * 4) = acc[mt];
  }
}

constexpr int BU_PITCH = 1032, BS_PITCH = 136;
constexpr int SSMY_LDS = 65 * 512 + 16 * BU_PITCH * 2 + 16 * BS_PITCH * 2 + 128 * 64 * 8;
__device__ __forceinline__ void ssm_outputs(const Params& p, int l, char* lds) {
  const int tid = opaque_tid(), lane = tid & 63, w = tid >> 6;
  h16* Kt = (h16*)lds;
  h16* Bu = (h16*)(lds + 65 * 512);
  h16* Bs = (h16*)(lds + 65 * 512 + 16 * BU_PITCH * 2);
  float2* Es = (float2*)(lds + 65 * 512 + 16 * BU_PITCH * 2 + 16 * BS_PITCH * 2);
  const h16* P = (const h16*)(WS(p) + O_P);
  const float* E = (const float*)(WS(p) + O_E);
  h16* Z = (h16*)(WS(p) + O_Z);
  for (int unit = blockIdx.x; unit < 1024; unit += gridDim.x) {
    const int g = unit & 31, bc = unit >> 5, b = bc >> 3, ct = bc & 7;
    const int lg = l * 32 + g;
    __syncthreads();
    const int c0 = ct * 16;
    {
      const h16x8* ks = (const h16x8*)(WS(p) + O_KTAB + (size_t)lg * SZ_KTAB);
      for (int i = tid; i < 65 * 32; i += NT) ((h16x8*)Kt)[i] = ks[i];
      for (int i = tid; i < 2048; i += NT) {
        int tk = i >> 1, hf = i & 1;
        h16x8 v = *(const h16x8*)(P + ((size_t)b * SEQ + ct * 1024 + tk) * IWP + OFF_U + g * 16 + hf * 8);
        *(h16x8*)(Bu + (tk >> 6) * BU_PITCH + (tk & 63) * 16 + hf * 8) = v;
      }
      const float2* Eb = (const float2*)E + ((size_t)(b * 128) * 32 + g) * 64;
      for (int i = tid; i < (c0 + 16) * 64; i += NT) Es[i] = Eb[(size_t)(i >> 6) * 2048 + (i & 63)];
    }
    __syncthreads();
    if (w == 0) {
      float2 at = ((const float2*)(WS(p) + O_AT))[lg * 64 + lane];
      float sr = 0.f, si = 0.f;
#pragma unroll 8
      for (int c = 0; c < c0; ++c) {
        float2 e = Es[c * 64 + lane];
        float nr = at.x * sr - at.y * si + e.x, ni = at.x * si + at.y * sr + e.y;
        sr = nr; si = ni;
      }
#pragma unroll
      for (int i = 0; i < 16; ++i) {
        Bs[i * BS_PITCH + 2 * lane] = (h16)sr;
        Bs[i * BS_PITCH + 2 * lane + 1] = (h16)si;
        float2 e = Es[(c0 + i) * 64 + lane];
        float nr = at.x * sr - at.y * si + e.x, ni = at.x * si + at.y * sr + e.y;
        sr = nr; si = ni;
      }
    }
    __syncthreads();
    const float dt = expf(p.in[8][lg]);
    const int col = lane & 15, hi = lane >> 5, qh = (lane >> 4) & 1, p0 = (lane >> 4) * 4;
    const h16* W3 = (const h16*)(WS(p) + O_W3 + (size_t)lg * SZ_W13);
    float dsk[4];
    for (int j = 0; j < 4; ++j) dsk[j] = p.in[13][l * 512 + g * 16 + p0 + j];
    for (int r = 0; r < 64 / NW; ++r) {
      const int base = (r >> 1) * 2 * NW;
      const int tau = (r & 1) ? base + 2 * NW - 1 - w : base + w;
      f32x4 acc = {0.f, 0.f, 0.f, 0.f};
      const int nks = tau / 2 + 1;
      h16x8 A3[4];
#pragma unroll
      for (int ks = 0; ks < 4; ++ks)
        A3[ks] = *(const h16x8*)(W3 + ((size_t)((tau * 16 + ks * 4 + (lane >> 4)) * 16) + (lane & 15)) * 8);
      for (int i = 0; i < nks; ++i) {
        int j = tau - (2 * i + hi);
        h16x8 A = *(const h16x8*)(Kt + (j + 1) * 256 + (lane & 15) * 16 + qh * 8);
        h16x8 B = *(const h16x8*)(Bu + col * BU_PITCH + (2 * i + hi) * 16 + qh * 8);
        acc = __builtin_amdgcn_mfma_f32_16x16x32_f16(A, B, acc, 0, 0, 0);
      }
#pragma unroll
      for (int ks = 0; ks < 4; ++ks) {
        h16x8 B = *(const h16x8*)(Bs + col * BS_PITCH + ks * 32 + (lane >> 4) * 8);
        acc = __builtin_amdgcn_mfma_f32_16x16x32_f16(A3[ks], B, acc, 0, 0, 0);
      }
      const h16* up = Bu + col * BU_PITCH + tau * 16 + p0;
      size_t tok = ((size_t)b * 128 + ct * 16 + col) * 64 + tau;
      h16 zz[4];
      for (int j = 0; j < 4; ++j) zz[j] = (h16)gelu_tanh(dt * acc[j] + dsk[j] * (float)up[j]);
      typedef __attribute__((ext_vector_type(4))) _Float16 h16x4;
      h16x4 zv = {zz[0], zz[1], zz[2], zz[3]};
      *(h16x4*)(Z + tok * 512 + g * 16 + p0) = zv;
    }
  }
}

#define LAS __attribute__((address_space(3)))
typedef _Float16 h16x4 __attribute__((ext_vector_type(4)));
#define XB_TMO      128
#define XB_XCNT(j)  (256  + 64 * (j))
#define XB_XSUB(j)  (1280 + 64 * (j))
#define XB_XGEN(j)  (2304 + 64 * (j))
#define XB_TOP      3328
#define XB_TOPGEN   3392
#define XCD_BAR_WORDS 3456
#define XB_SPIN_CAP (1u << 18)

__device__ __forceinline__ unsigned xb_ld(unsigned* p)              { return __hip_atomic_load(p, __ATOMIC_RELAXED, __HIP_MEMORY_SCOPE_AGENT); }
__device__ __forceinline__ unsigned xb_add(unsigned* p, unsigned v) { return __hip_atomic_fetch_add(p, v, __ATOMIC_RELAXED, __HIP_MEMORY_SCOPE_AGENT); }
__device__ __forceinline__ unsigned xb_xcc_id() { return (unsigned)__builtin_amdgcn_s_getreg((3 << 11) | 20) & 0xFu; }
#define XB_SPIN(cond, bar) do { unsigned _sp = 0; while (cond) { __builtin_amdgcn_s_sleep(1); \
    if ((++_sp & 255u) == 0u) { if (xb_ld(&(bar)[XB_TMO])) break; if (_sp > XB_SPIN_CAP) { atomicAdd(&(bar)[XB_TMO], 1u); break; } } } } while (0)

struct XcdBarrier {
    unsigned* bar; unsigned x;
    volatile LAS unsigned* st;
};

__device__ __forceinline__ XcdBarrier xcd_barrier_post(unsigned* bar, volatile LAS unsigned* st) {
    XcdBarrier b; b.bar = bar; b.x = xb_xcc_id(); b.st = st;
    if (threadIdx.x == 0) (void)xb_add(&bar[XB_XCNT(b.x)], 1u);
    return b;
}
__device__ __forceinline__ void xcd_barrier_complete(unsigned* bar, unsigned x, unsigned& nloc, unsigned& nx) {
    const unsigned G = gridDim.x * gridDim.y * gridDim.z;
    unsigned sum, cnt, mine, sp = 0u;
    for (;;) {
        sum = 0u; cnt = 0u; mine = 0u;
#pragma unroll
        for (unsigned j = 0; j < 16; ++j) { const unsigned c = xb_ld(&bar[XB_XCNT(j)]); sum += c; cnt += (c > 0u) ? 1u : 0u; mine = (j == x) ? c : mine; }
        if (sum == G) break;
        __builtin_amdgcn_s_sleep(1);
        if ((++sp & 255u) == 0u) { if (xb_ld(&bar[XB_TMO])) break; if (sp > XB_SPIN_CAP) { atomicAdd(&bar[XB_TMO], 1u); break; } }
    }
    nloc = mine > 0u ? mine : 1u; nx = cnt > 0u ? cnt : 1u;
}

__device__ __forceinline__ void xcd_barrier(const XcdBarrier& b) {
    asm volatile("s_waitcnt vmcnt(0)" ::: "memory");
    __syncthreads();
    if (threadIdx.x == 0) {
        unsigned* bar = b.bar;
        __builtin_amdgcn_s_waitcnt(0);
        unsigned nloc = b.st[0], nx = b.st[1];
        if (nloc == 0u) { xcd_barrier_complete(bar, b.x, nloc, nx); b.st[0] = nloc; b.st[1] = nx; }
        const unsigned old = xb_add(&bar[XB_XSUB(b.x)], 1u);
        const unsigned gen = old / nloc;
        if (old + 1u == (gen + 1u) * nloc) {
            __builtin_amdgcn_fence(__ATOMIC_RELEASE, "agent");
            asm volatile("s_waitcnt vmcnt(0)" ::: "memory");
            const unsigned og = xb_add(&bar[XB_TOP], 1u);
            const unsigned tg = og / nx;
            if (og + 1u == (tg + 1u) * nx) xb_add(&bar[XB_TOPGEN], 1u);
            else XB_SPIN(xb_ld(&bar[XB_TOPGEN]) == tg, bar);
            __builtin_amdgcn_fence(__ATOMIC_ACQUIRE, "agent");
            xb_add(&bar[XB_XGEN(b.x)], 1u);
            asm volatile("s_waitcnt vmcnt(0)" ::: "memory");
        } else {
            XB_SPIN(xb_ld(&bar[XB_XGEN(b.x)]) == gen, bar);
            __builtin_amdgcn_fence(__ATOMIC_ACQUIRE, "agent");
            asm volatile("s_waitcnt vmcnt(0)" ::: "memory");
        }
    }
    __syncthreads();
}


namespace g8 {
constexpr int BM = 256, BK = 64, HALF = 128, HTB = HALF * BK * 2, STAGE_BYTES = 8 * HTB, NXCD = 8, WGM = 8;
__device__ __forceinline__ int lds_byte(int r, int c) {
  const int st = (r >> 4) * 2 + (c >> 5), rr = r & 15, cc = c & 31, ob = rr * 64 + cc * 2;
  return st * 1024 + (ob ^ (((ob >> 9) & 1) << 5));
}
__device__ __forceinline__ void stage_rc(int b, int& R, int& C) {
  const int st = b / 1024, sb = b % 1024, swz = sb ^ (((sb >> 9) & 1) << 5);
  R = (st >> 1) * 16 + swz / 64;
  C = (st & 1) * 32 + (swz % 64) / 2;
}
struct Unit { int pm, pn; };
struct Order {
  int nM, nN, nwg, G, c;
  __device__ void init(int M, int N, int G_, int c_) { nM = M / BM; nN = N / BM; nwg = nM * nN; G = G_; c = c_; }
  __device__ bool next(int i, Unit& u) const {
    const long L = (long)i * G + c;
    if (L >= nwg) return false;
    int wgid = (int)L;
    { const int q = nwg / NXCD, r = nwg % NXCD, xcd = wgid % NXCD, off = wgid / NXCD; wgid = (xcd < r ? xcd * (q + 1) : r * (q + 1) + (xcd - r) * q) + off; }
    const int nig = WGM * nN, gid = wgid / nig, fm = gid * WGM, gsz = (nM - fm) < WGM ? (nM - fm) : WGM;
    u.pm = fm + ((wgid % nig) % gsz);
    u.pn = (wgid % nig) / gsz;
    return true;
  }
};
template <class Epi>
__device__ __forceinline__ void gemm_phase(LAS unsigned char* lds, const h16* A, const h16* Bt, int K, const Order& S, const Epi& E) {
  const int tid = opaque_tid(), wid = __builtin_amdgcn_readfirstlane(tid >> 6), lane = tid & 63, wr = wid >> 2, wc = wid & 3, fr = lane & 15, fq = lane >> 4;
  const int nt = K / BK;
  unsigned voffA[2];
#pragma unroll
  for (int i = 0; i < 2; ++i) { int R, C; stage_rc(tid * 16 + i * 8192, R, C); voffA[i] = (unsigned)(R * K + C) * 2u; }
  const size_t kstep = (size_t)(BK * 2);
  const size_t hstep = (size_t)HALF * K * 2;
  const size_t tstep = 2 * hstep;
  const unsigned ldsw = (unsigned)wid * 1024u;
  const int aoff = lds_byte(wr * 64 + fr, fq * 8), boff = lds_byte(wc * 32 + fr, fq * 8);
#define G8_SA(b, h) (((b) * 2 + (h)) * HTB)
#define G8_SB(b, h) ((4 + (b) * 2 + (h)) * HTB)
#define G8_STAGE(bufoff, gbase) do { _Pragma("unroll") for (int _i = 0; _i < 2; ++_i) \
    __builtin_amdgcn_global_load_lds((const unsigned*)((const char*)(gbase) + voffA[_i]), (LAS unsigned*)(lds + (bufoff) + ldsw + _i * 8192), 16, 0, 0); } while (0)
#define G8_LDA(dst, b, h) do { _Pragma("unroll") for (int m = 0; m < 4; ++m) _Pragma("unroll") for (int k = 0; k < 2; ++k) dst[m][k] = *(const LAS h16x8*)(lds + G8_SA(b, h) + aoff + m * 2048 + k * 1024); } while (0)
#define G8_LDB(dst, b, h) do { _Pragma("unroll") for (int n = 0; n < 2; ++n) _Pragma("unroll") for (int k = 0; k < 2; ++k) dst[n][k] = *(const LAS h16x8*)(lds + G8_SB(b, h) + boff + n * 2048 + k * 1024); } while (0)
#define G8_MMA(ai, bj, At, Bt_) do { __builtin_amdgcn_s_setprio(1); _Pragma("unroll") for (int m = 0; m < 4; ++m) _Pragma("unroll") for (int n = 0; n < 2; ++n) _Pragma("unroll") for (int k = 0; k < 2; ++k) \
    acc[ai][bj][m][n] = __builtin_amdgcn_mfma_f32_16x16x32_f16(Bt_[n][k], At[m][k], acc[ai][bj][m][n], 0, 0, 0); __builtin_amdgcn_s_setprio(0); } while (0)
#define G8_WAIT_V(n) asm volatile("s_waitcnt vmcnt(" #n ")" ::: "memory")
#define G8_WAIT_L(n) asm volatile("s_waitcnt lgkmcnt(" #n ")" ::: "memory")
#define G8_BAR __builtin_amdgcn_s_barrier()
#define G8_SCHED __builtin_amdgcn_sched_barrier(0)
  Unit cur, nxt;
  int ui = 0;
  if (!S.next(0, cur)) return;
  f32x4 acc[2][2][4][2];
#pragma unroll
  for (int a = 0; a < 2; ++a)
#pragma unroll
    for (int b = 0; b < 2; ++b)
#pragma unroll
      for (int m = 0; m < 4; ++m)
#pragma unroll
        for (int n = 0; n < 2; ++n) acc[a][b][m][n] = (f32x4){0.f, 0.f, 0.f, 0.f};
  h16x8 At[4][2], B0[2][2], B1[2][2];
  const char* cA = (const char*)A + (size_t)cur.pm * tstep;
  const char* cB = (const char*)Bt + (size_t)cur.pn * tstep;
  G8_STAGE(G8_SB(0, 0), cB); G8_STAGE(G8_SA(0, 0), cA); G8_STAGE(G8_SB(0, 1), cB + hstep); G8_STAGE(G8_SA(0, 1), cA + hstep);
  if (wr == 1) G8_BAR;
  G8_WAIT_V(4); G8_BAR;
  G8_STAGE(G8_SB(1, 0), cB + kstep); G8_STAGE(G8_SA(1, 0), cA + kstep); G8_STAGE(G8_SB(1, 1), cB + hstep + kstep);
  G8_WAIT_V(6); G8_BAR;
  for (;;) {
    const bool has_next = S.next(ui + 1, nxt);
    const char* nA = has_next ? (const char*)A + (size_t)nxt.pm * tstep : cA;
    const char* nB = has_next ? (const char*)Bt + (size_t)nxt.pn * tstep : cB;
    for (int t = 0; t < nt; t += 2) {
      const bool last = (t == nt - 2);
      const char* a1 = cA + (size_t)(t + 1) * kstep;
      const char* a2 = last ? nA : cA + (size_t)(t + 2) * kstep;
      const char* b2 = last ? nB : cB + (size_t)(t + 2) * kstep;
      const char* a3 = a2 + kstep;
      const char* b3 = b2 + kstep;
      if (Epi::MID_T >= 0 && t == Epi::MID_T) E.mid(acc, ui, wr, fr);
      G8_LDB(B0, 0, 0); G8_SCHED; G8_LDA(At, 0, 0); G8_STAGE(G8_SA(1, 1), a1 + hstep);
      G8_WAIT_L(8); G8_BAR; G8_WAIT_L(0); G8_MMA(0, 0, At, B0); G8_BAR; G8_SCHED;
      G8_LDB(B1, 0, 1); G8_STAGE(G8_SB(0, 0), b2);
      G8_BAR; G8_WAIT_L(0); G8_MMA(0, 1, At, B1); G8_BAR;
      G8_LDA(At, 0, 1); G8_STAGE(G8_SA(0, 0), a2);
      G8_BAR; G8_WAIT_L(0); G8_MMA(1, 0, At, B0); G8_BAR; G8_SCHED;
      G8_STAGE(G8_SB(0, 1), b2 + hstep);
      G8_WAIT_V(6); G8_BAR; G8_MMA(1, 1, At, B1); G8_BAR;
      G8_LDB(B0, 1, 0); G8_SCHED; G8_LDA(At, 1, 0); G8_STAGE(G8_SA(0, 1), a2 + hstep);
      G8_WAIT_L(8); G8_BAR; G8_WAIT_L(0); G8_MMA(0, 0, At, B0); G8_BAR; G8_SCHED;
      G8_LDB(B1, 1, 1); G8_STAGE(G8_SB(1, 0), b3);
      G8_BAR; G8_WAIT_L(0); G8_MMA(0, 1, At, B1); G8_BAR;
      G8_LDA(At, 1, 1); G8_STAGE(G8_SA(1, 0), a3);
      G8_BAR; G8_WAIT_L(0); G8_MMA(1, 0, At, B0); G8_BAR; G8_SCHED;
      G8_STAGE(G8_SB(1, 1), b3 + hstep);
      G8_WAIT_V(6); G8_BAR; G8_MMA(1, 1, At, B1); G8_BAR;
    }
    E(acc, cur, ui, wr, wc, fr, fq);
    if (!has_next) break;
#pragma unroll
    for (int a = 0; a < 2; ++a)
#pragma unroll
      for (int b = 0; b < 2; ++b)
#pragma unroll
        for (int m = 0; m < 4; ++m)
#pragma unroll
          for (int n = 0; n < 2; ++n) acc[a][b][m][n] = (f32x4){0.f, 0.f, 0.f, 0.f};
    cur = nxt; cA = nA; cB = nB; ++ui;
  }
  G8_WAIT_V(0);
  if (wr == 0) G8_BAR;
  G8_BAR;
#undef G8_SA
#undef G8_SB
#undef G8_STAGE
#undef G8_LDA
#undef G8_LDB
#undef G8_MMA
#undef G8_WAIT_V
#undef G8_WAIT_L
#undef G8_BAR
#undef G8_SCHED
}
}

constexpr int RSL_OFF = g8::STAGE_BYTES;
constexpr int LDS_GEMM = g8::STAGE_BYTES + 8 * 256 * 4;

__device__ __forceinline__ void fill_rowscales(float* rsl, const float* ssq, float inv_n, const g8::Order& S) {
  const int tid = opaque_tid();
  g8::Unit u;
  __syncthreads();
  for (int i = 0; S.next(i, u); ++i) {
    if (tid < 256) {
      const float4* s4 = (const float4*)(ssq + (size_t)(u.pm * 256 + tid) * 16);
      float s = 0.f;
      for (int k = 0; k < 4; ++k) { float4 v = s4[k]; s += v.x + v.y + v.z + v.w; }
      rsl[i * 256 + tid] = rsqrtf(s * inv_n + EPS);
    }
  }
  __syncthreads();
}

__device__ __forceinline__ h16x4 pack4(float a, float b, float c, float d) { h16x4 v = {(h16)a, (h16)b, (h16)c, (h16)d}; return v; }

struct EpiIn {
  static constexpr int MID_T = -1;
  __device__ __forceinline__ void mid(f32x4 (&)[2][2][4][2], int, int, int) const {}
  h16* P; const float* rsl; const float* qkg;
  __device__ __forceinline__ void operator()(const f32x4 (&acc)[2][2][4][2], const g8::Unit& u, int ui, int wr, int wc, int fr, int fq) const {
    const int hs = u.pn * 4 + wc;
    int gi = -1;
    if (hs < 4) gi = 0; else if (hs < 6) gi = 1; else if (hs >= 16 && hs < 20) gi = 2; else if (hs == 22) gi = 4; else if (hs == 24) gi = 5;
    const bool gate = (hs == 26);
#pragma unroll
    for (int ai = 0; ai < 2; ++ai)
#pragma unroll
      for (int m = 0; m < 4; ++m) {
        const int rl = 128 * ai + 64 * wr + 16 * m + fr;
        float r = rsl[ui * 256 + rl];
        if (gi >= 0) {
          float ss = 0.f;
#pragma unroll
          for (int bj = 0; bj < 2; ++bj)
#pragma unroll
            for (int n = 0; n < 2; ++n)
#pragma unroll
              for (int j = 0; j < 4; ++j) ss += acc[ai][bj][m][n][j] * acc[ai][bj][m][n][j];
          ss += xor16(ss);
          ss += __shfl_xor(ss, 32);
          r *= rsqrtf(ss * r * r * (1.f / 64.f) + EPS);
        }
        h16* rowp = P + (size_t)(u.pm * 256 + rl) * IWP + 64 * hs + 4 * fq;
#pragma unroll
        for (int bj = 0; bj < 2; ++bj)
#pragma unroll
          for (int n = 0; n < 2; ++n) {
            f32x4 v = acc[ai][bj][m][n] * r;
            if (gi >= 0) {
              const float4 g4 = *(const float4*)(qkg + gi * 64 + 32 * bj + 16 * n + 4 * fq);
              v[0] *= g4.x; v[1] *= g4.y; v[2] *= g4.z; v[3] *= g4.w;
            } else if (gate) {
#pragma unroll
              for (int j = 0; j < 4; ++j) v[j] = (32 * bj + 16 * n + 4 * fq + j) < 12 ? sigmoidf(v[j]) : 0.f;
            }
            *(h16x4*)(rowp + 32 * bj + 16 * n) = pack4(v[0], v[1], v[2], v[3]);
          }
      }
  }
};

struct EpiGlu {
  static constexpr int MID_T = -1;
  __device__ __forceinline__ void mid(f32x4 (&)[2][2][4][2], int, int, int) const {}
  h16* OB; float* ssqb; const float* gb;
  __device__ __forceinline__ void operator()(const f32x4 (&acc)[2][2][4][2], const g8::Unit& u, int ui, int wr, int wc, int fr, int fq) const {
    const int ocb = 128 * u.pn + 16 * wc + 4 * fq;
    float4 ba[2], bb[2];
#pragma unroll
    for (int bj = 0; bj < 2; ++bj) { ba[bj] = *(const float4*)(gb + ocb + 64 * bj); bb[bj] = *(const float4*)(gb + 512 + ocb + 64 * bj); }
#pragma unroll
    for (int ai = 0; ai < 2; ++ai)
#pragma unroll
      for (int m = 0; m < 4; ++m) {
        const size_t row = (size_t)u.pm * 256 + 128 * ai + 64 * wr + 16 * m + fr;
        float ss = 0.f;
#pragma unroll
        for (int bj = 0; bj < 2; ++bj) {
          const f32x4 a = acc[ai][bj][m][0], b = acc[ai][bj][m][1];
          float o0 = (a[0] + ba[bj].x) * sigmoidf(b[0] + bb[bj].x);
          float o1 = (a[1] + ba[bj].y) * sigmoidf(b[1] + bb[bj].y);
          float o2 = (a[2] + ba[bj].z) * sigmoidf(b[2] + bb[bj].z);
          float o3 = (a[3] + ba[bj].w) * sigmoidf(b[3] + bb[bj].w);
          *(h16x4*)(OB + row * 1024 + ocb + 64 * bj) = pack4(o0, o1, o2, o3);
          ss += o0 * o0 + o1 * o1 + o2 * o2 + o3 * o3;
        }
        ss += xor16(ss);
        ss += __shfl_xor(ss, 32);
        if (fq == 0) ssqb[row * 16 + u.pn * 4 + wc] = ss;
      }
  }
};

struct EpiRes {
  static constexpr int MID_T = -1;
  __device__ __forceinline__ void mid(f32x4 (&)[2][2][4][2], int, int, int) const {}
  float* xo; const float* xsrc; h16* xb; float* ssq;
  __device__ __forceinline__ void operator()(const f32x4 (&acc)[2][2][4][2], const g8::Unit& u, int ui, int wr, int wc, int fr, int fq) const {
#pragma unroll
    for (int ai = 0; ai < 2; ++ai)
#pragma unroll
      for (int m = 0; m < 4; ++m) {
        const size_t row = (size_t)u.pm * 256 + 128 * ai + 64 * wr + 16 * m + fr;
        const size_t base = row * DM + 256 * u.pn + 32 * wc + 4 * fq;
        float ss = 0.f;
#pragma unroll
        for (int bj = 0; bj < 2; ++bj)
#pragma unroll
          for (int n = 0; n < 2; ++n) {
            const size_t idx = base + 128 * bj + 16 * n;
            const float4 xv = *(const float4*)(xsrc + idx);
            const f32x4 a = acc[ai][bj][m][n];
            const float x0 = xv.x + a[0], x1 = xv.y + a[1], x2 = xv.z + a[2], x3 = xv.w + a[3];
            *(float4*)(xo + idx) = make_float4(x0, x1, x2, x3);
            *(h16x4*)(xb + idx) = pack4(x0, x1, x2, x3);
            ss += x0 * x0 + x1 * x1 + x2 * x2 + x3 * x3;
          }
        ss += xor16(ss);
        ss += __shfl_xor(ss, 32);
        if (fq == 0) ssq[row * 16 + u.pn * 4 + wc] = ss;
      }
  }
};

struct EpiOut : EpiRes {
  static constexpr int MID_T = 8;
  const float* rsl;
  __device__ __forceinline__ void mid(f32x4 (&acc)[2][2][4][2], int ui, int wr, int fr) const {
#pragma unroll
    for (int ai = 0; ai < 2; ++ai)
#pragma unroll
      for (int m = 0; m < 4; ++m) {
        const float r = rsl[ui * 256 + 128 * ai + 64 * wr + 16 * m + fr];
#pragma unroll
        for (int bj = 0; bj < 2; ++bj)
#pragma unroll
          for (int n = 0; n < 2; ++n) acc[ai][bj][m][n] *= r;
      }
  }
};

struct EpiUp {
  static constexpr int MID_T = -1;
  __device__ __forceinline__ void mid(f32x4 (&)[2][2][4][2], int, int, int) const {}
  h16* hid; const float* rsl;
  __device__ __forceinline__ void operator()(const f32x4 (&acc)[2][2][4][2], const g8::Unit& u, int ui, int wr, int wc, int fr, int fq) const {
#pragma unroll
    for (int ai = 0; ai < 2; ++ai)
#pragma unroll
      for (int m = 0; m < 4; ++m) {
        const int rl = 128 * ai + 64 * wr + 16 * m + fr;
        const float r = rsl[ui * 256 + rl];
        h16* rowp = hid + (size_t)(u.pm * 256 + rl) * DFF + 256 * u.pn + 32 * wc + 4 * fq;
#pragma unroll
        for (int bj = 0; bj < 2; ++bj)
#pragma unroll
          for (int n = 0; n < 2; ++n) {
            const f32x4 a = acc[ai][bj][m][n];
            float v0 = fmaxf(a[0] * r, 0.f), v1 = fmaxf(a[1] * r, 0.f), v2 = fmaxf(a[2] * r, 0.f), v3 = fmaxf(a[3] * r, 0.f);
            *(h16x4*)(rowp + 128 * bj + 16 * n) = pack4(v0 * v0, v1 * v1, v2 * v2, v3 * v3);
          }
      }
  }
};

__device__ __forceinline__ void phase_gemm1(const Params& p, int l, char* lds) {
  g8::Order S; S.init(NTOK, IWP, gridDim.x, blockIdx.x);
  float* rsl = (float*)(lds + RSL_OFF);
  fill_rowscales(rsl, (const float*)(WS(p) + O_SSQ), 1.f / DM, S);
  EpiIn E{(h16*)(WS(p) + O_P), rsl, p.in[3] + l * 6 * 64};
  g8::gemm_phase((LAS unsigned char*)lds, (const h16*)(WS(p) + O_XB), (const h16*)(WS(p) + O_WIN + l * SZ_WIN), DM, S, E);
}
__device__ __forceinline__ void phase_glu(const Params& p, int l, char* lds) {
  g8::Order S; S.init(NTOK, 1024, gridDim.x, blockIdx.x);
  __syncthreads();
  EpiGlu E{(h16*)(WS(p) + O_OB), (float*)(WS(p) + O_SSQB), p.in[15] + l * 1024};
  g8::gemm_phase((LAS unsigned char*)lds, (const h16*)(WS(p) + O_Z), (const h16*)(WS(p) + O_WGLU + l * SZ_WGLU), 512, S, E);
}
__device__ __forceinline__ void phase_wout(const Params& p, int l, char* lds) {
  g8::Order S; S.init(NTOK, DM, gridDim.x, blockIdx.x);
  float* rsl = (float*)(lds + RSL_OFF);
  fill_rowscales(rsl, (const float*)(WS(p) + O_SSQB), 1.f / 512.f, S);
  EpiOut E;
  E.xo = p.out; E.xsrc = (l == 0) ? p.in[0] : p.out; E.xb = (h16*)(WS(p) + O_XB); E.ssq = (float*)(WS(p) + O_SSQ); E.rsl = rsl;
  g8::gemm_phase((LAS unsigned char*)lds, (const h16*)(WS(p) + O_OB), (const h16*)(WS(p) + O_WOUT + l * SZ_WOUT), DM, S, E);
}
__device__ __forceinline__ void phase_up(const Params& p, int l, char* lds) {
  g8::Order S; S.init(NTOK, DFF, gridDim.x, blockIdx.x);
  float* rsl = (float*)(lds + RSL_OFF);
  fill_rowscales(rsl, (const float*)(WS(p) + O_SSQ), 1.f / DM, S);
  EpiUp E{(h16*)(WS(p) + O_HID), rsl};
  g8::gemm_phase((LAS unsigned char*)lds, (const h16*)(WS(p) + O_XB), (const h16*)(WS(p) + O_WUP + l * SZ_WUP), DM, S, E);
}
__device__ __forceinline__ void phase_down(const Params& p, int l, char* lds) {
  g8::Order S; S.init(NTOK, DM, gridDim.x, blockIdx.x);
  __syncthreads();
  EpiRes E{p.out, p.out, (h16*)(WS(p) + O_XB), (float*)(WS(p) + O_SSQ)};
  g8::gemm_phase((LAS unsigned char*)lds, (const h16*)(WS(p) + O_HID), (const h16*)(WS(p) + O_WDN + l * SZ_WDN), DFF, S, E);
}

constexpr int KP = 72;
enum { M_SWA = 0, M_WIN = 1, M_SEL = 2, M_CMPA = 3, M_CMPB = 4 };
constexpr float LOG2E = 1.4426950408889634f, SCL2 = 0.125f * LOG2E;
struct ColState { float m, l; };
typedef short s16x4v __attribute__((__vector_size__(8)));

__device__ __forceinline__ h16x8 ld_row8(const h16* base, int ld, int row, int nrows, int c8) {
  h16x8 z = {0, 0, 0, 0, 0, 0, 0, 0};
  return (row >= 0 && row < nrows) ? *(const h16x8*)(base + (size_t)row * ld + c8 * 8) : z;
}
__device__ __forceinline__ void st_k(h16* Ks, int row, int c8, h16x8 v) { *(h16x8*)(Ks + row * KP + c8 * 8) = v; }
__device__ __forceinline__ void st_vt(h16* Vt, int row, int c8, h16x8 v) {
#pragma unroll
  for (int e = 0; e < 8; ++e) Vt[(c8 * 8 + e) * KP + row] = v[e];
}
__device__ __forceinline__ float max4q(float v) {
  v = fmaxf(v, xor16(v));
  auto r = __builtin_amdgcn_permlane32_swap(__float_as_int(v), __float_as_int(v), false, false);
  return fmaxf(__int_as_float(r[0]), __int_as_float(r[1]));
}
__device__ __forceinline__ float sum4q(float v) {
  v += xor16(v);
  auto r = __builtin_amdgcn_permlane32_swap(__float_as_int(v), __float_as_int(v), false, false);
  return __int_as_float(r[0]) + __int_as_float(r[1]);
}
__device__ __forceinline__ float quadsum(float v) { v += dppf<0xB1>(v); v += dppf<0x4E>(v); return v; }

template <int MODE, int RGM>
__device__ __forceinline__ void attn_tile(const h16x8 (&Q)[2][2], f32x4 (&O)[2][4], ColState (&st)[2], const h16* Ks,
                                          const h16* Vt, const float* biasT, const int (&tq)[2], int hd, int kbase, bool far,
                                          const bool (&selbit)[2], float (&hq)[2][4], float (&h3)[2][4], const int lane) {
  const int col = lane & 15, q4 = lane >> 4;
  constexpr int DK = (MODE == M_CMPA || MODE == M_CMPB) ? 16 : 1;
  f32x4 S[2][4];
#pragma unroll
  for (int kt = 0; kt < 4; ++kt) {
#pragma unroll
    for (int rg = 0; rg < 2; ++rg) S[rg][kt] = f32x4{0.f, 0.f, 0.f, 0.f};
#pragma unroll
    for (int ks = 0; ks < 2; ++ks) {
      h16x8 Kf = *(const h16x8*)(Ks + (kt * 16 + col) * KP + ks * 32 + q4 * 8);
#pragma unroll
      for (int rg = 0; rg < 2; ++rg)
        if (RGM & (1 << rg)) S[rg][kt] = __builtin_amdgcn_mfma_f32_16x16x32_f16(Kf, Q[rg][ks], S[rg][kt], 0, 0, 0);
    }
  }
  h16x8 Pf[2][2];
#pragma unroll
  for (int rg = 0; rg < 2; ++rg) {
    if (!(RGM & (1 << rg))) continue;
    const float* bt = biasT + hd * 800;
    if (far) {
      const float b31 = bt[799];
      const bool ok = (MODE == M_SEL) ? selbit[rg] : true;
#pragma unroll
      for (int kt = 0; kt < 4; ++kt)
#pragma unroll
        for (int j = 0; j < 4; ++j) S[rg][kt][j] = ok ? S[rg][kt][j] * SCL2 + b31 : -1e30f;
    } else {
      const int kx0 = kbase + q4 * 4;
      const int d0 = (DK == 16) ? tq[rg] - 31 - 16 * kx0 : tq[rg] - kx0;
#pragma unroll
      for (int kt = 0; kt < 4; ++kt)
#pragma unroll
        for (int j = 0; j < 4; ++j) {
          const int dist = d0 - DK * (kt * 16 + j);
          const int kx = kx0 + kt * 16 + j;
          bool valid = dist >= 0;
          if (MODE == M_SWA) valid = valid && dist < 128 && kx >= 0;
          if (MODE == M_WIN) valid = valid && dist < 512 && kx >= 0;
          if (MODE == M_SEL) valid = valid && selbit[rg];
          if (DK == 16) valid = valid && kx < NCMP;
          const int dc = dist < 0 ? 0 : (dist > 799 ? 799 : dist);
          S[rg][kt][j] = valid ? S[rg][kt][j] * SCL2 + bt[dc] : -1e30f;
        }
    }
    if (MODE == M_CMPB) {
#pragma unroll
      for (int kt = 0; kt < 4; ++kt) {
        float h = 0.f;
#pragma unroll
        for (int j = 0; j < 4; ++j) {
          float pv = __builtin_amdgcn_exp2f(S[rg][kt][j] - st[rg].m) * st[rg].l;
          S[rg][kt][j] = pv;
          h += pv;
        }
        hq[rg][kt] = h;
        h3[rg][kt] = S[rg][kt][3];
      }
    } else {
      float mx = -1e30f;
#pragma unroll
      for (int kt = 0; kt < 4; ++kt)
#pragma unroll
        for (int j = 0; j < 4; ++j) mx = fmaxf(mx, S[rg][kt][j]);
      mx = max4q(mx);
      const float mn = fmaxf(st[rg].m, mx);
      const float corr = __builtin_amdgcn_exp2f(st[rg].m - mn);
      st[rg].m = mn;
      const float mm = fmaxf(mn, -1e20f);
      float ls = 0.f;
#pragma unroll
      for (int kt = 0; kt < 4; ++kt)
#pragma unroll
        for (int j = 0; j < 4; ++j) {
          float pv = __builtin_amdgcn_exp2f(S[rg][kt][j] - mm);
          S[rg][kt][j] = pv;
          ls += pv;
        }
      st[rg].l = st[rg].l * corr + ls;
      if (MODE != M_CMPA) {
#pragma unroll
        for (int nt = 0; nt < 4; ++nt) O[rg][nt] *= corr;
      }
    }
    if (MODE != M_CMPA) {
#pragma unroll
      for (int ks = 0; ks < 2; ++ks)
#pragma unroll
        for (int i = 0; i < 4; ++i) {
          Pf[rg][ks][i] = (h16)S[rg][2 * ks][i];
          Pf[rg][ks][4 + i] = (h16)S[rg][2 * ks + 1][i];
        }
    }
  }
  if (MODE == M_CMPA) return;
#pragma unroll
  for (int ks = 0; ks < 2; ++ks)
#pragma unroll
    for (int nt = 0; nt < 4; ++nt) {
      const h16* vp = Vt + (ks * 32 + q4 * 4 + (col >> 2)) * KP + nt * 16 + 4 * (col & 3);
      const s16x4v r0 = __builtin_amdgcn_ds_read_tr16_b64_v4i16((LAS s16x4v*)vp);
      const s16x4v r1 = __builtin_amdgcn_ds_read_tr16_b64_v4i16((LAS s16x4v*)(vp + 16 * KP));
      const h16x4 v0 = __builtin_bit_cast(h16x4, r0), v1 = __builtin_bit_cast(h16x4, r1);
      const h16x8 Vf = {v0[0], v0[1], v0[2], v0[3], v1[0], v1[1], v1[2], v1[3]};
#pragma unroll
      for (int rg = 0; rg < 2; ++rg)
        if (RGM & (1 << rg)) O[rg][nt] = __builtin_amdgcn_mfma_f32_16x16x32_f16(Vf, Pf[rg][ks], O[rg][nt], 0, 0, 0);
    }
}

constexpr int LDS_CMP = 8 * 16 * 128 * 4 + 16 * 136 * 2 + 4 * 16 * 4;
__device__ __forceinline__ void phase_compress(const Params& p, int l, char* lds) {
  const int tid = opaque_tid(), lane = tid & 63, w = tid >> 6, col = lane & 15, q4 = lane >> 4;
  float* red = (float*)lds;
  h16* hid = (h16*)(lds + 8 * 16 * 128 * 4);
  float* nrm2 = (float*)(lds + 8 * 16 * 128 * 4 + 16 * 136 * 2);
  const h16* P = (const h16*)(WS(p) + O_P);
  for (int u = blockIdx.x; u < BATCH * 2 * 32; u += gridDim.x) {
    const int mt = u & 31, st = (u >> 5) & 1, b = u >> 6;
    const h16* W1t = (const h16*)(WS(p) + O_W1T) + (size_t)(l * 2 + st) * 128 * 2048;
    const h16* W2t = (const h16*)(WS(p) + O_W2T) + (size_t)(l * 2 + st) * 64 * 128;
    const float* b1 = (const float*)(WS(p) + O_BIAS1) + (l * 2 + st) * 128;
    __syncthreads();
    {
      f32x4 acc[8];
#pragma unroll
      for (int nt = 0; nt < 8; ++nt) acc[nt] = f32x4{0.f, 0.f, 0.f, 0.f};
      const int m = 16 * mt + col;
#pragma unroll 2
      for (int kk = 0; kk < 8; ++kk) {
        const int ks = 8 * w + kk, tt = ks >> 1, d0 = (ks & 1) * 32 + q4 * 8;
        int tok = 16 * m + tt;
        if (tok > SEQ - 1) tok = SEQ - 1;
        const h16x8 A = *(const h16x8*)(P + ((size_t)b * SEQ + tok) * IWP + OFF_KVC + st * 64 + d0);
#pragma unroll
        for (int nt = 0; nt < 8; ++nt) {
          const h16x8 B = *(const h16x8*)(W1t + (size_t)(nt * 16 + col) * 2048 + ks * 32 + q4 * 8);
          acc[nt] = __builtin_amdgcn_mfma_f32_16x16x32_f16(A, B, acc[nt], 0, 0, 0);
        }
      }
#pragma unroll
      for (int nt = 0; nt < 8; ++nt)
#pragma unroll
        for (int j = 0; j < 4; ++j) red[(w * 16 + q4 * 4 + j) * 128 + nt * 16 + col] = acc[nt][j];
    }
    __syncthreads();
    {
      const int row = tid >> 5, c4 = (tid & 31) * 4;
      float4 sum = *(const float4*)(b1 + c4);
#pragma unroll
      for (int ww = 0; ww < 8; ++ww) {
        const float4 v = *(const float4*)(red + (ww * 16 + row) * 128 + c4);
        sum.x += v.x; sum.y += v.y; sum.z += v.z; sum.w += v.w;
      }
      *(h16x4*)(hid + row * 136 + c4) = pack4(gelu_tanh(sum.x), gelu_tanh(sum.y), gelu_tanh(sum.z), gelu_tanh(sum.w));
    }
    __syncthreads();
    f32x4 o2 = {0.f, 0.f, 0.f, 0.f};
    if (w < 4) {
#pragma unroll
      for (int ks = 0; ks < 4; ++ks) {
        const h16x8 A = *(const h16x8*)(hid + col * 136 + ks * 32 + q4 * 8);
        const h16x8 B = *(const h16x8*)(W2t + (size_t)(w * 16 + col) * 128 + ks * 32 + q4 * 8);
        o2 = __builtin_amdgcn_mfma_f32_16x16x32_f16(A, B, o2, 0, 0, 0);
      }
      if (st == 0) {
#pragma unroll
        for (int j = 0; j < 4; ++j) {
          float ss = sum16(o2[j] * o2[j]);
          if (col == 0) nrm2[w * 16 + q4 * 4 + j] = ss;
        }
      }
    }
    __syncthreads();
    if (w < 4) {
      const float g = p.in[3][(l * 6 + 3) * 64 + w * 16 + col];
      h16* dst = (h16*)(WS(p) + (st == 0 ? O_KCMP : O_VCMP));
#pragma unroll
      for (int j = 0; j < 4; ++j) {
        const int row = q4 * 4 + j, m = 16 * mt + row;
        float v = o2[j];
        if (st == 0) {
          float tot = nrm2[row] + nrm2[16 + row] + nrm2[32 + row] + nrm2[48 + row];
          v = v * rsqrtf(tot * (1.f / 64.f) + EPS) * g;
        }
        if (m >= NCMP) v = 0.f;
        dst[((size_t)b * 512 + m) * 64 + w * 16 + col] = (h16)v;
      }
    }
  }
}


template <int MODE, int TM>
__device__ __forceinline__ void attn_tile2(const h16x8 (&Q)[2], f32x4 (&O)[4], ColState& st, const h16* Ks0, const h16* Vt0,
                                           const h16* Ks1, const h16* Vt1, const float* biasT, int tq, int hd, int kbase0,
                                           const bool (&far)[2], const bool (&selbit)[2], float (&hq)[2][4], float (&h3)[2][4],
                                           const int lane) {
  const int col = lane & 15, q4 = lane >> 4;
  constexpr int DK = (MODE == M_CMPA || MODE == M_CMPB) ? 16 : 1;
  f32x4 S[2][4];
#pragma unroll
  for (int t = 0; t < 2; ++t) {
    if (!(TM & (1 << t))) continue;
    const h16* Ks = t ? Ks1 : Ks0;
#pragma unroll
    for (int kt = 0; kt < 4; ++kt) {
      S[t][kt] = f32x4{0.f, 0.f, 0.f, 0.f};
#pragma unroll
      for (int ks = 0; ks < 2; ++ks) {
        h16x8 Kf = *(const h16x8*)(Ks + (kt * 16 + col) * KP + ks * 32 + q4 * 8);
        S[t][kt] = __builtin_amdgcn_mfma_f32_16x16x32_f16(Kf, Q[ks], S[t][kt], 0, 0, 0);
      }
    }
  }
  const float* bt = biasT + hd * 800;
  float addc[2] = {0.f, 0.f}, sclc[2] = {1.f, 1.f};
#pragma unroll
  for (int t = 0; t < 2; ++t) {
    if (!(TM & (1 << t))) continue;
    const int kbase = kbase0 + 64 * t;
    if (far[t]) {
      const bool ok = (MODE == M_SEL) ? selbit[t] : true;
      addc[t] = ok ? bt[799] : -1e30f;
      sclc[t] = SCL2;
    } else {
      addc[t] = 0.f;
      sclc[t] = 1.f;
      const int kx0 = kbase + q4 * 4;
      const int d0 = (DK == 16) ? tq - 31 - 16 * kx0 : tq - kx0;
#pragma unroll
      for (int kt = 0; kt < 4; ++kt)
#pragma unroll
        for (int j = 0; j < 4; ++j) {
          const int dist = d0 - DK * (kt * 16 + j);
          const int kx = kx0 + kt * 16 + j;
          bool valid = dist >= 0;
          if (MODE == M_WIN) valid = valid && dist < 512 && kx >= 0;
          if (MODE == M_SEL) valid = valid && selbit[t];
          if (DK == 16) valid = valid && kx < NCMP;
          const int dc = dist < 0 ? 0 : (dist > 799 ? 799 : dist);
          S[t][kt][j] = valid ? S[t][kt][j] * SCL2 + bt[dc] : -1e30f;
        }
    }
  }
  if (MODE == M_CMPB) {
#pragma unroll
    for (int t = 0; t < 2; ++t) {
      if (!(TM & (1 << t))) continue;
#pragma unroll
      for (int kt = 0; kt < 4; ++kt) {
        float h = 0.f;
#pragma unroll
        for (int j = 0; j < 4; ++j) {
          float pv = __builtin_amdgcn_exp2f(S[t][kt][j] * sclc[t] + (addc[t] - st.m)) * st.l;
          S[t][kt][j] = pv;
          h += pv;
        }
        hq[t][kt] = h;
        h3[t][kt] = S[t][kt][3];
      }
    }
  } else {
    float mx = -1e30f;
#pragma unroll
    for (int t = 0; t < 2; ++t) {
      if (!(TM & (1 << t))) continue;
      float mt = -1e30f;
#pragma unroll
      for (int kt = 0; kt < 4; ++kt)
#pragma unroll
        for (int j = 0; j < 4; ++j) mt = fmaxf(mt, S[t][kt][j]);
      mx = fmaxf(mx, mt * sclc[t] + addc[t]);
    }
    mx = max4q(mx);
    const float mn = fmaxf(st.m, mx);
    const float corr = __builtin_amdgcn_exp2f(st.m - mn);
    st.m = mn;
    const float mm = fmaxf(mn, -1e20f);
    float ls = 0.f;
#pragma unroll
    for (int t = 0; t < 2; ++t) {
      if (!(TM & (1 << t))) continue;
      const float am = addc[t] - mm;
#pragma unroll
      for (int kt = 0; kt < 4; ++kt) {
        const f32x4 e = S[t][kt] * sclc[t] + am;
#pragma unroll
        for (int j = 0; j < 4; ++j) {
          float pv = __builtin_amdgcn_exp2f(e[j]);
          S[t][kt][j] = pv;
          ls += pv;
        }
      }
    }
    st.l = st.l * corr + ls;
    if (MODE != M_CMPA) {
#pragma unroll
      for (int nt = 0; nt < 4; ++nt) O[nt] *= corr;
    }
  }
  if (MODE == M_CMPA) return;
#pragma unroll
  for (int t = 0; t < 2; ++t) {
    if (!(TM & (1 << t))) continue;
    const h16* Vt = t ? Vt1 : Vt0;
#pragma unroll
    for (int ks = 0; ks < 2; ++ks) {
      h16x8 Pf;
#pragma unroll
      for (int i = 0; i < 4; ++i) { Pf[i] = (h16)S[t][2 * ks][i]; Pf[4 + i] = (h16)S[t][2 * ks + 1][i]; }
#pragma unroll
      for (int nt = 0; nt < 4; ++nt) {
        const h16* vp = Vt + (ks * 32 + q4 * 4 + (col >> 2)) * KP + nt * 16 + 4 * (col & 3);
        const s16x4v r0 = __builtin_amdgcn_ds_read_tr16_b64_v4i16((LAS s16x4v*)vp);
        const s16x4v r1 = __builtin_amdgcn_ds_read_tr16_b64_v4i16((LAS s16x4v*)(vp + 16 * KP));
        const h16x4 v0 = __builtin_bit_cast(h16x4, r0), v1 = __builtin_bit_cast(h16x4, r1);
        const h16x8 Vf = {v0[0], v0[1], v0[2], v0[3], v1[0], v1[1], v1[2], v1[3]};
        O[nt] = __builtin_amdgcn_mfma_f32_16x16x32_f16(Vf, Pf, O[nt], 0, 0, 0);
      }
    }
  }
}

template <int D, class LoadF, class StoreF, class CompF>
__device__ __forceinline__ void pair_pipeline(int n, LoadF load, StoreF store, CompF comp) {
  h16x8 r[D][4];
#pragma unroll
  for (int d = 0; d < D; ++d)
    if (d < n) load(d, r[d]);
  store(0, r[0]);
  if (D < n) load(D, r[0]);
  __syncthreads();
  for (int i0 = 0; i0 < n; i0 += D) {
#pragma unroll
    for (int d = 0; d < D; ++d) {
      const int i = i0 + d;
      if (i < n) {
        if (i + 1 < n) store(i + 1, r[(d + 1) % D]);
        if (i + 1 + D < n) load(i + 1 + D, r[(d + 1) % D]);
        comp(i);
        __syncthreads();
      }
    }
  }
}

template <int D, class LoadF, class StoreF, class CompF>
__device__ __forceinline__ void tile_pipeline(int n, LoadF load, StoreF store, CompF comp) {
  h16x8 rk[D], rv[D];
#pragma unroll
  for (int d = 0; d < D; ++d)
    if (d < n) load(d, rk[d], rv[d]);
  store(0, rk[0], rv[0]);
  if (D < n) load(D, rk[0], rv[0]);
  __syncthreads();
  for (int i0 = 0; i0 < n; i0 += D) {
#pragma unroll
    for (int d = 0; d < D; ++d) {
      const int i = i0 + d;
      if (i < n) {
        if (i + 1 < n) store(i + 1, rk[(d + 1) % D], rv[(d + 1) % D]);
        if (i + 1 + D < n) load(i + 1 + D, rk[(d + 1) % D], rv[(d + 1) % D]);
        comp(i);
        __syncthreads();
      }
    }
  }
}

constexpr int LDS_BIAS = 800 * 16;
__device__ __forceinline__ void phase_swa(const Params& p, int l, char* lds) {
  const int tid = opaque_tid(), lane = tid & 63, w = tid >> 6, col = lane & 15, q4 = lane >> 4;
  float* biasT = (float*)lds;
  h16* KV = (h16*)(lds + LDS_BIAS);
  float* nrm = (float*)(lds + LDS_BIAS + 4 * 64 * KP * 2);
  const h16* P = (const h16*)(WS(p) + O_P);
  const int* lut = (const int*)(WS(p) + O_LUT);
  h16* OAC = (h16*)(WS(p) + O_OAC);
  __syncthreads();
  for (int i = tid; i < 3200; i += NT) biasT[i] = p.in[5][lut[i % 800] * 8 + (i / 800)] * LOG2E;
  __syncthreads();
  const int head = w >> 1, kvh = w >> 2;
  const float sink = p.in[4][l * 4 + head] * LOG2E;
  const int srow = tid >> 3, c8 = tid & 7;
  float hpd[2][4], hpe[2][4];
  const bool nosel[2] = {false, false};
  for (int u = blockIdx.x; u < BATCH * 128; u += gridDim.x) {
    const int b = u >> 7, t0 = (u & 127) * 64;
    const h16* Pbat = P + (size_t)b * SEQ * IWP;
    h16x8 Q[2][2];
    int tq[2];
#pragma unroll
    for (int rg = 0; rg < 2; ++rg) {
      const int qb = (w & 1) * 32 + rg * 16;
      const h16* qp = Pbat + (size_t)(t0 + qb + col) * IWP + head * 64 + q4 * 8;
      Q[rg][0] = *(const h16x8*)qp;
      Q[rg][1] = *(const h16x8*)(qp + 32);
      tq[rg] = t0 + qb + col;
    }
    f32x4 O[2][4];
    ColState st[2];
#pragma unroll
    for (int rg = 0; rg < 2; ++rg) {
#pragma unroll
      for (int nt = 0; nt < 4; ++nt) O[rg][nt] = f32x4{0.f, 0.f, 0.f, 0.f};
      st[rg].m = -1e30f; st[rg].l = 0.f;
    }
    const int i0 = t0 >= 128 ? 0 : (t0 >= 64 ? 1 : 2);
    h16x8 rk[2], rv[2];
    {
      int sb = t0 - 128 + i0 * 64;
      for (int h2 = 0; h2 < 2; ++h2) {
        rk[h2] = ld_row8(Pbat + 256 + h2 * 64, IWP, sb + srow, SEQ, c8);
        rv[h2] = ld_row8(Pbat + 384 + h2 * 64, IWP, sb + srow, SEQ, c8);
      }
    }
    for (int i = i0; i < 3; ++i) {
      __syncthreads();
      for (int h2 = 0; h2 < 2; ++h2) {
        st_k(KV + h2 * 64 * KP, srow, c8, rk[h2]);
        st_k(KV + (2 + h2) * 64 * KP, srow, c8, rv[h2]);
      }
      __syncthreads();
      if (i + 1 < 3) {
        int sb = t0 - 128 + (i + 1) * 64;
        for (int h2 = 0; h2 < 2; ++h2) {
          rk[h2] = ld_row8(Pbat + 256 + h2 * 64, IWP, sb + srow, SEQ, c8);
          rv[h2] = ld_row8(Pbat + 384 + h2 * 64, IWP, sb + srow, SEQ, c8);
        }
      }
      const int kb = t0 - 128 + i * 64;
      attn_tile<M_SWA, 3>(Q, O, st, KV + kvh * 64 * KP, KV + (2 + kvh) * 64 * KP, biasT, tq, head, kb, false, nosel, hpd, hpe, lane);
    }
    __syncthreads();
#pragma unroll
    for (int rg = 0; rg < 2; ++rg) {
      const int qb = (w & 1) * 32 + rg * 16;
      const float lsum = sum4q(st[rg].l);
      const float mn = fmaxf(st[rg].m, sink);
      const float corr = __builtin_amdgcn_exp2f(st[rg].m - mn);
      const float inv = corr / (lsum * corr + __builtin_amdgcn_exp2f(sink - mn));
      float ss = 0.f;
#pragma unroll
      for (int nt = 0; nt < 4; ++nt) {
        O[rg][nt] *= inv;
#pragma unroll
        for (int j = 0; j < 4; ++j) ss += O[rg][nt][j] * O[rg][nt][j];
      }
      ss = sum4q(ss);
      if (q4 == 0) nrm[head * 64 + qb + col] = ss;
    }
    __syncthreads();
#pragma unroll
    for (int rg = 0; rg < 2; ++rg) {
      const int qi = (w & 1) * 32 + rg * 16 + col;
      const float tot = nrm[qi] + nrm[64 + qi] + nrm[128 + qi] + nrm[192 + qi];
      const float sc = rsqrtf(tot * (1.f / 256.f) + EPS);
#pragma unroll
      for (int nt = 0; nt < 4; ++nt)
        *(h16x4*)(OAC + ((size_t)b * SEQ + t0 + qi) * 1024 + head * 64 + nt * 16 + q4 * 4) =
            pack4(O[rg][nt][0] * sc, O[rg][nt][1] * sc, O[rg][nt][2] * sc, O[rg][nt][3] * sc);
    }
  }
}

constexpr int LDS_NSA = LDS_BIAS + 8 * 64 * KP * 2 + NW * 4 * 128 * 4 + 32 * 16;
constexpr int PFD = 2;
__device__ __forceinline__ void phase_nsa(const Params& p, int l, char* lds, const int parts = 15) {
  const int tid = opaque_tid(), lane = tid & 63, w = tid >> 6, col = lane & 15, q4 = lane >> 4;
  float* biasT = (float*)lds;
  h16* KV0 = (h16*)(lds + LDS_BIAS);
  float* impw = (float*)(lds + LDS_BIAS + 8 * 64 * KP * 2) + w * 4 * 128;
  unsigned long long* selm = (unsigned long long*)(lds + LDS_BIAS + 8 * 64 * KP * 2 + NW * 4 * 128 * 4);
#define KSB(i, t) (KV0 + (((i) & 1) * 4 + (t) * 2) * 64 * KP)
#define VTB(i, t) (KV0 + (((i) & 1) * 4 + (t) * 2 + 1) * 64 * KP)
  const h16* P = (const h16*)(WS(p) + O_P);
  const int* lut = (const int*)(WS(p) + O_LUT);
  h16* OAC = (h16*)(WS(p) + O_OAC);
  __syncthreads();
  for (int i = tid; i < 3200; i += NT) biasT[i] = p.in[5][lut[i % 800] * 8 + 4 + (i / 800)] * LOG2E;
  __syncthreads();
  const int srow = tid >> 3, c8 = tid & 7;
  const int hd = col & 3, qw = col >> 2;
  float hpd[2][4], hpe[2][4];
  const bool nosel[2] = {false, false};
  for (int u = blockIdx.x; u < 1024; u += gridDim.x) {
    const int rnd = u >> 8, b = (u & 255) >> 6, ti = u & 63;
    const int tile = rnd == 0 ? 255 - ti : (rnd == 1 ? 128 + ti : (rnd == 2 ? 127 - ti : ti));
    const int t0 = tile * 32, cur = t0 >> 6;
    const h16* Pbat = P + (size_t)b * SEQ * IWP;
    const h16* KC = (const h16*)(WS(p) + O_KCMP) + (size_t)b * 512 * 64;
    const h16* VC = (const h16*)(WS(p) + O_VCMP) + (size_t)b * 512 * 64;
    h16x8 Q[2];
    int tq;
    {
      const h16* qp = Pbat + (size_t)(t0 + w * 4 + qw) * IWP + OFF_QC + hd * 64 + q4 * 8;
      Q[0] = *(const h16x8*)qp;
      Q[1] = *(const h16x8*)(qp + 32);
      tq = t0 + w * 4 + qw;
    }
    const h16* gp = Pbat + (size_t)tq * IWP + OFF_GC + hd * 3;
    for (int i = lane; i < 512; i += 64) impw[i] = 0.f;
    f32x4 O[4], Oc[4];
    ColState st;
    int mvmax = t0 / 16 + 1;
    if (mvmax > NCMP) mvmax = NCMP;
    const int ntc = (mvmax + 63) >> 6;
    st.m = -1e30f; st.l = 0.f;
    const int npc = (ntc + 1) >> 1;
    if (parts & 1) pair_pipeline<PFD>(npc,
      [&](int i, h16x8 (&r)[4]) { r[0] = ld_row8(KC, 64, (2 * i) * 64 + srow, 512, c8); r[2] = ld_row8(KC, 64, (2 * i + 1) * 64 + srow, 512, c8); },
      [&](int i, const h16x8 (&r)[4]) { st_k(KSB(i, 0), srow, c8, r[0]); st_k(KSB(i, 1), srow, c8, r[2]); },
      [&](int i) {
        const bool far[2] = {t0 - 31 - 16 * (2 * i * 64 + 63) >= 799, t0 - 31 - 16 * ((2 * i + 1) * 64 + 63) >= 799};
        if (2 * i + 1 < ntc) attn_tile2<M_CMPA, 3>(Q, O, st, KSB(i, 0), VTB(i, 0), KSB(i, 1), VTB(i, 1), biasT, tq, hd, 2 * i * 64, far, nosel, hpd, hpe, lane);
        else attn_tile2<M_CMPA, 1>(Q, O, st, KSB(i, 0), VTB(i, 0), KSB(i, 1), VTB(i, 1), biasT, tq, hd, 2 * i * 64, far, nosel, hpd, hpe, lane);
      });
    {
      const float ls = sum4q(st.l);
      st.l = ls > 0.f ? 1.f / ls : 0.f;
    }
#pragma unroll
    for (int nt = 0; nt < 4; ++nt) O[nt] = f32x4{0.f, 0.f, 0.f, 0.f};
    float carry = 0.f;
    if (parts & 1) pair_pipeline<PFD>(npc,
      [&](int i, h16x8 (&r)[4]) {
        r[0] = ld_row8(KC, 64, (2 * i) * 64 + srow, 512, c8); r[1] = ld_row8(VC, 64, (2 * i) * 64 + srow, 512, c8);
        r[2] = ld_row8(KC, 64, (2 * i + 1) * 64 + srow, 512, c8); r[3] = ld_row8(VC, 64, (2 * i + 1) * 64 + srow, 512, c8); },
      [&](int i, const h16x8 (&r)[4]) {
        st_k(KSB(i, 0), srow, c8, r[0]); st_k(VTB(i, 0), srow, c8, r[1]); st_k(KSB(i, 1), srow, c8, r[2]); st_k(VTB(i, 1), srow, c8, r[3]); },
      [&](int i) {
        float hq[2][4], h3[2][4];
        const bool far[2] = {t0 - 31 - 16 * (2 * i * 64 + 63) >= 799, t0 - 31 - 16 * ((2 * i + 1) * 64 + 63) >= 799};
        const bool two = 2 * i + 1 < ntc;
        if (two) attn_tile2<M_CMPB, 3>(Q, O, st, KSB(i, 0), VTB(i, 0), KSB(i, 1), VTB(i, 1), biasT, tq, hd, 2 * i * 64, far, nosel, hq, h3, lane);
        else attn_tile2<M_CMPB, 1>(Q, O, st, KSB(i, 0), VTB(i, 0), KSB(i, 1), VTB(i, 1), biasT, tq, hd, 2 * i * 64, far, nosel, hq, h3, lane);
        float t3p = carry;
#pragma unroll
        for (int t = 0; t < 2; ++t) {
          if (t == 1 && !two) break;
#pragma unroll
          for (int kt = 0; kt < 4; ++kt) {
            const float qs = quadsum(hq[t][kt]);
            const float t3 = quadsum(h3[t][kt]);
            const float up = __shfl(t3, (lane + 48) & 63);
            const float wrp = __shfl(t3p, (lane + 48) & 63);
            const float pk = (q4 == 0) ? wrp : up;
            if (hd == 0) impw[qw * 128 + (2 * i + t) * 16 + kt * 4 + q4] = qs + pk;
            t3p = t3;
          }
        }
        carry = t3p;
      });
    {
      const float g0 = (float)gp[0];
#pragma unroll
      for (int nt = 0; nt < 4; ++nt) Oc[nt] = O[nt] * g0;
    }
    if (parts & 2) {
      const int nforced = cur >= 2 ? 3 : cur + 1;
      const int npick = 16 - nforced;
      for (int qi = 0; qi < 4; ++qi) {
        const float* im = impw + qi * 128;
        const int j0 = lane, j1 = lane + 64;
        const float v0 = im[j0], v1 = im[j1];
        int r0 = 0, r1 = 0;
#pragma unroll 8
        for (int jp = 1; jp <= cur - 2; ++jp) {
          float vp = im[jp];
          r0 += (vp > v0 || (vp == v0 && jp < j0)) ? 1 : 0;
          r1 += (vp > v1 || (vp == v1 && jp < j1)) ? 1 : 0;
        }
        bool c0 = j0 >= 1 && j0 <= cur - 2, c1 = j1 <= cur - 2;
        bool f0 = j0 == 0 || j0 == cur || j0 == cur - 1, f1 = j1 == cur || j1 == cur - 1;
        unsigned long long mlo = __ballot(f0 || (c0 && r0 < npick));
        unsigned long long mhi = __ballot(f1 || (c1 && r1 < npick));
        if (lane == 0) { selm[(w * 4 + qi) * 2] = mlo; selm[(w * 4 + qi) * 2 + 1] = mhi; }
      }
    }
    asm volatile("" ::: "memory");
    const unsigned long long slo = selm[(w * 4 + qw) * 2], shi = selm[(w * 4 + qw) * 2 + 1];
#pragma unroll
    for (int nt = 0; nt < 4; ++nt) O[nt] = f32x4{0.f, 0.f, 0.f, 0.f};
    st.m = -1e30f; st.l = 0.f;
    if (parts & 4) pair_pipeline<PFD>((cur + 2) >> 1,
      [&](int i, h16x8 (&r)[4]) {
        r[0] = ld_row8(Pbat + OFF_KVC + 128, IWP, (2 * i) * 64 + srow, SEQ, c8); r[1] = ld_row8(Pbat + OFF_KVC + 192, IWP, (2 * i) * 64 + srow, SEQ, c8);
        r[2] = ld_row8(Pbat + OFF_KVC + 128, IWP, (2 * i + 1) * 64 + srow, SEQ, c8); r[3] = ld_row8(Pbat + OFF_KVC + 192, IWP, (2 * i + 1) * 64 + srow, SEQ, c8); },
      [&](int i, const h16x8 (&r)[4]) {
        st_k(KSB(i, 0), srow, c8, r[0]); st_k(VTB(i, 0), srow, c8, r[1]); st_k(KSB(i, 1), srow, c8, r[2]); st_k(VTB(i, 1), srow, c8, r[3]); },
      [&](int i) {
        const int jb = 2 * i;
        bool sb[2];
        sb[0] = ((jb < 64 ? (slo >> jb) : (shi >> (jb - 64))) & 1ull) != 0;
        sb[1] = (jb + 1 <= cur) && (((jb + 1 < 64 ? (slo >> (jb + 1)) : (shi >> (jb + 1 - 64))) & 1ull) != 0);
        const bool far[2] = {t0 - (jb * 64 + 63) >= 799, t0 - (jb * 64 + 127) >= 799};
        const bool n0 = __any(sb[0]) != 0, n1 = __any(sb[1]) != 0;
        if (n0 && n1) attn_tile2<M_SEL, 3>(Q, O, st, KSB(i, 0), VTB(i, 0), KSB(i, 1), VTB(i, 1), biasT, tq, hd, jb * 64, far, sb, hpd, hpe, lane);
        else if (n0) attn_tile2<M_SEL, 1>(Q, O, st, KSB(i, 0), VTB(i, 0), KSB(i, 1), VTB(i, 1), biasT, tq, hd, jb * 64, far, sb, hpd, hpe, lane);
        else if (n1) attn_tile2<M_SEL, 2>(Q, O, st, KSB(i, 0), VTB(i, 0), KSB(i, 1), VTB(i, 1), biasT, tq, hd, jb * 64, far, sb, hpd, hpe, lane);
      });
    {
      const float ls = sum4q(st.l);
      const float f = ls > 0.f ? (float)gp[1] / ls : 0.f;
#pragma unroll
      for (int nt = 0; nt < 4; ++nt) Oc[nt] += O[nt] * f;
    }
#pragma unroll
    for (int nt = 0; nt < 4; ++nt) O[nt] = f32x4{0.f, 0.f, 0.f, 0.f};
    st.m = -1e30f; st.l = 0.f;
    const int w0 = cur >= 8 ? cur - 8 : 0;
    const int nwt = cur - w0 + 1;
    if (parts & 8) pair_pipeline<PFD>((nwt + 1) >> 1,
      [&](int i, h16x8 (&r)[4]) {
        r[0] = ld_row8(Pbat + OFF_KVC + 256, IWP, (w0 + 2 * i) * 64 + srow, SEQ, c8); r[1] = ld_row8(Pbat + OFF_KVC + 320, IWP, (w0 + 2 * i) * 64 + srow, SEQ, c8);
        r[2] = ld_row8(Pbat + OFF_KVC + 256, IWP, (w0 + 2 * i + 1) * 64 + srow, SEQ, c8); r[3] = ld_row8(Pbat + OFF_KVC + 320, IWP, (w0 + 2 * i + 1) * 64 + srow, SEQ, c8); },
      [&](int i, const h16x8 (&r)[4]) {
        st_k(KSB(i, 0), srow, c8, r[0]); st_k(VTB(i, 0), srow, c8, r[1]); st_k(KSB(i, 1), srow, c8, r[2]); st_k(VTB(i, 1), srow, c8, r[3]); },
      [&](int i) {
        const bool far[2] = {false, false};
        if (2 * i + 1 < nwt) attn_tile2<M_WIN, 3>(Q, O, st, KSB(i, 0), VTB(i, 0), KSB(i, 1), VTB(i, 1), biasT, tq, hd, (w0 + 2 * i) * 64, far, nosel, hpd, hpe, lane);
        else attn_tile2<M_WIN, 1>(Q, O, st, KSB(i, 0), VTB(i, 0), KSB(i, 1), VTB(i, 1), biasT, tq, hd, (w0 + 2 * i) * 64, far, nosel, hpd, hpe, lane);
      });
    {
      const float ls = sum4q(st.l);
      const float f = ls > 0.f ? (float)gp[2] / ls : 0.f;
      float ss = 0.f;
#pragma unroll
      for (int nt = 0; nt < 4; ++nt) {
        Oc[nt] += O[nt] * f;
#pragma unroll
        for (int j = 0; j < 4; ++j) ss += Oc[nt][j] * Oc[nt][j];
      }
      ss = quadsum(sum4q(ss));
      const float sc = rsqrtf(ss * (1.f / 256.f) + EPS);
#pragma unroll
      for (int nt = 0; nt < 4; ++nt)
        *(h16x4*)(OAC + ((size_t)b * SEQ + tq) * 1024 + 256 + hd * 64 + nt * 16 + q4 * 4) =
            pack4(Oc[nt][0] * sc, Oc[nt][1] * sc, Oc[nt][2] * sc, Oc[nt][3] * sc);
    }
  }
#undef KSB
#undef VTB
}

constexpr int LDS_SWA = LDS_BIAS + 4 * 64 * KP * 2 + 1024;
constexpr int lds_max(int a, int b) { return a > b ? a : b; }
constexpr int LDS_BYTES = lds_max(lds_max(LDS_NSA, SSMY_LDS), lds_max(LDS_SWA, lds_max(LDS_GEMM, lds_max(LDS_CMP, 64 * 65 * 4))));

__global__ void __launch_bounds__(NT) fwd_megakernel(Params p) {
  cg::grid_group grid = cg::this_grid();
  __shared__ __attribute__((aligned(16))) char lds[LDS_BYTES];
  __shared__ uint4 xb_words;
  if (threadIdx.x == 0) xb_words = make_uint4(0u, 0u, 0u, 0u);
  __syncthreads();
  (void)xcd_barrier_post((unsigned*)(WS(p) + O_BAR), (volatile LAS unsigned*)&xb_words);
#define GBAR() do { XcdBarrier _b; _b.bar = (unsigned*)(WS(p) + O_BAR); _b.x = xb_xcc_id(); _b.st = (volatile LAS unsigned*)&xb_words; xcd_barrier(_b); } while (0)
  phase0(p, (float*)lds);
  grid.sync();
  phase0b(p);
  GBAR();
  for (int l = 0; l < DEPTH; ++l) {
    phase_gemm1(p, l, lds);
    GBAR();
    ssm_endstates(p, l);
    phase_compress(p, l, lds);
    GBAR();
    phase_nsa(p, l, lds);
    phase_swa(p, l, lds);
    ssm_outputs(p, l, lds);
    GBAR();
    phase_glu(p, l, lds);
    GBAR();
    phase_wout(p, l, lds);
    GBAR();
    phase_up(p, l, lds);
    GBAR();
    phase_down(p, l, lds);
    GBAR();
  }
}

extern "C" void kernel_launch(void* const* d_in, const int* in_sizes, int n_in, void* d_out, int out_size, void* d_ws,
                              size_t ws_size, hipStream_t stream) {
  static int grid_blocks = 0;
  if (!grid_blocks) {
    int dev = 0, cus = 0, per_cu = 0;
    (void)hipGetDevice(&dev);
    (void)hipDeviceGetAttribute(&cus, hipDeviceAttributeMultiprocessorCount, dev);
    (void)hipOccupancyMaxActiveBlocksPerMultiprocessor(&per_cu, fwd_megakernel, NT, 0);
    if (per_cu > 1) per_cu = 1;
    grid_blocks = cus * per_cu;
  }
  if (ws_size < WS_NEED) {
    fprintf(stderr, "workspace too small: %zu < %zu\n", ws_size, WS_NEED);
    return;
  }
  Params p{};
  for (int i = 0; i < 24; ++i) p.in[i] = (const float*)d_in[i];
  p.out = (float*)d_out;
  p.ws = (char*)d_ws;
  (void)hipMemsetAsync((char*)d_ws + O_BAR, 0, SZ_BAR, stream);
  void* args[] = {&p};
  hipError_t e = hipLaunchCooperativeKernel((void*)fwd_megakernel, dim3(grid_blocks), dim3(NT), args, 0, stream);
  if (e != hipSuccess) fprintf(stderr, "cooperative launch failed: %s (grid %d)\n", hipGetErrorString(e), grid_blocks);
}
```

```cpp
#include <hip/hip_runtime.h>
#include <hip/hip_cooperative_groups.h>
#include <cstdio>
namespace cg = cooperative_groups;

typedef _Float16 h16;
typedef __attribute__((ext_vector_type(8))) _Float16 h16x8;
typedef __attribute__((ext_vector_type(4))) float f32x4;

constexpr int NT = 512;
constexpr int NW = NT / 64;
constexpr int BATCH = 4, SEQ = 8192, NTOK = BATCH * SEQ, DM = 1024, DEPTH = 4, IW = 1676, IWP = 1792, DFF = 4096;
constexpr int OFF_U = 512, OFF_QC = 1024, OFF_KVC = 1280, OFF_GC = 1664;
constexpr int NCMP = 511;
constexpr float EPS = 1e-6f;

constexpr size_t SZ_WIN = (size_t)IWP * DM * 2, SZ_WGLU = (size_t)1024 * 512 * 2, SZ_WOUT = (size_t)DM * DM * 2,
                 SZ_WUP = (size_t)DFF * DM * 2, SZ_WDN = (size_t)DM * DFF * 2;
constexpr size_t O_WIN = 0;
constexpr size_t O_WGLU = O_WIN + DEPTH * SZ_WIN;
constexpr size_t O_WOUT = O_WGLU + DEPTH * SZ_WGLU;
constexpr size_t O_WUP = O_WOUT + DEPTH * SZ_WOUT;
constexpr size_t O_WDN = O_WUP + DEPTH * SZ_WUP;
constexpr size_t O_XB = O_WDN + DEPTH * SZ_WDN;
constexpr size_t O_SSQ = O_XB + (size_t)NTOK * DM * 2;
constexpr size_t O_SSQB = O_SSQ + (size_t)NTOK * 16 * 4;
constexpr size_t O_KCMP = O_SSQB + (size_t)NTOK * 16 * 4;
constexpr size_t O_VCMP = O_KCMP + (size_t)BATCH * 512 * 64 * 4;
constexpr size_t O_ABAR = O_VCMP + (size_t)BATCH * 512 * 64 * 4;
constexpr size_t O_BBAR = O_ABAR + (size_t)DEPTH * 32 * 64 * 8;
constexpr size_t O_BIAS1 = O_BBAR + (size_t)DEPTH * 32 * 64 * 16 * 8;
constexpr size_t O_LUT = O_BIAS1 + (size_t)DEPTH * 2 * 128 * 4;
constexpr size_t O_AT = O_LUT + 8192 * 4;
constexpr size_t O_KTAB = O_AT + (size_t)128 * 64 * 8;
constexpr size_t SZ_KTAB = (size_t)65 * 256 * 2;
constexpr size_t O_W1 = O_KTAB + 128 * SZ_KTAB;
constexpr size_t SZ_W13 = (size_t)128 * 1024 * 2;
constexpr size_t O_W3 = O_W1 + 128 * SZ_W13;
constexpr size_t O_W1T = O_W3 + 128 * SZ_W13;
constexpr size_t O_W2T = O_W1T + (size_t)8 * 128 * 2048 * 2;
constexpr size_t O_B1P = O_W2T + (size_t)8 * 64 * 128 * 2;
constexpr size_t O_BAR = (O_B1P + (size_t)8 * 32 * 128 * 4 + 255) / 256 * 256;
constexpr size_t SZ_BAR = 3456 * 4;
constexpr size_t O_BIG = (O_BAR + SZ_BAR + 255) / 256 * 256;
constexpr size_t O_APOW = O_BIG;
constexpr size_t O_P = O_BIG;
constexpr size_t O_Z = O_P + (size_t)NTOK * IWP * 2;
constexpr size_t O_OB = O_Z + (size_t)NTOK * 512 * 2;
constexpr size_t O_OAC = O_OB + (size_t)512 * 2;
constexpr size_t O_E = O_OB + (size_t)NTOK * 1024 * 2;
constexpr size_t O_HID = O_BIG;
constexpr size_t WS_NEED = O_BIG + (size_t)NTOK * DFF * 2;

struct Params {
  const float* in[24];
  float* out;
  char* ws;
};

__device__ __forceinline__ char* WS(const Params& p) {
  int z;
  asm volatile("s_mov_b32 %0, 0" : "=s"(z));
  return p.ws + z;
}
__device__ __forceinline__ int opaque_tid() {
  int t = threadIdx.x;
  asm volatile("" : "+v"(t));
  return t;
}
template <int CTRL>
__device__ __forceinline__ float dppf(float v) {
  return __int_as_float(__builtin_amdgcn_update_dpp(0, __float_as_int(v), CTRL, 0xF, 0xF, true));
}
__device__ __forceinline__ float sum16(float v) {
  v += dppf<0xB1>(v); v += dppf<0x4E>(v); v += dppf<0x141>(v); v += dppf<0x140>(v);
  return v;
}
__device__ __forceinline__ float max16(float v) {
  v = fmaxf(v, dppf<0xB1>(v)); v = fmaxf(v, dppf<0x4E>(v)); v = fmaxf(v, dppf<0x141>(v)); v = fmaxf(v, dppf<0x140>(v));
  return v;
}
__device__ __forceinline__ float xor16(float v) { return __int_as_float(__builtin_amdgcn_ds_swizzle(__float_as_int(v), 0x401F)); }
__device__ __forceinline__ float rdlane_c(float v, int l) { return __int_as_float(__builtin_amdgcn_readlane(__float_as_int(v), l)); }
__device__ __forceinline__ float wave_sum(float v) {
  v = sum16(v); v += xor16(v);
  return rdlane_c(v, 0) + rdlane_c(v, 32);
}
__device__ __forceinline__ float gelu_tanh(float x) {
  float u = 0.7978845608028654f * (x + 0.044715f * x * x * x);
  return 0.5f * x * (1.f + tanhf(u));
}
__device__ __forceinline__ float sigmoidf(float x) { return 1.f / (1.f + __expf(-x)); }
__device__ __forceinline__ float rdlane(float v, int l) {
  return __int_as_float(__builtin_amdgcn_readlane(__float_as_int(v), l));
}

template <class SrcF>
__device__ __forceinline__ void conv_tile(SrcF src, h16* dst, int ldo, int n0, int k0, float* tile) {
  int tid = opaque_tid();
  for (int idx = tid; idx < 4096; idx += NT) {
    int kk = idx >> 6, nn = idx & 63;
    tile[kk * 65 + nn] = src(k0 + kk, n0 + nn);
  }
  __syncthreads();
  for (int idx = tid; idx < 4096; idx += NT) {
    int nn = idx >> 6, kk = idx & 63;
    dst[(long)(n0 + nn) * ldo + k0 + kk] = (h16)tile[kk * 65 + nn];
  }
  __syncthreads();
}

__device__ __forceinline__ void phase0(const Params& p, float* lds) {
  const int tid = opaque_tid();
  constexpr int T_IN = (IWP / 64) * (DM / 64);
  constexpr int T_GLU = 16 * 8;
  constexpr int T_OUT = 16 * 16;
  constexpr int T_UP = 64 * 16;
  constexpr int T_DN = 16 * 64;
  constexpr int T_L = T_IN + T_GLU + T_OUT + T_UP + T_DN;
  for (int ti = blockIdx.x; ti < DEPTH * T_L; ti += gridDim.x) {
    int l = ti / T_L, r = ti % T_L;
    if (r < T_IN) {
      int nt = r / 16, kt = r % 16;
      const float* w = p.in[2] + (size_t)l * DM * IW;
      const float* g = p.in[1] + l * DM;
      conv_tile([&](int k, int sl) {
        int n = (sl & ~255) + 64 * ((sl >> 5) & 3) + 32 * ((sl >> 7) & 1) + (sl & 31);
        return n < IW ? w[(long)k * IW + n] * g[k] : 0.f; },
                (h16*)(WS(p) + O_WIN + l * SZ_WIN), DM, nt * 64, kt * 64, lds);
    } else if ((r -= T_IN) < T_GLU) {
      int nt = r / 8, kt = r % 8;
      const float* w = p.in[14] + (size_t)l * 512 * 1024;
      conv_tile([&](int k, int n2) {
        int pn = n2 >> 8, bj = (n2 >> 7) & 1, wc = (n2 >> 5) & 3, nn = (n2 >> 4) & 1, r = n2 & 15;
        int n = (nn ? 512 : 0) + 128 * pn + 64 * bj + 16 * wc + r;
        return w[(long)k * 1024 + n]; },
                (h16*)(WS(p) + O_WGLU + l * SZ_WGLU), 512, nt * 64, kt * 64, lds);
    } else if ((r -= T_GLU) < T_OUT) {
      int nt = r / 16, kt = r % 16;
      const float* w = p.in[20] + (size_t)l * DM * DM;
      const float* g = p.in[19] + l * DM;
      conv_tile([&](int k2, int n) {
        int k = k2 < 512 ? 256 + k2 : (k2 < 768 ? k2 - 512 : k2);
        return w[(long)k * DM + n] * g[k]; },
                (h16*)(WS(p) + O_WOUT + l * SZ_WOUT), DM, nt * 64, kt * 64, lds);
    } else if ((r -= T_OUT) < T_UP) {
      int nt = r / 16, kt = r % 16;
      const float* w = p.in[22] + (size_t)l * DM * DFF;
      const float* g = p.in[21] + l * DM;
      conv_tile([&](int k, int n) { return w[(long)k * DFF + n] * g[k]; },
                (h16*)(WS(p) + O_WUP + l * SZ_WUP), DM, nt * 64, kt * 64, lds);
    } else {
      r -= T_UP;
      int nt = r / 64, kt = r % 64;
      const float* w = p.in[23] + (size_t)l * DFF * DM;
      conv_tile([&](int k, int n) { return w[(long)k * DM + n]; },
                (h16*)(WS(p) + O_WDN + l * SZ_WDN), DFF, nt * 64, kt * 64, lds);
    }
  }
  for (int ti = blockIdx.x; ti < 8 * 66; ti += gridDim.x) {
    int ls = ti / 66, r = ti % 66;
    if (r < 64) {
      int nt = r >> 5, kt = r & 31;
      const float* w = p.in[17] + (size_t)ls * 2048 * 128;
      conv_tile([&](int k, int n) { return w[(long)k * 128 + n]; }, (h16*)(WS(p) + O_W1T) + (size_t)ls * 128 * 2048, 2048, nt * 64, kt * 64, lds);
    } else {
      int kt = r - 64;
      const float* w = p.in[18] + (size_t)ls * 128 * 64;
      conv_tile([&](int k, int n) { return w[(long)k * 64 + n]; }, (h16*)(WS(p) + O_W2T) + (size_t)ls * 64 * 128, 128, 0, kt * 64, lds);
    }
  }
  {
    const int lane = tid & 63;
    const int gw = blockIdx.x * NW + (tid >> 6), nw = gridDim.x * NW;
    const float* x = p.in[0];
    h16* xb = (h16*)(WS(p) + O_XB);
    float* ssq = (float*)(WS(p) + O_SSQ);
    for (int row = gw; row < NTOK; row += nw) {
      const float4* xr = (const float4*)(x + (long)row * DM + lane * 16);
      float s = 0.f;
      h16 hv[16];
      for (int i = 0; i < 4; ++i) {
        float4 v = xr[i];
        s += v.x * v.x + v.y * v.y + v.z * v.z + v.w * v.w;
        hv[i * 4 + 0] = (h16)v.x; hv[i * 4 + 1] = (h16)v.y; hv[i * 4 + 2] = (h16)v.z; hv[i * 4 + 3] = (h16)v.w;
      }
      h16x8* xo = (h16x8*)(xb + (long)row * DM + lane * 16);
      h16x8 o0, o1;
      for (int i = 0; i < 8; ++i) { o0[i] = hv[i]; o1[i] = hv[8 + i]; }
      xo[0] = o0; xo[1] = o1;
      s += dppf<0xB1>(s);
      s += dppf<0x4E>(s);
      if ((lane & 3) == 0) ssq[(long)row * 16 + (lane >> 2)] = s;
    }
  }
  const int gt = blockIdx.x * NT + tid, ngt = gridDim.x * NT;
  for (int i = gt; i < DEPTH * 32 * 64; i += ngt) {
    int l = i / 2048, g = (i / 64) % 32;
    double are = p.in[6][i], aim = p.in[7][i];
    double dt = exp((double)p.in[8][l * 32 + g]);
    double er = exp(are * dt), abr = er * cos(aim * dt), abi = er * sin(aim * dt);
    ((float2*)(WS(p) + O_ABAR))[i] = make_float2((float)abr, (float)abi);
    double nr = abr - 1.0, ni = abi, den = are * are + aim * aim;
    double fr = (nr * are + ni * aim) / den, fi = (ni * are - nr * aim) / den;
    float2* bb = (float2*)(WS(p) + O_BBAR) + (size_t)i * 16;
    for (int q = 0; q < 16; ++q) {
      double br = p.in[9][(size_t)i * 16 + q], bi = p.in[10][(size_t)i * 16 + q];
      bb[q] = make_float2((float)((fr * br - fi * bi) / dt), (float)((fr * bi + fi * br) / dt));
    }
  }
  for (int i = gt; i < 128 * 65 * 64; i += ngt) {
    int n = i & 63, j = (i >> 6) % 65, lg = i / (65 * 64);
    double are = p.in[6][lg * 64 + n], aim = p.in[7][lg * 64 + n];
    double dt = exp((double)p.in[8][lg]);
    double er = exp(are * dt * j), ang = aim * dt * j;
    ((double2*)(WS(p) + O_APOW))[i] = make_double2(er * cos(ang), er * sin(ang));
  }
  for (int i = gt; i < DEPTH * 2 * 128 * 32; i += ngt) {
    int j = i & 127, kc = (i >> 7) & 31, ls = i >> 12;
    const float* pos = p.in[16] + (size_t)ls * 2048 + kc * 64;
    const float* w1 = p.in[17] + ((size_t)ls * 2048 + kc * 64) * 128;
    float a = 0.f;
#pragma unroll 16
    for (int k = 0; k < 64; ++k) a += pos[k] * w1[(long)k * 128 + j];
    ((float*)(WS(p) + O_B1P))[i] = a;
  }
  for (int d = gt; d < 8192; d += ngt) {
    int bk;
    if (d < 16) bk = d;
    else {
      float nf = (float)d;
      int large = 16 + (int)(logf(nf / 16.0f) / 4.1588830833596715f * 16.0f);
      bk = large < 31 ? large : 31;
    }
    ((int*)(WS(p) + O_LUT))[d] = bk;
  }
}

__device__ __forceinline__ void phase0b(const Params& p) {
  const int gt = blockIdx.x * NT + threadIdx.x, ngt = gridDim.x * NT;
  const double2* apow = (const double2*)(WS(p) + O_APOW);
  const float2* bbs = (const float2*)(WS(p) + O_BBAR);
  for (int i = gt; i < 128 * 64 * 64; i += ngt) {
    int tau = i & 63, n = (i >> 6) & 63, lg = i >> 12;
    double2 ap = apow[(lg * 65 + (63 - tau)) * 64 + n];
    const float2* bb = bbs + (size_t)(lg * 64 + n) * 16;
    h16x8 re0, re1, im0, im1;
#pragma unroll
    for (int q = 0; q < 8; ++q) {
      float2 b0 = bb[q], b1 = bb[8 + q];
      re0[q] = (h16)(float)(ap.x * b0.x - ap.y * b0.y);
      im0[q] = (h16)(float)(ap.x * b0.y + ap.y * b0.x);
      re1[q] = (h16)(float)(ap.x * b1.x - ap.y * b1.y);
      im1[q] = (h16)(float)(ap.x * b1.y + ap.y * b1.x);
    }
    h16* W1 = (h16*)(WS(p) + O_W1 + (size_t)lg * SZ_W13);
    *(h16x8*)(W1 + ((size_t)(2 * tau) * 128 + 2 * n) * 8) = re0;
    *(h16x8*)(W1 + ((size_t)(2 * tau) * 128 + 2 * n + 1) * 8) = im0;
    *(h16x8*)(W1 + ((size_t)(2 * tau + 1) * 128 + 2 * n) * 8) = re1;
    *(h16x8*)(W1 + ((size_t)(2 * tau + 1) * 128 + 2 * n + 1) * 8) = im1;
  }
  for (int i = gt; i < 128 * 64 * 16 * 16; i += ngt) {
    int pp = i & 15, kc = (i >> 4) & 15, tau = (i >> 8) & 63, lg = i >> 14;
    h16x8 v;
#pragma unroll
    for (int e = 0; e < 4; ++e) {
      int n = 4 * kc + e;
      double2 ap = apow[(lg * 65 + tau + 1) * 64 + n];
      double cr = p.in[11][((size_t)lg * 16 + pp) * 64 + n], ci = p.in[12][((size_t)lg * 16 + pp) * 64 + n];
      v[2 * e] = (h16)(float)(cr * ap.x - ci * ap.y);
      v[2 * e + 1] = (h16)(float)(-(cr * ap.y + ci * ap.x));
    }
    h16* W3 = (h16*)(WS(p) + O_W3 + (size_t)lg * SZ_W13);
    *(h16x8*)(W3 + ((size_t)((tau * 16 + kc) * 16) + pp) * 8) = v;
  }
  for (int i = gt; i < 128 * 65 * 16; i += ngt) {
    int pp = i & 15, slot = (i >> 4) % 65, lg = i / (65 * 16);
    float acc[16];
#pragma unroll
    for (int q = 0; q < 16; ++q) acc[q] = 0.f;
    if (slot > 0) {
      for (int n = 0; n < 64; ++n) {
        double2 ap = apow[(lg * 65 + slot - 1) * 64 + n];
        double cr = p.in[11][((size_t)lg * 16 + pp) * 64 + n], ci = p.in[12][((size_t)lg * 16 + pp) * 64 + n];
        float xr = (float)(cr * ap.x - ci * ap.y), xi = (float)(cr * ap.y + ci * ap.x);
        const float2* bb = bbs + (size_t)(lg * 64 + n) * 16;
#pragma unroll
        for (int q = 0; q < 16; ++q) { float2 b = bb[q]; acc[q] += xr * b.x - xi * b.y; }
      }
    }
    h16x8 v0, v1;
#pragma unroll
    for (int q = 0; q < 8; ++q) { v0[q] = (h16)acc[q]; v1[q] = (h16)acc[8 + q]; }
    h16* kt = (h16*)(WS(p) + O_KTAB + (size_t)lg * SZ_KTAB) + slot * 256 + pp * 16;
    *(h16x8*)kt = v0;
    *(h16x8*)(kt + 8) = v1;
  }
  for (int i = gt; i < 128 * 64; i += ngt) {
    double2 ap = apow[((i >> 6) * 65 + 64) * 64 + (i & 63)];
    ((float2*)(WS(p) + O_AT))[i] = make_float2((float)ap.x, (float)ap.y);
  }
  for (int i = gt; i < DEPTH * 2 * 128; i += ngt) {
    const float* pp = (const float*)(WS(p) + O_B1P) + (size_t)(i >> 7) * 32 * 128 + (i & 127);
    float a = 0.f;
    for (int kc = 0; kc < 32; ++kc) a += pp[kc * 128];
    ((float*)(WS(p) + O_BIAS1))[i] = a;
  }
}

__device__ __forceinline__ void ssm_endstates(const Params& p, int l, char* lds) {
  const int tid = opaque_tid(), lane = tid & 63, w = tid >> 6;
  const h16* P = (const h16*)(WS(p) + O_P);
  float* E = (float*)(WS(p) + O_E);
  f32x4* red = (f32x4*)lds;
  for (int ub4 = blockIdx.x; ub4 < 256; ub4 += gridDim.x) {
    const int unit = ub4 * 4 + (w & 3), kh = w >> 2;
    const int g = unit >> 5, ctile = unit & 31;
    const h16* W1 = (const h16*)(WS(p) + O_W1 + (size_t)(l * 32 + g) * SZ_W13);
    const int gch = ctile * 16 + (lane & 15);
    const h16* ub = P + (size_t)gch * 64 * IWP + OFF_U + g * 16 + ((lane >> 4) & 1) * 8 + (size_t)(lane >> 5) * IWP;
    f32x4 acc[8];
#pragma unroll
    for (int mt = 0; mt < 8; ++mt) acc[mt] = f32x4{0.f, 0.f, 0.f, 0.f};
#pragma unroll 4
    for (int kk = 0; kk < 16; ++kk) {
      const int ks = kh * 16 + kk;
      h16x8 B = *(const h16x8*)(ub + (size_t)(ks * 2) * IWP);
#pragma unroll
      for (int mt = 0; mt < 8; ++mt) {
        h16x8 A = *(const h16x8*)(W1 + ((size_t)(ks * 4 + (lane >> 4)) * 128 + mt * 16 + (lane & 15)) * 8);
        acc[mt] = __builtin_amdgcn_mfma_f32_16x16x32_f16(A, B, acc[mt], 0, 0, 0);
      }
    }
    __syncthreads();
    if (kh == 1) {
#pragma unroll
      for (int mt = 0; mt < 8; ++mt) red[((w & 3) * 8 + mt) * 64 + lane] = acc[mt];
    }
    __syncthreads();
    if (kh == 0) {
#pragma unroll
      for (int mt = 0; mt < 8; ++mt)
        *(f32x4*)(E + ((size_t)gch * 32 + g) * 128 + mt * 16 + (lane >> 4) * 4) = acc[mt] + red[((w & 3) * 8 + mt) * 64 + lane];
    }
  }
}

constexpr int BU_PITCH = 1032, BS_PITCH = 136;
constexpr int SSMY_LDS = 65 * 512 + 16 * BU_PITCH * 2 + 16 * BS_PITCH * 2 + 128 * 64 * 8;
__device__ __forceinline__ void ssm_outputs(const Params& p, int l, char* lds) {
  const int tid = opaque_tid(), lane = tid & 63, w = tid >> 6;
  h16* Kt = (h16*)lds;
  h16* Bu = (h16*)(lds + 65 * 512);
  h16* Bs = (h16*)(lds + 65 * 512 + 16 * BU_PITCH * 2);
  float2* Es = (float2*)(lds + 65 * 512 + 16 * BU_PITCH * 2 + 16 * BS_PITCH * 2);
  const h16* P = (const h16*)(WS(p) + O_P);
  const float* E = (const float*)(WS(p) + O_E);
  h16* Z = (h16*)(WS(p) + O_Z);
  for (int unit = blockIdx.x; unit < 1024; unit += gridDim.x) {
    const int g = unit & 31, bc = unit >> 5, b = bc >> 3, ct = bc & 7;
    const int lg = l * 32 + g;
    __syncthreads();
    const int c0 = ct * 16;
    {
      const h16x8* ks = (const h16x8*)(WS(p) + O_KTAB + (size_t)lg * SZ_KTAB);
      for (int i = tid; i < 65 * 32; i += NT) ((h16x8*)Kt)[i] = ks[i];
      for (int i = tid; i < 2048; i += NT) {
        int tk = i >> 1, hf = i & 1;
        h16x8 v = *(const h16x8*)(P + ((size_t)b * SEQ + ct * 1024 + tk) * IWP + OFF_U + g * 16 + hf * 8);
        *(h16x8*)(Bu + (tk >> 6) * BU_PITCH + (tk & 63) * 16 + hf * 8) = v;
      }
      const float2* Eb = (const float2*)E + ((size_t)(b * 128) * 32 + g) * 64;
      for (int i = tid; i < (c0 + 16) * 64; i += NT) Es[i] = Eb[(size_t)(i >> 6) * 2048 + (i & 63)];
    }
    __syncthreads();
    if (w == 0) {
      float2 at = ((const float2*)(WS(p) + O_AT))[lg * 64 + lane];
      float sr = 0.f, si = 0.f;
#pragma unroll 8
      for (int c = 0; c < c0; ++c) {
        float2 e = Es[c * 64 + lane];
        float nr = at.x * sr - at.y * si + e.x, ni = at.x * si + at.y * sr + e.y;
        sr = nr; si = ni;
      }
#pragma unroll
      for (int i = 0; i < 16; ++i) {
        Bs[i * BS_PITCH + 2 * lane] = (h16)sr;
        Bs[i * BS_PITCH + 2 * lane + 1] = (h16)si;
        float2 e = Es[(c0 + i) * 64 + lane];
        float nr = at.x * sr - at.y * si + e.x, ni = at.x * si + at.y * sr + e.y;
        sr = nr; si = ni;
      }
    }
    __syncthreads();
    const float dt = expf(p.in[8][lg]);
    const int col = lane & 15, hi = lane >> 5, qh = (lane >> 4) & 1, p0 = (lane >> 4) * 4;
    const h16* W3 = (const h16*)(WS(p) + O_W3 + (size_t)lg * SZ_W13);
    float dsk[4];
    for (int j = 0; j < 4; ++j) dsk[j] = p.in[13][l * 512 + g * 16 + p0 + j];
    for (int r = 0; r < 64 / NW; ++r) {
      const int base = (r >> 1) * 2 * NW;
      const int tau = (r & 1) ? base + 2 * NW - 1 - w : base + w;
      f32x4 acc = {0.f, 0.f, 0.f, 0.f};
      const int nks = tau / 2 + 1;
      h16x8 A3[4];
#pragma unroll
      for (int ks = 0; ks < 4; ++ks)
        A3[ks] = *(const h16x8*)(W3 + ((size_t)((tau * 16 + ks * 4 + (lane >> 4)) * 16) + (lane & 15)) * 8);
      for (int i = 0; i < nks; ++i) {
        int j = tau - (2 * i + hi);
        h16x8 A = *(const h16x8*)(Kt + (j + 1) * 256 + (lane & 15) * 16 + qh * 8);
        h16x8 B = *(const h16x8*)(Bu + col * BU_PITCH + (2 * i + hi) * 16 + qh * 8);
        acc = __builtin_amdgcn_mfma_f32_16x16x32_f16(A, B, acc, 0, 0, 0);
      }
#pragma unroll
      for (int ks = 0; ks < 4; ++ks) {
        h16x8 B = *(const h16x8*)(Bs + col * BS_PITCH + ks * 32 + (lane >> 4) * 8);
        acc = __builtin_amdgcn_mfma_f32_16x16x32_f16(A3[ks], B, acc, 0, 0, 0);
      }
      const h16* up = Bu + col * BU_PITCH + tau * 16 + p0;
      size_t tok = ((size_t)b * 128 + ct * 16 + col) * 64 + tau;
      h16 zz[4];
      for (int j = 0; j < 4; ++j) zz[j] = (h16)gelu_tanh(dt * acc[j] + dsk[j] * (float)up[j]);
      typedef __attribute__((ext_vector_type(4))) _Float16 h16x4;
      h16x4 zv = {zz[0], zz[1], zz[2], zz[3]};
      *(h16x4*)(Z + tok * 512 + g * 16 + p0) = zv;
    }
  }
}

#define LAS __attribute__((address_space(3)))
typedef _Float16 h16x4 __attribute__((ext_vector_type(4)));
#define XB_TMO      128
#define XB_XCNT(j)  (256  + 64 * (j))
#define XB_XSUB(j)  (1280 + 64 * (j))
#define XB_XGEN(j)  (2304 + 64 * (j))
#define XB_TOP      3328
#define XB_TOPGEN   3392
#define XCD_BAR_WORDS 3456
#define XB_SPIN_CAP (1u << 18)

__device__ __forceinline__ unsigned xb_ld(unsigned* p)              { return __hip_atomic_load(p, __ATOMIC_RELAXED, __HIP_MEMORY_SCOPE_AGENT); }
__device__ __forceinline__ unsigned xb_add(unsigned* p, unsigned v) { return __hip_atomic_fetch_add(p, v, __ATOMIC_RELAXED, __HIP_MEMORY_SCOPE_AGENT); }
__device__ __forceinline__ unsigned xb_xcc_id() { return (unsigned)__builtin_amdgcn_s_getreg((3 << 11) | 20) & 0xFu; }
#define XB_SPIN(cond, bar) do { unsigned _sp = 0; while (cond) { __builtin_amdgcn_s_sleep(1); \
    if ((++_sp & 255u) == 0u) { if (xb_ld(&(bar)[XB_TMO])) break; if (_sp > XB_SPIN_CAP) { atomicAdd(&(bar)[XB_TMO], 1u); break; } } } } while (0)

struct XcdBarrier {
    unsigned* bar; unsigned x;
    volatile LAS unsigned* st;
};

__device__ __forceinline__ XcdBarrier xcd_barrier_post(unsigned* bar, volatile LAS unsigned* st) {
    XcdBarrier b; b.bar = bar; b.x = xb_xcc_id(); b.st = st;
    if (threadIdx.x == 0) (void)xb_add(&bar[XB_XCNT(b.x)], 1u);
    return b;
}
__device__ __forceinline__ void xcd_barrier_complete(unsigned* bar, unsigned x, unsigned& nloc, unsigned& nx) {
    const unsigned G = gridDim.x * gridDim.y * gridDim.z;
    unsigned sum, cnt, mine, sp = 0u;
    for (;;) {
        sum = 0u; cnt = 0u; mine = 0u;
#pragma unroll
        for (unsigned j = 0; j < 16; ++j) { const unsigned c = xb_ld(&bar[XB_XCNT(j)]); sum += c; cnt += (c > 0u) ? 1u : 0u; mine = (j == x) ? c : mine; }
        if (sum == G) break;
        __builtin_amdgcn_s_sleep(1);
        if ((++sp & 255u) == 0u) { if (xb_ld(&bar[XB_TMO])) break; if (sp > XB_SPIN_CAP) { atomicAdd(&bar[XB_TMO], 1u); break; } }
    }
    nloc = mine > 0u ? mine : 1u; nx = cnt > 0u ? cnt : 1u;
}

__device__ __forceinline__ void xcd_barrier(const XcdBarrier& b) {
    asm volatile("s_waitcnt vmcnt(0)" ::: "memory");
    __syncthreads();
    if (threadIdx.x == 0) {
        unsigned* bar = b.bar;
        __builtin_amdgcn_s_waitcnt(0);
        unsigned nloc = b.st[0], nx = b.st[1];
        if (nloc == 0u) { xcd_barrier_complete(bar, b.x, nloc, nx); b.st[0] = nloc; b.st[1] = nx; }
        const unsigned old = xb_add(&bar[XB_XSUB(b.x)], 1u);
        const unsigned gen = old / nloc;
        if (old + 1u == (gen + 1u) * nloc) {
            __builtin_amdgcn_fence(__ATOMIC_RELEASE, "agent");
            asm volatile("s_waitcnt vmcnt(0)" ::: "memory");
            const unsigned og = xb_add(&bar[XB_TOP], 1u);
            const unsigned tg = og / nx;
            if (og + 1u == (tg + 1u) * nx) xb_add(&bar[XB_TOPGEN], 1u);
            else XB_SPIN(xb_ld(&bar[XB_TOPGEN]) == tg, bar);
            __builtin_amdgcn_fence(__ATOMIC_ACQUIRE, "agent");
            xb_add(&bar[XB_XGEN(b.x)], 1u);
            asm volatile("s_waitcnt vmcnt(0)" ::: "memory");
        } else {
            XB_SPIN(xb_ld(&bar[XB_XGEN(b.x)]) == gen, bar);
            __builtin_amdgcn_fence(__ATOMIC_ACQUIRE, "agent");
            asm volatile("s_waitcnt vmcnt(0)" ::: "memory");
        }
    }
    __syncthreads();
}


namespace g8 {
constexpr int BM = 256, BK = 64, HALF = 128, HTB = HALF * BK * 2, STAGE_BYTES = 8 * HTB, NXCD = 8, WGM = 8;
__device__ __forceinline__ int lds_byte(int r, int c) {
  const int st = (r >> 4) * 2 + (c >> 5), rr = r & 15, cc = c & 31, ob = rr * 64 + cc * 2;
  return st * 1024 + (ob ^ (((ob >> 9) & 1) << 5));
}
__device__ __forceinline__ void stage_rc(int b, int& R, int& C) {
  const int st = b / 1024, sb = b % 1024, swz = sb ^ (((sb >> 9) & 1) << 5);
  R = (st >> 1) * 16 + swz / 64;
  C = (st & 1) * 32 + (swz % 64) / 2;
}
struct Unit { int pm, pn; };
struct Order {
  int nM, nN, nwg, G, c;
  __device__ void init(int M, int N, int G_, int c_) { nM = M / BM; nN = N / BM; nwg = nM * nN; G = G_; c = c_; }
  __device__ bool next(int i, Unit& u) const {
    const long L = (long)i * G + c;
    if (L >= nwg) return false;
    int wgid = (int)L;
    { const int q = nwg / NXCD, r = nwg % NXCD, xcd = wgid % NXCD, off = wgid / NXCD; wgid = (xcd < r ? xcd * (q + 1) : r * (q + 1) + (xcd - r) * q) + off; }
    const int nig = WGM * nN, gid = wgid / nig, fm = gid * WGM, gsz = (nM - fm) < WGM ? (nM - fm) : WGM;
    u.pm = fm + ((wgid % nig) % gsz);
    u.pn = (wgid % nig) / gsz;
    return true;
  }
};
template <class Epi>
__device__ __forceinline__ void gemm_phase(LAS unsigned char* lds, const h16* A, const h16* Bt, int K, const Order& S, const Epi& E) {
  const int tid = opaque_tid(), wid = __builtin_amdgcn_readfirstlane(tid >> 6), lane = tid & 63, wr = wid >> 2, wc = wid & 3, fr = lane & 15, fq = lane >> 4;
  const int nt = K / BK;
  unsigned voffA[2];
#pragma unroll
  for (int i = 0; i < 2; ++i) { int R, C; stage_rc(tid * 16 + i * 8192, R, C); voffA[i] = (unsigned)(R * K + C) * 2u; }
  const size_t kstep = (size_t)(BK * 2);
  const size_t hstep = (size_t)HALF * K * 2;
  const size_t tstep = 2 * hstep;
  const unsigned ldsw = (unsigned)wid * 1024u;
  const int aoff = lds_byte(wr * 64 + fr, fq * 8), boff = lds_byte(wc * 32 + fr, fq * 8);
#define G8_SA(b, h) (((b) * 2 + (h)) * HTB)
#define G8_SB(b, h) ((4 + (b) * 2 + (h)) * HTB)
#define G8_STAGE(bufoff, gbase) do { _Pragma("unroll") for (int _i = 0; _i < 2; ++_i) \
    __builtin_amdgcn_global_load_lds((const unsigned*)((const char*)(gbase) + voffA[_i]), (LAS unsigned*)(lds + (bufoff) + ldsw + _i * 8192), 16, 0, 0); } while (0)
#define G8_LDA(dst, b, h) do { _Pragma("unroll") for (int m = 0; m < 4; ++m) _Pragma("unroll") for (int k = 0; k < 2; ++k) dst[m][k] = *(const LAS h16x8*)(lds + G8_SA(b, h) + aoff + m * 2048 + k * 1024); } while (0)
#define G8_LDB(dst, b, h) do { _Pragma("unroll") for (int n = 0; n < 2; ++n) _Pragma("unroll") for (int k = 0; k < 2; ++k) dst[n][k] = *(const LAS h16x8*)(lds + G8_SB(b, h) + boff + n * 2048 + k * 1024); } while (0)
#define G8_MMA(ai, bj, At, Bt_) do { __builtin_amdgcn_s_setprio(1); _Pragma("unroll") for (int m = 0; m < 4; ++m) _Pragma("unroll") for (int n = 0; n < 2; ++n) _Pragma("unroll") for (int k = 0; k < 2; ++k) \
    acc[ai][bj][m][n] = __builtin_amdgcn_mfma_f32_16x16x32_f16(Bt_[n][k], At[m][k], acc[ai][bj][m][n], 0, 0, 0); __builtin_amdgcn_s_setprio(0); } while (0)
#define G8_WAIT_V(n) asm volatile("s_waitcnt vmcnt(" #n ")" ::: "memory")
#define G8_WAIT_L(n) asm volatile("s_waitcnt lgkmcnt(" #n ")" ::: "memory")
#define G8_BAR __builtin_amdgcn_s_barrier()
#define G8_SCHED __builtin_amdgcn_sched_barrier(0)
  Unit cur, nxt;
  int ui = 0;
  if (!S.next(0, cur)) return;
  f32x4 acc[2][2][4][2];
#pragma unroll
  for (int a = 0; a < 2; ++a)
#pragma unroll
    for (int b = 0; b < 2; ++b)
#pragma unroll
      for (int m = 0; m < 4; ++m)
#pragma unroll
        for (int n = 0; n < 2; ++n) acc[a][b][m][n] = (f32x4){0.f, 0.f, 0.f, 0.f};
  h16x8 At[4][2], B0[2][2], B1[2][2];
  const char* cA = (const char*)A + (size_t)cur.pm * tstep;
  const char* cB = (const char*)Bt + (size_t)cur.pn * tstep;
  G8_STAGE(G8_SB(0, 0), cB); G8_STAGE(G8_SA(0, 0), cA); G8_STAGE(G8_SB(0, 1), cB + hstep); G8_STAGE(G8_SA(0, 1), cA + hstep);
  if (wr == 1) G8_BAR;
  G8_WAIT_V(4); G8_BAR;
  G8_STAGE(G8_SB(1, 0), cB + kstep); G8_STAGE(G8_SA(1, 0), cA + kstep); G8_STAGE(G8_SB(1, 1), cB + hstep + kstep);
  G8_WAIT_V(6); G8_BAR;
  for (;;) {
    const bool has_next = S.next(ui + 1, nxt);
    const char* nA = has_next ? (const char*)A + (size_t)nxt.pm * tstep : cA;
    const char* nB = has_next ? (const char*)Bt + (size_t)nxt.pn * tstep : cB;
    for (int t = 0; t < nt; t += 2) {
      const bool last = (t == nt - 2);
      const char* a1 = cA + (size_t)(t + 1) * kstep;
      const char* a2 = last ? nA : cA + (size_t)(t + 2) * kstep;
      const char* b2 = last ? nB : cB + (size_t)(t + 2) * kstep;
      const char* a3 = a2 + kstep;
      const char* b3 = b2 + kstep;
      if (Epi::MID_T >= 0 && t == Epi::MID_T) E.mid(acc, ui, wr, fr);
      G8_LDB(B0, 0, 0); G8_SCHED; G8_LDA(At, 0, 0); G8_STAGE(G8_SA(1, 1), a1 + hstep);
      G8_WAIT_L(8); G8_BAR; G8_WAIT_L(0); G8_MMA(0, 0, At, B0); G8_BAR; G8_SCHED;
      G8_LDB(B1, 0, 1); G8_STAGE(G8_SB(0, 0), b2);
      G8_BAR; G8_WAIT_L(0); G8_MMA(0, 1, At, B1); G8_BAR;
      G8_LDA(At, 0, 1); G8_STAGE(G8_SA(0, 0), a2);
      G8_BAR; G8_WAIT_L(0); G8_MMA(1, 0, At, B0); G8_BAR; G8_SCHED;
      G8_STAGE(G8_SB(0, 1), b2 + hstep);
      G8_WAIT_V(6); G8_BAR; G8_MMA(1, 1, At, B1); G8_BAR;
      G8_LDB(B0, 1, 0); G8_SCHED; G8_LDA(At, 1, 0); G8_STAGE(G8_SA(0, 1), a2 + hstep);
      G8_WAIT_L(8); G8_BAR; G8_WAIT_L(0); G8_MMA(0, 0, At, B0); G8_BAR; G8_SCHED;
      G8_LDB(B1, 1, 1); G8_STAGE(G8_SB(1, 0), b3);
      G8_BAR; G8_WAIT_L(0); G8_MMA(0, 1, At, B1); G8_BAR;
      G8_LDA(At, 1, 1); G8_STAGE(G8_SA(1, 0), a3);
      G8_BAR; G8_WAIT_L(0); G8_MMA(1, 0, At, B0); G8_BAR; G8_SCHED;
      G8_STAGE(G8_SB(1, 1), b3 + hstep);
      G8_WAIT_V(6); G8_BAR; G8_MMA(1, 1, At, B1); G8_BAR;
    }
    E(acc, cur, ui, wr, wc, fr, fq);
    if (!has_next) break;
#pragma unroll
    for (int a = 0; a < 2; ++a)
#pragma unroll
      for (int b = 0; b < 2; ++b)
#pragma unroll
        for (int m = 0; m < 4; ++m)
#pragma unroll
          for (int n = 0; n < 2; ++n) acc[a][b][m][n] = (f32x4){0.f, 0.f, 0.f, 0.f};
    cur = nxt; cA = nA; cB = nB; ++ui;
  }
  G8_WAIT_V(0);
  if (wr == 0) G8_BAR;
  G8_BAR;
#undef G8_SA
#undef G8_SB
#undef G8_STAGE
#undef G8_LDA
#undef G8_LDB
#undef G8_MMA
#undef G8_WAIT_V
#undef G8_WAIT_L
#undef G8_BAR
#undef G8_SCHED
}
}

constexpr int RSL_OFF = g8::STAGE_BYTES;
constexpr int LDS_GEMM = g8::STAGE_BYTES + 8 * 256 * 4;

__device__ __forceinline__ void fill_rowscales(float* rsl, const float* ssq, float inv_n, const g8::Order& S) {
  const int tid = opaque_tid();
  g8::Unit u;
  __syncthreads();
  for (int i = 0; S.next(i, u); ++i) {
    if (tid < 256) {
      const float4* s4 = (const float4*)(ssq + (size_t)(u.pm * 256 + tid) * 16);
      float s = 0.f;
      for (int k = 0; k < 4; ++k) { float4 v = s4[k]; s += v.x + v.y + v.z + v.w; }
      rsl[i * 256 + tid] = rsqrtf(s * inv_n + EPS);
    }
  }
  __syncthreads();
}

__device__ __forceinline__ h16x4 pack4(float a, float b, float c, float d) { h16x4 v = {(h16)a, (h16)b, (h16)c, (h16)d}; return v; }

struct EpiIn {
  static constexpr int MID_T = -1;
  __device__ __forceinline__ void mid(f32x4 (&)[2][2][4][2], int, int, int) const {}
  h16* P; const float* rsl; const float* qkg;
  __device__ __forceinline__ void operator()(const f32x4 (&acc)[2][2][4][2], const g8::Unit& u, int ui, int wr, int wc, int fr, int fq) const {
    const int hs = u.pn * 4 + wc;
    int gi = -1;
    if (hs < 4) gi = 0; else if (hs < 6) gi = 1; else if (hs >= 16 && hs < 20) gi = 2; else if (hs == 22) gi = 4; else if (hs == 24) gi = 5;
    const bool gate = (hs == 26);
#pragma unroll
    for (int ai = 0; ai < 2; ++ai)
#pragma unroll
      for (int m = 0; m < 4; ++m) {
        const int rl = 128 * ai + 64 * wr + 16 * m + fr;
        float r = rsl[ui * 256 + rl];
        if (gi >= 0) {
          float ss = 0.f;
#pragma unroll
          for (int bj = 0; bj < 2; ++bj)
#pragma unroll
            for (int n = 0; n < 2; ++n)
#pragma unroll
              for (int j = 0; j < 4; ++j) ss += acc[ai][bj][m][n][j] * acc[ai][bj][m][n][j];
          ss += xor16(ss);
          ss += __shfl_xor(ss, 32);
          r *= rsqrtf(ss * r * r * (1.f / 64.f) + EPS);
        }
        h16* rowp = P + (size_t)(u.pm * 256 + rl) * IWP + 64 * hs + 4 * fq;
#pragma unroll
        for (int bj = 0; bj < 2; ++bj)
#pragma unroll
          for (int n = 0; n < 2; ++n) {
            f32x4 v = acc[ai][bj][m][n] * r;
            if (gi >= 0) {
              const float4 g4 = *(const float4*)(qkg + gi * 64 + 32 * bj + 16 * n + 4 * fq);
              v[0] *= g4.x; v[1] *= g4.y; v[2] *= g4.z; v[3] *= g4.w;
            } else if (gate) {
#pragma unroll
              for (int j = 0; j < 4; ++j) v[j] = (32 * bj + 16 * n + 4 * fq + j) < 12 ? sigmoidf(v[j]) : 0.f;
            }
            *(h16x4*)(rowp + 32 * bj + 16 * n) = pack4(v[0], v[1], v[2], v[3]);
          }
      }
  }
};

struct EpiGlu {
  static constexpr int MID_T = -1;
  __device__ __forceinline__ void mid(f32x4 (&)[2][2][4][2], int, int, int) const {}
  h16* OB; float* ssqb; const float* gb;
  __device__ __forceinline__ void operator()(const f32x4 (&acc)[2][2][4][2], const g8::Unit& u, int ui, int wr, int wc, int fr, int fq) const {
    const int ocb = 128 * u.pn + 16 * wc + 4 * fq;
    float4 ba[2], bb[2];
#pragma unroll
    for (int bj = 0; bj < 2; ++bj) { ba[bj] = *(const float4*)(gb + ocb + 64 * bj); bb[bj] = *(const float4*)(gb + 512 + ocb + 64 * bj); }
#pragma unroll
    for (int ai = 0; ai < 2; ++ai)
#pragma unroll
      for (int m = 0; m < 4; ++m) {
        const size_t row = (size_t)u.pm * 256 + 128 * ai + 64 * wr + 16 * m + fr;
        float ss = 0.f;
#pragma unroll
        for (int bj = 0; bj < 2; ++bj) {
          const f32x4 a = acc[ai][bj][m][0], b = acc[ai][bj][m][1];
          float o0 = (a[0] + ba[bj].x) * sigmoidf(b[0] + bb[bj].x);
          float o1 = (a[1] + ba[bj].y) * sigmoidf(b[1] + bb[bj].y);
          float o2 = (a[2] + ba[bj].z) * sigmoidf(b[2] + bb[bj].z);
          float o3 = (a[3] + ba[bj].w) * sigmoidf(b[3] + bb[bj].w);
          *(h16x4*)(OB + row * 1024 + ocb + 64 * bj) = pack4(o0, o1, o2, o3);
          ss += o0 * o0 + o1 * o1 + o2 * o2 + o3 * o3;
        }
        ss += xor16(ss);
        ss += __shfl_xor(ss, 32);
        if (fq == 0) ssqb[row * 16 + u.pn * 4 + wc] = ss;
      }
  }
};

struct EpiRes {
  static constexpr int MID_T = -1;
  __device__ __forceinline__ void mid(f32x4 (&)[2][2][4][2], int, int, int) const {}
  float* xo; h16* xb; float* ssq; bool final_out;
  __device__ __forceinline__ void operator()(const f32x4 (&acc)[2][2][4][2], const g8::Unit& u, int ui, int wr, int wc, int fr, int fq) const {
#pragma unroll
    for (int ai = 0; ai < 2; ++ai)
#pragma unroll
      for (int m = 0; m < 4; ++m) {
        const size_t row = (size_t)u.pm * 256 + 128 * ai + 64 * wr + 16 * m + fr;
        const size_t base = row * DM + 256 * u.pn + 32 * wc + 4 * fq;
        float ss = 0.f;
#pragma unroll
        for (int bj = 0; bj < 2; ++bj)
#pragma unroll
          for (int n = 0; n < 2; ++n) {
            const size_t idx = base + 128 * bj + 16 * n;
            const h16x4 xv = *(const h16x4*)(xb + idx);
            const f32x4 a = acc[ai][bj][m][n];
            const float x0 = (float)xv[0] + a[0], x1 = (float)xv[1] + a[1], x2 = (float)xv[2] + a[2], x3 = (float)xv[3] + a[3];
            if (final_out) *(float4*)(xo + idx) = make_float4(x0, x1, x2, x3);
            else *(h16x4*)(xb + idx) = pack4(x0, x1, x2, x3);
            ss += x0 * x0 + x1 * x1 + x2 * x2 + x3 * x3;
          }
        ss += xor16(ss);
        ss += __shfl_xor(ss, 32);
        if (fq == 0) ssq[row * 16 + u.pn * 4 + wc] = ss;
      }
  }
};

struct EpiOut : EpiRes {
  static constexpr int MID_T = 8;
  const float* rsl;
  __device__ __forceinline__ void mid(f32x4 (&acc)[2][2][4][2], int ui, int wr, int fr) const {
#pragma unroll
    for (int ai = 0; ai < 2; ++ai)
#pragma unroll
      for (int m = 0; m < 4; ++m) {
        const float r = rsl[ui * 256 + 128 * ai + 64 * wr + 16 * m + fr];
#pragma unroll
        for (int bj = 0; bj < 2; ++bj)
#pragma unroll
          for (int n = 0; n < 2; ++n) acc[ai][bj][m][n] *= r;
      }
  }
};

struct EpiUp {
  static constexpr int MID_T = -1;
  __device__ __forceinline__ void mid(f32x4 (&)[2][2][4][2], int, int, int) const {}
  h16* hid; const float* rsl;
  __device__ __forceinline__ void operator()(const f32x4 (&acc)[2][2][4][2], const g8::Unit& u, int ui, int wr, int wc, int fr, int fq) const {
#pragma unroll
    for (int ai = 0; ai < 2; ++ai)
#pragma unroll
      for (int m = 0; m < 4; ++m) {
        const int rl = 128 * ai + 64 * wr + 16 * m + fr;
        const float r = rsl[ui * 256 + rl];
        h16* rowp = hid + (size_t)(u.pm * 256 + rl) * DFF + 256 * u.pn + 32 * wc + 4 * fq;
#pragma unroll
        for (int bj = 0; bj < 2; ++bj)
#pragma unroll
          for (int n = 0; n < 2; ++n) {
            const f32x4 a = acc[ai][bj][m][n];
            float v0 = fmaxf(a[0] * r, 0.f), v1 = fmaxf(a[1] * r, 0.f), v2 = fmaxf(a[2] * r, 0.f), v3 = fmaxf(a[3] * r, 0.f);
            *(h16x4*)(rowp + 128 * bj + 16 * n) = pack4(v0 * v0, v1 * v1, v2 * v2, v3 * v3);
          }
      }
  }
};

__device__ __forceinline__ void phase_gemm1(const Params& p, int l, char* lds) {
  g8::Order S; S.init(NTOK, IWP, gridDim.x, blockIdx.x);
  float* rsl = (float*)(lds + RSL_OFF);
  fill_rowscales(rsl, (const float*)(WS(p) + O_SSQ), 1.f / DM, S);
  EpiIn E{(h16*)(WS(p) + O_P), rsl, p.in[3] + l * 6 * 64};
  g8::gemm_phase((LAS unsigned char*)lds, (const h16*)(WS(p) + O_XB), (const h16*)(WS(p) + O_WIN + l * SZ_WIN), DM, S, E);
}
__device__ __forceinline__ void phase_glu(const Params& p, int l, char* lds) {
  g8::Order S; S.init(NTOK, 1024, gridDim.x, blockIdx.x);
  __syncthreads();
  EpiGlu E{(h16*)(WS(p) + O_OB), (float*)(WS(p) + O_SSQB), p.in[15] + l * 1024};
  g8::gemm_phase((LAS unsigned char*)lds, (const h16*)(WS(p) + O_Z), (const h16*)(WS(p) + O_WGLU + l * SZ_WGLU), 512, S, E);
}
__device__ __forceinline__ void phase_wout(const Params& p, int l, char* lds) {
  g8::Order S; S.init(NTOK, DM, gridDim.x, blockIdx.x);
  float* rsl = (float*)(lds + RSL_OFF);
  fill_rowscales(rsl, (const float*)(WS(p) + O_SSQB), 1.f / 512.f, S);
  EpiOut E;
  E.xo = p.out; E.xb = (h16*)(WS(p) + O_XB); E.ssq = (float*)(WS(p) + O_SSQ); E.final_out = false; E.rsl = rsl;
  g8::gemm_phase((LAS unsigned char*)lds, (const h16*)(WS(p) + O_OB), (const h16*)(WS(p) + O_WOUT + l * SZ_WOUT), DM, S, E);
}
__device__ __forceinline__ void phase_up(const Params& p, int l, char* lds) {
  g8::Order S; S.init(NTOK, DFF, gridDim.x, blockIdx.x);
  float* rsl = (float*)(lds + RSL_OFF);
  fill_rowscales(rsl, (const float*)(WS(p) + O_SSQ), 1.f / DM, S);
  EpiUp E{(h16*)(WS(p) + O_HID), rsl};
  g8::gemm_phase((LAS unsigned char*)lds, (const h16*)(WS(p) + O_XB), (const h16*)(WS(p) + O_WUP + l * SZ_WUP), DM, S, E);
}
__device__ __forceinline__ void phase_down(const Params& p, int l, char* lds) {
  g8::Order S; S.init(NTOK, DM, gridDim.x, blockIdx.x);
  __syncthreads();
  EpiRes E{p.out, (h16*)(WS(p) + O_XB), (float*)(WS(p) + O_SSQ), l == DEPTH - 1};
  g8::gemm_phase((LAS unsigned char*)lds, (const h16*)(WS(p) + O_HID), (const h16*)(WS(p) + O_WDN + l * SZ_WDN), DFF, S, E);
}

constexpr int KP = 72;
enum { M_SWA = 0, M_WIN = 1, M_SEL = 2, M_CMPA = 3, M_CMPB = 4 };
constexpr float LOG2E = 1.4426950408889634f, SCL2 = 0.125f * LOG2E;
struct ColState { float m, l; };
typedef short s16x4v __attribute__((__vector_size__(8)));

__device__ __forceinline__ h16x8 ld_row8(const h16* base, int ld, int row, int nrows, int c8) {
  h16x8 z = {0, 0, 0, 0, 0, 0, 0, 0};
  return (row >= 0 && row < nrows) ? *(const h16x8*)(base + (size_t)row * ld + c8 * 8) : z;
}
__device__ __forceinline__ void st_k(h16* Ks, int row, int c8, h16x8 v) { *(h16x8*)(Ks + row * KP + c8 * 8) = v; }
__device__ __forceinline__ void st_vt(h16* Vt, int row, int c8, h16x8 v) {
#pragma unroll
  for (int e = 0; e < 8; ++e) Vt[(c8 * 8 + e) * KP + row] = v[e];
}
__device__ __forceinline__ float max4q(float v) {
  v = fmaxf(v, xor16(v));
  auto r = __builtin_amdgcn_permlane32_swap(__float_as_int(v), __float_as_int(v), false, false);
  return fmaxf(__int_as_float(r[0]), __int_as_float(r[1]));
}
__device__ __forceinline__ float sum4q(float v) {
  v += xor16(v);
  auto r = __builtin_amdgcn_permlane32_swap(__float_as_int(v), __float_as_int(v), false, false);
  return __int_as_float(r[0]) + __int_as_float(r[1]);
}
__device__ __forceinline__ float quadsum(float v) { v += dppf<0xB1>(v); v += dppf<0x4E>(v); return v; }

template <int MODE, int RGM>
__device__ __forceinline__ void attn_tile(const h16x8 (&Q)[2][2], f32x4 (&O)[2][4], ColState (&st)[2], const h16* Ks,
                                          const h16* Vt, const float* biasT, const int (&tq)[2], int hd, int kbase, bool far,
                                          const bool (&selbit)[2], float (&hq)[2][4], float (&h3)[2][4], const int lane) {
  const int col = lane & 15, q4 = lane >> 4;
  constexpr int DK = (MODE == M_CMPA || MODE == M_CMPB) ? 16 : 1;
  f32x4 S[2][4];
#pragma unroll
  for (int kt = 0; kt < 4; ++kt) {
#pragma unroll
    for (int rg = 0; rg < 2; ++rg) S[rg][kt] = f32x4{0.f, 0.f, 0.f, 0.f};
#pragma unroll
    for (int ks = 0; ks < 2; ++ks) {
      h16x8 Kf = *(const h16x8*)(Ks + (kt * 16 + col) * KP + ks * 32 + q4 * 8);
#pragma unroll
      for (int rg = 0; rg < 2; ++rg)
        if (RGM & (1 << rg)) S[rg][kt] = __builtin_amdgcn_mfma_f32_16x16x32_f16(Kf, Q[rg][ks], S[rg][kt], 0, 0, 0);
    }
  }
  h16x8 Pf[2][2];
#pragma unroll
  for (int rg = 0; rg < 2; ++rg) {
    if (!(RGM & (1 << rg))) continue;
    const float* bt = biasT + hd * 800;
    if (far) {
      const float b31 = bt[799];
      const bool ok = (MODE == M_SEL) ? selbit[rg] : true;
#pragma unroll
      for (int kt = 0; kt < 4; ++kt)
#pragma unroll
        for (int j = 0; j < 4; ++j) S[rg][kt][j] = ok ? S[rg][kt][j] * SCL2 + b31 : -1e30f;
    } else {
      const int kx0 = kbase + q4 * 4;
      const int d0 = (DK == 16) ? tq[rg] - 31 - 16 * kx0 : tq[rg] - kx0;
#pragma unroll
      for (int kt = 0; kt < 4; ++kt)
#pragma unroll
        for (int j = 0; j < 4; ++j) {
          const int dist = d0 - DK * (kt * 16 + j);
          const int kx = kx0 + kt * 16 + j;
          bool valid = dist >= 0;
          if (MODE == M_SWA) valid = valid && dist < 128 && kx >= 0;
          if (MODE == M_WIN) valid = valid && dist < 512 && kx >= 0;
          if (MODE == M_SEL) valid = valid && selbit[rg];
          if (DK == 16) valid = valid && kx < NCMP;
          const int dc = dist < 0 ? 0 : (dist > 799 ? 799 : dist);
          S[rg][kt][j] = valid ? S[rg][kt][j] * SCL2 + bt[dc] : -1e30f;
        }
    }
    if (MODE == M_CMPB) {
#pragma unroll
      for (int kt = 0; kt < 4; ++kt) {
        float h = 0.f;
#pragma unroll
        for (int j = 0; j < 4; ++j) {
          float pv = __builtin_amdgcn_exp2f(S[rg][kt][j] - st[rg].m) * st[rg].l;
          S[rg][kt][j] = pv;
          h += pv;
        }
        hq[rg][kt] = h;
        h3[rg][kt] = S[rg][kt][3];
      }
    } else {
      float mx = -1e30f;
#pragma unroll
      for (int kt = 0; kt < 4; ++kt)
#pragma unroll
        for (int j = 0; j < 4; ++j) mx = fmaxf(mx, S[rg][kt][j]);
      mx = max4q(mx);
      const float mn = fmaxf(st[rg].m, mx);
      const float corr = __builtin_amdgcn_exp2f(st[rg].m - mn);
      st[rg].m = mn;
      const float mm = fmaxf(mn, -1e20f);
      float ls = 0.f;
#pragma unroll
      for (int kt = 0; kt < 4; ++kt)
#pragma unroll
        for (int j = 0; j < 4; ++j) {
          float pv = __builtin_amdgcn_exp2f(S[rg][kt][j] - mm);
          S[rg][kt][j] = pv;
          ls += pv;
        }
      st[rg].l = st[rg].l * corr + ls;
      if (MODE != M_CMPA) {
#pragma unroll
        for (int nt = 0; nt < 4; ++nt) O[rg][nt] *= corr;
      }
    }
    if (MODE != M_CMPA) {
#pragma unroll
      for (int ks = 0; ks < 2; ++ks)
#pragma unroll
        for (int i = 0; i < 4; ++i) {
          Pf[rg][ks][i] = (h16)S[rg][2 * ks][i];
          Pf[rg][ks][4 + i] = (h16)S[rg][2 * ks + 1][i];
        }
    }
  }
  if (MODE == M_CMPA) return;
#pragma unroll
  for (int ks = 0; ks < 2; ++ks)
#pragma unroll
    for (int nt = 0; nt < 4; ++nt) {
      const h16* vp = Vt + (ks * 32 + q4 * 4 + (col >> 2)) * KP + nt * 16 + 4 * (col & 3);
      const s16x4v r0 = __builtin_amdgcn_ds_read_tr16_b64_v4i16((LAS s16x4v*)vp);
      const s16x4v r1 = __builtin_amdgcn_ds_read_tr16_b64_v4i16((LAS s16x4v*)(vp + 16 * KP));
      const h16x4 v0 = __builtin_bit_cast(h16x4, r0), v1 = __builtin_bit_cast(h16x4, r1);
      const h16x8 Vf = {v0[0], v0[1], v0[2], v0[3], v1[0], v1[1], v1[2], v1[3]};
#pragma unroll
      for (int rg = 0; rg < 2; ++rg)
        if (RGM & (1 << rg)) O[rg][nt] = __builtin_amdgcn_mfma_f32_16x16x32_f16(Vf, Pf[rg][ks], O[rg][nt], 0, 0, 0);
    }
}

constexpr int LDS_CMP = 8 * 16 * 128 * 4 + 16 * 136 * 2 + 4 * 16 * 4;
__device__ __forceinline__ void phase_compress(const Params& p, int l, char* lds) {
  const int tid = opaque_tid(), lane = tid & 63, w = tid >> 6, col = lane & 15, q4 = lane >> 4;
  float* red = (float*)lds;
  h16* hid = (h16*)(lds + 8 * 16 * 128 * 4);
  float* nrm2 = (float*)(lds + 8 * 16 * 128 * 4 + 16 * 136 * 2);
  const h16* P = (const h16*)(WS(p) + O_P);
  for (int u = blockIdx.x; u < BATCH * 2 * 32; u += gridDim.x) {
    const int mt = u & 31, st = (u >> 5) & 1, b = u >> 6;
    const h16* W1t = (const h16*)(WS(p) + O_W1T) + (size_t)(l * 2 + st) * 128 * 2048;
    const h16* W2t = (const h16*)(WS(p) + O_W2T) + (size_t)(l * 2 + st) * 64 * 128;
    const float* b1 = (const float*)(WS(p) + O_BIAS1) + (l * 2 + st) * 128;
    __syncthreads();
    {
      f32x4 acc[8];
#pragma unroll
      for (int nt = 0; nt < 8; ++nt) acc[nt] = f32x4{0.f, 0.f, 0.f, 0.f};
      const int m = 16 * mt + col;
#pragma unroll 2
      for (int kk = 0; kk < 8; ++kk) {
        const int ks = 8 * w + kk, tt = ks >> 1, d0 = (ks & 1) * 32 + q4 * 8;
        int tok = 16 * m + tt;
        if (tok > SEQ - 1) tok = SEQ - 1;
        const h16x8 A = *(const h16x8*)(P + ((size_t)b * SEQ + tok) * IWP + OFF_KVC + st * 64 + d0);
#pragma unroll
        for (int nt = 0; nt < 8; ++nt) {
          const h16x8 B = *(const h16x8*)(W1t + (size_t)(nt * 16 + col) * 2048 + ks * 32 + q4 * 8);
          acc[nt] = __builtin_amdgcn_mfma_f32_16x16x32_f16(A, B, acc[nt], 0, 0, 0);
        }
      }
#pragma unroll
      for (int nt = 0; nt < 8; ++nt)
#pragma unroll
        for (int j = 0; j < 4; ++j) red[(w * 16 + q4 * 4 + j) * 128 + nt * 16 + col] = acc[nt][j];
    }
    __syncthreads();
    {
      const int row = tid >> 5, c4 = (tid & 31) * 4;
      float4 sum = *(const float4*)(b1 + c4);
#pragma unroll
      for (int ww = 0; ww < 8; ++ww) {
        const float4 v = *(const float4*)(red + (ww * 16 + row) * 128 + c4);
        sum.x += v.x; sum.y += v.y; sum.z += v.z; sum.w += v.w;
      }
      *(h16x4*)(hid + row * 136 + c4) = pack4(gelu_tanh(sum.x), gelu_tanh(sum.y), gelu_tanh(sum.z), gelu_tanh(sum.w));
    }
    __syncthreads();
    f32x4 o2 = {0.f, 0.f, 0.f, 0.f};
    if (w < 4) {
#pragma unroll
      for (int ks = 0; ks < 4; ++ks) {
        const h16x8 A = *(const h16x8*)(hid + col * 136 + ks * 32 + q4 * 8);
        const h16x8 B = *(const h16x8*)(W2t + (size_t)(w * 16 + col) * 128 + ks * 32 + q4 * 8);
        o2 = __builtin_amdgcn_mfma_f32_16x16x32_f16(A, B, o2, 0, 0, 0);
      }
      if (st == 0) {
#pragma unroll
        for (int j = 0; j < 4; ++j) {
          float ss = sum16(o2[j] * o2[j]);
          if (col == 0) nrm2[w * 16 + q4 * 4 + j] = ss;
        }
      }
    }
    __syncthreads();
    if (w < 4) {
      const float g = p.in[3][(l * 6 + 3) * 64 + w * 16 + col];
      h16* dst = (h16*)(WS(p) + (st == 0 ? O_KCMP : O_VCMP));
#pragma unroll
      for (int j = 0; j < 4; ++j) {
        const int row = q4 * 4 + j, m = 16 * mt + row;
        float v = o2[j];
        if (st == 0) {
          float tot = nrm2[row] + nrm2[16 + row] + nrm2[32 + row] + nrm2[48 + row];
          v = v * rsqrtf(tot * (1.f / 64.f) + EPS) * g;
        }
        if (m >= NCMP) v = 0.f;
        dst[((size_t)b * 512 + m) * 64 + w * 16 + col] = (h16)v;
      }
    }
  }
}


template <int MODE, int TM>
__device__ __forceinline__ void attn_tile2(const h16x8 (&Q)[2], f32x4 (&O)[4], ColState& st, const h16* Ks0, const h16* Vt0,
                                           const h16* Ks1, const h16* Vt1, const float* biasT, int tq, int hd, int kbase0,
                                           const bool (&far)[2], const bool (&selbit)[2], float (&hq)[2][4], float (&h3)[2][4],
                                           const int lane) {
  const int col = lane & 15, q4 = lane >> 4;
  constexpr int DK = (MODE == M_CMPA || MODE == M_CMPB) ? 16 : 1;
  f32x4 S[2][4];
#pragma unroll
  for (int t = 0; t < 2; ++t) {
    if (!(TM & (1 << t))) continue;
    const h16* Ks = t ? Ks1 : Ks0;
#pragma unroll
    for (int kt = 0; kt < 4; ++kt) {
      S[t][kt] = f32x4{0.f, 0.f, 0.f, 0.f};
#pragma unroll
      for (int ks = 0; ks < 2; ++ks) {
        h16x8 Kf = *(const h16x8*)(Ks + (kt * 16 + col) * KP + ks * 32 + q4 * 8);
        S[t][kt] = __builtin_amdgcn_mfma_f32_16x16x32_f16(Kf, Q[ks], S[t][kt], 0, 0, 0);
      }
    }
  }
  const float* bt = biasT + hd * 800;
  float addc[2] = {0.f, 0.f}, sclc[2] = {1.f, 1.f};
#pragma unroll
  for (int t = 0; t < 2; ++t) {
    if (!(TM & (1 << t))) continue;
    const int kbase = kbase0 + 64 * t;
    if (far[t]) {
      const bool ok = (MODE == M_SEL) ? selbit[t] : true;
      addc[t] = ok ? bt[799] : -1e30f;
      sclc[t] = SCL2;
    } else {
      addc[t] = 0.f;
      sclc[t] = 1.f;
      const int kx0 = kbase + q4 * 4;
      const int d0 = (DK == 16) ? tq - 31 - 16 * kx0 : tq - kx0;
#pragma unroll
      for (int kt = 0; kt < 4; ++kt)
#pragma unroll
        for (int j = 0; j < 4; ++j) {
          const int dist = d0 - DK * (kt * 16 + j);
          const int kx = kx0 + kt * 16 + j;
          bool valid = dist >= 0;
          if (MODE == M_WIN) valid = valid && dist < 512 && kx >= 0;
          if (MODE == M_SEL) valid = valid && selbit[t];
          if (DK == 16) valid = valid && kx < NCMP;
          const int dc = dist < 0 ? 0 : (dist > 799 ? 799 : dist);
          S[t][kt][j] = valid ? S[t][kt][j] * SCL2 + bt[dc] : -1e30f;
        }
    }
  }
  if (MODE == M_CMPB) {
#pragma unroll
    for (int t = 0; t < 2; ++t) {
      if (!(TM & (1 << t))) continue;
#pragma unroll
      for (int kt = 0; kt < 4; ++kt) {
        float h = 0.f;
#pragma unroll
        for (int j = 0; j < 4; ++j) {
          float pv = __builtin_amdgcn_exp2f(S[t][kt][j] * sclc[t] + (addc[t] - st.m)) * st.l;
          S[t][kt][j] = pv;
          h += pv;
        }
        hq[t][kt] = h;
        h3[t][kt] = S[t][kt][3];
      }
    }
  } else {
    float mx = -1e30f;
#pragma unroll
    for (int t = 0; t < 2; ++t) {
      if (!(TM & (1 << t))) continue;
      float mt = -1e30f;
#pragma unroll
      for (int kt = 0; kt < 4; ++kt)
#pragma unroll
        for (int j = 0; j < 4; ++j) mt = fmaxf(mt, S[t][kt][j]);
      mx = fmaxf(mx, mt * sclc[t] + addc[t]);
    }
    mx = max4q(mx);
    const float mn = fmaxf(st.m, mx);
    const float corr = __builtin_amdgcn_exp2f(st.m - mn);
    st.m = mn;
    const float mm = fmaxf(mn, -1e20f);
    float ls = 0.f;
#pragma unroll
    for (int t = 0; t < 2; ++t) {
      if (!(TM & (1 << t))) continue;
      const float am = addc[t] - mm;
#pragma unroll
      for (int kt = 0; kt < 4; ++kt) {
        const f32x4 e = S[t][kt] * sclc[t] + am;
#pragma unroll
        for (int j = 0; j < 4; ++j) {
          float pv = __builtin_amdgcn_exp2f(e[j]);
          S[t][kt][j] = pv;
          ls += pv;
        }
      }
    }
    st.l = st.l * corr + ls;
    if (MODE != M_CMPA) {
#pragma unroll
      for (int nt = 0; nt < 4; ++nt) O[nt] *= corr;
    }
  }
  if (MODE == M_CMPA) return;
#pragma unroll
  for (int t = 0; t < 2; ++t) {
    if (!(TM & (1 << t))) continue;
    const h16* Vt = t ? Vt1 : Vt0;
#pragma unroll
    for (int ks = 0; ks < 2; ++ks) {
      h16x8 Pf;
#pragma unroll
      for (int i = 0; i < 4; ++i) { Pf[i] = (h16)S[t][2 * ks][i]; Pf[4 + i] = (h16)S[t][2 * ks + 1][i]; }
#pragma unroll
      for (int nt = 0; nt < 4; ++nt) {
        const h16* vp = Vt + (ks * 32 + q4 * 4 + (col >> 2)) * KP + nt * 16 + 4 * (col & 3);
        const s16x4v r0 = __builtin_amdgcn_ds_read_tr16_b64_v4i16((LAS s16x4v*)vp);
        const s16x4v r1 = __builtin_amdgcn_ds_read_tr16_b64_v4i16((LAS s16x4v*)(vp + 16 * KP));
        const h16x4 v0 = __builtin_bit_cast(h16x4, r0), v1 = __builtin_bit_cast(h16x4, r1);
        const h16x8 Vf = {v0[0], v0[1], v0[2], v0[3], v1[0], v1[1], v1[2], v1[3]};
        O[nt] = __builtin_amdgcn_mfma_f32_16x16x32_f16(Vf, Pf, O[nt], 0, 0, 0);
      }
    }
  }
}

template <int D, class LoadF, class StoreF, class CompF>
__device__ __forceinline__ void pair_pipeline(int n, LoadF load, StoreF store, CompF comp) {
  h16x8 r[D][4];
#pragma unroll
  for (int d = 0; d < D; ++d)
    if (d < n) load(d, r[d]);
  store(0, r[0]);
  if (D < n) load(D, r[0]);
  __syncthreads();
  for (int i0 = 0; i0 < n; i0 += D) {
#pragma unroll
    for (int d = 0; d < D; ++d) {
      const int i = i0 + d;
      if (i < n) {
        if (i + 1 < n) store(i + 1, r[(d + 1) % D]);
        if (i + 1 + D < n) load(i + 1 + D, r[(d + 1) % D]);
        comp(i);
        __syncthreads();
      }
    }
  }
}

template <int D, class LoadF, class StoreF, class CompF>
__device__ __forceinline__ void tile_pipeline(int n, LoadF load, StoreF store, CompF comp) {
  h16x8 rk[D], rv[D];
#pragma unroll
  for (int d = 0; d < D; ++d)
    if (d < n) load(d, rk[d], rv[d]);
  store(0, rk[0], rv[0]);
  if (D < n) load(D, rk[0], rv[0]);
  __syncthreads();
  for (int i0 = 0; i0 < n; i0 += D) {
#pragma unroll
    for (int d = 0; d < D; ++d) {
      const int i = i0 + d;
      if (i < n) {
        if (i + 1 < n) store(i + 1, rk[(d + 1) % D], rv[(d + 1) % D]);
        if (i + 1 + D < n) load(i + 1 + D, rk[(d + 1) % D], rv[(d + 1) % D]);
        comp(i);
        __syncthreads();
      }
    }
  }
}

constexpr int LDS_BIAS = 800 * 16;
__device__ __forceinline__ void phase_swa(const Params& p, int l, char* lds) {
  const int tid = opaque_tid(), lane = tid & 63, w = tid >> 6, col = lane & 15, q4 = lane >> 4;
  float* biasT = (float*)lds;
  h16* KV = (h16*)(lds + LDS_BIAS);
  float* nrm = (float*)(lds + LDS_BIAS + 4 * 64 * KP * 2);
  const h16* P = (const h16*)(WS(p) + O_P);
  const int* lut = (const int*)(WS(p) + O_LUT);
  h16* OAC = (h16*)(WS(p) + O_OAC);
  __syncthreads();
  for (int i = tid; i < 3200; i += NT) biasT[i] = p.in[5][lut[i % 800] * 8 + (i / 800)] * LOG2E;
  __syncthreads();
  const int head = w >> 1, kvh = w >> 2;
  const float sink = p.in[4][l * 4 + head] * LOG2E;
  const int srow = tid >> 3, c8 = tid & 7;
  float hpd[2][4], hpe[2][4];
  const bool nosel[2] = {false, false};
  for (int u = blockIdx.x; u < BATCH * 128; u += gridDim.x) {
    const int b = u >> 7, t0 = (u & 127) * 64;
    const h16* Pbat = P + (size_t)b * SEQ * IWP;
    h16x8 Q[2][2];
    int tq[2];
#pragma unroll
    for (int rg = 0; rg < 2; ++rg) {
      const int qb = (w & 1) * 32 + rg * 16;
      const h16* qp = Pbat + (size_t)(t0 + qb + col) * IWP + head * 64 + q4 * 8;
      Q[rg][0] = *(const h16x8*)qp;
      Q[rg][1] = *(const h16x8*)(qp + 32);
      tq[rg] = t0 + qb + col;
    }
    f32x4 O[2][4];
    ColState st[2];
#pragma unroll
    for (int rg = 0; rg < 2; ++rg) {
#pragma unroll
      for (int nt = 0; nt < 4; ++nt) O[rg][nt] = f32x4{0.f, 0.f, 0.f, 0.f};
      st[rg].m = -1e30f; st[rg].l = 0.f;
    }
    const int i0 = t0 >= 128 ? 0 : (t0 >= 64 ? 1 : 2);
    h16x8 rk[2], rv[2];
    {
      int sb = t0 - 128 + i0 * 64;
      for (int h2 = 0; h2 < 2; ++h2) {
        rk[h2] = ld_row8(Pbat + 256 + h2 * 64, IWP, sb + srow, SEQ, c8);
        rv[h2] = ld_row8(Pbat + 384 + h2 * 64, IWP, sb + srow, SEQ, c8);
      }
    }
    for (int i = i0; i < 3; ++i) {
      __syncthreads();
      for (int h2 = 0; h2 < 2; ++h2) {
        st_k(KV + h2 * 64 * KP, srow, c8, rk[h2]);
        st_k(KV + (2 + h2) * 64 * KP, srow, c8, rv[h2]);
      }
      __syncthreads();
      if (i + 1 < 3) {
        int sb = t0 - 128 + (i + 1) * 64;
        for (int h2 = 0; h2 < 2; ++h2) {
          rk[h2] = ld_row8(Pbat + 256 + h2 * 64, IWP, sb + srow, SEQ, c8);
          rv[h2] = ld_row8(Pbat + 384 + h2 * 64, IWP, sb + srow, SEQ, c8);
        }
      }
      const int kb = t0 - 128 + i * 64;
      attn_tile<M_SWA, 3>(Q, O, st, KV + kvh * 64 * KP, KV + (2 + kvh) * 64 * KP, biasT, tq, head, kb, false, nosel, hpd, hpe, lane);
    }
    __syncthreads();
#pragma unroll
    for (int rg = 0; rg < 2; ++rg) {
      const int qb = (w & 1) * 32 + rg * 16;
      const float lsum = sum4q(st[rg].l);
      const float mn = fmaxf(st[rg].m, sink);
      const float corr = __builtin_amdgcn_exp2f(st[rg].m - mn);
      const float inv = corr / (lsum * corr + __builtin_amdgcn_exp2f(sink - mn));
      float ss = 0.f;
#pragma unroll
      for (int nt = 0; nt < 4; ++nt) {
        O[rg][nt] *= inv;
#pragma unroll
        for (int j = 0; j < 4; ++j) ss += O[rg][nt][j] * O[rg][nt][j];
      }
      ss = sum4q(ss);
      if (q4 == 0) nrm[head * 64 + qb + col] = ss;
    }
    __syncthreads();
#pragma unroll
    for (int rg = 0; rg < 2; ++rg) {
      const int qi = (w & 1) * 32 + rg * 16 + col;
      const float tot = nrm[qi] + nrm[64 + qi] + nrm[128 + qi] + nrm[192 + qi];
      const float sc = rsqrtf(tot * (1.f / 256.f) + EPS);
#pragma unroll
      for (int nt = 0; nt < 4; ++nt)
        *(h16x4*)(OAC + ((size_t)b * SEQ + t0 + qi) * 1024 + head * 64 + nt * 16 + q4 * 4) =
            pack4(O[rg][nt][0] * sc, O[rg][nt][1] * sc, O[rg][nt][2] * sc, O[rg][nt][3] * sc);
    }
  }
}

constexpr int LDS_NSA = LDS_BIAS + 8 * 64 * KP * 2 + NW * 4 * 128 * 4 + 32 * 16;
constexpr int PFD = 2;
__device__ __forceinline__ void phase_nsa(const Params& p, int l, char* lds, const int parts = 15) {
  const int tid = opaque_tid(), lane = tid & 63, w = tid >> 6, col = lane & 15, q4 = lane >> 4;
  float* biasT = (float*)lds;
  h16* KV0 = (h16*)(lds + LDS_BIAS);
  float* impw = (float*)(lds + LDS_BIAS + 8 * 64 * KP * 2) + w * 4 * 128;
  unsigned long long* selm = (unsigned long long*)(lds + LDS_BIAS + 8 * 64 * KP * 2 + NW * 4 * 128 * 4);
#define KSB(i, t) (KV0 + (((i) & 1) * 4 + (t) * 2) * 64 * KP)
#define VTB(i, t) (KV0 + (((i) & 1) * 4 + (t) * 2 + 1) * 64 * KP)
  const h16* P = (const h16*)(WS(p) + O_P);
  const int* lut = (const int*)(WS(p) + O_LUT);
  h16* OAC = (h16*)(WS(p) + O_OAC);
  __syncthreads();
  for (int i = tid; i < 3200; i += NT) biasT[i] = p.in[5][lut[i % 800] * 8 + 4 + (i / 800)] * LOG2E;
  __syncthreads();
  const int srow = tid >> 3, c8 = tid & 7;
  const int hd = col & 3, qw = col >> 2;
  float hpd[2][4], hpe[2][4];
  const bool nosel[2] = {false, false};
  for (int u = blockIdx.x; u < 1024; u += gridDim.x) {
    const int rnd = u >> 8, b = (u & 255) >> 6, ti = u & 63;
    const int tile = rnd == 0 ? 255 - ti : (rnd == 1 ? 128 + ti : (rnd == 2 ? 127 - ti : ti));
    const int t0 = tile * 32, cur = t0 >> 6;
    const h16* Pbat = P + (size_t)b * SEQ * IWP;
    const h16* KC = (const h16*)(WS(p) + O_KCMP) + (size_t)b * 512 * 64;
    const h16* VC = (const h16*)(WS(p) + O_VCMP) + (size_t)b * 512 * 64;
    h16x8 Q[2];
    int tq;
    {
      const h16* qp = Pbat + (size_t)(t0 + w * 4 + qw) * IWP + OFF_QC + hd * 64 + q4 * 8;
      Q[0] = *(const h16x8*)qp;
      Q[1] = *(const h16x8*)(qp + 32);
      tq = t0 + w * 4 + qw;
    }
    const h16* gp = Pbat + (size_t)tq * IWP + OFF_GC + hd * 3;
    for (int i = lane; i < 512; i += 64) impw[i] = 0.f;
    f32x4 O[4], Oc[4];
    ColState st;
    int mvmax = t0 / 16 + 1;
    if (mvmax > NCMP) mvmax = NCMP;
    const int ntc = (mvmax + 63) >> 6;
    st.m = -1e30f; st.l = 0.f;
    const int npc = (ntc + 1) >> 1;
    if (parts & 1) pair_pipeline<PFD>(npc,
      [&](int i, h16x8 (&r)[4]) { r[0] = ld_row8(KC, 64, (2 * i) * 64 + srow, 512, c8); r[2] = ld_row8(KC, 64, (2 * i + 1) * 64 + srow, 512, c8); },
      [&](int i, const h16x8 (&r)[4]) { st_k(KSB(i, 0), srow, c8, r[0]); st_k(KSB(i, 1), srow, c8, r[2]); },
      [&](int i) {
        const bool far[2] = {t0 - 31 - 16 * (2 * i * 64 + 63) >= 799, t0 - 31 - 16 * ((2 * i + 1) * 64 + 63) >= 799};
        if (2 * i + 1 < ntc) attn_tile2<M_CMPA, 3>(Q, O, st, KSB(i, 0), VTB(i, 0), KSB(i, 1), VTB(i, 1), biasT, tq, hd, 2 * i * 64, far, nosel, hpd, hpe, lane);
        else attn_tile2<M_CMPA, 1>(Q, O, st, KSB(i, 0), VTB(i, 0), KSB(i, 1), VTB(i, 1), biasT, tq, hd, 2 * i * 64, far, nosel, hpd, hpe, lane);
      });
    {
      const float ls = sum4q(st.l);
      st.l = ls > 0.f ? 1.f / ls : 0.f;
    }
#pragma unroll
    for (int nt = 0; nt < 4; ++nt) O[nt] = f32x4{0.f, 0.f, 0.f, 0.f};
    float carry = 0.f;
    if (parts & 1) pair_pipeline<PFD>(npc,
      [&](int i, h16x8 (&r)[4]) {
        r[0] = ld_row8(KC, 64, (2 * i) * 64 + srow, 512, c8); r[1] = ld_row8(VC, 64, (2 * i) * 64 + srow, 512, c8);
        r[2] = ld_row8(KC, 64, (2 * i + 1) * 64 + srow, 512, c8); r[3] = ld_row8(VC, 64, (2 * i + 1) * 64 + srow, 512, c8); },
      [&](int i, const h16x8 (&r)[4]) {
        st_k(KSB(i, 0), srow, c8, r[0]); st_k(VTB(i, 0), srow, c8, r[1]); st_k(KSB(i, 1), srow, c8, r[2]); st_k(VTB(i, 1), srow, c8, r[3]); },
      [&](int i) {
        float hq[2][4], h3[2][4];
        const bool far[2] = {t0 - 31 - 16 * (2 * i * 64 + 63) >= 799, t0 - 31 - 16 * ((2 * i + 1) * 64 + 63) >= 799};
        const bool two = 2 * i + 1 < ntc;
        if (two) attn_tile2<M_CMPB, 3>(Q, O, st, KSB(i, 0), VTB(i, 0), KSB(i, 1), VTB(i, 1), biasT, tq, hd, 2 * i * 64, far, nosel, hq, h3, lane);
        else attn_tile2<M_CMPB, 1>(Q, O, st, KSB(i, 0), VTB(i, 0), KSB(i, 1), VTB(i, 1), biasT, tq, hd, 2 * i * 64, far, nosel, hq, h3, lane);
        float t3p = carry;
#pragma unroll
        for (int t = 0; t < 2; ++t) {
          if (t == 1 && !two) break;
#pragma unroll
          for (int kt = 0; kt < 4; ++kt) {
            const float qs = quadsum(hq[t][kt]);
            const float t3 = quadsum(h3[t][kt]);
            const float up = __shfl(t3, (lane + 48) & 63);
            const float wrp = __shfl(t3p, (lane + 48) & 63);
            const float pk = (q4 == 0) ? wrp : up;
            if (hd == 0) impw[qw * 128 + (2 * i + t) * 16 + kt * 4 + q4] = qs + pk;
            t3p = t3;
          }
        }
        carry = t3p;
      });
    {
      const float g0 = (float)gp[0];
#pragma unroll
      for (int nt = 0; nt < 4; ++nt) Oc[nt] = O[nt] * g0;
    }
    if (parts & 2) {
      const int nforced = cur >= 2 ? 3 : cur + 1;
      const int npick = 16 - nforced;
      for (int qi = 0; qi < 4; ++qi) {
        const float* im = impw + qi * 128;
        const int j0 = lane, j1 = lane + 64;
        const float v0 = im[j0], v1 = im[j1];
        int r0 = 0, r1 = 0;
#pragma unroll 8
        for (int jp = 1; jp <= cur - 2; ++jp) {
          float vp = im[jp];
          r0 += (vp > v0 || (vp == v0 && jp < j0)) ? 1 : 0;
          r1 += (vp > v1 || (vp == v1 && jp < j1)) ? 1 : 0;
        }
        bool c0 = j0 >= 1 && j0 <= cur - 2, c1 = j1 <= cur - 2;
        bool f0 = j0 == 0 || j0 == cur || j0 == cur - 1, f1 = j1 == cur || j1 == cur - 1;
        unsigned long long mlo = __ballot(f0 || (c0 && r0 < npick));
        unsigned long long mhi = __ballot(f1 || (c1 && r1 < npick));
        if (lane == 0) { selm[(w * 4 + qi) * 2] = mlo; selm[(w * 4 + qi) * 2 + 1] = mhi; }
      }
    }
    asm volatile("" ::: "memory");
    const unsigned long long slo = selm[(w * 4 + qw) * 2], shi = selm[(w * 4 + qw) * 2 + 1];
#pragma unroll
    for (int nt = 0; nt < 4; ++nt) O[nt] = f32x4{0.f, 0.f, 0.f, 0.f};
    st.m = -1e30f; st.l = 0.f;
    if (parts & 4) pair_pipeline<PFD>((cur + 2) >> 1,
      [&](int i, h16x8 (&r)[4]) {
        r[0] = ld_row8(Pbat + OFF_KVC + 128, IWP, (2 * i) * 64 + srow, SEQ, c8); r[1] = ld_row8(Pbat + OFF_KVC + 192, IWP, (2 * i) * 64 + srow, SEQ, c8);
        r[2] = ld_row8(Pbat + OFF_KVC + 128, IWP, (2 * i + 1) * 64 + srow, SEQ, c8); r[3] = ld_row8(Pbat + OFF_KVC + 192, IWP, (2 * i + 1) * 64 + srow, SEQ, c8); },
      [&](int i, const h16x8 (&r)[4]) {
        st_k(KSB(i, 0), srow, c8, r[0]); st_k(VTB(i, 0), srow, c8, r[1]); st_k(KSB(i, 1), srow, c8, r[2]); st_k(VTB(i, 1), srow, c8, r[3]); },
      [&](int i) {
        const int jb = 2 * i;
        bool sb[2];
        sb[0] = ((jb < 64 ? (slo >> jb) : (shi >> (jb - 64))) & 1ull) != 0;
        sb[1] = (jb + 1 <= cur) && (((jb + 1 < 64 ? (slo >> (jb + 1)) : (shi >> (jb + 1 - 64))) & 1ull) != 0);
        const bool far[2] = {t0 - (jb * 64 + 63) >= 799, t0 - (jb * 64 + 127) >= 799};
        const bool n0 = __any(sb[0]) != 0, n1 = __any(sb[1]) != 0;
        if (n0 && n1) attn_tile2<M_SEL, 3>(Q, O, st, KSB(i, 0), VTB(i, 0), KSB(i, 1), VTB(i, 1), biasT, tq, hd, jb * 64, far, sb, hpd, hpe, lane);
        else if (n0) attn_tile2<M_SEL, 1>(Q, O, st, KSB(i, 0), VTB(i, 0), KSB(i, 1), VTB(i, 1), biasT, tq, hd, jb * 64, far, sb, hpd, hpe, lane);
        else if (n1) attn_tile2<M_SEL, 2>(Q, O, st, KSB(i, 0), VTB(i, 0), KSB(i, 1), VTB(i, 1), biasT, tq, hd, jb * 64, far, sb, hpd, hpe, lane);
      });
    {
      const float ls = sum4q(st.l);
      const float f = ls > 0.f ? (float)gp[1] / ls : 0.f;
#pragma unroll
      for (int nt = 0; nt < 4; ++nt) Oc[nt] += O[nt] * f;
    }
#pragma unroll
    for (int nt = 0; nt < 4; ++nt) O[nt] = f32x4{0.f, 0.f, 0.f, 0.f};
    st.m = -1e30f; st.l = 0.f;
    const int w0 = cur >= 8 ? cur - 8 : 0;
    const int nwt = cur - w0 + 1;
    if (parts & 8) pair_pipeline<PFD>((nwt + 1) >> 1,
      [&](int i, h16x8 (&r)[4]) {
        r[0] = ld_row8(Pbat + OFF_KVC + 256, IWP, (w0 + 2 * i) * 64 + srow, SEQ, c8); r[1] = ld_row8(Pbat + OFF_KVC + 320, IWP, (w0 + 2 * i) * 64 + srow, SEQ, c8);
        r[2] = ld_row8(Pbat + OFF_KVC + 256, IWP, (w0 + 2 * i + 1) * 64 + srow, SEQ, c8); r[3] = ld_row8(Pbat + OFF_KVC + 320, IWP, (w0 + 2 * i + 1) * 64 + srow, SEQ, c8); },
      [&](int i, const h16x8 (&r)[4]) {
        st_k(KSB(i, 0), srow, c8, r[0]); st_k(VTB(i, 0), srow, c8, r[1]); st_k(KSB(i, 1), srow, c8, r[2]); st_k(VTB(i, 1), srow, c8, r[3]); },
      [&](int i) {
        const bool far[2] = {false, false};
        if (2 * i + 1 < nwt) attn_tile2<M_WIN, 3>(Q, O, st, KSB(i, 0), VTB(i, 0), KSB(i, 1), VTB(i, 1), biasT, tq, hd, (w0 + 2 * i) * 64, far, nosel, hpd, hpe, lane);
        else attn_tile2<M_WIN, 1>(Q, O, st, KSB(i, 0), VTB(i, 0), KSB(i, 1), VTB(i, 1), biasT, tq, hd, (w0 + 2 * i) * 64, far, nosel, hpd, hpe, lane);
      });
    {
      const float ls = sum4q(st.l);
      const float f = ls > 0.f ? (float)gp[2] / ls : 0.f;
      float ss = 0.f;
#pragma unroll
      for (int nt = 0; nt < 4; ++nt) {
        Oc[nt] += O[nt] * f;
#pragma unroll
        for (int j = 0; j < 4; ++j) ss += Oc[nt][j] * Oc[nt][j];
      }
      ss = quadsum(sum4q(ss));
      const float sc = rsqrtf(ss * (1.f / 256.f) + EPS);
#pragma unroll
      for (int nt = 0; nt < 4; ++nt)
        *(h16x4*)(OAC + ((size_t)b * SEQ + tq) * 1024 + 256 + hd * 64 + nt * 16 + q4 * 4) =
            pack4(Oc[nt][0] * sc, Oc[nt][1] * sc, Oc[nt][2] * sc, Oc[nt][3] * sc);
    }
  }
#undef KSB
#undef VTB
}

constexpr int LDS_SWA = LDS_BIAS + 4 * 64 * KP * 2 + 1024;
constexpr int lds_max(int a, int b) { return a > b ? a : b; }
constexpr int LDS_BYTES = lds_max(lds_max(LDS_NSA, SSMY_LDS), lds_max(LDS_SWA, lds_max(LDS_GEMM, lds_max(LDS_CMP, 64 * 65 * 4))));

__global__ void __launch_bounds__(NT) fwd_megakernel(Params p) {
  cg::grid_group grid = cg::this_grid();
  __shared__ __attribute__((aligned(16))) char lds[LDS_BYTES];
  __shared__ uint4 xb_words;
  if (threadIdx.x == 0) xb_words = make_uint4(0u, 0u, 0u, 0u);
  __syncthreads();
  (void)xcd_barrier_post((unsigned*)(WS(p) + O_BAR), (volatile LAS unsigned*)&xb_words);
#define GBAR() do { XcdBarrier _b; _b.bar = (unsigned*)(WS(p) + O_BAR); _b.x = xb_xcc_id(); _b.st = (volatile LAS unsigned*)&xb_words; xcd_barrier(_b); } while (0)
  phase0(p, (float*)lds);
  grid.sync();
  phase0b(p);
  GBAR();
  for (int l = 0; l < DEPTH; ++l) {
    phase_gemm1(p, l, lds);
    GBAR();
    ssm_endstates(p, l, lds);
    phase_compress(p, l, lds);
    GBAR();
    phase_nsa(p, l, lds);
    phase_swa(p, l, lds);
    ssm_outputs(p, l, lds);
    GBAR();
    phase_glu(p, l, lds);
    GBAR();
    phase_wout(p, l, lds);
    GBAR();
    phase_up(p, l, lds);
    GBAR();
    phase_down(p, l, lds);
    GBAR();
  }
}

extern "C" void kernel_launch(void* const* d_in, const int* in_sizes, int n_in, void* d_out, int out_size, void* d_ws,
                              size_t ws_size, hipStream_t stream) {
  static int grid_blocks = 0;
  if (!grid_blocks) {
    int dev = 0, cus = 0, per_cu = 0;
    (void)hipGetDevice(&dev);
    (void)hipDeviceGetAttribute(&cus, hipDeviceAttributeMultiprocessorCount, dev);
    (void)hipOccupancyMaxActiveBlocksPerMultiprocessor(&per_cu, fwd_megakernel, NT, 0);
    if (per_cu > 1) per_cu = 1;
    grid_blocks = cus * per_cu;
  }
  if (ws_size < WS_NEED) {
    fprintf(stderr, "workspace too small: %zu < %zu\n", ws_size, WS_NEED);
    return;
  }
  Params p{};
  for (int i = 0; i < 24; ++i) p.in[i] = (const float*)d_in[i];
  p.out = (float*)d_out;
  p.ws = (char*)d_ws;
  (void)hipMemsetAsync((char*)d_ws + O_BAR, 0, SZ_BAR, stream);
  void* args[] = {&p};
  hipError_t e = hipLaunchCooperativeKernel((void*)fwd_megakernel, dim3(grid_blocks), dim3(NT), args, 0, stream);
  if (e != hipSuccess) fprintf(stderr, "cooperative launch failed: %s (grid %d)\n", hipGetErrorString(e), grid_blocks);
}
```

```cpp
#include <hip/hip_runtime.h>
#include <hip/hip_cooperative_groups.h>
#include <cstdio>
namespace cg = cooperative_groups;

typedef _Float16 h16;
typedef __attribute__((ext_vector_type(8))) _Float16 h16x8;
typedef __attribute__((ext_vector_type(4))) float f32x4;

constexpr int NT = 512;
constexpr int NW = NT / 64;
constexpr int BATCH = 4, SEQ = 8192, NTOK = BATCH * SEQ, DM = 1024, DEPTH = 4, IW = 1676, IWP = 1792, DFF = 4096;
constexpr int OFF_U = 512, OFF_QC = 1024, OFF_KVC = 1280, OFF_GC = 1664;
constexpr int NCMP = 511;
constexpr float EPS = 1e-6f;

constexpr size_t SZ_WIN = (size_t)IWP * DM * 2, SZ_WGLU = (size_t)1024 * 512 * 2, SZ_WOUT = (size_t)DM * DM * 2,
                 SZ_WUP = (size_t)DFF * DM * 2, SZ_WDN = (size_t)DM * DFF * 2;
constexpr size_t O_WIN = 0;
constexpr size_t O_WGLU = O_WIN + DEPTH * SZ_WIN;
constexpr size_t O_WOUT = O_WGLU + DEPTH * SZ_WGLU;
constexpr size_t O_WUP = O_WOUT + DEPTH * SZ_WOUT;
constexpr size_t O_WDN = O_WUP + DEPTH * SZ_WUP;
constexpr size_t O_XB = O_WDN + DEPTH * SZ_WDN;
constexpr size_t O_SSQ = O_XB + (size_t)NTOK * DM * 2;
constexpr size_t O_SSQB = O_SSQ + (size_t)NTOK * 16 * 4;
constexpr size_t O_KCMP = O_SSQB + (size_t)NTOK * 16 * 4;
constexpr size_t O_VCMP = O_KCMP + (size_t)BATCH * 512 * 64 * 4;
constexpr size_t O_ABAR = O_VCMP + (size_t)BATCH * 512 * 64 * 4;
constexpr size_t O_BBAR = O_ABAR + (size_t)DEPTH * 32 * 64 * 8;
constexpr size_t O_BIAS1 = O_BBAR + (size_t)DEPTH * 32 * 64 * 16 * 8;
constexpr size_t O_LUT = O_BIAS1 + (size_t)DEPTH * 2 * 128 * 4;
constexpr size_t O_AT = O_LUT + 8192 * 4;
constexpr size_t O_KTAB = O_AT + (size_t)128 * 64 * 8;
constexpr size_t SZ_KTAB = (size_t)65 * 256 * 2;
constexpr size_t O_W1 = O_KTAB + 128 * SZ_KTAB;
constexpr size_t SZ_W13 = (size_t)128 * 1024 * 2;
constexpr size_t O_W3 = O_W1 + 128 * SZ_W13;
constexpr size_t O_W1T = O_W3 + 128 * SZ_W13;
constexpr size_t O_W2T = O_W1T + (size_t)8 * 128 * 2048 * 2;
constexpr size_t O_B1P = O_W2T + (size_t)8 * 64 * 128 * 2;
constexpr size_t O_BAR = (O_B1P + (size_t)8 * 32 * 128 * 4 + 255) / 256 * 256;
constexpr size_t SZ_BAR = 3456 * 4;
constexpr size_t O_BIG = (O_BAR + SZ_BAR + 255) / 256 * 256;
constexpr size_t O_APOW = O_BIG;
constexpr size_t O_P = O_BIG;
constexpr size_t O_Z = O_P + (size_t)NTOK * IWP * 2;
constexpr size_t O_OB = O_Z + (size_t)NTOK * 512 * 2;
constexpr size_t O_OAC = O_OB + (size_t)512 * 2;
constexpr size_t O_E = O_OB + (size_t)NTOK * 1024 * 2;
constexpr size_t O_HID = O_BIG;
constexpr size_t WS_NEED = O_BIG + (size_t)NTOK * DFF * 2;

struct Params {
  const float* in[24];
  float* out;
  char* ws;
};

__device__ __forceinline__ char* WS(const Params& p) {
  int z;
  asm volatile("s_mov_b32 %0, 0" : "=s"(z));
  return p.ws + z;
}
__device__ __forceinline__ int opaque_tid() {
  int t = threadIdx.x;
  asm volatile("" : "+v"(t));
  return t;
}
template <int CTRL>
__device__ __forceinline__ float dppf(float v) {
  return __int_as_float(__builtin_amdgcn_update_dpp(0, __float_as_int(v), CTRL, 0xF, 0xF, true));
}
__device__ __forceinline__ float sum16(float v) {
  v += dppf<0xB1>(v); v += dppf<0x4E>(v); v += dppf<0x141>(v); v += dppf<0x140>(v);
  return v;
}
__device__ __forceinline__ float max16(float v) {
  v = fmaxf(v, dppf<0xB1>(v)); v = fmaxf(v, dppf<0x4E>(v)); v = fmaxf(v, dppf<0x141>(v)); v = fmaxf(v, dppf<0x140>(v));
  return v;
}
__device__ __forceinline__ float xor16(float v) { return __int_as_float(__builtin_amdgcn_ds_swizzle(__float_as_int(v), 0x401F)); }
__device__ __forceinline__ float rdlane_c(float v, int l) { return __int_as_float(__builtin_amdgcn_readlane(__float_as_int(v), l)); }
__device__ __forceinline__ float wave_sum(float v) {
  v = sum16(v); v += xor16(v);
  return rdlane_c(v, 0) + rdlane_c(v, 32);
}
__device__ __forceinline__ float gelu_tanh(float x) {
  float u = 0.7978845608028654f * (x + 0.044715f * x * x * x);
  return 0.5f * x * (1.f + tanhf(u));
}
__device__ __forceinline__ float sigmoidf(float x) { return 1.f / (1.f + __expf(-x)); }
__device__ __forceinline__ float rdlane(float v, int l) {
  return __int_as_float(__builtin_amdgcn_readlane(__float_as_int(v), l));
}

__device__ __forceinline__ int perm32(int rho) { return 8 * ((rho & 15) >> 2) + 4 * (rho >> 4) + (rho & 3); }

template <class SrcF>
__device__ __forceinline__ void conv_tile(SrcF src, h16* dst, int ldo, int n0, int k0, float* tile) {
  int tid = opaque_tid();
  for (int idx = tid; idx < 4096; idx += NT) {
    int kk = idx >> 6, nn = idx & 63;
    tile[kk * 65 + nn] = src(k0 + kk, n0 + nn);
  }
  __syncthreads();
  for (int idx = tid; idx < 4096; idx += NT) {
    int nn = idx >> 6, kk = idx & 63;
    dst[(long)(n0 + nn) * ldo + k0 + kk] = (h16)tile[kk * 65 + nn];
  }
  __syncthreads();
}

__device__ __forceinline__ void phase0(const Params& p, float* lds) {
  const int tid = opaque_tid();
  constexpr int T_IN = (IWP / 64) * (DM / 64);
  constexpr int T_GLU = 16 * 8;
  constexpr int T_OUT = 16 * 16;
  constexpr int T_UP = 64 * 16;
  constexpr int T_DN = 16 * 64;
  constexpr int T_L = T_IN + T_GLU + T_OUT + T_UP + T_DN;
  for (int ti = blockIdx.x; ti < DEPTH * T_L; ti += gridDim.x) {
    int l = ti / T_L, r = ti % T_L;
    if (r < T_IN) {
      int nt = r / 16, kt = r % 16;
      const float* w = p.in[2] + (size_t)l * DM * IW;
      const float* g = p.in[1] + l * DM;
      conv_tile([&](int k, int sl) {
        int n = (sl & ~255) + 64 * ((sl >> 5) & 3) + 32 * ((sl >> 7) & 1) + perm32(sl & 31);
        return n < IW ? w[(long)k * IW + n] * g[k] : 0.f; },
                (h16*)(WS(p) + O_WIN + l * SZ_WIN), DM, nt * 64, kt * 64, lds);
    } else if ((r -= T_IN) < T_GLU) {
      int nt = r / 8, kt = r % 8;
      const float* w = p.in[14] + (size_t)l * 512 * 1024;
      conv_tile([&](int k, int n2) {
        int pn = n2 >> 8, bj = (n2 >> 7) & 1, wc = (n2 >> 5) & 3, nn = (n2 >> 4) & 1, r = n2 & 15;
        int n = (nn ? 512 : 0) + 128 * pn + 64 * bj + 16 * wc + r;
        return w[(long)k * 1024 + n]; },
                (h16*)(WS(p) + O_WGLU + l * SZ_WGLU), 512, nt * 64, kt * 64, lds);
    } else if ((r -= T_GLU) < T_OUT) {
      int nt = r / 16, kt = r % 16;
      const float* w = p.in[20] + (size_t)l * DM * DM;
      const float* g = p.in[19] + l * DM;
      conv_tile([&](int k2, int n2) {
        int k = k2 < 512 ? 256 + k2 : (k2 < 768 ? k2 - 512 : k2);
        int n = (n2 & ~31) + perm32(n2 & 31);
        return w[(long)k * DM + n] * g[k]; },
                (h16*)(WS(p) + O_WOUT + l * SZ_WOUT), DM, nt * 64, kt * 64, lds);
    } else if ((r -= T_OUT) < T_UP) {
      int nt = r / 16, kt = r % 16;
      const float* w = p.in[22] + (size_t)l * DM * DFF;
      const float* g = p.in[21] + l * DM;
      conv_tile([&](int k, int n2) { int n = (n2 & ~31) + perm32(n2 & 31); return w[(long)k * DFF + n] * g[k]; },
                (h16*)(WS(p) + O_WUP + l * SZ_WUP), DM, nt * 64, kt * 64, lds);
    } else {
      r -= T_UP;
      int nt = r / 64, kt = r % 64;
      const float* w = p.in[23] + (size_t)l * DFF * DM;
      conv_tile([&](int k, int n2) { int n = (n2 & ~31) + perm32(n2 & 31); return w[(long)k * DM + n]; },
                (h16*)(WS(p) + O_WDN + l * SZ_WDN), DFF, nt * 64, kt * 64, lds);
    }
  }
  for (int ti = blockIdx.x; ti < 8 * 66; ti += gridDim.x) {
    int ls = ti / 66, r = ti % 66;
    if (r < 64) {
      int nt = r >> 5, kt = r & 31;
      const float* w = p.in[17] + (size_t)ls * 2048 * 128;
      conv_tile([&](int k, int n) { return w[(long)k * 128 + n]; }, (h16*)(WS(p) + O_W1T) + (size_t)ls * 128 * 2048, 2048, nt * 64, kt * 64, lds);
    } else {
      int kt = r - 64;
      const float* w = p.in[18] + (size_t)ls * 128 * 64;
      conv_tile([&](int k, int n) { return w[(long)k * 64 + n]; }, (h16*)(WS(p) + O_W2T) + (size_t)ls * 64 * 128, 128, 0, kt * 64, lds);
    }
  }
  {
    const int lane = tid & 63;
    const int gw = blockIdx.x * NW + (tid >> 6), nw = gridDim.x * NW;
    const float* x = p.in[0];
    h16* xb = (h16*)(WS(p) + O_XB);
    float* ssq = (float*)(WS(p) + O_SSQ);
    for (int row = gw; row < NTOK; row += nw) {
      const float4* xr = (const float4*)(x + (long)row * DM + lane * 16);
      float s = 0.f;
      h16 hv[16];
      for (int i = 0; i < 4; ++i) {
        float4 v = xr[i];
        s += v.x * v.x + v.y * v.y + v.z * v.z + v.w * v.w;
        hv[i * 4 + 0] = (h16)v.x; hv[i * 4 + 1] = (h16)v.y; hv[i * 4 + 2] = (h16)v.z; hv[i * 4 + 3] = (h16)v.w;
      }
      h16x8* xo = (h16x8*)(xb + (long)row * DM + lane * 16);
      h16x8 o0, o1;
      for (int i = 0; i < 8; ++i) { o0[i] = hv[i]; o1[i] = hv[8 + i]; }
      xo[0] = o0; xo[1] = o1;
      s += dppf<0xB1>(s);
      s += dppf<0x4E>(s);
      if ((lane & 3) == 0) ssq[(long)row * 16 + (lane >> 2)] = s;
    }
  }
  const int gt = blockIdx.x * NT + tid, ngt = gridDim.x * NT;
  for (int i = gt; i < DEPTH * 32 * 64; i += ngt) {
    int l = i / 2048, g = (i / 64) % 32;
    double are = p.in[6][i], aim = p.in[7][i];
    double dt = exp((double)p.in[8][l * 32 + g]);
    double er = exp(are * dt), abr = er * cos(aim * dt), abi = er * sin(aim * dt);
    ((float2*)(WS(p) + O_ABAR))[i] = make_float2((float)abr, (float)abi);
    double nr = abr - 1.0, ni = abi, den = are * are + aim * aim;
    double fr = (nr * are + ni * aim) / den, fi = (ni * are - nr * aim) / den;
    float2* bb = (float2*)(WS(p) + O_BBAR) + (size_t)i * 16;
    for (int q = 0; q < 16; ++q) {
      double br = p.in[9][(size_t)i * 16 + q], bi = p.in[10][(size_t)i * 16 + q];
      bb[q] = make_float2((float)((fr * br - fi * bi) / dt), (float)((fr * bi + fi * br) / dt));
    }
  }
  for (int i = gt; i < 128 * 65 * 64; i += ngt) {
    int n = i & 63, j = (i >> 6) % 65, lg = i / (65 * 64);
    double are = p.in[6][lg * 64 + n], aim = p.in[7][lg * 64 + n];
    double dt = exp((double)p.in[8][lg]);
    double er = exp(are * dt * j), ang = aim * dt * j;
    ((double2*)(WS(p) + O_APOW))[i] = make_double2(er * cos(ang), er * sin(ang));
  }
  for (int i = gt; i < DEPTH * 2 * 128 * 32; i += ngt) {
    int j = i & 127, kc = (i >> 7) & 31, ls = i >> 12;
    const float* pos = p.in[16] + (size_t)ls * 2048 + kc * 64;
    const float* w1 = p.in[17] + ((size_t)ls * 2048 + kc * 64) * 128;
    float a = 0.f;
#pragma unroll 16
    for (int k = 0; k < 64; ++k) a += pos[k] * w1[(long)k * 128 + j];
    ((float*)(WS(p) + O_B1P))[i] = a;
  }
  for (int d = gt; d < 8192; d += ngt) {
    int bk;
    if (d < 16) bk = d;
    else {
      float nf = (float)d;
      int large = 16 + (int)(logf(nf / 16.0f) / 4.1588830833596715f * 16.0f);
      bk = large < 31 ? large : 31;
    }
    ((int*)(WS(p) + O_LUT))[d] = bk;
  }
}

__device__ __forceinline__ void phase0b(const Params& p) {
  const int gt = blockIdx.x * NT + threadIdx.x, ngt = gridDim.x * NT;
  const double2* apow = (const double2*)(WS(p) + O_APOW);
  const float2* bbs = (const float2*)(WS(p) + O_BBAR);
  for (int i = gt; i < 128 * 64 * 64; i += ngt) {
    int tau = i & 63, n = (i >> 6) & 63, lg = i >> 12;
    double2 ap = apow[(lg * 65 + (63 - tau)) * 64 + n];
    const float2* bb = bbs + (size_t)(lg * 64 + n) * 16;
    h16x8 re0, re1, im0, im1;
#pragma unroll
    for (int q = 0; q < 8; ++q) {
      float2 b0 = bb[q], b1 = bb[8 + q];
      re0[q] = (h16)(float)(ap.x * b0.x - ap.y * b0.y);
      im0[q] = (h16)(float)(ap.x * b0.y + ap.y * b0.x);
      re1[q] = (h16)(float)(ap.x * b1.x - ap.y * b1.y);
      im1[q] = (h16)(float)(ap.x * b1.y + ap.y * b1.x);
    }
    h16* W1 = (h16*)(WS(p) + O_W1 + (size_t)lg * SZ_W13);
    *(h16x8*)(W1 + ((size_t)(2 * tau) * 128 + 2 * n) * 8) = re0;
    *(h16x8*)(W1 + ((size_t)(2 * tau) * 128 + 2 * n + 1) * 8) = im0;
    *(h16x8*)(W1 + ((size_t)(2 * tau + 1) * 128 + 2 * n) * 8) = re1;
    *(h16x8*)(W1 + ((size_t)(2 * tau + 1) * 128 + 2 * n + 1) * 8) = im1;
  }
  for (int i = gt; i < 128 * 64 * 16 * 16; i += ngt) {
    int pp = i & 15, kc = (i >> 4) & 15, tau = (i >> 8) & 63, lg = i >> 14;
    h16x8 v;
#pragma unroll
    for (int e = 0; e < 4; ++e) {
      int n = 4 * kc + e;
      double2 ap = apow[(lg * 65 + tau + 1) * 64 + n];
      double cr = p.in[11][((size_t)lg * 16 + pp) * 64 + n], ci = p.in[12][((size_t)lg * 16 + pp) * 64 + n];
      v[2 * e] = (h16)(float)(cr * ap.x - ci * ap.y);
      v[2 * e + 1] = (h16)(float)(-(cr * ap.y + ci * ap.x));
    }
    h16* W3 = (h16*)(WS(p) + O_W3 + (size_t)lg * SZ_W13);
    *(h16x8*)(W3 + ((size_t)((tau * 16 + kc) * 16) + pp) * 8) = v;
  }
  for (int i = gt; i < 128 * 65 * 16; i += ngt) {
    int pp = i & 15, slot = (i >> 4) % 65, lg = i / (65 * 16);
    float acc[16];
#pragma unroll
    for (int q = 0; q < 16; ++q) acc[q] = 0.f;
    if (slot > 0) {
      for (int n = 0; n < 64; ++n) {
        double2 ap = apow[(lg * 65 + slot - 1) * 64 + n];
        double cr = p.in[11][((size_t)lg * 16 + pp) * 64 + n], ci = p.in[12][((size_t)lg * 16 + pp) * 64 + n];
        float xr = (float)(cr * ap.x - ci * ap.y), xi = (float)(cr * ap.y + ci * ap.x);
        const float2* bb = bbs + (size_t)(lg * 64 + n) * 16;
#pragma unroll
        for (int q = 0; q < 16; ++q) { float2 b = bb[q]; acc[q] += xr * b.x - xi * b.y; }
      }
    }
    h16x8 v0, v1;
#pragma unroll
    for (int q = 0; q < 8; ++q) { v0[q] = (h16)acc[q]; v1[q] = (h16)acc[8 + q]; }
    h16* kt = (h16*)(WS(p) + O_KTAB + (size_t)lg * SZ_KTAB) + slot * 256 + pp * 16;
    *(h16x8*)kt = v0;
    *(h16x8*)(kt + 8) = v1;
  }
  for (int i = gt; i < 128 * 64; i += ngt) {
    double2 ap = apow[((i >> 6) * 65 + 64) * 64 + (i & 63)];
    ((float2*)(WS(p) + O_AT))[i] = make_float2((float)ap.x, (float)ap.y);
  }
  for (int i = gt; i < DEPTH * 2 * 128; i += ngt) {
    const float* pp = (const float*)(WS(p) + O_B1P) + (size_t)(i >> 7) * 32 * 128 + (i & 127);
    float a = 0.f;
    for (int kc = 0; kc < 32; ++kc) a += pp[kc * 128];
    ((float*)(WS(p) + O_BIAS1))[i] = a;
  }
}

__device__ __forceinline__ void ssm_endstates(const Params& p, int l, char* lds) {
  const int tid = opaque_tid(), lane = tid & 63, w = tid >> 6;
  const h16* P = (const h16*)(WS(p) + O_P);
  float* E = (float*)(WS(p) + O_E);
  f32x4* red = (f32x4*)lds;
  for (int ub4 = blockIdx.x; ub4 < 256; ub4 += gridDim.x) {
    const int unit = ub4 * 4 + (w & 3), kh = w >> 2;
    const int g = unit >> 5, ctile = unit & 31;
    const h16* W1 = (const h16*)(WS(p) + O_W1 + (size_t)(l * 32 + g) * SZ_W13);
    const int gch = ctile * 16 + (lane & 15);
    const h16* ub = P + (size_t)gch * 64 * IWP + OFF_U + g * 16 + ((lane >> 4) & 1) * 8 + (size_t)(lane >> 5) * IWP;
    f32x4 acc[8];
#pragma unroll
    for (int mt = 0; mt < 8; ++mt) acc[mt] = f32x4{0.f, 0.f, 0.f, 0.f};
#pragma unroll 4
    for (int kk = 0; kk < 16; ++kk) {
      const int ks = kh * 16 + kk;
      h16x8 B = *(const h16x8*)(ub + (size_t)(ks * 2) * IWP);
#pragma unroll
      for (int mt = 0; mt < 8; ++mt) {
        h16x8 A = *(const h16x8*)(W1 + ((size_t)(ks * 4 + (lane >> 4)) * 128 + mt * 16 + (lane & 15)) * 8);
        acc[mt] = __builtin_amdgcn_mfma_f32_16x16x32_f16(A, B, acc[mt], 0, 0, 0);
      }
    }
    __syncthreads();
    if (kh == 1) {
#pragma unroll
      for (int mt = 0; mt < 8; ++mt) red[((w & 3) * 8 + mt) * 64 + lane] = acc[mt];
    }
    __syncthreads();
    if (kh == 0) {
#pragma unroll
      for (int mt = 0; mt < 8; ++mt)
        *(f32x4*)(E + ((size_t)gch * 32 + g) * 128 + mt * 16 + (lane >> 4) * 4) = acc[mt] + red[((w & 3) * 8 + mt) * 64 + lane];
    }
  }
}

constexpr int BU_PITCH = 1032, BS_PITCH = 136;
constexpr int SSMY_LDS = 65 * 512 + 16 * BU_PITCH * 2 + 16 * BS_PITCH * 2 + 128 * 64 * 8;
__device__ __forceinline__ void ssm_outputs(const Params& p, int l, char* lds) {
  const int tid = opaque_tid(), lane = tid & 63, w = tid >> 6;
  h16* Kt = (h16*)lds;
  h16* Bu = (h16*)(lds + 65 * 512);
  h16* Bs = (h16*)(lds + 65 * 512 + 16 * BU_PITCH * 2);
  float2* Es = (float2*)(lds + 65 * 512 + 16 * BU_PITCH * 2 + 16 * BS_PITCH * 2);
  const h16* P = (const h16*)(WS(p) + O_P);
  const float* E = (const float*)(WS(p) + O_E);
  h16* Z = (h16*)(WS(p) + O_Z);
  for (int unit = blockIdx.x; unit < 1024; unit += gridDim.x) {
    const int g = unit & 31, bc = unit >> 5, b = bc >> 3, ct = bc & 7;
    const int lg = l * 32 + g;
    __syncthreads();
    const int c0 = ct * 16;
    {
      const h16x8* ks = (const h16x8*)(WS(p) + O_KTAB + (size_t)lg * SZ_KTAB);
      for (int i = tid; i < 65 * 32; i += NT) ((h16x8*)Kt)[i] = ks[i];
      for (int i = tid; i < 2048; i += NT) {
        int tk = i >> 1, hf = i & 1;
        h16x8 v = *(const h16x8*)(P + ((size_t)b * SEQ + ct * 1024 + tk) * IWP + OFF_U + g * 16 + hf * 8);
        *(h16x8*)(Bu + (tk >> 6) * BU_PITCH + (tk & 63) * 16 + hf * 8) = v;
      }
      const float2* Eb = (const float2*)E + ((size_t)(b * 128) * 32 + g) * 64;
      for (int i = tid; i < (c0 + 16) * 64; i += NT) Es[i] = Eb[(size_t)(i >> 6) * 2048 + (i & 63)];
    }
    __syncthreads();
    if (w == 0) {
      float2 at = ((const float2*)(WS(p) + O_AT))[lg * 64 + lane];
      float sr = 0.f, si = 0.f;
#pragma unroll 8
      for (int c = 0; c < c0; ++c) {
        float2 e = Es[c * 64 + lane];
        float nr = at.x * sr - at.y * si + e.x, ni = at.x * si + at.y * sr + e.y;
        sr = nr; si = ni;
      }
#pragma unroll
      for (int i = 0; i < 16; ++i) {
        Bs[i * BS_PITCH + 2 * lane] = (h16)sr;
        Bs[i * BS_PITCH + 2 * lane + 1] = (h16)si;
        float2 e = Es[(c0 + i) * 64 + lane];
        float nr = at.x * sr - at.y * si + e.x, ni = at.x * si + at.y * sr + e.y;
        sr = nr; si = ni;
      }
    }
    __syncthreads();
    const float dt = expf(p.in[8][lg]);
    const int col = lane & 15, hi = lane >> 5, qh = (lane >> 4) & 1, p0 = (lane >> 4) * 4;
    const h16* W3 = (const h16*)(WS(p) + O_W3 + (size_t)lg * SZ_W13);
    float dsk[4];
    for (int j = 0; j < 4; ++j) dsk[j] = p.in[13][l * 512 + g * 16 + p0 + j];
    for (int r = 0; r < 64 / NW; ++r) {
      const int base = (r >> 1) * 2 * NW;
      const int tau = (r & 1) ? base + 2 * NW - 1 - w : base + w;
      f32x4 acc = {0.f, 0.f, 0.f, 0.f};
      const int nks = tau / 2 + 1;
      h16x8 A3[4];
#pragma unroll
      for (int ks = 0; ks < 4; ++ks)
        A3[ks] = *(const h16x8*)(W3 + ((size_t)((tau * 16 + ks * 4 + (lane >> 4)) * 16) + (lane & 15)) * 8);
      for (int i = 0; i < nks; ++i) {
        int j = tau - (2 * i + hi);
        h16x8 A = *(const h16x8*)(Kt + (j + 1) * 256 + (lane & 15) * 16 + qh * 8);
        h16x8 B = *(const h16x8*)(Bu + col * BU_PITCH + (2 * i + hi) * 16 + qh * 8);
        acc = __builtin_amdgcn_mfma_f32_16x16x32_f16(A, B, acc, 0, 0, 0);
      }
#pragma unroll
      for (int ks = 0; ks < 4; ++ks) {
        h16x8 B = *(const h16x8*)(Bs + col * BS_PITCH + ks * 32 + (lane >> 4) * 8);
        acc = __builtin_amdgcn_mfma_f32_16x16x32_f16(A3[ks], B, acc, 0, 0, 0);
      }
      const h16* up = Bu + col * BU_PITCH + tau * 16 + p0;
      size_t tok = ((size_t)b * 128 + ct * 16 + col) * 64 + tau;
      h16 zz[4];
      for (int j = 0; j < 4; ++j) zz[j] = (h16)gelu_tanh(dt * acc[j] + dsk[j] * (float)up[j]);
      typedef __attribute__((ext_vector_type(4))) _Float16 h16x4;
      h16x4 zv = {zz[0], zz[1], zz[2], zz[3]};
      *(h16x4*)(Z + tok * 512 + g * 16 + p0) = zv;
    }
  }
}

#define LAS __attribute__((address_space(3)))
typedef _Float16 h16x4 __attribute__((ext_vector_type(4)));
#define XB_TMO      128
#define XB_XCNT(j)  (256  + 64 * (j))
#define XB_XSUB(j)  (1280 + 64 * (j))
#define XB_XGEN(j)  (2304 + 64 * (j))
#define XB_TOP      3328
#define XB_TOPGEN   3392
#define XCD_BAR_WORDS 3456
#define XB_SPIN_CAP (1u << 18)

__device__ __forceinline__ unsigned xb_ld(unsigned* p)              { return __hip_atomic_load(p, __ATOMIC_RELAXED, __HIP_MEMORY_SCOPE_AGENT); }
__device__ __forceinline__ unsigned xb_add(unsigned* p, unsigned v) { return __hip_atomic_fetch_add(p, v, __ATOMIC_RELAXED, __HIP_MEMORY_SCOPE_AGENT); }
__device__ __forceinline__ unsigned xb_xcc_id() { return (unsigned)__builtin_amdgcn_s_getreg((3 << 11) | 20) & 0xFu; }
#define XB_SPIN(cond, bar) do { unsigned _sp = 0; while (cond) { __builtin_amdgcn_s_sleep(1); \
    if ((++_sp & 255u) == 0u) { if (xb_ld(&(bar)[XB_TMO])) break; if (_sp > XB_SPIN_CAP) { atomicAdd(&(bar)[XB_TMO], 1u); break; } } } } while (0)

struct XcdBarrier {
    unsigned* bar; unsigned x;
    volatile LAS unsigned* st;
};

__device__ __forceinline__ XcdBarrier xcd_barrier_post(unsigned* bar, volatile LAS unsigned* st) {
    XcdBarrier b; b.bar = bar; b.x = xb_xcc_id(); b.st = st;
    if (threadIdx.x == 0) (void)xb_add(&bar[XB_XCNT(b.x)], 1u);
    return b;
}
__device__ __forceinline__ void xcd_barrier_complete(unsigned* bar, unsigned x, unsigned& nloc, unsigned& nx) {
    const unsigned G = gridDim.x * gridDim.y * gridDim.z;
    unsigned sum, cnt, mine, sp = 0u;
    for (;;) {
        sum = 0u; cnt = 0u; mine = 0u;
#pragma unroll
        for (unsigned j = 0; j < 16; ++j) { const unsigned c = xb_ld(&bar[XB_XCNT(j)]); sum += c; cnt += (c > 0u) ? 1u : 0u; mine = (j == x) ? c : mine; }
        if (sum == G) break;
        __builtin_amdgcn_s_sleep(1);
        if ((++sp & 255u) == 0u) { if (xb_ld(&bar[XB_TMO])) break; if (sp > XB_SPIN_CAP) { atomicAdd(&bar[XB_TMO], 1u); break; } }
    }
    nloc = mine > 0u ? mine : 1u; nx = cnt > 0u ? cnt : 1u;
}

__device__ __forceinline__ void xcd_barrier(const XcdBarrier& b) {
    asm volatile("s_waitcnt vmcnt(0)" ::: "memory");
    __syncthreads();
    if (threadIdx.x == 0) {
        unsigned* bar = b.bar;
        __builtin_amdgcn_s_waitcnt(0);
        unsigned nloc = b.st[0], nx = b.st[1];
        if (nloc == 0u) { xcd_barrier_complete(bar, b.x, nloc, nx); b.st[0] = nloc; b.st[1] = nx; }
        const unsigned old = xb_add(&bar[XB_XSUB(b.x)], 1u);
        const unsigned gen = old / nloc;
        if (old + 1u == (gen + 1u) * nloc) {
            __builtin_amdgcn_fence(__ATOMIC_RELEASE, "agent");
            asm volatile("s_waitcnt vmcnt(0)" ::: "memory");
            const unsigned og = xb_add(&bar[XB_TOP], 1u);
            const unsigned tg = og / nx;
            if (og + 1u == (tg + 1u) * nx) xb_add(&bar[XB_TOPGEN], 1u);
            else XB_SPIN(xb_ld(&bar[XB_TOPGEN]) == tg, bar);
            __builtin_amdgcn_fence(__ATOMIC_ACQUIRE, "agent");
            xb_add(&bar[XB_XGEN(b.x)], 1u);
            asm volatile("s_waitcnt vmcnt(0)" ::: "memory");
        } else {
            XB_SPIN(xb_ld(&bar[XB_XGEN(b.x)]) == gen, bar);
            __builtin_amdgcn_fence(__ATOMIC_ACQUIRE, "agent");
            asm volatile("s_waitcnt vmcnt(0)" ::: "memory");
        }
    }
    __syncthreads();
}


namespace g8 {
constexpr int BM = 256, BK = 64, HALF = 128, HTB = HALF * BK * 2, STAGE_BYTES = 8 * HTB, NXCD = 8, WGM = 8;
__device__ __forceinline__ int lds_byte(int r, int c) {
  const int st = (r >> 4) * 2 + (c >> 5), rr = r & 15, cc = c & 31, ob = rr * 64 + cc * 2;
  return st * 1024 + (ob ^ (((ob >> 9) & 1) << 5));
}
__device__ __forceinline__ void stage_rc(int b, int& R, int& C) {
  const int st = b / 1024, sb = b % 1024, swz = sb ^ (((sb >> 9) & 1) << 5);
  R = (st >> 1) * 16 + swz / 64;
  C = (st & 1) * 32 + (swz % 64) / 2;
}
struct Unit { int pm, pn; };
struct Order {
  int nM, nN, nwg, G, c;
  __device__ void init(int M, int N, int G_, int c_) { nM = M / BM; nN = N / BM; nwg = nM * nN; G = G_; c = c_; }
  __device__ bool next(int i, Unit& u) const {
    const long L = (long)i * G + c;
    if (L >= nwg) return false;
    int wgid = (int)L;
    { const int q = nwg / NXCD, r = nwg % NXCD, xcd = wgid % NXCD, off = wgid / NXCD; wgid = (xcd < r ? xcd * (q + 1) : r * (q + 1) + (xcd - r) * q) + off; }
    const int nig = WGM * nN, gid = wgid / nig, fm = gid * WGM, gsz = (nM - fm) < WGM ? (nM - fm) : WGM;
    u.pm = fm + ((wgid % nig) % gsz);
    u.pn = (wgid % nig) / gsz;
    return true;
  }
};
template <class Epi>
__device__ __forceinline__ void gemm_phase(LAS unsigned char* lds, const h16* A, const h16* Bt, int K, const Order& S, const Epi& E) {
  const int tid = opaque_tid(), wid = __builtin_amdgcn_readfirstlane(tid >> 6), lane = tid & 63, wr = wid >> 2, wc = wid & 3, fr = lane & 15, fq = lane >> 4;
  const int nt = K / BK;
  unsigned voffA[2];
#pragma unroll
  for (int i = 0; i < 2; ++i) { int R, C; stage_rc(tid * 16 + i * 8192, R, C); voffA[i] = (unsigned)(R * K + C) * 2u; }
  const size_t kstep = (size_t)(BK * 2);
  const size_t hstep = (size_t)HALF * K * 2;
  const size_t tstep = 2 * hstep;
  const unsigned ldsw = (unsigned)wid * 1024u;
  const int aoff = lds_byte(wr * 64 + fr, fq * 8), boff = lds_byte(wc * 32 + fr, fq * 8);
#define G8_SA(b, h) (((b) * 2 + (h)) * HTB)
#define G8_SB(b, h) ((4 + (b) * 2 + (h)) * HTB)
#define G8_STAGE(bufoff, gbase) do { _Pragma("unroll") for (int _i = 0; _i < 2; ++_i) \
    __builtin_amdgcn_global_load_lds((const unsigned*)((const char*)(gbase) + voffA[_i]), (LAS unsigned*)(lds + (bufoff) + ldsw + _i * 8192), 16, 0, 0); } while (0)
#define G8_LDA(dst, b, h) do { _Pragma("unroll") for (int m = 0; m < 4; ++m) _Pragma("unroll") for (int k = 0; k < 2; ++k) dst[m][k] = *(const LAS h16x8*)(lds + G8_SA(b, h) + aoff + m * 2048 + k * 1024); } while (0)
#define G8_LDB(dst, b, h) do { _Pragma("unroll") for (int n = 0; n < 2; ++n) _Pragma("unroll") for (int k = 0; k < 2; ++k) dst[n][k] = *(const LAS h16x8*)(lds + G8_SB(b, h) + boff + n * 2048 + k * 1024); } while (0)
#define G8_MMA(ai, bj, At, Bt_) do { __builtin_amdgcn_s_setprio(1); _Pragma("unroll") for (int m = 0; m < 4; ++m) _Pragma("unroll") for (int n = 0; n < 2; ++n) _Pragma("unroll") for (int k = 0; k < 2; ++k) \
    acc[ai][bj][m][n] = __builtin_amdgcn_mfma_f32_16x16x32_f16(Bt_[n][k], At[m][k], acc[ai][bj][m][n], 0, 0, 0); __builtin_amdgcn_s_setprio(0); } while (0)
#define G8_WAIT_V(n) asm volatile("s_waitcnt vmcnt(" #n ")" ::: "memory")
#define G8_WAIT_L(n) asm volatile("s_waitcnt lgkmcnt(" #n ")" ::: "memory")
#define G8_BAR __builtin_amdgcn_s_barrier()
#define G8_SCHED __builtin_amdgcn_sched_barrier(0)
  Unit cur, nxt;
  int ui = 0;
  if (!S.next(0, cur)) return;
  f32x4 acc[2][2][4][2];
#pragma unroll
  for (int a = 0; a < 2; ++a)
#pragma unroll
    for (int b = 0; b < 2; ++b)
#pragma unroll
      for (int m = 0; m < 4; ++m)
#pragma unroll
        for (int n = 0; n < 2; ++n) acc[a][b][m][n] = (f32x4){0.f, 0.f, 0.f, 0.f};
  h16x8 At[4][2], B0[2][2], B1[2][2];
  const char* cA = (const char*)A + (size_t)cur.pm * tstep;
  const char* cB = (const char*)Bt + (size_t)cur.pn * tstep;
  G8_STAGE(G8_SB(0, 0), cB); G8_STAGE(G8_SA(0, 0), cA); G8_STAGE(G8_SB(0, 1), cB + hstep); G8_STAGE(G8_SA(0, 1), cA + hstep);
  if (wr == 1) G8_BAR;
  G8_WAIT_V(4); G8_BAR;
  G8_STAGE(G8_SB(1, 0), cB + kstep); G8_STAGE(G8_SA(1, 0), cA + kstep); G8_STAGE(G8_SB(1, 1), cB + hstep + kstep);
  G8_WAIT_V(6); G8_BAR;
  for (;;) {
    const bool has_next = S.next(ui + 1, nxt);
    const char* nA = has_next ? (const char*)A + (size_t)nxt.pm * tstep : cA;
    const char* nB = has_next ? (const char*)Bt + (size_t)nxt.pn * tstep : cB;
    for (int t = 0; t < nt; t += 2) {
      const bool last = (t == nt - 2);
      const char* a1 = cA + (size_t)(t + 1) * kstep;
      const char* a2 = last ? nA : cA + (size_t)(t + 2) * kstep;
      const char* b2 = last ? nB : cB + (size_t)(t + 2) * kstep;
      const char* a3 = a2 + kstep;
      const char* b3 = b2 + kstep;
      if (Epi::MID_T >= 0 && t == Epi::MID_T) E.mid(acc, ui, wr, fr);
      G8_LDB(B0, 0, 0); G8_SCHED; G8_LDA(At, 0, 0); G8_STAGE(G8_SA(1, 1), a1 + hstep);
      G8_WAIT_L(8); G8_BAR; G8_WAIT_L(0); G8_MMA(0, 0, At, B0); G8_BAR; G8_SCHED;
      G8_LDB(B1, 0, 1); G8_STAGE(G8_SB(0, 0), b2);
      G8_BAR; G8_WAIT_L(0); G8_MMA(0, 1, At, B1); G8_BAR;
      G8_LDA(At, 0, 1); G8_STAGE(G8_SA(0, 0), a2);
      G8_BAR; G8_WAIT_L(0); G8_MMA(1, 0, At, B0); G8_BAR; G8_SCHED;
      G8_STAGE(G8_SB(0, 1), b2 + hstep);
      G8_WAIT_V(6); G8_BAR; G8_MMA(1, 1, At, B1); G8_BAR;
      G8_LDB(B0, 1, 0); G8_SCHED; G8_LDA(At, 1, 0); G8_STAGE(G8_SA(0, 1), a2 + hstep);
      G8_WAIT_L(8); G8_BAR; G8_WAIT_L(0); G8_MMA(0, 0, At, B0); G8_BAR; G8_SCHED;
      G8_LDB(B1, 1, 1); G8_STAGE(G8_SB(1, 0), b3);
      G8_BAR; G8_WAIT_L(0); G8_MMA(0, 1, At, B1); G8_BAR;
      G8_LDA(At, 1, 1); G8_STAGE(G8_SA(1, 0), a3);
      G8_BAR; G8_WAIT_L(0); G8_MMA(1, 0, At, B0); G8_BAR; G8_SCHED;
      G8_STAGE(G8_SB(1, 1), b3 + hstep);
      G8_WAIT_V(6); G8_BAR; G8_MMA(1, 1, At, B1); G8_BAR;
    }
    E(acc, cur, ui, wr, wc, fr, fq);
    if (!has_next) break;
#pragma unroll
    for (int a = 0; a < 2; ++a)
#pragma unroll
      for (int b = 0; b < 2; ++b)
#pragma unroll
        for (int m = 0; m < 4; ++m)
#pragma unroll
          for (int n = 0; n < 2; ++n) acc[a][b][m][n] = (f32x4){0.f, 0.f, 0.f, 0.f};
    cur = nxt; cA = nA; cB = nB; ++ui;
  }
  G8_WAIT_V(0);
  if (wr == 0) G8_BAR;
  G8_BAR;
#undef G8_SA
#undef G8_SB
#undef G8_STAGE
#undef G8_LDA
#undef G8_LDB
#undef G8_MMA
#undef G8_WAIT_V
#undef G8_WAIT_L
#undef G8_BAR
#undef G8_SCHED
}
}

constexpr int RSL_OFF = g8::STAGE_BYTES;
constexpr int LDS_GEMM = g8::STAGE_BYTES + 8 * 256 * 4;

__device__ __forceinline__ void fill_rowscales(float* rsl, const float* ssq, float inv_n, const g8::Order& S) {
  const int tid = opaque_tid();
  g8::Unit u;
  __syncthreads();
  for (int i = 0; S.next(i, u); ++i) {
    if (tid < 256) {
      const float4* s4 = (const float4*)(ssq + (size_t)(u.pm * 256 + tid) * 16);
      float s = 0.f;
      for (int k = 0; k < 4; ++k) { float4 v = s4[k]; s += v.x + v.y + v.z + v.w; }
      rsl[i * 256 + tid] = rsqrtf(s * inv_n + EPS);
    }
  }
  __syncthreads();
}

__device__ __forceinline__ h16x4 pack4(float a, float b, float c, float d) { h16x4 v = {(h16)a, (h16)b, (h16)c, (h16)d}; return v; }
__device__ __forceinline__ h16x8 pack8(f32x4 a, f32x4 b) {
  h16x8 v = {(h16)a[0], (h16)a[1], (h16)a[2], (h16)a[3], (h16)b[0], (h16)b[1], (h16)b[2], (h16)b[3]};
  return v;
}

struct EpiIn {
  static constexpr int MID_T = -1;
  __device__ __forceinline__ void mid(f32x4 (&)[2][2][4][2], int, int, int) const {}
  h16* P; const float* rsl; const float* qkg;
  __device__ __forceinline__ void operator()(const f32x4 (&acc)[2][2][4][2], const g8::Unit& u, int ui, int wr, int wc, int fr, int fq) const {
    const int hs = u.pn * 4 + wc;
    int gi = -1;
    if (hs < 4) gi = 0; else if (hs < 6) gi = 1; else if (hs >= 16 && hs < 20) gi = 2; else if (hs == 22) gi = 4; else if (hs == 24) gi = 5;
    const bool gate = (hs == 26);
#pragma unroll
    for (int ai = 0; ai < 2; ++ai)
#pragma unroll
      for (int m = 0; m < 4; ++m) {
        const int rl = 128 * ai + 64 * wr + 16 * m + fr;
        float r = rsl[ui * 256 + rl];
        if (gi >= 0) {
          float ss = 0.f;
#pragma unroll
          for (int bj = 0; bj < 2; ++bj)
#pragma unroll
            for (int n = 0; n < 2; ++n)
#pragma unroll
              for (int j = 0; j < 4; ++j) ss += acc[ai][bj][m][n][j] * acc[ai][bj][m][n][j];
          ss += xor16(ss);
          ss += __shfl_xor(ss, 32);
          r *= rsqrtf(ss * r * r * (1.f / 64.f) + EPS);
        }
        h16* rowp = P + (size_t)(u.pm * 256 + rl) * IWP + 64 * hs + 8 * fq;
#pragma unroll
        for (int bj = 0; bj < 2; ++bj) {
          f32x4 v[2];
#pragma unroll
          for (int n = 0; n < 2; ++n) {
            v[n] = acc[ai][bj][m][n] * r;
            if (gi >= 0) {
              const float4 g4 = *(const float4*)(qkg + gi * 64 + 32 * bj + 8 * fq + 4 * n);
              v[n][0] *= g4.x; v[n][1] *= g4.y; v[n][2] *= g4.z; v[n][3] *= g4.w;
            } else if (gate) {
#pragma unroll
              for (int j = 0; j < 4; ++j) v[n][j] = (32 * bj + 8 * fq + 4 * n + j) < 12 ? sigmoidf(v[n][j]) : 0.f;
            }
          }
          *(h16x8*)(rowp + 32 * bj) = pack8(v[0], v[1]);
        }
      }
  }
};

struct EpiGlu {
  static constexpr int MID_T = -1;
  __device__ __forceinline__ void mid(f32x4 (&)[2][2][4][2], int, int, int) const {}
  h16* OB; float* ssqb; const float* gb;
  __device__ __forceinline__ void operator()(const f32x4 (&acc)[2][2][4][2], const g8::Unit& u, int ui, int wr, int wc, int fr, int fq) const {
    const int ocb = 128 * u.pn + 16 * wc + 4 * fq;
    float4 ba[2], bb[2];
#pragma unroll
    for (int bj = 0; bj < 2; ++bj) { ba[bj] = *(const float4*)(gb + ocb + 64 * bj); bb[bj] = *(const float4*)(gb + 512 + ocb + 64 * bj); }
#pragma unroll
    for (int ai = 0; ai < 2; ++ai)
#pragma unroll
      for (int m = 0; m < 4; ++m) {
        const size_t row = (size_t)u.pm * 256 + 128 * ai + 64 * wr + 16 * m + fr;
        float ss = 0.f;
#pragma unroll
        for (int bj = 0; bj < 2; ++bj) {
          const f32x4 a = acc[ai][bj][m][0], b = acc[ai][bj][m][1];
          float o0 = (a[0] + ba[bj].x) * sigmoidf(b[0] + bb[bj].x);
          float o1 = (a[1] + ba[bj].y) * sigmoidf(b[1] + bb[bj].y);
          float o2 = (a[2] + ba[bj].z) * sigmoidf(b[2] + bb[bj].z);
          float o3 = (a[3] + ba[bj].w) * sigmoidf(b[3] + bb[bj].w);
          *(h16x4*)(OB + row * 1024 + ocb + 64 * bj) = pack4(o0, o1, o2, o3);
          ss += o0 * o0 + o1 * o1 + o2 * o2 + o3 * o3;
        }
        ss += xor16(ss);
        ss += __shfl_xor(ss, 32);
        if (fq == 0) ssqb[row * 16 + u.pn * 4 + wc] = ss;
      }
  }
};

struct EpiRes {
  static constexpr int MID_T = -1;
  __device__ __forceinline__ void mid(f32x4 (&)[2][2][4][2], int, int, int) const {}
  float* xo; h16* xb; float* ssq; bool final_out;
  __device__ __forceinline__ void operator()(const f32x4 (&acc)[2][2][4][2], const g8::Unit& u, int ui, int wr, int wc, int fr, int fq) const {
#pragma unroll
    for (int ai = 0; ai < 2; ++ai)
#pragma unroll
      for (int m = 0; m < 4; ++m) {
        const size_t row = (size_t)u.pm * 256 + 128 * ai + 64 * wr + 16 * m + fr;
        const size_t base = row * DM + 256 * u.pn + 32 * wc + 8 * fq;
        float ss = 0.f;
#pragma unroll
        for (int bj = 0; bj < 2; ++bj) {
          const size_t idx = base + 128 * bj;
          const h16x8 xv = *(const h16x8*)(xb + idx);
          f32x4 x0 = acc[ai][bj][m][0], x1 = acc[ai][bj][m][1];
#pragma unroll
          for (int j = 0; j < 4; ++j) { x0[j] += (float)xv[j]; x1[j] += (float)xv[4 + j]; ss += x0[j] * x0[j] + x1[j] * x1[j]; }
          if (final_out) {
            *(float4*)(xo + idx) = make_float4(x0[0], x0[1], x0[2], x0[3]);
            *(float4*)(xo + idx + 4) = make_float4(x1[0], x1[1], x1[2], x1[3]);
          } else {
            *(h16x8*)(xb + idx) = pack8(x0, x1);
          }
        }
        ss += xor16(ss);
        ss += __shfl_xor(ss, 32);
        if (fq == 0) ssq[row * 16 + u.pn * 4 + wc] = ss;
      }
  }
};

struct EpiOut : EpiRes {
  static constexpr int MID_T = 8;
  const float* rsl;
  __device__ __forceinline__ void mid(f32x4 (&acc)[2][2][4][2], int ui, int wr, int fr) const {
#pragma unroll
    for (int ai = 0; ai < 2; ++ai)
#pragma unroll
      for (int m = 0; m < 4; ++m) {
        const float r = rsl[ui * 256 + 128 * ai + 64 * wr + 16 * m + fr];
#pragma unroll
        for (int bj = 0; bj < 2; ++bj)
#pragma unroll
          for (int n = 0; n < 2; ++n) acc[ai][bj][m][n] *= r;
      }
  }
};

struct EpiUp {
  static constexpr int MID_T = -1;
  __device__ __forceinline__ void mid(f32x4 (&)[2][2][4][2], int, int, int) const {}
  h16* hid; const float* rsl;
  __device__ __forceinline__ void operator()(const f32x4 (&acc)[2][2][4][2], const g8::Unit& u, int ui, int wr, int wc, int fr, int fq) const {
#pragma unroll
    for (int ai = 0; ai < 2; ++ai)
#pragma unroll
      for (int m = 0; m < 4; ++m) {
        const int rl = 128 * ai + 64 * wr + 16 * m + fr;
        const float r = rsl[ui * 256 + rl];
        h16* rowp = hid + (size_t)(u.pm * 256 + rl) * DFF + 256 * u.pn + 32 * wc + 8 * fq;
#pragma unroll
        for (int bj = 0; bj < 2; ++bj) {
          f32x4 v[2];
#pragma unroll
          for (int n = 0; n < 2; ++n) {
            v[n] = acc[ai][bj][m][n] * r;
#pragma unroll
            for (int j = 0; j < 4; ++j) { const float t = fmaxf(v[n][j], 0.f); v[n][j] = t * t; }
          }
          *(h16x8*)(rowp + 128 * bj) = pack8(v[0], v[1]);
        }
      }
  }
};

__device__ __forceinline__ void phase_gemm1(const Params& p, int l, char* lds) {
  g8::Order S; S.init(NTOK, IWP, gridDim.x, blockIdx.x);
  float* rsl = (float*)(lds + RSL_OFF);
  fill_rowscales(rsl, (const float*)(WS(p) + O_SSQ), 1.f / DM, S);
  EpiIn E{(h16*)(WS(p) + O_P), rsl, p.in[3] + l * 6 * 64};
  g8::gemm_phase((LAS unsigned char*)lds, (const h16*)(WS(p) + O_XB), (const h16*)(WS(p) + O_WIN + l * SZ_WIN), DM, S, E);
}
__device__ __forceinline__ void phase_glu(const Params& p, int l, char* lds) {
  g8::Order S; S.init(NTOK, 1024, gridDim.x, blockIdx.x);
  __syncthreads();
  EpiGlu E{(h16*)(WS(p) + O_OB), (float*)(WS(p) + O_SSQB), p.in[15] + l * 1024};
  g8::gemm_phase((LAS unsigned char*)lds, (const h16*)(WS(p) + O_Z), (const h16*)(WS(p) + O_WGLU + l * SZ_WGLU), 512, S, E);
}
__device__ __forceinline__ void phase_wout(const Params& p, int l, char* lds) {
  g8::Order S; S.init(NTOK, DM, gridDim.x, blockIdx.x);
  float* rsl = (float*)(lds + RSL_OFF);
  fill_rowscales(rsl, (const float*)(WS(p) + O_SSQB), 1.f / 512.f, S);
  EpiOut E;
  E.xo = p.out; E.xb = (h16*)(WS(p) + O_XB); E.ssq = (float*)(WS(p) + O_SSQ); E.final_out = false; E.rsl = rsl;
  g8::gemm_phase((LAS unsigned char*)lds, (const h16*)(WS(p) + O_OB), (const h16*)(WS(p) + O_WOUT + l * SZ_WOUT), DM, S, E);
}
__device__ __forceinline__ void phase_up(const Params& p, int l, char* lds) {
  g8::Order S; S.init(NTOK, DFF, gridDim.x, blockIdx.x);
  float* rsl = (float*)(lds + RSL_OFF);
  fill_rowscales(rsl, (const float*)(WS(p) + O_SSQ), 1.f / DM, S);
  EpiUp E{(h16*)(WS(p) + O_HID), rsl};
  g8::gemm_phase((LAS unsigned char*)lds, (const h16*)(WS(p) + O_XB), (const h16*)(WS(p) + O_WUP + l * SZ_WUP), DM, S, E);
}
__device__ __forceinline__ void phase_down(const Params& p, int l, char* lds) {
  g8::Order S; S.init(NTOK, DM, gridDim.x, blockIdx.x);
  __syncthreads();
  EpiRes E{p.out, (h16*)(WS(p) + O_XB), (float*)(WS(p) + O_SSQ), l == DEPTH - 1};
  g8::gemm_phase((LAS unsigned char*)lds, (const h16*)(WS(p) + O_HID), (const h16*)(WS(p) + O_WDN + l * SZ_WDN), DFF, S, E);
}

constexpr int KP = 72;
enum { M_SWA = 0, M_WIN = 1, M_SEL = 2, M_CMPA = 3, M_CMPB = 4 };
constexpr float LOG2E = 1.4426950408889634f, SCL2 = 0.125f * LOG2E;
struct ColState { float m, l; };
typedef short s16x4v __attribute__((__vector_size__(8)));

__device__ __forceinline__ h16x8 ld_row8(const h16* base, int ld, int row, int nrows, int c8) {
  h16x8 z = {0, 0, 0, 0, 0, 0, 0, 0};
  return (row >= 0 && row < nrows) ? *(const h16x8*)(base + (size_t)row * ld + c8 * 8) : z;
}
__device__ __forceinline__ void st_k(h16* Ks, int row, int c8, h16x8 v) { *(h16x8*)(Ks + row * KP + c8 * 8) = v; }
__device__ __forceinline__ void st_vt(h16* Vt, int row, int c8, h16x8 v) {
#pragma unroll
  for (int e = 0; e < 8; ++e) Vt[(c8 * 8 + e) * KP + row] = v[e];
}
__device__ __forceinline__ float max4q(float v) {
  v = fmaxf(v, xor16(v));
  auto r = __builtin_amdgcn_permlane32_swap(__float_as_int(v), __float_as_int(v), false, false);
  return fmaxf(__int_as_float(r[0]), __int_as_float(r[1]));
}
__device__ __forceinline__ float sum4q(float v) {
  v += xor16(v);
  auto r = __builtin_amdgcn_permlane32_swap(__float_as_int(v), __float_as_int(v), false, false);
  return __int_as_float(r[0]) + __int_as_float(r[1]);
}
__device__ __forceinline__ float quadsum(float v) { v += dppf<0xB1>(v); v += dppf<0x4E>(v); return v; }

template <int MODE, int RGM>
__device__ __forceinline__ void attn_tile(const h16x8 (&Q)[2][2], f32x4 (&O)[2][4], ColState (&st)[2], const h16* Ks,
                                          const h16* Vt, const float* biasT, const int (&tq)[2], int hd, int kbase, bool far,
                                          const bool (&selbit)[2], float (&hq)[2][4], float (&h3)[2][4], const int lane) {
  const int col = lane & 15, q4 = lane >> 4;
  constexpr int DK = (MODE == M_CMPA || MODE == M_CMPB) ? 16 : 1;
  f32x4 S[2][4];
#pragma unroll
  for (int kt = 0; kt < 4; ++kt) {
#pragma unroll
    for (int rg = 0; rg < 2; ++rg) S[rg][kt] = f32x4{0.f, 0.f, 0.f, 0.f};
#pragma unroll
    for (int ks = 0; ks < 2; ++ks) {
      h16x8 Kf = *(const h16x8*)(Ks + (kt * 16 + col) * KP + ks * 32 + q4 * 8);
#pragma unroll
      for (int rg = 0; rg < 2; ++rg)
        if (RGM & (1 << rg)) S[rg][kt] = __builtin_amdgcn_mfma_f32_16x16x32_f16(Kf, Q[rg][ks], S[rg][kt], 0, 0, 0);
    }
  }
  h16x8 Pf[2][2];
#pragma unroll
  for (int rg = 0; rg < 2; ++rg) {
    if (!(RGM & (1 << rg))) continue;
    const float* bt = biasT + hd * 800;
    if (far) {
      const float b31 = bt[799];
      const bool ok = (MODE == M_SEL) ? selbit[rg] : true;
#pragma unroll
      for (int kt = 0; kt < 4; ++kt)
#pragma unroll
        for (int j = 0; j < 4; ++j) S[rg][kt][j] = ok ? S[rg][kt][j] * SCL2 + b31 : -1e30f;
    } else {
      const int kx0 = kbase + q4 * 4;
      const int d0 = (DK == 16) ? tq[rg] - 31 - 16 * kx0 : tq[rg] - kx0;
#pragma unroll
      for (int kt = 0; kt < 4; ++kt)
#pragma unroll
        for (int j = 0; j < 4; ++j) {
          const int dist = d0 - DK * (kt * 16 + j);
          const int kx = kx0 + kt * 16 + j;
          bool valid = dist >= 0;
          if (MODE == M_SWA) valid = valid && dist < 128 && kx >= 0;
          if (MODE == M_WIN) valid = valid && dist < 512 && kx >= 0;
          if (MODE == M_SEL) valid = valid && selbit[rg];
          if (DK == 16) valid = valid && kx < NCMP;
          const int dc = dist < 0 ? 0 : (dist > 799 ? 799 : dist);
          S[rg][kt][j] = valid ? S[rg][kt][j] * SCL2 + bt[dc] : -1e30f;
        }
    }
    if (MODE == M_CMPB) {
#pragma unroll
      for (int kt = 0; kt < 4; ++kt) {
        float h = 0.f;
#pragma unroll
        for (int j = 0; j < 4; ++j) {
          float pv = __builtin_amdgcn_exp2f(S[rg][kt][j] - st[rg].m) * st[rg].l;
          S[rg][kt][j] = pv;
          h += pv;
        }
        hq[rg][kt] = h;
        h3[rg][kt] = S[rg][kt][3];
      }
    } else {
      float mx = -1e30f;
#pragma unroll
      for (int kt = 0; kt < 4; ++kt)
#pragma unroll
        for (int j = 0; j < 4; ++j) mx = fmaxf(mx, S[rg][kt][j]);
      mx = max4q(mx);
      const float mn = fmaxf(st[rg].m, mx);
      const float corr = __builtin_amdgcn_exp2f(st[rg].m - mn);
      st[rg].m = mn;
      const float mm = fmaxf(mn, -1e20f);
      float ls = 0.f;
#pragma unroll
      for (int kt = 0; kt < 4; ++kt)
#pragma unroll
        for (int j = 0; j < 4; ++j) {
          float pv = __builtin_amdgcn_exp2f(S[rg][kt][j] - mm);
          S[rg][kt][j] = pv;
          ls += pv;
        }
      st[rg].l = st[rg].l * corr + ls;
      if (MODE != M_CMPA) {
#pragma unroll
        for (int nt = 0; nt < 4; ++nt) O[rg][nt] *= corr;
      }
    }
    if (MODE != M_CMPA) {
#pragma unroll
      for (int ks = 0; ks < 2; ++ks)
#pragma unroll
        for (int i = 0; i < 4; ++i) {
          Pf[rg][ks][i] = (h16)S[rg][2 * ks][i];
          Pf[rg][ks][4 + i] = (h16)S[rg][2 * ks + 1][i];
        }
    }
  }
  if (MODE == M_CMPA) return;
#pragma unroll
  for (int ks = 0; ks < 2; ++ks)
#pragma unroll
    for (int nt = 0; nt < 4; ++nt) {
      const h16* vp = Vt + (ks * 32 + q4 * 4 + (col >> 2)) * KP + nt * 16 + 4 * (col & 3);
      const s16x4v r0 = __builtin_amdgcn_ds_read_tr16_b64_v4i16((LAS s16x4v*)vp);
      const s16x4v r1 = __builtin_amdgcn_ds_read_tr16_b64_v4i16((LAS s16x4v*)(vp + 16 * KP));
      const h16x4 v0 = __builtin_bit_cast(h16x4, r0), v1 = __builtin_bit_cast(h16x4, r1);
      const h16x8 Vf = {v0[0], v0[1], v0[2], v0[3], v1[0], v1[1], v1[2], v1[3]};
#pragma unroll
      for (int rg = 0; rg < 2; ++rg)
        if (RGM & (1 << rg)) O[rg][nt] = __builtin_amdgcn_mfma_f32_16x16x32_f16(Vf, Pf[rg][ks], O[rg][nt], 0, 0, 0);
    }
}

constexpr int LDS_CMP = 8 * 16 * 128 * 4 + 16 * 136 * 2 + 4 * 16 * 4;
__device__ __forceinline__ void phase_compress(const Params& p, int l, char* lds) {
  const int tid = opaque_tid(), lane = tid & 63, w = tid >> 6, col = lane & 15, q4 = lane >> 4;
  float* red = (float*)lds;
  h16* hid = (h16*)(lds + 8 * 16 * 128 * 4);
  float* nrm2 = (float*)(lds + 8 * 16 * 128 * 4 + 16 * 136 * 2);
  const h16* P = (const h16*)(WS(p) + O_P);
  for (int u = blockIdx.x; u < BATCH * 2 * 32; u += gridDim.x) {
    const int mt = u & 31, st = (u >> 5) & 1, b = u >> 6;
    const h16* W1t = (const h16*)(WS(p) + O_W1T) + (size_t)(l * 2 + st) * 128 * 2048;
    const h16* W2t = (const h16*)(WS(p) + O_W2T) + (size_t)(l * 2 + st) * 64 * 128;
    const float* b1 = (const float*)(WS(p) + O_BIAS1) + (l * 2 + st) * 128;
    __syncthreads();
    {
      f32x4 acc[8];
#pragma unroll
      for (int nt = 0; nt < 8; ++nt) acc[nt] = f32x4{0.f, 0.f, 0.f, 0.f};
      const int m = 16 * mt + col;
#pragma unroll 2
      for (int kk = 0; kk < 8; ++kk) {
        const int ks = 8 * w + kk, tt = ks >> 1, d0 = (ks & 1) * 32 + q4 * 8;
        int tok = 16 * m + tt;
        if (tok > SEQ - 1) tok = SEQ - 1;
        const h16x8 A = *(const h16x8*)(P + ((size_t)b * SEQ + tok) * IWP + OFF_KVC + st * 64 + d0);
#pragma unroll
        for (int nt = 0; nt < 8; ++nt) {
          const h16x8 B = *(const h16x8*)(W1t + (size_t)(nt * 16 + col) * 2048 + ks * 32 + q4 * 8);
          acc[nt] = __builtin_amdgcn_mfma_f32_16x16x32_f16(A, B, acc[nt], 0, 0, 0);
        }
      }
#pragma unroll
      for (int nt = 0; nt < 8; ++nt)
#pragma unroll
        for (int j = 0; j < 4; ++j) red[(w * 16 + q4 * 4 + j) * 128 + nt * 16 + col] = acc[nt][j];
    }
    __syncthreads();
    {
      const int row = tid >> 5, c4 = (tid & 31) * 4;
      float4 sum = *(const float4*)(b1 + c4);
#pragma unroll
      for (int ww = 0; ww < 8; ++ww) {
        const float4 v = *(const float4*)(red + (ww * 16 + row) * 128 + c4);
        sum.x += v.x; sum.y += v.y; sum.z += v.z; sum.w += v.w;
      }
      *(h16x4*)(hid + row * 136 + c4) = pack4(gelu_tanh(sum.x), gelu_tanh(sum.y), gelu_tanh(sum.z), gelu_tanh(sum.w));
    }
    __syncthreads();
    f32x4 o2 = {0.f, 0.f, 0.f, 0.f};
    if (w < 4) {
#pragma unroll
      for (int ks = 0; ks < 4; ++ks) {
        const h16x8 A = *(const h16x8*)(hid + col * 136 + ks * 32 + q4 * 8);
        const h16x8 B = *(const h16x8*)(W2t + (size_t)(w * 16 + col) * 128 + ks * 32 + q4 * 8);
        o2 = __builtin_amdgcn_mfma_f32_16x16x32_f16(A, B, o2, 0, 0, 0);
      }
      if (st == 0) {
#pragma unroll
        for (int j = 0; j < 4; ++j) {
          float ss = sum16(o2[j] * o2[j]);
          if (col == 0) nrm2[w * 16 + q4 * 4 + j] = ss;
        }
      }
    }
    __syncthreads();
    if (w < 4) {
      const float g = p.in[3][(l * 6 + 3) * 64 + w * 16 + col];
      h16* dst = (h16*)(WS(p) + (st == 0 ? O_KCMP : O_VCMP));
#pragma unroll
      for (int j = 0; j < 4; ++j) {
        const int row = q4 * 4 + j, m = 16 * mt + row;
        float v = o2[j];
        if (st == 0) {
          float tot = nrm2[row] + nrm2[16 + row] + nrm2[32 + row] + nrm2[48 + row];
          v = v * rsqrtf(tot * (1.f / 64.f) + EPS) * g;
        }
        if (m >= NCMP) v = 0.f;
        dst[((size_t)b * 512 + m) * 64 + w * 16 + col] = (h16)v;
      }
    }
  }
}


template <int MODE, int TM>
__device__ __forceinline__ void attn_tile2(const h16x8 (&Q)[2], f32x4 (&O)[4], ColState& st, const h16* Ks0, const h16* Vt0,
                                           const h16* Ks1, const h16* Vt1, const float* biasT, int tq, int hd, int kbase0,
                                           const bool (&far)[2], const bool (&selbit)[2], float (&hq)[2][4], float (&h3)[2][4],
                                           const int lane) {
  const int col = lane & 15, q4 = lane >> 4;
  constexpr int DK = (MODE == M_CMPA || MODE == M_CMPB) ? 16 : 1;
  f32x4 S[2][4];
#pragma unroll
  for (int t = 0; t < 2; ++t) {
    if (!(TM & (1 << t))) continue;
    const h16* Ks = t ? Ks1 : Ks0;
#pragma unroll
    for (int kt = 0; kt < 4; ++kt) {
      S[t][kt] = f32x4{0.f, 0.f, 0.f, 0.f};
#pragma unroll
      for (int ks = 0; ks < 2; ++ks) {
        h16x8 Kf = *(const h16x8*)(Ks + (kt * 16 + col) * KP + ks * 32 + q4 * 8);
        S[t][kt] = __builtin_amdgcn_mfma_f32_16x16x32_f16(Kf, Q[ks], S[t][kt], 0, 0, 0);
      }
    }
  }
  const float* bt = biasT + hd * 800;
  float addc[2] = {0.f, 0.f}, sclc[2] = {1.f, 1.f};
#pragma unroll
  for (int t = 0; t < 2; ++t) {
    if (!(TM & (1 << t))) continue;
    const int kbase = kbase0 + 64 * t;
    if (far[t]) {
      const bool ok = (MODE == M_SEL) ? selbit[t] : true;
      addc[t] = ok ? bt[799] : -1e30f;
      sclc[t] = SCL2;
    } else {
      addc[t] = 0.f;
      sclc[t] = 1.f;
      const int kx0 = kbase + q4 * 4;
      const int d0 = (DK == 16) ? tq - 31 - 16 * kx0 : tq - kx0;
#pragma unroll
      for (int kt = 0; kt < 4; ++kt)
#pragma unroll
        for (int j = 0; j < 4; ++j) {
          const int dist = d0 - DK * (kt * 16 + j);
          const int kx = kx0 + kt * 16 + j;
          bool valid = dist >= 0;
          if (MODE == M_WIN) valid = valid && dist < 512 && kx >= 0;
          if (MODE == M_SEL) valid = valid && selbit[t];
          if (DK == 16) valid = valid && kx < NCMP;
          const int dc = dist < 0 ? 0 : (dist > 799 ? 799 : dist);
          S[t][kt][j] = valid ? S[t][kt][j] * SCL2 + bt[dc] : -1e30f;
        }
    }
  }
  if (MODE == M_CMPB) {
#pragma unroll
    for (int t = 0; t < 2; ++t) {
      if (!(TM & (1 << t))) continue;
#pragma unroll
      for (int kt = 0; kt < 4; ++kt) {
        float h = 0.f;
#pragma unroll
        for (int j = 0; j < 4; ++j) {
          float pv = __builtin_amdgcn_exp2f(S[t][kt][j] * sclc[t] + (addc[t] - st.m)) * st.l;
          S[t][kt][j] = pv;
          h += pv;
        }
        hq[t][kt] = h;
        h3[t][kt] = S[t][kt][3];
      }
    }
  } else {
    float mx = -1e30f;
#pragma unroll
    for (int t = 0; t < 2; ++t) {
      if (!(TM & (1 << t))) continue;
      float mt = -1e30f;
#pragma unroll
      for (int kt = 0; kt < 4; ++kt)
#pragma unroll
        for (int j = 0; j < 4; ++j) mt = fmaxf(mt, S[t][kt][j]);
      mx = fmaxf(mx, mt * sclc[t] + addc[t]);
    }
    mx = max4q(mx);
    const float mn = fmaxf(st.m, mx);
    const float corr = __builtin_amdgcn_exp2f(st.m - mn);
    st.m = mn;
    const float mm = fmaxf(mn, -1e20f);
    float ls = 0.f;
#pragma unroll
    for (int t = 0; t < 2; ++t) {
      if (!(TM & (1 << t))) continue;
      const float am = addc[t] - mm;
#pragma unroll
      for (int kt = 0; kt < 4; ++kt) {
        const f32x4 e = S[t][kt] * sclc[t] + am;
#pragma unroll
        for (int j = 0; j < 4; ++j) {
          float pv = __builtin_amdgcn_exp2f(e[j]);
          S[t][kt][j] = pv;
          ls += pv;
        }
      }
    }
    st.l = st.l * corr + ls;
    if (MODE != M_CMPA) {
#pragma unroll
      for (int nt = 0; nt < 4; ++nt) O[nt] *= corr;
    }
  }
  if (MODE == M_CMPA) return;
#pragma unroll
  for (int t = 0; t < 2; ++t) {
    if (!(TM & (1 << t))) continue;
    const h16* Vt = t ? Vt1 : Vt0;
#pragma unroll
    for (int ks = 0; ks < 2; ++ks) {
      h16x8 Pf;
#pragma unroll
      for (int i = 0; i < 4; ++i) { Pf[i] = (h16)S[t][2 * ks][i]; Pf[4 + i] = (h16)S[t][2 * ks + 1][i]; }
#pragma unroll
      for (int nt = 0; nt < 4; ++nt) {
        const h16* vp = Vt + (ks * 32 + q4 * 4 + (col >> 2)) * KP + nt * 16 + 4 * (col & 3);
        const s16x4v r0 = __builtin_amdgcn_ds_read_tr16_b64_v4i16((LAS s16x4v*)vp);
        const s16x4v r1 = __builtin_amdgcn_ds_read_tr16_b64_v4i16((LAS s16x4v*)(vp + 16 * KP));
        const h16x4 v0 = __builtin_bit_cast(h16x4, r0), v1 = __builtin_bit_cast(h16x4, r1);
        const h16x8 Vf = {v0[0], v0[1], v0[2], v0[3], v1[0], v1[1], v1[2], v1[3]};
        O[nt] = __builtin_amdgcn_mfma_f32_16x16x32_f16(Vf, Pf, O[nt], 0, 0, 0);
      }
    }
  }
}

template <int D, class LoadF, class StoreF, class CompF>
__device__ __forceinline__ void pair_pipeline(int n, LoadF load, StoreF store, CompF comp) {
  h16x8 r[D][4];
#pragma unroll
  for (int d = 0; d < D; ++d)
    if (d < n) load(d, r[d]);
  store(0, r[0]);
  if (D < n) load(D, r[0]);
  __syncthreads();
  for (int i0 = 0; i0 < n; i0 += D) {
#pragma unroll
    for (int d = 0; d < D; ++d) {
      const int i = i0 + d;
      if (i < n) {
        if (i + 1 < n) store(i + 1, r[(d + 1) % D]);
        if (i + 1 + D < n) load(i + 1 + D, r[(d + 1) % D]);
        comp(i);
        __syncthreads();
      }
    }
  }
}

template <int D, class LoadF, class StoreF, class CompF>
__device__ __forceinline__ void tile_pipeline(int n, LoadF load, StoreF store, CompF comp) {
  h16x8 rk[D], rv[D];
#pragma unroll
  for (int d = 0; d < D; ++d)
    if (d < n) load(d, rk[d], rv[d]);
  store(0, rk[0], rv[0]);
  if (D < n) load(D, rk[0], rv[0]);
  __syncthreads();
  for (int i0 = 0; i0 < n; i0 += D) {
#pragma unroll
    for (int d = 0; d < D; ++d) {
      const int i = i0 + d;
      if (i < n) {
        if (i + 1 < n) store(i + 1, rk[(d + 1) % D], rv[(d + 1) % D]);
        if (i + 1 + D < n) load(i + 1 + D, rk[(d + 1) % D], rv[(d + 1) % D]);
        comp(i);
        __syncthreads();
      }
    }
  }
}

constexpr int LDS_BIAS = 800 * 16;
__device__ __forceinline__ void phase_swa(const Params& p, int l, char* lds) {
  const int tid = opaque_tid(), lane = tid & 63, w = tid >> 6, col = lane & 15, q4 = lane >> 4;
  float* biasT = (float*)lds;
  h16* KV = (h16*)(lds + LDS_BIAS);
  float* nrm = (float*)(lds + LDS_BIAS + 4 * 64 * KP * 2);
  const h16* P = (const h16*)(WS(p) + O_P);
  const int* lut = (const int*)(WS(p) + O_LUT);
  h16* OAC = (h16*)(WS(p) + O_OAC);
  __syncthreads();
  for (int i = tid; i < 3200; i += NT) biasT[i] = p.in[5][lut[i % 800] * 8 + (i / 800)] * LOG2E;
  __syncthreads();
  const int head = w >> 1, kvh = w >> 2;
  const float sink = p.in[4][l * 4 + head] * LOG2E;
  const int srow = tid >> 3, c8 = tid & 7;
  float hpd[2][4], hpe[2][4];
  const bool nosel[2] = {false, false};
  for (int u = blockIdx.x; u < BATCH * 128; u += gridDim.x) {
    const int b = u >> 7, t0 = (u & 127) * 64;
    const h16* Pbat = P + (size_t)b * SEQ * IWP;
    h16x8 Q[2][2];
    int tq[2];
#pragma unroll
    for (int rg = 0; rg < 2; ++rg) {
      const int qb = (w & 1) * 32 + rg * 16;
      const h16* qp = Pbat + (size_t)(t0 + qb + col) * IWP + head * 64 + q4 * 8;
      Q[rg][0] = *(const h16x8*)qp;
      Q[rg][1] = *(const h16x8*)(qp + 32);
      tq[rg] = t0 + qb + col;
    }
    f32x4 O[2][4];
    ColState st[2];
#pragma unroll
    for (int rg = 0; rg < 2; ++rg) {
#pragma unroll
      for (int nt = 0; nt < 4; ++nt) O[rg][nt] = f32x4{0.f, 0.f, 0.f, 0.f};
      st[rg].m = -1e30f; st[rg].l = 0.f;
    }
    const int i0 = t0 >= 128 ? 0 : (t0 >= 64 ? 1 : 2);
    h16x8 rk[2], rv[2];
    {
      int sb = t0 - 128 + i0 * 64;
      for (int h2 = 0; h2 < 2; ++h2) {
        rk[h2] = ld_row8(Pbat + 256 + h2 * 64, IWP, sb + srow, SEQ, c8);
        rv[h2] = ld_row8(Pbat + 384 + h2 * 64, IWP, sb + srow, SEQ, c8);
      }
    }
    for (int i = i0; i < 3; ++i) {
      __syncthreads();
      for (int h2 = 0; h2 < 2; ++h2) {
        st_k(KV + h2 * 64 * KP, srow, c8, rk[h2]);
        st_k(KV + (2 + h2) * 64 * KP, srow, c8, rv[h2]);
      }
      __syncthreads();
      if (i + 1 < 3) {
        int sb = t0 - 128 + (i + 1) * 64;
        for (int h2 = 0; h2 < 2; ++h2) {
          rk[h2] = ld_row8(Pbat + 256 + h2 * 64, IWP, sb + srow, SEQ, c8);
          rv[h2] = ld_row8(Pbat + 384 + h2 * 64, IWP, sb + srow, SEQ, c8);
        }
      }
      const int kb = t0 - 128 + i * 64;
      attn_tile<M_SWA, 3>(Q, O, st, KV + kvh * 64 * KP, KV + (2 + kvh) * 64 * KP, biasT, tq, head, kb, false, nosel, hpd, hpe, lane);
    }
    __syncthreads();
#pragma unroll
    for (int rg = 0; rg < 2; ++rg) {
      const int qb = (w & 1) * 32 + rg * 16;
      const float lsum = sum4q(st[rg].l);
      const float mn = fmaxf(st[rg].m, sink);
      const float corr = __builtin_amdgcn_exp2f(st[rg].m - mn);
      const float inv = corr / (lsum * corr + __builtin_amdgcn_exp2f(sink - mn));
      float ss = 0.f;
#pragma unroll
      for (int nt = 0; nt < 4; ++nt) {
        O[rg][nt] *= inv;
#pragma unroll
        for (int j = 0; j < 4; ++j) ss += O[rg][nt][j] * O[rg][nt][j];
      }
      ss = sum4q(ss);
      if (q4 == 0) nrm[head * 64 + qb + col] = ss;
    }
    __syncthreads();
#pragma unroll
    for (int rg = 0; rg < 2; ++rg) {
      const int qi = (w & 1) * 32 + rg * 16 + col;
      const float tot = nrm[qi] + nrm[64 + qi] + nrm[128 + qi] + nrm[192 + qi];
      const float sc = rsqrtf(tot * (1.f / 256.f) + EPS);
#pragma unroll
      for (int nt = 0; nt < 4; ++nt)
        *(h16x4*)(OAC + ((size_t)b * SEQ + t0 + qi) * 1024 + head * 64 + nt * 16 + q4 * 4) =
            pack4(O[rg][nt][0] * sc, O[rg][nt][1] * sc, O[rg][nt][2] * sc, O[rg][nt][3] * sc);
    }
  }
}

constexpr int LDS_NSA = LDS_BIAS + 8 * 64 * KP * 2 + NW * 4 * 128 * 4 + 32 * 16;
constexpr int PFD = 2;
__device__ __forceinline__ void phase_nsa(const Params& p, int l, char* lds, const int parts = 15) {
  const int tid = opaque_tid(), lane = tid & 63, w = tid >> 6, col = lane & 15, q4 = lane >> 4;
  float* biasT = (float*)lds;
  h16* KV0 = (h16*)(lds + LDS_BIAS);
  float* impw = (float*)(lds + LDS_BIAS + 8 * 64 * KP * 2) + w * 4 * 128;
  unsigned long long* selm = (unsigned long long*)(lds + LDS_BIAS + 8 * 64 * KP * 2 + NW * 4 * 128 * 4);
#define KSB(i, t) (KV0 + (((i) & 1) * 4 + (t) * 2) * 64 * KP)
#define VTB(i, t) (KV0 + (((i) & 1) * 4 + (t) * 2 + 1) * 64 * KP)
  const h16* P = (const h16*)(WS(p) + O_P);
  const int* lut = (const int*)(WS(p) + O_LUT);
  h16* OAC = (h16*)(WS(p) + O_OAC);
  __syncthreads();
  for (int i = tid; i < 3200; i += NT) biasT[i] = p.in[5][lut[i % 800] * 8 + 4 + (i / 800)] * LOG2E;
  __syncthreads();
  const int srow = tid >> 3, c8 = tid & 7;
  const int hd = col & 3, qw = col >> 2;
  float hpd[2][4], hpe[2][4];
  const bool nosel[2] = {false, false};
  for (int u = blockIdx.x; u < 1024; u += gridDim.x) {
    const int rnd = u >> 8, b = (u & 255) >> 6, ti = u & 63;
    const int tile = rnd == 0 ? 255 - ti : (rnd == 1 ? 128 + ti : (rnd == 2 ? 127 - ti : ti));
    const int t0 = tile * 32, cur = t0 >> 6;
    const h16* Pbat = P + (size_t)b * SEQ * IWP;
    const h16* KC = (const h16*)(WS(p) + O_KCMP) + (size_t)b * 512 * 64;
    const h16* VC = (const h16*)(WS(p) + O_VCMP) + (size_t)b * 512 * 64;
    h16x8 Q[2];
    int tq;
    {
      const h16* qp = Pbat + (size_t)(t0 + w * 4 + qw) * IWP + OFF_QC + hd * 64 + q4 * 8;
      Q[0] = *(const h16x8*)qp;
      Q[1] = *(const h16x8*)(qp + 32);
      tq = t0 + w * 4 + qw;
    }
    const h16* gp = Pbat + (size_t)tq * IWP + OFF_GC + hd * 3;
    for (int i = lane; i < 512; i += 64) impw[i] = 0.f;
    f32x4 O[4], Oc[4];
    ColState st;
    int mvmax = t0 / 16 + 1;
    if (mvmax > NCMP) mvmax = NCMP;
    const int ntc = (mvmax + 63) >> 6;
    st.m = -1e30f; st.l = 0.f;
    const int npc = (ntc + 1) >> 1;
    if (parts & 1) pair_pipeline<PFD>(npc,
      [&](int i, h16x8 (&r)[4]) { r[0] = ld_row8(KC, 64, (2 * i) * 64 + srow, 512, c8); r[2] = ld_row8(KC, 64, (2 * i + 1) * 64 + srow, 512, c8); },
      [&](int i, const h16x8 (&r)[4]) { st_k(KSB(i, 0), srow, c8, r[0]); st_k(KSB(i, 1), srow, c8, r[2]); },
      [&](int i) {
        const bool far[2] = {t0 - 31 - 16 * (2 * i * 64 + 63) >= 799, t0 - 31 - 16 * ((2 * i + 1) * 64 + 63) >= 799};
        if (2 * i + 1 < ntc) attn_tile2<M_CMPA, 3>(Q, O, st, KSB(i, 0), VTB(i, 0), KSB(i, 1), VTB(i, 1), biasT, tq, hd, 2 * i * 64, far, nosel, hpd, hpe, lane);
        else attn_tile2<M_CMPA, 1>(Q, O, st, KSB(i, 0), VTB(i, 0), KSB(i, 1), VTB(i, 1), biasT, tq, hd, 2 * i * 64, far, nosel, hpd, hpe, lane);
      });
    {
      const float ls = sum4q(st.l);
      st.l = ls > 0.f ? 1.f / ls : 0.f;
    }
#pragma unroll
    for (int nt = 0; nt < 4; ++nt) O[nt] = f32x4{0.f, 0.f, 0.f, 0.f};
    float carry = 0.f;
    if (parts & 1) pair_pipeline<PFD>(npc,
      [&](int i, h16x8 (&r)[4]) {
        r[0] = ld_row8(KC, 64, (2 * i) * 64 + srow, 512, c8); r[1] = ld_row8(VC, 64, (2 * i) * 64 + srow, 512, c8);
        r[2] = ld_row8(KC, 64, (2 * i + 1) * 64 + srow, 512, c8); r[3] = ld_row8(VC, 64, (2 * i + 1) * 64 + srow, 512, c8); },
      [&](int i, const h16x8 (&r)[4]) {
        st_k(KSB(i, 0), srow, c8, r[0]); st_k(VTB(i, 0), srow, c8, r[1]); st_k(KSB(i, 1), srow, c8, r[2]); st_k(VTB(i, 1), srow, c8, r[3]); },
      [&](int i) {
        float hq[2][4], h3[2][4];
        const bool far[2] = {t0 - 31 - 16 * (2 * i * 64 + 63) >= 799, t0 - 31 - 16 * ((2 * i + 1) * 64 + 63) >= 799};
        const bool two = 2 * i + 1 < ntc;
        if (two) attn_tile2<M_CMPB, 3>(Q, O, st, KSB(i, 0), VTB(i, 0), KSB(i, 1), VTB(i, 1), biasT, tq, hd, 2 * i * 64, far, nosel, hq, h3, lane);
        else attn_tile2<M_CMPB, 1>(Q, O, st, KSB(i, 0), VTB(i, 0), KSB(i, 1), VTB(i, 1), biasT, tq, hd, 2 * i * 64, far, nosel, hq, h3, lane);
        float t3p = carry;
#pragma unroll
        for (int t = 0; t < 2; ++t) {
          if (t == 1 && !two) break;
#pragma unroll
          for (int kt = 0; kt < 4; ++kt) {
            const float qs = quadsum(hq[t][kt]);
            const float t3 = quadsum(h3[t][kt]);
            const float up = __shfl(t3, (lane + 48) & 63);
            const float wrp = __shfl(t3p, (lane + 48) & 63);
            const float pk = (q4 == 0) ? wrp : up;
            if (hd == 0) impw[qw * 128 + (2 * i + t) * 16 + kt * 4 + q4] = qs + pk;
            t3p = t3;
          }
        }
        carry = t3p;
      });
    {
      const float g0 = (float)gp[0];
#pragma unroll
      for (int nt = 0; nt < 4; ++nt) Oc[nt] = O[nt] * g0;
    }
    if (parts & 2) {
      const int nforced = cur >= 2 ? 3 : cur + 1;
      const int npick = 16 - nforced;
      for (int qi = 0; qi < 4; ++qi) {
        const float* im = impw + qi * 128;
        const int j0 = lane, j1 = lane + 64;
        const float v0 = im[j0], v1 = im[j1];
        int r0 = 0, r1 = 0;
#pragma unroll 8
        for (int jp = 1; jp <= cur - 2; ++jp) {
          float vp = im[jp];
          r0 += (vp > v0 || (vp == v0 && jp < j0)) ? 1 : 0;
          r1 += (vp > v1 || (vp == v1 && jp < j1)) ? 1 : 0;
        }
        bool c0 = j0 >= 1 && j0 <= cur - 2, c1 = j1 <= cur - 2;
        bool f0 = j0 == 0 || j0 == cur || j0 == cur - 1, f1 = j1 == cur || j1 == cur - 1;
        unsigned long long mlo = __ballot(f0 || (c0 && r0 < npick));
        unsigned long long mhi = __ballot(f1 || (c1 && r1 < npick));
        if (lane == 0) { selm[(w * 4 + qi) * 2] = mlo; selm[(w * 4 + qi) * 2 + 1] = mhi; }
      }
    }
    asm volatile("" ::: "memory");
    const unsigned long long slo = selm[(w * 4 + qw) * 2], shi = selm[(w * 4 + qw) * 2 + 1];
#pragma unroll
    for (int nt = 0; nt < 4; ++nt) O[nt] = f32x4{0.f, 0.f, 0.f, 0.f};
    st.m = -1e30f; st.l = 0.f;
    if (parts & 4) pair_pipeline<PFD>((cur + 2) >> 1,
      [&](int i, h16x8 (&r)[4]) {
        r[0] = ld_row8(Pbat + OFF_KVC + 128, IWP, (2 * i) * 64 + srow, SEQ, c8); r[1] = ld_row8(Pbat + OFF_KVC + 192, IWP, (2 * i) * 64 + srow, SEQ, c8);
        r[2] = ld_row8(Pbat + OFF_KVC + 128, IWP, (2 * i + 1) * 64 + srow, SEQ, c8); r[3] = ld_row8(Pbat + OFF_KVC + 192, IWP, (2 * i + 1) * 64 + srow, SEQ, c8); },
      [&](int i, const h16x8 (&r)[4]) {
        st_k(KSB(i, 0), srow, c8, r[0]); st_k(VTB(i, 0), srow, c8, r[1]); st_k(KSB(i, 1), srow, c8, r[2]); st_k(VTB(i, 1), srow, c8, r[3]); },
      [&](int i) {
        const int jb = 2 * i;
        bool sb[2];
        sb[0] = ((jb < 64 ? (slo >> jb) : (shi >> (jb - 64))) & 1ull) != 0;
        sb[1] = (jb + 1 <= cur) && (((jb + 1 < 64 ? (slo >> (jb + 1)) : (shi >> (jb + 1 - 64))) & 1ull) != 0);
        const bool far[2] = {t0 - (jb * 64 + 63) >= 799, t0 - (jb * 64 + 127) >= 799};
        const bool n0 = __any(sb[0]) != 0, n1 = __any(sb[1]) != 0;
        if (n0 && n1) attn_tile2<M_SEL, 3>(Q, O, st, KSB(i, 0), VTB(i, 0), KSB(i, 1), VTB(i, 1), biasT, tq, hd, jb * 64, far, sb, hpd, hpe, lane);
        else if (n0) attn_tile2<M_SEL, 1>(Q, O, st, KSB(i, 0), VTB(i, 0), KSB(i, 1), VTB(i, 1), biasT, tq, hd, jb * 64, far, sb, hpd, hpe, lane);
        else if (n1) attn_tile2<M_SEL, 2>(Q, O, st, KSB(i, 0), VTB(i, 0), KSB(i, 1), VTB(i, 1), biasT, tq, hd, jb * 64, far, sb, hpd, hpe, lane);
      });
    {
      const float ls = sum4q(st.l);
      const float f = ls > 0.f ? (float)gp[1] / ls : 0.f;
#pragma unroll
      for (int nt = 0; nt < 4; ++nt) Oc[nt] += O[nt] * f;
    }
#pragma unroll
    for (int nt = 0; nt < 4; ++nt) O[nt] = f32x4{0.f, 0.f, 0.f, 0.f};
    st.m = -1e30f; st.l = 0.f;
    const int w0 = cur >= 8 ? cur - 8 : 0;
    const int nwt = cur - w0 + 1;
    if (parts & 8) pair_pipeline<PFD>((nwt + 1) >> 1,
      [&](int i, h16x8 (&r)[4]) {
        r[0] = ld_row8(Pbat + OFF_KVC + 256, IWP, (w0 + 2 * i) * 64 + srow, SEQ, c8); r[1] = ld_row8(Pbat + OFF_KVC + 320, IWP, (w0 + 2 * i) * 64 + srow, SEQ, c8);
        r[2] = ld_row8(Pbat + OFF_KVC + 256, IWP, (w0 + 2 * i + 1) * 64 + srow, SEQ, c8); r[3] = ld_row8(Pbat + OFF_KVC + 320, IWP, (w0 + 2 * i + 1) * 64 + srow, SEQ, c8); },
      [&](int i, const h16x8 (&r)[4]) {
        st_k(KSB(i, 0), srow, c8, r[0]); st_k(VTB(i, 0), srow, c8, r[1]); st_k(KSB(i, 1), srow, c8, r[2]); st_k(VTB(i, 1), srow, c8, r[3]); },
      [&](int i) {
        const bool far[2] = {false, false};
        if (2 * i + 1 < nwt) attn_tile2<M_WIN, 3>(Q, O, st, KSB(i, 0), VTB(i, 0), KSB(i, 1), VTB(i, 1), biasT, tq, hd, (w0 + 2 * i) * 64, far, nosel, hpd, hpe, lane);
        else attn_tile2<M_WIN, 1>(Q, O, st, KSB(i, 0), VTB(i, 0), KSB(i, 1), VTB(i, 1), biasT, tq, hd, (w0 + 2 * i) * 64, far, nosel, hpd, hpe, lane);
      });
    {
      const float ls = sum4q(st.l);
      const float f = ls > 0.f ? (float)gp[2] / ls : 0.f;
      float ss = 0.f;
#pragma unroll
      for (int nt = 0; nt < 4; ++nt) {
        Oc[nt] += O[nt] * f;
#pragma unroll
        for (int j = 0; j < 4; ++j) ss += Oc[nt][j] * Oc[nt][j];
      }
      ss = quadsum(sum4q(ss));
      const float sc = rsqrtf(ss * (1.f / 256.f) + EPS);
#pragma unroll
      for (int nt = 0; nt < 4; ++nt)
        *(h16x4*)(OAC + ((size_t)b * SEQ + tq) * 1024 + 256 + hd * 64 + nt * 16 + q4 * 4) =
            pack4(Oc[nt][0] * sc, Oc[nt][1] * sc, Oc[nt][2] * sc, Oc[nt][3] * sc);
    }
  }
#undef KSB
#undef VTB
}

constexpr int LDS_SWA = LDS_BIAS + 4 * 64 * KP * 2 + 1024;
constexpr int lds_max(int a, int b) { return a > b ? a : b; }
constexpr int LDS_BYTES = lds_max(lds_max(LDS_NSA, SSMY_LDS), lds_max(LDS_SWA, lds_max(LDS_GEMM, lds_max(LDS_CMP, 64 * 65 * 4))));

__global__ void __launch_bounds__(NT) fwd_megakernel(Params p) {
  cg::grid_group grid = cg::this_grid();
  __shared__ __attribute__((aligned(16))) char lds[LDS_BYTES];
  __shared__ uint4 xb_words;
  if (threadIdx.x == 0) xb_words = make_uint4(0u, 0u, 0u, 0u);
  __syncthreads();
  (void)xcd_barrier_post((unsigned*)(WS(p) + O_BAR), (volatile LAS unsigned*)&xb_words);
#define GBAR() do { XcdBarrier _b; _b.bar = (unsigned*)(WS(p) + O_BAR); _b.x = xb_xcc_id(); _b.st = (volatile LAS unsigned*)&xb_words; xcd_barrier(_b); } while (0)
  phase0(p, (float*)lds);
  grid.sync();
  phase0b(p);
  GBAR();
  for (int l = 0; l < DEPTH; ++l) {
    phase_gemm1(p, l, lds);
    GBAR();
    ssm_endstates(p, l, lds);
    phase_compress(p, l, lds);
    GBAR();
    phase_nsa(p, l, lds);
    phase_swa(p, l, lds);
    ssm_outputs(p, l, lds);
    GBAR();
    phase_glu(p, l, lds);
    GBAR();
    phase_wout(p, l, lds);
    GBAR();
    phase_up(p, l, lds);
    GBAR();
    phase_down(p, l, lds);
    GBAR();
  }
}

extern "C" void kernel_launch(void* const* d_in, const int* in_sizes, int n_in, void* d_out, int out_size, void* d_ws,
                              size_t ws_size, hipStream_t stream) {
  static int grid_blocks = 0;
  if (!grid_blocks) {
    int dev = 0, cus = 0, per_cu = 0;
    (void)hipGetDevice(&dev);
    (void)hipDeviceGetAttribute(&cus, hipDeviceAttributeMultiprocessorCount, dev);
    (void)hipOccupancyMaxActiveBlocksPerMultiprocessor(&per_cu, fwd_megakernel, NT, 0);
    if (per_cu > 1) per_cu = 1;
    grid_blocks = cus * per_cu;
  }
  if (ws_size < WS_NEED) {
    fprintf(stderr, "workspace too small: %zu < %zu\n", ws_size, WS_NEED);
    return;
  }
  Params p{};
  for (int i = 0; i < 24; ++i) p.in[i] = (const float*)d_in[i];
  p.out = (float*)d_out;
  p.ws = (char*)d_ws;
  (void)hipMemsetAsync((char*)d_ws + O_BAR, 0, SZ_BAR, stream);
  void* args[] = {&p};
  hipError_t e = hipLaunchCooperativeKernel((void*)fwd_megakernel, dim3(grid_blocks), dim3(NT), args, 0, stream);
  if (e != hipSuccess) fprintf(stderr, "cooperative launch failed: %s (grid %d)\n", hipGetErrorString(e), grid_blocks);
}
```

```cpp
#include <hip/hip_runtime.h>
#include <hip/hip_cooperative_groups.h>
#include <cstdio>
namespace cg = cooperative_groups;

typedef _Float16 h16;
typedef __attribute__((ext_vector_type(8))) _Float16 h16x8;
typedef __attribute__((ext_vector_type(4))) float f32x4;

constexpr int NT = 512;
constexpr int NW = NT / 64;
constexpr int BATCH = 4, SEQ = 8192, NTOK = BATCH * SEQ, DM = 1024, DEPTH = 4, IW = 1676, IWP = 1792, DFF = 4096;
constexpr int OFF_U = 512, OFF_QC = 1024, OFF_KVC = 1280, OFF_GC = 1664;
constexpr int NCMP = 511;
constexpr float EPS = 1e-6f;

constexpr size_t SZ_WIN = (size_t)IWP * DM * 2, SZ_WGLU = (size_t)1024 * 512 * 2, SZ_WOUT = (size_t)DM * DM * 2,
                 SZ_WUP = (size_t)DFF * DM * 2, SZ_WDN = (size_t)DM * DFF * 2;
constexpr size_t O_WIN = 0;
constexpr size_t O_WGLU = O_WIN + DEPTH * SZ_WIN;
constexpr size_t O_WOUT = O_WGLU + DEPTH * SZ_WGLU;
constexpr size_t O_WUP = O_WOUT + DEPTH * SZ_WOUT;
constexpr size_t O_WDN = O_WUP + DEPTH * SZ_WUP;
constexpr size_t O_XB = O_WDN + DEPTH * SZ_WDN;
constexpr size_t O_SSQ = O_XB + (size_t)NTOK * DM * 2;
constexpr size_t O_SSQB = O_SSQ + (size_t)NTOK * 16 * 4;
constexpr size_t O_KCMP = O_SSQB + (size_t)NTOK * 16 * 4;
constexpr size_t O_VCMP = O_KCMP + (size_t)BATCH * 512 * 64 * 4;
constexpr size_t O_ABAR = O_VCMP + (size_t)BATCH * 512 * 64 * 4;
constexpr size_t O_BBAR = O_ABAR + (size_t)DEPTH * 32 * 64 * 8;
constexpr size_t O_BIAS1 = O_BBAR + (size_t)DEPTH * 32 * 64 * 16 * 8;
constexpr size_t O_LUT = O_BIAS1 + (size_t)DEPTH * 2 * 128 * 4;
constexpr size_t O_AT = O_LUT + 8192 * 4;
constexpr size_t O_KTAB = O_AT + (size_t)128 * 64 * 8;
constexpr size_t SZ_KTAB = (size_t)65 * 256 * 2;
constexpr size_t O_W1 = O_KTAB + 128 * SZ_KTAB;
constexpr size_t SZ_W13 = (size_t)128 * 1024 * 2;
constexpr size_t O_W3 = O_W1 + 128 * SZ_W13;
constexpr size_t O_W1T = O_W3 + 128 * SZ_W13;
constexpr size_t O_W2T = O_W1T + (size_t)8 * 128 * 2048 * 2;
constexpr size_t O_B1P = O_W2T + (size_t)8 * 64 * 128 * 2;
constexpr size_t O_BAR = (O_B1P + (size_t)8 * 32 * 128 * 4 + 255) / 256 * 256;
constexpr size_t SZ_BAR = 3456 * 4;
constexpr size_t O_BIG = (O_BAR + SZ_BAR + 255) / 256 * 256;
constexpr size_t O_APOW = O_BIG;
constexpr size_t O_P = O_BIG;
constexpr size_t O_Z = O_P + (size_t)NTOK * IWP * 2;
constexpr size_t O_OB = O_Z + (size_t)NTOK * 512 * 2;
constexpr size_t O_OAC = O_OB + (size_t)512 * 2;
constexpr size_t O_E = O_OB + (size_t)NTOK * 1024 * 2;
constexpr size_t O_HID = O_BIG;
constexpr size_t WS_NEED = O_BIG + (size_t)NTOK * DFF * 2;

struct Params {
  const float* in[24];
  float* out;
  char* ws;
};

__device__ __forceinline__ char* WS(const Params& p) {
  int z;
  asm volatile("s_mov_b32 %0, 0" : "=s"(z));
  return p.ws + z;
}
__device__ __forceinline__ int opaque_tid() {
  int t = threadIdx.x;
  asm volatile("" : "+v"(t));
  return t;
}
template <int CTRL>
__device__ __forceinline__ float dppf(float v) {
  return __int_as_float(__builtin_amdgcn_update_dpp(0, __float_as_int(v), CTRL, 0xF, 0xF, true));
}
__device__ __forceinline__ float sum16(float v) {
  v += dppf<0xB1>(v); v += dppf<0x4E>(v); v += dppf<0x141>(v); v += dppf<0x140>(v);
  return v;
}
__device__ __forceinline__ float max16(float v) {
  v = fmaxf(v, dppf<0xB1>(v)); v = fmaxf(v, dppf<0x4E>(v)); v = fmaxf(v, dppf<0x141>(v)); v = fmaxf(v, dppf<0x140>(v));
  return v;
}
__device__ __forceinline__ float xor16(float v) { return __int_as_float(__builtin_amdgcn_ds_swizzle(__float_as_int(v), 0x401F)); }
__device__ __forceinline__ float rdlane_c(float v, int l) { return __int_as_float(__builtin_amdgcn_readlane(__float_as_int(v), l)); }
__device__ __forceinline__ float wave_sum(float v) {
  v = sum16(v); v += xor16(v);
  return rdlane_c(v, 0) + rdlane_c(v, 32);
}
__device__ __forceinline__ float gelu_tanh(float x) {
  float u = 0.7978845608028654f * (x + 0.044715f * x * x * x);
  return 0.5f * x * (1.f + tanhf(u));
}
__device__ __forceinline__ float sigmoidf(float x) { return 1.f / (1.f + __expf(-x)); }
__device__ __forceinline__ float rdlane(float v, int l) {
  return __int_as_float(__builtin_amdgcn_readlane(__float_as_int(v), l));
}

__device__ __forceinline__ int perm32(int rho) { return 8 * ((rho & 15) >> 2) + 4 * (rho >> 4) + (rho & 3); }

template <class SrcF>
__device__ __forceinline__ void conv_tile(SrcF src, h16* dst, int ldo, int n0, int k0, float* tile) {
  int tid = opaque_tid();
  for (int idx = tid; idx < 4096; idx += NT) {
    int kk = idx >> 6, nn = idx & 63;
    tile[kk * 65 + nn] = src(k0 + kk, n0 + nn);
  }
  __syncthreads();
  for (int idx = tid; idx < 4096; idx += NT) {
    int nn = idx >> 6, kk = idx & 63;
    dst[(long)(n0 + nn) * ldo + k0 + kk] = (h16)tile[kk * 65 + nn];
  }
  __syncthreads();
}

__device__ __forceinline__ void phase0(const Params& p, float* lds) {
  const int tid = opaque_tid();
  constexpr int T_IN = (IWP / 64) * (DM / 64);
  constexpr int T_GLU = 16 * 8;
  constexpr int T_OUT = 16 * 16;
  constexpr int T_UP = 64 * 16;
  constexpr int T_DN = 16 * 64;
  constexpr int T_L = T_IN + T_GLU + T_OUT + T_UP + T_DN;
  for (int ti = blockIdx.x; ti < DEPTH * T_L; ti += gridDim.x) {
    int l = ti / T_L, r = ti % T_L;
    if (r < T_IN) {
      int nt = r / 16, kt = r % 16;
      const float* w = p.in[2] + (size_t)l * DM * IW;
      const float* g = p.in[1] + l * DM;
      conv_tile([&](int k, int sl) {
        int n = (sl & ~255) + 64 * ((sl >> 5) & 3) + 32 * ((sl >> 7) & 1) + perm32(sl & 31);
        return n < IW ? w[(long)k * IW + n] * g[k] : 0.f; },
                (h16*)(WS(p) + O_WIN + l * SZ_WIN), DM, nt * 64, kt * 64, lds);
    } else if ((r -= T_IN) < T_GLU) {
      int nt = r / 8, kt = r % 8;
      const float* w = p.in[14] + (size_t)l * 512 * 1024;
      conv_tile([&](int k, int n2) {
        int pn = n2 >> 8, bj = (n2 >> 7) & 1, wc = (n2 >> 5) & 3, nn = (n2 >> 4) & 1, r = n2 & 15;
        int n = (nn ? 512 : 0) + 128 * pn + 64 * bj + 16 * wc + r;
        return w[(long)k * 1024 + n]; },
                (h16*)(WS(p) + O_WGLU + l * SZ_WGLU), 512, nt * 64, kt * 64, lds);
    } else if ((r -= T_GLU) < T_OUT) {
      int nt = r / 16, kt = r % 16;
      const float* w = p.in[20] + (size_t)l * DM * DM;
      const float* g = p.in[19] + l * DM;
      conv_tile([&](int k2, int n2) {
        int k = k2 < 512 ? 256 + k2 : (k2 < 768 ? k2 - 512 : k2);
        int n = (n2 & ~31) + perm32(n2 & 31);
        return w[(long)k * DM + n] * g[k]; },
                (h16*)(WS(p) + O_WOUT + l * SZ_WOUT), DM, nt * 64, kt * 64, lds);
    } else if ((r -= T_OUT) < T_UP) {
      int nt = r / 16, kt = r % 16;
      const float* w = p.in[22] + (size_t)l * DM * DFF;
      const float* g = p.in[21] + l * DM;
      conv_tile([&](int k, int n2) { int n = (n2 & ~31) + perm32(n2 & 31); return w[(long)k * DFF + n] * g[k]; },
                (h16*)(WS(p) + O_WUP + l * SZ_WUP), DM, nt * 64, kt * 64, lds);
    } else {
      r -= T_UP;
      int nt = r / 64, kt = r % 64;
      const float* w = p.in[23] + (size_t)l * DFF * DM;
      conv_tile([&](int k, int n2) { int n = (n2 & ~31) + perm32(n2 & 31); return w[(long)k * DM + n]; },
                (h16*)(WS(p) + O_WDN + l * SZ_WDN), DFF, nt * 64, kt * 64, lds);
    }
  }
  for (int ti = blockIdx.x; ti < 8 * 66; ti += gridDim.x) {
    int ls = ti / 66, r = ti % 66;
    if (r < 64) {
      int nt = r >> 5, kt = r & 31;
      const float* w = p.in[17] + (size_t)ls * 2048 * 128;
      conv_tile([&](int k, int n) { return w[(long)k * 128 + n]; }, (h16*)(WS(p) + O_W1T) + (size_t)ls * 128 * 2048, 2048, nt * 64, kt * 64, lds);
    } else {
      int kt = r - 64;
      const float* w = p.in[18] + (size_t)ls * 128 * 64;
      conv_tile([&](int k, int n) { return w[(long)k * 64 + n]; }, (h16*)(WS(p) + O_W2T) + (size_t)ls * 64 * 128, 128, 0, kt * 64, lds);
    }
  }
  {
    const int lane = tid & 63;
    const int gw = blockIdx.x * NW + (tid >> 6), nw = gridDim.x * NW;
    const float* x = p.in[0];
    h16* xb = (h16*)(WS(p) + O_XB);
    float* ssq = (float*)(WS(p) + O_SSQ);
    for (int row = gw; row < NTOK; row += nw) {
      const float4* xr = (const float4*)(x + (long)row * DM + lane * 16);
      float s = 0.f;
      h16 hv[16];
      for (int i = 0; i < 4; ++i) {
        float4 v = xr[i];
        s += v.x * v.x + v.y * v.y + v.z * v.z + v.w * v.w;
        hv[i * 4 + 0] = (h16)v.x; hv[i * 4 + 1] = (h16)v.y; hv[i * 4 + 2] = (h16)v.z; hv[i * 4 + 3] = (h16)v.w;
      }
      h16x8* xo = (h16x8*)(xb + (long)row * DM + lane * 16);
      h16x8 o0, o1;
      for (int i = 0; i < 8; ++i) { o0[i] = hv[i]; o1[i] = hv[8 + i]; }
      xo[0] = o0; xo[1] = o1;
      s += dppf<0xB1>(s);
      s += dppf<0x4E>(s);
      if ((lane & 3) == 0) ssq[(long)row * 16 + (lane >> 2)] = s;
    }
  }
  const int gt = blockIdx.x * NT + tid, ngt = gridDim.x * NT;
  for (int i = gt; i < DEPTH * 32 * 64; i += ngt) {
    int l = i / 2048, g = (i / 64) % 32;
    double are = p.in[6][i], aim = p.in[7][i];
    double dt = exp((double)p.in[8][l * 32 + g]);
    double er = exp(are * dt), abr = er * cos(aim * dt), abi = er * sin(aim * dt);
    ((float2*)(WS(p) + O_ABAR))[i] = make_float2((float)abr, (float)abi);
    double nr = abr - 1.0, ni = abi, den = are * are + aim * aim;
    double fr = (nr * are + ni * aim) / den, fi = (ni * are - nr * aim) / den;
    float2* bb = (float2*)(WS(p) + O_BBAR) + (size_t)i * 16;
    for (int q = 0; q < 16; ++q) {
      double br = p.in[9][(size_t)i * 16 + q], bi = p.in[10][(size_t)i * 16 + q];
      bb[q] = make_float2((float)((fr * br - fi * bi) / dt), (float)((fr * bi + fi * br) / dt));
    }
  }
  for (int i = gt; i < 128 * 65 * 64; i += ngt) {
    int n = i & 63, j = (i >> 6) % 65, lg = i / (65 * 64);
    double are = p.in[6][lg * 64 + n], aim = p.in[7][lg * 64 + n];
    double dt = exp((double)p.in[8][lg]);
    double er = exp(are * dt * j), ang = aim * dt * j;
    ((double2*)(WS(p) + O_APOW))[i] = make_double2(er * cos(ang), er * sin(ang));
  }
  for (int i = gt; i < DEPTH * 2 * 128 * 32; i += ngt) {
    int j = i & 127, kc = (i >> 7) & 31, ls = i >> 12;
    const float* pos = p.in[16] + (size_t)ls * 2048 + kc * 64;
    const float* w1 = p.in[17] + ((size_t)ls * 2048 + kc * 64) * 128;
    float a = 0.f;
#pragma unroll 16
    for (int k = 0; k < 64; ++k) a += pos[k] * w1[(long)k * 128 + j];
    ((float*)(WS(p) + O_B1P))[i] = a;
  }
  for (int d = gt; d < 8192; d += ngt) {
    int bk;
    if (d < 16) bk = d;
    else {
      float nf = (float)d;
      int large = 16 + (int)(logf(nf / 16.0f) / 4.1588830833596715f * 16.0f);
      bk = large < 31 ? large : 31;
    }
    ((int*)(WS(p) + O_LUT))[d] = bk;
  }
}

__device__ __forceinline__ void phase0b(const Params& p) {
  const int gt = blockIdx.x * NT + threadIdx.x, ngt = gridDim.x * NT;
  const double2* apow = (const double2*)(WS(p) + O_APOW);
  const float2* bbs = (const float2*)(WS(p) + O_BBAR);
  for (int i = gt; i < 128 * 64 * 64; i += ngt) {
    int tau = i & 63, n = (i >> 6) & 63, lg = i >> 12;
    double2 ap = apow[(lg * 65 + (63 - tau)) * 64 + n];
    const float2* bb = bbs + (size_t)(lg * 64 + n) * 16;
    h16x8 re0, re1, im0, im1;
#pragma unroll
    for (int q = 0; q < 8; ++q) {
      float2 b0 = bb[q], b1 = bb[8 + q];
      re0[q] = (h16)(float)(ap.x * b0.x - ap.y * b0.y);
      im0[q] = (h16)(float)(ap.x * b0.y + ap.y * b0.x);
      re1[q] = (h16)(float)(ap.x * b1.x - ap.y * b1.y);
      im1[q] = (h16)(float)(ap.x * b1.y + ap.y * b1.x);
    }
    h16* W1 = (h16*)(WS(p) + O_W1 + (size_t)lg * SZ_W13);
    *(h16x8*)(W1 + ((size_t)(2 * tau) * 128 + 2 * n) * 8) = re0;
    *(h16x8*)(W1 + ((size_t)(2 * tau) * 128 + 2 * n + 1) * 8) = im0;
    *(h16x8*)(W1 + ((size_t)(2 * tau + 1) * 128 + 2 * n) * 8) = re1;
    *(h16x8*)(W1 + ((size_t)(2 * tau + 1) * 128 + 2 * n + 1) * 8) = im1;
  }
  for (int i = gt; i < 128 * 64 * 16 * 16; i += ngt) {
    int pp = i & 15, kc = (i >> 4) & 15, tau = (i >> 8) & 63, lg = i >> 14;
    h16x8 v;
#pragma unroll
    for (int e = 0; e < 4; ++e) {
      int n = 4 * kc + e;
      double2 ap = apow[(lg * 65 + tau + 1) * 64 + n];
      double cr = p.in[11][((size_t)lg * 16 + pp) * 64 + n], ci = p.in[12][((size_t)lg * 16 + pp) * 64 + n];
      v[2 * e] = (h16)(float)(cr * ap.x - ci * ap.y);
      v[2 * e + 1] = (h16)(float)(-(cr * ap.y + ci * ap.x));
    }
    h16* W3 = (h16*)(WS(p) + O_W3 + (size_t)lg * SZ_W13);
    *(h16x8*)(W3 + ((size_t)((tau * 16 + kc) * 16) + pp) * 8) = v;
  }
  for (int i = gt; i < 128 * 65 * 16; i += ngt) {
    int pp = i & 15, slot = (i >> 4) % 65, lg = i / (65 * 16);
    float acc[16];
#pragma unroll
    for (int q = 0; q < 16; ++q) acc[q] = 0.f;
    if (slot > 0) {
      for (int n = 0; n < 64; ++n) {
        double2 ap = apow[(lg * 65 + slot - 1) * 64 + n];
        double cr = p.in[11][((size_t)lg * 16 + pp) * 64 + n], ci = p.in[12][((size_t)lg * 16 + pp) * 64 + n];
        float xr = (float)(cr * ap.x - ci * ap.y), xi = (float)(cr * ap.y + ci * ap.x);
        const float2* bb = bbs + (size_t)(lg * 64 + n) * 16;
#pragma unroll
        for (int q = 0; q < 16; ++q) { float2 b = bb[q]; acc[q] += xr * b.x - xi * b.y; }
      }
    }
    h16x8 v0, v1;
#pragma unroll
    for (int q = 0; q < 8; ++q) { v0[q] = (h16)acc[q]; v1[q] = (h16)acc[8 + q]; }
    h16* kt = (h16*)(WS(p) + O_KTAB + (size_t)lg * SZ_KTAB) + slot * 256 + pp * 16;
    *(h16x8*)kt = v0;
    *(h16x8*)(kt + 8) = v1;
  }
  for (int i = gt; i < 128 * 64; i += ngt) {
    double2 ap = apow[((i >> 6) * 65 + 64) * 64 + (i & 63)];
    ((float2*)(WS(p) + O_AT))[i] = make_float2((float)ap.x, (float)ap.y);
  }
  for (int i = gt; i < DEPTH * 2 * 128; i += ngt) {
    const float* pp = (const float*)(WS(p) + O_B1P) + (size_t)(i >> 7) * 32 * 128 + (i & 127);
    float a = 0.f;
    for (int kc = 0; kc < 32; ++kc) a += pp[kc * 128];
    ((float*)(WS(p) + O_BIAS1))[i] = a;
  }
}

__device__ __forceinline__ void ssm_endstates(const Params& p, int l, char* lds) {
  const int tid = opaque_tid(), lane = tid & 63, w = tid >> 6;
  const h16* P = (const h16*)(WS(p) + O_P);
  float* E = (float*)(WS(p) + O_E);
  f32x4* red = (f32x4*)lds;
  for (int ub4 = blockIdx.x; ub4 < 256; ub4 += gridDim.x) {
    const int unit = ub4 * 4 + (w & 3), kh = w >> 2;
    const int g = unit >> 5, ctile = unit & 31;
    const h16* W1 = (const h16*)(WS(p) + O_W1 + (size_t)(l * 32 + g) * SZ_W13);
    const int gch = ctile * 16 + (lane & 15);
    const h16* ub = P + (size_t)gch * 64 * IWP + OFF_U + g * 16 + ((lane >> 4) & 1) * 8 + (size_t)(lane >> 5) * IWP;
    f32x4 acc[8];
#pragma unroll
    for (int mt = 0; mt < 8; ++mt) acc[mt] = f32x4{0.f, 0.f, 0.f, 0.f};
#pragma unroll 4
    for (int kk = 0; kk < 16; ++kk) {
      const int ks = kh * 16 + kk;
      h16x8 B = *(const h16x8*)(ub + (size_t)(ks * 2) * IWP);
#pragma unroll
      for (int mt = 0; mt < 8; ++mt) {
        h16x8 A = *(const h16x8*)(W1 + ((size_t)(ks * 4 + (lane >> 4)) * 128 + mt * 16 + (lane & 15)) * 8);
        acc[mt] = __builtin_amdgcn_mfma_f32_16x16x32_f16(A, B, acc[mt], 0, 0, 0);
      }
    }
    __syncthreads();
    if (kh == 1) {
#pragma unroll
      for (int mt = 0; mt < 8; ++mt) red[((w & 3) * 8 + mt) * 64 + lane] = acc[mt];
    }
    __syncthreads();
    if (kh == 0) {
#pragma unroll
      for (int mt = 0; mt < 8; ++mt)
        *(f32x4*)(E + ((size_t)gch * 32 + g) * 128 + mt * 16 + (lane >> 4) * 4) = acc[mt] + red[((w & 3) * 8 + mt) * 64 + lane];
    }
  }
}

constexpr int BU_PITCH = 1040, BS_PITCH = 144;
constexpr int SSMY_LDS = 65 * 512 + 16 * BU_PITCH * 2 + 16 * BS_PITCH * 2 + 128 * 64 * 8;
__device__ __forceinline__ void ssm_outputs(const Params& p, int l, char* lds) {
  const int tid = opaque_tid(), lane = tid & 63, w = tid >> 6;
  h16* Kt = (h16*)lds;
  h16* Bu = (h16*)(lds + 65 * 512);
  h16* Bs = (h16*)(lds + 65 * 512 + 16 * BU_PITCH * 2);
  float2* Es = (float2*)(lds + 65 * 512 + 16 * BU_PITCH * 2 + 16 * BS_PITCH * 2);
  const h16* P = (const h16*)(WS(p) + O_P);
  const float* E = (const float*)(WS(p) + O_E);
  h16* Z = (h16*)(WS(p) + O_Z);
  for (int unit = blockIdx.x; unit < 1024; unit += gridDim.x) {
    const int g = unit & 31, bc = unit >> 5, b = bc >> 3, ct = bc & 7;
    const int lg = l * 32 + g;
    __syncthreads();
    const int c0 = ct * 16;
    {
      const h16x8* ks = (const h16x8*)(WS(p) + O_KTAB + (size_t)lg * SZ_KTAB);
      for (int i = tid; i < 65 * 32; i += NT) ((h16x8*)Kt)[i] = ks[i];
      for (int i = tid; i < 2048; i += NT) {
        int tk = i >> 1, hf = i & 1;
        h16x8 v = *(const h16x8*)(P + ((size_t)b * SEQ + ct * 1024 + tk) * IWP + OFF_U + g * 16 + hf * 8);
        *(h16x8*)(Bu + (tk >> 6) * BU_PITCH + (tk & 63) * 16 + hf * 8) = v;
      }
      const float2* Eb = (const float2*)E + ((size_t)(b * 128) * 32 + g) * 64;
      for (int i = tid; i < (c0 + 16) * 64; i += NT) Es[i] = Eb[(size_t)(i >> 6) * 2048 + (i & 63)];
    }
    __syncthreads();
    if (w == 0) {
      float2 at = ((const float2*)(WS(p) + O_AT))[lg * 64 + lane];
      float sr = 0.f, si = 0.f;
#pragma unroll 8
      for (int c = 0; c < c0; ++c) {
        float2 e = Es[c * 64 + lane];
        float nr = at.x * sr - at.y * si + e.x, ni = at.x * si + at.y * sr + e.y;
        sr = nr; si = ni;
      }
#pragma unroll
      for (int i = 0; i < 16; ++i) {
        Bs[i * BS_PITCH + 2 * lane] = (h16)sr;
        Bs[i * BS_PITCH + 2 * lane + 1] = (h16)si;
        float2 e = Es[(c0 + i) * 64 + lane];
        float nr = at.x * sr - at.y * si + e.x, ni = at.x * si + at.y * sr + e.y;
        sr = nr; si = ni;
      }
    }
    __syncthreads();
    const float dt = expf(p.in[8][lg]);
    const int col = lane & 15, hi = lane >> 5, qh = (lane >> 4) & 1, p0 = (lane >> 4) * 4;
    const h16* W3 = (const h16*)(WS(p) + O_W3 + (size_t)lg * SZ_W13);
    float dsk[4];
    for (int j = 0; j < 4; ++j) dsk[j] = p.in[13][l * 512 + g * 16 + p0 + j];
    for (int r = 0; r < 64 / NW; ++r) {
      const int base = (r >> 1) * 2 * NW;
      const int tau = (r & 1) ? base + 2 * NW - 1 - w : base + w;
      f32x4 acc = {0.f, 0.f, 0.f, 0.f};
      const int nks = tau / 2 + 1;
      h16x8 A3[4];
#pragma unroll
      for (int ks = 0; ks < 4; ++ks)
        A3[ks] = *(const h16x8*)(W3 + ((size_t)((tau * 16 + ks * 4 + (lane >> 4)) * 16) + (lane & 15)) * 8);
      for (int i = 0; i < nks; ++i) {
        int j = tau - (2 * i + hi);
        h16x8 A = *(const h16x8*)(Kt + (j + 1) * 256 + (lane & 15) * 16 + qh * 8);
        h16x8 B = *(const h16x8*)(Bu + col * BU_PITCH + (2 * i + hi) * 16 + qh * 8);
        acc = __builtin_amdgcn_mfma_f32_16x16x32_f16(A, B, acc, 0, 0, 0);
      }
#pragma unroll
      for (int ks = 0; ks < 4; ++ks) {
        h16x8 B = *(const h16x8*)(Bs + col * BS_PITCH + ks * 32 + (lane >> 4) * 8);
        acc = __builtin_amdgcn_mfma_f32_16x16x32_f16(A3[ks], B, acc, 0, 0, 0);
      }
      const h16* up = Bu + col * BU_PITCH + tau * 16 + p0;
      size_t tok = ((size_t)b * 128 + ct * 16 + col) * 64 + tau;
      h16 zz[4];
      for (int j = 0; j < 4; ++j) zz[j] = (h16)gelu_tanh(dt * acc[j] + dsk[j] * (float)up[j]);
      typedef __attribute__((ext_vector_type(4))) _Float16 h16x4;
      h16x4 zv = {zz[0], zz[1], zz[2], zz[3]};
      *(h16x4*)(Z + tok * 512 + g * 16 + p0) = zv;
    }
  }
}

#define LAS __attribute__((address_space(3)))
typedef _Float16 h16x4 __attribute__((ext_vector_type(4)));
#define XB_TMO      128
#define XB_XCNT(j)  (256  + 64 * (j))
#define XB_XSUB(j)  (1280 + 64 * (j))
#define XB_XGEN(j)  (2304 + 64 * (j))
#define XB_TOP      3328
#define XB_TOPGEN   3392
#define XCD_BAR_WORDS 3456
#define XB_SPIN_CAP (1u << 18)

__device__ __forceinline__ unsigned xb_ld(unsigned* p)              { return __hip_atomic_load(p, __ATOMIC_RELAXED, __HIP_MEMORY_SCOPE_AGENT); }
__device__ __forceinline__ unsigned xb_add(unsigned* p, unsigned v) { return __hip_atomic_fetch_add(p, v, __ATOMIC_RELAXED, __HIP_MEMORY_SCOPE_AGENT); }
__device__ __forceinline__ unsigned xb_xcc_id() { return (unsigned)__builtin_amdgcn_s_getreg((3 << 11) | 20) & 0xFu; }
#define XB_SPIN(cond, bar) do { unsigned _sp = 0; while (cond) { __builtin_amdgcn_s_sleep(1); \
    if ((++_sp & 255u) == 0u) { if (xb_ld(&(bar)[XB_TMO])) break; if (_sp > XB_SPIN_CAP) { atomicAdd(&(bar)[XB_TMO], 1u); break; } } } } while (0)

struct XcdBarrier {
    unsigned* bar; unsigned x;
    volatile LAS unsigned* st;
};

__device__ __forceinline__ XcdBarrier xcd_barrier_post(unsigned* bar, volatile LAS unsigned* st) {
    XcdBarrier b; b.bar = bar; b.x = xb_xcc_id(); b.st = st;
    if (threadIdx.x == 0) (void)xb_add(&bar[XB_XCNT(b.x)], 1u);
    return b;
}
__device__ __forceinline__ void xcd_barrier_complete(unsigned* bar, unsigned x, unsigned& nloc, unsigned& nx) {
    const unsigned G = gridDim.x * gridDim.y * gridDim.z;
    unsigned sum, cnt, mine, sp = 0u;
    for (;;) {
        sum = 0u; cnt = 0u; mine = 0u;
#pragma unroll
        for (unsigned j = 0; j < 16; ++j) { const unsigned c = xb_ld(&bar[XB_XCNT(j)]); sum += c; cnt += (c > 0u) ? 1u : 0u; mine = (j == x) ? c : mine; }
        if (sum == G) break;
        __builtin_amdgcn_s_sleep(1);
        if ((++sp & 255u) == 0u) { if (xb_ld(&bar[XB_TMO])) break; if (sp > XB_SPIN_CAP) { atomicAdd(&bar[XB_TMO], 1u); break; } }
    }
    nloc = mine > 0u ? mine : 1u; nx = cnt > 0u ? cnt : 1u;
}

__device__ __forceinline__ void xcd_barrier(const XcdBarrier& b) {
    asm volatile("s_waitcnt vmcnt(0)" ::: "memory");
    __syncthreads();
    if (threadIdx.x == 0) {
        unsigned* bar = b.bar;
        __builtin_amdgcn_s_waitcnt(0);
        unsigned nloc = b.st[0], nx = b.st[1];
        if (nloc == 0u) { xcd_barrier_complete(bar, b.x, nloc, nx); b.st[0] = nloc; b.st[1] = nx; }
        const unsigned old = xb_add(&bar[XB_XSUB(b.x)], 1u);
        const unsigned gen = old / nloc;
        if (old + 1u == (gen + 1u) * nloc) {
            __builtin_amdgcn_fence(__ATOMIC_RELEASE, "agent");
            asm volatile("s_waitcnt vmcnt(0)" ::: "memory");
            const unsigned og = xb_add(&bar[XB_TOP], 1u);
            const unsigned tg = og / nx;
            if (og + 1u == (tg + 1u) * nx) xb_add(&bar[XB_TOPGEN], 1u);
            else XB_SPIN(xb_ld(&bar[XB_TOPGEN]) == tg, bar);
            __builtin_amdgcn_fence(__ATOMIC_ACQUIRE, "agent");
            xb_add(&bar[XB_XGEN(b.x)], 1u);
            asm volatile("s_waitcnt vmcnt(0)" ::: "memory");
        } else {
            XB_SPIN(xb_ld(&bar[XB_XGEN(b.x)]) == gen, bar);
            __builtin_amdgcn_fence(__ATOMIC_ACQUIRE, "agent");
            asm volatile("s_waitcnt vmcnt(0)" ::: "memory");
        }
    }
    __syncthreads();
}


namespace g8 {
constexpr int BM = 256, BK = 64, HALF = 128, HTB = HALF * BK * 2, STAGE_BYTES = 8 * HTB, NXCD = 8, WGM = 8;
__device__ __forceinline__ int lds_byte(int r, int c) {
  const int st = (r >> 4) * 2 + (c >> 5), rr = r & 15, cc = c & 31, ob = rr * 64 + cc * 2;
  return st * 1024 + (ob ^ (((ob >> 9) & 1) << 5));
}
__device__ __forceinline__ void stage_rc(int b, int& R, int& C) {
  const int st = b / 1024, sb = b % 1024, swz = sb ^ (((sb >> 9) & 1) << 5);
  R = (st >> 1) * 16 + swz / 64;
  C = (st & 1) * 32 + (swz % 64) / 2;
}
struct Unit { int pm, pn; };
struct Order {
  int nM, nN, nwg, G, c;
  __device__ void init(int M, int N, int G_, int c_) { nM = M / BM; nN = N / BM; nwg = nM * nN; G = G_; c = c_; }
  __device__ bool next(int i, Unit& u) const {
    const long L = (long)i * G + c;
    if (L >= nwg) return false;
    int wgid = (int)L;
    { const int q = nwg / NXCD, r = nwg % NXCD, xcd = wgid % NXCD, off = wgid / NXCD; wgid = (xcd < r ? xcd * (q + 1) : r * (q + 1) + (xcd - r) * q) + off; }
    const int nig = WGM * nN, gid = wgid / nig, fm = gid * WGM, gsz = (nM - fm) < WGM ? (nM - fm) : WGM;
    u.pm = fm + ((wgid % nig) % gsz);
    u.pn = (wgid % nig) / gsz;
    return true;
  }
};
template <class Epi>
__device__ __forceinline__ void gemm_phase(LAS unsigned char* lds, const h16* A, const h16* Bt, int K, const Order& S, const Epi& E) {
  const int tid = opaque_tid(), wid = __builtin_amdgcn_readfirstlane(tid >> 6), lane = tid & 63, wr = wid >> 2, wc = wid & 3, fr = lane & 15, fq = lane >> 4;
  const int nt = K / BK;
  unsigned voffA[2];
#pragma unroll
  for (int i = 0; i < 2; ++i) { int R, C; stage_rc(tid * 16 + i * 8192, R, C); voffA[i] = (unsigned)(R * K + C) * 2u; }
  const size_t kstep = (size_t)(BK * 2);
  const size_t hstep = (size_t)HALF * K * 2;
  const size_t tstep = 2 * hstep;
  const unsigned ldsw = (unsigned)wid * 1024u;
  const int aoff = lds_byte(wr * 64 + fr, fq * 8), boff = lds_byte(wc * 32 + fr, fq * 8);
#define G8_SA(b, h) (((b) * 2 + (h)) * HTB)
#define G8_SB(b, h) ((4 + (b) * 2 + (h)) * HTB)
#define G8_STAGE(bufoff, gbase) do { _Pragma("unroll") for (int _i = 0; _i < 2; ++_i) \
    __builtin_amdgcn_global_load_lds((const unsigned*)((const char*)(gbase) + voffA[_i]), (LAS unsigned*)(lds + (bufoff) + ldsw + _i * 8192), 16, 0, 0); } while (0)
#define G8_LDA(dst, b, h) do { _Pragma("unroll") for (int m = 0; m < 4; ++m) _Pragma("unroll") for (int k = 0; k < 2; ++k) dst[m][k] = *(const LAS h16x8*)(lds + G8_SA(b, h) + aoff + m * 2048 + k * 1024); } while (0)
#define G8_LDB(dst, b, h) do { _Pragma("unroll") for (int n = 0; n < 2; ++n) _Pragma("unroll") for (int k = 0; k < 2; ++k) dst[n][k] = *(const LAS h16x8*)(lds + G8_SB(b, h) + boff + n * 2048 + k * 1024); } while (0)
#define G8_MMA(ai, bj, At, Bt_) do { __builtin_amdgcn_s_setprio(1); _Pragma("unroll") for (int m = 0; m < 4; ++m) _Pragma("unroll") for (int n = 0; n < 2; ++n) _Pragma("unroll") for (int k = 0; k < 2; ++k) \
    acc[ai][bj][m][n] = __builtin_amdgcn_mfma_f32_16x16x32_f16(Bt_[n][k], At[m][k], acc[ai][bj][m][n], 0, 0, 0); __builtin_amdgcn_s_setprio(0); } while (0)
#define G8_WAIT_V(n) asm volatile("s_waitcnt vmcnt(" #n ")" ::: "memory")
#define G8_WAIT_L(n) asm volatile("s_waitcnt lgkmcnt(" #n ")" ::: "memory")
#define G8_BAR __builtin_amdgcn_s_barrier()
#define G8_SCHED __builtin_amdgcn_sched_barrier(0)
  Unit cur, nxt;
  int ui = 0;
  if (!S.next(0, cur)) return;
  f32x4 acc[2][2][4][2];
#pragma unroll
  for (int a = 0; a < 2; ++a)
#pragma unroll
    for (int b = 0; b < 2; ++b)
#pragma unroll
      for (int m = 0; m < 4; ++m)
#pragma unroll
        for (int n = 0; n < 2; ++n) acc[a][b][m][n] = (f32x4){0.f, 0.f, 0.f, 0.f};
  h16x8 At[4][2], B0[2][2], B1[2][2];
  const char* cA = (const char*)A + (size_t)cur.pm * tstep;
  const char* cB = (const char*)Bt + (size_t)cur.pn * tstep;
  G8_STAGE(G8_SB(0, 0), cB); G8_STAGE(G8_SA(0, 0), cA); G8_STAGE(G8_SB(0, 1), cB + hstep); G8_STAGE(G8_SA(0, 1), cA + hstep);
  if (wr == 1) G8_BAR;
  G8_WAIT_V(4); G8_BAR;
  G8_STAGE(G8_SB(1, 0), cB + kstep); G8_STAGE(G8_SA(1, 0), cA + kstep); G8_STAGE(G8_SB(1, 1), cB + hstep + kstep);
  G8_WAIT_V(6); G8_BAR;
  for (;;) {
    const bool has_next = S.next(ui + 1, nxt);
    const char* nA = has_next ? (const char*)A + (size_t)nxt.pm * tstep : cA;
    const char* nB = has_next ? (const char*)Bt + (size_t)nxt.pn * tstep : cB;
    for (int t = 0; t < nt; t += 2) {
      const bool last = (t == nt - 2);
      const char* a1 = cA + (size_t)(t + 1) * kstep;
      const char* a2 = last ? nA : cA + (size_t)(t + 2) * kstep;
      const char* b2 = last ? nB : cB + (size_t)(t + 2) * kstep;
      const char* a3 = a2 + kstep;
      const char* b3 = b2 + kstep;
      if (Epi::MID_T >= 0 && t == Epi::MID_T) E.mid(acc, ui, wr, fr);
      G8_LDB(B0, 0, 0); G8_SCHED; G8_LDA(At, 0, 0); G8_STAGE(G8_SA(1, 1), a1 + hstep);
      G8_WAIT_L(8); G8_BAR; G8_WAIT_L(0); G8_MMA(0, 0, At, B0); G8_BAR; G8_SCHED;
      G8_LDB(B1, 0, 1); G8_STAGE(G8_SB(0, 0), b2);
      G8_BAR; G8_WAIT_L(0); G8_MMA(0, 1, At, B1); G8_BAR;
      G8_LDA(At, 0, 1); G8_STAGE(G8_SA(0, 0), a2);
      G8_BAR; G8_WAIT_L(0); G8_MMA(1, 0, At, B0); G8_BAR; G8_SCHED;
      G8_STAGE(G8_SB(0, 1), b2 + hstep);
      G8_WAIT_V(6); G8_BAR; G8_MMA(1, 1, At, B1); G8_BAR;
      G8_LDB(B0, 1, 0); G8_SCHED; G8_LDA(At, 1, 0); G8_STAGE(G8_SA(0, 1), a2 + hstep);
      G8_WAIT_L(8); G8_BAR; G8_WAIT_L(0); G8_MMA(0, 0, At, B0); G8_BAR; G8_SCHED;
      G8_LDB(B1, 1, 1); G8_STAGE(G8_SB(1, 0), b3);
      G8_BAR; G8_WAIT_L(0); G8_MMA(0, 1, At, B1); G8_BAR;
      G8_LDA(At, 1, 1); G8_STAGE(G8_SA(1, 0), a3);
      G8_BAR; G8_WAIT_L(0); G8_MMA(1, 0, At, B0); G8_BAR; G8_SCHED;
      G8_STAGE(G8_SB(1, 1), b3 + hstep);
      G8_WAIT_V(6); G8_BAR; G8_MMA(1, 1, At, B1); G8_BAR;
    }
    E(acc, cur, ui, wr, wc, fr, fq);
    if (!has_next) break;
#pragma unroll
    for (int a = 0; a < 2; ++a)
#pragma unroll
      for (int b = 0; b < 2; ++b)
#pragma unroll
        for (int m = 0; m < 4; ++m)
#pragma unroll
          for (int n = 0; n < 2; ++n) acc[a][b][m][n] = (f32x4){0.f, 0.f, 0.f, 0.f};
    cur = nxt; cA = nA; cB = nB; ++ui;
  }
  G8_WAIT_V(0);
  if (wr == 0) G8_BAR;
  G8_BAR;
#undef G8_SA
#undef G8_SB
#undef G8_STAGE
#undef G8_LDA
#undef G8_LDB
#undef G8_MMA
#undef G8_WAIT_V
#undef G8_WAIT_L
#undef G8_BAR
#undef G8_SCHED
}
}

constexpr int RSL_OFF = g8::STAGE_BYTES;
constexpr int LDS_GEMM = g8::STAGE_BYTES + 8 * 256 * 4;

__device__ __forceinline__ void fill_rowscales(float* rsl, const float* ssq, float inv_n, const g8::Order& S) {
  const int tid = opaque_tid();
  g8::Unit u;
  __syncthreads();
  for (int i = 0; S.next(i, u); ++i) {
    if (tid < 256) {
      const float4* s4 = (const float4*)(ssq + (size_t)(u.pm * 256 + tid) * 16);
      float s = 0.f;
      for (int k = 0; k < 4; ++k) { float4 v = s4[k]; s += v.x + v.y + v.z + v.w; }
      rsl[i * 256 + tid] = rsqrtf(s * inv_n + EPS);
    }
  }
  __syncthreads();
}

__device__ __forceinline__ h16x4 pack4(float a, float b, float c, float d) { h16x4 v = {(h16)a, (h16)b, (h16)c, (h16)d}; return v; }
__device__ __forceinline__ h16x8 pack8(f32x4 a, f32x4 b) {
  h16x8 v = {(h16)a[0], (h16)a[1], (h16)a[2], (h16)a[3], (h16)b[0], (h16)b[1], (h16)b[2], (h16)b[3]};
  return v;
}

struct EpiIn {
  static constexpr int MID_T = -1;
  __device__ __forceinline__ void mid(f32x4 (&)[2][2][4][2], int, int, int) const {}
  h16* P; const float* rsl; const float* qkg;
  __device__ __forceinline__ void operator()(const f32x4 (&acc)[2][2][4][2], const g8::Unit& u, int ui, int wr, int wc, int fr, int fq) const {
    const int hs = u.pn * 4 + wc;
    int gi = -1;
    if (hs < 4) gi = 0; else if (hs < 6) gi = 1; else if (hs >= 16 && hs < 20) gi = 2; else if (hs == 22) gi = 4; else if (hs == 24) gi = 5;
    const bool gate = (hs == 26);
#pragma unroll
    for (int ai = 0; ai < 2; ++ai)
#pragma unroll
      for (int m = 0; m < 4; ++m) {
        const int rl = 128 * ai + 64 * wr + 16 * m + fr;
        float r = rsl[ui * 256 + rl];
        if (gi >= 0) {
          float ss = 0.f;
#pragma unroll
          for (int bj = 0; bj < 2; ++bj)
#pragma unroll
            for (int n = 0; n < 2; ++n)
#pragma unroll
              for (int j = 0; j < 4; ++j) ss += acc[ai][bj][m][n][j] * acc[ai][bj][m][n][j];
          ss += xor16(ss);
          ss += __shfl_xor(ss, 32);
          r *= rsqrtf(ss * r * r * (1.f / 64.f) + EPS);
        }
        h16* rowp = P + (size_t)(u.pm * 256 + rl) * IWP + 64 * hs + 8 * fq;
#pragma unroll
        for (int bj = 0; bj < 2; ++bj) {
          f32x4 v[2];
#pragma unroll
          for (int n = 0; n < 2; ++n) {
            v[n] = acc[ai][bj][m][n] * r;
            if (gi >= 0) {
              const float4 g4 = *(const float4*)(qkg + gi * 64 + 32 * bj + 8 * fq + 4 * n);
              v[n][0] *= g4.x; v[n][1] *= g4.y; v[n][2] *= g4.z; v[n][3] *= g4.w;
            } else if (gate) {
#pragma unroll
              for (int j = 0; j < 4; ++j) v[n][j] = (32 * bj + 8 * fq + 4 * n + j) < 12 ? sigmoidf(v[n][j]) : 0.f;
            }
          }
          *(h16x8*)(rowp + 32 * bj) = pack8(v[0], v[1]);
        }
      }
  }
};

struct EpiGlu {
  static constexpr int MID_T = -1;
  __device__ __forceinline__ void mid(f32x4 (&)[2][2][4][2], int, int, int) const {}
  h16* OB; float* ssqb; const float* gb;
  __device__ __forceinline__ void operator()(const f32x4 (&acc)[2][2][4][2], const g8::Unit& u, int ui, int wr, int wc, int fr, int fq) const {
    const int ocb = 128 * u.pn + 16 * wc + 4 * fq;
    float4 ba[2], bb[2];
#pragma unroll
    for (int bj = 0; bj < 2; ++bj) { ba[bj] = *(const float4*)(gb + ocb + 64 * bj); bb[bj] = *(const float4*)(gb + 512 + ocb + 64 * bj); }
#pragma unroll
    for (int ai = 0; ai < 2; ++ai)
#pragma unroll
      for (int m = 0; m < 4; ++m) {
        const size_t row = (size_t)u.pm * 256 + 128 * ai + 64 * wr + 16 * m + fr;
        float ss = 0.f;
#pragma unroll
        for (int bj = 0; bj < 2; ++bj) {
          const f32x4 a = acc[ai][bj][m][0], b = acc[ai][bj][m][1];
          float o0 = (a[0] + ba[bj].x) * sigmoidf(b[0] + bb[bj].x);
          float o1 = (a[1] + ba[bj].y) * sigmoidf(b[1] + bb[bj].y);
          float o2 = (a[2] + ba[bj].z) * sigmoidf(b[2] + bb[bj].z);
          float o3 = (a[3] + ba[bj].w) * sigmoidf(b[3] + bb[bj].w);
          *(h16x4*)(OB + row * 1024 + ocb + 64 * bj) = pack4(o0, o1, o2, o3);
          ss += o0 * o0 + o1 * o1 + o2 * o2 + o3 * o3;
        }
        ss += xor16(ss);
        ss += __shfl_xor(ss, 32);
        if (fq == 0) ssqb[row * 16 + u.pn * 4 + wc] = ss;
      }
  }
};

struct EpiRes {
  static constexpr int MID_T = -1;
  __device__ __forceinline__ void mid(f32x4 (&)[2][2][4][2], int, int, int) const {}
  float* xo; h16* xb; float* ssq; bool final_out;
  __device__ __forceinline__ void operator()(const f32x4 (&acc)[2][2][4][2], const g8::Unit& u, int ui, int wr, int wc, int fr, int fq) const {
#pragma unroll
    for (int ai = 0; ai < 2; ++ai)
#pragma unroll
      for (int m = 0; m < 4; ++m) {
        const size_t row = (size_t)u.pm * 256 + 128 * ai + 64 * wr + 16 * m + fr;
        const size_t base = row * DM + 256 * u.pn + 32 * wc + 8 * fq;
        float ss = 0.f;
#pragma unroll
        for (int bj = 0; bj < 2; ++bj) {
          const size_t idx = base + 128 * bj;
          const h16x8 xv = *(const h16x8*)(xb + idx);
          f32x4 x0 = acc[ai][bj][m][0], x1 = acc[ai][bj][m][1];
#pragma unroll
          for (int j = 0; j < 4; ++j) { x0[j] += (float)xv[j]; x1[j] += (float)xv[4 + j]; ss += x0[j] * x0[j] + x1[j] * x1[j]; }
          if (final_out) {
            *(float4*)(xo + idx) = make_float4(x0[0], x0[1], x0[2], x0[3]);
            *(float4*)(xo + idx + 4) = make_float4(x1[0], x1[1], x1[2], x1[3]);
          } else {
            *(h16x8*)(xb + idx) = pack8(x0, x1);
          }
        }
        ss += xor16(ss);
        ss += __shfl_xor(ss, 32);
        if (fq == 0) ssq[row * 16 + u.pn * 4 + wc] = ss;
      }
  }
};

struct EpiOut : EpiRes {
  static constexpr int MID_T = 8;
  const float* rsl;
  __device__ __forceinline__ void mid(f32x4 (&acc)[2][2][4][2], int ui, int wr, int fr) const {
#pragma unroll
    for (int ai = 0; ai < 2; ++ai)
#pragma unroll
      for (int m = 0; m < 4; ++m) {
        const float r = rsl[ui * 256 + 128 * ai + 64 * wr + 16 * m + fr];
#pragma unroll
        for (int bj = 0; bj < 2; ++bj)
#pragma unroll
          for (int n = 0; n < 2; ++n) acc[ai][bj][m][n] *= r;
      }
  }
};

struct EpiUp {
  static constexpr int MID_T = -1;
  __device__ __forceinline__ void mid(f32x4 (&)[2][2][4][2], int, int, int) const {}
  h16* hid; const float* rsl;
  __device__ __forceinline__ void operator()(const f32x4 (&acc)[2][2][4][2], const g8::Unit& u, int ui, int wr, int wc, int fr, int fq) const {
#pragma unroll
    for (int ai = 0; ai < 2; ++ai)
#pragma unroll
      for (int m = 0; m < 4; ++m) {
        const int rl = 128 * ai + 64 * wr + 16 * m + fr;
        const float r = rsl[ui * 256 + rl];
        h16* rowp = hid + (size_t)(u.pm * 256 + rl) * DFF + 256 * u.pn + 32 * wc + 8 * fq;
#pragma unroll
        for (int bj = 0; bj < 2; ++bj) {
          f32x4 v[2];
#pragma unroll
          for (int n = 0; n < 2; ++n) {
            v[n] = acc[ai][bj][m][n] * r;
#pragma unroll
            for (int j = 0; j < 4; ++j) { const float t = fmaxf(v[n][j], 0.f); v[n][j] = t * t; }
          }
          *(h16x8*)(rowp + 128 * bj) = pack8(v[0], v[1]);
        }
      }
  }
};

__device__ __forceinline__ void phase_gemm1(const Params& p, int l, char* lds) {
  g8::Order S; S.init(NTOK, IWP, gridDim.x, blockIdx.x);
  float* rsl = (float*)(lds + RSL_OFF);
  fill_rowscales(rsl, (const float*)(WS(p) + O_SSQ), 1.f / DM, S);
  EpiIn E{(h16*)(WS(p) + O_P), rsl, p.in[3] + l * 6 * 64};
  g8::gemm_phase((LAS unsigned char*)lds, (const h16*)(WS(p) + O_XB), (const h16*)(WS(p) + O_WIN + l * SZ_WIN), DM, S, E);
}
__device__ __forceinline__ void phase_glu(const Params& p, int l, char* lds) {
  g8::Order S; S.init(NTOK, 1024, gridDim.x, blockIdx.x);
  __syncthreads();
  EpiGlu E{(h16*)(WS(p) + O_OB), (float*)(WS(p) + O_SSQB), p.in[15] + l * 1024};
  g8::gemm_phase((LAS unsigned char*)lds, (const h16*)(WS(p) + O_Z), (const h16*)(WS(p) + O_WGLU + l * SZ_WGLU), 512, S, E);
}
__device__ __forceinline__ void phase_wout(const Params& p, int l, char* lds) {
  g8::Order S; S.init(NTOK, DM, gridDim.x, blockIdx.x);
  float* rsl = (float*)(lds + RSL_OFF);
  fill_rowscales(rsl, (const float*)(WS(p) + O_SSQB), 1.f / 512.f, S);
  EpiOut E;
  E.xo = p.out; E.xb = (h16*)(WS(p) + O_XB); E.ssq = (float*)(WS(p) + O_SSQ); E.final_out = false; E.rsl = rsl;
  g8::gemm_phase((LAS unsigned char*)lds, (const h16*)(WS(p) + O_OB), (const h16*)(WS(p) + O_WOUT + l * SZ_WOUT), DM, S, E);
}
__device__ __forceinline__ void phase_up(const Params& p, int l, char* lds) {
  g8::Order S; S.init(NTOK, DFF, gridDim.x, blockIdx.x);
  float* rsl = (float*)(lds + RSL_OFF);
  fill_rowscales(rsl, (const float*)(WS(p) + O_SSQ), 1.f / DM, S);
  EpiUp E{(h16*)(WS(p) + O_HID), rsl};
  g8::gemm_phase((LAS unsigned char*)lds, (const h16*)(WS(p) + O_XB), (const h16*)(WS(p) + O_WUP + l * SZ_WUP), DM, S, E);
}
__device__ __forceinline__ void phase_down(const Params& p, int l, char* lds) {
  g8::Order S; S.init(NTOK, DM, gridDim.x, blockIdx.x);
  __syncthreads();
  EpiRes E{p.out, (h16*)(WS(p) + O_XB), (float*)(WS(p) + O_SSQ), l == DEPTH - 1};
  g8::gemm_phase((LAS unsigned char*)lds, (const h16*)(WS(p) + O_HID), (const h16*)(WS(p) + O_WDN + l * SZ_WDN), DFF, S, E);
}

constexpr int KP = 80;
enum { M_SWA = 0, M_WIN = 1, M_SEL = 2, M_CMPA = 3, M_CMPB = 4 };
constexpr float LOG2E = 1.4426950408889634f, SCL2 = 0.125f * LOG2E;
struct ColState { float m, l; };
typedef short s16x4v __attribute__((__vector_size__(8)));

__device__ __forceinline__ h16x8 ld_row8(const h16* base, int ld, int row, int nrows, int c8) {
  h16x8 z = {0, 0, 0, 0, 0, 0, 0, 0};
  return (row >= 0 && row < nrows) ? *(const h16x8*)(base + (size_t)row * ld + c8 * 8) : z;
}
__device__ __forceinline__ void st_k(h16* Ks, int row, int c8, h16x8 v) { *(h16x8*)(Ks + row * KP + c8 * 8) = v; }
__device__ __forceinline__ void st_vt(h16* Vt, int row, int c8, h16x8 v) {
#pragma unroll
  for (int e = 0; e < 8; ++e) Vt[(c8 * 8 + e) * KP + row] = v[e];
}
__device__ __forceinline__ float max4q(float v) {
  v = fmaxf(v, xor16(v));
  auto r = __builtin_amdgcn_permlane32_swap(__float_as_int(v), __float_as_int(v), false, false);
  return fmaxf(__int_as_float(r[0]), __int_as_float(r[1]));
}
__device__ __forceinline__ float sum4q(float v) {
  v += xor16(v);
  auto r = __builtin_amdgcn_permlane32_swap(__float_as_int(v), __float_as_int(v), false, false);
  return __int_as_float(r[0]) + __int_as_float(r[1]);
}
__device__ __forceinline__ float quadsum(float v) { v += dppf<0xB1>(v); v += dppf<0x4E>(v); return v; }

template <int MODE, int RGM>
__device__ __forceinline__ void attn_tile(const h16x8 (&Q)[2][2], f32x4 (&O)[2][4], ColState (&st)[2], const h16* Ks,
                                          const h16* Vt, const float* biasT, const int (&tq)[2], int hd, int kbase, bool far,
                                          const bool (&selbit)[2], float (&hq)[2][4], float (&h3)[2][4], const int lane) {
  const int col = lane & 15, q4 = lane >> 4;
  constexpr int DK = (MODE == M_CMPA || MODE == M_CMPB) ? 16 : 1;
  f32x4 S[2][4];
#pragma unroll
  for (int kt = 0; kt < 4; ++kt) {
#pragma unroll
    for (int rg = 0; rg < 2; ++rg) S[rg][kt] = f32x4{0.f, 0.f, 0.f, 0.f};
#pragma unroll
    for (int ks = 0; ks < 2; ++ks) {
      h16x8 Kf = *(const h16x8*)(Ks + (kt * 16 + col) * KP + ks * 32 + q4 * 8);
#pragma unroll
      for (int rg = 0; rg < 2; ++rg)
        if (RGM & (1 << rg)) S[rg][kt] = __builtin_amdgcn_mfma_f32_16x16x32_f16(Kf, Q[rg][ks], S[rg][kt], 0, 0, 0);
    }
  }
  h16x8 Pf[2][2];
#pragma unroll
  for (int rg = 0; rg < 2; ++rg) {
    if (!(RGM & (1 << rg))) continue;
    const float* bt = biasT + hd * 800;
    if (far) {
      const float b31 = bt[799];
      const bool ok = (MODE == M_SEL) ? selbit[rg] : true;
#pragma unroll
      for (int kt = 0; kt < 4; ++kt)
#pragma unroll
        for (int j = 0; j < 4; ++j) S[rg][kt][j] = ok ? S[rg][kt][j] * SCL2 + b31 : -1e30f;
    } else {
      const int kx0 = kbase + q4 * 4;
      const int d0 = (DK == 16) ? tq[rg] - 31 - 16 * kx0 : tq[rg] - kx0;
#pragma unroll
      for (int kt = 0; kt < 4; ++kt)
#pragma unroll
        for (int j = 0; j < 4; ++j) {
          const int dist = d0 - DK * (kt * 16 + j);
          const int kx = kx0 + kt * 16 + j;
          bool valid = dist >= 0;
          if (MODE == M_SWA) valid = valid && dist < 128 && kx >= 0;
          if (MODE == M_WIN) valid = valid && dist < 512 && kx >= 0;
          if (MODE == M_SEL) valid = valid && selbit[rg];
          if (DK == 16) valid = valid && kx < NCMP;
          const int dc = dist < 0 ? 0 : (dist > 799 ? 799 : dist);
          S[rg][kt][j] = valid ? S[rg][kt][j] * SCL2 + bt[dc] : -1e30f;
        }
    }
    if (MODE == M_CMPB) {
#pragma unroll
      for (int kt = 0; kt < 4; ++kt) {
        float h = 0.f;
#pragma unroll
        for (int j = 0; j < 4; ++j) {
          float pv = __builtin_amdgcn_exp2f(S[rg][kt][j] - st[rg].m) * st[rg].l;
          S[rg][kt][j] = pv;
          h += pv;
        }
        hq[rg][kt] = h;
        h3[rg][kt] = S[rg][kt][3];
      }
    } else {
      float mx = -1e30f;
#pragma unroll
      for (int kt = 0; kt < 4; ++kt)
#pragma unroll
        for (int j = 0; j < 4; ++j) mx = fmaxf(mx, S[rg][kt][j]);
      mx = max4q(mx);
      const float mn = fmaxf(st[rg].m, mx);
      const float corr = __builtin_amdgcn_exp2f(st[rg].m - mn);
      st[rg].m = mn;
      const float mm = fmaxf(mn, -1e20f);
      float ls = 0.f;
#pragma unroll
      for (int kt = 0; kt < 4; ++kt)
#pragma unroll
        for (int j = 0; j < 4; ++j) {
          float pv = __builtin_amdgcn_exp2f(S[rg][kt][j] - mm);
          S[rg][kt][j] = pv;
          ls += pv;
        }
      st[rg].l = st[rg].l * corr + ls;
      if (MODE != M_CMPA) {
#pragma unroll
        for (int nt = 0; nt < 4; ++nt) O[rg][nt] *= corr;
      }
    }
    if (MODE != M_CMPA) {
#pragma unroll
      for (int ks = 0; ks < 2; ++ks)
#pragma unroll
        for (int i = 0; i < 4; ++i) {
          Pf[rg][ks][i] = (h16)S[rg][2 * ks][i];
          Pf[rg][ks][4 + i] = (h16)S[rg][2 * ks + 1][i];
        }
    }
  }
  if (MODE == M_CMPA) return;
#pragma unroll
  for (int ks = 0; ks < 2; ++ks)
#pragma unroll
    for (int nt = 0; nt < 4; ++nt) {
      const h16* vp = Vt + (ks * 32 + q4 * 4 + (col >> 2)) * KP + nt * 16 + 4 * (col & 3);
      const s16x4v r0 = __builtin_amdgcn_ds_read_tr16_b64_v4i16((LAS s16x4v*)vp);
      const s16x4v r1 = __builtin_amdgcn_ds_read_tr16_b64_v4i16((LAS s16x4v*)(vp + 16 * KP));
      const h16x4 v0 = __builtin_bit_cast(h16x4, r0), v1 = __builtin_bit_cast(h16x4, r1);
      const h16x8 Vf = {v0[0], v0[1], v0[2], v0[3], v1[0], v1[1], v1[2], v1[3]};
#pragma unroll
      for (int rg = 0; rg < 2; ++rg)
        if (RGM & (1 << rg)) O[rg][nt] = __builtin_amdgcn_mfma_f32_16x16x32_f16(Vf, Pf[rg][ks], O[rg][nt], 0, 0, 0);
    }
}

constexpr int LDS_CMP = 8 * 16 * 128 * 4 + 16 * 136 * 2 + 4 * 16 * 4;
__device__ __forceinline__ void phase_compress(const Params& p, int l, char* lds) {
  const int tid = opaque_tid(), lane = tid & 63, w = tid >> 6, col = lane & 15, q4 = lane >> 4;
  float* red = (float*)lds;
  h16* hid = (h16*)(lds + 8 * 16 * 128 * 4);
  float* nrm2 = (float*)(lds + 8 * 16 * 128 * 4 + 16 * 136 * 2);
  const h16* P = (const h16*)(WS(p) + O_P);
  for (int u = blockIdx.x; u < BATCH * 2 * 32; u += gridDim.x) {
    const int mt = u & 31, st = (u >> 5) & 1, b = u >> 6;
    const h16* W1t = (const h16*)(WS(p) + O_W1T) + (size_t)(l * 2 + st) * 128 * 2048;
    const h16* W2t = (const h16*)(WS(p) + O_W2T) + (size_t)(l * 2 + st) * 64 * 128;
    const float* b1 = (const float*)(WS(p) + O_BIAS1) + (l * 2 + st) * 128;
    __syncthreads();
    {
      f32x4 acc[8];
#pragma unroll
      for (int nt = 0; nt < 8; ++nt) acc[nt] = f32x4{0.f, 0.f, 0.f, 0.f};
      const int m = 16 * mt + col;
#pragma unroll 2
      for (int kk = 0; kk < 8; ++kk) {
        const int ks = 8 * w + kk, tt = ks >> 1, d0 = (ks & 1) * 32 + q4 * 8;
        int tok = 16 * m + tt;
        if (tok > SEQ - 1) tok = SEQ - 1;
        const h16x8 A = *(const h16x8*)(P + ((size_t)b * SEQ + tok) * IWP + OFF_KVC + st * 64 + d0);
#pragma unroll
        for (int nt = 0; nt < 8; ++nt) {
          const h16x8 B = *(const h16x8*)(W1t + (size_t)(nt * 16 + col) * 2048 + ks * 32 + q4 * 8);
          acc[nt] = __builtin_amdgcn_mfma_f32_16x16x32_f16(A, B, acc[nt], 0, 0, 0);
        }
      }
#pragma unroll
      for (int nt = 0; nt < 8; ++nt)
#pragma unroll
        for (int j = 0; j < 4; ++j) red[(w * 16 + q4 * 4 + j) * 128 + nt * 16 + col] = acc[nt][j];
    }
    __syncthreads();
    {
      const int row = tid >> 5, c4 = (tid & 31) * 4;
      float4 sum = *(const float4*)(b1 + c4);
#pragma unroll
      for (int ww = 0; ww < 8; ++ww) {
        const float4 v = *(const float4*)(red + (ww * 16 + row) * 128 + c4);
        sum.x += v.x; sum.y += v.y; sum.z += v.z; sum.w += v.w;
      }
      *(h16x4*)(hid + row * 136 + c4) = pack4(gelu_tanh(sum.x), gelu_tanh(sum.y), gelu_tanh(sum.z), gelu_tanh(sum.w));
    }
    __syncthreads();
    f32x4 o2 = {0.f, 0.f, 0.f, 0.f};
    if (w < 4) {
#pragma unroll
      for (int ks = 0; ks < 4; ++ks) {
        const h16x8 A = *(const h16x8*)(hid + col * 136 + ks * 32 + q4 * 8);
        const h16x8 B = *(const h16x8*)(W2t + (size_t)(w * 16 + col) * 128 + ks * 32 + q4 * 8);
        o2 = __builtin_amdgcn_mfma_f32_16x16x32_f16(A, B, o2, 0, 0, 0);
      }
      if (st == 0) {
#pragma unroll
        for (int j = 0; j < 4; ++j) {
          float ss = sum16(o2[j] * o2[j]);
          if (col == 0) nrm2[w * 16 + q4 * 4 + j] = ss;
        }
      }
    }
    __syncthreads();
    if (w < 4) {
      const float g = p.in[3][(l * 6 + 3) * 64 + w * 16 + col];
      h16* dst = (h16*)(WS(p) + (st == 0 ? O_KCMP : O_VCMP));
#pragma unroll
      for (int j = 0; j < 4; ++j) {
        const int row = q4 * 4 + j, m = 16 * mt + row;
        float v = o2[j];
        if (st == 0) {
          float tot = nrm2[row] + nrm2[16 + row] + nrm2[32 + row] + nrm2[48 + row];
          v = v * rsqrtf(tot * (1.f / 64.f) + EPS) * g;
        }
        if (m >= NCMP) v = 0.f;
        dst[((size_t)b * 512 + m) * 64 + w * 16 + col] = (h16)v;
      }
    }
  }
}


template <int MODE, int TM>
__device__ __forceinline__ void attn_tile2(const h16x8 (&Q)[2], f32x4 (&O)[4], ColState& st, const h16* Ks0, const h16* Vt0,
                                           const h16* Ks1, const h16* Vt1, const float* biasT, int tq, int hd, int kbase0,
                                           const bool (&far)[2], const bool (&selbit)[2], float (&hq)[2][4], float (&h3)[2][4],
                                           const int lane) {
  const int col = lane & 15, q4 = lane >> 4;
  constexpr int DK = (MODE == M_CMPA || MODE == M_CMPB) ? 16 : 1;
  f32x4 S[2][4];
  __builtin_amdgcn_s_setprio(1);
#pragma unroll
  for (int t = 0; t < 2; ++t) {
    if (!(TM & (1 << t))) continue;
    const h16* Ks = t ? Ks1 : Ks0;
#pragma unroll
    for (int kt = 0; kt < 4; ++kt) {
      S[t][kt] = f32x4{0.f, 0.f, 0.f, 0.f};
#pragma unroll
      for (int ks = 0; ks < 2; ++ks) {
        h16x8 Kf = *(const h16x8*)(Ks + (kt * 16 + col) * KP + ks * 32 + q4 * 8);
        S[t][kt] = __builtin_amdgcn_mfma_f32_16x16x32_f16(Kf, Q[ks], S[t][kt], 0, 0, 0);
      }
    }
  }
  __builtin_amdgcn_s_setprio(0);
  const float* bt = biasT + hd * 800;
  float addc[2] = {0.f, 0.f}, sclc[2] = {1.f, 1.f};
#pragma unroll
  for (int t = 0; t < 2; ++t) {
    if (!(TM & (1 << t))) continue;
    const int kbase = kbase0 + 64 * t;
    if (far[t]) {
      const bool ok = (MODE == M_SEL) ? selbit[t] : true;
      addc[t] = ok ? bt[799] : -1e30f;
      sclc[t] = SCL2;
    } else {
      addc[t] = 0.f;
      sclc[t] = 1.f;
      const int kx0 = kbase + q4 * 4;
      const int d0 = (DK == 16) ? tq - 31 - 16 * kx0 : tq - kx0;
#pragma unroll
      for (int kt = 0; kt < 4; ++kt)
#pragma unroll
        for (int j = 0; j < 4; ++j) {
          const int dist = d0 - DK * (kt * 16 + j);
          const int kx = kx0 + kt * 16 + j;
          bool valid = dist >= 0;
          if (MODE == M_WIN) valid = valid && dist < 512 && kx >= 0;
          if (MODE == M_SEL) valid = valid && selbit[t];
          if (DK == 16) valid = valid && kx < NCMP;
          const int dc = dist < 0 ? 0 : (dist > 799 ? 799 : dist);
          S[t][kt][j] = valid ? S[t][kt][j] * SCL2 + bt[dc] : -1e30f;
        }
    }
  }
  if (MODE == M_CMPB) {
#pragma unroll
    for (int t = 0; t < 2; ++t) {
      if (!(TM & (1 << t))) continue;
#pragma unroll
      for (int kt = 0; kt < 4; ++kt) {
        float h = 0.f;
#pragma unroll
        for (int j = 0; j < 4; ++j) {
          float pv = __builtin_amdgcn_exp2f(S[t][kt][j] * sclc[t] + (addc[t] - st.m)) * st.l;
          S[t][kt][j] = pv;
          h += pv;
        }
        hq[t][kt] = h;
        h3[t][kt] = S[t][kt][3];
      }
    }
  } else {
    float mx = -1e30f;
#pragma unroll
    for (int t = 0; t < 2; ++t) {
      if (!(TM & (1 << t))) continue;
      float mt = -1e30f;
#pragma unroll
      for (int kt = 0; kt < 4; ++kt)
#pragma unroll
        for (int j = 0; j < 4; ++j) mt = fmaxf(mt, S[t][kt][j]);
      mx = fmaxf(mx, mt * sclc[t] + addc[t]);
    }
    mx = max4q(mx);
    const float mn = fmaxf(st.m, mx);
    const float corr = __builtin_amdgcn_exp2f(st.m - mn);
    st.m = mn;
    const float mm = fmaxf(mn, -1e20f);
    float ls = 0.f;
#pragma unroll
    for (int t = 0; t < 2; ++t) {
      if (!(TM & (1 << t))) continue;
      const float am = addc[t] - mm;
#pragma unroll
      for (int kt = 0; kt < 4; ++kt) {
        const f32x4 e = S[t][kt] * sclc[t] + am;
#pragma unroll
        for (int j = 0; j < 4; ++j) {
          float pv = __builtin_amdgcn_exp2f(e[j]);
          S[t][kt][j] = pv;
          ls += pv;
        }
      }
    }
    st.l = st.l * corr + ls;
    if (MODE != M_CMPA) {
#pragma unroll
      for (int nt = 0; nt < 4; ++nt) O[nt] *= corr;
    }
  }
  if (MODE == M_CMPA) return;
  __builtin_amdgcn_s_setprio(1);
#pragma unroll
  for (int t = 0; t < 2; ++t) {
    if (!(TM & (1 << t))) continue;
    const h16* Vt = t ? Vt1 : Vt0;
#pragma unroll
    for (int ks = 0; ks < 2; ++ks) {
      h16x8 Pf;
#pragma unroll
      for (int i = 0; i < 4; ++i) { Pf[i] = (h16)S[t][2 * ks][i]; Pf[4 + i] = (h16)S[t][2 * ks + 1][i]; }
#pragma unroll
      for (int nt = 0; nt < 4; ++nt) {
        const h16* vp = Vt + (ks * 32 + q4 * 4 + (col >> 2)) * KP + nt * 16 + 4 * (col & 3);
        const s16x4v r0 = __builtin_amdgcn_ds_read_tr16_b64_v4i16((LAS s16x4v*)vp);
        const s16x4v r1 = __builtin_amdgcn_ds_read_tr16_b64_v4i16((LAS s16x4v*)(vp + 16 * KP));
        const h16x4 v0 = __builtin_bit_cast(h16x4, r0), v1 = __builtin_bit_cast(h16x4, r1);
        const h16x8 Vf = {v0[0], v0[1], v0[2], v0[3], v1[0], v1[1], v1[2], v1[3]};
        O[nt] = __builtin_amdgcn_mfma_f32_16x16x32_f16(Vf, Pf, O[nt], 0, 0, 0);
      }
    }
  }
  __builtin_amdgcn_s_setprio(0);
}

template <int D, class LoadF, class StoreF, class CompF>
__device__ __forceinline__ void pair_pipeline(int n, LoadF load, StoreF store, CompF comp) {
  h16x8 r[D][4];
#pragma unroll
  for (int d = 0; d < D; ++d)
    if (d < n) load(d, r[d]);
  store(0, r[0]);
  if (D < n) load(D, r[0]);
  __syncthreads();
  for (int i0 = 0; i0 < n; i0 += D) {
#pragma unroll
    for (int d = 0; d < D; ++d) {
      const int i = i0 + d;
      if (i < n) {
        if (i + 1 < n) store(i + 1, r[(d + 1) % D]);
        if (i + 1 + D < n) load(i + 1 + D, r[(d + 1) % D]);
        comp(i);
        __syncthreads();
      }
    }
  }
}

template <int D, class LoadF, class StoreF, class CompF>
__device__ __forceinline__ void tile_pipeline(int n, LoadF load, StoreF store, CompF comp) {
  h16x8 rk[D], rv[D];
#pragma unroll
  for (int d = 0; d < D; ++d)
    if (d < n) load(d, rk[d], rv[d]);
  store(0, rk[0], rv[0]);
  if (D < n) load(D, rk[0], rv[0]);
  __syncthreads();
  for (int i0 = 0; i0 < n; i0 += D) {
#pragma unroll
    for (int d = 0; d < D; ++d) {
      const int i = i0 + d;
      if (i < n) {
        if (i + 1 < n) store(i + 1, rk[(d + 1) % D], rv[(d + 1) % D]);
        if (i + 1 + D < n) load(i + 1 + D, rk[(d + 1) % D], rv[(d + 1) % D]);
        comp(i);
        __syncthreads();
      }
    }
  }
}

constexpr int LDS_BIAS = 800 * 16;
__device__ __forceinline__ void phase_swa(const Params& p, int l, char* lds) {
  const int tid = opaque_tid(), lane = tid & 63, w = tid >> 6, col = lane & 15, q4 = lane >> 4;
  float* biasT = (float*)lds;
  h16* KV = (h16*)(lds + LDS_BIAS);
  float* nrm = (float*)(lds + LDS_BIAS + 4 * 64 * KP * 2);
  const h16* P = (const h16*)(WS(p) + O_P);
  const int* lut = (const int*)(WS(p) + O_LUT);
  h16* OAC = (h16*)(WS(p) + O_OAC);
  __syncthreads();
  for (int i = tid; i < 3200; i += NT) biasT[i] = p.in[5][lut[i % 800] * 8 + (i / 800)] * LOG2E;
  __syncthreads();
  const int head = w >> 1, kvh = w >> 2;
  const float sink = p.in[4][l * 4 + head] * LOG2E;
  const int srow = tid >> 3, c8 = tid & 7;
  float hpd[2][4], hpe[2][4];
  const bool nosel[2] = {false, false};
  for (int u = blockIdx.x; u < BATCH * 128; u += gridDim.x) {
    const int b = u >> 7, t0 = (u & 127) * 64;
    const h16* Pbat = P + (size_t)b * SEQ * IWP;
    h16x8 Q[2][2];
    int tq[2];
#pragma unroll
    for (int rg = 0; rg < 2; ++rg) {
      const int qb = (w & 1) * 32 + rg * 16;
      const h16* qp = Pbat + (size_t)(t0 + qb + col) * IWP + head * 64 + q4 * 8;
      Q[rg][0] = *(const h16x8*)qp;
      Q[rg][1] = *(const h16x8*)(qp + 32);
      tq[rg] = t0 + qb + col;
    }
    f32x4 O[2][4];
    ColState st[2];
#pragma unroll
    for (int rg = 0; rg < 2; ++rg) {
#pragma unroll
      for (int nt = 0; nt < 4; ++nt) O[rg][nt] = f32x4{0.f, 0.f, 0.f, 0.f};
      st[rg].m = -1e30f; st[rg].l = 0.f;
    }
    const int i0 = t0 >= 128 ? 0 : (t0 >= 64 ? 1 : 2);
    h16x8 rk[2], rv[2];
    {
      int sb = t0 - 128 + i0 * 64;
      for (int h2 = 0; h2 < 2; ++h2) {
        rk[h2] = ld_row8(Pbat + 256 + h2 * 64, IWP, sb + srow, SEQ, c8);
        rv[h2] = ld_row8(Pbat + 384 + h2 * 64, IWP, sb + srow, SEQ, c8);
      }
    }
    for (int i = i0; i < 3; ++i) {
      __syncthreads();
      for (int h2 = 0; h2 < 2; ++h2) {
        st_k(KV + h2 * 64 * KP, srow, c8, rk[h2]);
        st_k(KV + (2 + h2) * 64 * KP, srow, c8, rv[h2]);
      }
      __syncthreads();
      if (i + 1 < 3) {
        int sb = t0 - 128 + (i + 1) * 64;
        for (int h2 = 0; h2 < 2; ++h2) {
          rk[h2] = ld_row8(Pbat + 256 + h2 * 64, IWP, sb + srow, SEQ, c8);
          rv[h2] = ld_row8(Pbat + 384 + h2 * 64, IWP, sb + srow, SEQ, c8);
        }
      }
      const int kb = t0 - 128 + i * 64;
      attn_tile<M_SWA, 3>(Q, O, st, KV + kvh * 64 * KP, KV + (2 + kvh) * 64 * KP, biasT, tq, head, kb, false, nosel, hpd, hpe, lane);
    }
    __syncthreads();
#pragma unroll
    for (int rg = 0; rg < 2; ++rg) {
      const int qb = (w & 1) * 32 + rg * 16;
      const float lsum = sum4q(st[rg].l);
      const float mn = fmaxf(st[rg].m, sink);
      const float corr = __builtin_amdgcn_exp2f(st[rg].m - mn);
      const float inv = corr / (lsum * corr + __builtin_amdgcn_exp2f(sink - mn));
      float ss = 0.f;
#pragma unroll
      for (int nt = 0; nt < 4; ++nt) {
        O[rg][nt] *= inv;
#pragma unroll
        for (int j = 0; j < 4; ++j) ss += O[rg][nt][j] * O[rg][nt][j];
      }
      ss = sum4q(ss);
      if (q4 == 0) nrm[head * 64 + qb + col] = ss;
    }
    __syncthreads();
#pragma unroll
    for (int rg = 0; rg < 2; ++rg) {
      const int qi = (w & 1) * 32 + rg * 16 + col;
      const float tot = nrm[qi] + nrm[64 + qi] + nrm[128 + qi] + nrm[192 + qi];
      const float sc = rsqrtf(tot * (1.f / 256.f) + EPS);
#pragma unroll
      for (int nt = 0; nt < 4; ++nt)
        *(h16x4*)(OAC + ((size_t)b * SEQ + t0 + qi) * 1024 + head * 64 + nt * 16 + q4 * 4) =
            pack4(O[rg][nt][0] * sc, O[rg][nt][1] * sc, O[rg][nt][2] * sc, O[rg][nt][3] * sc);
    }
  }
}

constexpr int LDS_NSA = LDS_BIAS + 8 * 64 * KP * 2 + NW * 4 * 128 * 4 + 32 * 16;
constexpr int PFD = 2;
__device__ __forceinline__ void phase_nsa(const Params& p, int l, char* lds, const int parts = 15) {
  const int tid = opaque_tid(), lane = tid & 63, w = tid >> 6, col = lane & 15, q4 = lane >> 4;
  float* biasT = (float*)lds;
  h16* KV0 = (h16*)(lds + LDS_BIAS);
  float* impw = (float*)(lds + LDS_BIAS + 8 * 64 * KP * 2) + w * 4 * 128;
  unsigned long long* selm = (unsigned long long*)(lds + LDS_BIAS + 8 * 64 * KP * 2 + NW * 4 * 128 * 4);
#define KSB(i, t) (KV0 + (((i) & 1) * 4 + (t) * 2) * 64 * KP)
#define VTB(i, t) (KV0 + (((i) & 1) * 4 + (t) * 2 + 1) * 64 * KP)
  const h16* P = (const h16*)(WS(p) + O_P);
  const int* lut = (const int*)(WS(p) + O_LUT);
  h16* OAC = (h16*)(WS(p) + O_OAC);
  __syncthreads();
  for (int i = tid; i < 3200; i += NT) biasT[i] = p.in[5][lut[i % 800] * 8 + 4 + (i / 800)] * LOG2E;
  __syncthreads();
  const int srow = tid >> 3, c8 = tid & 7;
  const int hd = col & 3, qw = col >> 2;
  float hpd[2][4], hpe[2][4];
  const bool nosel[2] = {false, false};
  for (int u = blockIdx.x; u < 1024; u += gridDim.x) {
    const int rnd = u >> 8, b = (u & 255) >> 6, ti = u & 63;
    const int tile = rnd == 0 ? 255 - ti : (rnd == 1 ? 128 + ti : (rnd == 2 ? 127 - ti : ti));
    const int t0 = tile * 32, cur = t0 >> 6;
    const h16* Pbat = P + (size_t)b * SEQ * IWP;
    const h16* KC = (const h16*)(WS(p) + O_KCMP) + (size_t)b * 512 * 64;
    const h16* VC = (const h16*)(WS(p) + O_VCMP) + (size_t)b * 512 * 64;
    h16x8 Q[2];
    int tq;
    {
      const h16* qp = Pbat + (size_t)(t0 + w * 4 + qw) * IWP + OFF_QC + hd * 64 + q4 * 8;
      Q[0] = *(const h16x8*)qp;
      Q[1] = *(const h16x8*)(qp + 32);
      tq = t0 + w * 4 + qw;
    }
    const h16* gp = Pbat + (size_t)tq * IWP + OFF_GC + hd * 3;
    for (int i = lane; i < 512; i += 64) impw[i] = 0.f;
    f32x4 O[4], Oc[4];
    ColState st;
    int mvmax = t0 / 16 + 1;
    if (mvmax > NCMP) mvmax = NCMP;
    const int ntc = (mvmax + 63) >> 6;
    st.m = -1e30f; st.l = 0.f;
    const int npc = (ntc + 1) >> 1;
    if (parts & 1) pair_pipeline<PFD>(npc,
      [&](int i, h16x8 (&r)[4]) { r[0] = ld_row8(KC, 64, (2 * i) * 64 + srow, 512, c8); r[2] = ld_row8(KC, 64, (2 * i + 1) * 64 + srow, 512, c8); },
      [&](int i, const h16x8 (&r)[4]) { st_k(KSB(i, 0), srow, c8, r[0]); st_k(KSB(i, 1), srow, c8, r[2]); },
      [&](int i) {
        const bool far[2] = {t0 - 31 - 16 * (2 * i * 64 + 63) >= 799, t0 - 31 - 16 * ((2 * i + 1) * 64 + 63) >= 799};
        if (2 * i + 1 < ntc) attn_tile2<M_CMPA, 3>(Q, O, st, KSB(i, 0), VTB(i, 0), KSB(i, 1), VTB(i, 1), biasT, tq, hd, 2 * i * 64, far, nosel, hpd, hpe, lane);
        else attn_tile2<M_CMPA, 1>(Q, O, st, KSB(i, 0), VTB(i, 0), KSB(i, 1), VTB(i, 1), biasT, tq, hd, 2 * i * 64, far, nosel, hpd, hpe, lane);
      });
    {
      const float ls = sum4q(st.l);
      st.l = ls > 0.f ? 1.f / ls : 0.f;
    }
#pragma unroll
    for (int nt = 0; nt < 4; ++nt) O[nt] = f32x4{0.f, 0.f, 0.f, 0.f};
    float carry = 0.f;
    if (parts & 1) pair_pipeline<PFD>(npc,
      [&](int i, h16x8 (&r)[4]) {
        r[0] = ld_row8(KC, 64, (2 * i) * 64 + srow, 512, c8); r[1] = ld_row8(VC, 64, (2 * i) * 64 + srow, 512, c8);
        r[2] = ld_row8(KC, 64, (2 * i + 1) * 64 + srow, 512, c8); r[3] = ld_row8(VC, 64, (2 * i + 1) * 64 + srow, 512, c8); },
      [&](int i, const h16x8 (&r)[4]) {
        st_k(KSB(i, 0), srow, c8, r[0]); st_k(VTB(i, 0), srow, c8, r[1]); st_k(KSB(i, 1), srow, c8, r[2]); st_k(VTB(i, 1), srow, c8, r[3]); },
      [&](int i) {
        float hq[2][4], h3[2][4];
        const bool far[2] = {t0 - 31 - 16 * (2 * i * 64 + 63) >= 799, t0 - 31 - 16 * ((2 * i + 1) * 64 + 63) >= 799};
        const bool two = 2 * i + 1 < ntc;
        if (two) attn_tile2<M_CMPB, 3>(Q, O, st, KSB(i, 0), VTB(i, 0), KSB(i, 1), VTB(i, 1), biasT, tq, hd, 2 * i * 64, far, nosel, hq, h3, lane);
        else attn_tile2<M_CMPB, 1>(Q, O, st, KSB(i, 0), VTB(i, 0), KSB(i, 1), VTB(i, 1), biasT, tq, hd, 2 * i * 64, far, nosel, hq, h3, lane);
        float t3p = carry;
#pragma unroll
        for (int t = 0; t < 2; ++t) {
          if (t == 1 && !two) break;
#pragma unroll
          for (int kt = 0; kt < 4; ++kt) {
            const float qs = quadsum(hq[t][kt]);
            const float t3 = quadsum(h3[t][kt]);
            const float up = __shfl(t3, (lane + 48) & 63);
            const float wrp = __shfl(t3p, (lane + 48) & 63);
            const float pk = (q4 == 0) ? wrp : up;
            if (hd == 0) impw[qw * 128 + (2 * i + t) * 16 + kt * 4 + q4] = qs + pk;
            t3p = t3;
          }
        }
        carry = t3p;
      });
    {
      const float g0 = (float)gp[0];
#pragma unroll
      for (int nt = 0; nt < 4; ++nt) Oc[nt] = O[nt] * g0;
    }
    if (parts & 2) {
      const int nforced = cur >= 2 ? 3 : cur + 1;
      const int npick = 16 - nforced;
      for (int qi = 0; qi < 4; ++qi) {
        const float* im = impw + qi * 128;
        const int j0 = lane, j1 = lane + 64;
        const float v0 = im[j0], v1 = im[j1];
        int r0 = 0, r1 = 0;
#pragma unroll 8
        for (int jp = 1; jp <= cur - 2; ++jp) {
          float vp = im[jp];
          r0 += (vp > v0 || (vp == v0 && jp < j0)) ? 1 : 0;
          r1 += (vp > v1 || (vp == v1 && jp < j1)) ? 1 : 0;
        }
        bool c0 = j0 >= 1 && j0 <= cur - 2, c1 = j1 <= cur - 2;
        bool f0 = j0 == 0 || j0 == cur || j0 == cur - 1, f1 = j1 == cur || j1 == cur - 1;
        unsigned long long mlo = __ballot(f0 || (c0 && r0 < npick));
        unsigned long long mhi = __ballot(f1 || (c1 && r1 < npick));
        if (lane == 0) { selm[(w * 4 + qi) * 2] = mlo; selm[(w * 4 + qi) * 2 + 1] = mhi; }
      }
    }
    asm volatile("" ::: "memory");
    const unsigned long long slo = selm[(w * 4 + qw) * 2], shi = selm[(w * 4 + qw) * 2 + 1];
#pragma unroll
    for (int nt = 0; nt < 4; ++nt) O[nt] = f32x4{0.f, 0.f, 0.f, 0.f};
    st.m = -1e30f; st.l = 0.f;
    if (parts & 4) pair_pipeline<PFD>((cur + 2) >> 1,
      [&](int i, h16x8 (&r)[4]) {
        r[0] = ld_row8(Pbat + OFF_KVC + 128, IWP, (2 * i) * 64 + srow, SEQ, c8); r[1] = ld_row8(Pbat + OFF_KVC + 192, IWP, (2 * i) * 64 + srow, SEQ, c8);
        r[2] = ld_row8(Pbat + OFF_KVC + 128, IWP, (2 * i + 1) * 64 + srow, SEQ, c8); r[3] = ld_row8(Pbat + OFF_KVC + 192, IWP, (2 * i + 1) * 64 + srow, SEQ, c8); },
      [&](int i, const h16x8 (&r)[4]) {
        st_k(KSB(i, 0), srow, c8, r[0]); st_k(VTB(i, 0), srow, c8, r[1]); st_k(KSB(i, 1), srow, c8, r[2]); st_k(VTB(i, 1), srow, c8, r[3]); },
      [&](int i) {
        const int jb = 2 * i;
        bool sb[2];
        sb[0] = ((jb < 64 ? (slo >> jb) : (shi >> (jb - 64))) & 1ull) != 0;
        sb[1] = (jb + 1 <= cur) && (((jb + 1 < 64 ? (slo >> (jb + 1)) : (shi >> (jb + 1 - 64))) & 1ull) != 0);
        const bool far[2] = {t0 - (jb * 64 + 63) >= 799, t0 - (jb * 64 + 127) >= 799};
        const bool n0 = __any(sb[0]) != 0, n1 = __any(sb[1]) != 0;
        if (n0 && n1) attn_tile2<M_SEL, 3>(Q, O, st, KSB(i, 0), VTB(i, 0), KSB(i, 1), VTB(i, 1), biasT, tq, hd, jb * 64, far, sb, hpd, hpe, lane);
        else if (n0) attn_tile2<M_SEL, 1>(Q, O, st, KSB(i, 0), VTB(i, 0), KSB(i, 1), VTB(i, 1), biasT, tq, hd, jb * 64, far, sb, hpd, hpe, lane);
        else if (n1) attn_tile2<M_SEL, 2>(Q, O, st, KSB(i, 0), VTB(i, 0), KSB(i, 1), VTB(i, 1), biasT, tq, hd, jb * 64, far, sb, hpd, hpe, lane);
      });
    {
      const float ls = sum4q(st.l);
      const float f = ls > 0.f ? (float)gp[1] / ls : 0.f;
#pragma unroll
      for (int nt = 0; nt < 4; ++nt) Oc[nt] += O[nt] * f;
    }
#pragma unroll
    for (int nt = 0; nt < 4; ++nt) O[nt] = f32x4{0.f, 0.f, 0.f, 0.f};
    st.m = -1e30f; st.l = 0.f;
    const int w0 = cur >= 8 ? cur - 8 : 0;
    const int nwt = cur - w0 + 1;
    if (parts & 8) pair_pipeline<PFD>((nwt + 1) >> 1,
      [&](int i, h16x8 (&r)[4]) {
        r[0] = ld_row8(Pbat + OFF_KVC + 256, IWP, (w0 + 2 * i) * 64 + srow, SEQ, c8); r[1] = ld_row8(Pbat + OFF_KVC + 320, IWP, (w0 + 2 * i) * 64 + srow, SEQ, c8);
        r[2] = ld_row8(Pbat + OFF_KVC + 256, IWP, (w0 + 2 * i + 1) * 64 + srow, SEQ, c8); r[3] = ld_row8(Pbat + OFF_KVC + 320, IWP, (w0 + 2 * i + 1) * 64 + srow, SEQ, c8); },
      [&](int i, const h16x8 (&r)[4]) {
        st_k(KSB(i, 0), srow, c8, r[0]); st_k(VTB(i, 0), srow, c8, r[1]); st_k(KSB(i, 1), srow, c8, r[2]); st_k(VTB(i, 1), srow, c8, r[3]); },
      [&](int i) {
        const bool far[2] = {false, false};
        if (2 * i + 1 < nwt) attn_tile2<M_WIN, 3>(Q, O, st, KSB(i, 0), VTB(i, 0), KSB(i, 1), VTB(i, 1), biasT, tq, hd, (w0 + 2 * i) * 64, far, nosel, hpd, hpe, lane);
        else attn_tile2<M_WIN, 1>(Q, O, st, KSB(i, 0), VTB(i, 0), KSB(i, 1), VTB(i, 1), biasT, tq, hd, (w0 + 2 * i) * 64, far, nosel, hpd, hpe, lane);
      });
    {
      const float ls = sum4q(st.l);
      const float f = ls > 0.f ? (float)gp[2] / ls : 0.f;
      float ss = 0.f;
#pragma unroll
      for (int nt = 0; nt < 4; ++nt) {
        Oc[nt] += O[nt] * f;
#pragma unroll
        for (int j = 0; j < 4; ++j) ss += Oc[nt][j] * Oc[nt][j];
      }
      ss = quadsum(sum4q(ss));
      const float sc = rsqrtf(ss * (1.f / 256.f) + EPS);
#pragma unroll
      for (int nt = 0; nt < 4; ++nt)
        *(h16x4*)(OAC + ((size_t)b * SEQ + tq) * 1024 + 256 + hd * 64 + nt * 16 + q4 * 4) =
            pack4(Oc[nt][0] * sc, Oc[nt][1] * sc, Oc[nt][2] * sc, Oc[nt][3] * sc);
    }
  }
#undef KSB
#undef VTB
}

constexpr int LDS_SWA = LDS_BIAS + 4 * 64 * KP * 2 + 1024;
constexpr int lds_max(int a, int b) { return a > b ? a : b; }
constexpr int LDS_BYTES = lds_max(lds_max(LDS_NSA, SSMY_LDS), lds_max(LDS_SWA, lds_max(LDS_GEMM, lds_max(LDS_CMP, 64 * 65 * 4))));

__global__ void __launch_bounds__(NT) fwd_megakernel(Params p) {
  cg::grid_group grid = cg::this_grid();
  __shared__ __attribute__((aligned(16))) char lds[LDS_BYTES];
  __shared__ uint4 xb_words;
  if (threadIdx.x == 0) xb_words = make_uint4(0u, 0u, 0u, 0u);
  __syncthreads();
  (void)xcd_barrier_post((unsigned*)(WS(p) + O_BAR), (volatile LAS unsigned*)&xb_words);
#define GBAR() do { XcdBarrier _b; _b.bar = (unsigned*)(WS(p) + O_BAR); _b.x = xb_xcc_id(); _b.st = (volatile LAS unsigned*)&xb_words; xcd_barrier(_b); } while (0)
  phase0(p, (float*)lds);
  grid.sync();
  phase0b(p);
  GBAR();
  for (int l = 0; l < DEPTH; ++l) {
    phase_gemm1(p, l, lds);
    GBAR();
    ssm_endstates(p, l, lds);
    phase_compress(p, l, lds);
    GBAR();
    phase_nsa(p, l, lds);
    phase_swa(p, l, lds);
    ssm_outputs(p, l, lds);
    GBAR();
    phase_glu(p, l, lds);
    GBAR();
    phase_wout(p, l, lds);
    GBAR();
    phase_up(p, l, lds);
    GBAR();
    phase_down(p, l, lds);
    GBAR();
  }
}

extern "C" void kernel_launch(void* const* d_in, const int* in_sizes, int n_in, void* d_out, int out_size, void* d_ws,
                              size_t ws_size, hipStream_t stream) {
  static int grid_blocks = 0;
  if (!grid_blocks) {
    int dev = 0, cus = 0, per_cu = 0;
    (void)hipGetDevice(&dev);
    (void)hipDeviceGetAttribute(&cus, hipDeviceAttributeMultiprocessorCount, dev);
    (void)hipOccupancyMaxActiveBlocksPerMultiprocessor(&per_cu, fwd_megakernel, NT, 0);
    if (per_cu > 1) per_cu = 1;
    grid_blocks = cus * per_cu;
  }
  if (ws_size < WS_NEED) {
    fprintf(stderr, "workspace too small: %zu < %zu\n", ws_size, WS_NEED);
    return;
  }
  Params p{};
  for (int i = 0; i < 24; ++i) p.in[i] = (const float*)d_in[i];
  p.out = (float*)d_out;
  p.ws = (char*)d_ws;
  (void)hipMemsetAsync((char*)d_ws + O_BAR, 0, SZ_BAR, stream);
  void* args[] = {&p};
  hipError_t e = hipLaunchCooperativeKernel((void*)fwd_megakernel, dim3(grid_blocks), dim3(NT), args, 0, stream);
  if (e != hipSuccess) fprintf(stderr, "cooperative launch failed: %s (grid %d)\n", hipGetErrorString(e), grid_blocks);
}
```

```cpp
#include <hip/hip_runtime.h>
#include <hip/hip_cooperative_groups.h>
#include <cstdio>
namespace cg = cooperative_groups;

typedef _Float16 h16;
typedef __attribute__((ext_vector_type(8))) _Float16 h16x8;
typedef __attribute__((ext_vector_type(4))) float f32x4;

constexpr int NT = 512;
constexpr int NW = NT / 64;
constexpr int BATCH = 4, SEQ = 8192, NTOK = BATCH * SEQ, DM = 1024, DEPTH = 4, IW = 1676, IWP = 1792, DFF = 4096;
constexpr int OFF_U = 512, OFF_QC = 1024, OFF_KVC = 1280, OFF_GC = 1664;
constexpr int NCMP = 511;
constexpr float EPS = 1e-6f;

constexpr size_t SZ_WIN = (size_t)IWP * DM * 2, SZ_WGLU = (size_t)1024 * 512 * 2, SZ_WOUT = (size_t)DM * DM * 2,
                 SZ_WUP = (size_t)DFF * DM * 2, SZ_WDN = (size_t)DM * DFF * 2;
constexpr size_t O_WIN = 0;
constexpr size_t O_WGLU = O_WIN + DEPTH * SZ_WIN;
constexpr size_t O_WOUT = O_WGLU + DEPTH * SZ_WGLU;
constexpr size_t O_WUP = O_WOUT + DEPTH * SZ_WOUT;
constexpr size_t O_WDN = O_WUP + DEPTH * SZ_WUP;
constexpr size_t O_XB = O_WDN + DEPTH * SZ_WDN;
constexpr size_t O_SSQ = O_XB + (size_t)NTOK * DM * 2;
constexpr size_t O_SSQB = O_SSQ + (size_t)NTOK * 16 * 4;
constexpr size_t O_KCMP = O_SSQB + (size_t)NTOK * 16 * 4;
constexpr size_t O_VCMP = O_KCMP + (size_t)BATCH * 512 * 64 * 4;
constexpr size_t O_ABAR = O_VCMP + (size_t)BATCH * 512 * 64 * 4;
constexpr size_t O_BBAR = O_ABAR + (size_t)DEPTH * 32 * 64 * 8;
constexpr size_t O_BIAS1 = O_BBAR + (size_t)DEPTH * 32 * 64 * 16 * 8;
constexpr size_t O_LUT = O_BIAS1 + (size_t)DEPTH * 2 * 128 * 4;
constexpr size_t O_AT = O_LUT + 8192 * 4;
constexpr size_t O_KTAB = O_AT + (size_t)128 * 64 * 8;
constexpr size_t SZ_KTAB = (size_t)65 * 256 * 2;
constexpr size_t O_W1 = O_KTAB + 128 * SZ_KTAB;
constexpr size_t SZ_W13 = (size_t)128 * 1024 * 2;
constexpr size_t O_W3 = O_W1 + 128 * SZ_W13;
constexpr size_t O_W1T = O_W3 + 128 * SZ_W13;
constexpr size_t O_W2T = O_W1T + (size_t)8 * 128 * 2048 * 2;
constexpr size_t O_B1P = O_W2T + (size_t)8 * 64 * 128 * 2;
constexpr size_t O_BAR = (O_B1P + (size_t)8 * 32 * 128 * 4 + 255) / 256 * 256;
constexpr size_t SZ_BAR = 3456 * 4 + 16 * 64 * 4;
constexpr size_t O_BIG = (O_BAR + SZ_BAR + 255) / 256 * 256;
constexpr size_t O_APOW = O_BIG;
constexpr size_t O_P = O_BIG;
constexpr size_t O_Z = O_P + (size_t)NTOK * IWP * 2;
constexpr size_t O_OB = O_Z + (size_t)NTOK * 512 * 2;
constexpr size_t O_OAC = O_OB + (size_t)512 * 2;
constexpr size_t O_E = O_OB + (size_t)NTOK * 1024 * 2;
constexpr size_t O_HID = O_BIG;
constexpr size_t WS_NEED = O_BIG + (size_t)NTOK * DFF * 2;

struct Params {
  const float* in[24];
  float* out;
  char* ws;
};

__device__ __forceinline__ char* WS(const Params& p) {
  int z;
  asm volatile("s_mov_b32 %0, 0" : "=s"(z));
  return p.ws + z;
}
__device__ __forceinline__ int fetch_unit(unsigned* ctr, int* slot) {
  __syncthreads();
  if (threadIdx.x == 0) *slot = (int)atomicAdd(ctr, 1u);
  __syncthreads();
  return *slot;
}
__device__ __forceinline__ int opaque_tid() {
  int t = threadIdx.x;
  asm volatile("" : "+v"(t));
  return t;
}
template <int CTRL>
__device__ __forceinline__ float dppf(float v) {
  return __int_as_float(__builtin_amdgcn_update_dpp(0, __float_as_int(v), CTRL, 0xF, 0xF, true));
}
__device__ __forceinline__ float sum16(float v) {
  v += dppf<0xB1>(v); v += dppf<0x4E>(v); v += dppf<0x141>(v); v += dppf<0x140>(v);
  return v;
}
__device__ __forceinline__ float max16(float v) {
  v = fmaxf(v, dppf<0xB1>(v)); v = fmaxf(v, dppf<0x4E>(v)); v = fmaxf(v, dppf<0x141>(v)); v = fmaxf(v, dppf<0x140>(v));
  return v;
}
__device__ __forceinline__ float xor16(float v) { return __int_as_float(__builtin_amdgcn_ds_swizzle(__float_as_int(v), 0x401F)); }
__device__ __forceinline__ float rdlane_c(float v, int l) { return __int_as_float(__builtin_amdgcn_readlane(__float_as_int(v), l)); }
__device__ __forceinline__ float wave_sum(float v) {
  v = sum16(v); v += xor16(v);
  return rdlane_c(v, 0) + rdlane_c(v, 32);
}
__device__ __forceinline__ float gelu_tanh(float x) {
  float u = 0.7978845608028654f * (x + 0.044715f * x * x * x);
  return 0.5f * x * (1.f + tanhf(u));
}
__device__ __forceinline__ float sigmoidf(float x) { return 1.f / (1.f + __expf(-x)); }
__device__ __forceinline__ float rdlane(float v, int l) {
  return __int_as_float(__builtin_amdgcn_readlane(__float_as_int(v), l));
}

__device__ __forceinline__ int perm32(int rho) { return 8 * ((rho & 15) >> 2) + 4 * (rho >> 4) + (rho & 3); }

template <class SrcF>
__device__ __forceinline__ void conv_tile(SrcF src, h16* dst, int ldo, int n0, int k0, float* tile) {
  int tid = opaque_tid();
  for (int idx = tid; idx < 4096; idx += NT) {
    int kk = idx >> 6, nn = idx & 63;
    tile[kk * 65 + nn] = src(k0 + kk, n0 + nn);
  }
  __syncthreads();
  for (int idx = tid; idx < 4096; idx += NT) {
    int nn = idx >> 6, kk = idx & 63;
    dst[(long)(n0 + nn) * ldo + k0 + kk] = (h16)tile[kk * 65 + nn];
  }
  __syncthreads();
}

__device__ __forceinline__ void phase0(const Params& p, float* lds) {
  const int tid = opaque_tid();
  constexpr int T_IN = (IWP / 64) * (DM / 64);
  constexpr int T_GLU = 16 * 8;
  constexpr int T_OUT = 16 * 16;
  constexpr int T_UP = 64 * 16;
  constexpr int T_DN = 16 * 64;
  constexpr int T_L = T_IN + T_GLU + T_OUT + T_UP + T_DN;
  for (int ti = blockIdx.x; ti < DEPTH * T_L; ti += gridDim.x) {
    int l = ti / T_L, r = ti % T_L;
    if (r < T_IN) {
      int nt = r / 16, kt = r % 16;
      const float* w = p.in[2] + (size_t)l * DM * IW;
      const float* g = p.in[1] + l * DM;
      conv_tile([&](int k, int sl) {
        int n = (sl & ~255) + 64 * ((sl >> 5) & 3) + 32 * ((sl >> 7) & 1) + perm32(sl & 31);
        return n < IW ? w[(long)k * IW + n] * g[k] : 0.f; },
                (h16*)(WS(p) + O_WIN + l * SZ_WIN), DM, nt * 64, kt * 64, lds);
    } else if ((r -= T_IN) < T_GLU) {
      int nt = r / 8, kt = r % 8;
      const float* w = p.in[14] + (size_t)l * 512 * 1024;
      conv_tile([&](int k, int n2) {
        int pn = n2 >> 8, bj = (n2 >> 7) & 1, wc = (n2 >> 5) & 3, nn = (n2 >> 4) & 1, r = n2 & 15;
        int n = (nn ? 512 : 0) + 128 * pn + 64 * bj + 16 * wc + r;
        return w[(long)k * 1024 + n]; },
                (h16*)(WS(p) + O_WGLU + l * SZ_WGLU), 512, nt * 64, kt * 64, lds);
    } else if ((r -= T_GLU) < T_OUT) {
      int nt = r / 16, kt = r % 16;
      const float* w = p.in[20] + (size_t)l * DM * DM;
      const float* g = p.in[19] + l * DM;
      conv_tile([&](int k2, int n2) {
        int k = k2 < 512 ? 256 + k2 : (k2 < 768 ? k2 - 512 : k2);
        int n = (n2 & ~31) + perm32(n2 & 31);
        return w[(long)k * DM + n] * g[k]; },
                (h16*)(WS(p) + O_WOUT + l * SZ_WOUT), DM, nt * 64, kt * 64, lds);
    } else if ((r -= T_OUT) < T_UP) {
      int nt = r / 16, kt = r % 16;
      const float* w = p.in[22] + (size_t)l * DM * DFF;
      const float* g = p.in[21] + l * DM;
      conv_tile([&](int k, int n2) { int n = (n2 & ~31) + perm32(n2 & 31); return w[(long)k * DFF + n] * g[k]; },
                (h16*)(WS(p) + O_WUP + l * SZ_WUP), DM, nt * 64, kt * 64, lds);
    } else {
      r -= T_UP;
      int nt = r / 64, kt = r % 64;
      const float* w = p.in[23] + (size_t)l * DFF * DM;
      conv_tile([&](int k, int n2) { int n = (n2 & ~31) + perm32(n2 & 31); return w[(long)k * DM + n]; },
                (h16*)(WS(p) + O_WDN + l * SZ_WDN), DFF, nt * 64, kt * 64, lds);
    }
  }
  for (int ti = blockIdx.x; ti < 8 * 66; ti += gridDim.x) {
    int ls = ti / 66, r = ti % 66;
    if (r < 64) {
      int nt = r >> 5, kt = r & 31;
      const float* w = p.in[17] + (size_t)ls * 2048 * 128;
      conv_tile([&](int k, int n) { return w[(long)k * 128 + n]; }, (h16*)(WS(p) + O_W1T) + (size_t)ls * 128 * 2048, 2048, nt * 64, kt * 64, lds);
    } else {
      int kt = r - 64;
      const float* w = p.in[18] + (size_t)ls * 128 * 64;
      conv_tile([&](int k, int n) { return w[(long)k * 64 + n]; }, (h16*)(WS(p) + O_W2T) + (size_t)ls * 64 * 128, 128, 0, kt * 64, lds);
    }
  }
  {
    const int lane = tid & 63;
    const int gw = blockIdx.x * NW + (tid >> 6), nw = gridDim.x * NW;
    const float* x = p.in[0];
    h16* xb = (h16*)(WS(p) + O_XB);
    float* ssq = (float*)(WS(p) + O_SSQ);
    for (int row = gw; row < NTOK; row += nw) {
      const float4* xr = (const float4*)(x + (long)row * DM + lane * 16);
      float s = 0.f;
      h16 hv[16];
      for (int i = 0; i < 4; ++i) {
        float4 v = xr[i];
        s += v.x * v.x + v.y * v.y + v.z * v.z + v.w * v.w;
        hv[i * 4 + 0] = (h16)v.x; hv[i * 4 + 1] = (h16)v.y; hv[i * 4 + 2] = (h16)v.z; hv[i * 4 + 3] = (h16)v.w;
      }
      h16x8* xo = (h16x8*)(xb + (long)row * DM + lane * 16);
      h16x8 o0, o1;
      for (int i = 0; i < 8; ++i) { o0[i] = hv[i]; o1[i] = hv[8 + i]; }
      xo[0] = o0; xo[1] = o1;
      s += dppf<0xB1>(s);
      s += dppf<0x4E>(s);
      if ((lane & 3) == 0) ssq[(long)row * 16 + (lane >> 2)] = s;
    }
  }
  const int gt = blockIdx.x * NT + tid, ngt = gridDim.x * NT;
  for (int i = gt; i < DEPTH * 32 * 64; i += ngt) {
    int l = i / 2048, g = (i / 64) % 32;
    double are = p.in[6][i], aim = p.in[7][i];
    double dt = exp((double)p.in[8][l * 32 + g]);
    double er = exp(are * dt), abr = er * cos(aim * dt), abi = er * sin(aim * dt);
    ((float2*)(WS(p) + O_ABAR))[i] = make_float2((float)abr, (float)abi);
    double nr = abr - 1.0, ni = abi, den = are * are + aim * aim;
    double fr = (nr * are + ni * aim) / den, fi = (ni * are - nr * aim) / den;
    float2* bb = (float2*)(WS(p) + O_BBAR) + (size_t)i * 16;
    for (int q = 0; q < 16; ++q) {
      double br = p.in[9][(size_t)i * 16 + q], bi = p.in[10][(size_t)i * 16 + q];
      bb[q] = make_float2((float)((fr * br - fi * bi) / dt), (float)((fr * bi + fi * br) / dt));
    }
  }
  for (int i = gt; i < 128 * 65 * 64; i += ngt) {
    int n = i & 63, j = (i >> 6) % 65, lg = i / (65 * 64);
    double are = p.in[6][lg * 64 + n], aim = p.in[7][lg * 64 + n];
    double dt = exp((double)p.in[8][lg]);
    double er = exp(are * dt * j), ang = aim * dt * j;
    ((double2*)(WS(p) + O_APOW))[i] = make_double2(er * cos(ang), er * sin(ang));
  }
  for (int i = gt; i < DEPTH * 2 * 128 * 32; i += ngt) {
    int j = i & 127, kc = (i >> 7) & 31, ls = i >> 12;
    const float* pos = p.in[16] + (size_t)ls * 2048 + kc * 64;
    const float* w1 = p.in[17] + ((size_t)ls * 2048 + kc * 64) * 128;
    float a = 0.f;
#pragma unroll 16
    for (int k = 0; k < 64; ++k) a += pos[k] * w1[(long)k * 128 + j];
    ((float*)(WS(p) + O_B1P))[i] = a;
  }
  for (int d = gt; d < 8192; d += ngt) {
    int bk;
    if (d < 16) bk = d;
    else {
      float nf = (float)d;
      int large = 16 + (int)(logf(nf / 16.0f) / 4.1588830833596715f * 16.0f);
      bk = large < 31 ? large : 31;
    }
    ((int*)(WS(p) + O_LUT))[d] = bk;
  }
}

__device__ __forceinline__ void phase0b(const Params& p) {
  const int gt = blockIdx.x * NT + threadIdx.x, ngt = gridDim.x * NT;
  const double2* apow = (const double2*)(WS(p) + O_APOW);
  const float2* bbs = (const float2*)(WS(p) + O_BBAR);
  for (int i = gt; i < 128 * 64 * 64; i += ngt) {
    int tau = i & 63, n = (i >> 6) & 63, lg = i >> 12;
    double2 ap = apow[(lg * 65 + (63 - tau)) * 64 + n];
    const float2* bb = bbs + (size_t)(lg * 64 + n) * 16;
    h16x8 re0, re1, im0, im1;
#pragma unroll
    for (int q = 0; q < 8; ++q) {
      float2 b0 = bb[q], b1 = bb[8 + q];
      re0[q] = (h16)(float)(ap.x * b0.x - ap.y * b0.y);
      im0[q] = (h16)(float)(ap.x * b0.y + ap.y * b0.x);
      re1[q] = (h16)(float)(ap.x * b1.x - ap.y * b1.y);
      im1[q] = (h16)(float)(ap.x * b1.y + ap.y * b1.x);
    }
    h16* W1 = (h16*)(WS(p) + O_W1 + (size_t)lg * SZ_W13);
    *(h16x8*)(W1 + ((size_t)(2 * tau) * 128 + 2 * n) * 8) = re0;
    *(h16x8*)(W1 + ((size_t)(2 * tau) * 128 + 2 * n + 1) * 8) = im0;
    *(h16x8*)(W1 + ((size_t)(2 * tau + 1) * 128 + 2 * n) * 8) = re1;
    *(h16x8*)(W1 + ((size_t)(2 * tau + 1) * 128 + 2 * n + 1) * 8) = im1;
  }
  for (int i = gt; i < 128 * 64 * 16 * 16; i += ngt) {
    int pp = i & 15, kc = (i >> 4) & 15, tau = (i >> 8) & 63, lg = i >> 14;
    h16x8 v;
#pragma unroll
    for (int e = 0; e < 4; ++e) {
      int n = 4 * kc + e;
      double2 ap = apow[(lg * 65 + tau + 1) * 64 + n];
      double cr = p.in[11][((size_t)lg * 16 + pp) * 64 + n], ci = p.in[12][((size_t)lg * 16 + pp) * 64 + n];
      v[2 * e] = (h16)(float)(cr * ap.x - ci * ap.y);
      v[2 * e + 1] = (h16)(float)(-(cr * ap.y + ci * ap.x));
    }
    h16* W3 = (h16*)(WS(p) + O_W3 + (size_t)lg * SZ_W13);
    *(h16x8*)(W3 + ((size_t)((tau * 16 + kc) * 16) + pp) * 8) = v;
  }
  for (int i = gt; i < 128 * 65 * 16; i += ngt) {
    int pp = i & 15, slot = (i >> 4) % 65, lg = i / (65 * 16);
    float acc[16];
#pragma unroll
    for (int q = 0; q < 16; ++q) acc[q] = 0.f;
    if (slot > 0) {
      for (int n = 0; n < 64; ++n) {
        double2 ap = apow[(lg * 65 + slot - 1) * 64 + n];
        double cr = p.in[11][((size_t)lg * 16 + pp) * 64 + n], ci = p.in[12][((size_t)lg * 16 + pp) * 64 + n];
        float xr = (float)(cr * ap.x - ci * ap.y), xi = (float)(cr * ap.y + ci * ap.x);
        const float2* bb = bbs + (size_t)(lg * 64 + n) * 16;
#pragma unroll
        for (int q = 0; q < 16; ++q) { float2 b = bb[q]; acc[q] += xr * b.x - xi * b.y; }
      }
    }
    h16x8 v0, v1;
#pragma unroll
    for (int q = 0; q < 8; ++q) { v0[q] = (h16)acc[q]; v1[q] = (h16)acc[8 + q]; }
    h16* kt = (h16*)(WS(p) + O_KTAB + (size_t)lg * SZ_KTAB) + slot * 256 + pp * 16;
    *(h16x8*)kt = v0;
    *(h16x8*)(kt + 8) = v1;
  }
  for (int i = gt; i < 128 * 64; i += ngt) {
    double2 ap = apow[((i >> 6) * 65 + 64) * 64 + (i & 63)];
    ((float2*)(WS(p) + O_AT))[i] = make_float2((float)ap.x, (float)ap.y);
  }
  for (int i = gt; i < DEPTH * 2 * 128; i += ngt) {
    const float* pp = (const float*)(WS(p) + O_B1P) + (size_t)(i >> 7) * 32 * 128 + (i & 127);
    float a = 0.f;
    for (int kc = 0; kc < 32; ++kc) a += pp[kc * 128];
    ((float*)(WS(p) + O_BIAS1))[i] = a;
  }
}

__device__ __forceinline__ void ssm_endstates(const Params& p, int l, char* lds) {
  const int tid = opaque_tid(), lane = tid & 63, w = tid >> 6;
  const h16* P = (const h16*)(WS(p) + O_P);
  float* E = (float*)(WS(p) + O_E);
  f32x4* red = (f32x4*)lds;
  for (int ub4 = blockIdx.x; ub4 < 256; ub4 += gridDim.x) {
    const int unit = ub4 * 4 + (w & 3), kh = w >> 2;
    const int g = unit >> 5, ctile = unit & 31;
    const h16* W1 = (const h16*)(WS(p) + O_W1 + (size_t)(l * 32 + g) * SZ_W13);
    const int gch = ctile * 16 + (lane & 15);
    const h16* ub = P + (size_t)gch * 64 * IWP + OFF_U + g * 16 + ((lane >> 4) & 1) * 8 + (size_t)(lane >> 5) * IWP;
    f32x4 acc[8];
#pragma unroll
    for (int mt = 0; mt < 8; ++mt) acc[mt] = f32x4{0.f, 0.f, 0.f, 0.f};
#pragma unroll 4
    for (int kk = 0; kk < 16; ++kk) {
      const int ks = kh * 16 + kk;
      h16x8 B = *(const h16x8*)(ub + (size_t)(ks * 2) * IWP);
#pragma unroll
      for (int mt = 0; mt < 8; ++mt) {
        h16x8 A = *(const h16x8*)(W1 + ((size_t)(ks * 4 + (lane >> 4)) * 128 + mt * 16 + (lane & 15)) * 8);
        acc[mt] = __builtin_amdgcn_mfma_f32_16x16x32_f16(A, B, acc[mt], 0, 0, 0);
      }
    }
    __syncthreads();
    if (kh == 1) {
#pragma unroll
      for (int mt = 0; mt < 8; ++mt) red[((w & 3) * 8 + mt) * 64 + lane] = acc[mt];
    }
    __syncthreads();
    if (kh == 0) {
#pragma unroll
      for (int mt = 0; mt < 8; ++mt)
        *(f32x4*)(E + ((size_t)gch * 32 + g) * 128 + mt * 16 + (lane >> 4) * 4) = acc[mt] + red[((w & 3) * 8 + mt) * 64 + lane];
    }
  }
}

constexpr int BU_PITCH = 1040, BS_PITCH = 144;
constexpr int SSMY_LDS = 65 * 512 + 16 * BU_PITCH * 2 + 16 * BS_PITCH * 2 + 128 * 64 * 8;
__device__ __forceinline__ void ssm_outputs(const Params& p, int l, char* lds, unsigned* ctr, int* slot) {
  const int tid = opaque_tid(), lane = tid & 63, w = tid >> 6;
  h16* Kt = (h16*)lds;
  h16* Bu = (h16*)(lds + 65 * 512);
  h16* Bs = (h16*)(lds + 65 * 512 + 16 * BU_PITCH * 2);
  float2* Es = (float2*)(lds + 65 * 512 + 16 * BU_PITCH * 2 + 16 * BS_PITCH * 2);
  const h16* P = (const h16*)(WS(p) + O_P);
  const float* E = (const float*)(WS(p) + O_E);
  h16* Z = (h16*)(WS(p) + O_Z);
  for (int unit = fetch_unit(ctr, slot); unit < 1024; unit = fetch_unit(ctr, slot)) {
    const int g = unit & 31, bc = unit >> 5, b = bc >> 3, ct = bc & 7;
    const int lg = l * 32 + g;
    __syncthreads();
    const int c0 = ct * 16;
    {
      const h16x8* ks = (const h16x8*)(WS(p) + O_KTAB + (size_t)lg * SZ_KTAB);
      for (int i = tid; i < 65 * 32; i += NT) ((h16x8*)Kt)[i] = ks[i];
      for (int i = tid; i < 2048; i += NT) {
        int tk = i >> 1, hf = i & 1;
        h16x8 v = *(const h16x8*)(P + ((size_t)b * SEQ + ct * 1024 + tk) * IWP + OFF_U + g * 16 + hf * 8);
        *(h16x8*)(Bu + (tk >> 6) * BU_PITCH + (tk & 63) * 16 + hf * 8) = v;
      }
      const float2* Eb = (const float2*)E + ((size_t)(b * 128) * 32 + g) * 64;
      for (int i = tid; i < (c0 + 16) * 64; i += NT) Es[i] = Eb[(size_t)(i >> 6) * 2048 + (i & 63)];
    }
    __syncthreads();
    if (w == 0) {
      float2 at = ((const float2*)(WS(p) + O_AT))[lg * 64 + lane];
      float sr = 0.f, si = 0.f;
#pragma unroll 8
      for (int c = 0; c < c0; ++c) {
        float2 e = Es[c * 64 + lane];
        float nr = at.x * sr - at.y * si + e.x, ni = at.x * si + at.y * sr + e.y;
        sr = nr; si = ni;
      }
#pragma unroll
      for (int i = 0; i < 16; ++i) {
        Bs[i * BS_PITCH + 2 * lane] = (h16)sr;
        Bs[i * BS_PITCH + 2 * lane + 1] = (h16)si;
        float2 e = Es[(c0 + i) * 64 + lane];
        float nr = at.x * sr - at.y * si + e.x, ni = at.x * si + at.y * sr + e.y;
        sr = nr; si = ni;
      }
    }
    __syncthreads();
    const float dt = expf(p.in[8][lg]);
    const int col = lane & 15, hi = lane >> 5, qh = (lane >> 4) & 1, p0 = (lane >> 4) * 4;
    const h16* W3 = (const h16*)(WS(p) + O_W3 + (size_t)lg * SZ_W13);
    float dsk[4];
    for (int j = 0; j < 4; ++j) dsk[j] = p.in[13][l * 512 + g * 16 + p0 + j];
    for (int r = 0; r < 64 / NW; ++r) {
      const int base = (r >> 1) * 2 * NW;
      const int tau = (r & 1) ? base + 2 * NW - 1 - w : base + w;
      f32x4 acc = {0.f, 0.f, 0.f, 0.f};
      const int nks = tau / 2 + 1;
      h16x8 A3[4];
#pragma unroll
      for (int ks = 0; ks < 4; ++ks)
        A3[ks] = *(const h16x8*)(W3 + ((size_t)((tau * 16 + ks * 4 + (lane >> 4)) * 16) + (lane & 15)) * 8);
      for (int i = 0; i < nks; ++i) {
        int j = tau - (2 * i + hi);
        h16x8 A = *(const h16x8*)(Kt + (j + 1) * 256 + (lane & 15) * 16 + qh * 8);
        h16x8 B = *(const h16x8*)(Bu + col * BU_PITCH + (2 * i + hi) * 16 + qh * 8);
        acc = __builtin_amdgcn_mfma_f32_16x16x32_f16(A, B, acc, 0, 0, 0);
      }
#pragma unroll
      for (int ks = 0; ks < 4; ++ks) {
        h16x8 B = *(const h16x8*)(Bs + col * BS_PITCH + ks * 32 + (lane >> 4) * 8);
        acc = __builtin_amdgcn_mfma_f32_16x16x32_f16(A3[ks], B, acc, 0, 0, 0);
      }
      const h16* up = Bu + col * BU_PITCH + tau * 16 + p0;
      size_t tok = ((size_t)b * 128 + ct * 16 + col) * 64 + tau;
      h16 zz[4];
      for (int j = 0; j < 4; ++j) zz[j] = (h16)gelu_tanh(dt * acc[j] + dsk[j] * (float)up[j]);
      typedef __attribute__((ext_vector_type(4))) _Float16 h16x4;
      h16x4 zv = {zz[0], zz[1], zz[2], zz[3]};
      *(h16x4*)(Z + tok * 512 + g * 16 + p0) = zv;
    }
  }
}

#define LAS __attribute__((address_space(3)))
typedef _Float16 h16x4 __attribute__((ext_vector_type(4)));
#define XB_TMO      128
#define XB_XCNT(j)  (256  + 64 * (j))
#define XB_XSUB(j)  (1280 + 64 * (j))
#define XB_XGEN(j)  (2304 + 64 * (j))
#define XB_TOP      3328
#define XB_TOPGEN   3392
#define XCD_BAR_WORDS 3456
#define XB_SPIN_CAP (1u << 18)

__device__ __forceinline__ unsigned xb_ld(unsigned* p)              { return __hip_atomic_load(p, __ATOMIC_RELAXED, __HIP_MEMORY_SCOPE_AGENT); }
__device__ __forceinline__ unsigned xb_add(unsigned* p, unsigned v) { return __hip_atomic_fetch_add(p, v, __ATOMIC_RELAXED, __HIP_MEMORY_SCOPE_AGENT); }
__device__ __forceinline__ unsigned xb_xcc_id() { return (unsigned)__builtin_amdgcn_s_getreg((3 << 11) | 20) & 0xFu; }
#define XB_SPIN(cond, bar) do { unsigned _sp = 0; while (cond) { __builtin_amdgcn_s_sleep(1); \
    if ((++_sp & 255u) == 0u) { if (xb_ld(&(bar)[XB_TMO])) break; if (_sp > XB_SPIN_CAP) { atomicAdd(&(bar)[XB_TMO], 1u); break; } } } } while (0)

struct XcdBarrier {
    unsigned* bar; unsigned x;
    volatile LAS unsigned* st;
};

__device__ __forceinline__ XcdBarrier xcd_barrier_post(unsigned* bar, volatile LAS unsigned* st) {
    XcdBarrier b; b.bar = bar; b.x = xb_xcc_id(); b.st = st;
    if (threadIdx.x == 0) (void)xb_add(&bar[XB_XCNT(b.x)], 1u);
    return b;
}
__device__ __forceinline__ void xcd_barrier_complete(unsigned* bar, unsigned x, unsigned& nloc, unsigned& nx) {
    const unsigned G = gridDim.x * gridDim.y * gridDim.z;
    unsigned sum, cnt, mine, sp = 0u;
    for (;;) {
        sum = 0u; cnt = 0u; mine = 0u;
#pragma unroll
        for (unsigned j = 0; j < 16; ++j) { const unsigned c = xb_ld(&bar[XB_XCNT(j)]); sum += c; cnt += (c > 0u) ? 1u : 0u; mine = (j == x) ? c : mine; }
        if (sum == G) break;
        __builtin_amdgcn_s_sleep(1);
        if ((++sp & 255u) == 0u) { if (xb_ld(&bar[XB_TMO])) break; if (sp > XB_SPIN_CAP) { atomicAdd(&bar[XB_TMO], 1u); break; } }
    }
    nloc = mine > 0u ? mine : 1u; nx = cnt > 0u ? cnt : 1u;
}

__device__ __forceinline__ void xcd_barrier(const XcdBarrier& b) {
    asm volatile("s_waitcnt vmcnt(0)" ::: "memory");
    __syncthreads();
    if (threadIdx.x == 0) {
        unsigned* bar = b.bar;
        __builtin_amdgcn_s_waitcnt(0);
        unsigned nloc = b.st[0], nx = b.st[1];
        if (nloc == 0u) { xcd_barrier_complete(bar, b.x, nloc, nx); b.st[0] = nloc; b.st[1] = nx; }
        const unsigned old = xb_add(&bar[XB_XSUB(b.x)], 1u);
        const unsigned gen = old / nloc;
        if (old + 1u == (gen + 1u) * nloc) {
            __builtin_amdgcn_fence(__ATOMIC_RELEASE, "agent");
            asm volatile("s_waitcnt vmcnt(0)" ::: "memory");
            const unsigned og = xb_add(&bar[XB_TOP], 1u);
            const unsigned tg = og / nx;
            if (og + 1u == (tg + 1u) * nx) xb_add(&bar[XB_TOPGEN], 1u);
            else XB_SPIN(xb_ld(&bar[XB_TOPGEN]) == tg, bar);
            __builtin_amdgcn_fence(__ATOMIC_ACQUIRE, "agent");
            xb_add(&bar[XB_XGEN(b.x)], 1u);
            asm volatile("s_waitcnt vmcnt(0)" ::: "memory");
        } else {
            XB_SPIN(xb_ld(&bar[XB_XGEN(b.x)]) == gen, bar);
            __builtin_amdgcn_fence(__ATOMIC_ACQUIRE, "agent");
            asm volatile("s_waitcnt vmcnt(0)" ::: "memory");
        }
    }
    __syncthreads();
}


namespace g8 {
constexpr int BM = 256, BK = 64, HALF = 128, HTB = HALF * BK * 2, STAGE_BYTES = 8 * HTB, NXCD = 8, WGM = 8;
__device__ __forceinline__ int lds_byte(int r, int c) {
  const int st = (r >> 4) * 2 + (c >> 5), rr = r & 15, cc = c & 31, ob = rr * 64 + cc * 2;
  return st * 1024 + (ob ^ (((ob >> 9) & 1) << 5));
}
__device__ __forceinline__ void stage_rc(int b, int& R, int& C) {
  const int st = b / 1024, sb = b % 1024, swz = sb ^ (((sb >> 9) & 1) << 5);
  R = (st >> 1) * 16 + swz / 64;
  C = (st & 1) * 32 + (swz % 64) / 2;
}
struct Unit { int pm, pn; };
struct Order {
  int nM, nN, nwg, G, c;
  __device__ void init(int M, int N, int G_, int c_) { nM = M / BM; nN = N / BM; nwg = nM * nN; G = G_; c = c_; }
  __device__ bool next(int i, Unit& u) const {
    const long L = (long)i * G + c;
    if (L >= nwg) return false;
    int wgid = (int)L;
    { const int q = nwg / NXCD, r = nwg % NXCD, xcd = wgid % NXCD, off = wgid / NXCD; wgid = (xcd < r ? xcd * (q + 1) : r * (q + 1) + (xcd - r) * q) + off; }
    const int nig = WGM * nN, gid = wgid / nig, fm = gid * WGM, gsz = (nM - fm) < WGM ? (nM - fm) : WGM;
    u.pm = fm + ((wgid % nig) % gsz);
    u.pn = (wgid % nig) / gsz;
    return true;
  }
};
template <class Epi>
__device__ __forceinline__ void gemm_phase(LAS unsigned char* lds, const h16* A, const h16* Bt, int K, const Order& S, const Epi& E) {
  const int tid = opaque_tid(), wid = __builtin_amdgcn_readfirstlane(tid >> 6), lane = tid & 63, wr = wid >> 2, wc = wid & 3, fr = lane & 15, fq = lane >> 4;
  const int nt = K / BK;
  unsigned voffA[2];
#pragma unroll
  for (int i = 0; i < 2; ++i) { int R, C; stage_rc(tid * 16 + i * 8192, R, C); voffA[i] = (unsigned)(R * K + C) * 2u; }
  const size_t kstep = (size_t)(BK * 2);
  const size_t hstep = (size_t)HALF * K * 2;
  const size_t tstep = 2 * hstep;
  const unsigned ldsw = (unsigned)wid * 1024u;
  const int aoff = lds_byte(wr * 64 + fr, fq * 8), boff = lds_byte(wc * 32 + fr, fq * 8);
#define G8_SA(b, h) (((b) * 2 + (h)) * HTB)
#define G8_SB(b, h) ((4 + (b) * 2 + (h)) * HTB)
#define G8_STAGE(bufoff, gbase) do { _Pragma("unroll") for (int _i = 0; _i < 2; ++_i) \
    __builtin_amdgcn_global_load_lds((const unsigned*)((const char*)(gbase) + voffA[_i]), (LAS unsigned*)(lds + (bufoff) + ldsw + _i * 8192), 16, 0, 0); } while (0)
#define G8_LDA(dst, b, h) do { _Pragma("unroll") for (int m = 0; m < 4; ++m) _Pragma("unroll") for (int k = 0; k < 2; ++k) dst[m][k] = *(const LAS h16x8*)(lds + G8_SA(b, h) + aoff + m * 2048 + k * 1024); } while (0)
#define G8_LDB(dst, b, h) do { _Pragma("unroll") for (int n = 0; n < 2; ++n) _Pragma("unroll") for (int k = 0; k < 2; ++k) dst[n][k] = *(const LAS h16x8*)(lds + G8_SB(b, h) + boff + n * 2048 + k * 1024); } while (0)
#define G8_MMA(ai, bj, At, Bt_) do { __builtin_amdgcn_s_setprio(1); _Pragma("unroll") for (int m = 0; m < 4; ++m) _Pragma("unroll") for (int n = 0; n < 2; ++n) _Pragma("unroll") for (int k = 0; k < 2; ++k) \
    acc[ai][bj][m][n] = __builtin_amdgcn_mfma_f32_16x16x32_f16(Bt_[n][k], At[m][k], acc[ai][bj][m][n], 0, 0, 0); __builtin_amdgcn_s_setprio(0); } while (0)
#define G8_WAIT_V(n) asm volatile("s_waitcnt vmcnt(" #n ")" ::: "memory")
#define G8_WAIT_L(n) asm volatile("s_waitcnt lgkmcnt(" #n ")" ::: "memory")
#define G8_BAR __builtin_amdgcn_s_barrier()
#define G8_SCHED __builtin_amdgcn_sched_barrier(0)
  Unit cur, nxt;
  int ui = 0;
  if (!S.next(0, cur)) return;
  f32x4 acc[2][2][4][2];
#pragma unroll
  for (int a = 0; a < 2; ++a)
#pragma unroll
    for (int b = 0; b < 2; ++b)
#pragma unroll
      for (int m = 0; m < 4; ++m)
#pragma unroll
        for (int n = 0; n < 2; ++n) acc[a][b][m][n] = (f32x4){0.f, 0.f, 0.f, 0.f};
  h16x8 At[4][2], B0[2][2], B1[2][2];
  const char* cA = (const char*)A + (size_t)cur.pm * tstep;
  const char* cB = (const char*)Bt + (size_t)cur.pn * tstep;
  G8_STAGE(G8_SB(0, 0), cB); G8_STAGE(G8_SA(0, 0), cA); G8_STAGE(G8_SB(0, 1), cB + hstep); G8_STAGE(G8_SA(0, 1), cA + hstep);
  if (wr == 1) G8_BAR;
  G8_WAIT_V(4); G8_BAR;
  G8_STAGE(G8_SB(1, 0), cB + kstep); G8_STAGE(G8_SA(1, 0), cA + kstep); G8_STAGE(G8_SB(1, 1), cB + hstep + kstep);
  G8_WAIT_V(6); G8_BAR;
  for (;;) {
    const bool has_next = S.next(ui + 1, nxt);
    const char* nA = has_next ? (const char*)A + (size_t)nxt.pm * tstep : cA;
    const char* nB = has_next ? (const char*)Bt + (size_t)nxt.pn * tstep : cB;
    for (int t = 0; t < nt; t += 2) {
      const bool last = (t == nt - 2);
      const char* a1 = cA + (size_t)(t + 1) * kstep;
      const char* a2 = last ? nA : cA + (size_t)(t + 2) * kstep;
      const char* b2 = last ? nB : cB + (size_t)(t + 2) * kstep;
      const char* a3 = a2 + kstep;
      const char* b3 = b2 + kstep;
      if (Epi::MID_T >= 0 && t == Epi::MID_T) E.mid(acc, ui, wr, fr);
      G8_LDB(B0, 0, 0); G8_SCHED; G8_LDA(At, 0, 0); G8_STAGE(G8_SA(1, 1), a1 + hstep);
      G8_WAIT_L(8); G8_BAR; G8_WAIT_L(0); G8_MMA(0, 0, At, B0); G8_BAR; G8_SCHED;
      G8_LDB(B1, 0, 1); G8_STAGE(G8_SB(0, 0), b2);
      G8_BAR; G8_WAIT_L(0); G8_MMA(0, 1, At, B1); G8_BAR;
      G8_LDA(At, 0, 1); G8_STAGE(G8_SA(0, 0), a2);
      G8_BAR; G8_WAIT_L(0); G8_MMA(1, 0, At, B0); G8_BAR; G8_SCHED;
      G8_STAGE(G8_SB(0, 1), b2 + hstep);
      G8_WAIT_V(6); G8_BAR; G8_MMA(1, 1, At, B1); G8_BAR;
      G8_LDB(B0, 1, 0); G8_SCHED; G8_LDA(At, 1, 0); G8_STAGE(G8_SA(0, 1), a2 + hstep);
      G8_WAIT_L(8); G8_BAR; G8_WAIT_L(0); G8_MMA(0, 0, At, B0); G8_BAR; G8_SCHED;
      G8_LDB(B1, 1, 1); G8_STAGE(G8_SB(1, 0), b3);
      G8_BAR; G8_WAIT_L(0); G8_MMA(0, 1, At, B1); G8_BAR;
      G8_LDA(At, 1, 1); G8_STAGE(G8_SA(1, 0), a3);
      G8_BAR; G8_WAIT_L(0); G8_MMA(1, 0, At, B0); G8_BAR; G8_SCHED;
      G8_STAGE(G8_SB(1, 1), b3 + hstep);
      G8_WAIT_V(6); G8_BAR; G8_MMA(1, 1, At, B1); G8_BAR;
    }
    E(acc, cur, ui, wr, wc, fr, fq);
    if (!has_next) break;
#pragma unroll
    for (int a = 0; a < 2; ++a)
#pragma unroll
      for (int b = 0; b < 2; ++b)
#pragma unroll
        for (int m = 0; m < 4; ++m)
#pragma unroll
          for (int n = 0; n < 2; ++n) acc[a][b][m][n] = (f32x4){0.f, 0.f, 0.f, 0.f};
    cur = nxt; cA = nA; cB = nB; ++ui;
  }
  G8_WAIT_V(0);
  if (wr == 0) G8_BAR;
  G8_BAR;
#undef G8_SA
#undef G8_SB
#undef G8_STAGE
#undef G8_LDA
#undef G8_LDB
#undef G8_MMA
#undef G8_WAIT_V
#undef G8_WAIT_L
#undef G8_BAR
#undef G8_SCHED
}
}

constexpr int RSL_OFF = g8::STAGE_BYTES;
constexpr int LDS_GEMM = g8::STAGE_BYTES + 8 * 256 * 4;

__device__ __forceinline__ void fill_rowscales(float* rsl, const float* ssq, float inv_n, const g8::Order& S) {
  const int tid = opaque_tid();
  g8::Unit u;
  __syncthreads();
  for (int i = 0; S.next(i, u); ++i) {
    if (tid < 256) {
      const float4* s4 = (const float4*)(ssq + (size_t)(u.pm * 256 + tid) * 16);
      float s = 0.f;
      for (int k = 0; k < 4; ++k) { float4 v = s4[k]; s += v.x + v.y + v.z + v.w; }
      rsl[i * 256 + tid] = rsqrtf(s * inv_n + EPS);
    }
  }
  __syncthreads();
}

__device__ __forceinline__ h16x4 pack4(float a, float b, float c, float d) { h16x4 v = {(h16)a, (h16)b, (h16)c, (h16)d}; return v; }
__device__ __forceinline__ h16x8 pack8(f32x4 a, f32x4 b) {
  h16x8 v = {(h16)a[0], (h16)a[1], (h16)a[2], (h16)a[3], (h16)b[0], (h16)b[1], (h16)b[2], (h16)b[3]};
  return v;
}

struct EpiIn {
  static constexpr int MID_T = -1;
  __device__ __forceinline__ void mid(f32x4 (&)[2][2][4][2], int, int, int) const {}
  h16* P; const float* rsl; const float* qkg;
  __device__ __forceinline__ void operator()(const f32x4 (&acc)[2][2][4][2], const g8::Unit& u, int ui, int wr, int wc, int fr, int fq) const {
    const int hs = u.pn * 4 + wc;
    int gi = -1;
    if (hs < 4) gi = 0; else if (hs < 6) gi = 1; else if (hs >= 16 && hs < 20) gi = 2; else if (hs == 22) gi = 4; else if (hs == 24) gi = 5;
    const bool gate = (hs == 26);
#pragma unroll
    for (int ai = 0; ai < 2; ++ai)
#pragma unroll
      for (int m = 0; m < 4; ++m) {
        const int rl = 128 * ai + 64 * wr + 16 * m + fr;
        float r = rsl[ui * 256 + rl];
        if (gi >= 0) {
          float ss = 0.f;
#pragma unroll
          for (int bj = 0; bj < 2; ++bj)
#pragma unroll
            for (int n = 0; n < 2; ++n)
#pragma unroll
              for (int j = 0; j < 4; ++j) ss += acc[ai][bj][m][n][j] * acc[ai][bj][m][n][j];
          ss += xor16(ss);
          ss += __shfl_xor(ss, 32);
          r *= rsqrtf(ss * r * r * (1.f / 64.f) + EPS);
        }
        h16* rowp = P + (size_t)(u.pm * 256 + rl) * IWP + 64 * hs + 8 * fq;
#pragma unroll
        for (int bj = 0; bj < 2; ++bj) {
          f32x4 v[2];
#pragma unroll
          for (int n = 0; n < 2; ++n) {
            v[n] = acc[ai][bj][m][n] * r;
            if (gi >= 0) {
              const float4 g4 = *(const float4*)(qkg + gi * 64 + 32 * bj + 8 * fq + 4 * n);
              v[n][0] *= g4.x; v[n][1] *= g4.y; v[n][2] *= g4.z; v[n][3] *= g4.w;
            } else if (gate) {
#pragma unroll
              for (int j = 0; j < 4; ++j) v[n][j] = (32 * bj + 8 * fq + 4 * n + j) < 12 ? sigmoidf(v[n][j]) : 0.f;
            }
          }
          *(h16x8*)(rowp + 32 * bj) = pack8(v[0], v[1]);
        }
      }
  }
};

struct EpiGlu {
  static constexpr int MID_T = -1;
  __device__ __forceinline__ void mid(f32x4 (&)[2][2][4][2], int, int, int) const {}
  h16* OB; float* ssqb; const float* gb;
  __device__ __forceinline__ void operator()(const f32x4 (&acc)[2][2][4][2], const g8::Unit& u, int ui, int wr, int wc, int fr, int fq) const {
    const int ocb = 128 * u.pn + 16 * wc + 4 * fq;
    float4 ba[2], bb[2];
#pragma unroll
    for (int bj = 0; bj < 2; ++bj) { ba[bj] = *(const float4*)(gb + ocb + 64 * bj); bb[bj] = *(const float4*)(gb + 512 + ocb + 64 * bj); }
#pragma unroll
    for (int ai = 0; ai < 2; ++ai)
#pragma unroll
      for (int m = 0; m < 4; ++m) {
        const size_t row = (size_t)u.pm * 256 + 128 * ai + 64 * wr + 16 * m + fr;
        float ss = 0.f;
#pragma unroll
        for (int bj = 0; bj < 2; ++bj) {
          const f32x4 a = acc[ai][bj][m][0], b = acc[ai][bj][m][1];
          float o0 = (a[0] + ba[bj].x) * sigmoidf(b[0] + bb[bj].x);
          float o1 = (a[1] + ba[bj].y) * sigmoidf(b[1] + bb[bj].y);
          float o2 = (a[2] + ba[bj].z) * sigmoidf(b[2] + bb[bj].z);
          float o3 = (a[3] + ba[bj].w) * sigmoidf(b[3] + bb[bj].w);
          *(h16x4*)(OB + row * 1024 + ocb + 64 * bj) = pack4(o0, o1, o2, o3);
          ss += o0 * o0 + o1 * o1 + o2 * o2 + o3 * o3;
        }
        ss += xor16(ss);
        ss += __shfl_xor(ss, 32);
        if (fq == 0) ssqb[row * 16 + u.pn * 4 + wc] = ss;
      }
  }
};

struct EpiRes {
  static constexpr int MID_T = -1;
  __device__ __forceinline__ void mid(f32x4 (&)[2][2][4][2], int, int, int) const {}
  float* xo; h16* xb; float* ssq; bool final_out;
  __device__ __forceinline__ void operator()(const f32x4 (&acc)[2][2][4][2], const g8::Unit& u, int ui, int wr, int wc, int fr, int fq) const {
#pragma unroll
    for (int ai = 0; ai < 2; ++ai)
#pragma unroll
      for (int m = 0; m < 4; ++m) {
        const size_t row = (size_t)u.pm * 256 + 128 * ai + 64 * wr + 16 * m + fr;
        const size_t base = row * DM + 256 * u.pn + 32 * wc + 8 * fq;
        float ss = 0.f;
#pragma unroll
        for (int bj = 0; bj < 2; ++bj) {
          const size_t idx = base + 128 * bj;
          const h16x8 xv = *(const h16x8*)(xb + idx);
          f32x4 x0 = acc[ai][bj][m][0], x1 = acc[ai][bj][m][1];
#pragma unroll
          for (int j = 0; j < 4; ++j) { x0[j] += (float)xv[j]; x1[j] += (float)xv[4 + j]; ss += x0[j] * x0[j] + x1[j] * x1[j]; }
          if (final_out) {
            *(float4*)(xo + idx) = make_float4(x0[0], x0[1], x0[2], x0[3]);
            *(float4*)(xo + idx + 4) = make_float4(x1[0], x1[1], x1[2], x1[3]);
          } else {
            *(h16x8*)(xb + idx) = pack8(x0, x1);
          }
        }
        ss += xor16(ss);
        ss += __shfl_xor(ss, 32);
        if (fq == 0) ssq[row * 16 + u.pn * 4 + wc] = ss;
      }
  }
};

struct EpiOut : EpiRes {
  static constexpr int MID_T = 8;
  const float* rsl;
  __device__ __forceinline__ void mid(f32x4 (&acc)[2][2][4][2], int ui, int wr, int fr) const {
#pragma unroll
    for (int ai = 0; ai < 2; ++ai)
#pragma unroll
      for (int m = 0; m < 4; ++m) {
        const float r = rsl[ui * 256 + 128 * ai + 64 * wr + 16 * m + fr];
#pragma unroll
        for (int bj = 0; bj < 2; ++bj)
#pragma unroll
          for (int n = 0; n < 2; ++n) acc[ai][bj][m][n] *= r;
      }
  }
};

struct EpiUp {
  static constexpr int MID_T = -1;
  __device__ __forceinline__ void mid(f32x4 (&)[2][2][4][2], int, int, int) const {}
  h16* hid; const float* rsl;
  __device__ __forceinline__ void operator()(const f32x4 (&acc)[2][2][4][2], const g8::Unit& u, int ui, int wr, int wc, int fr, int fq) const {
#pragma unroll
    for (int ai = 0; ai < 2; ++ai)
#pragma unroll
      for (int m = 0; m < 4; ++m) {
        const int rl = 128 * ai + 64 * wr + 16 * m + fr;
        const float r = rsl[ui * 256 + rl];
        h16* rowp = hid + (size_t)(u.pm * 256 + rl) * DFF + 256 * u.pn + 32 * wc + 8 * fq;
#pragma unroll
        for (int bj = 0; bj < 2; ++bj) {
          f32x4 v[2];
#pragma unroll
          for (int n = 0; n < 2; ++n) {
            v[n] = acc[ai][bj][m][n] * r;
#pragma unroll
            for (int j = 0; j < 4; ++j) { const float t = fmaxf(v[n][j], 0.f); v[n][j] = t * t; }
          }
          *(h16x8*)(rowp + 128 * bj) = pack8(v[0], v[1]);
        }
      }
  }
};

__device__ __forceinline__ void phase_gemm1(const Params& p, int l, char* lds) {
  g8::Order S; S.init(NTOK, IWP, gridDim.x, blockIdx.x);
  float* rsl = (float*)(lds + RSL_OFF);
  fill_rowscales(rsl, (const float*)(WS(p) + O_SSQ), 1.f / DM, S);
  EpiIn E{(h16*)(WS(p) + O_P), rsl, p.in[3] + l * 6 * 64};
  g8::gemm_phase((LAS unsigned char*)lds, (const h16*)(WS(p) + O_XB), (const h16*)(WS(p) + O_WIN + l * SZ_WIN), DM, S, E);
}
__device__ __forceinline__ void phase_glu(const Params& p, int l, char* lds) {
  g8::Order S; S.init(NTOK, 1024, gridDim.x, blockIdx.x);
  __syncthreads();
  EpiGlu E{(h16*)(WS(p) + O_OB), (float*)(WS(p) + O_SSQB), p.in[15] + l * 1024};
  g8::gemm_phase((LAS unsigned char*)lds, (const h16*)(WS(p) + O_Z), (const h16*)(WS(p) + O_WGLU + l * SZ_WGLU), 512, S, E);
}
__device__ __forceinline__ void phase_wout(const Params& p, int l, char* lds) {
  g8::Order S; S.init(NTOK, DM, gridDim.x, blockIdx.x);
  float* rsl = (float*)(lds + RSL_OFF);
  fill_rowscales(rsl, (const float*)(WS(p) + O_SSQB), 1.f / 512.f, S);
  EpiOut E;
  E.xo = p.out; E.xb = (h16*)(WS(p) + O_XB); E.ssq = (float*)(WS(p) + O_SSQ); E.final_out = false; E.rsl = rsl;
  g8::gemm_phase((LAS unsigned char*)lds, (const h16*)(WS(p) + O_OB), (const h16*)(WS(p) + O_WOUT + l * SZ_WOUT), DM, S, E);
}
__device__ __forceinline__ void phase_up(const Params& p, int l, char* lds) {
  g8::Order S; S.init(NTOK, DFF, gridDim.x, blockIdx.x);
  float* rsl = (float*)(lds + RSL_OFF);
  fill_rowscales(rsl, (const float*)(WS(p) + O_SSQ), 1.f / DM, S);
  EpiUp E{(h16*)(WS(p) + O_HID), rsl};
  g8::gemm_phase((LAS unsigned char*)lds, (const h16*)(WS(p) + O_XB), (const h16*)(WS(p) + O_WUP + l * SZ_WUP), DM, S, E);
}
__device__ __forceinline__ void phase_down(const Params& p, int l, char* lds) {
  g8::Order S; S.init(NTOK, DM, gridDim.x, blockIdx.x);
  __syncthreads();
  EpiRes E{p.out, (h16*)(WS(p) + O_XB), (float*)(WS(p) + O_SSQ), l == DEPTH - 1};
  g8::gemm_phase((LAS unsigned char*)lds, (const h16*)(WS(p) + O_HID), (const h16*)(WS(p) + O_WDN + l * SZ_WDN), DFF, S, E);
}

constexpr int KP = 80;
enum { M_SWA = 0, M_WIN = 1, M_SEL = 2, M_CMPA = 3, M_CMPB = 4 };
constexpr float LOG2E = 1.4426950408889634f, SCL2 = 0.125f * LOG2E;
struct ColState { float m, l; };
typedef short s16x4v __attribute__((__vector_size__(8)));

__device__ __forceinline__ h16x8 ld_row8(const h16* base, int ld, int row, int nrows, int c8) {
  h16x8 z = {0, 0, 0, 0, 0, 0, 0, 0};
  return (row >= 0 && row < nrows) ? *(const h16x8*)(base + (size_t)row * ld + c8 * 8) : z;
}
__device__ __forceinline__ void st_k(h16* Ks, int row, int c8, h16x8 v) { *(h16x8*)(Ks + row * KP + c8 * 8) = v; }
__device__ __forceinline__ void st_vt(h16* Vt, int row, int c8, h16x8 v) {
#pragma unroll
  for (int e = 0; e < 8; ++e) Vt[(c8 * 8 + e) * KP + row] = v[e];
}
__device__ __forceinline__ float max4q(float v) {
  v = fmaxf(v, xor16(v));
  auto r = __builtin_amdgcn_permlane32_swap(__float_as_int(v), __float_as_int(v), false, false);
  return fmaxf(__int_as_float(r[0]), __int_as_float(r[1]));
}
__device__ __forceinline__ float sum4q(float v) {
  v += xor16(v);
  auto r = __builtin_amdgcn_permlane32_swap(__float_as_int(v), __float_as_int(v), false, false);
  return __int_as_float(r[0]) + __int_as_float(r[1]);
}
__device__ __forceinline__ float quadsum(float v) { v += dppf<0xB1>(v); v += dppf<0x4E>(v); return v; }

template <int MODE, int RGM>
__device__ __forceinline__ void attn_tile(const h16x8 (&Q)[2][2], f32x4 (&O)[2][4], ColState (&st)[2], const h16* Ks,
                                          const h16* Vt, const float* biasT, const int (&tq)[2], int hd, int kbase, bool far,
                                          const bool (&selbit)[2], float (&hq)[2][4], float (&h3)[2][4], const int lane) {
  const int col = lane & 15, q4 = lane >> 4;
  constexpr int DK = (MODE == M_CMPA || MODE == M_CMPB) ? 16 : 1;
  f32x4 S[2][4];
#pragma unroll
  for (int kt = 0; kt < 4; ++kt) {
#pragma unroll
    for (int rg = 0; rg < 2; ++rg) S[rg][kt] = f32x4{0.f, 0.f, 0.f, 0.f};
#pragma unroll
    for (int ks = 0; ks < 2; ++ks) {
      h16x8 Kf = *(const h16x8*)(Ks + (kt * 16 + col) * KP + ks * 32 + q4 * 8);
#pragma unroll
      for (int rg = 0; rg < 2; ++rg)
        if (RGM & (1 << rg)) S[rg][kt] = __builtin_amdgcn_mfma_f32_16x16x32_f16(Kf, Q[rg][ks], S[rg][kt], 0, 0, 0);
    }
  }
  h16x8 Pf[2][2];
#pragma unroll
  for (int rg = 0; rg < 2; ++rg) {
    if (!(RGM & (1 << rg))) continue;
    const float* bt = biasT + hd * 800;
    if (far) {
      const float b31 = bt[799];
      const bool ok = (MODE == M_SEL) ? selbit[rg] : true;
#pragma unroll
      for (int kt = 0; kt < 4; ++kt)
#pragma unroll
        for (int j = 0; j < 4; ++j) S[rg][kt][j] = ok ? S[rg][kt][j] * SCL2 + b31 : -1e30f;
    } else {
      const int kx0 = kbase + q4 * 4;
      const int d0 = (DK == 16) ? tq[rg] - 31 - 16 * kx0 : tq[rg] - kx0;
#pragma unroll
      for (int kt = 0; kt < 4; ++kt)
#pragma unroll
        for (int j = 0; j < 4; ++j) {
          const int dist = d0 - DK * (kt * 16 + j);
          const int kx = kx0 + kt * 16 + j;
          bool valid = dist >= 0;
          if (MODE == M_SWA) valid = valid && dist < 128 && kx >= 0;
          if (MODE == M_WIN) valid = valid && dist < 512 && kx >= 0;
          if (MODE == M_SEL) valid = valid && selbit[rg];
          if (DK == 16) valid = valid && kx < NCMP;
          const int dc = dist < 0 ? 0 : (dist > 799 ? 799 : dist);
          S[rg][kt][j] = valid ? S[rg][kt][j] * SCL2 + bt[dc] : -1e30f;
        }
    }
    if (MODE == M_CMPB) {
#pragma unroll
      for (int kt = 0; kt < 4; ++kt) {
        float h = 0.f;
#pragma unroll
        for (int j = 0; j < 4; ++j) {
          float pv = __builtin_amdgcn_exp2f(S[rg][kt][j] - st[rg].m) * st[rg].l;
          S[rg][kt][j] = pv;
          h += pv;
        }
        hq[rg][kt] = h;
        h3[rg][kt] = S[rg][kt][3];
      }
    } else {
      float mx = -1e30f;
#pragma unroll
      for (int kt = 0; kt < 4; ++kt)
#pragma unroll
        for (int j = 0; j < 4; ++j) mx = fmaxf(mx, S[rg][kt][j]);
      mx = max4q(mx);
      const float mn = fmaxf(st[rg].m, mx);
      const float corr = __builtin_amdgcn_exp2f(st[rg].m - mn);
      st[rg].m = mn;
      const float mm = fmaxf(mn, -1e20f);
      float ls = 0.f;
#pragma unroll
      for (int kt = 0; kt < 4; ++kt)
#pragma unroll
        for (int j = 0; j < 4; ++j) {
          float pv = __builtin_amdgcn_exp2f(S[rg][kt][j] - mm);
          S[rg][kt][j] = pv;
          ls += pv;
        }
      st[rg].l = st[rg].l * corr + ls;
      if (MODE != M_CMPA) {
#pragma unroll
        for (int nt = 0; nt < 4; ++nt) O[rg][nt] *= corr;
      }
    }
    if (MODE != M_CMPA) {
#pragma unroll
      for (int ks = 0; ks < 2; ++ks)
#pragma unroll
        for (int i = 0; i < 4; ++i) {
          Pf[rg][ks][i] = (h16)S[rg][2 * ks][i];
          Pf[rg][ks][4 + i] = (h16)S[rg][2 * ks + 1][i];
        }
    }
  }
  if (MODE == M_CMPA) return;
#pragma unroll
  for (int ks = 0; ks < 2; ++ks)
#pragma unroll
    for (int nt = 0; nt < 4; ++nt) {
      const h16* vp = Vt + (ks * 32 + q4 * 4 + (col >> 2)) * KP + nt * 16 + 4 * (col & 3);
      const s16x4v r0 = __builtin_amdgcn_ds_read_tr16_b64_v4i16((LAS s16x4v*)vp);
      const s16x4v r1 = __builtin_amdgcn_ds_read_tr16_b64_v4i16((LAS s16x4v*)(vp + 16 * KP));
      const h16x4 v0 = __builtin_bit_cast(h16x4, r0), v1 = __builtin_bit_cast(h16x4, r1);
      const h16x8 Vf = {v0[0], v0[1], v0[2], v0[3], v1[0], v1[1], v1[2], v1[3]};
#pragma unroll
      for (int rg = 0; rg < 2; ++rg)
        if (RGM & (1 << rg)) O[rg][nt] = __builtin_amdgcn_mfma_f32_16x16x32_f16(Vf, Pf[rg][ks], O[rg][nt], 0, 0, 0);
    }
}

constexpr int LDS_CMP = 8 * 16 * 128 * 4 + 16 * 136 * 2 + 4 * 16 * 4;
__device__ __forceinline__ void phase_compress(const Params& p, int l, char* lds) {
  const int tid = opaque_tid(), lane = tid & 63, w = tid >> 6, col = lane & 15, q4 = lane >> 4;
  float* red = (float*)lds;
  h16* hid = (h16*)(lds + 8 * 16 * 128 * 4);
  float* nrm2 = (float*)(lds + 8 * 16 * 128 * 4 + 16 * 136 * 2);
  const h16* P = (const h16*)(WS(p) + O_P);
  for (int u = blockIdx.x; u < BATCH * 2 * 32; u += gridDim.x) {
    const int mt = u & 31, st = (u >> 5) & 1, b = u >> 6;
    const h16* W1t = (const h16*)(WS(p) + O_W1T) + (size_t)(l * 2 + st) * 128 * 2048;
    const h16* W2t = (const h16*)(WS(p) + O_W2T) + (size_t)(l * 2 + st) * 64 * 128;
    const float* b1 = (const float*)(WS(p) + O_BIAS1) + (l * 2 + st) * 128;
    __syncthreads();
    {
      f32x4 acc[8];
#pragma unroll
      for (int nt = 0; nt < 8; ++nt) acc[nt] = f32x4{0.f, 0.f, 0.f, 0.f};
      const int m = 16 * mt + col;
#pragma unroll 2
      for (int kk = 0; kk < 8; ++kk) {
        const int ks = 8 * w + kk, tt = ks >> 1, d0 = (ks & 1) * 32 + q4 * 8;
        int tok = 16 * m + tt;
        if (tok > SEQ - 1) tok = SEQ - 1;
        const h16x8 A = *(const h16x8*)(P + ((size_t)b * SEQ + tok) * IWP + OFF_KVC + st * 64 + d0);
#pragma unroll
        for (int nt = 0; nt < 8; ++nt) {
          const h16x8 B = *(const h16x8*)(W1t + (size_t)(nt * 16 + col) * 2048 + ks * 32 + q4 * 8);
          acc[nt] = __builtin_amdgcn_mfma_f32_16x16x32_f16(A, B, acc[nt], 0, 0, 0);
        }
      }
#pragma unroll
      for (int nt = 0; nt < 8; ++nt)
#pragma unroll
        for (int j = 0; j < 4; ++j) red[(w * 16 + q4 * 4 + j) * 128 + nt * 16 + col] = acc[nt][j];
    }
    __syncthreads();
    {
      const int row = tid >> 5, c4 = (tid & 31) * 4;
      float4 sum = *(const float4*)(b1 + c4);
#pragma unroll
      for (int ww = 0; ww < 8; ++ww) {
        const float4 v = *(const float4*)(red + (ww * 16 + row) * 128 + c4);
        sum.x += v.x; sum.y += v.y; sum.z += v.z; sum.w += v.w;
      }
      *(h16x4*)(hid + row * 136 + c4) = pack4(gelu_tanh(sum.x), gelu_tanh(sum.y), gelu_tanh(sum.z), gelu_tanh(sum.w));
    }
    __syncthreads();
    f32x4 o2 = {0.f, 0.f, 0.f, 0.f};
    if (w < 4) {
#pragma unroll
      for (int ks = 0; ks < 4; ++ks) {
        const h16x8 A = *(const h16x8*)(hid + col * 136 + ks * 32 + q4 * 8);
        const h16x8 B = *(const h16x8*)(W2t + (size_t)(w * 16 + col) * 128 + ks * 32 + q4 * 8);
        o2 = __builtin_amdgcn_mfma_f32_16x16x32_f16(A, B, o2, 0, 0, 0);
      }
      if (st == 0) {
#pragma unroll
        for (int j = 0; j < 4; ++j) {
          float ss = sum16(o2[j] * o2[j]);
          if (col == 0) nrm2[w * 16 + q4 * 4 + j] = ss;
        }
      }
    }
    __syncthreads();
    if (w < 4) {
      const float g = p.in[3][(l * 6 + 3) * 64 + w * 16 + col];
      h16* dst = (h16*)(WS(p) + (st == 0 ? O_KCMP : O_VCMP));
#pragma unroll
      for (int j = 0; j < 4; ++j) {
        const int row = q4 * 4 + j, m = 16 * mt + row;
        float v = o2[j];
        if (st == 0) {
          float tot = nrm2[row] + nrm2[16 + row] + nrm2[32 + row] + nrm2[48 + row];
          v = v * rsqrtf(tot * (1.f / 64.f) + EPS) * g;
        }
        if (m >= NCMP) v = 0.f;
        dst[((size_t)b * 512 + m) * 64 + w * 16 + col] = (h16)v;
      }
    }
  }
}


template <int MODE, int TM>
__device__ __forceinline__ void attn_tile2(const h16x8 (&Q)[2], f32x4 (&O)[4], ColState& st, const h16* Ks0, const h16* Vt0,
                                           const h16* Ks1, const h16* Vt1, const float* biasT, int tq, int hd, int kbase0,
                                           const bool (&far)[2], const bool (&selbit)[2], float (&hq)[2][4], float (&h3)[2][4],
                                           const int lane) {
  const int col = lane & 15, q4 = lane >> 4;
  constexpr int DK = (MODE == M_CMPA || MODE == M_CMPB) ? 16 : 1;
  f32x4 S[2][4];
  __builtin_amdgcn_s_setprio(1);
#pragma unroll
  for (int t = 0; t < 2; ++t) {
    if (!(TM & (1 << t))) continue;
    const h16* Ks = t ? Ks1 : Ks0;
#pragma unroll
    for (int kt = 0; kt < 4; ++kt) {
      S[t][kt] = f32x4{0.f, 0.f, 0.f, 0.f};
#pragma unroll
      for (int ks = 0; ks < 2; ++ks) {
        h16x8 Kf = *(const h16x8*)(Ks + (kt * 16 + col) * KP + ks * 32 + q4 * 8);
        S[t][kt] = __builtin_amdgcn_mfma_f32_16x16x32_f16(Kf, Q[ks], S[t][kt], 0, 0, 0);
      }
    }
  }
  __builtin_amdgcn_s_setprio(0);
  const float* bt = biasT + hd * 800;
  float addc[2] = {0.f, 0.f}, sclc[2] = {1.f, 1.f};
#pragma unroll
  for (int t = 0; t < 2; ++t) {
    if (!(TM & (1 << t))) continue;
    const int kbase = kbase0 + 64 * t;
    if (far[t]) {
      const bool ok = (MODE == M_SEL) ? selbit[t] : true;
      addc[t] = ok ? bt[799] : -1e30f;
      sclc[t] = SCL2;
    } else {
      addc[t] = 0.f;
      sclc[t] = 1.f;
      const int kx0 = kbase + q4 * 4;
      const int d0 = (DK == 16) ? tq - 31 - 16 * kx0 : tq - kx0;
#pragma unroll
      for (int kt = 0; kt < 4; ++kt)
#pragma unroll
        for (int j = 0; j < 4; ++j) {
          const int dist = d0 - DK * (kt * 16 + j);
          const int kx = kx0 + kt * 16 + j;
          bool valid = dist >= 0;
          if (MODE == M_WIN) valid = valid && dist < 512 && kx >= 0;
          if (MODE == M_SEL) valid = valid && selbit[t];
          if (DK == 16) valid = valid && kx < NCMP;
          const int dc = dist < 0 ? 0 : (dist > 799 ? 799 : dist);
          S[t][kt][j] = valid ? S[t][kt][j] * SCL2 + bt[dc] : -1e30f;
        }
    }
  }
  if (MODE == M_CMPB) {
#pragma unroll
    for (int t = 0; t < 2; ++t) {
      if (!(TM & (1 << t))) continue;
#pragma unroll
      for (int kt = 0; kt < 4; ++kt) {
        float h = 0.f;
#pragma unroll
        for (int j = 0; j < 4; ++j) {
          float pv = __builtin_amdgcn_exp2f(S[t][kt][j] * sclc[t] + (addc[t] - st.m)) * st.l;
          S[t][kt][j] = pv;
          h += pv;
        }
        hq[t][kt] = h;
        h3[t][kt] = S[t][kt][3];
      }
    }
  } else {
    float mx = -1e30f;
#pragma unroll
    for (int t = 0; t < 2; ++t) {
      if (!(TM & (1 << t))) continue;
      float mt = -1e30f;
#pragma unroll
      for (int kt = 0; kt < 4; ++kt)
#pragma unroll
        for (int j = 0; j < 4; ++j) mt = fmaxf(mt, S[t][kt][j]);
      mx = fmaxf(mx, mt * sclc[t] + addc[t]);
    }
    mx = max4q(mx);
    const float mn = fmaxf(st.m, mx);
    const float corr = __builtin_amdgcn_exp2f(st.m - mn);
    st.m = mn;
    const float mm = fmaxf(mn, -1e20f);
    float ls = 0.f;
#pragma unroll
    for (int t = 0; t < 2; ++t) {
      if (!(TM & (1 << t))) continue;
      const float am = addc[t] - mm;
#pragma unroll
      for (int kt = 0; kt < 4; ++kt) {
        const f32x4 e = S[t][kt] * sclc[t] + am;
#pragma unroll
        for (int j = 0; j < 4; ++j) {
          float pv = __builtin_amdgcn_exp2f(e[j]);
          S[t][kt][j] = pv;
          ls += pv;
        }
      }
    }
    st.l = st.l * corr + ls;
    if (MODE != M_CMPA) {
#pragma unroll
      for (int nt = 0; nt < 4; ++nt) O[nt] *= corr;
    }
  }
  if (MODE == M_CMPA) return;
  __builtin_amdgcn_s_setprio(1);
#pragma unroll
  for (int t = 0; t < 2; ++t) {
    if (!(TM & (1 << t))) continue;
    const h16* Vt = t ? Vt1 : Vt0;
#pragma unroll
    for (int ks = 0; ks < 2; ++ks) {
      h16x8 Pf;
#pragma unroll
      for (int i = 0; i < 4; ++i) { Pf[i] = (h16)S[t][2 * ks][i]; Pf[4 + i] = (h16)S[t][2 * ks + 1][i]; }
#pragma unroll
      for (int nt = 0; nt < 4; ++nt) {
        const h16* vp = Vt + (ks * 32 + q4 * 4 + (col >> 2)) * KP + nt * 16 + 4 * (col & 3);
        const s16x4v r0 = __builtin_amdgcn_ds_read_tr16_b64_v4i16((LAS s16x4v*)vp);
        const s16x4v r1 = __builtin_amdgcn_ds_read_tr16_b64_v4i16((LAS s16x4v*)(vp + 16 * KP));
        const h16x4 v0 = __builtin_bit_cast(h16x4, r0), v1 = __builtin_bit_cast(h16x4, r1);
        const h16x8 Vf = {v0[0], v0[1], v0[2], v0[3], v1[0], v1[1], v1[2], v1[3]};
        O[nt] = __builtin_amdgcn_mfma_f32_16x16x32_f16(Vf, Pf, O[nt], 0, 0, 0);
      }
    }
  }
  __builtin_amdgcn_s_setprio(0);
}

template <int D, class LoadF, class StoreF, class CompF>
__device__ __forceinline__ void pair_pipeline(int n, LoadF load, StoreF store, CompF comp) {
  h16x8 r[D][4];
#pragma unroll
  for (int d = 0; d < D; ++d)
    if (d < n) load(d, r[d]);
  store(0, r[0]);
  if (D < n) load(D, r[0]);
  __syncthreads();
  for (int i0 = 0; i0 < n; i0 += D) {
#pragma unroll
    for (int d = 0; d < D; ++d) {
      const int i = i0 + d;
      if (i < n) {
        if (i + 1 < n) store(i + 1, r[(d + 1) % D]);
        if (i + 1 + D < n) load(i + 1 + D, r[(d + 1) % D]);
        comp(i);
        __syncthreads();
      }
    }
  }
}

template <int D, class LoadF, class StoreF, class CompF>
__device__ __forceinline__ void tile_pipeline(int n, LoadF load, StoreF store, CompF comp) {
  h16x8 rk[D], rv[D];
#pragma unroll
  for (int d = 0; d < D; ++d)
    if (d < n) load(d, rk[d], rv[d]);
  store(0, rk[0], rv[0]);
  if (D < n) load(D, rk[0], rv[0]);
  __syncthreads();
  for (int i0 = 0; i0 < n; i0 += D) {
#pragma unroll
    for (int d = 0; d < D; ++d) {
      const int i = i0 + d;
      if (i < n) {
        if (i + 1 < n) store(i + 1, rk[(d + 1) % D], rv[(d + 1) % D]);
        if (i + 1 + D < n) load(i + 1 + D, rk[(d + 1) % D], rv[(d + 1) % D]);
        comp(i);
        __syncthreads();
      }
    }
  }
}

constexpr int LDS_BIAS = 800 * 16;
__device__ __forceinline__ void phase_swa(const Params& p, int l, char* lds, unsigned* ctr, int* slot) {
  const int tid = opaque_tid(), lane = tid & 63, w = tid >> 6, col = lane & 15, q4 = lane >> 4;
  float* biasT = (float*)lds;
  h16* KV = (h16*)(lds + LDS_BIAS);
  float* nrm = (float*)(lds + LDS_BIAS + 4 * 64 * KP * 2);
  const h16* P = (const h16*)(WS(p) + O_P);
  const int* lut = (const int*)(WS(p) + O_LUT);
  h16* OAC = (h16*)(WS(p) + O_OAC);
  __syncthreads();
  for (int i = tid; i < 3200; i += NT) biasT[i] = p.in[5][lut[i % 800] * 8 + (i / 800)] * LOG2E;
  __syncthreads();
  const int head = w >> 1, kvh = w >> 2;
  const float sink = p.in[4][l * 4 + head] * LOG2E;
  const int srow = tid >> 3, c8 = tid & 7;
  float hpd[2][4], hpe[2][4];
  const bool nosel[2] = {false, false};
  for (int u = fetch_unit(ctr, slot); u < BATCH * 128; u = fetch_unit(ctr, slot)) {
    const int b = u >> 7, t0 = (u & 127) * 64;
    const h16* Pbat = P + (size_t)b * SEQ * IWP;
    h16x8 Q[2][2];
    int tq[2];
#pragma unroll
    for (int rg = 0; rg < 2; ++rg) {
      const int qb = (w & 1) * 32 + rg * 16;
      const h16* qp = Pbat + (size_t)(t0 + qb + col) * IWP + head * 64 + q4 * 8;
      Q[rg][0] = *(const h16x8*)qp;
      Q[rg][1] = *(const h16x8*)(qp + 32);
      tq[rg] = t0 + qb + col;
    }
    f32x4 O[2][4];
    ColState st[2];
#pragma unroll
    for (int rg = 0; rg < 2; ++rg) {
#pragma unroll
      for (int nt = 0; nt < 4; ++nt) O[rg][nt] = f32x4{0.f, 0.f, 0.f, 0.f};
      st[rg].m = -1e30f; st[rg].l = 0.f;
    }
    const int i0 = t0 >= 128 ? 0 : (t0 >= 64 ? 1 : 2);
    h16x8 rk[2], rv[2];
    {
      int sb = t0 - 128 + i0 * 64;
      for (int h2 = 0; h2 < 2; ++h2) {
        rk[h2] = ld_row8(Pbat + 256 + h2 * 64, IWP, sb + srow, SEQ, c8);
        rv[h2] = ld_row8(Pbat + 384 + h2 * 64, IWP, sb + srow, SEQ, c8);
      }
    }
    for (int i = i0; i < 3; ++i) {
      __syncthreads();
      for (int h2 = 0; h2 < 2; ++h2) {
        st_k(KV + h2 * 64 * KP, srow, c8, rk[h2]);
        st_k(KV + (2 + h2) * 64 * KP, srow, c8, rv[h2]);
      }
      __syncthreads();
      if (i + 1 < 3) {
        int sb = t0 - 128 + (i + 1) * 64;
        for (int h2 = 0; h2 < 2; ++h2) {
          rk[h2] = ld_row8(Pbat + 256 + h2 * 64, IWP, sb + srow, SEQ, c8);
          rv[h2] = ld_row8(Pbat + 384 + h2 * 64, IWP, sb + srow, SEQ, c8);
        }
      }
      const int kb = t0 - 128 + i * 64;
      attn_tile<M_SWA, 3>(Q, O, st, KV + kvh * 64 * KP, KV + (2 + kvh) * 64 * KP, biasT, tq, head, kb, false, nosel, hpd, hpe, lane);
    }
    __syncthreads();
#pragma unroll
    for (int rg = 0; rg < 2; ++rg) {
      const int qb = (w & 1) * 32 + rg * 16;
      const float lsum = sum4q(st[rg].l);
      const float mn = fmaxf(st[rg].m, sink);
      const float corr = __builtin_amdgcn_exp2f(st[rg].m - mn);
      const float inv = corr / (lsum * corr + __builtin_amdgcn_exp2f(sink - mn));
      float ss = 0.f;
#pragma unroll
      for (int nt = 0; nt < 4; ++nt) {
        O[rg][nt] *= inv;
#pragma unroll
        for (int j = 0; j < 4; ++j) ss += O[rg][nt][j] * O[rg][nt][j];
      }
      ss = sum4q(ss);
      if (q4 == 0) nrm[head * 64 + qb + col] = ss;
    }
    __syncthreads();
#pragma unroll
    for (int rg = 0; rg < 2; ++rg) {
      const int qi = (w & 1) * 32 + rg * 16 + col;
      const float tot = nrm[qi] + nrm[64 + qi] + nrm[128 + qi] + nrm[192 + qi];
      const float sc = rsqrtf(tot * (1.f / 256.f) + EPS);
#pragma unroll
      for (int nt = 0; nt < 4; ++nt)
        *(h16x4*)(OAC + ((size_t)b * SEQ + t0 + qi) * 1024 + head * 64 + nt * 16 + q4 * 4) =
            pack4(O[rg][nt][0] * sc, O[rg][nt][1] * sc, O[rg][nt][2] * sc, O[rg][nt][3] * sc);
    }
  }
}

constexpr int LDS_NSA = LDS_BIAS + 8 * 64 * KP * 2 + NW * 4 * 128 * 4 + 32 * 16;
constexpr int PFD = 2;
__device__ __forceinline__ void phase_nsa(const Params& p, int l, char* lds, unsigned* ctr, int* slot, const int parts = 15) {
  const int tid = opaque_tid(), lane = tid & 63, w = tid >> 6, col = lane & 15, q4 = lane >> 4;
  float* biasT = (float*)lds;
  h16* KV0 = (h16*)(lds + LDS_BIAS);
  float* impw = (float*)(lds + LDS_BIAS + 8 * 64 * KP * 2) + w * 4 * 128;
  unsigned long long* selm = (unsigned long long*)(lds + LDS_BIAS + 8 * 64 * KP * 2 + NW * 4 * 128 * 4);
#define KSB(i, t) (KV0 + (((i) & 1) * 4 + (t) * 2) * 64 * KP)
#define VTB(i, t) (KV0 + (((i) & 1) * 4 + (t) * 2 + 1) * 64 * KP)
  const h16* P = (const h16*)(WS(p) + O_P);
  const int* lut = (const int*)(WS(p) + O_LUT);
  h16* OAC = (h16*)(WS(p) + O_OAC);
  __syncthreads();
  for (int i = tid; i < 3200; i += NT) biasT[i] = p.in[5][lut[i % 800] * 8 + 4 + (i / 800)] * LOG2E;
  __syncthreads();
  const int srow = tid >> 3, c8 = tid & 7;
  const int hd = col & 3, qw = col >> 2;
  float hpd[2][4], hpe[2][4];
  const bool nosel[2] = {false, false};
  for (int u = fetch_unit(ctr, slot); u < 1024; u = fetch_unit(ctr, slot)) {
    const int rnd = u >> 8, b = (u & 255) >> 6, ti = u & 63;
    const int tile = rnd == 0 ? 255 - ti : (rnd == 1 ? 128 + ti : (rnd == 2 ? 127 - ti : ti));
    const int t0 = tile * 32, cur = t0 >> 6;
    const h16* Pbat = P + (size_t)b * SEQ * IWP;
    const h16* KC = (const h16*)(WS(p) + O_KCMP) + (size_t)b * 512 * 64;
    const h16* VC = (const h16*)(WS(p) + O_VCMP) + (size_t)b * 512 * 64;
    h16x8 Q[2];
    int tq;
    {
      const h16* qp = Pbat + (size_t)(t0 + w * 4 + qw) * IWP + OFF_QC + hd * 64 + q4 * 8;
      Q[0] = *(const h16x8*)qp;
      Q[1] = *(const h16x8*)(qp + 32);
      tq = t0 + w * 4 + qw;
    }
    const h16* gp = Pbat + (size_t)tq * IWP + OFF_GC + hd * 3;
    for (int i = lane; i < 512; i += 64) impw[i] = 0.f;
    f32x4 O[4], Oc[4];
    ColState st;
    int mvmax = t0 / 16 + 1;
    if (mvmax > NCMP) mvmax = NCMP;
    const int ntc = (mvmax + 63) >> 6;
    st.m = -1e30f; st.l = 0.f;
    const int npc = (ntc + 1) >> 1;
    if (parts & 1) pair_pipeline<PFD>(npc,
      [&](int i, h16x8 (&r)[4]) { r[0] = ld_row8(KC, 64, (2 * i) * 64 + srow, 512, c8); r[2] = ld_row8(KC, 64, (2 * i + 1) * 64 + srow, 512, c8); },
      [&](int i, const h16x8 (&r)[4]) { st_k(KSB(i, 0), srow, c8, r[0]); st_k(KSB(i, 1), srow, c8, r[2]); },
      [&](int i) {
        const bool far[2] = {t0 - 31 - 16 * (2 * i * 64 + 63) >= 799, t0 - 31 - 16 * ((2 * i + 1) * 64 + 63) >= 799};
        if (2 * i + 1 < ntc) attn_tile2<M_CMPA, 3>(Q, O, st, KSB(i, 0), VTB(i, 0), KSB(i, 1), VTB(i, 1), biasT, tq, hd, 2 * i * 64, far, nosel, hpd, hpe, lane);
        else attn_tile2<M_CMPA, 1>(Q, O, st, KSB(i, 0), VTB(i, 0), KSB(i, 1), VTB(i, 1), biasT, tq, hd, 2 * i * 64, far, nosel, hpd, hpe, lane);
      });
    {
      const float ls = sum4q(st.l);
      st.l = ls > 0.f ? 1.f / ls : 0.f;
    }
#pragma unroll
    for (int nt = 0; nt < 4; ++nt) O[nt] = f32x4{0.f, 0.f, 0.f, 0.f};
    float carry = 0.f;
    if (parts & 1) pair_pipeline<PFD>(npc,
      [&](int i, h16x8 (&r)[4]) {
        r[0] = ld_row8(KC, 64, (2 * i) * 64 + srow, 512, c8); r[1] = ld_row8(VC, 64, (2 * i) * 64 + srow, 512, c8);
        r[2] = ld_row8(KC, 64, (2 * i + 1) * 64 + srow, 512, c8); r[3] = ld_row8(VC, 64, (2 * i + 1) * 64 + srow, 512, c8); },
      [&](int i, const h16x8 (&r)[4]) {
        st_k(KSB(i, 0), srow, c8, r[0]); st_k(VTB(i, 0), srow, c8, r[1]); st_k(KSB(i, 1), srow, c8, r[2]); st_k(VTB(i, 1), srow, c8, r[3]); },
      [&](int i) {
        float hq[2][4], h3[2][4];
        const bool far[2] = {t0 - 31 - 16 * (2 * i * 64 + 63) >= 799, t0 - 31 - 16 * ((2 * i + 1) * 64 + 63) >= 799};
        const bool two = 2 * i + 1 < ntc;
        if (two) attn_tile2<M_CMPB, 3>(Q, O, st, KSB(i, 0), VTB(i, 0), KSB(i, 1), VTB(i, 1), biasT, tq, hd, 2 * i * 64, far, nosel, hq, h3, lane);
        else attn_tile2<M_CMPB, 1>(Q, O, st, KSB(i, 0), VTB(i, 0), KSB(i, 1), VTB(i, 1), biasT, tq, hd, 2 * i * 64, far, nosel, hq, h3, lane);
        float t3p = carry;
#pragma unroll
        for (int t = 0; t < 2; ++t) {
          if (t == 1 && !two) break;
#pragma unroll
          for (int kt = 0; kt < 4; ++kt) {
            const float qs = quadsum(hq[t][kt]);
            const float t3 = quadsum(h3[t][kt]);
            const float up = __shfl(t3, (lane + 48) & 63);
            const float wrp = __shfl(t3p, (lane + 48) & 63);
            const float pk = (q4 == 0) ? wrp : up;
            if (hd == 0) impw[qw * 128 + (2 * i + t) * 16 + kt * 4 + q4] = qs + pk;
            t3p = t3;
          }
        }
        carry = t3p;
      });
    {
      const float g0 = (float)gp[0];
#pragma unroll
      for (int nt = 0; nt < 4; ++nt) Oc[nt] = O[nt] * g0;
    }
    if (parts & 2) {
      const int nforced = cur >= 2 ? 3 : cur + 1;
      const int npick = 16 - nforced;
      for (int qi = 0; qi < 4; ++qi) {
        const float* im = impw + qi * 128;
        const int j0 = lane, j1 = lane + 64;
        const float v0 = im[j0], v1 = im[j1];
        int r0 = 0, r1 = 0;
#pragma unroll 8
        for (int jp = 1; jp <= cur - 2; ++jp) {
          float vp = im[jp];
          r0 += (vp > v0 || (vp == v0 && jp < j0)) ? 1 : 0;
          r1 += (vp > v1 || (vp == v1 && jp < j1)) ? 1 : 0;
        }
        bool c0 = j0 >= 1 && j0 <= cur - 2, c1 = j1 <= cur - 2;
        bool f0 = j0 == 0 || j0 == cur || j0 == cur - 1, f1 = j1 == cur || j1 == cur - 1;
        unsigned long long mlo = __ballot(f0 || (c0 && r0 < npick));
        unsigned long long mhi = __ballot(f1 || (c1 && r1 < npick));
        if (lane == 0) { selm[(w * 4 + qi) * 2] = mlo; selm[(w * 4 + qi) * 2 + 1] = mhi; }
      }
    }
    asm volatile("" ::: "memory");
    const unsigned long long slo = selm[(w * 4 + qw) * 2], shi = selm[(w * 4 + qw) * 2 + 1];
#pragma unroll
    for (int nt = 0; nt < 4; ++nt) O[nt] = f32x4{0.f, 0.f, 0.f, 0.f};
    st.m = -1e30f; st.l = 0.f;
    if (parts & 4) pair_pipeline<PFD>((cur + 2) >> 1,
      [&](int i, h16x8 (&r)[4]) {
        r[0] = ld_row8(Pbat + OFF_KVC + 128, IWP, (2 * i) * 64 + srow, SEQ, c8); r[1] = ld_row8(Pbat + OFF_KVC + 192, IWP, (2 * i) * 64 + srow, SEQ, c8);
        r[2] = ld_row8(Pbat + OFF_KVC + 128, IWP, (2 * i + 1) * 64 + srow, SEQ, c8); r[3] = ld_row8(Pbat + OFF_KVC + 192, IWP, (2 * i + 1) * 64 + srow, SEQ, c8); },
      [&](int i, const h16x8 (&r)[4]) {
        st_k(KSB(i, 0), srow, c8, r[0]); st_k(VTB(i, 0), srow, c8, r[1]); st_k(KSB(i, 1), srow, c8, r[2]); st_k(VTB(i, 1), srow, c8, r[3]); },
      [&](int i) {
        const int jb = 2 * i;
        bool sb[2];
        sb[0] = ((jb < 64 ? (slo >> jb) : (shi >> (jb - 64))) & 1ull) != 0;
        sb[1] = (jb + 1 <= cur) && (((jb + 1 < 64 ? (slo >> (jb + 1)) : (shi >> (jb + 1 - 64))) & 1ull) != 0);
        const bool far[2] = {t0 - (jb * 64 + 63) >= 799, t0 - (jb * 64 + 127) >= 799};
        const bool n0 = __any(sb[0]) != 0, n1 = __any(sb[1]) != 0;
        if (n0 && n1) attn_tile2<M_SEL, 3>(Q, O, st, KSB(i, 0), VTB(i, 0), KSB(i, 1), VTB(i, 1), biasT, tq, hd, jb * 64, far, sb, hpd, hpe, lane);
        else if (n0) attn_tile2<M_SEL, 1>(Q, O, st, KSB(i, 0), VTB(i, 0), KSB(i, 1), VTB(i, 1), biasT, tq, hd, jb * 64, far, sb, hpd, hpe, lane);
        else if (n1) attn_tile2<M_SEL, 2>(Q, O, st, KSB(i, 0), VTB(i, 0), KSB(i, 1), VTB(i, 1), biasT, tq, hd, jb * 64, far, sb, hpd, hpe, lane);
      });
    {
      const float ls = sum4q(st.l);
      const float f = ls > 0.f ? (float)gp[1] / ls : 0.f;
#pragma unroll
      for (int nt = 0; nt < 4; ++nt) Oc[nt] += O[nt] * f;
    }
#pragma unroll
    for (int nt = 0; nt < 4; ++nt) O[nt] = f32x4{0.f, 0.f, 0.f, 0.f};
    st.m = -1e30f; st.l = 0.f;
    const int w0 = cur >= 8 ? cur - 8 : 0;
    const int nwt = cur - w0 + 1;
    if (parts & 8) pair_pipeline<PFD>((nwt + 1) >> 1,
      [&](int i, h16x8 (&r)[4]) {
        r[0] = ld_row8(Pbat + OFF_KVC + 256, IWP, (w0 + 2 * i) * 64 + srow, SEQ, c8); r[1] = ld_row8(Pbat + OFF_KVC + 320, IWP, (w0 + 2 * i) * 64 + srow, SEQ, c8);
        r[2] = ld_row8(Pbat + OFF_KVC + 256, IWP, (w0 + 2 * i + 1) * 64 + srow, SEQ, c8); r[3] = ld_row8(Pbat + OFF_KVC + 320, IWP, (w0 + 2 * i + 1) * 64 + srow, SEQ, c8); },
      [&](int i, const h16x8 (&r)[4]) {
        st_k(KSB(i, 0), srow, c8, r[0]); st_k(VTB(i, 0), srow, c8, r[1]); st_k(KSB(i, 1), srow, c8, r[2]); st_k(VTB(i, 1), srow, c8, r[3]); },
      [&](int i) {
        const bool far[2] = {false, false};
        if (2 * i + 1 < nwt) attn_tile2<M_WIN, 3>(Q, O, st, KSB(i, 0), VTB(i, 0), KSB(i, 1), VTB(i, 1), biasT, tq, hd, (w0 + 2 * i) * 64, far, nosel, hpd, hpe, lane);
        else attn_tile2<M_WIN, 1>(Q, O, st, KSB(i, 0), VTB(i, 0), KSB(i, 1), VTB(i, 1), biasT, tq, hd, (w0 + 2 * i) * 64, far, nosel, hpd, hpe, lane);
      });
    {
      const float ls = sum4q(st.l);
      const float f = ls > 0.f ? (float)gp[2] / ls : 0.f;
      float ss = 0.f;
#pragma unroll
      for (int nt = 0; nt < 4; ++nt) {
        Oc[nt] += O[nt] * f;
#pragma unroll
        for (int j = 0; j < 4; ++j) ss += Oc[nt][j] * Oc[nt][j];
      }
      ss = quadsum(sum4q(ss));
      const float sc = rsqrtf(ss * (1.f / 256.f) + EPS);
#pragma unroll
      for (int nt = 0; nt < 4; ++nt)
        *(h16x4*)(OAC + ((size_t)b * SEQ + tq) * 1024 + 256 + hd * 64 + nt * 16 + q4 * 4) =
            pack4(Oc[nt][0] * sc, Oc[nt][1] * sc, Oc[nt][2] * sc, Oc[nt][3] * sc);
    }
  }
#undef KSB
#undef VTB
}

constexpr int LDS_SWA = LDS_BIAS + 4 * 64 * KP * 2 + 1024;
constexpr int lds_max(int a, int b) { return a > b ? a : b; }
constexpr int LDS_BYTES = lds_max(lds_max(LDS_NSA, SSMY_LDS), lds_max(LDS_SWA, lds_max(LDS_GEMM, lds_max(LDS_CMP, 64 * 65 * 4))));

__global__ void __launch_bounds__(NT) fwd_megakernel(Params p) {
  cg::grid_group grid = cg::this_grid();
  __shared__ __attribute__((aligned(16))) char lds[LDS_BYTES];
  __shared__ uint4 xb_words;
  __shared__ int wq_slot;
  if (threadIdx.x == 0) xb_words = make_uint4(0u, 0u, 0u, 0u);
  __syncthreads();
  (void)xcd_barrier_post((unsigned*)(WS(p) + O_BAR), (volatile LAS unsigned*)&xb_words);
#define GBAR() do { XcdBarrier _b; _b.bar = (unsigned*)(WS(p) + O_BAR); _b.x = xb_xcc_id(); _b.st = (volatile LAS unsigned*)&xb_words; xcd_barrier(_b); } while (0)
  phase0(p, (float*)lds);
  grid.sync();
  phase0b(p);
  GBAR();
  for (int l = 0; l < DEPTH; ++l) {
    phase_gemm1(p, l, lds);
    GBAR();
    ssm_endstates(p, l, lds);
    phase_compress(p, l, lds);
    GBAR();
    {
      unsigned* q = (unsigned*)(WS(p) + O_BAR) + 3456 + l * 3 * 64;
      phase_nsa(p, l, lds, q, &wq_slot);
      ssm_outputs(p, l, lds, q + 64, &wq_slot);
      phase_swa(p, l, lds, q + 128, &wq_slot);
    }
    GBAR();
    phase_glu(p, l, lds);
    GBAR();
    phase_wout(p, l, lds);
    GBAR();
    phase_up(p, l, lds);
    GBAR();
    phase_down(p, l, lds);
    GBAR();
  }
}

extern "C" void kernel_launch(void* const* d_in, const int* in_sizes, int n_in, void* d_out, int out_size, void* d_ws,
                              size_t ws_size, hipStream_t stream) {
  static int grid_blocks = 0;
  if (!grid_blocks) {
    int dev = 0, cus = 0, per_cu = 0;
    (void)hipGetDevice(&dev);
    (void)hipDeviceGetAttribute(&cus, hipDeviceAttributeMultiprocessorCount, dev);
    (void)hipOccupancyMaxActiveBlocksPerMultiprocessor(&per_cu, fwd_megakernel, NT, 0);
    if (per_cu > 1) per_cu = 1;
    grid_blocks = cus * per_cu;
  }
  if (ws_size < WS_NEED) {
    fprintf(stderr, "workspace too small: %zu < %zu\n", ws_size, WS_NEED);
    return;
  }
  Params p{};
  for (int i = 0; i < 24; ++i) p.in[i] = (const float*)d_in[i];
  p.out = (float*)d_out;
  p.ws = (char*)d_ws;
  (void)hipMemsetAsync((char*)d_ws + O_BAR, 0, SZ_BAR, stream);
  void* args[] = {&p};
  hipError_t e = hipLaunchCooperativeKernel((void*)fwd_megakernel, dim3(grid_blocks), dim3(NT), args, 0, stream);
  if (e != hipSuccess) fprintf(stderr, "cooperative launch failed: %s (grid %d)\n", hipGetErrorString(e), grid_blocks);
}
```

```cpp
#include <hip/hip_runtime.h>
#include <hip/hip_cooperative_groups.h>
#include <cstdio>
namespace cg = cooperative_groups;

typedef _Float16 h16;
typedef __attribute__((ext_vector_type(8))) _Float16 h16x8;
typedef __attribute__((ext_vector_type(4))) float f32x4;

constexpr int NT = 512;
constexpr int NW = NT / 64;
constexpr int BATCH = 4, SEQ = 8192, NTOK = BATCH * SEQ, DM = 1024, DEPTH = 4, IW = 1676, IWP = 1792, DFF = 4096;
constexpr int OFF_U = 512, OFF_QC = 1024, OFF_KVC = 1280, OFF_GC = 1664;
constexpr int NCMP = 511;
constexpr float EPS = 1e-6f;

constexpr size_t SZ_WIN = (size_t)IWP * DM * 2, SZ_WGLU = (size_t)1024 * 512 * 2, SZ_WOUT = (size_t)DM * DM * 2,
                 SZ_WUP = (size_t)DFF * DM * 2, SZ_WDN = (size_t)DM * DFF * 2;
constexpr size_t O_WIN = 0;
constexpr size_t O_WGLU = O_WIN + DEPTH * SZ_WIN;
constexpr size_t O_WOUT = O_WGLU + DEPTH * SZ_WGLU;
constexpr size_t O_WUP = O_WOUT + DEPTH * SZ_WOUT;
constexpr size_t O_WDN = O_WUP + DEPTH * SZ_WUP;
constexpr size_t O_XB = O_WDN + DEPTH * SZ_WDN;
constexpr size_t O_SSQ = O_XB + (size_t)NTOK * DM * 2;
constexpr size_t O_SSQB = O_SSQ + (size_t)NTOK * 16 * 4;
constexpr size_t O_KCMP = O_SSQB + (size_t)NTOK * 16 * 4;
constexpr size_t O_VCMP = O_KCMP + (size_t)BATCH * 512 * 64 * 4;
constexpr size_t O_ABAR = O_VCMP + (size_t)BATCH * 512 * 64 * 4;
constexpr size_t O_BBAR = O_ABAR + (size_t)DEPTH * 32 * 64 * 8;
constexpr size_t O_BIAS1 = O_BBAR + (size_t)DEPTH * 32 * 64 * 16 * 8;
constexpr size_t O_LUT = O_BIAS1 + (size_t)DEPTH * 2 * 128 * 4;
constexpr size_t O_AT = O_LUT + 8192 * 4;
constexpr size_t O_KTAB = O_AT + (size_t)128 * 64 * 8;
constexpr size_t SZ_KTAB = (size_t)65 * 256 * 2;
constexpr size_t O_W1 = O_KTAB + 128 * SZ_KTAB;
constexpr size_t SZ_W13 = (size_t)128 * 1024 * 2;
constexpr size_t O_W3 = O_W1 + 128 * SZ_W13;
constexpr size_t O_W1T = O_W3 + 128 * SZ_W13;
constexpr size_t O_W2T = O_W1T + (size_t)8 * 128 * 2048 * 2;
constexpr size_t O_B1P = O_W2T + (size_t)8 * 64 * 128 * 2;
constexpr size_t O_BAR = (O_B1P + (size_t)8 * 32 * 128 * 4 + 255) / 256 * 256;
constexpr size_t SZ_BAR = 3456 * 4 + 16 * 64 * 4;
constexpr size_t O_BIG = (O_BAR + SZ_BAR + 255) / 256 * 256;
constexpr size_t O_APOW = O_BIG;
constexpr size_t O_P = O_BIG;
constexpr size_t O_Z = O_P + (size_t)NTOK * IWP * 2;
constexpr size_t O_OB = O_Z + (size_t)NTOK * 512 * 2;
constexpr size_t O_OAC = O_OB + (size_t)512 * 2;
constexpr size_t O_E = O_OB + (size_t)NTOK * 1024 * 2;
constexpr size_t O_HID = O_BIG;
constexpr size_t WS_NEED = O_BIG + (size_t)NTOK * DFF * 2;

struct Params {
  const float* in[24];
  float* out;
  char* ws;
};

__device__ __forceinline__ char* WS(const Params& p) {
  int z;
  asm volatile("s_mov_b32 %0, 0" : "=s"(z));
  return p.ws + z;
}
__device__ __forceinline__ int fetch_unit(unsigned* ctr, int* slot) {
  __syncthreads();
  if (threadIdx.x == 0) *slot = (int)atomicAdd(ctr, 1u);
  __syncthreads();
  return *slot;
}
__device__ __forceinline__ int opaque_tid() {
  int t = threadIdx.x;
  asm volatile("" : "+v"(t));
  return t;
}
template <int CTRL>
__device__ __forceinline__ float dppf(float v) {
  return __int_as_float(__builtin_amdgcn_update_dpp(0, __float_as_int(v), CTRL, 0xF, 0xF, true));
}
__device__ __forceinline__ float sum16(float v) {
  v += dppf<0xB1>(v); v += dppf<0x4E>(v); v += dppf<0x141>(v); v += dppf<0x140>(v);
  return v;
}
__device__ __forceinline__ float max16(float v) {
  v = fmaxf(v, dppf<0xB1>(v)); v = fmaxf(v, dppf<0x4E>(v)); v = fmaxf(v, dppf<0x141>(v)); v = fmaxf(v, dppf<0x140>(v));
  return v;
}
__device__ __forceinline__ float xor16(float v) { return __int_as_float(__builtin_amdgcn_ds_swizzle(__float_as_int(v), 0x401F)); }
__device__ __forceinline__ float rdlane_c(float v, int l) { return __int_as_float(__builtin_amdgcn_readlane(__float_as_int(v), l)); }
__device__ __forceinline__ float wave_sum(float v) {
  v = sum16(v); v += xor16(v);
  return rdlane_c(v, 0) + rdlane_c(v, 32);
}
__device__ __forceinline__ float gelu_tanh(float x) {
  float u = 0.7978845608028654f * (x + 0.044715f * x * x * x);
  return 0.5f * x * (1.f + tanhf(u));
}
__device__ __forceinline__ float sigmoidf(float x) { return 1.f / (1.f + __expf(-x)); }
__device__ __forceinline__ float rdlane(float v, int l) {
  return __int_as_float(__builtin_amdgcn_readlane(__float_as_int(v), l));
}

__device__ __forceinline__ int perm32(int rho) { return 8 * ((rho & 15) >> 2) + 4 * (rho >> 4) + (rho & 3); }

template <class SrcF>
__device__ __forceinline__ void conv_tile(SrcF src, h16* dst, int ldo, int n0, int k0, float* tile) {
  int tid = opaque_tid();
  for (int idx = tid; idx < 4096; idx += NT) {
    int kk = idx >> 6, nn = idx & 63;
    tile[kk * 65 + nn] = src(k0 + kk, n0 + nn);
  }
  __syncthreads();
  for (int idx = tid; idx < 4096; idx += NT) {
    int nn = idx >> 6, kk = idx & 63;
    dst[(long)(n0 + nn) * ldo + k0 + kk] = (h16)tile[kk * 65 + nn];
  }
  __syncthreads();
}

template <class SrcF>
__device__ __forceinline__ void conv_tile_h(SrcF src, h16* dst, int ldo, int n0, int k0, float* tile, int t, bool act) {
  if (act)
    for (int idx = t; idx < 4096; idx += 256) {
      int kk = idx >> 6, nn = idx & 63;
      tile[kk * 65 + nn] = src(k0 + kk, n0 + nn);
    }
  __syncthreads();
  if (act)
    for (int idx = t; idx < 4096; idx += 256) {
      int nn = idx >> 6, kk = idx & 63;
      dst[(long)(n0 + nn) * ldo + k0 + kk] = (h16)tile[kk * 65 + nn];
    }
  __syncthreads();
}

__device__ __forceinline__ void phase0(const Params& p, float* lds) {
  const int tid = opaque_tid();
  constexpr int T_IN = (IWP / 64) * (DM / 64);
  constexpr int T_GLU = 16 * 8;
  constexpr int T_OUT = 16 * 16;
  constexpr int T_UP = 64 * 16;
  constexpr int T_DN = 16 * 64;
  constexpr int T_L = T_IN + T_GLU + T_OUT + T_UP + T_DN;
  const int hf = tid >> 8, t8 = tid & 255;
  float* ldh = lds + hf * (64 * 65 + 16);
  for (int tp = blockIdx.x; tp * 2 < DEPTH * T_L; tp += gridDim.x) {
    const int ti = tp * 2 + hf;
    const bool act = ti < DEPTH * T_L;
    int l = act ? ti / T_L : 0, r = act ? ti % T_L : 0;
    if (r < T_IN) {
      int nt = r / 16, kt = r % 16;
      const float* w = p.in[2] + (size_t)l * DM * IW;
      const float* g = p.in[1] + l * DM;
      conv_tile_h([&](int k, int sl) {
        int n = (sl & ~255) + 64 * ((sl >> 5) & 3) + 32 * ((sl >> 7) & 1) + perm32(sl & 31);
        return n < IW ? w[(long)k * IW + n] * g[k] : 0.f; },
                (h16*)(WS(p) + O_WIN + l * SZ_WIN), DM, nt * 64, kt * 64, ldh, t8, act);
    } else if ((r -= T_IN) < T_GLU) {
      int nt = r / 8, kt = r % 8;
      const float* w = p.in[14] + (size_t)l * 512 * 1024;
      conv_tile_h([&](int k, int n2) {
        int pn = n2 >> 8, bj = (n2 >> 7) & 1, wc = (n2 >> 5) & 3, nn = (n2 >> 4) & 1, r = n2 & 15;
        int n = (nn ? 512 : 0) + 128 * pn + 64 * bj + 16 * wc + r;
        return w[(long)k * 1024 + n]; },
                (h16*)(WS(p) + O_WGLU + l * SZ_WGLU), 512, nt * 64, kt * 64, ldh, t8, act);
    } else if ((r -= T_GLU) < T_OUT) {
      int nt = r / 16, kt = r % 16;
      const float* w = p.in[20] + (size_t)l * DM * DM;
      const float* g = p.in[19] + l * DM;
      conv_tile_h([&](int k2, int n2) {
        int k = k2 < 512 ? 256 + k2 : (k2 < 768 ? k2 - 512 : k2);
        int n = (n2 & ~31) + perm32(n2 & 31);
        return w[(long)k * DM + n] * g[k]; },
                (h16*)(WS(p) + O_WOUT + l * SZ_WOUT), DM, nt * 64, kt * 64, ldh, t8, act);
    } else if ((r -= T_OUT) < T_UP) {
      int nt = r / 16, kt = r % 16;
      const float* w = p.in[22] + (size_t)l * DM * DFF;
      const float* g = p.in[21] + l * DM;
      conv_tile_h([&](int k, int n2) { int n = (n2 & ~31) + perm32(n2 & 31); return w[(long)k * DFF + n] * g[k]; },
                (h16*)(WS(p) + O_WUP + l * SZ_WUP), DM, nt * 64, kt * 64, ldh, t8, act);
    } else {
      r -= T_UP;
      int nt = r / 64, kt = r % 64;
      const float* w = p.in[23] + (size_t)l * DFF * DM;
      conv_tile_h([&](int k, int n2) { int n = (n2 & ~31) + perm32(n2 & 31); return w[(long)k * DM + n]; },
                (h16*)(WS(p) + O_WDN + l * SZ_WDN), DFF, nt * 64, kt * 64, ldh, t8, act);
    }
  }
  for (int ti = blockIdx.x; ti < 8 * 66; ti += gridDim.x) {
    int ls = ti / 66, r = ti % 66;
    if (r < 64) {
      int nt = r >> 5, kt = r & 31;
      const float* w = p.in[17] + (size_t)ls * 2048 * 128;
      conv_tile([&](int k, int n) { return w[(long)k * 128 + n]; }, (h16*)(WS(p) + O_W1T) + (size_t)ls * 128 * 2048, 2048, nt * 64, kt * 64, lds);
    } else {
      int kt = r - 64;
      const float* w = p.in[18] + (size_t)ls * 128 * 64;
      conv_tile([&](int k, int n) { return w[(long)k * 64 + n]; }, (h16*)(WS(p) + O_W2T) + (size_t)ls * 64 * 128, 128, 0, kt * 64, lds);
    }
  }
  {
    const int lane = tid & 63;
    const int gw = blockIdx.x * NW + (tid >> 6), nw = gridDim.x * NW;
    const float* x = p.in[0];
    h16* xb = (h16*)(WS(p) + O_XB);
    float* ssq = (float*)(WS(p) + O_SSQ);
    for (int row = gw; row < NTOK; row += nw) {
      const float4* xr = (const float4*)(x + (long)row * DM + lane * 16);
      float s = 0.f;
      h16 hv[16];
      for (int i = 0; i < 4; ++i) {
        float4 v = xr[i];
        s += v.x * v.x + v.y * v.y + v.z * v.z + v.w * v.w;
        hv[i * 4 + 0] = (h16)v.x; hv[i * 4 + 1] = (h16)v.y; hv[i * 4 + 2] = (h16)v.z; hv[i * 4 + 3] = (h16)v.w;
      }
      h16x8* xo = (h16x8*)(xb + (long)row * DM + lane * 16);
      h16x8 o0, o1;
      for (int i = 0; i < 8; ++i) { o0[i] = hv[i]; o1[i] = hv[8 + i]; }
      xo[0] = o0; xo[1] = o1;
      s += dppf<0xB1>(s);
      s += dppf<0x4E>(s);
      if ((lane & 3) == 0) ssq[(long)row * 16 + (lane >> 2)] = s;
    }
  }
  const int gt = blockIdx.x * NT + tid, ngt = gridDim.x * NT;
  for (int i = gt; i < DEPTH * 32 * 64; i += ngt) {
    int l = i / 2048, g = (i / 64) % 32;
    double are = p.in[6][i], aim = p.in[7][i];
    double dt = exp((double)p.in[8][l * 32 + g]);
    double er = exp(are * dt), abr = er * cos(aim * dt), abi = er * sin(aim * dt);
    ((float2*)(WS(p) + O_ABAR))[i] = make_float2((float)abr, (float)abi);
    double nr = abr - 1.0, ni = abi, den = are * are + aim * aim;
    double fr = (nr * are + ni * aim) / den, fi = (ni * are - nr * aim) / den;
    float2* bb = (float2*)(WS(p) + O_BBAR) + (size_t)i * 16;
    for (int q = 0; q < 16; ++q) {
      double br = p.in[9][(size_t)i * 16 + q], bi = p.in[10][(size_t)i * 16 + q];
      bb[q] = make_float2((float)((fr * br - fi * bi) / dt), (float)((fr * bi + fi * br) / dt));
    }
  }
  for (int i = gt; i < 128 * 65 * 64; i += ngt) {
    int n = i & 63, j = (i >> 6) % 65, lg = i / (65 * 64);
    double are = p.in[6][lg * 64 + n], aim = p.in[7][lg * 64 + n];
    double dt = exp((double)p.in[8][lg]);
    double er = exp(are * dt * j), ang = aim * dt * j;
    ((double2*)(WS(p) + O_APOW))[i] = make_double2(er * cos(ang), er * sin(ang));
  }
  for (int i = gt; i < DEPTH * 2 * 128 * 32; i += ngt) {
    int j = i & 127, kc = (i >> 7) & 31, ls = i >> 12;
    const float* pos = p.in[16] + (size_t)ls * 2048 + kc * 64;
    const float* w1 = p.in[17] + ((size_t)ls * 2048 + kc * 64) * 128;
    float a = 0.f;
#pragma unroll 16
    for (int k = 0; k < 64; ++k) a += pos[k] * w1[(long)k * 128 + j];
    ((float*)(WS(p) + O_B1P))[i] = a;
  }
  for (int d = gt; d < 8192; d += ngt) {
    int bk;
    if (d < 16) bk = d;
    else {
      float nf = (float)d;
      int large = 16 + (int)(logf(nf / 16.0f) / 4.1588830833596715f * 16.0f);
      bk = large < 31 ? large : 31;
    }
    ((int*)(WS(p) + O_LUT))[d] = bk;
  }
}

__device__ __forceinline__ void phase0b(const Params& p) {
  const int gt = blockIdx.x * NT + threadIdx.x, ngt = gridDim.x * NT;
  const double2* apow = (const double2*)(WS(p) + O_APOW);
  const float2* bbs = (const float2*)(WS(p) + O_BBAR);
  for (int i = gt; i < 128 * 64 * 64; i += ngt) {
    int tau = i & 63, n = (i >> 6) & 63, lg = i >> 12;
    double2 ap = apow[(lg * 65 + (63 - tau)) * 64 + n];
    const float2* bb = bbs + (size_t)(lg * 64 + n) * 16;
    h16x8 re0, re1, im0, im1;
#pragma unroll
    for (int q = 0; q < 8; ++q) {
      float2 b0 = bb[q], b1 = bb[8 + q];
      re0[q] = (h16)(float)(ap.x * b0.x - ap.y * b0.y);
      im0[q] = (h16)(float)(ap.x * b0.y + ap.y * b0.x);
      re1[q] = (h16)(float)(ap.x * b1.x - ap.y * b1.y);
      im1[q] = (h16)(float)(ap.x * b1.y + ap.y * b1.x);
    }
    h16* W1 = (h16*)(WS(p) + O_W1 + (size_t)lg * SZ_W13);
    *(h16x8*)(W1 + ((size_t)(2 * tau) * 128 + 2 * n) * 8) = re0;
    *(h16x8*)(W1 + ((size_t)(2 * tau) * 128 + 2 * n + 1) * 8) = im0;
    *(h16x8*)(W1 + ((size_t)(2 * tau + 1) * 128 + 2 * n) * 8) = re1;
    *(h16x8*)(W1 + ((size_t)(2 * tau + 1) * 128 + 2 * n + 1) * 8) = im1;
  }
  for (int i = gt; i < 128 * 64 * 16 * 16; i += ngt) {
    int pp = i & 15, kc = (i >> 4) & 15, tau = (i >> 8) & 63, lg = i >> 14;
    h16x8 v;
#pragma unroll
    for (int e = 0; e < 4; ++e) {
      int n = 4 * kc + e;
      double2 ap = apow[(lg * 65 + tau + 1) * 64 + n];
      double cr = p.in[11][((size_t)lg * 16 + pp) * 64 + n], ci = p.in[12][((size_t)lg * 16 + pp) * 64 + n];
      v[2 * e] = (h16)(float)(cr * ap.x - ci * ap.y);
      v[2 * e + 1] = (h16)(float)(-(cr * ap.y + ci * ap.x));
    }
    h16* W3 = (h16*)(WS(p) + O_W3 + (size_t)lg * SZ_W13);
    *(h16x8*)(W3 + ((size_t)((tau * 16 + kc) * 16) + pp) * 8) = v;
  }
  for (int i = gt; i < 128 * 65 * 16; i += ngt) {
    int pp = i & 15, slot = (i >> 4) % 65, lg = i / (65 * 16);
    float acc[16];
#pragma unroll
    for (int q = 0; q < 16; ++q) acc[q] = 0.f;
    if (slot > 0) {
      for (int n = 0; n < 64; ++n) {
        double2 ap = apow[(lg * 65 + slot - 1) * 64 + n];
        double cr = p.in[11][((size_t)lg * 16 + pp) * 64 + n], ci = p.in[12][((size_t)lg * 16 + pp) * 64 + n];
        float xr = (float)(cr * ap.x - ci * ap.y), xi = (float)(cr * ap.y + ci * ap.x);
        const float2* bb = bbs + (size_t)(lg * 64 + n) * 16;
#pragma unroll
        for (int q = 0; q < 16; ++q) { float2 b = bb[q]; acc[q] += xr * b.x - xi * b.y; }
      }
    }
    h16x8 v0, v1;
#pragma unroll
    for (int q = 0; q < 8; ++q) { v0[q] = (h16)acc[q]; v1[q] = (h16)acc[8 + q]; }
    h16* kt = (h16*)(WS(p) + O_KTAB + (size_t)lg * SZ_KTAB) + slot * 256 + pp * 16;
    *(h16x8*)kt = v0;
    *(h16x8*)(kt + 8) = v1;
  }
  for (int i = gt; i < 128 * 64; i += ngt) {
    double2 ap = apow[((i >> 6) * 65 + 64) * 64 + (i & 63)];
    ((float2*)(WS(p) + O_AT))[i] = make_float2((float)ap.x, (float)ap.y);
  }
  for (int i = gt; i < DEPTH * 2 * 128; i += ngt) {
    const float* pp = (const float*)(WS(p) + O_B1P) + (size_t)(i >> 7) * 32 * 128 + (i & 127);
    float a = 0.f;
    for (int kc = 0; kc < 32; ++kc) a += pp[kc * 128];
    ((float*)(WS(p) + O_BIAS1))[i] = a;
  }
}

__device__ __forceinline__ void ssm_endstates(const Params& p, int l, char* lds) {
  const int tid = opaque_tid(), lane = tid & 63, w = tid >> 6;
  const h16* P = (const h16*)(WS(p) + O_P);
  float* E = (float*)(WS(p) + O_E);
  f32x4* red = (f32x4*)lds;
  for (int ub4 = blockIdx.x; ub4 < 256; ub4 += gridDim.x) {
    const int unit = ub4 * 4 + (w & 3), kh = w >> 2;
    const int g = unit >> 5, ctile = unit & 31;
    const h16* W1 = (const h16*)(WS(p) + O_W1 + (size_t)(l * 32 + g) * SZ_W13);
    const int gch = ctile * 16 + (lane & 15);
    const h16* ub = P + (size_t)gch * 64 * IWP + OFF_U + g * 16 + ((lane >> 4) & 1) * 8 + (size_t)(lane >> 5) * IWP;
    f32x4 acc[8];
#pragma unroll
    for (int mt = 0; mt < 8; ++mt) acc[mt] = f32x4{0.f, 0.f, 0.f, 0.f};
#pragma unroll 4
    for (int kk = 0; kk < 16; ++kk) {
      const int ks = kh * 16 + kk;
      h16x8 B = *(const h16x8*)(ub + (size_t)(ks * 2) * IWP);
#pragma unroll
      for (int mt = 0; mt < 8; ++mt) {
        h16x8 A = *(const h16x8*)(W1 + ((size_t)(ks * 4 + (lane >> 4)) * 128 + mt * 16 + (lane & 15)) * 8);
        acc[mt] = __builtin_amdgcn_mfma_f32_16x16x32_f16(A, B, acc[mt], 0, 0, 0);
      }
    }
    __syncthreads();
    if (kh == 1) {
#pragma unroll
      for (int mt = 0; mt < 8; ++mt) red[((w & 3) * 8 + mt) * 64 + lane] = acc[mt];
    }
    __syncthreads();
    if (kh == 0) {
#pragma unroll
      for (int mt = 0; mt < 8; ++mt)
        *(f32x4*)(E + ((size_t)gch * 32 + g) * 128 + mt * 16 + (lane >> 4) * 4) = acc[mt] + red[((w & 3) * 8 + mt) * 64 + lane];
    }
  }
}

constexpr int BU_PITCH = 1040, BS_PITCH = 144;
constexpr int SSMY_LDS = 65 * 512 + 16 * BU_PITCH * 2 + 16 * BS_PITCH * 2 + 128 * 64 * 8;
__device__ __forceinline__ void ssm_outputs(const Params& p, int l, char* lds, unsigned* ctr, int* slot) {
  const int tid = opaque_tid(), lane = tid & 63, w = tid >> 6;
  h16* Kt = (h16*)lds;
  h16* Bu = (h16*)(lds + 65 * 512);
  h16* Bs = (h16*)(lds + 65 * 512 + 16 * BU_PITCH * 2);
  float2* Es = (float2*)(lds + 65 * 512 + 16 * BU_PITCH * 2 + 16 * BS_PITCH * 2);
  const h16* P = (const h16*)(WS(p) + O_P);
  const float* E = (const float*)(WS(p) + O_E);
  h16* Z = (h16*)(WS(p) + O_Z);
  for (int unit = fetch_unit(ctr, slot); unit < 1024; unit = fetch_unit(ctr, slot)) {
    const int g = unit & 31, bc = unit >> 5, b = bc >> 3, ct = bc & 7;
    const int lg = l * 32 + g;
    __syncthreads();
    const int c0 = ct * 16;
    {
      const h16x8* ks = (const h16x8*)(WS(p) + O_KTAB + (size_t)lg * SZ_KTAB);
      for (int i = tid; i < 65 * 32; i += NT) ((h16x8*)Kt)[i] = ks[i];
      for (int i = tid; i < 2048; i += NT) {
        int tk = i >> 1, hf = i & 1;
        h16x8 v = *(const h16x8*)(P + ((size_t)b * SEQ + ct * 1024 + tk) * IWP + OFF_U + g * 16 + hf * 8);
        *(h16x8*)(Bu + (tk >> 6) * BU_PITCH + (tk & 63) * 16 + hf * 8) = v;
      }
      const float2* Eb = (const float2*)E + ((size_t)(b * 128) * 32 + g) * 64;
      for (int i = tid; i < (c0 + 16) * 64; i += NT) Es[i] = Eb[(size_t)(i >> 6) * 2048 + (i & 63)];
    }
    __syncthreads();
    if (w == 0) {
      float2 at = ((const float2*)(WS(p) + O_AT))[lg * 64 + lane];
      float sr = 0.f, si = 0.f;
#pragma unroll 8
      for (int c = 0; c < c0; ++c) {
        float2 e = Es[c * 64 + lane];
        float nr = at.x * sr - at.y * si + e.x, ni = at.x * si + at.y * sr + e.y;
        sr = nr; si = ni;
      }
#pragma unroll
      for (int i = 0; i < 16; ++i) {
        Bs[i * BS_PITCH + 2 * lane] = (h16)sr;
        Bs[i * BS_PITCH + 2 * lane + 1] = (h16)si;
        float2 e = Es[(c0 + i) * 64 + lane];
        float nr = at.x * sr - at.y * si + e.x, ni = at.x * si + at.y * sr + e.y;
        sr = nr; si = ni;
      }
    }
    __syncthreads();
    const float dt = expf(p.in[8][lg]);
    const int col = lane & 15, hi = lane >> 5, qh = (lane >> 4) & 1, p0 = (lane >> 4) * 4;
    const h16* W3 = (const h16*)(WS(p) + O_W3 + (size_t)lg * SZ_W13);
    float dsk[4];
    for (int j = 0; j < 4; ++j) dsk[j] = p.in[13][l * 512 + g * 16 + p0 + j];
    for (int r = 0; r < 64 / NW; ++r) {
      const int base = (r >> 1) * 2 * NW;
      const int tau = (r & 1) ? base + 2 * NW - 1 - w : base + w;
      f32x4 acc = {0.f, 0.f, 0.f, 0.f};
      const int nks = tau / 2 + 1;
      h16x8 A3[4];
#pragma unroll
      for (int ks = 0; ks < 4; ++ks)
        A3[ks] = *(const h16x8*)(W3 + ((size_t)((tau * 16 + ks * 4 + (lane >> 4)) * 16) + (lane & 15)) * 8);
      for (int i = 0; i < nks; ++i) {
        int j = tau - (2 * i + hi);
        h16x8 A = *(const h16x8*)(Kt + (j + 1) * 256 + (lane & 15) * 16 + qh * 8);
        h16x8 B = *(const h16x8*)(Bu + col * BU_PITCH + (2 * i + hi) * 16 + qh * 8);
        acc = __builtin_amdgcn_mfma_f32_16x16x32_f16(A, B, acc, 0, 0, 0);
      }
#pragma unroll
      for (int ks = 0; ks < 4; ++ks) {
        h16x8 B = *(const h16x8*)(Bs + col * BS_PITCH + ks * 32 + (lane >> 4) * 8);
        acc = __builtin_amdgcn_mfma_f32_16x16x32_f16(A3[ks], B, acc, 0, 0, 0);
      }
      const h16* up = Bu + col * BU_PITCH + tau * 16 + p0;
      size_t tok = ((size_t)b * 128 + ct * 16 + col) * 64 + tau;
      h16 zz[4];
      for (int j = 0; j < 4; ++j) zz[j] = (h16)gelu_tanh(dt * acc[j] + dsk[j] * (float)up[j]);
      typedef __attribute__((ext_vector_type(4))) _Float16 h16x4;
      h16x4 zv = {zz[0], zz[1], zz[2], zz[3]};
      *(h16x4*)(Z + tok * 512 + g * 16 + p0) = zv;
    }
  }
}

#define LAS __attribute__((address_space(3)))
typedef _Float16 h16x4 __attribute__((ext_vector_type(4)));
#define XB_TMO      128
#define XB_XCNT(j)  (256  + 64 * (j))
#define XB_XSUB(j)  (1280 + 64 * (j))
#define XB_XGEN(j)  (2304 + 64 * (j))
#define XB_TOP      3328
#define XB_TOPGEN   3392
#define XCD_BAR_WORDS 3456
#define XB_SPIN_CAP (1u << 18)

__device__ __forceinline__ unsigned xb_ld(unsigned* p)              { return __hip_atomic_load(p, __ATOMIC_RELAXED, __HIP_MEMORY_SCOPE_AGENT); }
__device__ __forceinline__ unsigned xb_add(unsigned* p, unsigned v) { return __hip_atomic_fetch_add(p, v, __ATOMIC_RELAXED, __HIP_MEMORY_SCOPE_AGENT); }
__device__ __forceinline__ unsigned xb_xcc_id() { return (unsigned)__builtin_amdgcn_s_getreg((3 << 11) | 20) & 0xFu; }
#define XB_SPIN(cond, bar) do { unsigned _sp = 0; while (cond) { __builtin_amdgcn_s_sleep(1); \
    if ((++_sp & 255u) == 0u) { if (xb_ld(&(bar)[XB_TMO])) break; if (_sp > XB_SPIN_CAP) { atomicAdd(&(bar)[XB_TMO], 1u); break; } } } } while (0)

struct XcdBarrier {
    unsigned* bar; unsigned x;
    volatile LAS unsigned* st;
};

__device__ __forceinline__ XcdBarrier xcd_barrier_post(unsigned* bar, volatile LAS unsigned* st) {
    XcdBarrier b; b.bar = bar; b.x = xb_xcc_id(); b.st = st;
    if (threadIdx.x == 0) (void)xb_add(&bar[XB_XCNT(b.x)], 1u);
    return b;
}
__device__ __forceinline__ void xcd_barrier_complete(unsigned* bar, unsigned x, unsigned& nloc, unsigned& nx) {
    const unsigned G = gridDim.x * gridDim.y * gridDim.z;
    unsigned sum, cnt, mine, sp = 0u;
    for (;;) {
        sum = 0u; cnt = 0u; mine = 0u;
#pragma unroll
        for (unsigned j = 0; j < 16; ++j) { const unsigned c = xb_ld(&bar[XB_XCNT(j)]); sum += c; cnt += (c > 0u) ? 1u : 0u; mine = (j == x) ? c : mine; }
        if (sum == G) break;
        __builtin_amdgcn_s_sleep(1);
        if ((++sp & 255u) == 0u) { if (xb_ld(&bar[XB_TMO])) break; if (sp > XB_SPIN_CAP) { atomicAdd(&bar[XB_TMO], 1u); break; } }
    }
    nloc = mine > 0u ? mine : 1u; nx = cnt > 0u ? cnt : 1u;
}

__device__ __forceinline__ void xcd_barrier(const XcdBarrier& b) {
    asm volatile("s_waitcnt vmcnt(0)" ::: "memory");
    __syncthreads();
    if (threadIdx.x == 0) {
        unsigned* bar = b.bar;
        __builtin_amdgcn_s_waitcnt(0);
        unsigned nloc = b.st[0], nx = b.st[1];
        if (nloc == 0u) { xcd_barrier_complete(bar, b.x, nloc, nx); b.st[0] = nloc; b.st[1] = nx; }
        const unsigned old = xb_add(&bar[XB_XSUB(b.x)], 1u);
        const unsigned gen = old / nloc;
        if (old + 1u == (gen + 1u) * nloc) {
            __builtin_amdgcn_fence(__ATOMIC_RELEASE, "agent");
            asm volatile("s_waitcnt vmcnt(0)" ::: "memory");
            const unsigned og = xb_add(&bar[XB_TOP], 1u);
            const unsigned tg = og / nx;
            if (og + 1u == (tg + 1u) * nx) xb_add(&bar[XB_TOPGEN], 1u);
            else XB_SPIN(xb_ld(&bar[XB_TOPGEN]) == tg, bar);
            __builtin_amdgcn_fence(__ATOMIC_ACQUIRE, "agent");
            xb_add(&bar[XB_XGEN(b.x)], 1u);
            asm volatile("s_waitcnt vmcnt(0)" ::: "memory");
        } else {
            XB_SPIN(xb_ld(&bar[XB_XGEN(b.x)]) == gen, bar);
            __builtin_amdgcn_fence(__ATOMIC_ACQUIRE, "agent");
            asm volatile("s_waitcnt vmcnt(0)" ::: "memory");
        }
    }
    __syncthreads();
}


namespace g8 {
constexpr int BM = 256, BK = 64, HALF = 128, HTB = HALF * BK * 2, STAGE_BYTES = 8 * HTB, NXCD = 8, WGM = 8;
__device__ __forceinline__ int lds_byte(int r, int c) {
  const int st = (r >> 4) * 2 + (c >> 5), rr = r & 15, cc = c & 31, ob = rr * 64 + cc * 2;
  return st * 1024 + (ob ^ (((ob >> 9) & 1) << 5));
}
__device__ __forceinline__ void stage_rc(int b, int& R, int& C) {
  const int st = b / 1024, sb = b % 1024, swz = sb ^ (((sb >> 9) & 1) << 5);
  R = (st >> 1) * 16 + swz / 64;
  C = (st & 1) * 32 + (swz % 64) / 2;
}
struct Unit { int pm, pn; };
struct Order {
  int nM, nN, nwg, G, c;
  __device__ void init(int M, int N, int G_, int c_) { nM = M / BM; nN = N / BM; nwg = nM * nN; G = G_; c = c_; }
  __device__ bool next(int i, Unit& u) const {
    const long L = (long)i * G + c;
    if (L >= nwg) return false;
    int wgid = (int)L;
    { const int q = nwg / NXCD, r = nwg % NXCD, xcd = wgid % NXCD, off = wgid / NXCD; wgid = (xcd < r ? xcd * (q + 1) : r * (q + 1) + (xcd - r) * q) + off; }
    const int nig = WGM * nN, gid = wgid / nig, fm = gid * WGM, gsz = (nM - fm) < WGM ? (nM - fm) : WGM;
    u.pm = fm + ((wgid % nig) % gsz);
    u.pn = (wgid % nig) / gsz;
    return true;
  }
};
template <class Epi>
__device__ __forceinline__ void gemm_phase(LAS unsigned char* lds, const h16* A, const h16* Bt, int K, const Order& S, const Epi& E) {
  const int tid = opaque_tid(), wid = __builtin_amdgcn_readfirstlane(tid >> 6), lane = tid & 63, wr = wid >> 2, wc = wid & 3, fr = lane & 15, fq = lane >> 4;
  const int nt = K / BK;
  unsigned voffA[2];
#pragma unroll
  for (int i = 0; i < 2; ++i) { int R, C; stage_rc(tid * 16 + i * 8192, R, C); voffA[i] = (unsigned)(R * K + C) * 2u; }
  const size_t kstep = (size_t)(BK * 2);
  const size_t hstep = (size_t)HALF * K * 2;
  const size_t tstep = 2 * hstep;
  const unsigned ldsw = (unsigned)wid * 1024u;
  const int aoff = lds_byte(wr * 64 + fr, fq * 8), boff = lds_byte(wc * 32 + fr, fq * 8);
#define G8_SA(b, h) (((b) * 2 + (h)) * HTB)
#define G8_SB(b, h) ((4 + (b) * 2 + (h)) * HTB)
#define G8_STAGE(bufoff, gbase) do { _Pragma("unroll") for (int _i = 0; _i < 2; ++_i) \
    __builtin_amdgcn_global_load_lds((const unsigned*)((const char*)(gbase) + voffA[_i]), (LAS unsigned*)(lds + (bufoff) + ldsw + _i * 8192), 16, 0, 0); } while (0)
#define G8_LDA(dst, b, h) do { _Pragma("unroll") for (int m = 0; m < 4; ++m) _Pragma("unroll") for (int k = 0; k < 2; ++k) dst[m][k] = *(const LAS h16x8*)(lds + G8_SA(b, h) + aoff + m * 2048 + k * 1024); } while (0)
#define G8_LDB(dst, b, h) do { _Pragma("unroll") for (int n = 0; n < 2; ++n) _Pragma("unroll") for (int k = 0; k < 2; ++k) dst[n][k] = *(const LAS h16x8*)(lds + G8_SB(b, h) + boff + n * 2048 + k * 1024); } while (0)
#define G8_MMA(ai, bj, At, Bt_) do { __builtin_amdgcn_s_setprio(1); _Pragma("unroll") for (int m = 0; m < 4; ++m) _Pragma("unroll") for (int n = 0; n < 2; ++n) _Pragma("unroll") for (int k = 0; k < 2; ++k) \
    acc[ai][bj][m][n] = __builtin_amdgcn_mfma_f32_16x16x32_f16(Bt_[n][k], At[m][k], acc[ai][bj][m][n], 0, 0, 0); __builtin_amdgcn_s_setprio(0); } while (0)
#define G8_WAIT_V(n) asm volatile("s_waitcnt vmcnt(" #n ")" ::: "memory")
#define G8_WAIT_L(n) asm volatile("s_waitcnt lgkmcnt(" #n ")" ::: "memory")
#define G8_BAR __builtin_amdgcn_s_barrier()
#define G8_SCHED __builtin_amdgcn_sched_barrier(0)
  Unit cur, nxt;
  int ui = 0;
  if (!S.next(0, cur)) return;
  f32x4 acc[2][2][4][2];
#pragma unroll
  for (int a = 0; a < 2; ++a)
#pragma unroll
    for (int b = 0; b < 2; ++b)
#pragma unroll
      for (int m = 0; m < 4; ++m)
#pragma unroll
        for (int n = 0; n < 2; ++n) acc[a][b][m][n] = (f32x4){0.f, 0.f, 0.f, 0.f};
  h16x8 At[4][2], B0[2][2], B1[2][2];
  const char* cA = (const char*)A + (size_t)cur.pm * tstep;
  const char* cB = (const char*)Bt + (size_t)cur.pn * tstep;
  G8_STAGE(G8_SB(0, 0), cB); G8_STAGE(G8_SA(0, 0), cA); G8_STAGE(G8_SB(0, 1), cB + hstep); G8_STAGE(G8_SA(0, 1), cA + hstep);
  if (wr == 1) G8_BAR;
  G8_WAIT_V(4); G8_BAR;
  G8_STAGE(G8_SB(1, 0), cB + kstep); G8_STAGE(G8_SA(1, 0), cA + kstep); G8_STAGE(G8_SB(1, 1), cB + hstep + kstep);
  G8_WAIT_V(6); G8_BAR;
  for (;;) {
    const bool has_next = S.next(ui + 1, nxt);
    const char* nA = has_next ? (const char*)A + (size_t)nxt.pm * tstep : cA;
    const char* nB = has_next ? (const char*)Bt + (size_t)nxt.pn * tstep : cB;
    for (int t = 0; t < nt; t += 2) {
      const bool last = (t == nt - 2);
      const char* a1 = cA + (size_t)(t + 1) * kstep;
      const char* a2 = last ? nA : cA + (size_t)(t + 2) * kstep;
      const char* b2 = last ? nB : cB + (size_t)(t + 2) * kstep;
      const char* a3 = a2 + kstep;
      const char* b3 = b2 + kstep;
      if (Epi::MID_T >= 0 && t == Epi::MID_T) E.mid(acc, ui, wr, fr);
      G8_LDB(B0, 0, 0); G8_SCHED; G8_LDA(At, 0, 0); G8_STAGE(G8_SA(1, 1), a1 + hstep);
      G8_WAIT_L(8); G8_BAR; G8_WAIT_L(0); G8_MMA(0, 0, At, B0); G8_BAR; G8_SCHED;
      G8_LDB(B1, 0, 1); G8_STAGE(G8_SB(0, 0), b2);
      G8_BAR; G8_WAIT_L(0); G8_MMA(0, 1, At, B1); G8_BAR;
      G8_LDA(At, 0, 1); G8_STAGE(G8_SA(0, 0), a2);
      G8_BAR; G8_WAIT_L(0); G8_MMA(1, 0, At, B0); G8_BAR; G8_SCHED;
      G8_STAGE(G8_SB(0, 1), b2 + hstep);
      G8_WAIT_V(6); G8_BAR; G8_MMA(1, 1, At, B1); G8_BAR;
      G8_LDB(B0, 1, 0); G8_SCHED; G8_LDA(At, 1, 0); G8_STAGE(G8_SA(0, 1), a2 + hstep);
      G8_WAIT_L(8); G8_BAR; G8_WAIT_L(0); G8_MMA(0, 0, At, B0); G8_BAR; G8_SCHED;
      G8_LDB(B1, 1, 1); G8_STAGE(G8_SB(1, 0), b3);
      G8_BAR; G8_WAIT_L(0); G8_MMA(0, 1, At, B1); G8_BAR;
      G8_LDA(At, 1, 1); G8_STAGE(G8_SA(1, 0), a3);
      G8_BAR; G8_WAIT_L(0); G8_MMA(1, 0, At, B0); G8_BAR; G8_SCHED;
      G8_STAGE(G8_SB(1, 1), b3 + hstep);
      G8_WAIT_V(6); G8_BAR; G8_MMA(1, 1, At, B1); G8_BAR;
    }
    E(acc, cur, ui, wr, wc, fr, fq);
    if (!has_next) break;
#pragma unroll
    for (int a = 0; a < 2; ++a)
#pragma unroll
      for (int b = 0; b < 2; ++b)
#pragma unroll
        for (int m = 0; m < 4; ++m)
#pragma unroll
          for (int n = 0; n < 2; ++n) acc[a][b][m][n] = (f32x4){0.f, 0.f, 0.f, 0.f};
    cur = nxt; cA = nA; cB = nB; ++ui;
  }
  G8_WAIT_V(0);
  if (wr == 0) G8_BAR;
  G8_BAR;
#undef G8_SA
#undef G8_SB
#undef G8_STAGE
#undef G8_LDA
#undef G8_LDB
#undef G8_MMA
#undef G8_WAIT_V
#undef G8_WAIT_L
#undef G8_BAR
#undef G8_SCHED
}
}

constexpr int RSL_OFF = g8::STAGE_BYTES;
constexpr int LDS_GEMM = g8::STAGE_BYTES + 8 * 256 * 4;

__device__ __forceinline__ void fill_rowscales(float* rsl, const float* ssq, float inv_n, const g8::Order& S) {
  const int tid = opaque_tid();
  g8::Unit u;
  __syncthreads();
  for (int i = 0; S.next(i, u); ++i) {
    if (tid < 256) {
      const float4* s4 = (const float4*)(ssq + (size_t)(u.pm * 256 + tid) * 16);
      float s = 0.f;
      for (int k = 0; k < 4; ++k) { float4 v = s4[k]; s += v.x + v.y + v.z + v.w; }
      rsl[i * 256 + tid] = rsqrtf(s * inv_n + EPS);
    }
  }
  __syncthreads();
}

__device__ __forceinline__ h16x4 pack4(float a, float b, float c, float d) { h16x4 v = {(h16)a, (h16)b, (h16)c, (h16)d}; return v; }
__device__ __forceinline__ h16x8 pack8(f32x4 a, f32x4 b) {
  h16x8 v = {(h16)a[0], (h16)a[1], (h16)a[2], (h16)a[3], (h16)b[0], (h16)b[1], (h16)b[2], (h16)b[3]};
  return v;
}

struct EpiIn {
  static constexpr int MID_T = -1;
  __device__ __forceinline__ void mid(f32x4 (&)[2][2][4][2], int, int, int) const {}
  h16* P; const float* rsl; const float* qkg;
  __device__ __forceinline__ void operator()(const f32x4 (&acc)[2][2][4][2], const g8::Unit& u, int ui, int wr, int wc, int fr, int fq) const {
    const int hs = u.pn * 4 + wc;
    int gi = -1;
    if (hs < 4) gi = 0; else if (hs < 6) gi = 1; else if (hs >= 16 && hs < 20) gi = 2; else if (hs == 22) gi = 4; else if (hs == 24) gi = 5;
    const bool gate = (hs == 26);
#pragma unroll
    for (int ai = 0; ai < 2; ++ai)
#pragma unroll
      for (int m = 0; m < 4; ++m) {
        const int rl = 128 * ai + 64 * wr + 16 * m + fr;
        float r = rsl[ui * 256 + rl];
        if (gi >= 0) {
          float ss = 0.f;
#pragma unroll
          for (int bj = 0; bj < 2; ++bj)
#pragma unroll
            for (int n = 0; n < 2; ++n)
#pragma unroll
              for (int j = 0; j < 4; ++j) ss += acc[ai][bj][m][n][j] * acc[ai][bj][m][n][j];
          ss += xor16(ss);
          ss += __shfl_xor(ss, 32);
          r *= rsqrtf(ss * r * r * (1.f / 64.f) + EPS);
        }
        h16* rowp = P + (size_t)(u.pm * 256 + rl) * IWP + 64 * hs + 8 * fq;
#pragma unroll
        for (int bj = 0; bj < 2; ++bj) {
          f32x4 v[2];
#pragma unroll
          for (int n = 0; n < 2; ++n) {
            v[n] = acc[ai][bj][m][n] * r;
            if (gi >= 0) {
              const float4 g4 = *(const float4*)(qkg + gi * 64 + 32 * bj + 8 * fq + 4 * n);
              v[n][0] *= g4.x; v[n][1] *= g4.y; v[n][2] *= g4.z; v[n][3] *= g4.w;
            } else if (gate) {
#pragma unroll
              for (int j = 0; j < 4; ++j) v[n][j] = (32 * bj + 8 * fq + 4 * n + j) < 12 ? sigmoidf(v[n][j]) : 0.f;
            }
          }
          *(h16x8*)(rowp + 32 * bj) = pack8(v[0], v[1]);
        }
      }
  }
};

struct EpiGlu {
  static constexpr int MID_T = -1;
  __device__ __forceinline__ void mid(f32x4 (&)[2][2][4][2], int, int, int) const {}
  h16* OB; float* ssqb; const float* gb;
  __device__ __forceinline__ void operator()(const f32x4 (&acc)[2][2][4][2], const g8::Unit& u, int ui, int wr, int wc, int fr, int fq) const {
    const int ocb = 128 * u.pn + 16 * wc + 4 * fq;
    float4 ba[2], bb[2];
#pragma unroll
    for (int bj = 0; bj < 2; ++bj) { ba[bj] = *(const float4*)(gb + ocb + 64 * bj); bb[bj] = *(const float4*)(gb + 512 + ocb + 64 * bj); }
#pragma unroll
    for (int ai = 0; ai < 2; ++ai)
#pragma unroll
      for (int m = 0; m < 4; ++m) {
        const size_t row = (size_t)u.pm * 256 + 128 * ai + 64 * wr + 16 * m + fr;
        float ss = 0.f;
#pragma unroll
        for (int bj = 0; bj < 2; ++bj) {
          const f32x4 a = acc[ai][bj][m][0], b = acc[ai][bj][m][1];
          float o0 = (a[0] + ba[bj].x) * sigmoidf(b[0] + bb[bj].x);
          float o1 = (a[1] + ba[bj].y) * sigmoidf(b[1] + bb[bj].y);
          float o2 = (a[2] + ba[bj].z) * sigmoidf(b[2] + bb[bj].z);
          float o3 = (a[3] + ba[bj].w) * sigmoidf(b[3] + bb[bj].w);
          *(h16x4*)(OB + row * 1024 + ocb + 64 * bj) = pack4(o0, o1, o2, o3);
          ss += o0 * o0 + o1 * o1 + o2 * o2 + o3 * o3;
        }
        ss += xor16(ss);
        ss += __shfl_xor(ss, 32);
        if (fq == 0) ssqb[row * 16 + u.pn * 4 + wc] = ss;
      }
  }
};

struct EpiRes {
  static constexpr int MID_T = -1;
  __device__ __forceinline__ void mid(f32x4 (&)[2][2][4][2], int, int, int) const {}
  float* xo; h16* xb; float* ssq; bool final_out;
  __device__ __forceinline__ void operator()(const f32x4 (&acc)[2][2][4][2], const g8::Unit& u, int ui, int wr, int wc, int fr, int fq) const {
#pragma unroll
    for (int ai = 0; ai < 2; ++ai)
#pragma unroll
      for (int m = 0; m < 4; ++m) {
        const size_t row = (size_t)u.pm * 256 + 128 * ai + 64 * wr + 16 * m + fr;
        const size_t base = row * DM + 256 * u.pn + 32 * wc + 8 * fq;
        float ss = 0.f;
#pragma unroll
        for (int bj = 0; bj < 2; ++bj) {
          const size_t idx = base + 128 * bj;
          const h16x8 xv = *(const h16x8*)(xb + idx);
          f32x4 x0 = acc[ai][bj][m][0], x1 = acc[ai][bj][m][1];
#pragma unroll
          for (int j = 0; j < 4; ++j) { x0[j] += (float)xv[j]; x1[j] += (float)xv[4 + j]; ss += x0[j] * x0[j] + x1[j] * x1[j]; }
          if (final_out) {
            *(float4*)(xo + idx) = make_float4(x0[0], x0[1], x0[2], x0[3]);
            *(float4*)(xo + idx + 4) = make_float4(x1[0], x1[1], x1[2], x1[3]);
          } else {
            *(h16x8*)(xb + idx) = pack8(x0, x1);
          }
        }
        ss += xor16(ss);
        ss += __shfl_xor(ss, 32);
        if (fq == 0) ssq[row * 16 + u.pn * 4 + wc] = ss;
      }
  }
};

struct EpiOut : EpiRes {
  static constexpr int MID_T = 8;
  const float* rsl;
  __device__ __forceinline__ void mid(f32x4 (&acc)[2][2][4][2], int ui, int wr, int fr) const {
#pragma unroll
    for (int ai = 0; ai < 2; ++ai)
#pragma unroll
      for (int m = 0; m < 4; ++m) {
        const float r = rsl[ui * 256 + 128 * ai + 64 * wr + 16 * m + fr];
#pragma unroll
        for (int bj = 0; bj < 2; ++bj)
#pragma unroll
          for (int n = 0; n < 2; ++n) acc[ai][bj][m][n] *= r;
      }
  }
};

struct EpiUp {
  static constexpr int MID_T = -1;
  __device__ __forceinline__ void mid(f32x4 (&)[2][2][4][2], int, int, int) const {}
  h16* hid; const float* rsl;
  __device__ __forceinline__ void operator()(const f32x4 (&acc)[2][2][4][2], const g8::Unit& u, int ui, int wr, int wc, int fr, int fq) const {
#pragma unroll
    for (int ai = 0; ai < 2; ++ai)
#pragma unroll
      for (int m = 0; m < 4; ++m) {
        const int rl = 128 * ai + 64 * wr + 16 * m + fr;
        const float r = rsl[ui * 256 + rl];
        h16* rowp = hid + (size_t)(u.pm * 256 + rl) * DFF + 256 * u.pn + 32 * wc + 8 * fq;
#pragma unroll
        for (int bj = 0; bj < 2; ++bj) {
          f32x4 v[2];
#pragma unroll
          for (int n = 0; n < 2; ++n) {
            v[n] = acc[ai][bj][m][n] * r;
#pragma unroll
            for (int j = 0; j < 4; ++j) { const float t = fmaxf(v[n][j], 0.f); v[n][j] = t * t; }
          }
          *(h16x8*)(rowp + 128 * bj) = pack8(v[0], v[1]);
        }
      }
  }
};

__device__ __forceinline__ void phase_gemm1(const Params& p, int l, char* lds) {
  g8::Order S; S.init(NTOK, IWP, gridDim.x, blockIdx.x);
  float* rsl = (float*)(lds + RSL_OFF);
  fill_rowscales(rsl, (const float*)(WS(p) + O_SSQ), 1.f / DM, S);
  EpiIn E{(h16*)(WS(p) + O_P), rsl, p.in[3] + l * 6 * 64};
  g8::gemm_phase((LAS unsigned char*)lds, (const h16*)(WS(p) + O_XB), (const h16*)(WS(p) + O_WIN + l * SZ_WIN), DM, S, E);
}
__device__ __forceinline__ void phase_glu(const Params& p, int l, char* lds) {
  g8::Order S; S.init(NTOK, 1024, gridDim.x, blockIdx.x);
  __syncthreads();
  EpiGlu E{(h16*)(WS(p) + O_OB), (float*)(WS(p) + O_SSQB), p.in[15] + l * 1024};
  g8::gemm_phase((LAS unsigned char*)lds, (const h16*)(WS(p) + O_Z), (const h16*)(WS(p) + O_WGLU + l * SZ_WGLU), 512, S, E);
}
__device__ __forceinline__ void phase_wout(const Params& p, int l, char* lds) {
  g8::Order S; S.init(NTOK, DM, gridDim.x, blockIdx.x);
  float* rsl = (float*)(lds + RSL_OFF);
  fill_rowscales(rsl, (const float*)(WS(p) + O_SSQB), 1.f / 512.f, S);
  EpiOut E;
  E.xo = p.out; E.xb = (h16*)(WS(p) + O_XB); E.ssq = (float*)(WS(p) + O_SSQ); E.final_out = false; E.rsl = rsl;
  g8::gemm_phase((LAS unsigned char*)lds, (const h16*)(WS(p) + O_OB), (const h16*)(WS(p) + O_WOUT + l * SZ_WOUT), DM, S, E);
}
__device__ __forceinline__ void phase_up(const Params& p, int l, char* lds) {
  g8::Order S; S.init(NTOK, DFF, gridDim.x, blockIdx.x);
  float* rsl = (float*)(lds + RSL_OFF);
  fill_rowscales(rsl, (const float*)(WS(p) + O_SSQ), 1.f / DM, S);
  EpiUp E{(h16*)(WS(p) + O_HID), rsl};
  g8::gemm_phase((LAS unsigned char*)lds, (const h16*)(WS(p) + O_XB), (const h16*)(WS(p) + O_WUP + l * SZ_WUP), DM, S, E);
}
__device__ __forceinline__ void phase_down(const Params& p, int l, char* lds) {
  g8::Order S; S.init(NTOK, DM, gridDim.x, blockIdx.x);
  __syncthreads();
  EpiRes E{p.out, (h16*)(WS(p) + O_XB), (float*)(WS(p) + O_SSQ), l == DEPTH - 1};
  g8::gemm_phase((LAS unsigned char*)lds, (const h16*)(WS(p) + O_HID), (const h16*)(WS(p) + O_WDN + l * SZ_WDN), DFF, S, E);
}

constexpr int KP = 80;
enum { M_SWA = 0, M_WIN = 1, M_SEL = 2, M_CMPA = 3, M_CMPB = 4 };
constexpr float LOG2E = 1.4426950408889634f, SCL2 = 0.125f * LOG2E;
struct ColState { float m, l; };
typedef short s16x4v __attribute__((__vector_size__(8)));

__device__ __forceinline__ h16x8 ld_row8(const h16* base, int ld, int row, int nrows, int c8) {
  h16x8 z = {0, 0, 0, 0, 0, 0, 0, 0};
  return (row >= 0 && row < nrows) ? *(const h16x8*)(base + (size_t)row * ld + c8 * 8) : z;
}
__device__ __forceinline__ void st_k(h16* Ks, int row, int c8, h16x8 v) { *(h16x8*)(Ks + row * KP + c8 * 8) = v; }
__device__ __forceinline__ void st_vt(h16* Vt, int row, int c8, h16x8 v) {
#pragma unroll
  for (int e = 0; e < 8; ++e) Vt[(c8 * 8 + e) * KP + row] = v[e];
}
__device__ __forceinline__ float max4q(float v) {
  v = fmaxf(v, xor16(v));
  auto r = __builtin_amdgcn_permlane32_swap(__float_as_int(v), __float_as_int(v), false, false);
  return fmaxf(__int_as_float(r[0]), __int_as_float(r[1]));
}
__device__ __forceinline__ float sum4q(float v) {
  v += xor16(v);
  auto r = __builtin_amdgcn_permlane32_swap(__float_as_int(v), __float_as_int(v), false, false);
  return __int_as_float(r[0]) + __int_as_float(r[1]);
}
__device__ __forceinline__ float quadsum(float v) { v += dppf<0xB1>(v); v += dppf<0x4E>(v); return v; }

template <int MODE, int RGM>
__device__ __forceinline__ void attn_tile(const h16x8 (&Q)[2][2], f32x4 (&O)[2][4], ColState (&st)[2], const h16* Ks,
                                          const h16* Vt, const float* biasT, const int (&tq)[2], int hd, int kbase, bool far,
                                          const bool (&selbit)[2], float (&hq)[2][4], float (&h3)[2][4], const int lane) {
  const int col = lane & 15, q4 = lane >> 4;
  constexpr int DK = (MODE == M_CMPA || MODE == M_CMPB) ? 16 : 1;
  f32x4 S[2][4];
#pragma unroll
  for (int kt = 0; kt < 4; ++kt) {
#pragma unroll
    for (int rg = 0; rg < 2; ++rg) S[rg][kt] = f32x4{0.f, 0.f, 0.f, 0.f};
#pragma unroll
    for (int ks = 0; ks < 2; ++ks) {
      h16x8 Kf = *(const h16x8*)(Ks + (kt * 16 + col) * KP + ks * 32 + q4 * 8);
#pragma unroll
      for (int rg = 0; rg < 2; ++rg)
        if (RGM & (1 << rg)) S[rg][kt] = __builtin_amdgcn_mfma_f32_16x16x32_f16(Kf, Q[rg][ks], S[rg][kt], 0, 0, 0);
    }
  }
  h16x8 Pf[2][2];
#pragma unroll
  for (int rg = 0; rg < 2; ++rg) {
    if (!(RGM & (1 << rg))) continue;
    const float* bt = biasT + hd * 800;
    if (far) {
      const float b31 = bt[799];
      const bool ok = (MODE == M_SEL) ? selbit[rg] : true;
#pragma unroll
      for (int kt = 0; kt < 4; ++kt)
#pragma unroll
        for (int j = 0; j < 4; ++j) S[rg][kt][j] = ok ? S[rg][kt][j] * SCL2 + b31 : -1e30f;
    } else {
      const int kx0 = kbase + q4 * 4;
      const int d0 = (DK == 16) ? tq[rg] - 31 - 16 * kx0 : tq[rg] - kx0;
#pragma unroll
      for (int kt = 0; kt < 4; ++kt)
#pragma unroll
        for (int j = 0; j < 4; ++j) {
          const int dist = d0 - DK * (kt * 16 + j);
          const int kx = kx0 + kt * 16 + j;
          bool valid = dist >= 0;
          if (MODE == M_SWA) valid = valid && dist < 128 && kx >= 0;
          if (MODE == M_WIN) valid = valid && dist < 512 && kx >= 0;
          if (MODE == M_SEL) valid = valid && selbit[rg];
          if (DK == 16) valid = valid && kx < NCMP;
          const int dc = dist < 0 ? 0 : (dist > 799 ? 799 : dist);
          S[rg][kt][j] = valid ? S[rg][kt][j] * SCL2 + bt[dc] : -1e30f;
        }
    }
    if (MODE == M_CMPB) {
#pragma unroll
      for (int kt = 0; kt < 4; ++kt) {
        float h = 0.f;
#pragma unroll
        for (int j = 0; j < 4; ++j) {
          float pv = __builtin_amdgcn_exp2f(S[rg][kt][j] - st[rg].m) * st[rg].l;
          S[rg][kt][j] = pv;
          h += pv;
        }
        hq[rg][kt] = h;
        h3[rg][kt] = S[rg][kt][3];
      }
    } else {
      float mx = -1e30f;
#pragma unroll
      for (int kt = 0; kt < 4; ++kt)
#pragma unroll
        for (int j = 0; j < 4; ++j) mx = fmaxf(mx, S[rg][kt][j]);
      mx = max4q(mx);
      const float mn = fmaxf(st[rg].m, mx);
      const float corr = __builtin_amdgcn_exp2f(st[rg].m - mn);
      st[rg].m = mn;
      const float mm = fmaxf(mn, -1e20f);
      float ls = 0.f;
#pragma unroll
      for (int kt = 0; kt < 4; ++kt)
#pragma unroll
        for (int j = 0; j < 4; ++j) {
          float pv = __builtin_amdgcn_exp2f(S[rg][kt][j] - mm);
          S[rg][kt][j] = pv;
          ls += pv;
        }
      st[rg].l = st[rg].l * corr + ls;
      if (MODE != M_CMPA) {
#pragma unroll
        for (int nt = 0; nt < 4; ++nt) O[rg][nt] *= corr;
      }
    }
    if (MODE != M_CMPA) {
#pragma unroll
      for (int ks = 0; ks < 2; ++ks)
#pragma unroll
        for (int i = 0; i < 4; ++i) {
          Pf[rg][ks][i] = (h16)S[rg][2 * ks][i];
          Pf[rg][ks][4 + i] = (h16)S[rg][2 * ks + 1][i];
        }
    }
  }
  if (MODE == M_CMPA) return;
#pragma unroll
  for (int ks = 0; ks < 2; ++ks)
#pragma unroll
    for (int nt = 0; nt < 4; ++nt) {
      const h16* vp = Vt + (ks * 32 + q4 * 4 + (col >> 2)) * KP + nt * 16 + 4 * (col & 3);
      const s16x4v r0 = __builtin_amdgcn_ds_read_tr16_b64_v4i16((LAS s16x4v*)vp);
      const s16x4v r1 = __builtin_amdgcn_ds_read_tr16_b64_v4i16((LAS s16x4v*)(vp + 16 * KP));
      const h16x4 v0 = __builtin_bit_cast(h16x4, r0), v1 = __builtin_bit_cast(h16x4, r1);
      const h16x8 Vf = {v0[0], v0[1], v0[2], v0[3], v1[0], v1[1], v1[2], v1[3]};
#pragma unroll
      for (int rg = 0; rg < 2; ++rg)
        if (RGM & (1 << rg)) O[rg][nt] = __builtin_amdgcn_mfma_f32_16x16x32_f16(Vf, Pf[rg][ks], O[rg][nt], 0, 0, 0);
    }
}

constexpr int LDS_CMP = 8 * 16 * 128 * 4 + 16 * 136 * 2 + 4 * 16 * 4;
__device__ __forceinline__ void phase_compress(const Params& p, int l, char* lds) {
  const int tid = opaque_tid(), lane = tid & 63, w = tid >> 6, col = lane & 15, q4 = lane >> 4;
  float* red = (float*)lds;
  h16* hid = (h16*)(lds + 8 * 16 * 128 * 4);
  float* nrm2 = (float*)(lds + 8 * 16 * 128 * 4 + 16 * 136 * 2);
  const h16* P = (const h16*)(WS(p) + O_P);
  for (int u = blockIdx.x; u < BATCH * 2 * 32; u += gridDim.x) {
    const int mt = u & 31, st = (u >> 5) & 1, b = u >> 6;
    const h16* W1t = (const h16*)(WS(p) + O_W1T) + (size_t)(l * 2 + st) * 128 * 2048;
    const h16* W2t = (const h16*)(WS(p) + O_W2T) + (size_t)(l * 2 + st) * 64 * 128;
    const float* b1 = (const float*)(WS(p) + O_BIAS1) + (l * 2 + st) * 128;
    __syncthreads();
    {
      f32x4 acc[8];
#pragma unroll
      for (int nt = 0; nt < 8; ++nt) acc[nt] = f32x4{0.f, 0.f, 0.f, 0.f};
      const int m = 16 * mt + col;
#pragma unroll 2
      for (int kk = 0; kk < 8; ++kk) {
        const int ks = 8 * w + kk, tt = ks >> 1, d0 = (ks & 1) * 32 + q4 * 8;
        int tok = 16 * m + tt;
        if (tok > SEQ - 1) tok = SEQ - 1;
        const h16x8 A = *(const h16x8*)(P + ((size_t)b * SEQ + tok) * IWP + OFF_KVC + st * 64 + d0);
#pragma unroll
        for (int nt = 0; nt < 8; ++nt) {
          const h16x8 B = *(const h16x8*)(W1t + (size_t)(nt * 16 + col) * 2048 + ks * 32 + q4 * 8);
          acc[nt] = __builtin_amdgcn_mfma_f32_16x16x32_f16(A, B, acc[nt], 0, 0, 0);
        }
      }
#pragma unroll
      for (int nt = 0; nt < 8; ++nt)
#pragma unroll
        for (int j = 0; j < 4; ++j) red[(w * 16 + q4 * 4 + j) * 128 + nt * 16 + col] = acc[nt][j];
    }
    __syncthreads();
    {
      const int row = tid >> 5, c4 = (tid & 31) * 4;
      float4 sum = *(const float4*)(b1 + c4);
#pragma unroll
      for (int ww = 0; ww < 8; ++ww) {
        const float4 v = *(const float4*)(red + (ww * 16 + row) * 128 + c4);
        sum.x += v.x; sum.y += v.y; sum.z += v.z; sum.w += v.w;
      }
      *(h16x4*)(hid + row * 136 + c4) = pack4(gelu_tanh(sum.x), gelu_tanh(sum.y), gelu_tanh(sum.z), gelu_tanh(sum.w));
    }
    __syncthreads();
    f32x4 o2 = {0.f, 0.f, 0.f, 0.f};
    if (w < 4) {
#pragma unroll
      for (int ks = 0; ks < 4; ++ks) {
        const h16x8 A = *(const h16x8*)(hid + col * 136 + ks * 32 + q4 * 8);
        const h16x8 B = *(const h16x8*)(W2t + (size_t)(w * 16 + col) * 128 + ks * 32 + q4 * 8);
        o2 = __builtin_amdgcn_mfma_f32_16x16x32_f16(A, B, o2, 0, 0, 0);
      }
      if (st == 0) {
#pragma unroll
        for (int j = 0; j < 4; ++j) {
          float ss = sum16(o2[j] * o2[j]);
          if (col == 0) nrm2[w * 16 + q4 * 4 + j] = ss;
        }
      }
    }
    __syncthreads();
    if (w < 4) {
      const float g = p.in[3][(l * 6 + 3) * 64 + w * 16 + col];
      h16* dst = (h16*)(WS(p) + (st == 0 ? O_KCMP : O_VCMP));
#pragma unroll
      for (int j = 0; j < 4; ++j) {
        const int row = q4 * 4 + j, m = 16 * mt + row;
        float v = o2[j];
        if (st == 0) {
          float tot = nrm2[row] + nrm2[16 + row] + nrm2[32 + row] + nrm2[48 + row];
          v = v * rsqrtf(tot * (1.f / 64.f) + EPS) * g;
        }
        if (m >= NCMP) v = 0.f;
        dst[((size_t)b * 512 + m) * 64 + w * 16 + col] = (h16)v;
      }
    }
  }
}


template <int MODE, int TM>
__device__ __forceinline__ void attn_tile2(const h16x8 (&Q)[2], f32x4 (&O)[4], ColState& st, const h16* Ks0, const h16* Vt0,
                                           const h16* Ks1, const h16* Vt1, const float* biasT, int tq, int hd, int kbase0,
                                           const bool (&far)[2], const bool (&selbit)[2], float (&hq)[2][4], float (&h3)[2][4],
                                           const int lane) {
  const int col = lane & 15, q4 = lane >> 4;
  constexpr int DK = (MODE == M_CMPA || MODE == M_CMPB) ? 16 : 1;
  f32x4 S[2][4];
  __builtin_amdgcn_s_setprio(1);
#pragma unroll
  for (int t = 0; t < 2; ++t) {
    if (!(TM & (1 << t))) continue;
    const h16* Ks = t ? Ks1 : Ks0;
#pragma unroll
    for (int kt = 0; kt < 4; ++kt) {
      S[t][kt] = f32x4{0.f, 0.f, 0.f, 0.f};
#pragma unroll
      for (int ks = 0; ks < 2; ++ks) {
        h16x8 Kf = *(const h16x8*)(Ks + (kt * 16 + col) * KP + ks * 32 + q4 * 8);
        S[t][kt] = __builtin_amdgcn_mfma_f32_16x16x32_f16(Kf, Q[ks], S[t][kt], 0, 0, 0);
      }
    }
  }
  __builtin_amdgcn_s_setprio(0);
  const float* bt = biasT + hd * 800;
  float addc[2] = {0.f, 0.f}, sclc[2] = {1.f, 1.f};
#pragma unroll
  for (int t = 0; t < 2; ++t) {
    if (!(TM & (1 << t))) continue;
    const int kbase = kbase0 + 64 * t;
    if (far[t]) {
      const bool ok = (MODE == M_SEL) ? selbit[t] : true;
      addc[t] = ok ? bt[799] : -1e30f;
      sclc[t] = SCL2;
    } else {
      addc[t] = 0.f;
      sclc[t] = 1.f;
      const int kx0 = kbase + q4 * 4;
      const int d0 = (DK == 16) ? tq - 31 - 16 * kx0 : tq - kx0;
#pragma unroll
      for (int kt = 0; kt < 4; ++kt)
#pragma unroll
        for (int j = 0; j < 4; ++j) {
          const int dist = d0 - DK * (kt * 16 + j);
          const int kx = kx0 + kt * 16 + j;
          bool valid = dist >= 0;
          if (MODE == M_WIN) valid = valid && dist < 512 && kx >= 0;
          if (MODE == M_SEL) valid = valid && selbit[t];
          if (DK == 16) valid = valid && kx < NCMP;
          const int dc = dist < 0 ? 0 : (dist > 799 ? 799 : dist);
          S[t][kt][j] = valid ? S[t][kt][j] * SCL2 + bt[dc] : -1e30f;
        }
    }
  }
  if (MODE == M_CMPB) {
#pragma unroll
    for (int t = 0; t < 2; ++t) {
      if (!(TM & (1 << t))) continue;
#pragma unroll
      for (int kt = 0; kt < 4; ++kt) {
        float h = 0.f;
#pragma unroll
        for (int j = 0; j < 4; ++j) {
          float pv = __builtin_amdgcn_exp2f(S[t][kt][j] * sclc[t] + (addc[t] - st.m)) * st.l;
          S[t][kt][j] = pv;
          h += pv;
        }
        hq[t][kt] = h;
        h3[t][kt] = S[t][kt][3];
      }
    }
  } else {
    float mx = -1e30f;
#pragma unroll
    for (int t = 0; t < 2; ++t) {
      if (!(TM & (1 << t))) continue;
      float mt = -1e30f;
#pragma unroll
      for (int kt = 0; kt < 4; ++kt)
#pragma unroll
        for (int j = 0; j < 4; ++j) mt = fmaxf(mt, S[t][kt][j]);
      mx = fmaxf(mx, mt * sclc[t] + addc[t]);
    }
    mx = max4q(mx);
    const float mn = fmaxf(st.m, mx);
    const float corr = __builtin_amdgcn_exp2f(st.m - mn);
    st.m = mn;
    const float mm = fmaxf(mn, -1e20f);
    float ls = 0.f;
#pragma unroll
    for (int t = 0; t < 2; ++t) {
      if (!(TM & (1 << t))) continue;
      const float am = addc[t] - mm;
#pragma unroll
      for (int kt = 0; kt < 4; ++kt) {
        const f32x4 e = S[t][kt] * sclc[t] + am;
#pragma unroll
        for (int j = 0; j < 4; ++j) {
          float pv = __builtin_amdgcn_exp2f(e[j]);
          S[t][kt][j] = pv;
          ls += pv;
        }
      }
    }
    st.l = st.l * corr + ls;
    if (MODE != M_CMPA) {
#pragma unroll
      for (int nt = 0; nt < 4; ++nt) O[nt] *= corr;
    }
  }
  if (MODE == M_CMPA) return;
  __builtin_amdgcn_s_setprio(1);
#pragma unroll
  for (int t = 0; t < 2; ++t) {
    if (!(TM & (1 << t))) continue;
    const h16* Vt = t ? Vt1 : Vt0;
#pragma unroll
    for (int ks = 0; ks < 2; ++ks) {
      h16x8 Pf;
#pragma unroll
      for (int i = 0; i < 4; ++i) { Pf[i] = (h16)S[t][2 * ks][i]; Pf[4 + i] = (h16)S[t][2 * ks + 1][i]; }
#pragma unroll
      for (int nt = 0; nt < 4; ++nt) {
        const h16* vp = Vt + (ks * 32 + q4 * 4 + (col >> 2)) * KP + nt * 16 + 4 * (col & 3);
        const s16x4v r0 = __builtin_amdgcn_ds_read_tr16_b64_v4i16((LAS s16x4v*)vp);
        const s16x4v r1 = __builtin_amdgcn_ds_read_tr16_b64_v4i16((LAS s16x4v*)(vp + 16 * KP));
        const h16x4 v0 = __builtin_bit_cast(h16x4, r0), v1 = __builtin_bit_cast(h16x4, r1);
        const h16x8 Vf = {v0[0], v0[1], v0[2], v0[3], v1[0], v1[1], v1[2], v1[3]};
        O[nt] = __builtin_amdgcn_mfma_f32_16x16x32_f16(Vf, Pf, O[nt], 0, 0, 0);
      }
    }
  }
  __builtin_amdgcn_s_setprio(0);
}

template <int D, class LoadF, class StoreF, class CompF>
__device__ __forceinline__ void pair_pipeline(int n, LoadF load, StoreF store, CompF comp) {
  h16x8 r[D][4];
#pragma unroll
  for (int d = 0; d < D; ++d)
    if (d < n) load(d, r[d]);
  store(0, r[0]);
  if (D < n) load(D, r[0]);
  __syncthreads();
  for (int i0 = 0; i0 < n; i0 += D) {
#pragma unroll
    for (int d = 0; d < D; ++d) {
      const int i = i0 + d;
      if (i < n) {
        if (i + 1 < n) store(i + 1, r[(d + 1) % D]);
        if (i + 1 + D < n) load(i + 1 + D, r[(d + 1) % D]);
        comp(i);
        __syncthreads();
      }
    }
  }
}

template <int D, class LoadF, class StoreF, class CompF>
__device__ __forceinline__ void tile_pipeline(int n, LoadF load, StoreF store, CompF comp) {
  h16x8 rk[D], rv[D];
#pragma unroll
  for (int d = 0; d < D; ++d)
    if (d < n) load(d, rk[d], rv[d]);
  store(0, rk[0], rv[0]);
  if (D < n) load(D, rk[0], rv[0]);
  __syncthreads();
  for (int i0 = 0; i0 < n; i0 += D) {
#pragma unroll
    for (int d = 0; d < D; ++d) {
      const int i = i0 + d;
      if (i < n) {
        if (i + 1 < n) store(i + 1, rk[(d + 1) % D], rv[(d + 1) % D]);
        if (i + 1 + D < n) load(i + 1 + D, rk[(d + 1) % D], rv[(d + 1) % D]);
        comp(i);
        __syncthreads();
      }
    }
  }
}

constexpr int LDS_BIAS = 800 * 16;
__device__ __forceinline__ void phase_swa(const Params& p, int l, char* lds, unsigned* ctr, int* slot) {
  const int tid = opaque_tid(), lane = tid & 63, w = tid >> 6, col = lane & 15, q4 = lane >> 4;
  float* biasT = (float*)lds;
  h16* KV = (h16*)(lds + LDS_BIAS);
  float* nrm = (float*)(lds + LDS_BIAS + 4 * 64 * KP * 2);
  const h16* P = (const h16*)(WS(p) + O_P);
  const int* lut = (const int*)(WS(p) + O_LUT);
  h16* OAC = (h16*)(WS(p) + O_OAC);
  __syncthreads();
  for (int i = tid; i < 3200; i += NT) biasT[i] = p.in[5][lut[i % 800] * 8 + (i / 800)] * LOG2E;
  __syncthreads();
  const int head = w >> 1, kvh = w >> 2;
  const float sink = p.in[4][l * 4 + head] * LOG2E;
  const int srow = tid >> 3, c8 = tid & 7;
  float hpd[2][4], hpe[2][4];
  const bool nosel[2] = {false, false};
  for (int u = fetch_unit(ctr, slot); u < BATCH * 128; u = fetch_unit(ctr, slot)) {
    const int b = u >> 7, t0 = (u & 127) * 64;
    const h16* Pbat = P + (size_t)b * SEQ * IWP;
    h16x8 Q[2][2];
    int tq[2];
#pragma unroll
    for (int rg = 0; rg < 2; ++rg) {
      const int qb = (w & 1) * 32 + rg * 16;
      const h16* qp = Pbat + (size_t)(t0 + qb + col) * IWP + head * 64 + q4 * 8;
      Q[rg][0] = *(const h16x8*)qp;
      Q[rg][1] = *(const h16x8*)(qp + 32);
      tq[rg] = t0 + qb + col;
    }
    f32x4 O[2][4];
    ColState st[2];
#pragma unroll
    for (int rg = 0; rg < 2; ++rg) {
#pragma unroll
      for (int nt = 0; nt < 4; ++nt) O[rg][nt] = f32x4{0.f, 0.f, 0.f, 0.f};
      st[rg].m = -1e30f; st[rg].l = 0.f;
    }
    const int i0 = t0 >= 128 ? 0 : (t0 >= 64 ? 1 : 2);
    h16x8 rk[2], rv[2];
    {
      int sb = t0 - 128 + i0 * 64;
      for (int h2 = 0; h2 < 2; ++h2) {
        rk[h2] = ld_row8(Pbat + 256 + h2 * 64, IWP, sb + srow, SEQ, c8);
        rv[h2] = ld_row8(Pbat + 384 + h2 * 64, IWP, sb + srow, SEQ, c8);
      }
    }
    for (int i = i0; i < 3; ++i) {
      __syncthreads();
      for (int h2 = 0; h2 < 2; ++h2) {
        st_k(KV + h2 * 64 * KP, srow, c8, rk[h2]);
        st_k(KV + (2 + h2) * 64 * KP, srow, c8, rv[h2]);
      }
      __syncthreads();
      if (i + 1 < 3) {
        int sb = t0 - 128 + (i + 1) * 64;
        for (int h2 = 0; h2 < 2; ++h2) {
          rk[h2] = ld_row8(Pbat + 256 + h2 * 64, IWP, sb + srow, SEQ, c8);
          rv[h2] = ld_row8(Pbat + 384 + h2 * 64, IWP, sb + srow, SEQ, c8);
        }
      }
      const int kb = t0 - 128 + i * 64;
      attn_tile<M_SWA, 3>(Q, O, st, KV + kvh * 64 * KP, KV + (2 + kvh) * 64 * KP, biasT, tq, head, kb, false, nosel, hpd, hpe, lane);
    }
    __syncthreads();
#pragma unroll
    for (int rg = 0; rg < 2; ++rg) {
      const int qb = (w & 1) * 32 + rg * 16;
      const float lsum = sum4q(st[rg].l);
      const float mn = fmaxf(st[rg].m, sink);
      const float corr = __builtin_amdgcn_exp2f(st[rg].m - mn);
      const float inv = corr / (lsum * corr + __builtin_amdgcn_exp2f(sink - mn));
      float ss = 0.f;
#pragma unroll
      for (int nt = 0; nt < 4; ++nt) {
        O[rg][nt] *= inv;
#pragma unroll
        for (int j = 0; j < 4; ++j) ss += O[rg][nt][j] * O[rg][nt][j];
      }
      ss = sum4q(ss);
      if (q4 == 0) nrm[head * 64 + qb + col] = ss;
    }
    __syncthreads();
#pragma unroll
    for (int rg = 0; rg < 2; ++rg) {
      const int qi = (w & 1) * 32 + rg * 16 + col;
      const float tot = nrm[qi] + nrm[64 + qi] + nrm[128 + qi] + nrm[192 + qi];
      const float sc = rsqrtf(tot * (1.f / 256.f) + EPS);
#pragma unroll
      for (int nt = 0; nt < 4; ++nt)
        *(h16x4*)(OAC + ((size_t)b * SEQ + t0 + qi) * 1024 + head * 64 + nt * 16 + q4 * 4) =
            pack4(O[rg][nt][0] * sc, O[rg][nt][1] * sc, O[rg][nt][2] * sc, O[rg][nt][3] * sc);
    }
  }
}

constexpr int LDS_NSA = LDS_BIAS + 8 * 64 * KP * 2 + NW * 4 * 128 * 4 + 32 * 16;
constexpr int PFD = 2;
__device__ __forceinline__ void phase_nsa(const Params& p, int l, char* lds, unsigned* ctr, int* slot, const int parts = 15) {
  const int tid = opaque_tid(), lane = tid & 63, w = tid >> 6, col = lane & 15, q4 = lane >> 4;
  float* biasT = (float*)lds;
  h16* KV0 = (h16*)(lds + LDS_BIAS);
  float* impw = (float*)(lds + LDS_BIAS + 8 * 64 * KP * 2) + w * 4 * 128;
  unsigned long long* selm = (unsigned long long*)(lds + LDS_BIAS + 8 * 64 * KP * 2 + NW * 4 * 128 * 4);
#define KSB(i, t) (KV0 + (((i) & 1) * 4 + (t) * 2) * 64 * KP)
#define VTB(i, t) (KV0 + (((i) & 1) * 4 + (t) * 2 + 1) * 64 * KP)
  const h16* P = (const h16*)(WS(p) + O_P);
  const int* lut = (const int*)(WS(p) + O_LUT);
  h16* OAC = (h16*)(WS(p) + O_OAC);
  __syncthreads();
  for (int i = tid; i < 3200; i += NT) biasT[i] = p.in[5][lut[i % 800] * 8 + 4 + (i / 800)] * LOG2E;
  __syncthreads();
  const int srow = tid >> 3, c8 = tid & 7;
  const int hd = col & 3, qw = col >> 2;
  float hpd[2][4], hpe[2][4];
  const bool nosel[2] = {false, false};
  for (int u = fetch_unit(ctr, slot); u < 1024; u = fetch_unit(ctr, slot)) {
    const int rnd = u >> 8, b = (u & 255) >> 6, ti = u & 63;
    const int tile = rnd == 0 ? 255 - ti : (rnd == 1 ? 128 + ti : (rnd == 2 ? 127 - ti : ti));
    const int t0 = tile * 32, cur = t0 >> 6;
    const h16* Pbat = P + (size_t)b * SEQ * IWP;
    const h16* KC = (const h16*)(WS(p) + O_KCMP) + (size_t)b * 512 * 64;
    const h16* VC = (const h16*)(WS(p) + O_VCMP) + (size_t)b * 512 * 64;
    h16x8 Q[2];
    int tq;
    {
      const h16* qp = Pbat + (size_t)(t0 + w * 4 + qw) * IWP + OFF_QC + hd * 64 + q4 * 8;
      Q[0] = *(const h16x8*)qp;
      Q[1] = *(const h16x8*)(qp + 32);
      tq = t0 + w * 4 + qw;
    }
    const h16* gp = Pbat + (size_t)tq * IWP + OFF_GC + hd * 3;
    for (int i = lane; i < 512; i += 64) impw[i] = 0.f;
    f32x4 O[4], Oc[4];
    ColState st;
    int mvmax = t0 / 16 + 1;
    if (mvmax > NCMP) mvmax = NCMP;
    const int ntc = (mvmax + 63) >> 6;
    st.m = -1e30f; st.l = 0.f;
    const int npc = (ntc + 1) >> 1;
    if (parts & 1) pair_pipeline<PFD>(npc,
      [&](int i, h16x8 (&r)[4]) { r[0] = ld_row8(KC, 64, (2 * i) * 64 + srow, 512, c8); r[2] = ld_row8(KC, 64, (2 * i + 1) * 64 + srow, 512, c8); },
      [&](int i, const h16x8 (&r)[4]) { st_k(KSB(i, 0), srow, c8, r[0]); st_k(KSB(i, 1), srow, c8, r[2]); },
      [&](int i) {
        const bool far[2] = {t0 - 31 - 16 * (2 * i * 64 + 63) >= 799, t0 - 31 - 16 * ((2 * i + 1) * 64 + 63) >= 799};
        if (2 * i + 1 < ntc) attn_tile2<M_CMPA, 3>(Q, O, st, KSB(i, 0), VTB(i, 0), KSB(i, 1), VTB(i, 1), biasT, tq, hd, 2 * i * 64, far, nosel, hpd, hpe, lane);
        else attn_tile2<M_CMPA, 1>(Q, O, st, KSB(i, 0), VTB(i, 0), KSB(i, 1), VTB(i, 1), biasT, tq, hd, 2 * i * 64, far, nosel, hpd, hpe, lane);
      });
    {
      const float ls = sum4q(st.l);
      st.l = ls > 0.f ? 1.f / ls : 0.f;
    }
#pragma unroll
    for (int nt = 0; nt < 4; ++nt) O[nt] = f32x4{0.f, 0.f, 0.f, 0.f};
    float carry = 0.f;
    if (parts & 1) pair_pipeline<PFD>(npc,
      [&](int i, h16x8 (&r)[4]) {
        r[0] = ld_row8(KC, 64, (2 * i) * 64 + srow, 512, c8); r[1] = ld_row8(VC, 64, (2 * i) * 64 + srow, 512, c8);
        r[2] = ld_row8(KC, 64, (2 * i + 1) * 64 + srow, 512, c8); r[3] = ld_row8(VC, 64, (2 * i + 1) * 64 + srow, 512, c8); },
      [&](int i, const h16x8 (&r)[4]) {
        st_k(KSB(i, 0), srow, c8, r[0]); st_k(VTB(i, 0), srow, c8, r[1]); st_k(KSB(i, 1), srow, c8, r[2]); st_k(VTB(i, 1), srow, c8, r[3]); },
      [&](int i) {
        float hq[2][4], h3[2][4];
        const bool far[2] = {t0 - 31 - 16 * (2 * i * 64 + 63) >= 799, t0 - 31 - 16 * ((2 * i + 1) * 64 + 63) >= 799};
        const bool two = 2 * i + 1 < ntc;
        if (two) attn_tile2<M_CMPB, 3>(Q, O, st, KSB(i, 0), VTB(i, 0), KSB(i, 1), VTB(i, 1), biasT, tq, hd, 2 * i * 64, far, nosel, hq, h3, lane);
        else attn_tile2<M_CMPB, 1>(Q, O, st, KSB(i, 0), VTB(i, 0), KSB(i, 1), VTB(i, 1), biasT, tq, hd, 2 * i * 64, far, nosel, hq, h3, lane);
        float t3p = carry;
#pragma unroll
        for (int t = 0; t < 2; ++t) {
          if (t == 1 && !two) break;
#pragma unroll
          for (int kt = 0; kt < 4; ++kt) {
            const float qs = quadsum(hq[t][kt]);
            const float t3 = quadsum(h3[t][kt]);
            const float up = __shfl(t3, (lane + 48) & 63);
            const float wrp = __shfl(t3p, (lane + 48) & 63);
            const float pk = (q4 == 0) ? wrp : up;
            if (hd == 0) impw[qw * 128 + (2 * i + t) * 16 + kt * 4 + q4] = qs + pk;
            t3p = t3;
          }
        }
        carry = t3p;
      });
    {
      const float g0 = (float)gp[0];
#pragma unroll
      for (int nt = 0; nt < 4; ++nt) Oc[nt] = O[nt] * g0;
    }
    if (parts & 2) {
      const int nforced = cur >= 2 ? 3 : cur + 1;
      const int npick = 16 - nforced;
      for (int qi = 0; qi < 4; ++qi) {
        const float* im = impw + qi * 128;
        const int j0 = lane, j1 = lane + 64;
        const float v0 = im[j0], v1 = im[j1];
        int r0 = 0, r1 = 0;
#pragma unroll 8
        for (int jp = 1; jp <= cur - 2; ++jp) {
          float vp = im[jp];
          r0 += (vp > v0 || (vp == v0 && jp < j0)) ? 1 : 0;
          r1 += (vp > v1 || (vp == v1 && jp < j1)) ? 1 : 0;
        }
        bool c0 = j0 >= 1 && j0 <= cur - 2, c1 = j1 <= cur - 2;
        bool f0 = j0 == 0 || j0 == cur || j0 == cur - 1, f1 = j1 == cur || j1 == cur - 1;
        unsigned long long mlo = __ballot(f0 || (c0 && r0 < npick));
        unsigned long long mhi = __ballot(f1 || (c1 && r1 < npick));
        if (lane == 0) { selm[(w * 4 + qi) * 2] = mlo; selm[(w * 4 + qi) * 2 + 1] = mhi; }
      }
    }
    asm volatile("" ::: "memory");
    const unsigned long long slo = selm[(w * 4 + qw) * 2], shi = selm[(w * 4 + qw) * 2 + 1];
#pragma unroll
    for (int nt = 0; nt < 4; ++nt) O[nt] = f32x4{0.f, 0.f, 0.f, 0.f};
    st.m = -1e30f; st.l = 0.f;
    if (parts & 4) pair_pipeline<PFD>((cur + 2) >> 1,
      [&](int i, h16x8 (&r)[4]) {
        r[0] = ld_row8(Pbat + OFF_KVC + 128, IWP, (2 * i) * 64 + srow, SEQ, c8); r[1] = ld_row8(Pbat + OFF_KVC + 192, IWP, (2 * i) * 64 + srow, SEQ, c8);
        r[2] = ld_row8(Pbat + OFF_KVC + 128, IWP, (2 * i + 1) * 64 + srow, SEQ, c8); r[3] = ld_row8(Pbat + OFF_KVC + 192, IWP, (2 * i + 1) * 64 + srow, SEQ, c8); },
      [&](int i, const h16x8 (&r)[4]) {
        st_k(KSB(i, 0), srow, c8, r[0]); st_k(VTB(i, 0), srow, c8, r[1]); st_k(KSB(i, 1), srow, c8, r[2]); st_k(VTB(i, 1), srow, c8, r[3]); },
      [&](int i) {
        const int jb = 2 * i;
        bool sb[2];
        sb[0] = ((jb < 64 ? (slo >> jb) : (shi >> (jb - 64))) & 1ull) != 0;
        sb[1] = (jb + 1 <= cur) && (((jb + 1 < 64 ? (slo >> (jb + 1)) : (shi >> (jb + 1 - 64))) & 1ull) != 0);
        const bool far[2] = {t0 - (jb * 64 + 63) >= 799, t0 - (jb * 64 + 127) >= 799};
        const bool n0 = __any(sb[0]) != 0, n1 = __any(sb[1]) != 0;
        if (n0 && n1) attn_tile2<M_SEL, 3>(Q, O, st, KSB(i, 0), VTB(i, 0), KSB(i, 1), VTB(i, 1), biasT, tq, hd, jb * 64, far, sb, hpd, hpe, lane);
        else if (n0) attn_tile2<M_SEL, 1>(Q, O, st, KSB(i, 0), VTB(i, 0), KSB(i, 1), VTB(i, 1), biasT, tq, hd, jb * 64, far, sb, hpd, hpe, lane);
        else if (n1) attn_tile2<M_SEL, 2>(Q, O, st, KSB(i, 0), VTB(i, 0), KSB(i, 1), VTB(i, 1), biasT, tq, hd, jb * 64, far, sb, hpd, hpe, lane);
      });
    {
      const float ls = sum4q(st.l);
      const float f = ls > 0.f ? (float)gp[1] / ls : 0.f;
#pragma unroll
      for (int nt = 0; nt < 4; ++nt) Oc[nt] += O[nt] * f;
    }
#pragma unroll
    for (int nt = 0; nt < 4; ++nt) O[nt] = f32x4{0.f, 0.f, 0.f, 0.f};
    st.m = -1e30f; st.l = 0.f;
    const int w0 = cur >= 8 ? cur - 8 : 0;
    const int nwt = cur - w0 + 1;
    if (parts & 8) pair_pipeline<PFD>((nwt + 1) >> 1,
      [&](int i, h16x8 (&r)[4]) {
        r[0] = ld_row8(Pbat + OFF_KVC + 256, IWP, (w0 + 2 * i) * 64 + srow, SEQ, c8); r[1] = ld_row8(Pbat + OFF_KVC + 320, IWP, (w0 + 2 * i) * 64 + srow, SEQ, c8);
        r[2] = ld_row8(Pbat + OFF_KVC + 256, IWP, (w0 + 2 * i + 1) * 64 + srow, SEQ, c8); r[3] = ld_row8(Pbat + OFF_KVC + 320, IWP, (w0 + 2 * i + 1) * 64 + srow, SEQ, c8); },
      [&](int i, const h16x8 (&r)[4]) {
        st_k(KSB(i, 0), srow, c8, r[0]); st_k(VTB(i, 0), srow, c8, r[1]); st_k(KSB(i, 1), srow, c8, r[2]); st_k(VTB(i, 1), srow, c8, r[3]); },
      [&](int i) {
        const bool far[2] = {false, false};
        if (2 * i + 1 < nwt) attn_tile2<M_WIN, 3>(Q, O, st, KSB(i, 0), VTB(i, 0), KSB(i, 1), VTB(i, 1), biasT, tq, hd, (w0 + 2 * i) * 64, far, nosel, hpd, hpe, lane);
        else attn_tile2<M_WIN, 1>(Q, O, st, KSB(i, 0), VTB(i, 0), KSB(i, 1), VTB(i, 1), biasT, tq, hd, (w0 + 2 * i) * 64, far, nosel, hpd, hpe, lane);
      });
    {
      const float ls = sum4q(st.l);
      const float f = ls > 0.f ? (float)gp[2] / ls : 0.f;
      float ss = 0.f;
#pragma unroll
      for (int nt = 0; nt < 4; ++nt) {
        Oc[nt] += O[nt] * f;
#pragma unroll
        for (int j = 0; j < 4; ++j) ss += Oc[nt][j] * Oc[nt][j];
      }
      ss = quadsum(sum4q(ss));
      const float sc = rsqrtf(ss * (1.f / 256.f) + EPS);
#pragma unroll
      for (int nt = 0; nt < 4; ++nt)
        *(h16x4*)(OAC + ((size_t)b * SEQ + tq) * 1024 + 256 + hd * 64 + nt * 16 + q4 * 4) =
            pack4(Oc[nt][0] * sc, Oc[nt][1] * sc, Oc[nt][2] * sc, Oc[nt][3] * sc);
    }
  }
#undef KSB
#undef VTB
}

constexpr int LDS_SWA = LDS_BIAS + 4 * 64 * KP * 2 + 1024;
constexpr int lds_max(int a, int b) { return a > b ? a : b; }
constexpr int LDS_BYTES = lds_max(lds_max(LDS_NSA, SSMY_LDS), lds_max(LDS_SWA, lds_max(LDS_GEMM, lds_max(LDS_CMP, 64 * 65 * 4))));

__global__ void __launch_bounds__(NT) fwd_megakernel(Params p) {
  cg::grid_group grid = cg::this_grid();
  __shared__ __attribute__((aligned(16))) char lds[LDS_BYTES];
  __shared__ uint4 xb_words;
  __shared__ int wq_slot;
  if (threadIdx.x == 0) xb_words = make_uint4(0u, 0u, 0u, 0u);
  __syncthreads();
  (void)xcd_barrier_post((unsigned*)(WS(p) + O_BAR), (volatile LAS unsigned*)&xb_words);
#define GBAR() do { XcdBarrier _b; _b.bar = (unsigned*)(WS(p) + O_BAR); _b.x = xb_xcc_id(); _b.st = (volatile LAS unsigned*)&xb_words; xcd_barrier(_b); } while (0)
  phase0(p, (float*)lds);
  grid.sync();
  phase0b(p);
  GBAR();
  for (int l = 0; l < DEPTH; ++l) {
    phase_gemm1(p, l, lds);
    GBAR();
    ssm_endstates(p, l, lds);
    phase_compress(p, l, lds);
    GBAR();
    {
      unsigned* q = (unsigned*)(WS(p) + O_BAR) + 3456 + l * 3 * 64;
      phase_nsa(p, l, lds, q, &wq_slot);
      ssm_outputs(p, l, lds, q + 64, &wq_slot);
      phase_swa(p, l, lds, q + 128, &wq_slot);
    }
    GBAR();
    phase_glu(p, l, lds);
    GBAR();
    phase_wout(p, l, lds);
    GBAR();
    phase_up(p, l, lds);
    GBAR();
    phase_down(p, l, lds);
    GBAR();
  }
}

extern "C" void kernel_launch(void* const* d_in, const int* in_sizes, int n_in, void* d_out, int out_size, void* d_ws,
                              size_t ws_size, hipStream_t stream) {
  static int grid_blocks = 0;
  if (!grid_blocks) {
    int dev = 0, cus = 0, per_cu = 0;
    (void)hipGetDevice(&dev);
    (void)hipDeviceGetAttribute(&cus, hipDeviceAttributeMultiprocessorCount, dev);
    (void)hipOccupancyMaxActiveBlocksPerMultiprocessor(&per_cu, fwd_megakernel, NT, 0);
    if (per_cu > 1) per_cu = 1;
    grid_blocks = cus * per_cu;
  }
  if (ws_size < WS_NEED) {
    fprintf(stderr, "workspace too small: %zu < %zu\n", ws_size, WS_NEED);
    return;
  }
  Params p{};
  for (int i = 0; i < 24; ++i) p.in[i] = (const float*)d_in[i];
  p.out = (float*)d_out;
  p.ws = (char*)d_ws;
  (void)hipMemsetAsync((char*)d_ws + O_BAR, 0, SZ_BAR, stream);
  void* args[] = {&p};
  hipError_t e = hipLaunchCooperativeKernel((void*)fwd_megakernel, dim3(grid_blocks), dim3(NT), args, 0, stream);
  if (e != hipSuccess) fprintf(stderr, "cooperative launch failed: %s (grid %d)\n", hipGetErrorString(e), grid_blocks);
}
```

```cpp
#include <hip/hip_runtime.h>
#include <hip/hip_cooperative_groups.h>
#include <cstdio>
namespace cg = cooperative_groups;

typedef _Float16 h16;
typedef __attribute__((ext_vector_type(8))) _Float16 h16x8;
typedef __attribute__((ext_vector_type(4))) float f32x4;

constexpr int NT = 512;
constexpr int NW = NT / 64;
constexpr int BATCH = 4, SEQ = 8192, NTOK = BATCH * SEQ, DM = 1024, DEPTH = 4, IW = 1676, IWP = 1792, DFF = 4096;
constexpr int OFF_U = 512, OFF_QC = 1024, OFF_KVC = 1280, OFF_GC = 1664;
constexpr int NCMP = 511;
constexpr float EPS = 1e-6f;

constexpr size_t SZ_WIN = (size_t)IWP * DM * 2, SZ_WGLU = (size_t)1024 * 512 * 2, SZ_WOUT = (size_t)DM * DM * 2,
                 SZ_WUP = (size_t)DFF * DM * 2, SZ_WDN = (size_t)DM * DFF * 2;
constexpr size_t O_WIN = 0;
constexpr size_t O_WGLU = O_WIN + DEPTH * SZ_WIN;
constexpr size_t O_WOUT = O_WGLU + DEPTH * SZ_WGLU;
constexpr size_t O_WUP = O_WOUT + DEPTH * SZ_WOUT;
constexpr size_t O_WDN = O_WUP + DEPTH * SZ_WUP;
constexpr size_t O_XB = O_WDN + DEPTH * SZ_WDN;
constexpr size_t O_SSQ = O_XB + (size_t)NTOK * DM * 2;
constexpr size_t O_SSQB = O_SSQ + (size_t)NTOK * 16 * 4;
constexpr size_t O_KCMP = O_SSQB + (size_t)NTOK * 16 * 4;
constexpr size_t O_VCMP = O_KCMP + (size_t)BATCH * 512 * 64 * 4;
constexpr size_t O_ABAR = O_VCMP + (size_t)BATCH * 512 * 64 * 4;
constexpr size_t O_BBAR = O_ABAR + (size_t)DEPTH * 32 * 64 * 8;
constexpr size_t O_BIAS1 = O_BBAR + (size_t)DEPTH * 32 * 64 * 16 * 8;
constexpr size_t O_LUT = O_BIAS1 + (size_t)DEPTH * 2 * 128 * 4;
constexpr size_t O_AT = O_LUT + 8192 * 4;
constexpr size_t O_KTAB = O_AT + (size_t)128 * 64 * 8;
constexpr size_t SZ_KTAB = (size_t)65 * 256 * 2;
constexpr size_t O_W1 = O_KTAB + 128 * SZ_KTAB;
constexpr size_t SZ_W13 = (size_t)128 * 1024 * 2;
constexpr size_t O_W3 = O_W1 + 128 * SZ_W13;
constexpr size_t O_W1T = O_W3 + 128 * SZ_W13;
constexpr size_t O_W2T = O_W1T + (size_t)8 * 128 * 2048 * 2;
constexpr size_t O_B1P = O_W2T + (size_t)8 * 64 * 128 * 2;
constexpr size_t O_BAR = (O_B1P + (size_t)8 * 32 * 128 * 4 + 255) / 256 * 256;
constexpr size_t SZ_BAR = 3456 * 4 + 16 * 64 * 4;
constexpr size_t O_BIG = (O_BAR + SZ_BAR + 255) / 256 * 256;
constexpr size_t O_P = O_BIG;
constexpr size_t O_Z = O_P + (size_t)NTOK * IWP * 2;
constexpr size_t O_OB = O_Z + (size_t)NTOK * 512 * 2;
constexpr size_t O_OAC = O_OB + (size_t)512 * 2;
constexpr size_t O_E = O_OB + (size_t)NTOK * 1024 * 2;
constexpr size_t O_APOW = O_E + (size_t)512 * 32 * 128 * 4;
static_assert(O_APOW + (size_t)128 * 65 * 64 * 16 <= O_BIG + (size_t)NTOK * DFF * 2, "Apow scratch must fit inside the big region");
constexpr size_t O_HID = O_BIG;
constexpr size_t WS_NEED = O_BIG + (size_t)NTOK * DFF * 2;

struct Params {
  const float* in[24];
  float* out;
  char* ws;
};

__device__ __forceinline__ char* WS(const Params& p) {
  int z;
  asm volatile("s_mov_b32 %0, 0" : "=s"(z));
  return p.ws + z;
}
__device__ __forceinline__ int fetch_unit(unsigned* ctr, int* slot) {
  __syncthreads();
  if (threadIdx.x == 0) *slot = (int)atomicAdd(ctr, 1u);
  __syncthreads();
  return *slot;
}
__device__ __forceinline__ int opaque_tid() {
  int t = threadIdx.x;
  asm volatile("" : "+v"(t));
  return t;
}
template <int CTRL>
__device__ __forceinline__ float dppf(float v) {
  return __int_as_float(__builtin_amdgcn_update_dpp(0, __float_as_int(v), CTRL, 0xF, 0xF, true));
}
__device__ __forceinline__ float sum16(float v) {
  v += dppf<0xB1>(v); v += dppf<0x4E>(v); v += dppf<0x141>(v); v += dppf<0x140>(v);
  return v;
}
__device__ __forceinline__ float max16(float v) {
  v = fmaxf(v, dppf<0xB1>(v)); v = fmaxf(v, dppf<0x4E>(v)); v = fmaxf(v, dppf<0x141>(v)); v = fmaxf(v, dppf<0x140>(v));
  return v;
}
__device__ __forceinline__ float xor16(float v) { return __int_as_float(__builtin_amdgcn_ds_swizzle(__float_as_int(v), 0x401F)); }
__device__ __forceinline__ float rdlane_c(float v, int l) { return __int_as_float(__builtin_amdgcn_readlane(__float_as_int(v), l)); }
__device__ __forceinline__ float wave_sum(float v) {
  v = sum16(v); v += xor16(v);
  return rdlane_c(v, 0) + rdlane_c(v, 32);
}
__device__ __forceinline__ float gelu_tanh(float x) {
  float u = 0.7978845608028654f * (x + 0.044715f * x * x * x);
  return 0.5f * x * (1.f + tanhf(u));
}
__device__ __forceinline__ float sigmoidf(float x) { return 1.f / (1.f + __expf(-x)); }
__device__ __forceinline__ float rdlane(float v, int l) {
  return __int_as_float(__builtin_amdgcn_readlane(__float_as_int(v), l));
}

__device__ __forceinline__ int perm32(int rho) { return 8 * ((rho & 15) >> 2) + 4 * (rho >> 4) + (rho & 3); }

template <class SrcF>
__device__ __forceinline__ void conv_tile(SrcF src, h16* dst, int ldo, int n0, int k0, float* tile) {
  int tid = opaque_tid();
  for (int idx = tid; idx < 4096; idx += NT) {
    int kk = idx >> 6, nn = idx & 63;
    tile[kk * 65 + nn] = src(k0 + kk, n0 + nn);
  }
  __syncthreads();
  for (int idx = tid; idx < 4096; idx += NT) {
    int nn = idx >> 6, kk = idx & 63;
    dst[(long)(n0 + nn) * ldo + k0 + kk] = (h16)tile[kk * 65 + nn];
  }
  __syncthreads();
}

template <class SrcF>
__device__ __forceinline__ void conv_tile_h(SrcF src, h16* dst, int ldo, int n0, int k0, float* tile, int t, bool act) {
  if (act)
    for (int idx = t; idx < 4096; idx += 256) {
      int kk = idx >> 6, nn = idx & 63;
      tile[kk * 65 + nn] = src(k0 + kk, n0 + nn);
    }
  __syncthreads();
  if (act)
    for (int idx = t; idx < 4096; idx += 256) {
      int nn = idx >> 6, kk = idx & 63;
      dst[(long)(n0 + nn) * ldo + k0 + kk] = (h16)tile[kk * 65 + nn];
    }
  __syncthreads();
}

__device__ __forceinline__ void phase0(const Params& p, float* lds) {
  const int tid = opaque_tid();
  constexpr int T_IN = (IWP / 64) * (DM / 64);
  constexpr int T_GLU = 16 * 8;
  constexpr int T_OUT = 16 * 16;
  constexpr int T_UP = 64 * 16;
  constexpr int T_DN = 16 * 64;
  constexpr int T_L = T_IN + T_GLU + T_OUT + T_UP + T_DN;
  const int hf = tid >> 8, t8 = tid & 255;
  float* ldh = lds + hf * (64 * 65 + 16);
  for (int tp = blockIdx.x; tp * 2 < DEPTH * T_L; tp += gridDim.x) {
    const int ti = tp * 2 + hf;
    const bool act = ti < DEPTH * T_L;
    int l = act ? ti / T_L : 0, r = act ? ti % T_L : 0;
    if (r < T_IN) {
      int nt = r / 16, kt = r % 16;
      const float* w = p.in[2] + (size_t)l * DM * IW;
      const float* g = p.in[1] + l * DM;
      conv_tile_h([&](int k, int sl) {
        int n = (sl & ~255) + 64 * ((sl >> 5) & 3) + 32 * ((sl >> 7) & 1) + perm32(sl & 31);
        return n < IW ? w[(long)k * IW + n] * g[k] : 0.f; },
                (h16*)(WS(p) + O_WIN + l * SZ_WIN), DM, nt * 64, kt * 64, ldh, t8, act);
    } else if ((r -= T_IN) < T_GLU) {
      int nt = r / 8, kt = r % 8;
      const float* w = p.in[14] + (size_t)l * 512 * 1024;
      conv_tile_h([&](int k, int n2) {
        int pn = n2 >> 8, bj = (n2 >> 7) & 1, wc = (n2 >> 5) & 3, nn = (n2 >> 4) & 1, r = n2 & 15;
        int n = (nn ? 512 : 0) + 128 * pn + 64 * bj + 16 * wc + r;
        return w[(long)k * 1024 + n]; },
                (h16*)(WS(p) + O_WGLU + l * SZ_WGLU), 512, nt * 64, kt * 64, ldh, t8, act);
    } else if ((r -= T_GLU) < T_OUT) {
      int nt = r / 16, kt = r % 16;
      const float* w = p.in[20] + (size_t)l * DM * DM;
      const float* g = p.in[19] + l * DM;
      conv_tile_h([&](int k2, int n2) {
        int k = k2 < 512 ? 256 + k2 : (k2 < 768 ? k2 - 512 : k2);
        int n = (n2 & ~31) + perm32(n2 & 31);
        return w[(long)k * DM + n] * g[k]; },
                (h16*)(WS(p) + O_WOUT + l * SZ_WOUT), DM, nt * 64, kt * 64, ldh, t8, act);
    } else if ((r -= T_OUT) < T_UP) {
      int nt = r / 16, kt = r % 16;
      const float* w = p.in[22] + (size_t)l * DM * DFF;
      const float* g = p.in[21] + l * DM;
      conv_tile_h([&](int k, int n2) { int n = (n2 & ~31) + perm32(n2 & 31); return w[(long)k * DFF + n] * g[k]; },
                (h16*)(WS(p) + O_WUP + l * SZ_WUP), DM, nt * 64, kt * 64, ldh, t8, act);
    } else {
      r -= T_UP;
      int nt = r / 64, kt = r % 64;
      const float* w = p.in[23] + (size_t)l * DFF * DM;
      conv_tile_h([&](int k, int n2) { int n = (n2 & ~31) + perm32(n2 & 31); return w[(long)k * DM + n]; },
                (h16*)(WS(p) + O_WDN + l * SZ_WDN), DFF, nt * 64, kt * 64, ldh, t8, act);
    }
  }
  for (int ti = blockIdx.x; ti < 8 * 66; ti += gridDim.x) {
    int ls = ti / 66, r = ti % 66;
    if (r < 64) {
      int nt = r >> 5, kt = r & 31;
      const float* w = p.in[17] + (size_t)ls * 2048 * 128;
      conv_tile([&](int k, int n) { return w[(long)k * 128 + n]; }, (h16*)(WS(p) + O_W1T) + (size_t)ls * 128 * 2048, 2048, nt * 64, kt * 64, lds);
    } else {
      int kt = r - 64;
      const float* w = p.in[18] + (size_t)ls * 128 * 64;
      conv_tile([&](int k, int n) { return w[(long)k * 64 + n]; }, (h16*)(WS(p) + O_W2T) + (size_t)ls * 64 * 128, 128, 0, kt * 64, lds);
    }
  }
  {
    const int lane = tid & 63;
    const int gw = blockIdx.x * NW + (tid >> 6), nw = gridDim.x * NW;
    const float* x = p.in[0];
    h16* xb = (h16*)(WS(p) + O_XB);
    float* ssq = (float*)(WS(p) + O_SSQ);
    for (int row = gw; row < NTOK; row += nw) {
      const float4* xr = (const float4*)(x + (long)row * DM + lane * 16);
      float s = 0.f;
      h16 hv[16];
      for (int i = 0; i < 4; ++i) {
        float4 v = xr[i];
        s += v.x * v.x + v.y * v.y + v.z * v.z + v.w * v.w;
        hv[i * 4 + 0] = (h16)v.x; hv[i * 4 + 1] = (h16)v.y; hv[i * 4 + 2] = (h16)v.z; hv[i * 4 + 3] = (h16)v.w;
      }
      h16x8* xo = (h16x8*)(xb + (long)row * DM + lane * 16);
      h16x8 o0, o1;
      for (int i = 0; i < 8; ++i) { o0[i] = hv[i]; o1[i] = hv[8 + i]; }
      xo[0] = o0; xo[1] = o1;
      s += dppf<0xB1>(s);
      s += dppf<0x4E>(s);
      if ((lane & 3) == 0) ssq[(long)row * 16 + (lane >> 2)] = s;
    }
  }
  const int gt = blockIdx.x * NT + tid, ngt = gridDim.x * NT;
  for (int i = gt; i < DEPTH * 32 * 64; i += ngt) {
    int l = i / 2048, g = (i / 64) % 32;
    double are = p.in[6][i], aim = p.in[7][i];
    double dt = exp((double)p.in[8][l * 32 + g]);
    double er = exp(are * dt), abr = er * cos(aim * dt), abi = er * sin(aim * dt);
    ((float2*)(WS(p) + O_ABAR))[i] = make_float2((float)abr, (float)abi);
    double nr = abr - 1.0, ni = abi, den = are * are + aim * aim;
    double fr = (nr * are + ni * aim) / den, fi = (ni * are - nr * aim) / den;
    float2* bb = (float2*)(WS(p) + O_BBAR) + (size_t)i * 16;
    for (int q = 0; q < 16; ++q) {
      double br = p.in[9][(size_t)i * 16 + q], bi = p.in[10][(size_t)i * 16 + q];
      bb[q] = make_float2((float)((fr * br - fi * bi) / dt), (float)((fr * bi + fi * br) / dt));
    }
  }
  for (int i = gt; i < 128 * 65 * 64; i += ngt) {
    int n = i & 63, j = (i >> 6) % 65, lg = i / (65 * 64);
    double are = p.in[6][lg * 64 + n], aim = p.in[7][lg * 64 + n];
    double dt = exp((double)p.in[8][lg]);
    double er = exp(are * dt * j), ang = aim * dt * j;
    ((double2*)(WS(p) + O_APOW))[i] = make_double2(er * cos(ang), er * sin(ang));
  }
  for (int i = gt; i < DEPTH * 2 * 128 * 32; i += ngt) {
    int j = i & 127, kc = (i >> 7) & 31, ls = i >> 12;
    const float* pos = p.in[16] + (size_t)ls * 2048 + kc * 64;
    const float* w1 = p.in[17] + ((size_t)ls * 2048 + kc * 64) * 128;
    float a = 0.f;
#pragma unroll 16
    for (int k = 0; k < 64; ++k) a += pos[k] * w1[(long)k * 128 + j];
    ((float*)(WS(p) + O_B1P))[i] = a;
  }
  for (int d = gt; d < 8192; d += ngt) {
    int bk;
    if (d < 16) bk = d;
    else {
      float nf = (float)d;
      int large = 16 + (int)(logf(nf / 16.0f) / 4.1588830833596715f * 16.0f);
      bk = large < 31 ? large : 31;
    }
    ((int*)(WS(p) + O_LUT))[d] = bk;
  }
}

__device__ __forceinline__ void phase0b(const Params& p) {
  const int gt = blockIdx.x * NT + threadIdx.x, ngt = gridDim.x * NT;
  const double2* apow = (const double2*)(WS(p) + O_APOW);
  const float2* bbs = (const float2*)(WS(p) + O_BBAR);
  for (int i = gt; i < 128 * 64 * 64; i += ngt) {
    int tau = i & 63, n = (i >> 6) & 63, lg = i >> 12;
    double2 ap = apow[(lg * 65 + (63 - tau)) * 64 + n];
    const float2* bb = bbs + (size_t)(lg * 64 + n) * 16;
    h16x8 re0, re1, im0, im1;
#pragma unroll
    for (int q = 0; q < 8; ++q) {
      float2 b0 = bb[q], b1 = bb[8 + q];
      re0[q] = (h16)(float)(ap.x * b0.x - ap.y * b0.y);
      im0[q] = (h16)(float)(ap.x * b0.y + ap.y * b0.x);
      re1[q] = (h16)(float)(ap.x * b1.x - ap.y * b1.y);
      im1[q] = (h16)(float)(ap.x * b1.y + ap.y * b1.x);
    }
    h16* W1 = (h16*)(WS(p) + O_W1 + (size_t)lg * SZ_W13);
    *(h16x8*)(W1 + ((size_t)(2 * tau) * 128 + 2 * n) * 8) = re0;
    *(h16x8*)(W1 + ((size_t)(2 * tau) * 128 + 2 * n + 1) * 8) = im0;
    *(h16x8*)(W1 + ((size_t)(2 * tau + 1) * 128 + 2 * n) * 8) = re1;
    *(h16x8*)(W1 + ((size_t)(2 * tau + 1) * 128 + 2 * n + 1) * 8) = im1;
  }
  for (int i = gt; i < 128 * 64 * 16 * 16; i += ngt) {
    int pp = i & 15, kc = (i >> 4) & 15, tau = (i >> 8) & 63, lg = i >> 14;
    h16x8 v;
#pragma unroll
    for (int e = 0; e < 4; ++e) {
      int n = 4 * kc + e;
      double2 ap = apow[(lg * 65 + tau + 1) * 64 + n];
      double cr = p.in[11][((size_t)lg * 16 + pp) * 64 + n], ci = p.in[12][((size_t)lg * 16 + pp) * 64 + n];
      v[2 * e] = (h16)(float)(cr * ap.x - ci * ap.y);
      v[2 * e + 1] = (h16)(float)(-(cr * ap.y + ci * ap.x));
    }
    h16* W3 = (h16*)(WS(p) + O_W3 + (size_t)lg * SZ_W13);
    *(h16x8*)(W3 + ((size_t)((tau * 16 + kc) * 16) + pp) * 8) = v;
  }
  for (int i = gt; i < 128 * 65 * 16; i += ngt) {
    int pp = i & 15, slot = (i >> 4) % 65, lg = i / (65 * 16);
    float acc[16];
#pragma unroll
    for (int q = 0; q < 16; ++q) acc[q] = 0.f;
    if (slot > 0) {
#pragma unroll 4
      for (int n = 0; n < 64; ++n) {
        double2 ap = apow[(lg * 65 + slot - 1) * 64 + n];
        double cr = p.in[11][((size_t)lg * 16 + pp) * 64 + n], ci = p.in[12][((size_t)lg * 16 + pp) * 64 + n];
        float xr = (float)(cr * ap.x - ci * ap.y), xi = (float)(cr * ap.y + ci * ap.x);
        const float2* bb = bbs + (size_t)(lg * 64 + n) * 16;
#pragma unroll
        for (int q = 0; q < 16; ++q) { float2 b = bb[q]; acc[q] += xr * b.x - xi * b.y; }
      }
    }
    h16x8 v0, v1;
#pragma unroll
    for (int q = 0; q < 8; ++q) { v0[q] = (h16)acc[q]; v1[q] = (h16)acc[8 + q]; }
    h16* kt = (h16*)(WS(p) + O_KTAB + (size_t)lg * SZ_KTAB) + slot * 256 + pp * 16;
    *(h16x8*)kt = v0;
    *(h16x8*)(kt + 8) = v1;
  }
  for (int i = gt; i < 128 * 64; i += ngt) {
    double2 ap = apow[((i >> 6) * 65 + 64) * 64 + (i & 63)];
    ((float2*)(WS(p) + O_AT))[i] = make_float2((float)ap.x, (float)ap.y);
  }
  for (int i = gt; i < DEPTH * 2 * 128; i += ngt) {
    const float* pp = (const float*)(WS(p) + O_B1P) + (size_t)(i >> 7) * 32 * 128 + (i & 127);
    float a = 0.f;
    for (int kc = 0; kc < 32; ++kc) a += pp[kc * 128];
    ((float*)(WS(p) + O_BIAS1))[i] = a;
  }
}

__device__ __forceinline__ void ssm_endstates(const Params& p, int l, char* lds) {
  const int tid = opaque_tid(), lane = tid & 63, w = tid >> 6;
  const h16* P = (const h16*)(WS(p) + O_P);
  float* E = (float*)(WS(p) + O_E);
  f32x4* red = (f32x4*)lds;
  for (int ub4 = blockIdx.x; ub4 < 256; ub4 += gridDim.x) {
    const int unit = ub4 * 4 + (w & 3), kh = w >> 2;
    const int g = unit >> 5, ctile = unit & 31;
    const h16* W1 = (const h16*)(WS(p) + O_W1 + (size_t)(l * 32 + g) * SZ_W13);
    const int gch = ctile * 16 + (lane & 15);
    const h16* ub = P + (size_t)gch * 64 * IWP + OFF_U + g * 16 + ((lane >> 4) & 1) * 8 + (size_t)(lane >> 5) * IWP;
    f32x4 acc[8];
#pragma unroll
    for (int mt = 0; mt < 8; ++mt) acc[mt] = f32x4{0.f, 0.f, 0.f, 0.f};
#pragma unroll 4
    for (int kk = 0; kk < 16; ++kk) {
      const int ks = kh * 16 + kk;
      h16x8 B = *(const h16x8*)(ub + (size_t)(ks * 2) * IWP);
#pragma unroll
      for (int mt = 0; mt < 8; ++mt) {
        h16x8 A = *(const h16x8*)(W1 + ((size_t)(ks * 4 + (lane >> 4)) * 128 + mt * 16 + (lane & 15)) * 8);
        acc[mt] = __builtin_amdgcn_mfma_f32_16x16x32_f16(A, B, acc[mt], 0, 0, 0);
      }
    }
    __syncthreads();
    if (kh == 1) {
#pragma unroll
      for (int mt = 0; mt < 8; ++mt) red[((w & 3) * 8 + mt) * 64 + lane] = acc[mt];
    }
    __syncthreads();
    if (kh == 0) {
#pragma unroll
      for (int mt = 0; mt < 8; ++mt)
        *(f32x4*)(E + ((size_t)gch * 32 + g) * 128 + mt * 16 + (lane >> 4) * 4) = acc[mt] + red[((w & 3) * 8 + mt) * 64 + lane];
    }
  }
}

constexpr int BU_PITCH = 1040, BS_PITCH = 144;
constexpr int SSMY_LDS = 65 * 512 + 16 * BU_PITCH * 2 + 16 * BS_PITCH * 2 + 128 * 64 * 8;
__device__ __forceinline__ void ssm_outputs(const Params& p, int l, char* lds, unsigned* ctr, int* slot) {
  const int tid = opaque_tid(), lane = tid & 63, w = tid >> 6;
  h16* Kt = (h16*)lds;
  h16* Bu = (h16*)(lds + 65 * 512);
  h16* Bs = (h16*)(lds + 65 * 512 + 16 * BU_PITCH * 2);
  float2* Es = (float2*)(lds + 65 * 512 + 16 * BU_PITCH * 2 + 16 * BS_PITCH * 2);
  const h16* P = (const h16*)(WS(p) + O_P);
  const float* E = (const float*)(WS(p) + O_E);
  h16* Z = (h16*)(WS(p) + O_Z);
  for (int unit = fetch_unit(ctr, slot); unit < 1024; unit = fetch_unit(ctr, slot)) {
    const int g = unit & 31, bc = unit >> 5, b = bc >> 3, ct = bc & 7;
    const int lg = l * 32 + g;
    __syncthreads();
    const int c0 = ct * 16;
    {
      const h16x8* ks = (const h16x8*)(WS(p) + O_KTAB + (size_t)lg * SZ_KTAB);
      for (int i = tid; i < 65 * 32; i += NT) ((h16x8*)Kt)[i] = ks[i];
      for (int i = tid; i < 2048; i += NT) {
        int tk = i >> 1, hf = i & 1;
        h16x8 v = *(const h16x8*)(P + ((size_t)b * SEQ + ct * 1024 + tk) * IWP + OFF_U + g * 16 + hf * 8);
        *(h16x8*)(Bu + (tk >> 6) * BU_PITCH + (tk & 63) * 16 + hf * 8) = v;
      }
      const float2* Eb = (const float2*)E + ((size_t)(b * 128) * 32 + g) * 64;
      for (int i = tid; i < (c0 + 16) * 64; i += NT) Es[i] = Eb[(size_t)(i >> 6) * 2048 + (i & 63)];
    }
    __syncthreads();
    if (w == 0) {
      float2 at = ((const float2*)(WS(p) + O_AT))[lg * 64 + lane];
      float sr = 0.f, si = 0.f;
#pragma unroll 8
      for (int c = 0; c < c0; ++c) {
        float2 e = Es[c * 64 + lane];
        float nr = at.x * sr - at.y * si + e.x, ni = at.x * si + at.y * sr + e.y;
        sr = nr; si = ni;
      }
#pragma unroll
      for (int i = 0; i < 16; ++i) {
        Bs[i * BS_PITCH + 2 * lane] = (h16)sr;
        Bs[i * BS_PITCH + 2 * lane + 1] = (h16)si;
        float2 e = Es[(c0 + i) * 64 + lane];
        float nr = at.x * sr - at.y * si + e.x, ni = at.x * si + at.y * sr + e.y;
        sr = nr; si = ni;
      }
    }
    __syncthreads();
    const float dt = expf(p.in[8][lg]);
    const int col = lane & 15, hi = lane >> 5, qh = (lane >> 4) & 1, p0 = (lane >> 4) * 4;
    const h16* W3 = (const h16*)(WS(p) + O_W3 + (size_t)lg * SZ_W13);
    float dsk[4];
    for (int j = 0; j < 4; ++j) dsk[j] = p.in[13][l * 512 + g * 16 + p0 + j];
    for (int r = 0; r < 64 / NW; ++r) {
      const int base = (r >> 1) * 2 * NW;
      const int tau = (r & 1) ? base + 2 * NW - 1 - w : base + w;
      f32x4 acc = {0.f, 0.f, 0.f, 0.f};
      const int nks = tau / 2 + 1;
      h16x8 A3[4];
#pragma unroll
      for (int ks = 0; ks < 4; ++ks)
        A3[ks] = *(const h16x8*)(W3 + ((size_t)((tau * 16 + ks * 4 + (lane >> 4)) * 16) + (lane & 15)) * 8);
      for (int i = 0; i < nks; ++i) {
        int j = tau - (2 * i + hi);
        h16x8 A = *(const h16x8*)(Kt + (j + 1) * 256 + (lane & 15) * 16 + qh * 8);
        h16x8 B = *(const h16x8*)(Bu + col * BU_PITCH + (2 * i + hi) * 16 + qh * 8);
        acc = __builtin_amdgcn_mfma_f32_16x16x32_f16(A, B, acc, 0, 0, 0);
      }
#pragma unroll
      for (int ks = 0; ks < 4; ++ks) {
        h16x8 B = *(const h16x8*)(Bs + col * BS_PITCH + ks * 32 + (lane >> 4) * 8);
        acc = __builtin_amdgcn_mfma_f32_16x16x32_f16(A3[ks], B, acc, 0, 0, 0);
      }
      const h16* up = Bu + col * BU_PITCH + tau * 16 + p0;
      size_t tok = ((size_t)b * 128 + ct * 16 + col) * 64 + tau;
      h16 zz[4];
      for (int j = 0; j < 4; ++j) zz[j] = (h16)gelu_tanh(dt * acc[j] + dsk[j] * (float)up[j]);
      typedef __attribute__((ext_vector_type(4))) _Float16 h16x4;
      h16x4 zv = {zz[0], zz[1], zz[2], zz[3]};
      *(h16x4*)(Z + tok * 512 + g * 16 + p0) = zv;
    }
  }
}

#define LAS __attribute__((address_space(3)))
typedef _Float16 h16x4 __attribute__((ext_vector_type(4)));
#define XB_TMO      128
#define XB_XCNT(j)  (256  + 64 * (j))
#define XB_XSUB(j)  (1280 + 64 * (j))
#define XB_XGEN(j)  (2304 + 64 * (j))
#define XB_TOP      3328
#define XB_TOPGEN   3392
#define XCD_BAR_WORDS 3456
#define XB_SPIN_CAP (1u << 18)

__device__ __forceinline__ unsigned xb_ld(unsigned* p)              { return __hip_atomic_load(p, __ATOMIC_RELAXED, __HIP_MEMORY_SCOPE_AGENT); }
__device__ __forceinline__ unsigned xb_add(unsigned* p, unsigned v) { return __hip_atomic_fetch_add(p, v, __ATOMIC_RELAXED, __HIP_MEMORY_SCOPE_AGENT); }
__device__ __forceinline__ unsigned xb_xcc_id() { return (unsigned)__builtin_amdgcn_s_getreg((3 << 11) | 20) & 0xFu; }
#define XB_SPIN(cond, bar) do { unsigned _sp = 0; while (cond) { __builtin_amdgcn_s_sleep(1); \
    if ((++_sp & 255u) == 0u) { if (xb_ld(&(bar)[XB_TMO])) break; if (_sp > XB_SPIN_CAP) { atomicAdd(&(bar)[XB_TMO], 1u); break; } } } } while (0)

struct XcdBarrier {
    unsigned* bar; unsigned x;
    volatile LAS unsigned* st;
};

__device__ __forceinline__ XcdBarrier xcd_barrier_post(unsigned* bar, volatile LAS unsigned* st) {
    XcdBarrier b; b.bar = bar; b.x = xb_xcc_id(); b.st = st;
    if (threadIdx.x == 0) (void)xb_add(&bar[XB_XCNT(b.x)], 1u);
    return b;
}
__device__ __forceinline__ void xcd_barrier_complete(unsigned* bar, unsigned x, unsigned& nloc, unsigned& nx) {
    const unsigned G = gridDim.x * gridDim.y * gridDim.z;
    unsigned sum, cnt, mine, sp = 0u;
    for (;;) {
        sum = 0u; cnt = 0u; mine = 0u;
#pragma unroll
        for (unsigned j = 0; j < 16; ++j) { const unsigned c = xb_ld(&bar[XB_XCNT(j)]); sum += c; cnt += (c > 0u) ? 1u : 0u; mine = (j == x) ? c : mine; }
        if (sum == G) break;
        __builtin_amdgcn_s_sleep(1);
        if ((++sp & 255u) == 0u) { if (xb_ld(&bar[XB_TMO])) break; if (sp > XB_SPIN_CAP) { atomicAdd(&bar[XB_TMO], 1u); break; } }
    }
    nloc = mine > 0u ? mine : 1u; nx = cnt > 0u ? cnt : 1u;
}

__device__ __forceinline__ void xcd_barrier(const XcdBarrier& b) {
    asm volatile("s_waitcnt vmcnt(0)" ::: "memory");
    __syncthreads();
    if (threadIdx.x == 0) {
        unsigned* bar = b.bar;
        __builtin_amdgcn_s_waitcnt(0);
        unsigned nloc = b.st[0], nx = b.st[1];
        if (nloc == 0u) { xcd_barrier_complete(bar, b.x, nloc, nx); b.st[0] = nloc; b.st[1] = nx; }
        const unsigned old = xb_add(&bar[XB_XSUB(b.x)], 1u);
        const unsigned gen = old / nloc;
        if (old + 1u == (gen + 1u) * nloc) {
            __builtin_amdgcn_fence(__ATOMIC_RELEASE, "agent");
            asm volatile("s_waitcnt vmcnt(0)" ::: "memory");
            const unsigned og = xb_add(&bar[XB_TOP], 1u);
            const unsigned tg = og / nx;
            if (og + 1u == (tg + 1u) * nx) xb_add(&bar[XB_TOPGEN], 1u);
            else XB_SPIN(xb_ld(&bar[XB_TOPGEN]) == tg, bar);
            __builtin_amdgcn_fence(__ATOMIC_ACQUIRE, "agent");
            xb_add(&bar[XB_XGEN(b.x)], 1u);
            asm volatile("s_waitcnt vmcnt(0)" ::: "memory");
        } else {
            XB_SPIN(xb_ld(&bar[XB_XGEN(b.x)]) == gen, bar);
            __builtin_amdgcn_fence(__ATOMIC_ACQUIRE, "agent");
            asm volatile("s_waitcnt vmcnt(0)" ::: "memory");
        }
    }
    __syncthreads();
}


namespace g8 {
constexpr int BM = 256, BK = 64, HALF = 128, HTB = HALF * BK * 2, STAGE_BYTES = 8 * HTB, NXCD = 8, WGM = 8;
__device__ __forceinline__ int lds_byte(int r, int c) {
  const int st = (r >> 4) * 2 + (c >> 5), rr = r & 15, cc = c & 31, ob = rr * 64 + cc * 2;
  return st * 1024 + (ob ^ (((ob >> 9) & 1) << 5));
}
__device__ __forceinline__ void stage_rc(int b, int& R, int& C) {
  const int st = b / 1024, sb = b % 1024, swz = sb ^ (((sb >> 9) & 1) << 5);
  R = (st >> 1) * 16 + swz / 64;
  C = (st & 1) * 32 + (swz % 64) / 2;
}
struct Unit { int pm, pn; };
struct Order {
  int nM, nN, nwg, G, c;
  __device__ void init(int M, int N, int G_, int c_) { nM = M / BM; nN = N / BM; nwg = nM * nN; G = G_; c = c_; }
  __device__ bool next(int i, Unit& u) const {
    const long L = (long)i * G + c;
    if (L >= nwg) return false;
    int wgid = (int)L;
    { const int q = nwg / NXCD, r = nwg % NXCD, xcd = wgid % NXCD, off = wgid / NXCD; wgid = (xcd < r ? xcd * (q + 1) : r * (q + 1) + (xcd - r) * q) + off; }
    const int nig = WGM * nN, gid = wgid / nig, fm = gid * WGM, gsz = (nM - fm) < WGM ? (nM - fm) : WGM;
    u.pm = fm + ((wgid % nig) % gsz);
    u.pn = (wgid % nig) / gsz;
    return true;
  }
};
template <class Epi, int AUXA = 0>
__device__ __forceinline__ void gemm_phase(LAS unsigned char* lds, const h16* A, const h16* Bt, int K, const Order& S, const Epi& E) {
  const int tid = opaque_tid(), wid = __builtin_amdgcn_readfirstlane(tid >> 6), lane = tid & 63, wr = wid >> 2, wc = wid & 3, fr = lane & 15, fq = lane >> 4;
  const int nt = K / BK;
  unsigned voffA[2];
#pragma unroll
  for (int i = 0; i < 2; ++i) { int R, C; stage_rc(tid * 16 + i * 8192, R, C); voffA[i] = (unsigned)(R * K + C) * 2u; }
  const size_t kstep = (size_t)(BK * 2);
  const size_t hstep = (size_t)HALF * K * 2;
  const size_t tstep = 2 * hstep;
  const unsigned ldsw = (unsigned)wid * 1024u;
  const int aoff = lds_byte(wr * 64 + fr, fq * 8), boff = lds_byte(wc * 32 + fr, fq * 8);
#define G8_SA(b, h) (((b) * 2 + (h)) * HTB)
#define G8_SB(b, h) ((4 + (b) * 2 + (h)) * HTB)
#define G8_STAGEX(bufoff, gbase, aux) do { _Pragma("unroll") for (int _i = 0; _i < 2; ++_i) \
    __builtin_amdgcn_global_load_lds((const unsigned*)((const char*)(gbase) + voffA[_i]), (LAS unsigned*)(lds + (bufoff) + ldsw + _i * 8192), 16, 0, aux); } while (0)
#define G8_STAGE(bufoff, gbase) G8_STAGEX(bufoff, gbase, 0)
#define G8_STAGEA(bufoff, gbase) G8_STAGEX(bufoff, gbase, AUXA)
#define G8_LDA(dst, b, h) do { _Pragma("unroll") for (int m = 0; m < 4; ++m) _Pragma("unroll") for (int k = 0; k < 2; ++k) dst[m][k] = *(const LAS h16x8*)(lds + G8_SA(b, h) + aoff + m * 2048 + k * 1024); } while (0)
#define G8_LDB(dst, b, h) do { _Pragma("unroll") for (int n = 0; n < 2; ++n) _Pragma("unroll") for (int k = 0; k < 2; ++k) dst[n][k] = *(const LAS h16x8*)(lds + G8_SB(b, h) + boff + n * 2048 + k * 1024); } while (0)
#define G8_MMA(ai, bj, At, Bt_) do { __builtin_amdgcn_s_setprio(1); _Pragma("unroll") for (int m = 0; m < 4; ++m) _Pragma("unroll") for (int n = 0; n < 2; ++n) _Pragma("unroll") for (int k = 0; k < 2; ++k) \
    acc[ai][bj][m][n] = __builtin_amdgcn_mfma_f32_16x16x32_f16(Bt_[n][k], At[m][k], acc[ai][bj][m][n], 0, 0, 0); __builtin_amdgcn_s_setprio(0); } while (0)
#define G8_WAIT_V(n) asm volatile("s_waitcnt vmcnt(" #n ")" ::: "memory")
#define G8_WAIT_L(n) asm volatile("s_waitcnt lgkmcnt(" #n ")" ::: "memory")
#define G8_BAR __builtin_amdgcn_s_barrier()
#define G8_SCHED __builtin_amdgcn_sched_barrier(0)
  Unit cur, nxt;
  int ui = 0;
  if (!S.next(0, cur)) return;
  f32x4 acc[2][2][4][2];
#pragma unroll
  for (int a = 0; a < 2; ++a)
#pragma unroll
    for (int b = 0; b < 2; ++b)
#pragma unroll
      for (int m = 0; m < 4; ++m)
#pragma unroll
        for (int n = 0; n < 2; ++n) acc[a][b][m][n] = (f32x4){0.f, 0.f, 0.f, 0.f};
  h16x8 At[4][2], B0[2][2], B1[2][2];
  const char* cA = (const char*)A + (size_t)cur.pm * tstep;
  const char* cB = (const char*)Bt + (size_t)cur.pn * tstep;
  G8_STAGE(G8_SB(0, 0), cB); G8_STAGEA(G8_SA(0, 0), cA); G8_STAGE(G8_SB(0, 1), cB + hstep); G8_STAGEA(G8_SA(0, 1), cA + hstep);
  if (wr == 1) G8_BAR;
  G8_WAIT_V(4); G8_BAR;
  G8_STAGE(G8_SB(1, 0), cB + kstep); G8_STAGEA(G8_SA(1, 0), cA + kstep); G8_STAGE(G8_SB(1, 1), cB + hstep + kstep);
  G8_WAIT_V(6); G8_BAR;
  for (;;) {
    const bool has_next = S.next(ui + 1, nxt);
    const char* nA = has_next ? (const char*)A + (size_t)nxt.pm * tstep : cA;
    const char* nB = has_next ? (const char*)Bt + (size_t)nxt.pn * tstep : cB;
    for (int t = 0; t < nt; t += 2) {
      const bool last = (t == nt - 2);
      const char* a1 = cA + (size_t)(t + 1) * kstep;
      const char* a2 = last ? nA : cA + (size_t)(t + 2) * kstep;
      const char* b2 = last ? nB : cB + (size_t)(t + 2) * kstep;
      const char* a3 = a2 + kstep;
      const char* b3 = b2 + kstep;
      if (Epi::MID_T >= 0 && t == Epi::MID_T) E.mid(acc, ui, wr, fr);
      G8_LDB(B0, 0, 0); G8_SCHED; G8_LDA(At, 0, 0); G8_STAGEA(G8_SA(1, 1), a1 + hstep);
      G8_WAIT_L(8); G8_BAR; G8_WAIT_L(0); G8_MMA(0, 0, At, B0); G8_BAR; G8_SCHED;
      G8_LDB(B1, 0, 1); G8_STAGE(G8_SB(0, 0), b2);
      G8_BAR; G8_WAIT_L(0); G8_MMA(0, 1, At, B1); G8_BAR;
      G8_LDA(At, 0, 1); G8_STAGEA(G8_SA(0, 0), a2);
      G8_BAR; G8_WAIT_L(0); G8_MMA(1, 0, At, B0); G8_BAR; G8_SCHED;
      G8_STAGE(G8_SB(0, 1), b2 + hstep);
      G8_WAIT_V(6); G8_BAR; G8_MMA(1, 1, At, B1); G8_BAR;
      G8_LDB(B0, 1, 0); G8_SCHED; G8_LDA(At, 1, 0); G8_STAGEA(G8_SA(0, 1), a2 + hstep);
      G8_WAIT_L(8); G8_BAR; G8_WAIT_L(0); G8_MMA(0, 0, At, B0); G8_BAR; G8_SCHED;
      G8_LDB(B1, 1, 1); G8_STAGE(G8_SB(1, 0), b3);
      G8_BAR; G8_WAIT_L(0); G8_MMA(0, 1, At, B1); G8_BAR;
      G8_LDA(At, 1, 1); G8_STAGEA(G8_SA(1, 0), a3);
      G8_BAR; G8_WAIT_L(0); G8_MMA(1, 0, At, B0); G8_BAR; G8_SCHED;
      G8_STAGE(G8_SB(1, 1), b3 + hstep);
      G8_WAIT_V(6); G8_BAR; G8_MMA(1, 1, At, B1); G8_BAR;
    }
    E(acc, cur, ui, wr, wc, fr, fq);
    if (!has_next) break;
#pragma unroll
    for (int a = 0; a < 2; ++a)
#pragma unroll
      for (int b = 0; b < 2; ++b)
#pragma unroll
        for (int m = 0; m < 4; ++m)
#pragma unroll
          for (int n = 0; n < 2; ++n) acc[a][b][m][n] = (f32x4){0.f, 0.f, 0.f, 0.f};
    cur = nxt; cA = nA; cB = nB; ++ui;
  }
  G8_WAIT_V(0);
  if (wr == 0) G8_BAR;
  G8_BAR;
#undef G8_SA
#undef G8_SB
#undef G8_STAGE
#undef G8_STAGEA
#undef G8_STAGEX
#undef G8_LDA
#undef G8_LDB
#undef G8_MMA
#undef G8_WAIT_V
#undef G8_WAIT_L
#undef G8_BAR
#undef G8_SCHED
}
}

constexpr int RSL_OFF = g8::STAGE_BYTES;
constexpr int LDS_GEMM = g8::STAGE_BYTES + 8 * 256 * 4;

__device__ __forceinline__ void fill_rowscales(float* rsl, const float* ssq, float inv_n, const g8::Order& S) {
  const int tid = opaque_tid();
  g8::Unit u;
  __syncthreads();
  for (int i = 0; S.next(i, u); ++i) {
    if (tid < 256) {
      const float4* s4 = (const float4*)(ssq + (size_t)(u.pm * 256 + tid) * 16);
      float s = 0.f;
      for (int k = 0; k < 4; ++k) { float4 v = s4[k]; s += v.x + v.y + v.z + v.w; }
      rsl[i * 256 + tid] = rsqrtf(s * inv_n + EPS);
    }
  }
  __syncthreads();
}

__device__ __forceinline__ h16x4 pack4(float a, float b, float c, float d) { h16x4 v = {(h16)a, (h16)b, (h16)c, (h16)d}; return v; }
__device__ __forceinline__ h16x8 pack8(f32x4 a, f32x4 b) {
  h16x8 v = {(h16)a[0], (h16)a[1], (h16)a[2], (h16)a[3], (h16)b[0], (h16)b[1], (h16)b[2], (h16)b[3]};
  return v;
}

struct EpiIn {
  static constexpr int MID_T = -1;
  __device__ __forceinline__ void mid(f32x4 (&)[2][2][4][2], int, int, int) const {}
  h16* P; const float* rsl; const float* qkg;
  __device__ __forceinline__ void operator()(const f32x4 (&acc)[2][2][4][2], const g8::Unit& u, int ui, int wr, int wc, int fr, int fq) const {
    const int hs = u.pn * 4 + wc;
    int gi = -1;
    if (hs < 4) gi = 0; else if (hs < 6) gi = 1; else if (hs >= 16 && hs < 20) gi = 2; else if (hs == 22) gi = 4; else if (hs == 24) gi = 5;
    const bool gate = (hs == 26);
#pragma unroll
    for (int ai = 0; ai < 2; ++ai)
#pragma unroll
      for (int m = 0; m < 4; ++m) {
        const int rl = 128 * ai + 64 * wr + 16 * m + fr;
        float r = rsl[ui * 256 + rl];
        if (gi >= 0) {
          float ss = 0.f;
#pragma unroll
          for (int bj = 0; bj < 2; ++bj)
#pragma unroll
            for (int n = 0; n < 2; ++n)
#pragma unroll
              for (int j = 0; j < 4; ++j) ss += acc[ai][bj][m][n][j] * acc[ai][bj][m][n][j];
          ss += xor16(ss);
          ss += __shfl_xor(ss, 32);
          r *= rsqrtf(ss * r * r * (1.f / 64.f) + EPS);
        }
        h16* rowp = P + (size_t)(u.pm * 256 + rl) * IWP + 64 * hs + 8 * fq;
#pragma unroll
        for (int bj = 0; bj < 2; ++bj) {
          f32x4 v[2];
#pragma unroll
          for (int n = 0; n < 2; ++n) {
            v[n] = acc[ai][bj][m][n] * r;
            if (gi >= 0) {
              const float4 g4 = *(const float4*)(qkg + gi * 64 + 32 * bj + 8 * fq + 4 * n);
              v[n][0] *= g4.x; v[n][1] *= g4.y; v[n][2] *= g4.z; v[n][3] *= g4.w;
            } else if (gate) {
#pragma unroll
              for (int j = 0; j < 4; ++j) v[n][j] = (32 * bj + 8 * fq + 4 * n + j) < 12 ? sigmoidf(v[n][j]) : 0.f;
            }
          }
          *(h16x8*)(rowp + 32 * bj) = pack8(v[0], v[1]);
        }
      }
  }
};

struct EpiGlu {
  static constexpr int MID_T = -1;
  __device__ __forceinline__ void mid(f32x4 (&)[2][2][4][2], int, int, int) const {}
  h16* OB; float* ssqb; const float* gb;
  __device__ __forceinline__ void operator()(const f32x4 (&acc)[2][2][4][2], const g8::Unit& u, int ui, int wr, int wc, int fr, int fq) const {
    const int ocb = 128 * u.pn + 16 * wc + 4 * fq;
    float4 ba[2], bb[2];
#pragma unroll
    for (int bj = 0; bj < 2; ++bj) { ba[bj] = *(const float4*)(gb + ocb + 64 * bj); bb[bj] = *(const float4*)(gb + 512 + ocb + 64 * bj); }
#pragma unroll
    for (int ai = 0; ai < 2; ++ai)
#pragma unroll
      for (int m = 0; m < 4; ++m) {
        const size_t row = (size_t)u.pm * 256 + 128 * ai + 64 * wr + 16 * m + fr;
        float ss = 0.f;
#pragma unroll
        for (int bj = 0; bj < 2; ++bj) {
          const f32x4 a = acc[ai][bj][m][0], b = acc[ai][bj][m][1];
          float o0 = (a[0] + ba[bj].x) * sigmoidf(b[0] + bb[bj].x);
          float o1 = (a[1] + ba[bj].y) * sigmoidf(b[1] + bb[bj].y);
          float o2 = (a[2] + ba[bj].z) * sigmoidf(b[2] + bb[bj].z);
          float o3 = (a[3] + ba[bj].w) * sigmoidf(b[3] + bb[bj].w);
          *(h16x4*)(OB + row * 1024 + ocb + 64 * bj) = pack4(o0, o1, o2, o3);
          ss += o0 * o0 + o1 * o1 + o2 * o2 + o3 * o3;
        }
        ss += xor16(ss);
        ss += __shfl_xor(ss, 32);
        if (fq == 0) ssqb[row * 16 + u.pn * 4 + wc] = ss;
      }
  }
};

struct EpiRes {
  static constexpr int MID_T = -1;
  __device__ __forceinline__ void mid(f32x4 (&)[2][2][4][2], int, int, int) const {}
  float* xo; h16* xb; float* ssq; bool final_out;
  __device__ __forceinline__ void operator()(const f32x4 (&acc)[2][2][4][2], const g8::Unit& u, int ui, int wr, int wc, int fr, int fq) const {
#pragma unroll
    for (int ai = 0; ai < 2; ++ai)
#pragma unroll
      for (int m = 0; m < 4; ++m) {
        const size_t row = (size_t)u.pm * 256 + 128 * ai + 64 * wr + 16 * m + fr;
        const size_t base = row * DM + 256 * u.pn + 32 * wc + 8 * fq;
        float ss = 0.f;
#pragma unroll
        for (int bj = 0; bj < 2; ++bj) {
          const size_t idx = base + 128 * bj;
          const h16x8 xv = *(const h16x8*)(xb + idx);
          f32x4 x0 = acc[ai][bj][m][0], x1 = acc[ai][bj][m][1];
#pragma unroll
          for (int j = 0; j < 4; ++j) { x0[j] += (float)xv[j]; x1[j] += (float)xv[4 + j]; ss += x0[j] * x0[j] + x1[j] * x1[j]; }
          if (final_out) {
            *(float4*)(xo + idx) = make_float4(x0[0], x0[1], x0[2], x0[3]);
            *(float4*)(xo + idx + 4) = make_float4(x1[0], x1[1], x1[2], x1[3]);
          } else {
            *(h16x8*)(xb + idx) = pack8(x0, x1);
          }
        }
        ss += xor16(ss);
        ss += __shfl_xor(ss, 32);
        if (fq == 0) ssq[row * 16 + u.pn * 4 + wc] = ss;
      }
  }
};

struct EpiOut : EpiRes {
  static constexpr int MID_T = 8;
  const float* rsl;
  __device__ __forceinline__ void mid(f32x4 (&acc)[2][2][4][2], int ui, int wr, int fr) const {
#pragma unroll
    for (int ai = 0; ai < 2; ++ai)
#pragma unroll
      for (int m = 0; m < 4; ++m) {
        const float r = rsl[ui * 256 + 128 * ai + 64 * wr + 16 * m + fr];
#pragma unroll
        for (int bj = 0; bj < 2; ++bj)
#pragma unroll
          for (int n = 0; n < 2; ++n) acc[ai][bj][m][n] *= r;
      }
  }
};

struct EpiUp {
  static constexpr int MID_T = -1;
  __device__ __forceinline__ void mid(f32x4 (&)[2][2][4][2], int, int, int) const {}
  h16* hid; const float* rsl;
  __device__ __forceinline__ void operator()(const f32x4 (&acc)[2][2][4][2], const g8::Unit& u, int ui, int wr, int wc, int fr, int fq) const {
#pragma unroll
    for (int ai = 0; ai < 2; ++ai)
#pragma unroll
      for (int m = 0; m < 4; ++m) {
        const int rl = 128 * ai + 64 * wr + 16 * m + fr;
        const float r = rsl[ui * 256 + rl];
        h16* rowp = hid + (size_t)(u.pm * 256 + rl) * DFF + 256 * u.pn + 32 * wc + 8 * fq;
#pragma unroll
        for (int bj = 0; bj < 2; ++bj) {
          f32x4 v[2];
#pragma unroll
          for (int n = 0; n < 2; ++n) {
            v[n] = acc[ai][bj][m][n] * r;
#pragma unroll
            for (int j = 0; j < 4; ++j) { const float t = fmaxf(v[n][j], 0.f); v[n][j] = t * t; }
          }
          __builtin_nontemporal_store(pack8(v[0], v[1]), (h16x8*)(rowp + 128 * bj));
        }
      }
  }
};

__device__ __forceinline__ void phase_gemm1(const Params& p, int l, char* lds) {
  g8::Order S; S.init(NTOK, IWP, gridDim.x, blockIdx.x);
  float* rsl = (float*)(lds + RSL_OFF);
  fill_rowscales(rsl, (const float*)(WS(p) + O_SSQ), 1.f / DM, S);
  EpiIn E{(h16*)(WS(p) + O_P), rsl, p.in[3] + l * 6 * 64};
  g8::gemm_phase((LAS unsigned char*)lds, (const h16*)(WS(p) + O_XB), (const h16*)(WS(p) + O_WIN + l * SZ_WIN), DM, S, E);
}
__device__ __forceinline__ void phase_glu(const Params& p, int l, char* lds) {
  g8::Order S; S.init(NTOK, 1024, gridDim.x, blockIdx.x);
  __syncthreads();
  EpiGlu E{(h16*)(WS(p) + O_OB), (float*)(WS(p) + O_SSQB), p.in[15] + l * 1024};
  g8::gemm_phase((LAS unsigned char*)lds, (const h16*)(WS(p) + O_Z), (const h16*)(WS(p) + O_WGLU + l * SZ_WGLU), 512, S, E);
}
__device__ __forceinline__ void phase_wout(const Params& p, int l, char* lds) {
  g8::Order S; S.init(NTOK, DM, gridDim.x, blockIdx.x);
  float* rsl = (float*)(lds + RSL_OFF);
  fill_rowscales(rsl, (const float*)(WS(p) + O_SSQB), 1.f / 512.f, S);
  EpiOut E;
  E.xo = p.out; E.xb = (h16*)(WS(p) + O_XB); E.ssq = (float*)(WS(p) + O_SSQ); E.final_out = false; E.rsl = rsl;
  g8::gemm_phase((LAS unsigned char*)lds, (const h16*)(WS(p) + O_OB), (const h16*)(WS(p) + O_WOUT + l * SZ_WOUT), DM, S, E);
}
__device__ __forceinline__ void phase_up(const Params& p, int l, char* lds) {
  g8::Order S; S.init(NTOK, DFF, gridDim.x, blockIdx.x);
  float* rsl = (float*)(lds + RSL_OFF);
  fill_rowscales(rsl, (const float*)(WS(p) + O_SSQ), 1.f / DM, S);
  EpiUp E{(h16*)(WS(p) + O_HID), rsl};
  g8::gemm_phase((LAS unsigned char*)lds, (const h16*)(WS(p) + O_XB), (const h16*)(WS(p) + O_WUP + l * SZ_WUP), DM, S, E);
}
__device__ __forceinline__ void phase_down(const Params& p, int l, char* lds) {
  g8::Order S; S.init(NTOK, DM, gridDim.x, blockIdx.x);
  __syncthreads();
  EpiRes E{p.out, (h16*)(WS(p) + O_XB), (float*)(WS(p) + O_SSQ), l == DEPTH - 1};
  g8::gemm_phase<EpiRes, 2>((LAS unsigned char*)lds, (const h16*)(WS(p) + O_HID), (const h16*)(WS(p) + O_WDN + l * SZ_WDN), DFF, S, E);
}

constexpr int KP = 80;
enum { M_SWA = 0, M_WIN = 1, M_SEL = 2, M_CMPA = 3, M_CMPB = 4 };
constexpr float LOG2E = 1.4426950408889634f, SCL2 = 0.125f * LOG2E;
struct ColState { float m, l; };
typedef short s16x4v __attribute__((__vector_size__(8)));

__device__ __forceinline__ h16x8 ld_row8(const h16* base, int ld, int row, int nrows, int c8) {
  h16x8 z = {0, 0, 0, 0, 0, 0, 0, 0};
  return (row >= 0 && row < nrows) ? *(const h16x8*)(base + (size_t)row * ld + c8 * 8) : z;
}
__device__ __forceinline__ void st_k(h16* Ks, int row, int c8, h16x8 v) { *(h16x8*)(Ks + row * KP + c8 * 8) = v; }
__device__ __forceinline__ void st_vt(h16* Vt, int row, int c8, h16x8 v) {
#pragma unroll
  for (int e = 0; e < 8; ++e) Vt[(c8 * 8 + e) * KP + row] = v[e];
}
__device__ __forceinline__ float max4q(float v) {
  v = fmaxf(v, xor16(v));
  auto r = __builtin_amdgcn_permlane32_swap(__float_as_int(v), __float_as_int(v), false, false);
  return fmaxf(__int_as_float(r[0]), __int_as_float(r[1]));
}
__device__ __forceinline__ float sum4q(float v) {
  v += xor16(v);
  auto r = __builtin_amdgcn_permlane32_swap(__float_as_int(v), __float_as_int(v), false, false);
  return __int_as_float(r[0]) + __int_as_float(r[1]);
}
__device__ __forceinline__ float quadsum(float v) { v += dppf<0xB1>(v); v += dppf<0x4E>(v); return v; }

template <int MODE, int RGM>
__device__ __forceinline__ void attn_tile(const h16x8 (&Q)[2][2], f32x4 (&O)[2][4], ColState (&st)[2], const h16* Ks,
                                          const h16* Vt, const float* biasT, const int (&tq)[2], int hd, int kbase, bool far,
                                          const bool (&selbit)[2], float (&hq)[2][4], float (&h3)[2][4], const int lane) {
  const int col = lane & 15, q4 = lane >> 4;
  constexpr int DK = (MODE == M_CMPA || MODE == M_CMPB) ? 16 : 1;
  f32x4 S[2][4];
#pragma unroll
  for (int kt = 0; kt < 4; ++kt) {
#pragma unroll
    for (int rg = 0; rg < 2; ++rg) S[rg][kt] = f32x4{0.f, 0.f, 0.f, 0.f};
#pragma unroll
    for (int ks = 0; ks < 2; ++ks) {
      h16x8 Kf = *(const h16x8*)(Ks + (kt * 16 + col) * KP + ks * 32 + q4 * 8);
#pragma unroll
      for (int rg = 0; rg < 2; ++rg)
        if (RGM & (1 << rg)) S[rg][kt] = __builtin_amdgcn_mfma_f32_16x16x32_f16(Kf, Q[rg][ks], S[rg][kt], 0, 0, 0);
    }
  }
  h16x8 Pf[2][2];
#pragma unroll
  for (int rg = 0; rg < 2; ++rg) {
    if (!(RGM & (1 << rg))) continue;
    const float* bt = biasT + hd * 800;
    if (far) {
      const float b31 = bt[799];
      const bool ok = (MODE == M_SEL) ? selbit[rg] : true;
#pragma unroll
      for (int kt = 0; kt < 4; ++kt)
#pragma unroll
        for (int j = 0; j < 4; ++j) S[rg][kt][j] = ok ? S[rg][kt][j] * SCL2 + b31 : -1e30f;
    } else {
      const int kx0 = kbase + q4 * 4;
      const int d0 = (DK == 16) ? tq[rg] - 31 - 16 * kx0 : tq[rg] - kx0;
#pragma unroll
      for (int kt = 0; kt < 4; ++kt)
#pragma unroll
        for (int j = 0; j < 4; ++j) {
          const int dist = d0 - DK * (kt * 16 + j);
          const int kx = kx0 + kt * 16 + j;
          bool valid = dist >= 0;
          if (MODE == M_SWA) valid = valid && dist < 128 && kx >= 0;
          if (MODE == M_WIN) valid = valid && dist < 512 && kx >= 0;
          if (MODE == M_SEL) valid = valid && selbit[rg];
          if (DK == 16) valid = valid && kx < NCMP;
          const int dc = dist < 0 ? 0 : (dist > 799 ? 799 : dist);
          S[rg][kt][j] = valid ? S[rg][kt][j] * SCL2 + bt[dc] : -1e30f;
        }
    }
    if (MODE == M_CMPB) {
#pragma unroll
      for (int kt = 0; kt < 4; ++kt) {
        float h = 0.f;
#pragma unroll
        for (int j = 0; j < 4; ++j) {
          float pv = __builtin_amdgcn_exp2f(S[rg][kt][j] - st[rg].m) * st[rg].l;
          S[rg][kt][j] = pv;
          h += pv;
        }
        hq[rg][kt] = h;
        h3[rg][kt] = S[rg][kt][3];
      }
    } else {
      float mx = -1e30f;
#pragma unroll
      for (int kt = 0; kt < 4; ++kt)
#pragma unroll
        for (int j = 0; j < 4; ++j) mx = fmaxf(mx, S[rg][kt][j]);
      mx = max4q(mx);
      const float mn = fmaxf(st[rg].m, mx);
      const float corr = __builtin_amdgcn_exp2f(st[rg].m - mn);
      st[rg].m = mn;
      const float mm = fmaxf(mn, -1e20f);
      float ls = 0.f;
#pragma unroll
      for (int kt = 0; kt < 4; ++kt)
#pragma unroll
        for (int j = 0; j < 4; ++j) {
          float pv = __builtin_amdgcn_exp2f(S[rg][kt][j] - mm);
          S[rg][kt][j] = pv;
          ls += pv;
        }
      st[rg].l = st[rg].l * corr + ls;
      if (MODE != M_CMPA) {
#pragma unroll
        for (int nt = 0; nt < 4; ++nt) O[rg][nt] *= corr;
      }
    }
    if (MODE != M_CMPA) {
#pragma unroll
      for (int ks = 0; ks < 2; ++ks)
#pragma unroll
        for (int i = 0; i < 4; ++i) {
          Pf[rg][ks][i] = (h16)S[rg][2 * ks][i];
          Pf[rg][ks][4 + i] = (h16)S[rg][2 * ks + 1][i];
        }
    }
  }
  if (MODE == M_CMPA) return;
#pragma unroll
  for (int ks = 0; ks < 2; ++ks)
#pragma unroll
    for (int nt = 0; nt < 4; ++nt) {
      const h16* vp = Vt + (ks * 32 + q4 * 4 + (col >> 2)) * KP + nt * 16 + 4 * (col & 3);
      const s16x4v r0 = __builtin_amdgcn_ds_read_tr16_b64_v4i16((LAS s16x4v*)vp);
      const s16x4v r1 = __builtin_amdgcn_ds_read_tr16_b64_v4i16((LAS s16x4v*)(vp + 16 * KP));
      const h16x4 v0 = __builtin_bit_cast(h16x4, r0), v1 = __builtin_bit_cast(h16x4, r1);
      const h16x8 Vf = {v0[0], v0[1], v0[2], v0[3], v1[0], v1[1], v1[2], v1[3]};
#pragma unroll
      for (int rg = 0; rg < 2; ++rg)
        if (RGM & (1 << rg)) O[rg][nt] = __builtin_amdgcn_mfma_f32_16x16x32_f16(Vf, Pf[rg][ks], O[rg][nt], 0, 0, 0);
    }
}

constexpr int LDS_CMP = 8 * 16 * 128 * 4 + 16 * 136 * 2 + 4 * 16 * 4;
__device__ __forceinline__ void phase_compress(const Params& p, int l, char* lds) {
  const int tid = opaque_tid(), lane = tid & 63, w = tid >> 6, col = lane & 15, q4 = lane >> 4;
  float* red = (float*)lds;
  h16* hid = (h16*)(lds + 8 * 16 * 128 * 4);
  float* nrm2 = (float*)(lds + 8 * 16 * 128 * 4 + 16 * 136 * 2);
  const h16* P = (const h16*)(WS(p) + O_P);
  for (int u = blockIdx.x; u < BATCH * 2 * 32; u += gridDim.x) {
    const int mt = u & 31, st = (u >> 5) & 1, b = u >> 6;
    const h16* W1t = (const h16*)(WS(p) + O_W1T) + (size_t)(l * 2 + st) * 128 * 2048;
    const h16* W2t = (const h16*)(WS(p) + O_W2T) + (size_t)(l * 2 + st) * 64 * 128;
    const float* b1 = (const float*)(WS(p) + O_BIAS1) + (l * 2 + st) * 128;
    __syncthreads();
    {
      f32x4 acc[8];
#pragma unroll
      for (int nt = 0; nt < 8; ++nt) acc[nt] = f32x4{0.f, 0.f, 0.f, 0.f};
      const int m = 16 * mt + col;
#pragma unroll 2
      for (int kk = 0; kk < 8; ++kk) {
        const int ks = 8 * w + kk, tt = ks >> 1, d0 = (ks & 1) * 32 + q4 * 8;
        int tok = 16 * m + tt;
        if (tok > SEQ - 1) tok = SEQ - 1;
        const h16x8 A = *(const h16x8*)(P + ((size_t)b * SEQ + tok) * IWP + OFF_KVC + st * 64 + d0);
#pragma unroll
        for (int nt = 0; nt < 8; ++nt) {
          const h16x8 B = *(const h16x8*)(W1t + (size_t)(nt * 16 + col) * 2048 + ks * 32 + q4 * 8);
          acc[nt] = __builtin_amdgcn_mfma_f32_16x16x32_f16(A, B, acc[nt], 0, 0, 0);
        }
      }
#pragma unroll
      for (int nt = 0; nt < 8; ++nt)
#pragma unroll
        for (int j = 0; j < 4; ++j) red[(w * 16 + q4 * 4 + j) * 128 + nt * 16 + col] = acc[nt][j];
    }
    __syncthreads();
    {
      const int row = tid >> 5, c4 = (tid & 31) * 4;
      float4 sum = *(const float4*)(b1 + c4);
#pragma unroll
      for (int ww = 0; ww < 8; ++ww) {
        const float4 v = *(const float4*)(red + (ww * 16 + row) * 128 + c4);
        sum.x += v.x; sum.y += v.y; sum.z += v.z; sum.w += v.w;
      }
      *(h16x4*)(hid + row * 136 + c4) = pack4(gelu_tanh(sum.x), gelu_tanh(sum.y), gelu_tanh(sum.z), gelu_tanh(sum.w));
    }
    __syncthreads();
    f32x4 o2 = {0.f, 0.f, 0.f, 0.f};
    if (w < 4) {
#pragma unroll
      for (int ks = 0; ks < 4; ++ks) {
        const h16x8 A = *(const h16x8*)(hid + col * 136 + ks * 32 + q4 * 8);
        const h16x8 B = *(const h16x8*)(W2t + (size_t)(w * 16 + col) * 128 + ks * 32 + q4 * 8);
        o2 = __builtin_amdgcn_mfma_f32_16x16x32_f16(A, B, o2, 0, 0, 0);
      }
      if (st == 0) {
#pragma unroll
        for (int j = 0; j < 4; ++j) {
          float ss = sum16(o2[j] * o2[j]);
          if (col == 0) nrm2[w * 16 + q4 * 4 + j] = ss;
        }
      }
    }
    __syncthreads();
    if (w < 4) {
      const float g = p.in[3][(l * 6 + 3) * 64 + w * 16 + col];
      h16* dst = (h16*)(WS(p) + (st == 0 ? O_KCMP : O_VCMP));
#pragma unroll
      for (int j = 0; j < 4; ++j) {
        const int row = q4 * 4 + j, m = 16 * mt + row;
        float v = o2[j];
        if (st == 0) {
          float tot = nrm2[row] + nrm2[16 + row] + nrm2[32 + row] + nrm2[48 + row];
          v = v * rsqrtf(tot * (1.f / 64.f) + EPS) * g;
        }
        if (m >= NCMP) v = 0.f;
        dst[((size_t)b * 512 + m) * 64 + w * 16 + col] = (h16)v;
      }
    }
  }
}


template <int MODE, int TM>
__device__ __forceinline__ void attn_tile2(const h16x8 (&Q)[2], f32x4 (&O)[4], ColState& st, const h16* Ks0, const h16* Vt0,
                                           const h16* Ks1, const h16* Vt1, const float* biasT, int tq, int hd, int kbase0,
                                           const bool (&far)[2], const bool (&selbit)[2], float (&hq)[2][4], float (&h3)[2][4],
                                           const int lane) {
  const int col = lane & 15, q4 = lane >> 4;
  constexpr int DK = (MODE == M_CMPA || MODE == M_CMPB) ? 16 : 1;
  f32x4 S[2][4];
  __builtin_amdgcn_s_setprio(1);
#pragma unroll
  for (int t = 0; t < 2; ++t) {
    if (!(TM & (1 << t))) continue;
    const h16* Ks = t ? Ks1 : Ks0;
#pragma unroll
    for (int kt = 0; kt < 4; ++kt) {
      S[t][kt] = f32x4{0.f, 0.f, 0.f, 0.f};
#pragma unroll
      for (int ks = 0; ks < 2; ++ks) {
        h16x8 Kf = *(const h16x8*)(Ks + (kt * 16 + col) * KP + ks * 32 + q4 * 8);
        S[t][kt] = __builtin_amdgcn_mfma_f32_16x16x32_f16(Kf, Q[ks], S[t][kt], 0, 0, 0);
      }
    }
  }
  __builtin_amdgcn_s_setprio(0);
  const float* bt = biasT + hd * 800;
  float addc[2] = {0.f, 0.f}, sclc[2] = {1.f, 1.f};
#pragma unroll
  for (int t = 0; t < 2; ++t) {
    if (!(TM & (1 << t))) continue;
    const int kbase = kbase0 + 64 * t;
    if (far[t]) {
      const bool ok = (MODE == M_SEL) ? selbit[t] : true;
      addc[t] = ok ? bt[799] : -1e30f;
      sclc[t] = SCL2;
    } else {
      addc[t] = 0.f;
      sclc[t] = 1.f;
      const int kx0 = kbase + q4 * 4;
      const int d0 = (DK == 16) ? tq - 31 - 16 * kx0 : tq - kx0;
#pragma unroll
      for (int kt = 0; kt < 4; ++kt)
#pragma unroll
        for (int j = 0; j < 4; ++j) {
          const int dist = d0 - DK * (kt * 16 + j);
          const int kx = kx0 + kt * 16 + j;
          bool valid = dist >= 0;
          if (MODE == M_WIN) valid = valid && dist < 512 && kx >= 0;
          if (MODE == M_SEL) valid = valid && selbit[t];
          if (DK == 16) valid = valid && kx < NCMP;
          const int dc = dist < 0 ? 0 : (dist > 799 ? 799 : dist);
          S[t][kt][j] = valid ? S[t][kt][j] * SCL2 + bt[dc] : -1e30f;
        }
    }
  }
  if (MODE == M_CMPB) {
#pragma unroll
    for (int t = 0; t < 2; ++t) {
      if (!(TM & (1 << t))) continue;
#pragma unroll
      for (int kt = 0; kt < 4; ++kt) {
        float h = 0.f;
#pragma unroll
        for (int j = 0; j < 4; ++j) {
          float pv = __builtin_amdgcn_exp2f(S[t][kt][j] * sclc[t] + (addc[t] - st.m)) * st.l;
          S[t][kt][j] = pv;
          h += pv;
        }
        hq[t][kt] = h;
        h3[t][kt] = S[t][kt][3];
      }
    }
  } else {
    float mx = -1e30f;
#pragma unroll
    for (int t = 0; t < 2; ++t) {
      if (!(TM & (1 << t))) continue;
      float mt = -1e30f;
#pragma unroll
      for (int kt = 0; kt < 4; ++kt)
#pragma unroll
        for (int j = 0; j < 4; ++j) mt = fmaxf(mt, S[t][kt][j]);
      mx = fmaxf(mx, mt * sclc[t] + addc[t]);
    }
    mx = max4q(mx);
    const float mn = fmaxf(st.m, mx);
    const float corr = __builtin_amdgcn_exp2f(st.m - mn);
    st.m = mn;
    const float mm = fmaxf(mn, -1e20f);
    float ls = 0.f;
#pragma unroll
    for (int t = 0; t < 2; ++t) {
      if (!(TM & (1 << t))) continue;
      const float am = addc[t] - mm;
#pragma unroll
      for (int kt = 0; kt < 4; ++kt) {
        const f32x4 e = S[t][kt] * sclc[t] + am;
#pragma unroll
        for (int j = 0; j < 4; ++j) {
          float pv = __builtin_amdgcn_exp2f(e[j]);
          S[t][kt][j] = pv;
          ls += pv;
        }
      }
    }
    st.l = st.l * corr + ls;
    if (MODE != M_CMPA) {
#pragma unroll
      for (int nt = 0; nt < 4; ++nt) O[nt] *= corr;
    }
  }
  if (MODE == M_CMPA) return;
  __builtin_amdgcn_s_setprio(1);
#pragma unroll
  for (int t = 0; t < 2; ++t) {
    if (!(TM & (1 << t))) continue;
    const h16* Vt = t ? Vt1 : Vt0;
#pragma unroll
    for (int ks = 0; ks < 2; ++ks) {
      h16x8 Pf;
#pragma unroll
      for (int i = 0; i < 4; ++i) { Pf[i] = (h16)S[t][2 * ks][i]; Pf[4 + i] = (h16)S[t][2 * ks + 1][i]; }
#pragma unroll
      for (int nt = 0; nt < 4; ++nt) {
        const h16* vp = Vt + (ks * 32 + q4 * 4 + (col >> 2)) * KP + nt * 16 + 4 * (col & 3);
        const s16x4v r0 = __builtin_amdgcn_ds_read_tr16_b64_v4i16((LAS s16x4v*)vp);
        const s16x4v r1 = __builtin_amdgcn_ds_read_tr16_b64_v4i16((LAS s16x4v*)(vp + 16 * KP));
        const h16x4 v0 = __builtin_bit_cast(h16x4, r0), v1 = __builtin_bit_cast(h16x4, r1);
        const h16x8 Vf = {v0[0], v0[1], v0[2], v0[3], v1[0], v1[1], v1[2], v1[3]};
        O[nt] = __builtin_amdgcn_mfma_f32_16x16x32_f16(Vf, Pf, O[nt], 0, 0, 0);
      }
    }
  }
  __builtin_amdgcn_s_setprio(0);
}

template <int D, class LoadF, class StoreF, class CompF>
__device__ __forceinline__ void pair_pipeline(int n, LoadF load, StoreF store, CompF comp) {
  h16x8 r[D][4];
#pragma unroll
  for (int d = 0; d < D; ++d)
    if (d < n) load(d, r[d]);
  store(0, r[0]);
  if (D < n) load(D, r[0]);
  __syncthreads();
  for (int i0 = 0; i0 < n; i0 += D) {
#pragma unroll
    for (int d = 0; d < D; ++d) {
      const int i = i0 + d;
      if (i < n) {
        if (i + 1 < n) store(i + 1, r[(d + 1) % D]);
        if (i + 1 + D < n) load(i + 1 + D, r[(d + 1) % D]);
        comp(i);
        __syncthreads();
      }
    }
  }
}

template <int D, class LoadF, class StoreF, class CompF>
__device__ __forceinline__ void tile_pipeline(int n, LoadF load, StoreF store, CompF comp) {
  h16x8 rk[D], rv[D];
#pragma unroll
  for (int d = 0; d < D; ++d)
    if (d < n) load(d, rk[d], rv[d]);
  store(0, rk[0], rv[0]);
  if (D < n) load(D, rk[0], rv[0]);
  __syncthreads();
  for (int i0 = 0; i0 < n; i0 += D) {
#pragma unroll
    for (int d = 0; d < D; ++d) {
      const int i = i0 + d;
      if (i < n) {
        if (i + 1 < n) store(i + 1, rk[(d + 1) % D], rv[(d + 1) % D]);
        if (i + 1 + D < n) load(i + 1 + D, rk[(d + 1) % D], rv[(d + 1) % D]);
        comp(i);
        __syncthreads();
      }
    }
  }
}

constexpr int LDS_BIAS = 800 * 16;
__device__ __forceinline__ void phase_swa(const Params& p, int l, char* lds, unsigned* ctr, int* slot) {
  const int tid = opaque_tid(), lane = tid & 63, w = tid >> 6, col = lane & 15, q4 = lane >> 4;
  float* biasT = (float*)lds;
  h16* KV = (h16*)(lds + LDS_BIAS);
  float* nrm = (float*)(lds + LDS_BIAS + 4 * 64 * KP * 2);
  const h16* P = (const h16*)(WS(p) + O_P);
  const int* lut = (const int*)(WS(p) + O_LUT);
  h16* OAC = (h16*)(WS(p) + O_OAC);
  __syncthreads();
  for (int i = tid; i < 3200; i += NT) biasT[i] = p.in[5][lut[i % 800] * 8 + (i / 800)] * LOG2E;
  __syncthreads();
  const int head = w >> 1, kvh = w >> 2;
  const float sink = p.in[4][l * 4 + head] * LOG2E;
  const int srow = tid >> 3, c8 = tid & 7;
  float hpd[2][4], hpe[2][4];
  const bool nosel[2] = {false, false};
  for (int u = fetch_unit(ctr, slot); u < BATCH * 128; u = fetch_unit(ctr, slot)) {
    const int b = u >> 7, t0 = (u & 127) * 64;
    const h16* Pbat = P + (size_t)b * SEQ * IWP;
    h16x8 Q[2][2];
    int tq[2];
#pragma unroll
    for (int rg = 0; rg < 2; ++rg) {
      const int qb = (w & 1) * 32 + rg * 16;
      const h16* qp = Pbat + (size_t)(t0 + qb + col) * IWP + head * 64 + q4 * 8;
      Q[rg][0] = *(const h16x8*)qp;
      Q[rg][1] = *(const h16x8*)(qp + 32);
      tq[rg] = t0 + qb + col;
    }
    f32x4 O[2][4];
    ColState st[2];
#pragma unroll
    for (int rg = 0; rg < 2; ++rg) {
#pragma unroll
      for (int nt = 0; nt < 4; ++nt) O[rg][nt] = f32x4{0.f, 0.f, 0.f, 0.f};
      st[rg].m = -1e30f; st[rg].l = 0.f;
    }
    const int i0 = t0 >= 128 ? 0 : (t0 >= 64 ? 1 : 2);
    h16x8 rk[2], rv[2];
    {
      int sb = t0 - 128 + i0 * 64;
      for (int h2 = 0; h2 < 2; ++h2) {
        rk[h2] = ld_row8(Pbat + 256 + h2 * 64, IWP, sb + srow, SEQ, c8);
        rv[h2] = ld_row8(Pbat + 384 + h2 * 64, IWP, sb + srow, SEQ, c8);
      }
    }
    for (int i = i0; i < 3; ++i) {
      __syncthreads();
      for (int h2 = 0; h2 < 2; ++h2) {
        st_k(KV + h2 * 64 * KP, srow, c8, rk[h2]);
        st_k(KV + (2 + h2) * 64 * KP, srow, c8, rv[h2]);
      }
      __syncthreads();
      if (i + 1 < 3) {
        int sb = t0 - 128 + (i + 1) * 64;
        for (int h2 = 0; h2 < 2; ++h2) {
          rk[h2] = ld_row8(Pbat + 256 + h2 * 64, IWP, sb + srow, SEQ, c8);
          rv[h2] = ld_row8(Pbat + 384 + h2 * 64, IWP, sb + srow, SEQ, c8);
        }
      }
      const int kb = t0 - 128 + i * 64;
      attn_tile<M_SWA, 3>(Q, O, st, KV + kvh * 64 * KP, KV + (2 + kvh) * 64 * KP, biasT, tq, head, kb, false, nosel, hpd, hpe, lane);
    }
    __syncthreads();
#pragma unroll
    for (int rg = 0; rg < 2; ++rg) {
      const int qb = (w & 1) * 32 + rg * 16;
      const float lsum = sum4q(st[rg].l);
      const float mn = fmaxf(st[rg].m, sink);
      const float corr = __builtin_amdgcn_exp2f(st[rg].m - mn);
      const float inv = corr / (lsum * corr + __builtin_amdgcn_exp2f(sink - mn));
      float ss = 0.f;
#pragma unroll
      for (int nt = 0; nt < 4; ++nt) {
        O[rg][nt] *= inv;
#pragma unroll
        for (int j = 0; j < 4; ++j) ss += O[rg][nt][j] * O[rg][nt][j];
      }
      ss = sum4q(ss);
      if (q4 == 0) nrm[head * 64 + qb + col] = ss;
    }
    __syncthreads();
#pragma unroll
    for (int rg = 0; rg < 2; ++rg) {
      const int qi = (w & 1) * 32 + rg * 16 + col;
      const float tot = nrm[qi] + nrm[64 + qi] + nrm[128 + qi] + nrm[192 + qi];
      const float sc = rsqrtf(tot * (1.f / 256.f) + EPS);
#pragma unroll
      for (int nt = 0; nt < 4; ++nt)
        *(h16x4*)(OAC + ((size_t)b * SEQ + t0 + qi) * 1024 + head * 64 + nt * 16 + q4 * 4) =
            pack4(O[rg][nt][0] * sc, O[rg][nt][1] * sc, O[rg][nt][2] * sc, O[rg][nt][3] * sc);
    }
  }
}

constexpr int LDS_NSA = LDS_BIAS + 8 * 64 * KP * 2 + NW * 4 * 128 * 4 + 32 * 16;
constexpr int PFD = 2;
__device__ __forceinline__ void phase_nsa(const Params& p, int l, char* lds, unsigned* ctr, int* slot, const int parts = 15) {
  const int tid = opaque_tid(), lane = tid & 63, w = tid >> 6, col = lane & 15, q4 = lane >> 4;
  float* biasT = (float*)lds;
  h16* KV0 = (h16*)(lds + LDS_BIAS);
  float* impw = (float*)(lds + LDS_BIAS + 8 * 64 * KP * 2) + w * 4 * 128;
  unsigned long long* selm = (unsigned long long*)(lds + LDS_BIAS + 8 * 64 * KP * 2 + NW * 4 * 128 * 4);
#define KSB(i, t) (KV0 + (((i) & 1) * 4 + (t) * 2) * 64 * KP)
#define VTB(i, t) (KV0 + (((i) & 1) * 4 + (t) * 2 + 1) * 64 * KP)
  const h16* P = (const h16*)(WS(p) + O_P);
  const int* lut = (const int*)(WS(p) + O_LUT);
  h16* OAC = (h16*)(WS(p) + O_OAC);
  __syncthreads();
  for (int i = tid; i < 3200; i += NT) biasT[i] = p.in[5][lut[i % 800] * 8 + 4 + (i / 800)] * LOG2E;
  __syncthreads();
  const int srow = tid >> 3, c8 = tid & 7;
  const int hd = col & 3, qw = col >> 2;
  float hpd[2][4], hpe[2][4];
  const bool nosel[2] = {false, false};
  for (int u = fetch_unit(ctr, slot); u < 1024; u = fetch_unit(ctr, slot)) {
    const int rnd = u >> 8, b = (u & 255) >> 6, ti = u & 63;
    const int tile = rnd == 0 ? 255 - ti : (rnd == 1 ? 128 + ti : (rnd == 2 ? 127 - ti : ti));
    const int t0 = tile * 32, cur = t0 >> 6;
    const h16* Pbat = P + (size_t)b * SEQ * IWP;
    const h16* KC = (const h16*)(WS(p) + O_KCMP) + (size_t)b * 512 * 64;
    const h16* VC = (const h16*)(WS(p) + O_VCMP) + (size_t)b * 512 * 64;
    h16x8 Q[2];
    int tq;
    {
      const h16* qp = Pbat + (size_t)(t0 + w * 4 + qw) * IWP + OFF_QC + hd * 64 + q4 * 8;
      Q[0] = *(const h16x8*)qp;
      Q[1] = *(const h16x8*)(qp + 32);
      tq = t0 + w * 4 + qw;
    }
    const h16* gp = Pbat + (size_t)tq * IWP + OFF_GC + hd * 3;
    for (int i = lane; i < 512; i += 64) impw[i] = 0.f;
    f32x4 O[4], Oc[4];
    ColState st;
    int mvmax = t0 / 16 + 1;
    if (mvmax > NCMP) mvmax = NCMP;
    const int ntc = (mvmax + 63) >> 6;
    st.m = -1e30f; st.l = 0.f;
    const int npc = (ntc + 1) >> 1;
    if (parts & 1) pair_pipeline<PFD>(npc,
      [&](int i, h16x8 (&r)[4]) { r[0] = ld_row8(KC, 64, (2 * i) * 64 + srow, 512, c8); r[2] = ld_row8(KC, 64, (2 * i + 1) * 64 + srow, 512, c8); },
      [&](int i, const h16x8 (&r)[4]) { st_k(KSB(i, 0), srow, c8, r[0]); st_k(KSB(i, 1), srow, c8, r[2]); },
      [&](int i) {
        const bool far[2] = {t0 - 31 - 16 * (2 * i * 64 + 63) >= 799, t0 - 31 - 16 * ((2 * i + 1) * 64 + 63) >= 799};
        if (2 * i + 1 < ntc) attn_tile2<M_CMPA, 3>(Q, O, st, KSB(i, 0), VTB(i, 0), KSB(i, 1), VTB(i, 1), biasT, tq, hd, 2 * i * 64, far, nosel, hpd, hpe, lane);
        else attn_tile2<M_CMPA, 1>(Q, O, st, KSB(i, 0), VTB(i, 0), KSB(i, 1), VTB(i, 1), biasT, tq, hd, 2 * i * 64, far, nosel, hpd, hpe, lane);
      });
    {
      const float ls = sum4q(st.l);
      st.l = ls > 0.f ? 1.f / ls : 0.f;
    }
#pragma unroll
    for (int nt = 0; nt < 4; ++nt) O[nt] = f32x4{0.f, 0.f, 0.f, 0.f};
    float carry = 0.f;
    if (parts & 1) pair_pipeline<PFD>(npc,
      [&](int i, h16x8 (&r)[4]) {
        r[0] = ld_row8(KC, 64, (2 * i) * 64 + srow, 512, c8); r[1] = ld_row8(VC, 64, (2 * i) * 64 + srow, 512, c8);
        r[2] = ld_row8(KC, 64, (2 * i + 1) * 64 + srow, 512, c8); r[3] = ld_row8(VC, 64, (2 * i + 1) * 64 + srow, 512, c8); },
      [&](int i, const h16x8 (&r)[4]) {
        st_k(KSB(i, 0), srow, c8, r[0]); st_k(VTB(i, 0), srow, c8, r[1]); st_k(KSB(i, 1), srow, c8, r[2]); st_k(VTB(i, 1), srow, c8, r[3]); },
      [&](int i) {
        float hq[2][4], h3[2][4];
        const bool far[2] = {t0 - 31 - 16 * (2 * i * 64 + 63) >= 799, t0 - 31 - 16 * ((2 * i + 1) * 64 + 63) >= 799};
        const bool two = 2 * i + 1 < ntc;
        if (two) attn_tile2<M_CMPB, 3>(Q, O, st, KSB(i, 0), VTB(i, 0), KSB(i, 1), VTB(i, 1), biasT, tq, hd, 2 * i * 64, far, nosel, hq, h3, lane);
        else attn_tile2<M_CMPB, 1>(Q, O, st, KSB(i, 0), VTB(i, 0), KSB(i, 1), VTB(i, 1), biasT, tq, hd, 2 * i * 64, far, nosel, hq, h3, lane);
        float t3p = carry;
#pragma unroll
        for (int t = 0; t < 2; ++t) {
          if (t == 1 && !two) break;
#pragma unroll
          for (int kt = 0; kt < 4; ++kt) {
            const float qs = quadsum(hq[t][kt]);
            const float t3 = quadsum(h3[t][kt]);
            const float up = __shfl(t3, (lane + 48) & 63);
            const float wrp = __shfl(t3p, (lane + 48) & 63);
            const float pk = (q4 == 0) ? wrp : up;
            if (hd == 0) impw[qw * 128 + (2 * i + t) * 16 + kt * 4 + q4] = qs + pk;
            t3p = t3;
          }
        }
        carry = t3p;
      });
    {
      const float g0 = (float)gp[0];
#pragma unroll
      for (int nt = 0; nt < 4; ++nt) Oc[nt] = O[nt] * g0;
    }
    if (parts & 2) {
      const int nforced = cur >= 2 ? 3 : cur + 1;
      const int npick = 16 - nforced;
      for (int qi = 0; qi < 4; ++qi) {
        const float* im = impw + qi * 128;
        const int j0 = lane, j1 = lane + 64;
        const float v0 = im[j0], v1 = im[j1];
        int r0 = 0, r1 = 0;
#pragma unroll 8
        for (int jp = 1; jp <= cur - 2; ++jp) {
          float vp = im[jp];
          r0 += (vp > v0 || (vp == v0 && jp < j0)) ? 1 : 0;
          r1 += (vp > v1 || (vp == v1 && jp < j1)) ? 1 : 0;
        }
        bool c0 = j0 >= 1 && j0 <= cur - 2, c1 = j1 <= cur - 2;
        bool f0 = j0 == 0 || j0 == cur || j0 == cur - 1, f1 = j1 == cur || j1 == cur - 1;
        unsigned long long mlo = __ballot(f0 || (c0 && r0 < npick));
        unsigned long long mhi = __ballot(f1 || (c1 && r1 < npick));
        if (lane == 0) { selm[(w * 4 + qi) * 2] = mlo; selm[(w * 4 + qi) * 2 + 1] = mhi; }
      }
    }
    asm volatile("" ::: "memory");
    const unsigned long long slo = selm[(w * 4 + qw) * 2], shi = selm[(w * 4 + qw) * 2 + 1];
#pragma unroll
    for (int nt = 0; nt < 4; ++nt) O[nt] = f32x4{0.f, 0.f, 0.f, 0.f};
    st.m = -1e30f; st.l = 0.f;
    if (parts & 4) pair_pipeline<PFD>((cur + 2) >> 1,
      [&](int i, h16x8 (&r)[4]) {
        r[0] = ld_row8(Pbat + OFF_KVC + 128, IWP, (2 * i) * 64 + srow, SEQ, c8); r[1] = ld_row8(Pbat + OFF_KVC + 192, IWP, (2 * i) * 64 + srow, SEQ, c8);
        r[2] = ld_row8(Pbat + OFF_KVC + 128, IWP, (2 * i + 1) * 64 + srow, SEQ, c8); r[3] = ld_row8(Pbat + OFF_KVC + 192, IWP, (2 * i + 1) * 64 + srow, SEQ, c8); },
      [&](int i, const h16x8 (&r)[4]) {
        st_k(KSB(i, 0), srow, c8, r[0]); st_k(VTB(i, 0), srow, c8, r[1]); st_k(KSB(i, 1), srow, c8, r[2]); st_k(VTB(i, 1), srow, c8, r[3]); },
      [&](int i) {
        const int jb = 2 * i;
        bool sb[2];
        sb[0] = ((jb < 64 ? (slo >> jb) : (shi >> (jb - 64))) & 1ull) != 0;
        sb[1] = (jb + 1 <= cur) && (((jb + 1 < 64 ? (slo >> (jb + 1)) : (shi >> (jb + 1 - 64))) & 1ull) != 0);
        const bool far[2] = {t0 - (jb * 64 + 63) >= 799, t0 - (jb * 64 + 127) >= 799};
        const bool n0 = __any(sb[0]) != 0, n1 = __any(sb[1]) != 0;
        if (n0 && n1) attn_tile2<M_SEL, 3>(Q, O, st, KSB(i, 0), VTB(i, 0), KSB(i, 1), VTB(i, 1), biasT, tq, hd, jb * 64, far, sb, hpd, hpe, lane);
        else if (n0) attn_tile2<M_SEL, 1>(Q, O, st, KSB(i, 0), VTB(i, 0), KSB(i, 1), VTB(i, 1), biasT, tq, hd, jb * 64, far, sb, hpd, hpe, lane);
        else if (n1) attn_tile2<M_SEL, 2>(Q, O, st, KSB(i, 0), VTB(i, 0), KSB(i, 1), VTB(i, 1), biasT, tq, hd, jb * 64, far, sb, hpd, hpe, lane);
      });
    {
      const float ls = sum4q(st.l);
      const float f = ls > 0.f ? (float)gp[1] / ls : 0.f;
#pragma unroll
      for (int nt = 0; nt < 4; ++nt) Oc[nt] += O[nt] * f;
    }
#pragma unroll
    for (int nt = 0; nt < 4; ++nt) O[nt] = f32x4{0.f, 0.f, 0.f, 0.f};
    st.m = -1e30f; st.l = 0.f;
    const int w0 = cur >= 8 ? cur - 8 : 0;
    const int nwt = cur - w0 + 1;
    if (parts & 8) pair_pipeline<PFD>((nwt + 1) >> 1,
      [&](int i, h16x8 (&r)[4]) {
        r[0] = ld_row8(Pbat + OFF_KVC + 256, IWP, (w0 + 2 * i) * 64 + srow, SEQ, c8); r[1] = ld_row8(Pbat + OFF_KVC + 320, IWP, (w0 + 2 * i) * 64 + srow, SEQ, c8);
        r[2] = ld_row8(Pbat + OFF_KVC + 256, IWP, (w0 + 2 * i + 1) * 64 + srow, SEQ, c8); r[3] = ld_row8(Pbat + OFF_KVC + 320, IWP, (w0 + 2 * i + 1) * 64 + srow, SEQ, c8); },
      [&](int i, const h16x8 (&r)[4]) {
        st_k(KSB(i, 0), srow, c8, r[0]); st_k(VTB(i, 0), srow, c8, r[1]); st_k(KSB(i, 1), srow, c8, r[2]); st_k(VTB(i, 1), srow, c8, r[3]); },
      [&](int i) {
        const bool far[2] = {false, false};
        if (2 * i + 1 < nwt) attn_tile2<M_WIN, 3>(Q, O, st, KSB(i, 0), VTB(i, 0), KSB(i, 1), VTB(i, 1), biasT, tq, hd, (w0 + 2 * i) * 64, far, nosel, hpd, hpe, lane);
        else attn_tile2<M_WIN, 1>(Q, O, st, KSB(i, 0), VTB(i, 0), KSB(i, 1), VTB(i, 1), biasT, tq, hd, (w0 + 2 * i) * 64, far, nosel, hpd, hpe, lane);
      });
    {
      const float ls = sum4q(st.l);
      const float f = ls > 0.f ? (float)gp[2] / ls : 0.f;
      float ss = 0.f;
#pragma unroll
      for (int nt = 0; nt < 4; ++nt) {
        Oc[nt] += O[nt] * f;
#pragma unroll
        for (int j = 0; j < 4; ++j) ss += Oc[nt][j] * Oc[nt][j];
      }
      ss = quadsum(sum4q(ss));
      const float sc = rsqrtf(ss * (1.f / 256.f) + EPS);
#pragma unroll
      for (int nt = 0; nt < 4; ++nt)
        *(h16x4*)(OAC + ((size_t)b * SEQ + tq) * 1024 + 256 + hd * 64 + nt * 16 + q4 * 4) =
            pack4(Oc[nt][0] * sc, Oc[nt][1] * sc, Oc[nt][2] * sc, Oc[nt][3] * sc);
    }
  }
#undef KSB
#undef VTB
}

constexpr int LDS_SWA = LDS_BIAS + 4 * 64 * KP * 2 + 1024;
constexpr int lds_max(int a, int b) { return a > b ? a : b; }
constexpr int LDS_BYTES = lds_max(lds_max(LDS_NSA, SSMY_LDS), lds_max(LDS_SWA, lds_max(LDS_GEMM, lds_max(LDS_CMP, 64 * 65 * 4))));

__global__ void __launch_bounds__(NT) fwd_megakernel(Params p) {
  cg::grid_group grid = cg::this_grid();
  __shared__ __attribute__((aligned(16))) char lds[LDS_BYTES];
  __shared__ uint4 xb_words;
  __shared__ int wq_slot;
  if (threadIdx.x == 0) xb_words = make_uint4(0u, 0u, 0u, 0u);
  __syncthreads();
  (void)xcd_barrier_post((unsigned*)(WS(p) + O_BAR), (volatile LAS unsigned*)&xb_words);
#define GBAR() do { XcdBarrier _b; _b.bar = (unsigned*)(WS(p) + O_BAR); _b.x = xb_xcc_id(); _b.st = (volatile LAS unsigned*)&xb_words; xcd_barrier(_b); } while (0)
  phase0(p, (float*)lds);
  grid.sync();
  phase0b(p);
  for (int l = 0; l < DEPTH; ++l) {
    phase_gemm1(p, l, lds);
    GBAR();
    ssm_endstates(p, l, lds);
    phase_compress(p, l, lds);
    GBAR();
    {
      unsigned* q = (unsigned*)(WS(p) + O_BAR) + 3456 + l * 3 * 64;
      phase_nsa(p, l, lds, q, &wq_slot);
      ssm_outputs(p, l, lds, q + 64, &wq_slot);
      phase_swa(p, l, lds, q + 128, &wq_slot);
    }
    GBAR();
    phase_glu(p, l, lds);
    GBAR();
    phase_wout(p, l, lds);
    GBAR();
    phase_up(p, l, lds);
    GBAR();
    phase_down(p, l, lds);
    if (l + 1 < DEPTH) GBAR();
  }
}

extern "C" void kernel_launch(void* const* d_in, const int* in_sizes, int n_in, void* d_out, int out_size, void* d_ws,
                              size_t ws_size, hipStream_t stream) {
  static int grid_blocks = 0;
  if (!grid_blocks) {
    int dev = 0, cus = 0, per_cu = 0;
    (void)hipGetDevice(&dev);
    (void)hipDeviceGetAttribute(&cus, hipDeviceAttributeMultiprocessorCount, dev);
    (void)hipOccupancyMaxActiveBlocksPerMultiprocessor(&per_cu, fwd_megakernel, NT, 0);
    if (per_cu > 1) per_cu = 1;
    grid_blocks = cus * per_cu;
  }
  if (ws_size < WS_NEED) {
    fprintf(stderr, "workspace too small: %zu < %zu\n", ws_size, WS_NEED);
    return;
  }
  Params p{};
  for (int i = 0; i < 24; ++i) p.in[i] = (const float*)d_in[i];
  p.out = (float*)d_out;
  p.ws = (char*)d_ws;
  (void)hipMemsetAsync((char*)d_ws + O_BAR, 0, SZ_BAR, stream);
  void* args[] = {&p};
  hipError_t e = hipLaunchCooperativeKernel((void*)fwd_megakernel, dim3(grid_blocks), dim3(NT), args, 0, stream);
  if (e != hipSuccess) fprintf(stderr, "cooperative launch failed: %s (grid %d)\n", hipGetErrorString(e), grid_blocks);
}
```

```cpp
#include <hip/hip_runtime.h>
#include <hip/hip_cooperative_groups.h>
#include <cstdio>
namespace cg = cooperative_groups;

typedef _Float16 h16;
typedef __attribute__((ext_vector_type(8))) _Float16 h16x8;
typedef __attribute__((ext_vector_type(4))) float f32x4;

constexpr int NT = 512;
constexpr int NW = NT / 64;
constexpr int BATCH = 4, SEQ = 8192, NTOK = BATCH * SEQ, DM = 1024, DEPTH = 4, IW = 1676, IWP = 1792, DFF = 4096;
constexpr int OFF_U = 512, OFF_QC = 1024, OFF_KVC = 1280, OFF_GC = 1664;
constexpr int NCMP = 511;
constexpr float EPS = 1e-6f;

constexpr size_t SZ_WIN = (size_t)IWP * DM * 2, SZ_WGLU = (size_t)1024 * 512 * 2, SZ_WOUT = (size_t)DM * DM * 2,
                 SZ_WUP = (size_t)DFF * DM * 2, SZ_WDN = (size_t)DM * DFF * 2;
constexpr size_t O_WIN = 0;
constexpr size_t O_WGLU = O_WIN + DEPTH * SZ_WIN;
constexpr size_t O_WOUT = O_WGLU + DEPTH * SZ_WGLU;
constexpr size_t O_WUP = O_WOUT + DEPTH * SZ_WOUT;
constexpr size_t O_WDN = O_WUP + DEPTH * SZ_WUP;
constexpr size_t O_XB = O_WDN + DEPTH * SZ_WDN;
constexpr size_t O_SSQ = O_XB + (size_t)NTOK * DM * 2;
constexpr size_t O_SSQB = O_SSQ + (size_t)NTOK * 16 * 4;
constexpr size_t O_KCMP = O_SSQB + (size_t)NTOK * 16 * 4;
constexpr size_t O_VCMP = O_KCMP + (size_t)BATCH * 512 * 64 * 4;
constexpr size_t O_ABAR = O_VCMP + (size_t)BATCH * 512 * 64 * 4;
constexpr size_t O_BBAR = O_ABAR + (size_t)DEPTH * 32 * 64 * 8;
constexpr size_t O_BIAS1 = O_BBAR + (size_t)DEPTH * 32 * 64 * 16 * 8;
constexpr size_t O_LUT = O_BIAS1 + (size_t)DEPTH * 2 * 128 * 4;
constexpr size_t O_AT = O_LUT + 8192 * 4;
constexpr size_t O_KTAB = O_AT + (size_t)128 * 64 * 8;
constexpr size_t SZ_KTAB = (size_t)65 * 256 * 2;
constexpr size_t O_W1 = O_KTAB + 128 * SZ_KTAB;
constexpr size_t SZ_W13 = (size_t)128 * 1024 * 2;
constexpr size_t O_W3 = O_W1 + 128 * SZ_W13;
constexpr size_t O_W1T = O_W3 + 128 * SZ_W13;
constexpr size_t O_W2T = O_W1T + (size_t)8 * 128 * 2048 * 2;
constexpr size_t O_B1P = O_W2T + (size_t)8 * 64 * 128 * 2;
constexpr size_t O_BAR = (O_B1P + (size_t)8 * 32 * 128 * 4 + 255) / 256 * 256;
constexpr size_t SZ_BAR = 3456 * 4 + 16 * 64 * 4;
constexpr size_t O_BIG = (O_BAR + SZ_BAR + 255) / 256 * 256;
constexpr size_t O_P = O_BIG;
constexpr size_t O_Z = O_P + (size_t)NTOK * IWP * 2;
constexpr size_t O_OB = O_Z + (size_t)NTOK * 512 * 2;
constexpr size_t O_OAC = O_OB + (size_t)512 * 2;
constexpr size_t O_E = O_OB + (size_t)NTOK * 1024 * 2;
constexpr size_t O_APOW = O_E + (size_t)512 * 32 * 128 * 4;
static_assert(O_APOW + (size_t)128 * 65 * 64 * 16 <= O_BIG + (size_t)NTOK * DFF * 2, "Apow scratch must fit inside the big region");
constexpr size_t O_HID = O_BIG;
constexpr size_t WS_NEED = O_BIG + (size_t)NTOK * DFF * 2;

struct Params {
  const float* in[24];
  float* out;
  char* ws;
};

__device__ __forceinline__ char* WS(const Params& p) {
  int z;
  asm volatile("s_mov_b32 %0, 0" : "=s"(z));
  return p.ws + z;
}
__device__ __forceinline__ int fetch_unit(unsigned* ctr, int* slot) {
  __syncthreads();
  if (threadIdx.x == 0) *slot = (int)atomicAdd(ctr, 1u);
  __syncthreads();
  return *slot;
}
__device__ __forceinline__ int opaque_tid() {
  int t = threadIdx.x;
  asm volatile("" : "+v"(t));
  return t;
}
template <int CTRL>
__device__ __forceinline__ float dppf(float v) {
  return __int_as_float(__builtin_amdgcn_update_dpp(0, __float_as_int(v), CTRL, 0xF, 0xF, true));
}
__device__ __forceinline__ float sum16(float v) {
  v += dppf<0xB1>(v); v += dppf<0x4E>(v); v += dppf<0x141>(v); v += dppf<0x140>(v);
  return v;
}
__device__ __forceinline__ float max16(float v) {
  v = fmaxf(v, dppf<0xB1>(v)); v = fmaxf(v, dppf<0x4E>(v)); v = fmaxf(v, dppf<0x141>(v)); v = fmaxf(v, dppf<0x140>(v));
  return v;
}
__device__ __forceinline__ float xor16(float v) { return __int_as_float(__builtin_amdgcn_ds_swizzle(__float_as_int(v), 0x401F)); }
__device__ __forceinline__ float rdlane_c(float v, int l) { return __int_as_float(__builtin_amdgcn_readlane(__float_as_int(v), l)); }
__device__ __forceinline__ float wave_sum(float v) {
  v = sum16(v); v += xor16(v);
  return rdlane_c(v, 0) + rdlane_c(v, 32);
}
__device__ __forceinline__ float gelu_tanh(float x) {
  float u = 0.7978845608028654f * (x + 0.044715f * x * x * x);
  return 0.5f * x * (1.f + tanhf(u));
}
__device__ __forceinline__ float sigmoidf(float x) { return 1.f / (1.f + __expf(-x)); }
__device__ __forceinline__ float rdlane(float v, int l) {
  return __int_as_float(__builtin_amdgcn_readlane(__float_as_int(v), l));
}

__device__ __forceinline__ int perm32(int rho) { return 8 * ((rho & 15) >> 2) + 4 * (rho >> 4) + (rho & 3); }

template <class SrcF>
__device__ __forceinline__ void conv_tile(SrcF src, h16* dst, int ldo, int n0, int k0, float* tile) {
  int tid = opaque_tid();
  for (int idx = tid; idx < 4096; idx += NT) {
    int kk = idx >> 6, nn = idx & 63;
    tile[kk * 65 + nn] = src(k0 + kk, n0 + nn);
  }
  __syncthreads();
  for (int idx = tid; idx < 4096; idx += NT) {
    int nn = idx >> 6, kk = idx & 63;
    dst[(long)(n0 + nn) * ldo + k0 + kk] = (h16)tile[kk * 65 + nn];
  }
  __syncthreads();
}

template <class SrcF>
__device__ __forceinline__ void conv_tile_h(SrcF src, h16* dst, int ldo, int n0, int k0, float* tile, int t, bool act) {
  if (act)
    for (int idx = t; idx < 4096; idx += 256) {
      int kk = idx >> 6, nn = idx & 63;
      tile[kk * 65 + nn] = src(k0 + kk, n0 + nn);
    }
  __syncthreads();
  if (act)
    for (int idx = t; idx < 4096; idx += 256) {
      int nn = idx >> 6, kk = idx & 63;
      dst[(long)(n0 + nn) * ldo + k0 + kk] = (h16)tile[kk * 65 + nn];
    }
  __syncthreads();
}

__device__ __forceinline__ void phase0(const Params& p, float* lds) {
  const int tid = opaque_tid();
  constexpr int T_IN = (IWP / 64) * (DM / 64);
  constexpr int T_GLU = 16 * 8;
  constexpr int T_OUT = 16 * 16;
  constexpr int T_UP = 64 * 16;
  constexpr int T_DN = 16 * 64;
  constexpr int T_L = T_IN + T_GLU + T_OUT + T_UP + T_DN;
  const int hf = tid >> 8, t8 = tid & 255;
  float* ldh = lds + hf * (64 * 65 + 16);
  for (int tp = blockIdx.x; tp * 2 < DEPTH * T_L; tp += gridDim.x) {
    const int ti = tp * 2 + hf;
    const bool act = ti < DEPTH * T_L;
    int l = act ? ti / T_L : 0, r = act ? ti % T_L : 0;
    if (r < T_IN) {
      int nt = r / 16, kt = r % 16;
      const float* w = p.in[2] + (size_t)l * DM * IW;
      const float* g = p.in[1] + l * DM;
      conv_tile_h([&](int k, int sl) {
        int n = (sl & ~255) + 64 * ((sl >> 5) & 3) + 32 * ((sl >> 7) & 1) + perm32(sl & 31);
        return n < IW ? w[(long)k * IW + n] * g[k] : 0.f; },
                (h16*)(WS(p) + O_WIN + l * SZ_WIN), DM, nt * 64, kt * 64, ldh, t8, act);
    } else if ((r -= T_IN) < T_GLU) {
      int nt = r / 8, kt = r % 8;
      const float* w = p.in[14] + (size_t)l * 512 * 1024;
      conv_tile_h([&](int k, int n2) {
        int pn = n2 >> 8, bj = (n2 >> 7) & 1, wc = (n2 >> 5) & 3, nn = (n2 >> 4) & 1, r = n2 & 15;
        int n = (nn ? 512 : 0) + 128 * pn + 64 * bj + 16 * wc + r;
        return w[(long)k * 1024 + n]; },
                (h16*)(WS(p) + O_WGLU + l * SZ_WGLU), 512, nt * 64, kt * 64, ldh, t8, act);
    } else if ((r -= T_GLU) < T_OUT) {
      int nt = r / 16, kt = r % 16;
      const float* w = p.in[20] + (size_t)l * DM * DM;
      const float* g = p.in[19] + l * DM;
      conv_tile_h([&](int k2, int n2) {
        int k = k2 < 512 ? 256 + k2 : (k2 < 768 ? k2 - 512 : k2);
        int n = (n2 & ~31) + perm32(n2 & 31);
        return w[(long)k * DM + n] * g[k]; },
                (h16*)(WS(p) + O_WOUT + l * SZ_WOUT), DM, nt * 64, kt * 64, ldh, t8, act);
    } else if ((r -= T_OUT) < T_UP) {
      int nt = r / 16, kt = r % 16;
      const float* w = p.in[22] + (size_t)l * DM * DFF;
      const float* g = p.in[21] + l * DM;
      conv_tile_h([&](int k, int n2) { int n = (n2 & ~31) + perm32(n2 & 31); return w[(long)k * DFF + n] * g[k]; },
                (h16*)(WS(p) + O_WUP + l * SZ_WUP), DM, nt * 64, kt * 64, ldh, t8, act);
    } else {
      r -= T_UP;
      int nt = r / 64, kt = r % 64;
      const float* w = p.in[23] + (size_t)l * DFF * DM;
      conv_tile_h([&](int k, int n2) { int n = (n2 & ~31) + perm32(n2 & 31); return w[(long)k * DM + n]; },
                (h16*)(WS(p) + O_WDN + l * SZ_WDN), DFF, nt * 64, kt * 64, ldh, t8, act);
    }
  }
  for (int ti = blockIdx.x; ti < 8 * 66; ti += gridDim.x) {
    int ls = ti / 66, r = ti % 66;
    if (r < 64) {
      int nt = r >> 5, kt = r & 31;
      const float* w = p.in[17] + (size_t)ls * 2048 * 128;
      conv_tile([&](int k, int n) { return w[(long)k * 128 + n]; }, (h16*)(WS(p) + O_W1T) + (size_t)ls * 128 * 2048, 2048, nt * 64, kt * 64, lds);
    } else {
      int kt = r - 64;
      const float* w = p.in[18] + (size_t)ls * 128 * 64;
      conv_tile([&](int k, int n) { return w[(long)k * 64 + n]; }, (h16*)(WS(p) + O_W2T) + (size_t)ls * 64 * 128, 128, 0, kt * 64, lds);
    }
  }
  {
    const int lane = tid & 63;
    const int gw = blockIdx.x * NW + (tid >> 6), nw = gridDim.x * NW;
    const float* x = p.in[0];
    h16* xb = (h16*)(WS(p) + O_XB);
    float* ssq = (float*)(WS(p) + O_SSQ);
    for (int row = gw; row < NTOK; row += nw) {
      const float4* xr = (const float4*)(x + (long)row * DM + lane * 16);
      float s = 0.f;
      h16 hv[16];
      for (int i = 0; i < 4; ++i) {
        float4 v = xr[i];
        s += v.x * v.x + v.y * v.y + v.z * v.z + v.w * v.w;
        hv[i * 4 + 0] = (h16)v.x; hv[i * 4 + 1] = (h16)v.y; hv[i * 4 + 2] = (h16)v.z; hv[i * 4 + 3] = (h16)v.w;
      }
      h16x8* xo = (h16x8*)(xb + (long)row * DM + lane * 16);
      h16x8 o0, o1;
      for (int i = 0; i < 8; ++i) { o0[i] = hv[i]; o1[i] = hv[8 + i]; }
      xo[0] = o0; xo[1] = o1;
      s += dppf<0xB1>(s);
      s += dppf<0x4E>(s);
      if ((lane & 3) == 0) ssq[(long)row * 16 + (lane >> 2)] = s;
    }
  }
  const int gt = blockIdx.x * NT + tid, ngt = gridDim.x * NT;
  for (int i = gt; i < DEPTH * 32 * 64; i += ngt) {
    int l = i / 2048, g = (i / 64) % 32;
    double are = p.in[6][i], aim = p.in[7][i];
    double dt = exp((double)p.in[8][l * 32 + g]);
    double er = exp(are * dt), abr = er * cos(aim * dt), abi = er * sin(aim * dt);
    ((float2*)(WS(p) + O_ABAR))[i] = make_float2((float)abr, (float)abi);
    double nr = abr - 1.0, ni = abi, den = are * are + aim * aim;
    double fr = (nr * are + ni * aim) / den, fi = (ni * are - nr * aim) / den;
    float2* bb = (float2*)(WS(p) + O_BBAR) + (size_t)i * 16;
    for (int q = 0; q < 16; ++q) {
      double br = p.in[9][(size_t)i * 16 + q], bi = p.in[10][(size_t)i * 16 + q];
      bb[q] = make_float2((float)((fr * br - fi * bi) / dt), (float)((fr * bi + fi * br) / dt));
    }
  }
  for (int i = gt; i < 128 * 65 * 64; i += ngt) {
    int n = i & 63, j = (i >> 6) % 65, lg = i / (65 * 64);
    double are = p.in[6][lg * 64 + n], aim = p.in[7][lg * 64 + n];
    double dt = exp((double)p.in[8][lg]);
    double er = exp(are * dt * j), ang = aim * dt * j;
    ((double2*)(WS(p) + O_APOW))[i] = make_double2(er * cos(ang), er * sin(ang));
  }
  for (int i = gt; i < DEPTH * 2 * 128 * 32; i += ngt) {
    int j = i & 127, kc = (i >> 7) & 31, ls = i >> 12;
    const float* pos = p.in[16] + (size_t)ls * 2048 + kc * 64;
    const float* w1 = p.in[17] + ((size_t)ls * 2048 + kc * 64) * 128;
    float a = 0.f;
#pragma unroll 16
    for (int k = 0; k < 64; ++k) a += pos[k] * w1[(long)k * 128 + j];
    ((float*)(WS(p) + O_B1P))[i] = a;
  }
  for (int d = gt; d < 8192; d += ngt) {
    int bk;
    if (d < 16) bk = d;
    else {
      float nf = (float)d;
      int large = 16 + (int)(logf(nf / 16.0f) / 4.1588830833596715f * 16.0f);
      bk = large < 31 ? large : 31;
    }
    ((int*)(WS(p) + O_LUT))[d] = bk;
  }
}

__device__ __forceinline__ void phase0b(const Params& p) {
  const int gt = blockIdx.x * NT + threadIdx.x, ngt = gridDim.x * NT;
  const double2* apow = (const double2*)(WS(p) + O_APOW);
  const float2* bbs = (const float2*)(WS(p) + O_BBAR);
  for (int i = gt; i < 128 * 64 * 64; i += ngt) {
    int tau = i & 63, n = (i >> 6) & 63, lg = i >> 12;
    double2 ap = apow[(lg * 65 + (63 - tau)) * 64 + n];
    const float2* bb = bbs + (size_t)(lg * 64 + n) * 16;
    h16x8 re0, re1, im0, im1;
#pragma unroll
    for (int q = 0; q < 8; ++q) {
      float2 b0 = bb[q], b1 = bb[8 + q];
      re0[q] = (h16)(float)(ap.x * b0.x - ap.y * b0.y);
      im0[q] = (h16)(float)(ap.x * b0.y + ap.y * b0.x);
      re1[q] = (h16)(float)(ap.x * b1.x - ap.y * b1.y);
      im1[q] = (h16)(float)(ap.x * b1.y + ap.y * b1.x);
    }
    h16* W1 = (h16*)(WS(p) + O_W1 + (size_t)lg * SZ_W13);
    *(h16x8*)(W1 + ((size_t)(2 * tau) * 128 + 2 * n) * 8) = re0;
    *(h16x8*)(W1 + ((size_t)(2 * tau) * 128 + 2 * n + 1) * 8) = im0;
    *(h16x8*)(W1 + ((size_t)(2 * tau + 1) * 128 + 2 * n) * 8) = re1;
    *(h16x8*)(W1 + ((size_t)(2 * tau + 1) * 128 + 2 * n + 1) * 8) = im1;
  }
  for (int i = gt; i < 128 * 64 * 16 * 16; i += ngt) {
    int pp = i & 15, kc = (i >> 4) & 15, tau = (i >> 8) & 63, lg = i >> 14;
    h16x8 v;
#pragma unroll
    for (int e = 0; e < 4; ++e) {
      int n = 4 * kc + e;
      double2 ap = apow[(lg * 65 + tau + 1) * 64 + n];
      double cr = p.in[11][((size_t)lg * 16 + pp) * 64 + n], ci = p.in[12][((size_t)lg * 16 + pp) * 64 + n];
      v[2 * e] = (h16)(float)(cr * ap.x - ci * ap.y);
      v[2 * e + 1] = (h16)(float)(-(cr * ap.y + ci * ap.x));
    }
    h16* W3 = (h16*)(WS(p) + O_W3 + (size_t)lg * SZ_W13);
    *(h16x8*)(W3 + ((size_t)((tau * 16 + kc) * 16) + pp) * 8) = v;
  }
  for (int i = gt; i < 128 * 65 * 16; i += ngt) {
    int pp = i & 15, slot = (i >> 4) % 65, lg = i / (65 * 16);
    float acc[16];
#pragma unroll
    for (int q = 0; q < 16; ++q) acc[q] = 0.f;
    if (slot > 0) {
#pragma unroll 4
      for (int n = 0; n < 64; ++n) {
        double2 ap = apow[(lg * 65 + slot - 1) * 64 + n];
        double cr = p.in[11][((size_t)lg * 16 + pp) * 64 + n], ci = p.in[12][((size_t)lg * 16 + pp) * 64 + n];
        float xr = (float)(cr * ap.x - ci * ap.y), xi = (float)(cr * ap.y + ci * ap.x);
        const float2* bb = bbs + (size_t)(lg * 64 + n) * 16;
#pragma unroll
        for (int q = 0; q < 16; ++q) { float2 b = bb[q]; acc[q] += xr * b.x - xi * b.y; }
      }
    }
    h16x8 v0, v1;
#pragma unroll
    for (int q = 0; q < 8; ++q) { v0[q] = (h16)acc[q]; v1[q] = (h16)acc[8 + q]; }
    h16* kt = (h16*)(WS(p) + O_KTAB + (size_t)lg * SZ_KTAB) + slot * 256 + pp * 16;
    *(h16x8*)kt = v0;
    *(h16x8*)(kt + 8) = v1;
  }
  for (int i = gt; i < 128 * 64; i += ngt) {
    double2 ap = apow[((i >> 6) * 65 + 64) * 64 + (i & 63)];
    ((float2*)(WS(p) + O_AT))[i] = make_float2((float)ap.x, (float)ap.y);
  }
  for (int i = gt; i < DEPTH * 2 * 128; i += ngt) {
    const float* pp = (const float*)(WS(p) + O_B1P) + (size_t)(i >> 7) * 32 * 128 + (i & 127);
    float a = 0.f;
    for (int kc = 0; kc < 32; ++kc) a += pp[kc * 128];
    ((float*)(WS(p) + O_BIAS1))[i] = a;
  }
}

__device__ __forceinline__ void ssm_endstates(const Params& p, int l, char* lds) {
  const int tid = opaque_tid(), lane = tid & 63, w = tid >> 6;
  const h16* P = (const h16*)(WS(p) + O_P);
  float* E = (float*)(WS(p) + O_E);
  f32x4* red = (f32x4*)lds;
  for (int ub4 = blockIdx.x; ub4 < 256; ub4 += gridDim.x) {
    const int unit = ub4 * 4 + (w & 3), kh = w >> 2;
    const int g = unit >> 5, ctile = unit & 31;
    const h16* W1 = (const h16*)(WS(p) + O_W1 + (size_t)(l * 32 + g) * SZ_W13);
    const int gch = ctile * 16 + (lane & 15);
    const h16* ub = P + (size_t)gch * 64 * IWP + OFF_U + g * 16 + ((lane >> 4) & 1) * 8 + (size_t)(lane >> 5) * IWP;
    f32x4 acc[8];
#pragma unroll
    for (int mt = 0; mt < 8; ++mt) acc[mt] = f32x4{0.f, 0.f, 0.f, 0.f};
#pragma unroll 4
    for (int kk = 0; kk < 16; ++kk) {
      const int ks = kh * 16 + kk;
      h16x8 B = *(const h16x8*)(ub + (size_t)(ks * 2) * IWP);
#pragma unroll
      for (int mt = 0; mt < 8; ++mt) {
        h16x8 A = *(const h16x8*)(W1 + ((size_t)(ks * 4 + (lane >> 4)) * 128 + mt * 16 + (lane & 15)) * 8);
        acc[mt] = __builtin_amdgcn_mfma_f32_16x16x32_f16(A, B, acc[mt], 0, 0, 0);
      }
    }
    __syncthreads();
    if (kh == 1) {
#pragma unroll
      for (int mt = 0; mt < 8; ++mt) red[((w & 3) * 8 + mt) * 64 + lane] = acc[mt];
    }
    __syncthreads();
    if (kh == 0) {
#pragma unroll
      for (int mt = 0; mt < 8; ++mt)
        *(f32x4*)(E + ((size_t)gch * 32 + g) * 128 + mt * 16 + (lane >> 4) * 4) = acc[mt] + red[((w & 3) * 8 + mt) * 64 + lane];
    }
  }
}

constexpr int BU_PITCH = 1040, BS_PITCH = 144;
constexpr int SSMY_LDS = 65 * 512 + 16 * BU_PITCH * 2 + 16 * BS_PITCH * 2 + 128 * 64 * 8;
__device__ __forceinline__ void ssm_outputs(const Params& p, int l, char* lds, unsigned* ctr, int* slot) {
  const int tid = opaque_tid(), lane = tid & 63, w = tid >> 6;
  h16* Kt = (h16*)lds;
  h16* Bu = (h16*)(lds + 65 * 512);
  h16* Bs = (h16*)(lds + 65 * 512 + 16 * BU_PITCH * 2);
  float2* Es = (float2*)(lds + 65 * 512 + 16 * BU_PITCH * 2 + 16 * BS_PITCH * 2);
  const h16* P = (const h16*)(WS(p) + O_P);
  const float* E = (const float*)(WS(p) + O_E);
  h16* Z = (h16*)(WS(p) + O_Z);
  for (int unit = fetch_unit(ctr, slot); unit < 1024; unit = fetch_unit(ctr, slot)) {
    const int g = unit & 31, bc = unit >> 5, b = bc >> 3, ct = bc & 7;
    const int lg = l * 32 + g;
    __syncthreads();
    const int c0 = ct * 16;
    {
      const h16x8* ks = (const h16x8*)(WS(p) + O_KTAB + (size_t)lg * SZ_KTAB);
      for (int i = tid; i < 65 * 32; i += NT) ((h16x8*)Kt)[i] = ks[i];
      for (int i = tid; i < 2048; i += NT) {
        int tk = i >> 1, hf = i & 1;
        h16x8 v = *(const h16x8*)(P + ((size_t)b * SEQ + ct * 1024 + tk) * IWP + OFF_U + g * 16 + hf * 8);
        *(h16x8*)(Bu + (tk >> 6) * BU_PITCH + (tk & 63) * 16 + hf * 8) = v;
      }
      const float2* Eb = (const float2*)E + ((size_t)(b * 128) * 32 + g) * 64;
      for (int i = tid; i < (c0 + 16) * 64; i += NT) Es[i] = Eb[(size_t)(i >> 6) * 2048 + (i & 63)];
    }
    __syncthreads();
    if (w == 0) {
      float2 at = ((const float2*)(WS(p) + O_AT))[lg * 64 + lane];
      float sr = 0.f, si = 0.f;
#pragma unroll 8
      for (int c = 0; c < c0; ++c) {
        float2 e = Es[c * 64 + lane];
        float nr = at.x * sr - at.y * si + e.x, ni = at.x * si + at.y * sr + e.y;
        sr = nr; si = ni;
      }
#pragma unroll
      for (int i = 0; i < 16; ++i) {
        Bs[i * BS_PITCH + 2 * lane] = (h16)sr;
        Bs[i * BS_PITCH + 2 * lane + 1] = (h16)si;
        float2 e = Es[(c0 + i) * 64 + lane];
        float nr = at.x * sr - at.y * si + e.x, ni = at.x * si + at.y * sr + e.y;
        sr = nr; si = ni;
      }
    }
    __syncthreads();
    const float dt = expf(p.in[8][lg]);
    const int col = lane & 15, hi = lane >> 5, qh = (lane >> 4) & 1, p0 = (lane >> 4) * 4;
    const h16* W3 = (const h16*)(WS(p) + O_W3 + (size_t)lg * SZ_W13);
    float dsk[4];
    for (int j = 0; j < 4; ++j) dsk[j] = p.in[13][l * 512 + g * 16 + p0 + j];
    for (int r = 0; r < 64 / NW; ++r) {
      const int base = (r >> 1) * 2 * NW;
      const int tau = (r & 1) ? base + 2 * NW - 1 - w : base + w;
      f32x4 acc = {0.f, 0.f, 0.f, 0.f};
      const int nks = tau / 2 + 1;
      h16x8 A3[4];
#pragma unroll
      for (int ks = 0; ks < 4; ++ks)
        A3[ks] = *(const h16x8*)(W3 + ((size_t)((tau * 16 + ks * 4 + (lane >> 4)) * 16) + (lane & 15)) * 8);
      for (int i = 0; i < nks; ++i) {
        int j = tau - (2 * i + hi);
        h16x8 A = *(const h16x8*)(Kt + (j + 1) * 256 + (lane & 15) * 16 + qh * 8);
        h16x8 B = *(const h16x8*)(Bu + col * BU_PITCH + (2 * i + hi) * 16 + qh * 8);
        acc = __builtin_amdgcn_mfma_f32_16x16x32_f16(A, B, acc, 0, 0, 0);
      }
#pragma unroll
      for (int ks = 0; ks < 4; ++ks) {
        h16x8 B = *(const h16x8*)(Bs + col * BS_PITCH + ks * 32 + (lane >> 4) * 8);
        acc = __builtin_amdgcn_mfma_f32_16x16x32_f16(A3[ks], B, acc, 0, 0, 0);
      }
      const h16* up = Bu + col * BU_PITCH + tau * 16 + p0;
      size_t tok = ((size_t)b * 128 + ct * 16 + col) * 64 + tau;
      h16 zz[4];
      for (int j = 0; j < 4; ++j) zz[j] = (h16)gelu_tanh(dt * acc[j] + dsk[j] * (float)up[j]);
      typedef __attribute__((ext_vector_type(4))) _Float16 h16x4;
      h16x4 zv = {zz[0], zz[1], zz[2], zz[3]};
      *(h16x4*)(Z + tok * 512 + g * 16 + p0) = zv;
    }
  }
}

#define LAS __attribute__((address_space(3)))
typedef _Float16 h16x4 __attribute__((ext_vector_type(4)));
#define XB_TMO      128
#define XB_XCNT(j)  (256  + 64 * (j))
#define XB_XSUB(j)  (1280 + 64 * (j))
#define XB_XGEN(j)  (2304 + 64 * (j))
#define XB_TOP      3328
#define XB_TOPGEN   3392
#define XCD_BAR_WORDS 3456
#define XB_SPIN_CAP (1u << 18)

__device__ __forceinline__ unsigned xb_ld(unsigned* p)              { return __hip_atomic_load(p, __ATOMIC_RELAXED, __HIP_MEMORY_SCOPE_AGENT); }
__device__ __forceinline__ unsigned xb_add(unsigned* p, unsigned v) { return __hip_atomic_fetch_add(p, v, __ATOMIC_RELAXED, __HIP_MEMORY_SCOPE_AGENT); }
__device__ __forceinline__ unsigned xb_xcc_id() { return (unsigned)__builtin_amdgcn_s_getreg((3 << 11) | 20) & 0xFu; }
#define XB_SPIN(cond, bar) do { unsigned _sp = 0; while (cond) { __builtin_amdgcn_s_sleep(1); \
    if ((++_sp & 255u) == 0u) { if (xb_ld(&(bar)[XB_TMO])) break; if (_sp > XB_SPIN_CAP) { atomicAdd(&(bar)[XB_TMO], 1u); break; } } } } while (0)

struct XcdBarrier {
    unsigned* bar; unsigned x;
    volatile LAS unsigned* st;
};

__device__ __forceinline__ XcdBarrier xcd_barrier_post(unsigned* bar, volatile LAS unsigned* st) {
    XcdBarrier b; b.bar = bar; b.x = xb_xcc_id(); b.st = st;
    if (threadIdx.x == 0) (void)xb_add(&bar[XB_XCNT(b.x)], 1u);
    return b;
}
__device__ __forceinline__ void xcd_barrier_complete(unsigned* bar, unsigned x, unsigned& nloc, unsigned& nx) {
    const unsigned G = gridDim.x * gridDim.y * gridDim.z;
    unsigned sum, cnt, mine, sp = 0u;
    for (;;) {
        sum = 0u; cnt = 0u; mine = 0u;
#pragma unroll
        for (unsigned j = 0; j < 16; ++j) { const unsigned c = xb_ld(&bar[XB_XCNT(j)]); sum += c; cnt += (c > 0u) ? 1u : 0u; mine = (j == x) ? c : mine; }
        if (sum == G) break;
        __builtin_amdgcn_s_sleep(1);
        if ((++sp & 255u) == 0u) { if (xb_ld(&bar[XB_TMO])) break; if (sp > XB_SPIN_CAP) { atomicAdd(&bar[XB_TMO], 1u); break; } }
    }
    nloc = mine > 0u ? mine : 1u; nx = cnt > 0u ? cnt : 1u;
}

__device__ __forceinline__ void xcd_barrier(const XcdBarrier& b) {
    asm volatile("s_waitcnt vmcnt(0)" ::: "memory");
    __syncthreads();
    if (threadIdx.x == 0) {
        unsigned* bar = b.bar;
        __builtin_amdgcn_s_waitcnt(0);
        unsigned nloc = b.st[0], nx = b.st[1];
        if (nloc == 0u) { xcd_barrier_complete(bar, b.x, nloc, nx); b.st[0] = nloc; b.st[1] = nx; }
        const unsigned old = xb_add(&bar[XB_XSUB(b.x)], 1u);
        const unsigned gen = old / nloc;
        if (old + 1u == (gen + 1u) * nloc) {
            __builtin_amdgcn_fence(__ATOMIC_RELEASE, "agent");
            asm volatile("s_waitcnt vmcnt(0)" ::: "memory");
            const unsigned og = xb_add(&bar[XB_TOP], 1u);
            const unsigned tg = og / nx;
            if (og + 1u == (tg + 1u) * nx) xb_add(&bar[XB_TOPGEN], 1u);
            else XB_SPIN(xb_ld(&bar[XB_TOPGEN]) == tg, bar);
            __builtin_amdgcn_fence(__ATOMIC_ACQUIRE, "agent");
            xb_add(&bar[XB_XGEN(b.x)], 1u);
            asm volatile("s_waitcnt vmcnt(0)" ::: "memory");
        } else {
            XB_SPIN(xb_ld(&bar[XB_XGEN(b.x)]) == gen, bar);
            __builtin_amdgcn_fence(__ATOMIC_ACQUIRE, "agent");
            asm volatile("s_waitcnt vmcnt(0)" ::: "memory");
        }
    }
    __syncthreads();
}


namespace g8 {
constexpr int BM = 256, BK = 64, HALF = 128, HTB = HALF * BK * 2, STAGE_BYTES = 8 * HTB, NXCD = 8, WGM = 8;
__device__ __forceinline__ int lds_byte(int r, int c) {
  const int st = (r >> 4) * 2 + (c >> 5), rr = r & 15, cc = c & 31, ob = rr * 64 + cc * 2;
  return st * 1024 + (ob ^ (((ob >> 9) & 1) << 5));
}
__device__ __forceinline__ void stage_rc(int b, int& R, int& C) {
  const int st = b / 1024, sb = b % 1024, swz = sb ^ (((sb >> 9) & 1) << 5);
  R = (st >> 1) * 16 + swz / 64;
  C = (st & 1) * 32 + (swz % 64) / 2;
}
struct Unit { int pm, pn; };
struct Order {
  int nM, nN, nwg, G, c;
  __device__ void init(int M, int N, int G_, int c_) { nM = M / BM; nN = N / BM; nwg = nM * nN; G = G_; c = c_; }
  __device__ bool next(int i, Unit& u) const {
    const long L = (long)i * G + c;
    if (L >= nwg) return false;
    int wgid = (int)L;
    { const int q = nwg / NXCD, r = nwg % NXCD, xcd = wgid % NXCD, off = wgid / NXCD; wgid = (xcd < r ? xcd * (q + 1) : r * (q + 1) + (xcd - r) * q) + off; }
    const int nig = WGM * nN, gid = wgid / nig, fm = gid * WGM, gsz = (nM - fm) < WGM ? (nM - fm) : WGM;
    u.pm = fm + ((wgid % nig) % gsz);
    u.pn = (wgid % nig) / gsz;
    return true;
  }
};
template <class Epi>
__device__ __forceinline__ void gemm_phase(LAS unsigned char* lds, const h16* A, const h16* Bt, int K, const Order& S, const Epi& E) {
  const int tid = opaque_tid(), wid = __builtin_amdgcn_readfirstlane(tid >> 6), lane = tid & 63, wr = wid >> 2, wc = wid & 3, fr = lane & 15, fq = lane >> 4;
  const int nt = K / BK;
  unsigned voffA[2];
#pragma unroll
  for (int i = 0; i < 2; ++i) { int R, C; stage_rc(tid * 16 + i * 8192, R, C); voffA[i] = (unsigned)(R * K + C) * 2u; }
  const size_t kstep = (size_t)(BK * 2);
  const size_t hstep = (size_t)HALF * K * 2;
  const size_t tstep = 2 * hstep;
  const unsigned ldsw = (unsigned)wid * 1024u;
  const int aoff = lds_byte(wr * 64 + fr, fq * 8), boff = lds_byte(wc * 32 + fr, fq * 8);
#define G8_SA(b, h) (((b) * 2 + (h)) * HTB)
#define G8_SB(b, h) ((4 + (b) * 2 + (h)) * HTB)
#define G8_STAGE(bufoff, gbase) do { _Pragma("unroll") for (int _i = 0; _i < 2; ++_i) \
    __builtin_amdgcn_global_load_lds((const unsigned*)((const char*)(gbase) + voffA[_i]), (LAS unsigned*)(lds + (bufoff) + ldsw + _i * 8192), 16, 0, 0); } while (0)
#define G8_LDA(dst, b, h) do { _Pragma("unroll") for (int m = 0; m < 4; ++m) _Pragma("unroll") for (int k = 0; k < 2; ++k) dst[m][k] = *(const LAS h16x8*)(lds + G8_SA(b, h) + aoff + m * 2048 + k * 1024); } while (0)
#define G8_LDB(dst, b, h) do { _Pragma("unroll") for (int n = 0; n < 2; ++n) _Pragma("unroll") for (int k = 0; k < 2; ++k) dst[n][k] = *(const LAS h16x8*)(lds + G8_SB(b, h) + boff + n * 2048 + k * 1024); } while (0)
#define G8_MMA(ai, bj, At, Bt_) do { __builtin_amdgcn_s_setprio(1); _Pragma("unroll") for (int m = 0; m < 4; ++m) _Pragma("unroll") for (int n = 0; n < 2; ++n) _Pragma("unroll") for (int k = 0; k < 2; ++k) \
    acc[ai][bj][m][n] = __builtin_amdgcn_mfma_f32_16x16x32_f16(Bt_[n][k], At[m][k], acc[ai][bj][m][n], 0, 0, 0); __builtin_amdgcn_s_setprio(0); } while (0)
#define G8_WAIT_V(n) asm volatile("s_waitcnt vmcnt(" #n ")" ::: "memory")
#define G8_WAIT_L(n) asm volatile("s_waitcnt lgkmcnt(" #n ")" ::: "memory")
#define G8_BAR __builtin_amdgcn_s_barrier()
#define G8_SCHED __builtin_amdgcn_sched_barrier(0)
  Unit cur, nxt;
  int ui = 0;
  if (!S.next(0, cur)) return;
  f32x4 acc[2][2][4][2];
#pragma unroll
  for (int a = 0; a < 2; ++a)
#pragma unroll
    for (int b = 0; b < 2; ++b)
#pragma unroll
      for (int m = 0; m < 4; ++m)
#pragma unroll
        for (int n = 0; n < 2; ++n) acc[a][b][m][n] = (f32x4){0.f, 0.f, 0.f, 0.f};
  h16x8 At[4][2], B0[2][2], B1[2][2];
  const char* cA = (const char*)A + (size_t)cur.pm * tstep;
  const char* cB = (const char*)Bt + (size_t)cur.pn * tstep;
  G8_STAGE(G8_SB(0, 0), cB); G8_STAGE(G8_SA(0, 0), cA); G8_STAGE(G8_SB(0, 1), cB + hstep); G8_STAGE(G8_SA(0, 1), cA + hstep);
  if (wr == 1) G8_BAR;
  G8_WAIT_V(4); G8_BAR;
  G8_STAGE(G8_SB(1, 0), cB + kstep); G8_STAGE(G8_SA(1, 0), cA + kstep); G8_STAGE(G8_SB(1, 1), cB + hstep + kstep);
  G8_WAIT_V(6); G8_BAR;
  for (;;) {
    const bool has_next = S.next(ui + 1, nxt);
    const char* nA = has_next ? (const char*)A + (size_t)nxt.pm * tstep : cA;
    const char* nB = has_next ? (const char*)Bt + (size_t)nxt.pn * tstep : cB;
    for (int t = 0; t < nt; t += 2) {
      const bool last = (t == nt - 2);
      const char* a1 = cA + (size_t)(t + 1) * kstep;
      const char* a2 = last ? nA : cA + (size_t)(t + 2) * kstep;
      const char* b2 = last ? nB : cB + (size_t)(t + 2) * kstep;
      const char* a3 = a2 + kstep;
      const char* b3 = b2 + kstep;
      if (Epi::MID_T >= 0 && t == Epi::MID_T) E.mid(acc, ui, wr, fr);
      G8_LDB(B0, 0, 0); G8_SCHED; G8_LDA(At, 0, 0); G8_STAGE(G8_SA(1, 1), a1 + hstep);
      G8_WAIT_L(8); G8_BAR; G8_WAIT_L(0); G8_MMA(0, 0, At, B0); G8_BAR; G8_SCHED;
      G8_LDB(B1, 0, 1); G8_STAGE(G8_SB(0, 0), b2);
      G8_BAR; G8_WAIT_L(0); G8_MMA(0, 1, At, B1); G8_BAR;
      G8_LDA(At, 0, 1); G8_STAGE(G8_SA(0, 0), a2);
      G8_BAR; G8_WAIT_L(0); G8_MMA(1, 0, At, B0); G8_BAR; G8_SCHED;
      G8_STAGE(G8_SB(0, 1), b2 + hstep);
      G8_WAIT_V(6); G8_BAR; G8_MMA(1, 1, At, B1); G8_BAR;
      G8_LDB(B0, 1, 0); G8_SCHED; G8_LDA(At, 1, 0); G8_STAGE(G8_SA(0, 1), a2 + hstep);
      G8_WAIT_L(8); G8_BAR; G8_WAIT_L(0); G8_MMA(0, 0, At, B0); G8_BAR; G8_SCHED;
      G8_LDB(B1, 1, 1); G8_STAGE(G8_SB(1, 0), b3);
      G8_BAR; G8_WAIT_L(0); G8_MMA(0, 1, At, B1); G8_BAR;
      G8_LDA(At, 1, 1); G8_STAGE(G8_SA(1, 0), a3);
      G8_BAR; G8_WAIT_L(0); G8_MMA(1, 0, At, B0); G8_BAR; G8_SCHED;
      G8_STAGE(G8_SB(1, 1), b3 + hstep);
      G8_WAIT_V(6); G8_BAR; G8_MMA(1, 1, At, B1); G8_BAR;
    }
    E(acc, cur, ui, wr, wc, fr, fq);
    if (!has_next) break;
#pragma unroll
    for (int a = 0; a < 2; ++a)
#pragma unroll
      for (int b = 0; b < 2; ++b)
#pragma unroll
        for (int m = 0; m < 4; ++m)
#pragma unroll
          for (int n = 0; n < 2; ++n) acc[a][b][m][n] = (f32x4){0.f, 0.f, 0.f, 0.f};
    cur = nxt; cA = nA; cB = nB; ++ui;
  }
  G8_WAIT_V(0);
  if (wr == 0) G8_BAR;
  G8_BAR;
#undef G8_SA
#undef G8_SB
#undef G8_STAGE
#undef G8_LDA
#undef G8_LDB
#undef G8_MMA
#undef G8_WAIT_V
#undef G8_WAIT_L
#undef G8_BAR
#undef G8_SCHED
}
}

constexpr int RSL_OFF = g8::STAGE_BYTES;
constexpr int LDS_GEMM = g8::STAGE_BYTES + 8 * 256 * 4;

__device__ __forceinline__ void fill_rowscales(float* rsl, const float* ssq, float inv_n, const g8::Order& S) {
  const int tid = opaque_tid();
  g8::Unit u;
  __syncthreads();
  for (int i = 0; S.next(i, u); ++i) {
    if (tid < 256) {
      const float4* s4 = (const float4*)(ssq + (size_t)(u.pm * 256 + tid) * 16);
      float s = 0.f;
      for (int k = 0; k < 4; ++k) { float4 v = s4[k]; s += v.x + v.y + v.z + v.w; }
      rsl[i * 256 + tid] = rsqrtf(s * inv_n + EPS);
    }
  }
  __syncthreads();
}

__device__ __forceinline__ h16x4 pack4(float a, float b, float c, float d) { h16x4 v = {(h16)a, (h16)b, (h16)c, (h16)d}; return v; }
__device__ __forceinline__ h16x8 pack8(f32x4 a, f32x4 b) {
  h16x8 v = {(h16)a[0], (h16)a[1], (h16)a[2], (h16)a[3], (h16)b[0], (h16)b[1], (h16)b[2], (h16)b[3]};
  return v;
}

struct EpiIn {
  static constexpr int MID_T = -1;
  __device__ __forceinline__ void mid(f32x4 (&)[2][2][4][2], int, int, int) const {}
  h16* P; const float* rsl; const float* qkg;
  __device__ __forceinline__ void operator()(const f32x4 (&acc)[2][2][4][2], const g8::Unit& u, int ui, int wr, int wc, int fr, int fq) const {
    const int hs = u.pn * 4 + wc;
    int gi = -1;
    if (hs < 4) gi = 0; else if (hs < 6) gi = 1; else if (hs >= 16 && hs < 20) gi = 2; else if (hs == 22) gi = 4; else if (hs == 24) gi = 5;
    const bool gate = (hs == 26);
#pragma unroll
    for (int ai = 0; ai < 2; ++ai)
#pragma unroll
      for (int m = 0; m < 4; ++m) {
        const int rl = 128 * ai + 64 * wr + 16 * m + fr;
        float r = rsl[ui * 256 + rl];
        if (gi >= 0) {
          float ss = 0.f;
#pragma unroll
          for (int bj = 0; bj < 2; ++bj)
#pragma unroll
            for (int n = 0; n < 2; ++n)
#pragma unroll
              for (int j = 0; j < 4; ++j) ss += acc[ai][bj][m][n][j] * acc[ai][bj][m][n][j];
          ss += xor16(ss);
          ss += __shfl_xor(ss, 32);
          r *= rsqrtf(ss * r * r * (1.f / 64.f) + EPS);
        }
        h16* rowp = P + (size_t)(u.pm * 256 + rl) * IWP + 64 * hs + 8 * fq;
#pragma unroll
        for (int bj = 0; bj < 2; ++bj) {
          f32x4 v[2];
#pragma unroll
          for (int n = 0; n < 2; ++n) {
            v[n] = acc[ai][bj][m][n] * r;
            if (gi >= 0) {
              const float4 g4 = *(const float4*)(qkg + gi * 64 + 32 * bj + 8 * fq + 4 * n);
              v[n][0] *= g4.x; v[n][1] *= g4.y; v[n][2] *= g4.z; v[n][3] *= g4.w;
            } else if (gate) {
#pragma unroll
              for (int j = 0; j < 4; ++j) v[n][j] = (32 * bj + 8 * fq + 4 * n + j) < 12 ? sigmoidf(v[n][j]) : 0.f;
            }
          }
          *(h16x8*)(rowp + 32 * bj) = pack8(v[0], v[1]);
        }
      }
  }
};

struct EpiGlu {
  static constexpr int MID_T = -1;
  __device__ __forceinline__ void mid(f32x4 (&)[2][2][4][2], int, int, int) const {}
  h16* OB; float* ssqb; const float* gb;
  __device__ __forceinline__ void operator()(const f32x4 (&acc)[2][2][4][2], const g8::Unit& u, int ui, int wr, int wc, int fr, int fq) const {
    const int ocb = 128 * u.pn + 16 * wc + 4 * fq;
    float4 ba[2], bb[2];
#pragma unroll
    for (int bj = 0; bj < 2; ++bj) { ba[bj] = *(const float4*)(gb + ocb + 64 * bj); bb[bj] = *(const float4*)(gb + 512 + ocb + 64 * bj); }
#pragma unroll
    for (int ai = 0; ai < 2; ++ai)
#pragma unroll
      for (int m = 0; m < 4; ++m) {
        const size_t row = (size_t)u.pm * 256 + 128 * ai + 64 * wr + 16 * m + fr;
        float ss = 0.f;
#pragma unroll
        for (int bj = 0; bj < 2; ++bj) {
          const f32x4 a = acc[ai][bj][m][0], b = acc[ai][bj][m][1];
          float o0 = (a[0] + ba[bj].x) * sigmoidf(b[0] + bb[bj].x);
          float o1 = (a[1] + ba[bj].y) * sigmoidf(b[1] + bb[bj].y);
          float o2 = (a[2] + ba[bj].z) * sigmoidf(b[2] + bb[bj].z);
          float o3 = (a[3] + ba[bj].w) * sigmoidf(b[3] + bb[bj].w);
          *(h16x4*)(OB + row * 1024 + ocb + 64 * bj) = pack4(o0, o1, o2, o3);
          ss += o0 * o0 + o1 * o1 + o2 * o2 + o3 * o3;
        }
        ss += xor16(ss);
        ss += __shfl_xor(ss, 32);
        if (fq == 0) ssqb[row * 16 + u.pn * 4 + wc] = ss;
      }
  }
};

struct EpiRes {
  static constexpr int MID_T = -1;
  __device__ __forceinline__ void mid(f32x4 (&)[2][2][4][2], int, int, int) const {}
  float* xo; h16* xb; float* ssq; bool final_out;
  __device__ __forceinline__ void operator()(const f32x4 (&acc)[2][2][4][2], const g8::Unit& u, int ui, int wr, int wc, int fr, int fq) const {
#pragma unroll
    for (int ai = 0; ai < 2; ++ai)
#pragma unroll
      for (int m = 0; m < 4; ++m) {
        const size_t row = (size_t)u.pm * 256 + 128 * ai + 64 * wr + 16 * m + fr;
        const size_t base = row * DM + 256 * u.pn + 32 * wc + 8 * fq;
        float ss = 0.f;
#pragma unroll
        for (int bj = 0; bj < 2; ++bj) {
          const size_t idx = base + 128 * bj;
          const h16x8 xv = *(const h16x8*)(xb + idx);
          f32x4 x0 = acc[ai][bj][m][0], x1 = acc[ai][bj][m][1];
#pragma unroll
          for (int j = 0; j < 4; ++j) { x0[j] += (float)xv[j]; x1[j] += (float)xv[4 + j]; ss += x0[j] * x0[j] + x1[j] * x1[j]; }
          if (final_out) {
            __builtin_nontemporal_store(x0, (f32x4*)(xo + idx));
            __builtin_nontemporal_store(x1, (f32x4*)(xo + idx + 4));
          } else {
            *(h16x8*)(xb + idx) = pack8(x0, x1);
          }
        }
        ss += xor16(ss);
        ss += __shfl_xor(ss, 32);
        if (fq == 0) ssq[row * 16 + u.pn * 4 + wc] = ss;
      }
  }
};

struct EpiOut : EpiRes {
  static constexpr int MID_T = 8;
  const float* rsl;
  __device__ __forceinline__ void mid(f32x4 (&acc)[2][2][4][2], int ui, int wr, int fr) const {
#pragma unroll
    for (int ai = 0; ai < 2; ++ai)
#pragma unroll
      for (int m = 0; m < 4; ++m) {
        const float r = rsl[ui * 256 + 128 * ai + 64 * wr + 16 * m + fr];
#pragma unroll
        for (int bj = 0; bj < 2; ++bj)
#pragma unroll
          for (int n = 0; n < 2; ++n) acc[ai][bj][m][n] *= r;
      }
  }
};

struct EpiUp {
  static constexpr int MID_T = -1;
  __device__ __forceinline__ void mid(f32x4 (&)[2][2][4][2], int, int, int) const {}
  h16* hid; const float* rsl;
  __device__ __forceinline__ void operator()(const f32x4 (&acc)[2][2][4][2], const g8::Unit& u, int ui, int wr, int wc, int fr, int fq) const {
#pragma unroll
    for (int ai = 0; ai < 2; ++ai)
#pragma unroll
      for (int m = 0; m < 4; ++m) {
        const int rl = 128 * ai + 64 * wr + 16 * m + fr;
        const float r = rsl[ui * 256 + rl];
        h16* rowp = hid + (size_t)(u.pm * 256 + rl) * DFF + 256 * u.pn + 32 * wc + 8 * fq;
#pragma unroll
        for (int bj = 0; bj < 2; ++bj) {
          f32x4 v[2];
#pragma unroll
          for (int n = 0; n < 2; ++n) {
            v[n] = acc[ai][bj][m][n] * r;
#pragma unroll
            for (int j = 0; j < 4; ++j) { const float t = fmaxf(v[n][j], 0.f); v[n][j] = t * t; }
          }
          __builtin_nontemporal_store(pack8(v[0], v[1]), (h16x8*)(rowp + 128 * bj));
        }
      }
  }
};

__device__ __forceinline__ void phase_gemm1(const Params& p, int l, char* lds) {
  g8::Order S; S.init(NTOK, IWP, gridDim.x, blockIdx.x);
  float* rsl = (float*)(lds + RSL_OFF);
  fill_rowscales(rsl, (const float*)(WS(p) + O_SSQ), 1.f / DM, S);
  EpiIn E{(h16*)(WS(p) + O_P), rsl, p.in[3] + l * 6 * 64};
  g8::gemm_phase((LAS unsigned char*)lds, (const h16*)(WS(p) + O_XB), (const h16*)(WS(p) + O_WIN + l * SZ_WIN), DM, S, E);
}
__device__ __forceinline__ void phase_glu(const Params& p, int l, char* lds) {
  g8::Order S; S.init(NTOK, 1024, gridDim.x, blockIdx.x);
  __syncthreads();
  EpiGlu E{(h16*)(WS(p) + O_OB), (float*)(WS(p) + O_SSQB), p.in[15] + l * 1024};
  g8::gemm_phase((LAS unsigned char*)lds, (const h16*)(WS(p) + O_Z), (const h16*)(WS(p) + O_WGLU + l * SZ_WGLU), 512, S, E);
}
__device__ __forceinline__ void phase_wout(const Params& p, int l, char* lds) {
  g8::Order S; S.init(NTOK, DM, gridDim.x, blockIdx.x);
  float* rsl = (float*)(lds + RSL_OFF);
  fill_rowscales(rsl, (const float*)(WS(p) + O_SSQB), 1.f / 512.f, S);
  EpiOut E;
  E.xo = p.out; E.xb = (h16*)(WS(p) + O_XB); E.ssq = (float*)(WS(p) + O_SSQ); E.final_out = false; E.rsl = rsl;
  g8::gemm_phase((LAS unsigned char*)lds, (const h16*)(WS(p) + O_OB), (const h16*)(WS(p) + O_WOUT + l * SZ_WOUT), DM, S, E);
}
__device__ __forceinline__ void phase_up(const Params& p, int l, char* lds) {
  g8::Order S; S.init(NTOK, DFF, gridDim.x, blockIdx.x);
  float* rsl = (float*)(lds + RSL_OFF);
  fill_rowscales(rsl, (const float*)(WS(p) + O_SSQ), 1.f / DM, S);
  EpiUp E{(h16*)(WS(p) + O_HID), rsl};
  g8::gemm_phase((LAS unsigned char*)lds, (const h16*)(WS(p) + O_XB), (const h16*)(WS(p) + O_WUP + l * SZ_WUP), DM, S, E);
}
__device__ __forceinline__ void phase_down(const Params& p, int l, char* lds) {
  g8::Order S; S.init(NTOK, DM, gridDim.x, blockIdx.x);
  __syncthreads();
  EpiRes E{p.out, (h16*)(WS(p) + O_XB), (float*)(WS(p) + O_SSQ), l == DEPTH - 1};
  g8::gemm_phase((LAS unsigned char*)lds, (const h16*)(WS(p) + O_HID), (const h16*)(WS(p) + O_WDN + l * SZ_WDN), DFF, S, E);
}

constexpr int KP = 80;
enum { M_SWA = 0, M_WIN = 1, M_SEL = 2, M_CMPA = 3, M_CMPB = 4 };
constexpr float LOG2E = 1.4426950408889634f, SCL2 = 0.125f * LOG2E;
struct ColState { float m, l; };
typedef short s16x4v __attribute__((__vector_size__(8)));

__device__ __forceinline__ h16x8 ld_row8(const h16* base, int ld, int row, int nrows, int c8) {
  h16x8 z = {0, 0, 0, 0, 0, 0, 0, 0};
  return (row >= 0 && row < nrows) ? *(const h16x8*)(base + (size_t)row * ld + c8 * 8) : z;
}
__device__ __forceinline__ void st_k(h16* Ks, int row, int c8, h16x8 v) { *(h16x8*)(Ks + row * KP + c8 * 8) = v; }
__device__ __forceinline__ void st_vt(h16* Vt, int row, int c8, h16x8 v) {
#pragma unroll
  for (int e = 0; e < 8; ++e) Vt[(c8 * 8 + e) * KP + row] = v[e];
}
__device__ __forceinline__ float max4q(float v) {
  v = fmaxf(v, xor16(v));
  auto r = __builtin_amdgcn_permlane32_swap(__float_as_int(v), __float_as_int(v), false, false);
  return fmaxf(__int_as_float(r[0]), __int_as_float(r[1]));
}
__device__ __forceinline__ float sum4q(float v) {
  v += xor16(v);
  auto r = __builtin_amdgcn_permlane32_swap(__float_as_int(v), __float_as_int(v), false, false);
  return __int_as_float(r[0]) + __int_as_float(r[1]);
}
__device__ __forceinline__ float quadsum(float v) { v += dppf<0xB1>(v); v += dppf<0x4E>(v); return v; }

template <int MODE, int RGM>
__device__ __forceinline__ void attn_tile(const h16x8 (&Q)[2][2], f32x4 (&O)[2][4], ColState (&st)[2], const h16* Ks,
                                          const h16* Vt, const float* biasT, const int (&tq)[2], int hd, int kbase, bool far,
                                          const bool (&selbit)[2], float (&hq)[2][4], float (&h3)[2][4], const int lane) {
  const int col = lane & 15, q4 = lane >> 4;
  constexpr int DK = (MODE == M_CMPA || MODE == M_CMPB) ? 16 : 1;
  f32x4 S[2][4];
#pragma unroll
  for (int kt = 0; kt < 4; ++kt) {
#pragma unroll
    for (int rg = 0; rg < 2; ++rg) S[rg][kt] = f32x4{0.f, 0.f, 0.f, 0.f};
#pragma unroll
    for (int ks = 0; ks < 2; ++ks) {
      h16x8 Kf = *(const h16x8*)(Ks + (kt * 16 + col) * KP + ks * 32 + q4 * 8);
#pragma unroll
      for (int rg = 0; rg < 2; ++rg)
        if (RGM & (1 << rg)) S[rg][kt] = __builtin_amdgcn_mfma_f32_16x16x32_f16(Kf, Q[rg][ks], S[rg][kt], 0, 0, 0);
    }
  }
  h16x8 Pf[2][2];
#pragma unroll
  for (int rg = 0; rg < 2; ++rg) {
    if (!(RGM & (1 << rg))) continue;
    const float* bt = biasT + hd * 800;
    if (far) {
      const float b31 = bt[799];
      const bool ok = (MODE == M_SEL) ? selbit[rg] : true;
#pragma unroll
      for (int kt = 0; kt < 4; ++kt)
#pragma unroll
        for (int j = 0; j < 4; ++j) S[rg][kt][j] = ok ? S[rg][kt][j] * SCL2 + b31 : -1e30f;
    } else {
      const int kx0 = kbase + q4 * 4;
      const int d0 = (DK == 16) ? tq[rg] - 31 - 16 * kx0 : tq[rg] - kx0;
#pragma unroll
      for (int kt = 0; kt < 4; ++kt)
#pragma unroll
        for (int j = 0; j < 4; ++j) {
          const int dist = d0 - DK * (kt * 16 + j);
          const int kx = kx0 + kt * 16 + j;
          bool valid = dist >= 0;
          if (MODE == M_SWA) valid = valid && dist < 128 && kx >= 0;
          if (MODE == M_WIN) valid = valid && dist < 512 && kx >= 0;
          if (MODE == M_SEL) valid = valid && selbit[rg];
          if (DK == 16) valid = valid && kx < NCMP;
          const int dc = dist < 0 ? 0 : (dist > 799 ? 799 : dist);
          S[rg][kt][j] = valid ? S[rg][kt][j] * SCL2 + bt[dc] : -1e30f;
        }
    }
    if (MODE == M_CMPB) {
#pragma unroll
      for (int kt = 0; kt < 4; ++kt) {
        float h = 0.f;
#pragma unroll
        for (int j = 0; j < 4; ++j) {
          float pv = __builtin_amdgcn_exp2f(S[rg][kt][j] - st[rg].m) * st[rg].l;
          S[rg][kt][j] = pv;
          h += pv;
        }
        hq[rg][kt] = h;
        h3[rg][kt] = S[rg][kt][3];
      }
    } else {
      float mx = -1e30f;
#pragma unroll
      for (int kt = 0; kt < 4; ++kt)
#pragma unroll
        for (int j = 0; j < 4; ++j) mx = fmaxf(mx, S[rg][kt][j]);
      mx = max4q(mx);
      const float mn = fmaxf(st[rg].m, mx);
      const float corr = __builtin_amdgcn_exp2f(st[rg].m - mn);
      st[rg].m = mn;
      const float mm = fmaxf(mn, -1e20f);
      float ls = 0.f;
#pragma unroll
      for (int kt = 0; kt < 4; ++kt)
#pragma unroll
        for (int j = 0; j < 4; ++j) {
          float pv = __builtin_amdgcn_exp2f(S[rg][kt][j] - mm);
          S[rg][kt][j] = pv;
          ls += pv;
        }
      st[rg].l = st[rg].l * corr + ls;
      if (MODE != M_CMPA) {
#pragma unroll
        for (int nt = 0; nt < 4; ++nt) O[rg][nt] *= corr;
      }
    }
    if (MODE != M_CMPA) {
#pragma unroll
      for (int ks = 0; ks < 2; ++ks)
#pragma unroll
        for (int i = 0; i < 4; ++i) {
          Pf[rg][ks][i] = (h16)S[rg][2 * ks][i];
          Pf[rg][ks][4 + i] = (h16)S[rg][2 * ks + 1][i];
        }
    }
  }
  if (MODE == M_CMPA) return;
#pragma unroll
  for (int ks = 0; ks < 2; ++ks)
#pragma unroll
    for (int nt = 0; nt < 4; ++nt) {
      const h16* vp = Vt + (ks * 32 + q4 * 4 + (col >> 2)) * KP + nt * 16 + 4 * (col & 3);
      const s16x4v r0 = __builtin_amdgcn_ds_read_tr16_b64_v4i16((LAS s16x4v*)vp);
      const s16x4v r1 = __builtin_amdgcn_ds_read_tr16_b64_v4i16((LAS s16x4v*)(vp + 16 * KP));
      const h16x4 v0 = __builtin_bit_cast(h16x4, r0), v1 = __builtin_bit_cast(h16x4, r1);
      const h16x8 Vf = {v0[0], v0[1], v0[2], v0[3], v1[0], v1[1], v1[2], v1[3]};
#pragma unroll
      for (int rg = 0; rg < 2; ++rg)
        if (RGM & (1 << rg)) O[rg][nt] = __builtin_amdgcn_mfma_f32_16x16x32_f16(Vf, Pf[rg][ks], O[rg][nt], 0, 0, 0);
    }
}

constexpr int LDS_CMP = 8 * 16 * 128 * 4 + 16 * 136 * 2 + 4 * 16 * 4;
__device__ __forceinline__ void phase_compress(const Params& p, int l, char* lds) {
  const int tid = opaque_tid(), lane = tid & 63, w = tid >> 6, col = lane & 15, q4 = lane >> 4;
  float* red = (float*)lds;
  h16* hid = (h16*)(lds + 8 * 16 * 128 * 4);
  float* nrm2 = (float*)(lds + 8 * 16 * 128 * 4 + 16 * 136 * 2);
  const h16* P = (const h16*)(WS(p) + O_P);
  for (int u = blockIdx.x; u < BATCH * 2 * 32; u += gridDim.x) {
    const int mt = u & 31, st = (u >> 5) & 1, b = u >> 6;
    const h16* W1t = (const h16*)(WS(p) + O_W1T) + (size_t)(l * 2 + st) * 128 * 2048;
    const h16* W2t = (const h16*)(WS(p) + O_W2T) + (size_t)(l * 2 + st) * 64 * 128;
    const float* b1 = (const float*)(WS(p) + O_BIAS1) + (l * 2 + st) * 128;
    __syncthreads();
    {
      f32x4 acc[8];
#pragma unroll
      for (int nt = 0; nt < 8; ++nt) acc[nt] = f32x4{0.f, 0.f, 0.f, 0.f};
      const int m = 16 * mt + col;
#pragma unroll 2
      for (int kk = 0; kk < 8; ++kk) {
        const int ks = 8 * w + kk, tt = ks >> 1, d0 = (ks & 1) * 32 + q4 * 8;
        int tok = 16 * m + tt;
        if (tok > SEQ - 1) tok = SEQ - 1;
        const h16x8 A = *(const h16x8*)(P + ((size_t)b * SEQ + tok) * IWP + OFF_KVC + st * 64 + d0);
#pragma unroll
        for (int nt = 0; nt < 8; ++nt) {
          const h16x8 B = *(const h16x8*)(W1t + (size_t)(nt * 16 + col) * 2048 + ks * 32 + q4 * 8);
          acc[nt] = __builtin_amdgcn_mfma_f32_16x16x32_f16(A, B, acc[nt], 0, 0, 0);
        }
      }
#pragma unroll
      for (int nt = 0; nt < 8; ++nt)
#pragma unroll
        for (int j = 0; j < 4; ++j) red[(w * 16 + q4 * 4 + j) * 128 + nt * 16 + col] = acc[nt][j];
    }
    __syncthreads();
    {
      const int row = tid >> 5, c4 = (tid & 31) * 4;
      float4 sum = *(const float4*)(b1 + c4);
#pragma unroll
      for (int ww = 0; ww < 8; ++ww) {
        const float4 v = *(const float4*)(red + (ww * 16 + row) * 128 + c4);
        sum.x += v.x; sum.y += v.y; sum.z += v.z; sum.w += v.w;
      }
      *(h16x4*)(hid + row * 136 + c4) = pack4(gelu_tanh(sum.x), gelu_tanh(sum.y), gelu_tanh(sum.z), gelu_tanh(sum.w));
    }
    __syncthreads();
    f32x4 o2 = {0.f, 0.f, 0.f, 0.f};
    if (w < 4) {
#pragma unroll
      for (int ks = 0; ks < 4; ++ks) {
        const h16x8 A = *(const h16x8*)(hid + col * 136 + ks * 32 + q4 * 8);
        const h16x8 B = *(const h16x8*)(W2t + (size_t)(w * 16 + col) * 128 + ks * 32 + q4 * 8);
        o2 = __builtin_amdgcn_mfma_f32_16x16x32_f16(A, B, o2, 0, 0, 0);
      }
      if (st == 0) {
#pragma unroll
        for (int j = 0; j < 4; ++j) {
          float ss = sum16(o2[j] * o2[j]);
          if (col == 0) nrm2[w * 16 + q4 * 4 + j] = ss;
        }
      }
    }
    __syncthreads();
    if (w < 4) {
      const float g = p.in[3][(l * 6 + 3) * 64 + w * 16 + col];
      h16* dst = (h16*)(WS(p) + (st == 0 ? O_KCMP : O_VCMP));
#pragma unroll
      for (int j = 0; j < 4; ++j) {
        const int row = q4 * 4 + j, m = 16 * mt + row;
        float v = o2[j];
        if (st == 0) {
          float tot = nrm2[row] + nrm2[16 + row] + nrm2[32 + row] + nrm2[48 + row];
          v = v * rsqrtf(tot * (1.f / 64.f) + EPS) * g;
        }
        if (m >= NCMP) v = 0.f;
        dst[((size_t)b * 512 + m) * 64 + w * 16 + col] = (h16)v;
      }
    }
  }
}


template <int MODE, int TM>
__device__ __forceinline__ void attn_tile2(const h16x8 (&Q)[2], f32x4 (&O)[4], ColState& st, const h16* Ks0, const h16* Vt0,
                                           const h16* Ks1, const h16* Vt1, const float* biasT, int tq, int hd, int kbase0,
                                           const bool (&far)[2], const bool (&selbit)[2], float (&hq)[2][4], float (&h3)[2][4],
                                           const int lane) {
  const int col = lane & 15, q4 = lane >> 4;
  constexpr int DK = (MODE == M_CMPA || MODE == M_CMPB) ? 16 : 1;
  f32x4 S[2][4];
  __builtin_amdgcn_s_setprio(1);
#pragma unroll
  for (int t = 0; t < 2; ++t) {
    if (!(TM & (1 << t))) continue;
    const h16* Ks = t ? Ks1 : Ks0;
#pragma unroll
    for (int kt = 0; kt < 4; ++kt) {
      S[t][kt] = f32x4{0.f, 0.f, 0.f, 0.f};
#pragma unroll
      for (int ks = 0; ks < 2; ++ks) {
        h16x8 Kf = *(const h16x8*)(Ks + (kt * 16 + col) * KP + ks * 32 + q4 * 8);
        S[t][kt] = __builtin_amdgcn_mfma_f32_16x16x32_f16(Kf, Q[ks], S[t][kt], 0, 0, 0);
      }
    }
  }
  __builtin_amdgcn_s_setprio(0);
  const float* bt = biasT + hd * 800;
  float addc[2] = {0.f, 0.f}, sclc[2] = {1.f, 1.f};
#pragma unroll
  for (int t = 0; t < 2; ++t) {
    if (!(TM & (1 << t))) continue;
    const int kbase = kbase0 + 64 * t;
    if (far[t]) {
      const bool ok = (MODE == M_SEL) ? selbit[t] : true;
      addc[t] = ok ? bt[799] : -1e30f;
      sclc[t] = SCL2;
    } else {
      addc[t] = 0.f;
      sclc[t] = 1.f;
      const int kx0 = kbase + q4 * 4;
      const int d0 = (DK == 16) ? tq - 31 - 16 * kx0 : tq - kx0;
#pragma unroll
      for (int kt = 0; kt < 4; ++kt)
#pragma unroll
        for (int j = 0; j < 4; ++j) {
          const int dist = d0 - DK * (kt * 16 + j);
          const int kx = kx0 + kt * 16 + j;
          bool valid = dist >= 0;
          if (MODE == M_WIN) valid = valid && dist < 512 && kx >= 0;
          if (MODE == M_SEL) valid = valid && selbit[t];
          if (DK == 16) valid = valid && kx < NCMP;
          const int dc = dist < 0 ? 0 : (dist > 799 ? 799 : dist);
          S[t][kt][j] = valid ? S[t][kt][j] * SCL2 + bt[dc] : -1e30f;
        }
    }
  }
  if (MODE == M_CMPB) {
#pragma unroll
    for (int t = 0; t < 2; ++t) {
      if (!(TM & (1 << t))) continue;
#pragma unroll
      for (int kt = 0; kt < 4; ++kt) {
        float h = 0.f;
#pragma unroll
        for (int j = 0; j < 4; ++j) {
          float pv = __builtin_amdgcn_exp2f(S[t][kt][j] * sclc[t] + (addc[t] - st.m)) * st.l;
          S[t][kt][j] = pv;
          h += pv;
        }
        hq[t][kt] = h;
        h3[t][kt] = S[t][kt][3];
      }
    }
  } else {
    float mx = -1e30f;
#pragma unroll
    for (int t = 0; t < 2; ++t) {
      if (!(TM & (1 << t))) continue;
      float mt = -1e30f;
#pragma unroll
      for (int kt = 0; kt < 4; ++kt)
#pragma unroll
        for (int j = 0; j < 4; ++j) mt = fmaxf(mt, S[t][kt][j]);
      mx = fmaxf(mx, mt * sclc[t] + addc[t]);
    }
    mx = max4q(mx);
    const float mn = fmaxf(st.m, mx);
    const float corr = __builtin_amdgcn_exp2f(st.m - mn);
    st.m = mn;
    const float mm = fmaxf(mn, -1e20f);
    float ls = 0.f;
#pragma unroll
    for (int t = 0; t < 2; ++t) {
      if (!(TM & (1 << t))) continue;
      const float am = addc[t] - mm;
#pragma unroll
      for (int kt = 0; kt < 4; ++kt) {
        const f32x4 e = S[t][kt] * sclc[t] + am;
#pragma unroll
        for (int j = 0; j < 4; ++j) {
          float pv = __builtin_amdgcn_exp2f(e[j]);
          S[t][kt][j] = pv;
          ls += pv;
        }
      }
    }
    st.l = st.l * corr + ls;
    if (MODE != M_CMPA) {
#pragma unroll
      for (int nt = 0; nt < 4; ++nt) O[nt] *= corr;
    }
  }
  if (MODE == M_CMPA) return;
  __builtin_amdgcn_s_setprio(1);
#pragma unroll
  for (int t = 0; t < 2; ++t) {
    if (!(TM & (1 << t))) continue;
    const h16* Vt = t ? Vt1 : Vt0;
#pragma unroll
    for (int ks = 0; ks < 2; ++ks) {
      h16x8 Pf;
#pragma unroll
      for (int i = 0; i < 4; ++i) { Pf[i] = (h16)S[t][2 * ks][i]; Pf[4 + i] = (h16)S[t][2 * ks + 1][i]; }
#pragma unroll
      for (int nt = 0; nt < 4; ++nt) {
        const h16* vp = Vt + (ks * 32 + q4 * 4 + (col >> 2)) * KP + nt * 16 + 4 * (col & 3);
        const s16x4v r0 = __builtin_amdgcn_ds_read_tr16_b64_v4i16((LAS s16x4v*)vp);
        const s16x4v r1 = __builtin_amdgcn_ds_read_tr16_b64_v4i16((LAS s16x4v*)(vp + 16 * KP));
        const h16x4 v0 = __builtin_bit_cast(h16x4, r0), v1 = __builtin_bit_cast(h16x4, r1);
        const h16x8 Vf = {v0[0], v0[1], v0[2], v0[3], v1[0], v1[1], v1[2], v1[3]};
        O[nt] = __builtin_amdgcn_mfma_f32_16x16x32_f16(Vf, Pf, O[nt], 0, 0, 0);
      }
    }
  }
  __builtin_amdgcn_s_setprio(0);
}

template <int D, class LoadF, class StoreF, class CompF>
__device__ __forceinline__ void pair_pipeline(int n, LoadF load, StoreF store, CompF comp) {
  h16x8 r[D][4];
#pragma unroll
  for (int d = 0; d < D; ++d)
    if (d < n) load(d, r[d]);
  store(0, r[0]);
  if (D < n) load(D, r[0]);
  __syncthreads();
  for (int i0 = 0; i0 < n; i0 += D) {
#pragma unroll
    for (int d = 0; d < D; ++d) {
      const int i = i0 + d;
      if (i < n) {
        if (i + 1 < n) store(i + 1, r[(d + 1) % D]);
        if (i + 1 + D < n) load(i + 1 + D, r[(d + 1) % D]);
        comp(i);
        __syncthreads();
      }
    }
  }
}

template <int D, class LoadF, class StoreF, class CompF>
__device__ __forceinline__ void tile_pipeline(int n, LoadF load, StoreF store, CompF comp) {
  h16x8 rk[D], rv[D];
#pragma unroll
  for (int d = 0; d < D; ++d)
    if (d < n) load(d, rk[d], rv[d]);
  store(0, rk[0], rv[0]);
  if (D < n) load(D, rk[0], rv[0]);
  __syncthreads();
  for (int i0 = 0; i0 < n; i0 += D) {
#pragma unroll
    for (int d = 0; d < D; ++d) {
      const int i = i0 + d;
      if (i < n) {
        if (i + 1 < n) store(i + 1, rk[(d + 1) % D], rv[(d + 1) % D]);
        if (i + 1 + D < n) load(i + 1 + D, rk[(d + 1) % D], rv[(d + 1) % D]);
        comp(i);
        __syncthreads();
      }
    }
  }
}

constexpr int LDS_BIAS = 800 * 16;
__device__ __forceinline__ void phase_swa(const Params& p, int l, char* lds, unsigned* ctr, int* slot) {
  const int tid = opaque_tid(), lane = tid & 63, w = tid >> 6, col = lane & 15, q4 = lane >> 4;
  float* biasT = (float*)lds;
  h16* KV = (h16*)(lds + LDS_BIAS);
  float* nrm = (float*)(lds + LDS_BIAS + 4 * 64 * KP * 2);
  const h16* P = (const h16*)(WS(p) + O_P);
  const int* lut = (const int*)(WS(p) + O_LUT);
  h16* OAC = (h16*)(WS(p) + O_OAC);
  __syncthreads();
  for (int i = tid; i < 3200; i += NT) biasT[i] = p.in[5][lut[i % 800] * 8 + (i / 800)] * LOG2E;
  __syncthreads();
  const int head = w >> 1, kvh = w >> 2;
  const float sink = p.in[4][l * 4 + head] * LOG2E;
  const int srow = tid >> 3, c8 = tid & 7;
  float hpd[2][4], hpe[2][4];
  const bool nosel[2] = {false, false};
  for (int u = fetch_unit(ctr, slot); u < BATCH * 128; u = fetch_unit(ctr, slot)) {
    const int b = u >> 7, t0 = (u & 127) * 64;
    const h16* Pbat = P + (size_t)b * SEQ * IWP;
    h16x8 Q[2][2];
    int tq[2];
#pragma unroll
    for (int rg = 0; rg < 2; ++rg) {
      const int qb = (w & 1) * 32 + rg * 16;
      const h16* qp = Pbat + (size_t)(t0 + qb + col) * IWP + head * 64 + q4 * 8;
      Q[rg][0] = *(const h16x8*)qp;
      Q[rg][1] = *(const h16x8*)(qp + 32);
      tq[rg] = t0 + qb + col;
    }
    f32x4 O[2][4];
    ColState st[2];
#pragma unroll
    for (int rg = 0; rg < 2; ++rg) {
#pragma unroll
      for (int nt = 0; nt < 4; ++nt) O[rg][nt] = f32x4{0.f, 0.f, 0.f, 0.f};
      st[rg].m = -1e30f; st[rg].l = 0.f;
    }
    const int i0 = t0 >= 128 ? 0 : (t0 >= 64 ? 1 : 2);
    h16x8 rk[2], rv[2];
    {
      int sb = t0 - 128 + i0 * 64;
      for (int h2 = 0; h2 < 2; ++h2) {
        rk[h2] = ld_row8(Pbat + 256 + h2 * 64, IWP, sb + srow, SEQ, c8);
        rv[h2] = ld_row8(Pbat + 384 + h2 * 64, IWP, sb + srow, SEQ, c8);
      }
    }
    for (int i = i0; i < 3; ++i) {
      __syncthreads();
      for (int h2 = 0; h2 < 2; ++h2) {
        st_k(KV + h2 * 64 * KP, srow, c8, rk[h2]);
        st_k(KV + (2 + h2) * 64 * KP, srow, c8, rv[h2]);
      }
      __syncthreads();
      if (i + 1 < 3) {
        int sb = t0 - 128 + (i + 1) * 64;
        for (int h2 = 0; h2 < 2; ++h2) {
          rk[h2] = ld_row8(Pbat + 256 + h2 * 64, IWP, sb + srow, SEQ, c8);
          rv[h2] = ld_row8(Pbat + 384 + h2 * 64, IWP, sb + srow, SEQ, c8);
        }
      }
      const int kb = t0 - 128 + i * 64;
      attn_tile<M_SWA, 3>(Q, O, st, KV + kvh * 64 * KP, KV + (2 + kvh) * 64 * KP, biasT, tq, head, kb, false, nosel, hpd, hpe, lane);
    }
    __syncthreads();
#pragma unroll
    for (int rg = 0; rg < 2; ++rg) {
      const int qb = (w & 1) * 32 + rg * 16;
      const float lsum = sum4q(st[rg].l);
      const float mn = fmaxf(st[rg].m, sink);
      const float corr = __builtin_amdgcn_exp2f(st[rg].m - mn);
      const float inv = corr / (lsum * corr + __builtin_amdgcn_exp2f(sink - mn));
      float ss = 0.f;
#pragma unroll
      for (int nt = 0; nt < 4; ++nt) {
        O[rg][nt] *= inv;
#pragma unroll
        for (int j = 0; j < 4; ++j) ss += O[rg][nt][j] * O[rg][nt][j];
      }
      ss = sum4q(ss);
      if (q4 == 0) nrm[head * 64 + qb + col] = ss;
    }
    __syncthreads();
#pragma unroll
    for (int rg = 0; rg < 2; ++rg) {
      const int qi = (w & 1) * 32 + rg * 16 + col;
      const float tot = nrm[qi] + nrm[64 + qi] + nrm[128 + qi] + nrm[192 + qi];
      const float sc = rsqrtf(tot * (1.f / 256.f) + EPS);
#pragma unroll
      for (int nt = 0; nt < 4; ++nt)
        *(h16x4*)(OAC + ((size_t)b * SEQ + t0 + qi) * 1024 + head * 64 + nt * 16 + q4 * 4) =
            pack4(O[rg][nt][0] * sc, O[rg][nt][1] * sc, O[rg][nt][2] * sc, O[rg][nt][3] * sc);
    }
  }
}

constexpr int LDS_NSA = LDS_BIAS + 8 * 64 * KP * 2 + NW * 4 * 128 * 4 + 32 * 16;
constexpr int PFD = 2;
__device__ __forceinline__ void phase_nsa(const Params& p, int l, char* lds, unsigned* ctr, int* slot, const int parts = 15) {
  const int tid = opaque_tid(), lane = tid & 63, w = tid >> 6, col = lane & 15, q4 = lane >> 4;
  float* biasT = (float*)lds;
  h16* KV0 = (h16*)(lds + LDS_BIAS);
  float* impw = (float*)(lds + LDS_BIAS + 8 * 64 * KP * 2) + w * 4 * 128;
  unsigned long long* selm = (unsigned long long*)(lds + LDS_BIAS + 8 * 64 * KP * 2 + NW * 4 * 128 * 4);
#define KSB(i, t) (KV0 + (((i) & 1) * 4 + (t) * 2) * 64 * KP)
#define VTB(i, t) (KV0 + (((i) & 1) * 4 + (t) * 2 + 1) * 64 * KP)
  const h16* P = (const h16*)(WS(p) + O_P);
  const int* lut = (const int*)(WS(p) + O_LUT);
  h16* OAC = (h16*)(WS(p) + O_OAC);
  __syncthreads();
  for (int i = tid; i < 3200; i += NT) biasT[i] = p.in[5][lut[i % 800] * 8 + 4 + (i / 800)] * LOG2E;
  __syncthreads();
  const int srow = tid >> 3, c8 = tid & 7;
  const int hd = col & 3, qw = col >> 2;
  float hpd[2][4], hpe[2][4];
  const bool nosel[2] = {false, false};
  for (int u = fetch_unit(ctr, slot); u < 1024; u = fetch_unit(ctr, slot)) {
    const int rnd = u >> 8, b = (u & 255) >> 6, ti = u & 63;
    const int tile = rnd == 0 ? 255 - ti : (rnd == 1 ? 128 + ti : (rnd == 2 ? 127 - ti : ti));
    const int t0 = tile * 32, cur = t0 >> 6;
    const h16* Pbat = P + (size_t)b * SEQ * IWP;
    const h16* KC = (const h16*)(WS(p) + O_KCMP) + (size_t)b * 512 * 64;
    const h16* VC = (const h16*)(WS(p) + O_VCMP) + (size_t)b * 512 * 64;
    h16x8 Q[2];
    int tq;
    {
      const h16* qp = Pbat + (size_t)(t0 + w * 4 + qw) * IWP + OFF_QC + hd * 64 + q4 * 8;
      Q[0] = *(const h16x8*)qp;
      Q[1] = *(const h16x8*)(qp + 32);
      tq = t0 + w * 4 + qw;
    }
    const h16* gp = Pbat + (size_t)tq * IWP + OFF_GC + hd * 3;
    for (int i = lane; i < 512; i += 64) impw[i] = 0.f;
    f32x4 O[4], Oc[4];
    ColState st;
    int mvmax = t0 / 16 + 1;
    if (mvmax > NCMP) mvmax = NCMP;
    const int ntc = (mvmax + 63) >> 6;
    st.m = -1e30f; st.l = 0.f;
    const int npc = (ntc + 1) >> 1;
    if (parts & 1) pair_pipeline<PFD>(npc,
      [&](int i, h16x8 (&r)[4]) { r[0] = ld_row8(KC, 64, (2 * i) * 64 + srow, 512, c8); r[2] = ld_row8(KC, 64, (2 * i + 1) * 64 + srow, 512, c8); },
      [&](int i, const h16x8 (&r)[4]) { st_k(KSB(i, 0), srow, c8, r[0]); st_k(KSB(i, 1), srow, c8, r[2]); },
      [&](int i) {
        const bool far[2] = {t0 - 31 - 16 * (2 * i * 64 + 63) >= 799, t0 - 31 - 16 * ((2 * i + 1) * 64 + 63) >= 799};
        if (2 * i + 1 < ntc) attn_tile2<M_CMPA, 3>(Q, O, st, KSB(i, 0), VTB(i, 0), KSB(i, 1), VTB(i, 1), biasT, tq, hd, 2 * i * 64, far, nosel, hpd, hpe, lane);
        else attn_tile2<M_CMPA, 1>(Q, O, st, KSB(i, 0), VTB(i, 0), KSB(i, 1), VTB(i, 1), biasT, tq, hd, 2 * i * 64, far, nosel, hpd, hpe, lane);
      });
    {
      const float ls = sum4q(st.l);
      st.l = ls > 0.f ? 1.f / ls : 0.f;
    }
#pragma unroll
    for (int nt = 0; nt < 4; ++nt) O[nt] = f32x4{0.f, 0.f, 0.f, 0.f};
    float carry = 0.f;
    if (parts & 1) pair_pipeline<PFD>(npc,
      [&](int i, h16x8 (&r)[4]) {
        r[0] = ld_row8(KC, 64, (2 * i) * 64 + srow, 512, c8); r[1] = ld_row8(VC, 64, (2 * i) * 64 + srow, 512, c8);
        r[2] = ld_row8(KC, 64, (2 * i + 1) * 64 + srow, 512, c8); r[3] = ld_row8(VC, 64, (2 * i + 1) * 64 + srow, 512, c8); },
      [&](int i, const h16x8 (&r)[4]) {
        st_k(KSB(i, 0), srow, c8, r[0]); st_k(VTB(i, 0), srow, c8, r[1]); st_k(KSB(i, 1), srow, c8, r[2]); st_k(VTB(i, 1), srow, c8, r[3]); },
      [&](int i) {
        float hq[2][4], h3[2][4];
        const bool far[2] = {t0 - 31 - 16 * (2 * i * 64 + 63) >= 799, t0 - 31 - 16 * ((2 * i + 1) * 64 + 63) >= 799};
        const bool two = 2 * i + 1 < ntc;
        if (two) attn_tile2<M_CMPB, 3>(Q, O, st, KSB(i, 0), VTB(i, 0), KSB(i, 1), VTB(i, 1), biasT, tq, hd, 2 * i * 64, far, nosel, hq, h3, lane);
        else attn_tile2<M_CMPB, 1>(Q, O, st, KSB(i, 0), VTB(i, 0), KSB(i, 1), VTB(i, 1), biasT, tq, hd, 2 * i * 64, far, nosel, hq, h3, lane);
        float t3p = carry;
#pragma unroll
        for (int t = 0; t < 2; ++t) {
          if (t == 1 && !two) break;
#pragma unroll
          for (int kt = 0; kt < 4; ++kt) {
            const float qs = quadsum(hq[t][kt]);
            const float t3 = quadsum(h3[t][kt]);
            const float up = __shfl(t3, (lane + 48) & 63);
            const float wrp = __shfl(t3p, (lane + 48) & 63);
            const float pk = (q4 == 0) ? wrp : up;
            if (hd == 0) impw[qw * 128 + (2 * i + t) * 16 + kt * 4 + q4] = qs + pk;
            t3p = t3;
          }
        }
        carry = t3p;
      });
    {
      const float g0 = (float)gp[0];
#pragma unroll
      for (int nt = 0; nt < 4; ++nt) Oc[nt] = O[nt] * g0;
    }
    if (parts & 2) {
      const int nforced = cur >= 2 ? 3 : cur + 1;
      const int npick = 16 - nforced;
      for (int qi = 0; qi < 4; ++qi) {
        const float* im = impw + qi * 128;
        const int j0 = lane, j1 = lane + 64;
        const float v0 = im[j0], v1 = im[j1];
        int r0 = 0, r1 = 0;
#pragma unroll 8
        for (int jp = 1; jp <= cur - 2; ++jp) {
          float vp = im[jp];
          r0 += (vp > v0 || (vp == v0 && jp < j0)) ? 1 : 0;
          r1 += (vp > v1 || (vp == v1 && jp < j1)) ? 1 : 0;
        }
        bool c0 = j0 >= 1 && j0 <= cur - 2, c1 = j1 <= cur - 2;
        bool f0 = j0 == 0 || j0 == cur || j0 == cur - 1, f1 = j1 == cur || j1 == cur - 1;
        unsigned long long mlo = __ballot(f0 || (c0 && r0 < npick));
        unsigned long long mhi = __ballot(f1 || (c1 && r1 < npick));
        if (lane == 0) { selm[(w * 4 + qi) * 2] = mlo; selm[(w * 4 + qi) * 2 + 1] = mhi; }
      }
    }
    asm volatile("" ::: "memory");
    const unsigned long long slo = selm[(w * 4 + qw) * 2], shi = selm[(w * 4 + qw) * 2 + 1];
#pragma unroll
    for (int nt = 0; nt < 4; ++nt) O[nt] = f32x4{0.f, 0.f, 0.f, 0.f};
    st.m = -1e30f; st.l = 0.f;
    if (parts & 4) pair_pipeline<PFD>((cur + 2) >> 1,
      [&](int i, h16x8 (&r)[4]) {
        r[0] = ld_row8(Pbat + OFF_KVC + 128, IWP, (2 * i) * 64 + srow, SEQ, c8); r[1] = ld_row8(Pbat + OFF_KVC + 192, IWP, (2 * i) * 64 + srow, SEQ, c8);
        r[2] = ld_row8(Pbat + OFF_KVC + 128, IWP, (2 * i + 1) * 64 + srow, SEQ, c8); r[3] = ld_row8(Pbat + OFF_KVC + 192, IWP, (2 * i + 1) * 64 + srow, SEQ, c8); },
      [&](int i, const h16x8 (&r)[4]) {
        st_k(KSB(i, 0), srow, c8, r[0]); st_k(VTB(i, 0), srow, c8, r[1]); st_k(KSB(i, 1), srow, c8, r[2]); st_k(VTB(i, 1), srow, c8, r[3]); },
      [&](int i) {
        const int jb = 2 * i;
        bool sb[2];
        sb[0] = ((jb < 64 ? (slo >> jb) : (shi >> (jb - 64))) & 1ull) != 0;
        sb[1] = (jb + 1 <= cur) && (((jb + 1 < 64 ? (slo >> (jb + 1)) : (shi >> (jb + 1 - 64))) & 1ull) != 0);
        const bool far[2] = {t0 - (jb * 64 + 63) >= 799, t0 - (jb * 64 + 127) >= 799};
        const bool n0 = __any(sb[0]) != 0, n1 = __any(sb[1]) != 0;
        if (n0 && n1) attn_tile2<M_SEL, 3>(Q, O, st, KSB(i, 0), VTB(i, 0), KSB(i, 1), VTB(i, 1), biasT, tq, hd, jb * 64, far, sb, hpd, hpe, lane);
        else if (n0) attn_tile2<M_SEL, 1>(Q, O, st, KSB(i, 0), VTB(i, 0), KSB(i, 1), VTB(i, 1), biasT, tq, hd, jb * 64, far, sb, hpd, hpe, lane);
        else if (n1) attn_tile2<M_SEL, 2>(Q, O, st, KSB(i, 0), VTB(i, 0), KSB(i, 1), VTB(i, 1), biasT, tq, hd, jb * 64, far, sb, hpd, hpe, lane);
      });
    {
      const float ls = sum4q(st.l);
      const float f = ls > 0.f ? (float)gp[1] / ls : 0.f;
#pragma unroll
      for (int nt = 0; nt < 4; ++nt) Oc[nt] += O[nt] * f;
    }
#pragma unroll
    for (int nt = 0; nt < 4; ++nt) O[nt] = f32x4{0.f, 0.f, 0.f, 0.f};
    st.m = -1e30f; st.l = 0.f;
    const int w0 = cur >= 8 ? cur - 8 : 0;
    const int nwt = cur - w0 + 1;
    if (parts & 8) pair_pipeline<PFD>((nwt + 1) >> 1,
      [&](int i, h16x8 (&r)[4]) {
        r[0] = ld_row8(Pbat + OFF_KVC + 256, IWP, (w0 + 2 * i) * 64 + srow, SEQ, c8); r[1] = ld_row8(Pbat + OFF_KVC + 320, IWP, (w0 + 2 * i) * 64 + srow, SEQ, c8);
        r[2] = ld_row8(Pbat + OFF_KVC + 256, IWP, (w0 + 2 * i + 1) * 64 + srow, SEQ, c8); r[3] = ld_row8(Pbat + OFF_KVC + 320, IWP, (w0 + 2 * i + 1) * 64 + srow, SEQ, c8); },
      [&](int i, const h16x8 (&r)[4]) {
        st_k(KSB(i, 0), srow, c8, r[0]); st_k(VTB(i, 0), srow, c8, r[1]); st_k(KSB(i, 1), srow, c8, r[2]); st_k(VTB(i, 1), srow, c8, r[3]); },
      [&](int i) {
        const bool far[2] = {false, false};
        if (2 * i + 1 < nwt) attn_tile2<M_WIN, 3>(Q, O, st, KSB(i, 0), VTB(i, 0), KSB(i, 1), VTB(i, 1), biasT, tq, hd, (w0 + 2 * i) * 64, far, nosel, hpd, hpe, lane);
        else attn_tile2<M_WIN, 1>(Q, O, st, KSB(i, 0), VTB(i, 0), KSB(i, 1), VTB(i, 1), biasT, tq, hd, (w0 + 2 * i) * 64, far, nosel, hpd, hpe, lane);
      });
    {
      const float ls = sum4q(st.l);
      const float f = ls > 0.f ? (float)gp[2] / ls : 0.f;
      float ss = 0.f;
#pragma unroll
      for (int nt = 0; nt < 4; ++nt) {
        Oc[nt] += O[nt] * f;
#pragma unroll
        for (int j = 0; j < 4; ++j) ss += Oc[nt][j] * Oc[nt][j];
      }
      ss = quadsum(sum4q(ss));
      const float sc = rsqrtf(ss * (1.f / 256.f) + EPS);
#pragma unroll
      for (int nt = 0; nt < 4; ++nt)
        *(h16x4*)(OAC + ((size_t)b * SEQ + tq) * 1024 + 256 + hd * 64 + nt * 16 + q4 * 4) =
            pack4(Oc[nt][0] * sc, Oc[nt][1] * sc, Oc[nt][2] * sc, Oc[nt][3] * sc);
    }
  }
#undef KSB
#undef VTB
}

constexpr int LDS_SWA = LDS_BIAS + 4 * 64 * KP * 2 + 1024;
constexpr int lds_max(int a, int b) { return a > b ? a : b; }
constexpr int LDS_BYTES = lds_max(lds_max(LDS_NSA, SSMY_LDS), lds_max(LDS_SWA, lds_max(LDS_GEMM, lds_max(LDS_CMP, 64 * 65 * 4))));

__global__ void __launch_bounds__(NT) fwd_megakernel(Params p) {
  cg::grid_group grid = cg::this_grid();
  __shared__ __attribute__((aligned(16))) char lds[LDS_BYTES];
  __shared__ uint4 xb_words;
  __shared__ int wq_slot;
  if (threadIdx.x == 0) xb_words = make_uint4(0u, 0u, 0u, 0u);
  __syncthreads();
  (void)xcd_barrier_post((unsigned*)(WS(p) + O_BAR), (volatile LAS unsigned*)&xb_words);
#define GBAR() do { XcdBarrier _b; _b.bar = (unsigned*)(WS(p) + O_BAR); _b.x = xb_xcc_id(); _b.st = (volatile LAS unsigned*)&xb_words; xcd_barrier(_b); } while (0)
  phase0(p, (float*)lds);
  grid.sync();
  phase0b(p);
  for (int l = 0; l < DEPTH; ++l) {
    phase_gemm1(p, l, lds);
    GBAR();
    ssm_endstates(p, l, lds);
    phase_compress(p, l, lds);
    GBAR();
    {
      unsigned* q = (unsigned*)(WS(p) + O_BAR) + 3456 + l * 3 * 64;
      phase_nsa(p, l, lds, q, &wq_slot);
      ssm_outputs(p, l, lds, q + 64, &wq_slot);
      phase_swa(p, l, lds, q + 128, &wq_slot);
    }
    GBAR();
    phase_glu(p, l, lds);
    GBAR();
    phase_wout(p, l, lds);
    GBAR();
    phase_up(p, l, lds);
    GBAR();
    phase_down(p, l, lds);
    if (l + 1 < DEPTH) GBAR();
  }
}

extern "C" void kernel_launch(void* const* d_in, const int* in_sizes, int n_in, void* d_out, int out_size, void* d_ws,
                              size_t ws_size, hipStream_t stream) {
  static int grid_blocks = 0;
  if (!grid_blocks) {
    int dev = 0, cus = 0, per_cu = 0;
    (void)hipGetDevice(&dev);
    (void)hipDeviceGetAttribute(&cus, hipDeviceAttributeMultiprocessorCount, dev);
    (void)hipOccupancyMaxActiveBlocksPerMultiprocessor(&per_cu, fwd_megakernel, NT, 0);
    if (per_cu > 1) per_cu = 1;
    grid_blocks = cus * per_cu;
  }
  if (ws_size < WS_NEED) {
    fprintf(stderr, "workspace too small: %zu < %zu\n", ws_size, WS_NEED);
    return;
  }
  Params p{};
  for (int i = 0; i < 24; ++i) p.in[i] = (const float*)d_in[i];
  p.out = (float*)d_out;
  p.ws = (char*)d_ws;
  (void)hipMemsetAsync((char*)d_ws + O_BAR, 0, SZ_BAR, stream);
  void* args[] = {&p};
  hipError_t e = hipLaunchCooperativeKernel((void*)fwd_megakernel, dim3(grid_blocks), dim3(NT), args, 0, stream);
  if (e != hipSuccess) fprintf(stderr, "cooperative launch failed: %s (grid %d)\n", hipGetErrorString(e), grid_blocks);
}
```

```cpp
#include <hip/hip_runtime.h>
#include <hip/hip_cooperative_groups.h>
#include <cstdio>
namespace cg = cooperative_groups;

typedef _Float16 h16;
typedef __attribute__((ext_vector_type(8))) _Float16 h16x8;
typedef __attribute__((ext_vector_type(4))) float f32x4;

constexpr int NT = 512;
constexpr int NW = NT / 64;
constexpr int BATCH = 4, SEQ = 8192, NTOK = BATCH * SEQ, DM = 1024, DEPTH = 4, IW = 1676, IWP = 1792, DFF = 4096;
constexpr int OFF_U = 512, OFF_QC = 1024, OFF_KVC = 1280, OFF_GC = 1664;
constexpr int NCMP = 511;
constexpr float EPS = 1e-6f;

constexpr size_t SZ_WIN = (size_t)IWP * DM * 2, SZ_WGLU = (size_t)1024 * 512 * 2, SZ_WOUT = (size_t)DM * DM * 2,
                 SZ_WUP = (size_t)DFF * DM * 2, SZ_WDN = (size_t)DM * DFF * 2;
constexpr size_t O_WIN = 0;
constexpr size_t O_WGLU = O_WIN + DEPTH * SZ_WIN;
constexpr size_t O_WOUT = O_WGLU + DEPTH * SZ_WGLU;
constexpr size_t O_WUP = O_WOUT + DEPTH * SZ_WOUT;
constexpr size_t O_WDN = O_WUP + DEPTH * SZ_WUP;
constexpr size_t O_XB = O_WDN + DEPTH * SZ_WDN;
constexpr size_t O_SSQ = O_XB + (size_t)NTOK * DM * 2;
constexpr size_t O_SSQB = O_SSQ + (size_t)NTOK * 16 * 4;
constexpr size_t O_KCMP = O_SSQB + (size_t)NTOK * 16 * 4;
constexpr size_t O_VCMP = O_KCMP + (size_t)BATCH * 512 * 64 * 4;
constexpr size_t O_ABAR = O_VCMP + (size_t)BATCH * 512 * 64 * 4;
constexpr size_t O_BBAR = O_ABAR + (size_t)DEPTH * 32 * 64 * 8;
constexpr size_t O_BIAS1 = O_BBAR + (size_t)DEPTH * 32 * 64 * 16 * 8;
constexpr size_t O_LUT = O_BIAS1 + (size_t)DEPTH * 2 * 128 * 4;
constexpr size_t O_AT = O_LUT + 8192 * 4;
constexpr size_t O_KTAB = O_AT + (size_t)128 * 64 * 8;
constexpr size_t SZ_KTAB = (size_t)65 * 256 * 2;
constexpr size_t O_W1 = O_KTAB + 128 * SZ_KTAB;
constexpr size_t SZ_W13 = (size_t)128 * 1024 * 2;
constexpr size_t O_W3 = O_W1 + 128 * SZ_W13;
constexpr size_t O_W1T = O_W3 + 128 * SZ_W13;
constexpr size_t O_W2T = O_W1T + (size_t)8 * 128 * 2048 * 2;
constexpr size_t O_B1P = O_W2T + (size_t)8 * 64 * 128 * 2;
constexpr size_t O_BAR = (O_B1P + (size_t)8 * 32 * 128 * 4 + 255) / 256 * 256;
constexpr size_t SZ_BAR = 3456 * 4 + 16 * 64 * 4;
constexpr size_t O_BIG = (O_BAR + SZ_BAR + 255) / 256 * 256;
constexpr size_t O_P = O_BIG;
constexpr size_t O_Z = O_P + (size_t)NTOK * IWP * 2;
constexpr size_t O_OB = O_Z + (size_t)NTOK * 512 * 2;
constexpr size_t O_OAC = O_OB + (size_t)512 * 2;
constexpr size_t O_E = O_OB + (size_t)NTOK * 1024 * 2;
constexpr size_t O_APOW = O_E + (size_t)512 * 32 * 128 * 4;
static_assert(O_APOW + (size_t)128 * 65 * 64 * 16 <= O_BIG + (size_t)NTOK * DFF * 2, "Apow scratch must fit inside the big region");
constexpr size_t O_HID = O_BIG;
constexpr size_t WS_NEED = O_BIG + (size_t)NTOK * DFF * 2;

struct Params {
  const float* in[24];
  float* out;
  char* ws;
};

__device__ __forceinline__ char* WS(const Params& p) {
  int z;
  asm volatile("s_mov_b32 %0, 0" : "=s"(z));
  return p.ws + z;
}
__device__ __forceinline__ int fetch_unit(unsigned* ctr, int* slot) {
  __syncthreads();
  if (threadIdx.x == 0) *slot = (int)atomicAdd(ctr, 1u);
  __syncthreads();
  return *slot;
}
__device__ __forceinline__ int opaque_tid() {
  int t = threadIdx.x;
  asm volatile("" : "+v"(t));
  return t;
}
template <int CTRL>
__device__ __forceinline__ float dppf(float v) {
  return __int_as_float(__builtin_amdgcn_update_dpp(0, __float_as_int(v), CTRL, 0xF, 0xF, true));
}
__device__ __forceinline__ float sum16(float v) {
  v += dppf<0xB1>(v); v += dppf<0x4E>(v); v += dppf<0x141>(v); v += dppf<0x140>(v);
  return v;
}
__device__ __forceinline__ float max16(float v) {
  v = fmaxf(v, dppf<0xB1>(v)); v = fmaxf(v, dppf<0x4E>(v)); v = fmaxf(v, dppf<0x141>(v)); v = fmaxf(v, dppf<0x140>(v));
  return v;
}
__device__ __forceinline__ float xor16(float v) { return __int_as_float(__builtin_amdgcn_ds_swizzle(__float_as_int(v), 0x401F)); }
__device__ __forceinline__ float rdlane_c(float v, int l) { return __int_as_float(__builtin_amdgcn_readlane(__float_as_int(v), l)); }
__device__ __forceinline__ float wave_sum(float v) {
  v = sum16(v); v += xor16(v);
  return rdlane_c(v, 0) + rdlane_c(v, 32);
}
__device__ __forceinline__ float gelu_tanh(float x) {
  float u = 0.7978845608028654f * (x + 0.044715f * x * x * x);
  return 0.5f * x * (1.f + tanhf(u));
}
__device__ __forceinline__ float sigmoidf(float x) { return 1.f / (1.f + __expf(-x)); }
__device__ __forceinline__ float rdlane(float v, int l) {
  return __int_as_float(__builtin_amdgcn_readlane(__float_as_int(v), l));
}

__device__ __forceinline__ int perm32(int rho) { return 8 * ((rho & 15) >> 2) + 4 * (rho >> 4) + (rho & 3); }

template <class SrcF>
__device__ __forceinline__ void conv_tile(SrcF src, h16* dst, int ldo, int n0, int k0, float* tile) {
  int tid = opaque_tid();
  for (int idx = tid; idx < 4096; idx += NT) {
    int kk = idx >> 6, nn = idx & 63;
    tile[kk * 65 + nn] = src(k0 + kk, n0 + nn);
  }
  __syncthreads();
  for (int idx = tid; idx < 4096; idx += NT) {
    int nn = idx >> 6, kk = idx & 63;
    dst[(long)(n0 + nn) * ldo + k0 + kk] = (h16)tile[kk * 65 + nn];
  }
  __syncthreads();
}

template <class SrcF>
__device__ __forceinline__ void conv_tile_h(SrcF src, h16* dst, int ldo, int n0, int k0, float* tile, int t, bool act) {
  if (act)
    for (int idx = t; idx < 4096; idx += 256) {
      int kk = idx >> 6, nn = idx & 63;
      tile[kk * 65 + nn] = src(k0 + kk, n0 + nn);
    }
  __syncthreads();
  if (act)
    for (int idx = t; idx < 4096; idx += 256) {
      int nn = idx >> 6, kk = idx & 63;
      dst[(long)(n0 + nn) * ldo + k0 + kk] = (h16)tile[kk * 65 + nn];
    }
  __syncthreads();
}

__device__ __forceinline__ void phase0(const Params& p, float* lds) {
  const int tid = opaque_tid();
  constexpr int T_IN = (IWP / 64) * (DM / 64);
  constexpr int T_GLU = 16 * 8;
  constexpr int T_OUT = 16 * 16;
  constexpr int T_UP = 64 * 16;
  constexpr int T_DN = 16 * 64;
  constexpr int T_L = T_IN + T_GLU + T_OUT + T_UP + T_DN;
  const int hf = tid >> 8, t8 = tid & 255;
  float* ldh = lds + hf * (64 * 65 + 16);
  for (int tp = blockIdx.x; tp * 2 < DEPTH * T_L; tp += gridDim.x) {
    const int ti = tp * 2 + hf;
    const bool act = ti < DEPTH * T_L;
    int l = act ? ti / T_L : 0, r = act ? ti % T_L : 0;
    if (r < T_IN) {
      int nt = r / 16, kt = r % 16;
      const float* w = p.in[2] + (size_t)l * DM * IW;
      const float* g = p.in[1] + l * DM;
      conv_tile_h([&](int k, int sl) {
        int n = (sl & ~255) + 64 * ((sl >> 5) & 3) + 32 * ((sl >> 7) & 1) + perm32(sl & 31);
        return n < IW ? w[(long)k * IW + n] * g[k] : 0.f; },
                (h16*)(WS(p) + O_WIN + l * SZ_WIN), DM, nt * 64, kt * 64, ldh, t8, act);
    } else if ((r -= T_IN) < T_GLU) {
      int nt = r / 8, kt = r % 8;
      const float* w = p.in[14] + (size_t)l * 512 * 1024;
      conv_tile_h([&](int k, int n2) {
        int pn = n2 >> 8, bj = (n2 >> 7) & 1, wc = (n2 >> 5) & 3, nn = (n2 >> 4) & 1, r = n2 & 15;
        int n = (nn ? 512 : 0) + 128 * pn + 64 * bj + 16 * wc + r;
        return w[(long)k * 1024 + n]; },
                (h16*)(WS(p) + O_WGLU + l * SZ_WGLU), 512, nt * 64, kt * 64, ldh, t8, act);
    } else if ((r -= T_GLU) < T_OUT) {
      int nt = r / 16, kt = r % 16;
      const float* w = p.in[20] + (size_t)l * DM * DM;
      const float* g = p.in[19] + l * DM;
      conv_tile_h([&](int k2, int n2) {
        int k = k2 < 512 ? 256 + k2 : (k2 < 768 ? k2 - 512 : k2);
        int n = (n2 & ~31) + perm32(n2 & 31);
        return w[(long)k * DM + n] * g[k]; },
                (h16*)(WS(p) + O_WOUT + l * SZ_WOUT), DM, nt * 64, kt * 64, ldh, t8, act);
    } else if ((r -= T_OUT) < T_UP) {
      int nt = r / 16, kt = r % 16;
      const float* w = p.in[22] + (size_t)l * DM * DFF;
      const float* g = p.in[21] + l * DM;
      conv_tile_h([&](int k, int n2) { int n = (n2 & ~31) + perm32(n2 & 31); return w[(long)k * DFF + n] * g[k]; },
                (h16*)(WS(p) + O_WUP + l * SZ_WUP), DM, nt * 64, kt * 64, ldh, t8, act);
    } else {
      r -= T_UP;
      int nt = r / 64, kt = r % 64;
      const float* w = p.in[23] + (size_t)l * DFF * DM;
      conv_tile_h([&](int k, int n2) { int n = (n2 & ~31) + perm32(n2 & 31); return w[(long)k * DM + n]; },
                (h16*)(WS(p) + O_WDN + l * SZ_WDN), DFF, nt * 64, kt * 64, ldh, t8, act);
    }
  }
  for (int ti = blockIdx.x; ti < 8 * 66; ti += gridDim.x) {
    int ls = ti / 66, r = ti % 66;
    if (r < 64) {
      int nt = r >> 5, kt = r & 31;
      const float* w = p.in[17] + (size_t)ls * 2048 * 128;
      conv_tile([&](int k, int n) { return w[(long)k * 128 + n]; }, (h16*)(WS(p) + O_W1T) + (size_t)ls * 128 * 2048, 2048, nt * 64, kt * 64, lds);
    } else {
      int kt = r - 64;
      const float* w = p.in[18] + (size_t)ls * 128 * 64;
      conv_tile([&](int k, int n) { return w[(long)k * 64 + n]; }, (h16*)(WS(p) + O_W2T) + (size_t)ls * 64 * 128, 128, 0, kt * 64, lds);
    }
  }
  {
    const int lane = tid & 63;
    const int gw = blockIdx.x * NW + (tid >> 6), nw = gridDim.x * NW;
    const float* x = p.in[0];
    h16* xb = (h16*)(WS(p) + O_XB);
    float* ssq = (float*)(WS(p) + O_SSQ);
    for (int row = gw; row < NTOK; row += nw) {
      const float4* xr = (const float4*)(x + (long)row * DM + lane * 16);
      float s = 0.f;
      h16 hv[16];
      for (int i = 0; i < 4; ++i) {
        float4 v = xr[i];
        s += v.x * v.x + v.y * v.y + v.z * v.z + v.w * v.w;
        hv[i * 4 + 0] = (h16)v.x; hv[i * 4 + 1] = (h16)v.y; hv[i * 4 + 2] = (h16)v.z; hv[i * 4 + 3] = (h16)v.w;
      }
      h16x8* xo = (h16x8*)(xb + (long)row * DM + lane * 16);
      h16x8 o0, o1;
      for (int i = 0; i < 8; ++i) { o0[i] = hv[i]; o1[i] = hv[8 + i]; }
      xo[0] = o0; xo[1] = o1;
      s += dppf<0xB1>(s);
      s += dppf<0x4E>(s);
      if ((lane & 3) == 0) ssq[(long)row * 16 + (lane >> 2)] = s;
    }
  }
  const int gt = blockIdx.x * NT + tid, ngt = gridDim.x * NT;
  for (int i = gt; i < DEPTH * 32 * 64; i += ngt) {
    int l = i / 2048, g = (i / 64) % 32;
    double are = p.in[6][i], aim = p.in[7][i];
    double dt = exp((double)p.in[8][l * 32 + g]);
    double er = exp(are * dt), abr = er * cos(aim * dt), abi = er * sin(aim * dt);
    ((float2*)(WS(p) + O_ABAR))[i] = make_float2((float)abr, (float)abi);
    double nr = abr - 1.0, ni = abi, den = are * are + aim * aim;
    double fr = (nr * are + ni * aim) / den, fi = (ni * are - nr * aim) / den;
    float2* bb = (float2*)(WS(p) + O_BBAR) + (size_t)i * 16;
    for (int q = 0; q < 16; ++q) {
      double br = p.in[9][(size_t)i * 16 + q], bi = p.in[10][(size_t)i * 16 + q];
      bb[q] = make_float2((float)((fr * br - fi * bi) / dt), (float)((fr * bi + fi * br) / dt));
    }
  }
  for (int i = gt; i < 128 * 65 * 64; i += ngt) {
    int n = i & 63, j = (i >> 6) % 65, lg = i / (65 * 64);
    double are = p.in[6][lg * 64 + n], aim = p.in[7][lg * 64 + n];
    double dt = exp((double)p.in[8][lg]);
    double er = exp(are * dt * j), ang = aim * dt * j;
    ((double2*)(WS(p) + O_APOW))[i] = make_double2(er * cos(ang), er * sin(ang));
  }
  for (int i = gt; i < DEPTH * 2 * 128 * 32; i += ngt) {
    int j = i & 127, kc = (i >> 7) & 31, ls = i >> 12;
    const float* pos = p.in[16] + (size_t)ls * 2048 + kc * 64;
    const float* w1 = p.in[17] + ((size_t)ls * 2048 + kc * 64) * 128;
    float a = 0.f;
#pragma unroll 16
    for (int k = 0; k < 64; ++k) a += pos[k] * w1[(long)k * 128 + j];
    ((float*)(WS(p) + O_B1P))[i] = a;
  }
  for (int d = gt; d < 8192; d += ngt) {
    int bk;
    if (d < 16) bk = d;
    else {
      float nf = (float)d;
      int large = 16 + (int)(logf(nf / 16.0f) / 4.1588830833596715f * 16.0f);
      bk = large < 31 ? large : 31;
    }
    ((int*)(WS(p) + O_LUT))[d] = bk;
  }
}

__device__ __forceinline__ void phase0b(const Params& p) {
  const int gt = blockIdx.x * NT + threadIdx.x, ngt = gridDim.x * NT;
  const double2* apow = (const double2*)(WS(p) + O_APOW);
  const float2* bbs = (const float2*)(WS(p) + O_BBAR);
  for (int i = gt; i < 128 * 64 * 64; i += ngt) {
    int tau = i & 63, n = (i >> 6) & 63, lg = i >> 12;
    double2 ap = apow[(lg * 65 + (63 - tau)) * 64 + n];
    const float2* bb = bbs + (size_t)(lg * 64 + n) * 16;
    h16x8 re0, re1, im0, im1;
#pragma unroll
    for (int q = 0; q < 8; ++q) {
      float2 b0 = bb[q], b1 = bb[8 + q];
      re0[q] = (h16)(float)(ap.x * b0.x - ap.y * b0.y);
      im0[q] = (h16)(float)(ap.x * b0.y + ap.y * b0.x);
      re1[q] = (h16)(float)(ap.x * b1.x - ap.y * b1.y);
      im1[q] = (h16)(float)(ap.x * b1.y + ap.y * b1.x);
    }
    h16* W1 = (h16*)(WS(p) + O_W1 + (size_t)lg * SZ_W13);
    *(h16x8*)(W1 + ((size_t)(2 * tau) * 128 + 2 * n) * 8) = re0;
    *(h16x8*)(W1 + ((size_t)(2 * tau) * 128 + 2 * n + 1) * 8) = im0;
    *(h16x8*)(W1 + ((size_t)(2 * tau + 1) * 128 + 2 * n) * 8) = re1;
    *(h16x8*)(W1 + ((size_t)(2 * tau + 1) * 128 + 2 * n + 1) * 8) = im1;
  }
  for (int i = gt; i < 128 * 64 * 16 * 16; i += ngt) {
    int pp = i & 15, kc = (i >> 4) & 15, tau = (i >> 8) & 63, lg = i >> 14;
    h16x8 v;
#pragma unroll
    for (int e = 0; e < 4; ++e) {
      int n = 4 * kc + e;
      double2 ap = apow[(lg * 65 + tau + 1) * 64 + n];
      double cr = p.in[11][((size_t)lg * 16 + pp) * 64 + n], ci = p.in[12][((size_t)lg * 16 + pp) * 64 + n];
      v[2 * e] = (h16)(float)(cr * ap.x - ci * ap.y);
      v[2 * e + 1] = (h16)(float)(-(cr * ap.y + ci * ap.x));
    }
    h16* W3 = (h16*)(WS(p) + O_W3 + (size_t)lg * SZ_W13);
    *(h16x8*)(W3 + ((size_t)((tau * 16 + kc) * 16) + pp) * 8) = v;
  }
  for (int i = gt; i < 128 * 65 * 16; i += ngt) {
    int pp = i & 15, slot = (i >> 4) % 65, lg = i / (65 * 16);
    float acc[16];
#pragma unroll
    for (int q = 0; q < 16; ++q) acc[q] = 0.f;
    if (slot > 0) {
#pragma unroll 4
      for (int n = 0; n < 64; ++n) {
        double2 ap = apow[(lg * 65 + slot - 1) * 64 + n];
        double cr = p.in[11][((size_t)lg * 16 + pp) * 64 + n], ci = p.in[12][((size_t)lg * 16 + pp) * 64 + n];
        float xr = (float)(cr * ap.x - ci * ap.y), xi = (float)(cr * ap.y + ci * ap.x);
        const float2* bb = bbs + (size_t)(lg * 64 + n) * 16;
#pragma unroll
        for (int q = 0; q < 16; ++q) { float2 b = bb[q]; acc[q] += xr * b.x - xi * b.y; }
      }
    }
    h16x8 v0, v1;
#pragma unroll
    for (int q = 0; q < 8; ++q) { v0[q] = (h16)acc[q]; v1[q] = (h16)acc[8 + q]; }
    h16* kt = (h16*)(WS(p) + O_KTAB + (size_t)lg * SZ_KTAB) + slot * 256 + pp * 16;
    *(h16x8*)kt = v0;
    *(h16x8*)(kt + 8) = v1;
  }
  for (int i = gt; i < 128 * 64; i += ngt) {
    double2 ap = apow[((i >> 6) * 65 + 64) * 64 + (i & 63)];
    ((float2*)(WS(p) + O_AT))[i] = make_float2((float)ap.x, (float)ap.y);
  }
  for (int i = gt; i < DEPTH * 2 * 128; i += ngt) {
    const float* pp = (const float*)(WS(p) + O_B1P) + (size_t)(i >> 7) * 32 * 128 + (i & 127);
    float a = 0.f;
    for (int kc = 0; kc < 32; ++kc) a += pp[kc * 128];
    ((float*)(WS(p) + O_BIAS1))[i] = a;
  }
}

__device__ __forceinline__ void ssm_endstates(const Params& p, int l, char* lds) {
  const int tid = opaque_tid(), lane = tid & 63, w = tid >> 6;
  const h16* P = (const h16*)(WS(p) + O_P);
  float* E = (float*)(WS(p) + O_E);
  f32x4* red = (f32x4*)lds;
  for (int ub4 = blockIdx.x; ub4 < 256; ub4 += gridDim.x) {
    const int unit = ub4 * 4 + (w & 3), kh = w >> 2;
    const int g = unit >> 5, ctile = unit & 31;
    const h16* W1 = (const h16*)(WS(p) + O_W1 + (size_t)(l * 32 + g) * SZ_W13);
    const int gch = ctile * 16 + (lane & 15);
    const h16* ub = P + (size_t)gch * 64 * IWP + OFF_U + g * 16 + ((lane >> 4) & 1) * 8 + (size_t)(lane >> 5) * IWP;
    f32x4 acc[8];
#pragma unroll
    for (int mt = 0; mt < 8; ++mt) acc[mt] = f32x4{0.f, 0.f, 0.f, 0.f};
#pragma unroll 4
    for (int kk = 0; kk < 16; ++kk) {
      const int ks = kh * 16 + kk;
      h16x8 B = *(const h16x8*)(ub + (size_t)(ks * 2) * IWP);
#pragma unroll
      for (int mt = 0; mt < 8; ++mt) {
        h16x8 A = *(const h16x8*)(W1 + ((size_t)(ks * 4 + (lane >> 4)) * 128 + mt * 16 + (lane & 15)) * 8);
        acc[mt] = __builtin_amdgcn_mfma_f32_16x16x32_f16(A, B, acc[mt], 0, 0, 0);
      }
    }
    __syncthreads();
    if (kh == 1) {
#pragma unroll
      for (int mt = 0; mt < 8; ++mt) red[((w & 3) * 8 + mt) * 64 + lane] = acc[mt];
    }
    __syncthreads();
    if (kh == 0) {
#pragma unroll
      for (int mt = 0; mt < 8; ++mt)
        *(f32x4*)(E + ((size_t)gch * 32 + g) * 128 + mt * 16 + (lane >> 4) * 4) = acc[mt] + red[((w & 3) * 8 + mt) * 64 + lane];
    }
  }
}

constexpr int BU_PITCH = 1040, BS_PITCH = 144;
constexpr int SSMY_LDS = 65 * 512 + 16 * BU_PITCH * 2 + 16 * BS_PITCH * 2 + 128 * 64 * 8;
__device__ __forceinline__ void ssm_outputs(const Params& p, int l, char* lds, unsigned* ctr, int* slot) {
  const int tid = opaque_tid(), lane = tid & 63, w = tid >> 6;
  h16* Kt = (h16*)lds;
  h16* Bu = (h16*)(lds + 65 * 512);
  h16* Bs = (h16*)(lds + 65 * 512 + 16 * BU_PITCH * 2);
  float2* Es = (float2*)(lds + 65 * 512 + 16 * BU_PITCH * 2 + 16 * BS_PITCH * 2);
  const h16* P = (const h16*)(WS(p) + O_P);
  const float* E = (const float*)(WS(p) + O_E);
  h16* Z = (h16*)(WS(p) + O_Z);
  for (int unit = fetch_unit(ctr, slot); unit < 1024; unit = fetch_unit(ctr, slot)) {
    const int g = unit & 31, bc = unit >> 5, b = bc >> 3, ct = bc & 7;
    const int lg = l * 32 + g;
    __syncthreads();
    const int c0 = ct * 16;
    {
      const h16x8* ks = (const h16x8*)(WS(p) + O_KTAB + (size_t)lg * SZ_KTAB);
      for (int i = tid; i < 65 * 32; i += NT) ((h16x8*)Kt)[i] = ks[i];
      for (int i = tid; i < 2048; i += NT) {
        int tk = i >> 1, hf = i & 1;
        h16x8 v = *(const h16x8*)(P + ((size_t)b * SEQ + ct * 1024 + tk) * IWP + OFF_U + g * 16 + hf * 8);
        *(h16x8*)(Bu + (tk >> 6) * BU_PITCH + (tk & 63) * 16 + hf * 8) = v;
      }
      const float2* Eb = (const float2*)E + ((size_t)(b * 128) * 32 + g) * 64;
      for (int i = tid; i < (c0 + 16) * 64; i += NT) Es[i] = Eb[(size_t)(i >> 6) * 2048 + (i & 63)];
    }
    __syncthreads();
    if (w == 0) {
      float2 at = ((const float2*)(WS(p) + O_AT))[lg * 64 + lane];
      float sr = 0.f, si = 0.f;
#pragma unroll 8
      for (int c = 0; c < c0; ++c) {
        float2 e = Es[c * 64 + lane];
        float nr = at.x * sr - at.y * si + e.x, ni = at.x * si + at.y * sr + e.y;
        sr = nr; si = ni;
      }
#pragma unroll
      for (int i = 0; i < 16; ++i) {
        Bs[i * BS_PITCH + 2 * lane] = (h16)sr;
        Bs[i * BS_PITCH + 2 * lane + 1] = (h16)si;
        float2 e = Es[(c0 + i) * 64 + lane];
        float nr = at.x * sr - at.y * si + e.x, ni = at.x * si + at.y * sr + e.y;
        sr = nr; si = ni;
      }
    }
    __syncthreads();
    const float dt = expf(p.in[8][lg]);
    const int col = lane & 15, hi = lane >> 5, qh = (lane >> 4) & 1, p0 = (lane >> 4) * 4;
    const h16* W3 = (const h16*)(WS(p) + O_W3 + (size_t)lg * SZ_W13);
    float dsk[4];
    for (int j = 0; j < 4; ++j) dsk[j] = p.in[13][l * 512 + g * 16 + p0 + j];
    for (int r = 0; r < 64 / NW; ++r) {
      const int base = (r >> 1) * 2 * NW;
      const int tau = (r & 1) ? base + 2 * NW - 1 - w : base + w;
      f32x4 acc = {0.f, 0.f, 0.f, 0.f};
      const int nks = tau / 2 + 1;
      h16x8 A3[4];
#pragma unroll
      for (int ks = 0; ks < 4; ++ks)
        A3[ks] = *(const h16x8*)(W3 + ((size_t)((tau * 16 + ks * 4 + (lane >> 4)) * 16) + (lane & 15)) * 8);
      for (int i = 0; i < nks; ++i) {
        int j = tau - (2 * i + hi);
        h16x8 A = *(const h16x8*)(Kt + (j + 1) * 256 + (lane & 15) * 16 + qh * 8);
        h16x8 B = *(const h16x8*)(Bu + col * BU_PITCH + (2 * i + hi) * 16 + qh * 8);
        acc = __builtin_amdgcn_mfma_f32_16x16x32_f16(A, B, acc, 0, 0, 0);
      }
#pragma unroll
      for (int ks = 0; ks < 4; ++ks) {
        h16x8 B = *(const h16x8*)(Bs + col * BS_PITCH + ks * 32 + (lane >> 4) * 8);
        acc = __builtin_amdgcn_mfma_f32_16x16x32_f16(A3[ks], B, acc, 0, 0, 0);
      }
      const h16* up = Bu + col * BU_PITCH + tau * 16 + p0;
      size_t tok = ((size_t)b * 128 + ct * 16 + col) * 64 + tau;
      h16 zz[4];
      for (int j = 0; j < 4; ++j) zz[j] = (h16)gelu_tanh(dt * acc[j] + dsk[j] * (float)up[j]);
      typedef __attribute__((ext_vector_type(4))) _Float16 h16x4;
      h16x4 zv = {zz[0], zz[1], zz[2], zz[3]};
      *(h16x4*)(Z + tok * 512 + g * 16 + p0) = zv;
    }
  }
}

#define LAS __attribute__((address_space(3)))
typedef _Float16 h16x4 __attribute__((ext_vector_type(4)));
#define XB_TMO      128
#define XB_XCNT(j)  (256  + 64 * (j))
#define XB_XSUB(j)  (1280 + 64 * (j))
#define XB_XGEN(j)  (2304 + 64 * (j))
#define XB_TOP      3328
#define XB_TOPGEN   3392
#define XCD_BAR_WORDS 3456
#define XB_SPIN_CAP (1u << 18)

__device__ __forceinline__ unsigned xb_ld(unsigned* p)              { return __hip_atomic_load(p, __ATOMIC_RELAXED, __HIP_MEMORY_SCOPE_AGENT); }
__device__ __forceinline__ unsigned xb_add(unsigned* p, unsigned v) { return __hip_atomic_fetch_add(p, v, __ATOMIC_RELAXED, __HIP_MEMORY_SCOPE_AGENT); }
__device__ __forceinline__ unsigned xb_xcc_id() { return (unsigned)__builtin_amdgcn_s_getreg((3 << 11) | 20) & 0xFu; }
#define XB_SPIN(cond, bar) do { unsigned _sp = 0; while (cond) { __builtin_amdgcn_s_sleep(1); \
    if ((++_sp & 255u) == 0u) { if (xb_ld(&(bar)[XB_TMO])) break; if (_sp > XB_SPIN_CAP) { atomicAdd(&(bar)[XB_TMO], 1u); break; } } } } while (0)

struct XcdBarrier {
    unsigned* bar; unsigned x;
    volatile LAS unsigned* st;
};

__device__ __forceinline__ XcdBarrier xcd_barrier_post(unsigned* bar, volatile LAS unsigned* st) {
    XcdBarrier b; b.bar = bar; b.x = xb_xcc_id(); b.st = st;
    if (threadIdx.x == 0) (void)xb_add(&bar[XB_XCNT(b.x)], 1u);
    return b;
}
__device__ __forceinline__ void xcd_barrier_complete(unsigned* bar, unsigned x, unsigned& nloc, unsigned& nx) {
    const unsigned G = gridDim.x * gridDim.y * gridDim.z;
    unsigned sum, cnt, mine, sp = 0u;
    for (;;) {
        sum = 0u; cnt = 0u; mine = 0u;
#pragma unroll
        for (unsigned j = 0; j < 16; ++j) { const unsigned c = xb_ld(&bar[XB_XCNT(j)]); sum += c; cnt += (c > 0u) ? 1u : 0u; mine = (j == x) ? c : mine; }
        if (sum == G) break;
        __builtin_amdgcn_s_sleep(1);
        if ((++sp & 255u) == 0u) { if (xb_ld(&bar[XB_TMO])) break; if (sp > XB_SPIN_CAP) { atomicAdd(&bar[XB_TMO], 1u); break; } }
    }
    nloc = mine > 0u ? mine : 1u; nx = cnt > 0u ? cnt : 1u;
}

__device__ __forceinline__ void xcd_barrier(const XcdBarrier& b) {
    asm volatile("s_waitcnt vmcnt(0)" ::: "memory");
    __syncthreads();
    if (threadIdx.x == 0) {
        unsigned* bar = b.bar;
        __builtin_amdgcn_s_waitcnt(0);
        unsigned nloc = b.st[0], nx = b.st[1];
        if (nloc == 0u) { xcd_barrier_complete(bar, b.x, nloc, nx); b.st[0] = nloc; b.st[1] = nx; }
        const unsigned old = xb_add(&bar[XB_XSUB(b.x)], 1u);
        const unsigned gen = old / nloc;
        if (old + 1u == (gen + 1u) * nloc) {
            __builtin_amdgcn_fence(__ATOMIC_RELEASE, "agent");
            asm volatile("s_waitcnt vmcnt(0)" ::: "memory");
            const unsigned og = xb_add(&bar[XB_TOP], 1u);
            const unsigned tg = og / nx;
            if (og + 1u == (tg + 1u) * nx) xb_add(&bar[XB_TOPGEN], 1u);
            else XB_SPIN(xb_ld(&bar[XB_TOPGEN]) == tg, bar);
            __builtin_amdgcn_fence(__ATOMIC_ACQUIRE, "agent");
            xb_add(&bar[XB_XGEN(b.x)], 1u);
            asm volatile("s_waitcnt vmcnt(0)" ::: "memory");
        } else {
            XB_SPIN(xb_ld(&bar[XB_XGEN(b.x)]) == gen, bar);
            __builtin_amdgcn_fence(__ATOMIC_ACQUIRE, "agent");
            asm volatile("s_waitcnt vmcnt(0)" ::: "memory");
        }
    }
    __syncthreads();
}


namespace g8 {
constexpr int BM = 256, BK = 64, HALF = 128, HTB = HALF * BK * 2, STAGE_BYTES = 8 * HTB, NXCD = 8, WGM = 8;
__device__ __forceinline__ int lds_byte(int r, int c) {
  const int st = (r >> 4) * 2 + (c >> 5), rr = r & 15, cc = c & 31, ob = rr * 64 + cc * 2;
  return st * 1024 + (ob ^ (((ob >> 9) & 1) << 5));
}
__device__ __forceinline__ void stage_rc(int b, int& R, int& C) {
  const int st = b / 1024, sb = b % 1024, swz = sb ^ (((sb >> 9) & 1) << 5);
  R = (st >> 1) * 16 + swz / 64;
  C = (st & 1) * 32 + (swz % 64) / 2;
}
struct Unit { int pm, pn; };
struct Order {
  int nM, nN, nwg, G, c;
  __device__ void init(int M, int N, int G_, int c_) { nM = M / BM; nN = N / BM; nwg = nM * nN; G = G_; c = c_; }
  __device__ bool next(int i, Unit& u) const {
    const long L = (long)i * G + c;
    if (L >= nwg) return false;
    int wgid = (int)L;
    { const int q = nwg / NXCD, r = nwg % NXCD, xcd = wgid % NXCD, off = wgid / NXCD; wgid = (xcd < r ? xcd * (q + 1) : r * (q + 1) + (xcd - r) * q) + off; }
    const int nig = WGM * nN, gid = wgid / nig, fm = gid * WGM, gsz = (nM - fm) < WGM ? (nM - fm) : WGM;
    u.pm = fm + ((wgid % nig) % gsz);
    u.pn = (wgid % nig) / gsz;
    return true;
  }
};
template <class Epi>
__device__ __forceinline__ void gemm_phase(LAS unsigned char* lds, const h16* A, const h16* Bt, int K, const Order& S, const Epi& E) {
  const int tid = opaque_tid(), wid = __builtin_amdgcn_readfirstlane(tid >> 6), lane = tid & 63, wr = wid >> 2, wc = wid & 3, fr = lane & 15, fq = lane >> 4;
  const int nt = K / BK;
  unsigned voffA[2];
#pragma unroll
  for (int i = 0; i < 2; ++i) { int R, C; stage_rc(tid * 16 + i * 8192, R, C); voffA[i] = (unsigned)(R * K + C) * 2u; }
  const size_t kstep = (size_t)(BK * 2);
  const size_t hstep = (size_t)HALF * K * 2;
  const size_t tstep = 2 * hstep;
  const unsigned ldsw = (unsigned)wid * 1024u;
  const int aoff = lds_byte(wr * 64 + fr, fq * 8), boff = lds_byte(wc * 32 + fr, fq * 8);
#define G8_SA(b, h) (((b) * 2 + (h)) * HTB)
#define G8_SB(b, h) ((4 + (b) * 2 + (h)) * HTB)
#define G8_STAGE(bufoff, gbase) do { _Pragma("unroll") for (int _i = 0; _i < 2; ++_i) \
    __builtin_amdgcn_global_load_lds((const unsigned*)((const char*)(gbase) + voffA[_i]), (LAS unsigned*)(lds + (bufoff) + ldsw + _i * 8192), 16, 0, 0); } while (0)
#define G8_LDA(dst, b, h) do { _Pragma("unroll") for (int m = 0; m < 4; ++m) _Pragma("unroll") for (int k = 0; k < 2; ++k) dst[m][k] = *(const LAS h16x8*)(lds + G8_SA(b, h) + aoff + m * 2048 + k * 1024); } while (0)
#define G8_LDB(dst, b, h) do { _Pragma("unroll") for (int n = 0; n < 2; ++n) _Pragma("unroll") for (int k = 0; k < 2; ++k) dst[n][k] = *(const LAS h16x8*)(lds + G8_SB(b, h) + boff + n * 2048 + k * 1024); } while (0)
#define G8_MMA(ai, bj, At, Bt_) do { __builtin_amdgcn_s_setprio(1); _Pragma("unroll") for (int m = 0; m < 4; ++m) _Pragma("unroll") for (int n = 0; n < 2; ++n) _Pragma("unroll") for (int k = 0; k < 2; ++k) \
    acc[ai][bj][m][n] = __builtin_amdgcn_mfma_f32_16x16x32_f16(Bt_[n][k], At[m][k], acc[ai][bj][m][n], 0, 0, 0); __builtin_amdgcn_s_setprio(0); } while (0)
#define G8_WAIT_V(n) asm volatile("s_waitcnt vmcnt(" #n ")" ::: "memory")
#define G8_WAIT_L(n) asm volatile("s_waitcnt lgkmcnt(" #n ")" ::: "memory")
#define G8_BAR __builtin_amdgcn_s_barrier()
#define G8_SCHED __builtin_amdgcn_sched_barrier(0)
  Unit cur, nxt;
  int ui = 0;
  if (!S.next(0, cur)) return;
  f32x4 acc[2][2][4][2];
#pragma unroll
  for (int a = 0; a < 2; ++a)
#pragma unroll
    for (int b = 0; b < 2; ++b)
#pragma unroll
      for (int m = 0; m < 4; ++m)
#pragma unroll
        for (int n = 0; n < 2; ++n) acc[a][b][m][n] = (f32x4){0.f, 0.f, 0.f, 0.f};
  h16x8 At[4][2], B0[2][2], B1[2][2];
  const char* cA = (const char*)A + (size_t)cur.pm * tstep;
  const char* cB = (const char*)Bt + (size_t)cur.pn * tstep;
  G8_STAGE(G8_SB(0, 0), cB); G8_STAGE(G8_SA(0, 0), cA); G8_STAGE(G8_SB(0, 1), cB + hstep); G8_STAGE(G8_SA(0, 1), cA + hstep);
  if (wr == 1) G8_BAR;
  G8_WAIT_V(4); G8_BAR;
  G8_STAGE(G8_SB(1, 0), cB + kstep); G8_STAGE(G8_SA(1, 0), cA + kstep); G8_STAGE(G8_SB(1, 1), cB + hstep + kstep);
  G8_WAIT_V(6); G8_BAR;
  for (;;) {
    const bool has_next = S.next(ui + 1, nxt);
    const char* nA = has_next ? (const char*)A + (size_t)nxt.pm * tstep : cA;
    const char* nB = has_next ? (const char*)Bt + (size_t)nxt.pn * tstep : cB;
    for (int t = 0; t < nt; t += 2) {
      const bool last = (t == nt - 2);
      const char* a1 = cA + (size_t)(t + 1) * kstep;
      const char* a2 = last ? nA : cA + (size_t)(t + 2) * kstep;
      const char* b2 = last ? nB : cB + (size_t)(t + 2) * kstep;
      const char* a3 = a2 + kstep;
      const char* b3 = b2 + kstep;
      if (Epi::MID_T >= 0 && t == Epi::MID_T) E.mid(acc, ui, wr, fr);
      G8_LDB(B0, 0, 0); G8_SCHED; G8_LDA(At, 0, 0); G8_STAGE(G8_SA(1, 1), a1 + hstep);
      G8_WAIT_L(8); G8_BAR; G8_WAIT_L(0); G8_MMA(0, 0, At, B0); G8_BAR; G8_SCHED;
      G8_LDB(B1, 0, 1); G8_STAGE(G8_SB(0, 0), b2);
      G8_BAR; G8_WAIT_L(0); G8_MMA(0, 1, At, B1); G8_BAR;
      G8_LDA(At, 0, 1); G8_STAGE(G8_SA(0, 0), a2);
      G8_BAR; G8_WAIT_L(0); G8_MMA(1, 0, At, B0); G8_BAR; G8_SCHED;
      G8_STAGE(G8_SB(0, 1), b2 + hstep);
      G8_WAIT_V(6); G8_BAR; G8_MMA(1, 1, At, B1); G8_BAR;
      G8_LDB(B0, 1, 0); G8_SCHED; G8_LDA(At, 1, 0); G8_STAGE(G8_SA(0, 1), a2 + hstep);
      G8_WAIT_L(8); G8_BAR; G8_WAIT_L(0); G8_MMA(0, 0, At, B0); G8_BAR; G8_SCHED;
      G8_LDB(B1, 1, 1); G8_STAGE(G8_SB(1, 0), b3);
      G8_BAR; G8_WAIT_L(0); G8_MMA(0, 1, At, B1); G8_BAR;
      G8_LDA(At, 1, 1); G8_STAGE(G8_SA(1, 0), a3);
      G8_BAR; G8_WAIT_L(0); G8_MMA(1, 0, At, B0); G8_BAR; G8_SCHED;
      G8_STAGE(G8_SB(1, 1), b3 + hstep);
      G8_WAIT_V(6); G8_BAR; G8_MMA(1, 1, At, B1); G8_BAR;
    }
    E(acc, cur, ui, wr, wc, fr, fq);
    if (!has_next) break;
#pragma unroll
    for (int a = 0; a < 2; ++a)
#pragma unroll
      for (int b = 0; b < 2; ++b)
#pragma unroll
        for (int m = 0; m < 4; ++m)
#pragma unroll
          for (int n = 0; n < 2; ++n) acc[a][b][m][n] = (f32x4){0.f, 0.f, 0.f, 0.f};
    cur = nxt; cA = nA; cB = nB; ++ui;
  }
  G8_WAIT_V(0);
  if (wr == 0) G8_BAR;
  G8_BAR;
#undef G8_SA
#undef G8_SB
#undef G8_STAGE
#undef G8_LDA
#undef G8_LDB
#undef G8_MMA
#undef G8_WAIT_V
#undef G8_WAIT_L
#undef G8_BAR
#undef G8_SCHED
}
}

constexpr int RSL_OFF = g8::STAGE_BYTES;
constexpr int LDS_GEMM = g8::STAGE_BYTES + 8 * 256 * 4;

__device__ __forceinline__ void fill_rowscales(float* rsl, const float* ssq, float inv_n, const g8::Order& S) {
  const int tid = opaque_tid();
  g8::Unit u;
  __syncthreads();
  for (int i = 0; S.next(i, u); ++i) {
    if (tid < 256) {
      const float4* s4 = (const float4*)(ssq + (size_t)(u.pm * 256 + tid) * 16);
      float s = 0.f;
      for (int k = 0; k < 4; ++k) { float4 v = s4[k]; s += v.x + v.y + v.z + v.w; }
      rsl[i * 256 + tid] = rsqrtf(s * inv_n + EPS);
    }
  }
  __syncthreads();
}

__device__ __forceinline__ h16x4 pack4(float a, float b, float c, float d) { h16x4 v = {(h16)a, (h16)b, (h16)c, (h16)d}; return v; }
__device__ __forceinline__ h16x8 pack8(f32x4 a, f32x4 b) {
  h16x8 v = {(h16)a[0], (h16)a[1], (h16)a[2], (h16)a[3], (h16)b[0], (h16)b[1], (h16)b[2], (h16)b[3]};
  return v;
}

struct EpiIn {
  static constexpr int MID_T = -1;
  __device__ __forceinline__ void mid(f32x4 (&)[2][2][4][2], int, int, int) const {}
  h16* P; const float* rsl; const float* qkg;
  __device__ __forceinline__ void operator()(const f32x4 (&acc)[2][2][4][2], const g8::Unit& u, int ui, int wr, int wc, int fr, int fq) const {
    const int hs = u.pn * 4 + wc;
    int gi = -1;
    if (hs < 4) gi = 0; else if (hs < 6) gi = 1; else if (hs >= 16 && hs < 20) gi = 2; else if (hs == 22) gi = 4; else if (hs == 24) gi = 5;
    const bool gate = (hs == 26);
#pragma unroll
    for (int ai = 0; ai < 2; ++ai)
#pragma unroll
      for (int m = 0; m < 4; ++m) {
        const int rl = 128 * ai + 64 * wr + 16 * m + fr;
        float r = rsl[ui * 256 + rl];
        if (gi >= 0) {
          float ss = 0.f;
#pragma unroll
          for (int bj = 0; bj < 2; ++bj)
#pragma unroll
            for (int n = 0; n < 2; ++n)
#pragma unroll
              for (int j = 0; j < 4; ++j) ss += acc[ai][bj][m][n][j] * acc[ai][bj][m][n][j];
          ss += xor16(ss);
          ss += __shfl_xor(ss, 32);
          r *= rsqrtf(ss * r * r * (1.f / 64.f) + EPS);
        }
        h16* rowp = P + (size_t)(u.pm * 256 + rl) * IWP + 64 * hs + 8 * fq;
#pragma unroll
        for (int bj = 0; bj < 2; ++bj) {
          f32x4 v[2];
#pragma unroll
          for (int n = 0; n < 2; ++n) {
            v[n] = acc[ai][bj][m][n] * r;
            if (gi >= 0) {
              const float4 g4 = *(const float4*)(qkg + gi * 64 + 32 * bj + 8 * fq + 4 * n);
              v[n][0] *= g4.x; v[n][1] *= g4.y; v[n][2] *= g4.z; v[n][3] *= g4.w;
            } else if (gate) {
#pragma unroll
              for (int j = 0; j < 4; ++j) v[n][j] = (32 * bj + 8 * fq + 4 * n + j) < 12 ? sigmoidf(v[n][j]) : 0.f;
            }
          }
          *(h16x8*)(rowp + 32 * bj) = pack8(v[0], v[1]);
        }
      }
  }
};

struct EpiGlu {
  static constexpr int MID_T = -1;
  __device__ __forceinline__ void mid(f32x4 (&)[2][2][4][2], int, int, int) const {}
  h16* OB; float* ssqb; const float* gb;
  __device__ __forceinline__ void operator()(const f32x4 (&acc)[2][2][4][2], const g8::Unit& u, int ui, int wr, int wc, int fr, int fq) const {
    const int ocb = 128 * u.pn + 16 * wc + 4 * fq;
    float4 ba[2], bb[2];
#pragma unroll
    for (int bj = 0; bj < 2; ++bj) { ba[bj] = *(const float4*)(gb + ocb + 64 * bj); bb[bj] = *(const float4*)(gb + 512 + ocb + 64 * bj); }
#pragma unroll
    for (int ai = 0; ai < 2; ++ai)
#pragma unroll
      for (int m = 0; m < 4; ++m) {
        const size_t row = (size_t)u.pm * 256 + 128 * ai + 64 * wr + 16 * m + fr;
        float ss = 0.f;
#pragma unroll
        for (int bj = 0; bj < 2; ++bj) {
          const f32x4 a = acc[ai][bj][m][0], b = acc[ai][bj][m][1];
          float o0 = (a[0] + ba[bj].x) * sigmoidf(b[0] + bb[bj].x);
          float o1 = (a[1] + ba[bj].y) * sigmoidf(b[1] + bb[bj].y);
          float o2 = (a[2] + ba[bj].z) * sigmoidf(b[2] + bb[bj].z);
          float o3 = (a[3] + ba[bj].w) * sigmoidf(b[3] + bb[bj].w);
          *(h16x4*)(OB + row * 1024 + ocb + 64 * bj) = pack4(o0, o1, o2, o3);
          ss += o0 * o0 + o1 * o1 + o2 * o2 + o3 * o3;
        }
        ss += xor16(ss);
        ss += __shfl_xor(ss, 32);
        if (fq == 0) ssqb[row * 16 + u.pn * 4 + wc] = ss;
      }
  }
};

struct EpiRes {
  static constexpr int MID_T = -1;
  __device__ __forceinline__ void mid(f32x4 (&)[2][2][4][2], int, int, int) const {}
  float* xo; h16* xb; float* ssq; bool final_out;
  __device__ __forceinline__ void operator()(const f32x4 (&acc)[2][2][4][2], const g8::Unit& u, int ui, int wr, int wc, int fr, int fq) const {
#pragma unroll
    for (int ai = 0; ai < 2; ++ai)
#pragma unroll
      for (int m = 0; m < 4; ++m) {
        const size_t row = (size_t)u.pm * 256 + 128 * ai + 64 * wr + 16 * m + fr;
        const size_t base = row * DM + 256 * u.pn + 32 * wc + 8 * fq;
        float ss = 0.f;
#pragma unroll
        for (int bj = 0; bj < 2; ++bj) {
          const size_t idx = base + 128 * bj;
          const h16x8 xv = *(const h16x8*)(xb + idx);
          f32x4 x0 = acc[ai][bj][m][0], x1 = acc[ai][bj][m][1];
#pragma unroll
          for (int j = 0; j < 4; ++j) { x0[j] += (float)xv[j]; x1[j] += (float)xv[4 + j]; ss += x0[j] * x0[j] + x1[j] * x1[j]; }
          if (final_out) {
            __builtin_nontemporal_store(x0, (f32x4*)(xo + idx));
            __builtin_nontemporal_store(x1, (f32x4*)(xo + idx + 4));
          } else {
            *(h16x8*)(xb + idx) = pack8(x0, x1);
          }
        }
        ss += xor16(ss);
        ss += __shfl_xor(ss, 32);
        if (fq == 0) ssq[row * 16 + u.pn * 4 + wc] = ss;
      }
  }
};

struct EpiOut : EpiRes {
  static constexpr int MID_T = 8;
  const float* rsl;
  __device__ __forceinline__ void mid(f32x4 (&acc)[2][2][4][2], int ui, int wr, int fr) const {
#pragma unroll
    for (int ai = 0; ai < 2; ++ai)
#pragma unroll
      for (int m = 0; m < 4; ++m) {
        const float r = rsl[ui * 256 + 128 * ai + 64 * wr + 16 * m + fr];
#pragma unroll
        for (int bj = 0; bj < 2; ++bj)
#pragma unroll
          for (int n = 0; n < 2; ++n) acc[ai][bj][m][n] *= r;
      }
  }
};

struct EpiUp {
  static constexpr int MID_T = -1;
  __device__ __forceinline__ void mid(f32x4 (&)[2][2][4][2], int, int, int) const {}
  h16* hid; const float* rsl;
  __device__ __forceinline__ void operator()(const f32x4 (&acc)[2][2][4][2], const g8::Unit& u, int ui, int wr, int wc, int fr, int fq) const {
#pragma unroll
    for (int ai = 0; ai < 2; ++ai)
#pragma unroll
      for (int m = 0; m < 4; ++m) {
        const int rl = 128 * ai + 64 * wr + 16 * m + fr;
        const float r = rsl[ui * 256 + rl];
        h16* rowp = hid + (size_t)(u.pm * 256 + rl) * DFF + 256 * u.pn + 32 * wc + 8 * fq;
#pragma unroll
        for (int bj = 0; bj < 2; ++bj) {
          f32x4 v[2];
#pragma unroll
          for (int n = 0; n < 2; ++n) {
            v[n] = acc[ai][bj][m][n] * r;
#pragma unroll
            for (int j = 0; j < 4; ++j) { const float t = fmaxf(v[n][j], 0.f); v[n][j] = t * t; }
          }
          __builtin_nontemporal_store(pack8(v[0], v[1]), (h16x8*)(rowp + 128 * bj));
        }
      }
  }
};

__device__ __forceinline__ void phase_gemm1(const Params& p, int l, char* lds) {
  g8::Order S; S.init(NTOK, IWP, gridDim.x, blockIdx.x);
  float* rsl = (float*)(lds + RSL_OFF);
  fill_rowscales(rsl, (const float*)(WS(p) + O_SSQ), 1.f / DM, S);
  EpiIn E{(h16*)(WS(p) + O_P), rsl, p.in[3] + l * 6 * 64};
  g8::gemm_phase((LAS unsigned char*)lds, (const h16*)(WS(p) + O_XB), (const h16*)(WS(p) + O_WIN + l * SZ_WIN), DM, S, E);
}
__device__ __forceinline__ void phase_glu(const Params& p, int l, char* lds) {
  g8::Order S; S.init(NTOK, 1024, gridDim.x, blockIdx.x);
  __syncthreads();
  EpiGlu E{(h16*)(WS(p) + O_OB), (float*)(WS(p) + O_SSQB), p.in[15] + l * 1024};
  g8::gemm_phase((LAS unsigned char*)lds, (const h16*)(WS(p) + O_Z), (const h16*)(WS(p) + O_WGLU + l * SZ_WGLU), 512, S, E);
}
__device__ __forceinline__ void phase_wout(const Params& p, int l, char* lds) {
  g8::Order S; S.init(NTOK, DM, gridDim.x, blockIdx.x);
  float* rsl = (float*)(lds + RSL_OFF);
  fill_rowscales(rsl, (const float*)(WS(p) + O_SSQB), 1.f / 512.f, S);
  EpiOut E;
  E.xo = p.out; E.xb = (h16*)(WS(p) + O_XB); E.ssq = (float*)(WS(p) + O_SSQ); E.final_out = false; E.rsl = rsl;
  g8::gemm_phase((LAS unsigned char*)lds, (const h16*)(WS(p) + O_OB), (const h16*)(WS(p) + O_WOUT + l * SZ_WOUT), DM, S, E);
}
__device__ __forceinline__ void phase_up(const Params& p, int l, char* lds) {
  g8::Order S; S.init(NTOK, DFF, gridDim.x, blockIdx.x);
  float* rsl = (float*)(lds + RSL_OFF);
  fill_rowscales(rsl, (const float*)(WS(p) + O_SSQ), 1.f / DM, S);
  EpiUp E{(h16*)(WS(p) + O_HID), rsl};
  g8::gemm_phase((LAS unsigned char*)lds, (const h16*)(WS(p) + O_XB), (const h16*)(WS(p) + O_WUP + l * SZ_WUP), DM, S, E);
}
__device__ __forceinline__ void phase_down(const Params& p, int l, char* lds) {
  g8::Order S; S.init(NTOK, DM, gridDim.x, blockIdx.x);
  __syncthreads();
  EpiRes E{p.out, (h16*)(WS(p) + O_XB), (float*)(WS(p) + O_SSQ), l == DEPTH - 1};
  g8::gemm_phase((LAS unsigned char*)lds, (const h16*)(WS(p) + O_HID), (const h16*)(WS(p) + O_WDN + l * SZ_WDN), DFF, S, E);
}

constexpr int KP = 80;
enum { M_SWA = 0, M_WIN = 1, M_SEL = 2, M_CMPA = 3, M_CMPB = 4 };
constexpr float LOG2E = 1.4426950408889634f, SCL2 = 0.125f * LOG2E;
struct ColState { float m, l; };
typedef short s16x4v __attribute__((__vector_size__(8)));

__device__ __forceinline__ h16x8 ld_row8(const h16* base, int ld, int row, int nrows, int c8) {
  h16x8 z = {0, 0, 0, 0, 0, 0, 0, 0};
  return (row >= 0 && row < nrows) ? *(const h16x8*)(base + (size_t)row * ld + c8 * 8) : z;
}
__device__ __forceinline__ void st_k(h16* Ks, int row, int c8, h16x8 v) { *(h16x8*)(Ks + row * KP + c8 * 8) = v; }
__device__ __forceinline__ void st_vt(h16* Vt, int row, int c8, h16x8 v) {
#pragma unroll
  for (int e = 0; e < 8; ++e) Vt[(c8 * 8 + e) * KP + row] = v[e];
}
__device__ __forceinline__ float max4q(float v) {
  v = fmaxf(v, xor16(v));
  auto r = __builtin_amdgcn_permlane32_swap(__float_as_int(v), __float_as_int(v), false, false);
  return fmaxf(__int_as_float(r[0]), __int_as_float(r[1]));
}
__device__ __forceinline__ float sum4q(float v) {
  v += xor16(v);
  auto r = __builtin_amdgcn_permlane32_swap(__float_as_int(v), __float_as_int(v), false, false);
  return __int_as_float(r[0]) + __int_as_float(r[1]);
}
__device__ __forceinline__ float quadsum(float v) { v += dppf<0xB1>(v); v += dppf<0x4E>(v); return v; }

template <int MODE, int RGM>
__device__ __forceinline__ void attn_tile(const h16x8 (&Q)[2][2], f32x4 (&O)[2][4], ColState (&st)[2], const h16* Ks,
                                          const h16* Vt, const float* biasT, const int (&tq)[2], int hd, int kbase, bool far,
                                          const bool (&selbit)[2], float (&hq)[2][4], float (&h3)[2][4], const int lane) {
  const int col = lane & 15, q4 = lane >> 4;
  constexpr int DK = (MODE == M_CMPA || MODE == M_CMPB) ? 16 : 1;
  f32x4 S[2][4];
#pragma unroll
  for (int kt = 0; kt < 4; ++kt) {
#pragma unroll
    for (int rg = 0; rg < 2; ++rg) S[rg][kt] = f32x4{0.f, 0.f, 0.f, 0.f};
#pragma unroll
    for (int ks = 0; ks < 2; ++ks) {
      h16x8 Kf = *(const h16x8*)(Ks + (kt * 16 + col) * KP + ks * 32 + q4 * 8);
#pragma unroll
      for (int rg = 0; rg < 2; ++rg)
        if (RGM & (1 << rg)) S[rg][kt] = __builtin_amdgcn_mfma_f32_16x16x32_f16(Kf, Q[rg][ks], S[rg][kt], 0, 0, 0);
    }
  }
  h16x8 Pf[2][2];
#pragma unroll
  for (int rg = 0; rg < 2; ++rg) {
    if (!(RGM & (1 << rg))) continue;
    const float* bt = biasT + hd * 800;
    if (far) {
      const float b31 = bt[799];
      const bool ok = (MODE == M_SEL) ? selbit[rg] : true;
#pragma unroll
      for (int kt = 0; kt < 4; ++kt)
#pragma unroll
        for (int j = 0; j < 4; ++j) S[rg][kt][j] = ok ? S[rg][kt][j] * SCL2 + b31 : -1e30f;
    } else {
      const int kx0 = kbase + q4 * 4;
      const int d0 = (DK == 16) ? tq[rg] - 31 - 16 * kx0 : tq[rg] - kx0;
#pragma unroll
      for (int kt = 0; kt < 4; ++kt)
#pragma unroll
        for (int j = 0; j < 4; ++j) {
          const int dist = d0 - DK * (kt * 16 + j);
          const int kx = kx0 + kt * 16 + j;
          bool valid = dist >= 0;
          if (MODE == M_SWA) valid = valid && dist < 128 && kx >= 0;
          if (MODE == M_WIN) valid = valid && dist < 512 && kx >= 0;
          if (MODE == M_SEL) valid = valid && selbit[rg];
          if (DK == 16) valid = valid && kx < NCMP;
          const int dc = dist < 0 ? 0 : (dist > 799 ? 799 : dist);
          S[rg][kt][j] = valid ? S[rg][kt][j] * SCL2 + bt[dc] : -1e30f;
        }
    }
    if (MODE == M_CMPB) {
#pragma unroll
      for (int kt = 0; kt < 4; ++kt) {
        float h = 0.f;
#pragma unroll
        for (int j = 0; j < 4; ++j) {
          float pv = __builtin_amdgcn_exp2f(S[rg][kt][j] - st[rg].m) * st[rg].l;
          S[rg][kt][j] = pv;
          h += pv;
        }
        hq[rg][kt] = h;
        h3[rg][kt] = S[rg][kt][3];
      }
    } else {
      float mx = -1e30f;
#pragma unroll
      for (int kt = 0; kt < 4; ++kt)
#pragma unroll
        for (int j = 0; j < 4; ++j) mx = fmaxf(mx, S[rg][kt][j]);
      mx = max4q(mx);
      const float mn = fmaxf(st[rg].m, mx);
      const float corr = __builtin_amdgcn_exp2f(st[rg].m - mn);
      st[rg].m = mn;
      const float mm = fmaxf(mn, -1e20f);
      float ls = 0.f;
#pragma unroll
      for (int kt = 0; kt < 4; ++kt)
#pragma unroll
        for (int j = 0; j < 4; ++j) {
          float pv = __builtin_amdgcn_exp2f(S[rg][kt][j] - mm);
          S[rg][kt][j] = pv;
          ls += pv;
        }
      st[rg].l = st[rg].l * corr + ls;
      if (MODE != M_CMPA) {
#pragma unroll
        for (int nt = 0; nt < 4; ++nt) O[rg][nt] *= corr;
      }
    }
    if (MODE != M_CMPA) {
#pragma unroll
      for (int ks = 0; ks < 2; ++ks)
#pragma unroll
        for (int i = 0; i < 4; ++i) {
          Pf[rg][ks][i] = (h16)S[rg][2 * ks][i];
          Pf[rg][ks][4 + i] = (h16)S[rg][2 * ks + 1][i];
        }
    }
  }
  if (MODE == M_CMPA) return;
#pragma unroll
  for (int ks = 0; ks < 2; ++ks)
#pragma unroll
    for (int nt = 0; nt < 4; ++nt) {
      const h16* vp = Vt + (ks * 32 + q4 * 4 + (col >> 2)) * KP + nt * 16 + 4 * (col & 3);
      const s16x4v r0 = __builtin_amdgcn_ds_read_tr16_b64_v4i16((LAS s16x4v*)vp);
      const s16x4v r1 = __builtin_amdgcn_ds_read_tr16_b64_v4i16((LAS s16x4v*)(vp + 16 * KP));
      const h16x4 v0 = __builtin_bit_cast(h16x4, r0), v1 = __builtin_bit_cast(h16x4, r1);
      const h16x8 Vf = {v0[0], v0[1], v0[2], v0[3], v1[0], v1[1], v1[2], v1[3]};
#pragma unroll
      for (int rg = 0; rg < 2; ++rg)
        if (RGM & (1 << rg)) O[rg][nt] = __builtin_amdgcn_mfma_f32_16x16x32_f16(Vf, Pf[rg][ks], O[rg][nt], 0, 0, 0);
    }
}

constexpr int RPAD = 132, HPAD = 144;
constexpr int LDS_CMP = 8 * 16 * RPAD * 4 + 16 * HPAD * 2 + 4 * 16 * 4;
__device__ __forceinline__ void phase_compress(const Params& p, int l, char* lds) {
  const int tid = opaque_tid(), lane = tid & 63, w = tid >> 6, col = lane & 15, q4 = lane >> 4;
  float* red = (float*)lds;
  h16* hid = (h16*)(lds + 8 * 16 * RPAD * 4);
  float* nrm2 = (float*)(lds + 8 * 16 * RPAD * 4 + 16 * HPAD * 2);
  const h16* P = (const h16*)(WS(p) + O_P);
  for (int u = blockIdx.x; u < BATCH * 2 * 32; u += gridDim.x) {
    const int mt = u & 31, st = (u >> 5) & 1, b = u >> 6;
    const h16* W1t = (const h16*)(WS(p) + O_W1T) + (size_t)(l * 2 + st) * 128 * 2048;
    const h16* W2t = (const h16*)(WS(p) + O_W2T) + (size_t)(l * 2 + st) * 64 * 128;
    const float* b1 = (const float*)(WS(p) + O_BIAS1) + (l * 2 + st) * 128;
    __syncthreads();
    {
      f32x4 acc[8];
#pragma unroll
      for (int nt = 0; nt < 8; ++nt) acc[nt] = f32x4{0.f, 0.f, 0.f, 0.f};
      const int m = 16 * mt + col;
#pragma unroll 2
      for (int kk = 0; kk < 8; ++kk) {
        const int ks = 8 * w + kk, tt = ks >> 1, d0 = (ks & 1) * 32 + q4 * 8;
        int tok = 16 * m + tt;
        if (tok > SEQ - 1) tok = SEQ - 1;
        const h16x8 A = *(const h16x8*)(P + ((size_t)b * SEQ + tok) * IWP + OFF_KVC + st * 64 + d0);
#pragma unroll
        for (int nt = 0; nt < 8; ++nt) {
          const h16x8 B = *(const h16x8*)(W1t + (size_t)(nt * 16 + col) * 2048 + ks * 32 + q4 * 8);
          acc[nt] = __builtin_amdgcn_mfma_f32_16x16x32_f16(A, B, acc[nt], 0, 0, 0);
        }
      }
#pragma unroll
      for (int nt = 0; nt < 8; ++nt)
#pragma unroll
        for (int j = 0; j < 4; ++j) red[(w * 16 + q4 * 4 + j) * RPAD + nt * 16 + col] = acc[nt][j];
    }
    __syncthreads();
    {
      const int row = tid >> 5, c4 = (tid & 31) * 4;
      float4 sum = *(const float4*)(b1 + c4);
#pragma unroll
      for (int ww = 0; ww < 8; ++ww) {
        const float4 v = *(const float4*)(red + (ww * 16 + row) * RPAD + c4);
        sum.x += v.x; sum.y += v.y; sum.z += v.z; sum.w += v.w;
      }
      *(h16x4*)(hid + row * HPAD + c4) = pack4(gelu_tanh(sum.x), gelu_tanh(sum.y), gelu_tanh(sum.z), gelu_tanh(sum.w));
    }
    __syncthreads();
    f32x4 o2 = {0.f, 0.f, 0.f, 0.f};
    if (w < 4) {
#pragma unroll
      for (int ks = 0; ks < 4; ++ks) {
        const h16x8 A = *(const h16x8*)(hid + col * HPAD + ks * 32 + q4 * 8);
        const h16x8 B = *(const h16x8*)(W2t + (size_t)(w * 16 + col) * 128 + ks * 32 + q4 * 8);
        o2 = __builtin_amdgcn_mfma_f32_16x16x32_f16(A, B, o2, 0, 0, 0);
      }
      if (st == 0) {
#pragma unroll
        for (int j = 0; j < 4; ++j) {
          float ss = sum16(o2[j] * o2[j]);
          if (col == 0) nrm2[w * 16 + q4 * 4 + j] = ss;
        }
      }
    }
    __syncthreads();
    if (w < 4) {
      const float g = p.in[3][(l * 6 + 3) * 64 + w * 16 + col];
      h16* dst = (h16*)(WS(p) + (st == 0 ? O_KCMP : O_VCMP));
#pragma unroll
      for (int j = 0; j < 4; ++j) {
        const int row = q4 * 4 + j, m = 16 * mt + row;
        float v = o2[j];
        if (st == 0) {
          float tot = nrm2[row] + nrm2[16 + row] + nrm2[32 + row] + nrm2[48 + row];
          v = v * rsqrtf(tot * (1.f / 64.f) + EPS) * g;
        }
        if (m >= NCMP) v = 0.f;
        dst[((size_t)b * 512 + m) * 64 + w * 16 + col] = (h16)v;
      }
    }
  }
}


template <int MODE, int TM>
__device__ __forceinline__ void attn_tile2(const h16x8 (&Q)[2], f32x4 (&O)[4], ColState& st, const h16* Ks0, const h16* Vt0,
                                           const h16* Ks1, const h16* Vt1, const float* biasT, int tq, int hd, int kbase0,
                                           const bool (&far)[2], const bool (&selbit)[2], float (&hq)[2][4], float (&h3)[2][4],
                                           const int lane) {
  const int col = lane & 15, q4 = lane >> 4;
  constexpr int DK = (MODE == M_CMPA || MODE == M_CMPB) ? 16 : 1;
  f32x4 S[2][4];
  __builtin_amdgcn_s_setprio(1);
#pragma unroll
  for (int t = 0; t < 2; ++t) {
    if (!(TM & (1 << t))) continue;
    const h16* Ks = t ? Ks1 : Ks0;
#pragma unroll
    for (int kt = 0; kt < 4; ++kt) {
      S[t][kt] = f32x4{0.f, 0.f, 0.f, 0.f};
#pragma unroll
      for (int ks = 0; ks < 2; ++ks) {
        h16x8 Kf = *(const h16x8*)(Ks + (kt * 16 + col) * KP + ks * 32 + q4 * 8);
        S[t][kt] = __builtin_amdgcn_mfma_f32_16x16x32_f16(Kf, Q[ks], S[t][kt], 0, 0, 0);
      }
    }
  }
  __builtin_amdgcn_s_setprio(0);
  const float* bt = biasT + hd * 800;
  float addc[2] = {0.f, 0.f}, sclc[2] = {1.f, 1.f};
#pragma unroll
  for (int t = 0; t < 2; ++t) {
    if (!(TM & (1 << t))) continue;
    const int kbase = kbase0 + 64 * t;
    if (far[t]) {
      const bool ok = (MODE == M_SEL) ? selbit[t] : true;
      addc[t] = ok ? bt[799] : -1e30f;
      sclc[t] = SCL2;
    } else {
      addc[t] = 0.f;
      sclc[t] = 1.f;
      const int kx0 = kbase + q4 * 4;
      const int d0 = (DK == 16) ? tq - 31 - 16 * kx0 : tq - kx0;
#pragma unroll
      for (int kt = 0; kt < 4; ++kt)
#pragma unroll
        for (int j = 0; j < 4; ++j) {
          const int dist = d0 - DK * (kt * 16 + j);
          const int kx = kx0 + kt * 16 + j;
          bool valid = dist >= 0;
          if (MODE == M_WIN) valid = valid && dist < 512 && kx >= 0;
          if (MODE == M_SEL) valid = valid && selbit[t];
          if (DK == 16) valid = valid && kx < NCMP;
          const int dc = dist < 0 ? 0 : (dist > 799 ? 799 : dist);
          S[t][kt][j] = valid ? S[t][kt][j] * SCL2 + bt[dc] : -1e30f;
        }
    }
  }
  if (MODE == M_CMPB) {
#pragma unroll
    for (int t = 0; t < 2; ++t) {
      if (!(TM & (1 << t))) continue;
#pragma unroll
      for (int kt = 0; kt < 4; ++kt) {
        float h = 0.f;
#pragma unroll
        for (int j = 0; j < 4; ++j) {
          float pv = __builtin_amdgcn_exp2f(S[t][kt][j] * sclc[t] + (addc[t] - st.m)) * st.l;
          S[t][kt][j] = pv;
          h += pv;
        }
        hq[t][kt] = h;
        h3[t][kt] = S[t][kt][3];
      }
    }
  } else {
    float mx = -1e30f;
#pragma unroll
    for (int t = 0; t < 2; ++t) {
      if (!(TM & (1 << t))) continue;
      float mt = -1e30f;
#pragma unroll
      for (int kt = 0; kt < 4; ++kt)
#pragma unroll
        for (int j = 0; j < 4; ++j) mt = fmaxf(mt, S[t][kt][j]);
      mx = fmaxf(mx, mt * sclc[t] + addc[t]);
    }
    mx = max4q(mx);
    const float mn = fmaxf(st.m, mx);
    const float corr = __builtin_amdgcn_exp2f(st.m - mn);
    st.m = mn;
    const float mm = fmaxf(mn, -1e20f);
    float ls = 0.f;
#pragma unroll
    for (int t = 0; t < 2; ++t) {
      if (!(TM & (1 << t))) continue;
      const float am = addc[t] - mm;
#pragma unroll
      for (int kt = 0; kt < 4; ++kt) {
        const f32x4 e = S[t][kt] * sclc[t] + am;
#pragma unroll
        for (int j = 0; j < 4; ++j) {
          float pv = __builtin_amdgcn_exp2f(e[j]);
          S[t][kt][j] = pv;
          ls += pv;
        }
      }
    }
    st.l = st.l * corr + ls;
    if (MODE != M_CMPA) {
#pragma unroll
      for (int nt = 0; nt < 4; ++nt) O[nt] *= corr;
    }
  }
  if (MODE == M_CMPA) return;
  __builtin_amdgcn_s_setprio(1);
#pragma unroll
  for (int t = 0; t < 2; ++t) {
    if (!(TM & (1 << t))) continue;
    const h16* Vt = t ? Vt1 : Vt0;
#pragma unroll
    for (int ks = 0; ks < 2; ++ks) {
      h16x8 Pf;
#pragma unroll
      for (int i = 0; i < 4; ++i) { Pf[i] = (h16)S[t][2 * ks][i]; Pf[4 + i] = (h16)S[t][2 * ks + 1][i]; }
#pragma unroll
      for (int nt = 0; nt < 4; ++nt) {
        const h16* vp = Vt + (ks * 32 + q4 * 4 + (col >> 2)) * KP + nt * 16 + 4 * (col & 3);
        const s16x4v r0 = __builtin_amdgcn_ds_read_tr16_b64_v4i16((LAS s16x4v*)vp);
        const s16x4v r1 = __builtin_amdgcn_ds_read_tr16_b64_v4i16((LAS s16x4v*)(vp + 16 * KP));
        const h16x4 v0 = __builtin_bit_cast(h16x4, r0), v1 = __builtin_bit_cast(h16x4, r1);
        const h16x8 Vf = {v0[0], v0[1], v0[2], v0[3], v1[0], v1[1], v1[2], v1[3]};
        O[nt] = __builtin_amdgcn_mfma_f32_16x16x32_f16(Vf, Pf, O[nt], 0, 0, 0);
      }
    }
  }
  __builtin_amdgcn_s_setprio(0);
}

template <int D, class LoadF, class StoreF, class CompF>
__device__ __forceinline__ void pair_pipeline(int n, LoadF load, StoreF store, CompF comp) {
  h16x8 r[D][4];
#pragma unroll
  for (int d = 0; d < D; ++d)
    if (d < n) load(d, r[d]);
  store(0, r[0]);
  if (D < n) load(D, r[0]);
  __syncthreads();
  for (int i0 = 0; i0 < n; i0 += D) {
#pragma unroll
    for (int d = 0; d < D; ++d) {
      const int i = i0 + d;
      if (i < n) {
        if (i + 1 < n) store(i + 1, r[(d + 1) % D]);
        if (i + 1 + D < n) load(i + 1 + D, r[(d + 1) % D]);
        comp(i);
        __syncthreads();
      }
    }
  }
}

template <int D, class LoadF, class StoreF, class CompF>
__device__ __forceinline__ void tile_pipeline(int n, LoadF load, StoreF store, CompF comp) {
  h16x8 rk[D], rv[D];
#pragma unroll
  for (int d = 0; d < D; ++d)
    if (d < n) load(d, rk[d], rv[d]);
  store(0, rk[0], rv[0]);
  if (D < n) load(D, rk[0], rv[0]);
  __syncthreads();
  for (int i0 = 0; i0 < n; i0 += D) {
#pragma unroll
    for (int d = 0; d < D; ++d) {
      const int i = i0 + d;
      if (i < n) {
        if (i + 1 < n) store(i + 1, rk[(d + 1) % D], rv[(d + 1) % D]);
        if (i + 1 + D < n) load(i + 1 + D, rk[(d + 1) % D], rv[(d + 1) % D]);
        comp(i);
        __syncthreads();
      }
    }
  }
}

constexpr int LDS_BIAS = 800 * 16;
__device__ __forceinline__ void phase_swa(const Params& p, int l, char* lds, unsigned* ctr, int* slot) {
  const int tid = opaque_tid(), lane = tid & 63, w = tid >> 6, col = lane & 15, q4 = lane >> 4;
  float* biasT = (float*)lds;
  h16* KV = (h16*)(lds + LDS_BIAS);
  float* nrm = (float*)(lds + LDS_BIAS + 4 * 64 * KP * 2);
  const h16* P = (const h16*)(WS(p) + O_P);
  const int* lut = (const int*)(WS(p) + O_LUT);
  h16* OAC = (h16*)(WS(p) + O_OAC);
  __syncthreads();
  for (int i = tid; i < 3200; i += NT) biasT[i] = p.in[5][lut[i % 800] * 8 + (i / 800)] * LOG2E;
  __syncthreads();
  const int head = w >> 1, kvh = w >> 2;
  const float sink = p.in[4][l * 4 + head] * LOG2E;
  const int srow = tid >> 3, c8 = tid & 7;
  float hpd[2][4], hpe[2][4];
  const bool nosel[2] = {false, false};
  for (int u = fetch_unit(ctr, slot); u < BATCH * 128; u = fetch_unit(ctr, slot)) {
    const int b = u >> 7, t0 = (u & 127) * 64;
    const h16* Pbat = P + (size_t)b * SEQ * IWP;
    h16x8 Q[2][2];
    int tq[2];
#pragma unroll
    for (int rg = 0; rg < 2; ++rg) {
      const int qb = (w & 1) * 32 + rg * 16;
      const h16* qp = Pbat + (size_t)(t0 + qb + col) * IWP + head * 64 + q4 * 8;
      Q[rg][0] = *(const h16x8*)qp;
      Q[rg][1] = *(const h16x8*)(qp + 32);
      tq[rg] = t0 + qb + col;
    }
    f32x4 O[2][4];
    ColState st[2];
#pragma unroll
    for (int rg = 0; rg < 2; ++rg) {
#pragma unroll
      for (int nt = 0; nt < 4; ++nt) O[rg][nt] = f32x4{0.f, 0.f, 0.f, 0.f};
      st[rg].m = -1e30f; st[rg].l = 0.f;
    }
    const int i0 = t0 >= 128 ? 0 : (t0 >= 64 ? 1 : 2);
    h16x8 rk[2], rv[2];
    {
      int sb = t0 - 128 + i0 * 64;
      for (int h2 = 0; h2 < 2; ++h2) {
        rk[h2] = ld_row8(Pbat + 256 + h2 * 64, IWP, sb + srow, SEQ, c8);
        rv[h2] = ld_row8(Pbat + 384 + h2 * 64, IWP, sb + srow, SEQ, c8);
      }
    }
    for (int i = i0; i < 3; ++i) {
      __syncthreads();
      for (int h2 = 0; h2 < 2; ++h2) {
        st_k(KV + h2 * 64 * KP, srow, c8, rk[h2]);
        st_k(KV + (2 + h2) * 64 * KP, srow, c8, rv[h2]);
      }
      __syncthreads();
      if (i + 1 < 3) {
        int sb = t0 - 128 + (i + 1) * 64;
        for (int h2 = 0; h2 < 2; ++h2) {
          rk[h2] = ld_row8(Pbat + 256 + h2 * 64, IWP, sb + srow, SEQ, c8);
          rv[h2] = ld_row8(Pbat + 384 + h2 * 64, IWP, sb + srow, SEQ, c8);
        }
      }
      const int kb = t0 - 128 + i * 64;
      attn_tile<M_SWA, 3>(Q, O, st, KV + kvh * 64 * KP, KV + (2 + kvh) * 64 * KP, biasT, tq, head, kb, false, nosel, hpd, hpe, lane);
    }
    __syncthreads();
#pragma unroll
    for (int rg = 0; rg < 2; ++rg) {
      const int qb = (w & 1) * 32 + rg * 16;
      const float lsum = sum4q(st[rg].l);
      const float mn = fmaxf(st[rg].m, sink);
      const float corr = __builtin_amdgcn_exp2f(st[rg].m - mn);
      const float inv = corr / (lsum * corr + __builtin_amdgcn_exp2f(sink - mn));
      float ss = 0.f;
#pragma unroll
      for (int nt = 0; nt < 4; ++nt) {
        O[rg][nt] *= inv;
#pragma unroll
        for (int j = 0; j < 4; ++j) ss += O[rg][nt][j] * O[rg][nt][j];
      }
      ss = sum4q(ss);
      if (q4 == 0) nrm[head * 64 + qb + col] = ss;
    }
    __syncthreads();
#pragma unroll
    for (int rg = 0; rg < 2; ++rg) {
      const int qi = (w & 1) * 32 + rg * 16 + col;
      const float tot = nrm[qi] + nrm[64 + qi] + nrm[128 + qi] + nrm[192 + qi];
      const float sc = rsqrtf(tot * (1.f / 256.f) + EPS);
#pragma unroll
      for (int nt = 0; nt < 4; ++nt)
        *(h16x4*)(OAC + ((size_t)b * SEQ + t0 + qi) * 1024 + head * 64 + nt * 16 + q4 * 4) =
            pack4(O[rg][nt][0] * sc, O[rg][nt][1] * sc, O[rg][nt][2] * sc, O[rg][nt][3] * sc);
    }
  }
}

constexpr int LDS_NSA = LDS_BIAS + 8 * 64 * KP * 2 + NW * 4 * 128 * 4 + 32 * 16;
constexpr int PFD = 2;
__device__ __forceinline__ void phase_nsa(const Params& p, int l, char* lds, unsigned* ctr, int* slot, const int parts = 15) {
  const int tid = opaque_tid(), lane = tid & 63, w = tid >> 6, col = lane & 15, q4 = lane >> 4;
  float* biasT = (float*)lds;
  h16* KV0 = (h16*)(lds + LDS_BIAS);
  float* impw = (float*)(lds + LDS_BIAS + 8 * 64 * KP * 2) + w * 4 * 128;
  unsigned long long* selm = (unsigned long long*)(lds + LDS_BIAS + 8 * 64 * KP * 2 + NW * 4 * 128 * 4);
#define KSB(i, t) (KV0 + (((i) & 1) * 4 + (t) * 2) * 64 * KP)
#define VTB(i, t) (KV0 + (((i) & 1) * 4 + (t) * 2 + 1) * 64 * KP)
  const h16* P = (const h16*)(WS(p) + O_P);
  const int* lut = (const int*)(WS(p) + O_LUT);
  h16* OAC = (h16*)(WS(p) + O_OAC);
  __syncthreads();
  for (int i = tid; i < 3200; i += NT) biasT[i] = p.in[5][lut[i % 800] * 8 + 4 + (i / 800)] * LOG2E;
  __syncthreads();
  const int srow = tid >> 3, c8 = tid & 7;
  const int hd = col & 3, qw = col >> 2;
  float hpd[2][4], hpe[2][4];
  const bool nosel[2] = {false, false};
  for (int u = fetch_unit(ctr, slot); u < 1024; u = fetch_unit(ctr, slot)) {
    const int rnd = u >> 8, b = (u & 255) >> 6, ti = u & 63;
    const int tile = rnd == 0 ? 255 - ti : (rnd == 1 ? 128 + ti : (rnd == 2 ? 127 - ti : ti));
    const int t0 = tile * 32, cur = t0 >> 6;
    const h16* Pbat = P + (size_t)b * SEQ * IWP;
    const h16* KC = (const h16*)(WS(p) + O_KCMP) + (size_t)b * 512 * 64;
    const h16* VC = (const h16*)(WS(p) + O_VCMP) + (size_t)b * 512 * 64;
    h16x8 Q[2];
    int tq;
    {
      const h16* qp = Pbat + (size_t)(t0 + w * 4 + qw) * IWP + OFF_QC + hd * 64 + q4 * 8;
      Q[0] = *(const h16x8*)qp;
      Q[1] = *(const h16x8*)(qp + 32);
      tq = t0 + w * 4 + qw;
    }
    const h16* gp = Pbat + (size_t)tq * IWP + OFF_GC + hd * 3;
    for (int i = lane; i < 512; i += 64) impw[i] = 0.f;
    f32x4 O[4], Oc[4];
    ColState st;
    int mvmax = t0 / 16 + 1;
    if (mvmax > NCMP) mvmax = NCMP;
    const int ntc = (mvmax + 63) >> 6;
    st.m = -1e30f; st.l = 0.f;
    const int npc = (ntc + 1) >> 1;
    if (parts & 1) pair_pipeline<PFD>(npc,
      [&](int i, h16x8 (&r)[4]) { r[0] = ld_row8(KC, 64, (2 * i) * 64 + srow, 512, c8); r[2] = ld_row8(KC, 64, (2 * i + 1) * 64 + srow, 512, c8); },
      [&](int i, const h16x8 (&r)[4]) { st_k(KSB(i, 0), srow, c8, r[0]); st_k(KSB(i, 1), srow, c8, r[2]); },
      [&](int i) {
        const bool far[2] = {t0 - 31 - 16 * (2 * i * 64 + 63) >= 799, t0 - 31 - 16 * ((2 * i + 1) * 64 + 63) >= 799};
        if (2 * i + 1 < ntc) attn_tile2<M_CMPA, 3>(Q, O, st, KSB(i, 0), VTB(i, 0), KSB(i, 1), VTB(i, 1), biasT, tq, hd, 2 * i * 64, far, nosel, hpd, hpe, lane);
        else attn_tile2<M_CMPA, 1>(Q, O, st, KSB(i, 0), VTB(i, 0), KSB(i, 1), VTB(i, 1), biasT, tq, hd, 2 * i * 64, far, nosel, hpd, hpe, lane);
      });
    {
      const float ls = sum4q(st.l);
      st.l = ls > 0.f ? 1.f / ls : 0.f;
    }
#pragma unroll
    for (int nt = 0; nt < 4; ++nt) O[nt] = f32x4{0.f, 0.f, 0.f, 0.f};
    float carry = 0.f;
    if (parts & 1) pair_pipeline<PFD>(npc,
      [&](int i, h16x8 (&r)[4]) {
        r[0] = ld_row8(KC, 64, (2 * i) * 64 + srow, 512, c8); r[1] = ld_row8(VC, 64, (2 * i) * 64 + srow, 512, c8);
        r[2] = ld_row8(KC, 64, (2 * i + 1) * 64 + srow, 512, c8); r[3] = ld_row8(VC, 64, (2 * i + 1) * 64 + srow, 512, c8); },
      [&](int i, const h16x8 (&r)[4]) {
        st_k(KSB(i, 0), srow, c8, r[0]); st_k(VTB(i, 0), srow, c8, r[1]); st_k(KSB(i, 1), srow, c8, r[2]); st_k(VTB(i, 1), srow, c8, r[3]); },
      [&](int i) {
        float hq[2][4], h3[2][4];
        const bool far[2] = {t0 - 31 - 16 * (2 * i * 64 + 63) >= 799, t0 - 31 - 16 * ((2 * i + 1) * 64 + 63) >= 799};
        const bool two = 2 * i + 1 < ntc;
        if (two) attn_tile2<M_CMPB, 3>(Q, O, st, KSB(i, 0), VTB(i, 0), KSB(i, 1), VTB(i, 1), biasT, tq, hd, 2 * i * 64, far, nosel, hq, h3, lane);
        else attn_tile2<M_CMPB, 1>(Q, O, st, KSB(i, 0), VTB(i, 0), KSB(i, 1), VTB(i, 1), biasT, tq, hd, 2 * i * 64, far, nosel, hq, h3, lane);
        float t3p = carry;
#pragma unroll
        for (int t = 0; t < 2; ++t) {
          if (t == 1 && !two) break;
#pragma unroll
          for (int kt = 0; kt < 4; ++kt) {
            const float qs = quadsum(hq[t][kt]);
            const float t3 = quadsum(h3[t][kt]);
            const float up = __shfl(t3, (lane + 48) & 63);
            const float wrp = __shfl(t3p, (lane + 48) & 63);
            const float pk = (q4 == 0) ? wrp : up;
            if (hd == 0) impw[qw * 128 + (2 * i + t) * 16 + kt * 4 + q4] = qs + pk;
            t3p = t3;
          }
        }
        carry = t3p;
      });
    {
      const float g0 = (float)gp[0];
#pragma unroll
      for (int nt = 0; nt < 4; ++nt) Oc[nt] = O[nt] * g0;
    }
    if (parts & 2) {
      const int nforced = cur >= 2 ? 3 : cur + 1;
      const int npick = 16 - nforced;
      for (int qi = 0; qi < 4; ++qi) {
        const float* im = impw + qi * 128;
        const int j0 = lane, j1 = lane + 64;
        const float v0 = im[j0], v1 = im[j1];
        int r0 = 0, r1 = 0;
#pragma unroll 8
        for (int jp = 1; jp <= cur - 2; ++jp) {
          float vp = im[jp];
          r0 += (vp > v0 || (vp == v0 && jp < j0)) ? 1 : 0;
          r1 += (vp > v1 || (vp == v1 && jp < j1)) ? 1 : 0;
        }
        bool c0 = j0 >= 1 && j0 <= cur - 2, c1 = j1 <= cur - 2;
        bool f0 = j0 == 0 || j0 == cur || j0 == cur - 1, f1 = j1 == cur || j1 == cur - 1;
        unsigned long long mlo = __ballot(f0 || (c0 && r0 < npick));
        unsigned long long mhi = __ballot(f1 || (c1 && r1 < npick));
        if (lane == 0) { selm[(w * 4 + qi) * 2] = mlo; selm[(w * 4 + qi) * 2 + 1] = mhi; }
      }
    }
    asm volatile("" ::: "memory");
    const unsigned long long slo = selm[(w * 4 + qw) * 2], shi = selm[(w * 4 + qw) * 2 + 1];
#pragma unroll
    for (int nt = 0; nt < 4; ++nt) O[nt] = f32x4{0.f, 0.f, 0.f, 0.f};
    st.m = -1e30f; st.l = 0.f;
    if (parts & 4) pair_pipeline<PFD>((cur + 2) >> 1,
      [&](int i, h16x8 (&r)[4]) {
        r[0] = ld_row8(Pbat + OFF_KVC + 128, IWP, (2 * i) * 64 + srow, SEQ, c8); r[1] = ld_row8(Pbat + OFF_KVC + 192, IWP, (2 * i) * 64 + srow, SEQ, c8);
        r[2] = ld_row8(Pbat + OFF_KVC + 128, IWP, (2 * i + 1) * 64 + srow, SEQ, c8); r[3] = ld_row8(Pbat + OFF_KVC + 192, IWP, (2 * i + 1) * 64 + srow, SEQ, c8); },
      [&](int i, const h16x8 (&r)[4]) {
        st_k(KSB(i, 0), srow, c8, r[0]); st_k(VTB(i, 0), srow, c8, r[1]); st_k(KSB(i, 1), srow, c8, r[2]); st_k(VTB(i, 1), srow, c8, r[3]); },
      [&](int i) {
        const int jb = 2 * i;
        bool sb[2];
        sb[0] = ((jb < 64 ? (slo >> jb) : (shi >> (jb - 64))) & 1ull) != 0;
        sb[1] = (jb + 1 <= cur) && (((jb + 1 < 64 ? (slo >> (jb + 1)) : (shi >> (jb + 1 - 64))) & 1ull) != 0);
        const bool far[2] = {t0 - (jb * 64 + 63) >= 799, t0 - (jb * 64 + 127) >= 799};
        const bool n0 = __any(sb[0]) != 0, n1 = __any(sb[1]) != 0;
        if (n0 && n1) attn_tile2<M_SEL, 3>(Q, O, st, KSB(i, 0), VTB(i, 0), KSB(i, 1), VTB(i, 1), biasT, tq, hd, jb * 64, far, sb, hpd, hpe, lane);
        else if (n0) attn_tile2<M_SEL, 1>(Q, O, st, KSB(i, 0), VTB(i, 0), KSB(i, 1), VTB(i, 1), biasT, tq, hd, jb * 64, far, sb, hpd, hpe, lane);
        else if (n1) attn_tile2<M_SEL, 2>(Q, O, st, KSB(i, 0), VTB(i, 0), KSB(i, 1), VTB(i, 1), biasT, tq, hd, jb * 64, far, sb, hpd, hpe, lane);
      });
    {
      const float ls = sum4q(st.l);
      const float f = ls > 0.f ? (float)gp[1] / ls : 0.f;
#pragma unroll
      for (int nt = 0; nt < 4; ++nt) Oc[nt] += O[nt] * f;
    }
#pragma unroll
    for (int nt = 0; nt < 4; ++nt) O[nt] = f32x4{0.f, 0.f, 0.f, 0.f};
    st.m = -1e30f; st.l = 0.f;
    const int w0 = cur >= 8 ? cur - 8 : 0;
    const int nwt = cur - w0 + 1;
    if (parts & 8) pair_pipeline<PFD>((nwt + 1) >> 1,
      [&](int i, h16x8 (&r)[4]) {
        r[0] = ld_row8(Pbat + OFF_KVC + 256, IWP, (w0 + 2 * i) * 64 + srow, SEQ, c8); r[1] = ld_row8(Pbat + OFF_KVC + 320, IWP, (w0 + 2 * i) * 64 + srow, SEQ, c8);
        r[2] = ld_row8(Pbat + OFF_KVC + 256, IWP, (w0 + 2 * i + 1) * 64 + srow, SEQ, c8); r[3] = ld_row8(Pbat + OFF_KVC + 320, IWP, (w0 + 2 * i + 1) * 64 + srow, SEQ, c8); },
      [&](int i, const h16x8 (&r)[4]) {
        st_k(KSB(i, 0), srow, c8, r[0]); st_k(VTB(i, 0), srow, c8, r[1]); st_k(KSB(i, 1), srow, c8, r[2]); st_k(VTB(i, 1), srow, c8, r[3]); },
      [&](int i) {
        const bool far[2] = {false, false};
        if (2 * i + 1 < nwt) attn_tile2<M_WIN, 3>(Q, O, st, KSB(i, 0), VTB(i, 0), KSB(i, 1), VTB(i, 1), biasT, tq, hd, (w0 + 2 * i) * 64, far, nosel, hpd, hpe, lane);
        else attn_tile2<M_WIN, 1>(Q, O, st, KSB(i, 0), VTB(i, 0), KSB(i, 1), VTB(i, 1), biasT, tq, hd, (w0 + 2 * i) * 64, far, nosel, hpd, hpe, lane);
      });
    {
      const float ls = sum4q(st.l);
      const float f = ls > 0.f ? (float)gp[2] / ls : 0.f;
      float ss = 0.f;
#pragma unroll
      for (int nt = 0; nt < 4; ++nt) {
        Oc[nt] += O[nt] * f;
#pragma unroll
        for (int j = 0; j < 4; ++j) ss += Oc[nt][j] * Oc[nt][j];
      }
      ss = quadsum(sum4q(ss));
      const float sc = rsqrtf(ss * (1.f / 256.f) + EPS);
#pragma unroll
      for (int nt = 0; nt < 4; ++nt)
        *(h16x4*)(OAC + ((size_t)b * SEQ + tq) * 1024 + 256 + hd * 64 + nt * 16 + q4 * 4) =
            pack4(Oc[nt][0] * sc, Oc[nt][1] * sc, Oc[nt][2] * sc, Oc[nt][3] * sc);
    }
  }
#undef KSB
#undef VTB
}

constexpr int LDS_SWA = LDS_BIAS + 4 * 64 * KP * 2 + 1024;
constexpr int lds_max(int a, int b) { return a > b ? a : b; }
constexpr int LDS_BYTES = lds_max(lds_max(LDS_NSA, SSMY_LDS), lds_max(LDS_SWA, lds_max(LDS_GEMM, lds_max(LDS_CMP, 64 * 65 * 4))));

__global__ void __launch_bounds__(NT) fwd_megakernel(Params p) {
  cg::grid_group grid = cg::this_grid();
  __shared__ __attribute__((aligned(16))) char lds[LDS_BYTES];
  __shared__ uint4 xb_words;
  __shared__ int wq_slot;
  if (threadIdx.x == 0) xb_words = make_uint4(0u, 0u, 0u, 0u);
  __syncthreads();
  (void)xcd_barrier_post((unsigned*)(WS(p) + O_BAR), (volatile LAS unsigned*)&xb_words);
#define GBAR() do { XcdBarrier _b; _b.bar = (unsigned*)(WS(p) + O_BAR); _b.x = xb_xcc_id(); _b.st = (volatile LAS unsigned*)&xb_words; xcd_barrier(_b); } while (0)
  phase0(p, (float*)lds);
  grid.sync();
  phase0b(p);
  for (int l = 0; l < DEPTH; ++l) {
    phase_gemm1(p, l, lds);
    GBAR();
    ssm_endstates(p, l, lds);
    phase_compress(p, l, lds);
    GBAR();
    {
      unsigned* q = (unsigned*)(WS(p) + O_BAR) + 3456 + l * 3 * 64;
      phase_nsa(p, l, lds, q, &wq_slot);
      ssm_outputs(p, l, lds, q + 64, &wq_slot);
      phase_swa(p, l, lds, q + 128, &wq_slot);
    }
    GBAR();
    phase_glu(p, l, lds);
    GBAR();
    phase_wout(p, l, lds);
    GBAR();
    phase_up(p, l, lds);
    GBAR();
    phase_down(p, l, lds);
    if (l + 1 < DEPTH) GBAR();
  }
}

extern "C" void kernel_launch(void* const* d_in, const int* in_sizes, int n_in, void* d_out, int out_size, void* d_ws,
                              size_t ws_size, hipStream_t stream) {
  static int grid_blocks = 0;
  if (!grid_blocks) {
    int dev = 0, cus = 0, per_cu = 0;
    (void)hipGetDevice(&dev);
    (void)hipDeviceGetAttribute(&cus, hipDeviceAttributeMultiprocessorCount, dev);
    (void)hipOccupancyMaxActiveBlocksPerMultiprocessor(&per_cu, fwd_megakernel, NT, 0);
    if (per_cu > 1) per_cu = 1;
    grid_blocks = cus * per_cu;
  }
  if (ws_size < WS_NEED) {
    fprintf(stderr, "workspace too small: %zu < %zu\n", ws_size, WS_NEED);
    return;
  }
  Params p{};
  for (int i = 0; i < 24; ++i) p.in[i] = (const float*)d_in[i];
  p.out = (float*)d_out;
  p.ws = (char*)d_ws;
  (void)hipMemsetAsync((char*)d_ws + O_BAR, 0, SZ_BAR, stream);
  void* args[] = {&p};
  hipError_t e = hipLaunchCooperativeKernel((void*)fwd_megakernel, dim3(grid_blocks), dim3(NT), args, 0, stream);
  if (e != hipSuccess) fprintf(stderr, "cooperative launch failed: %s (grid %d)\n", hipGetErrorString(e), grid_blocks);
}
```
